# Optimizing an MI355X kernel written in HIP

```python
import jax
import jax.numpy as jnp
from jax import lax
import numpy as np

D_MODEL = 1024
BATCH = 8
SEQ = 2048
DEPTH = 4

GRID_W = 64
CTX_LEN = 256
CONV_WIDTH = 512
CONV_TAPS = 3
HG_WIDTH = 512
HG_HEADS = 4
HG_HEAD_DIM = HG_WIDTH // HG_HEADS
MIX_WIDTH = CONV_WIDTH + HG_WIDTH
PROJ_WIDTH = 3 * CONV_WIDTH + 5 * HG_WIDTH
PROJ_SPLITS = (CONV_WIDTH, 2 * CONV_WIDTH, 3 * CONV_WIDTH, 3 * CONV_WIDTH + HG_WIDTH, 3 * CONV_WIDTH + 2 * HG_WIDTH, 3 * CONV_WIDTH + 3 * HG_WIDTH, 3 * CONV_WIDTH + 4 * HG_WIDTH)
CTX_STATE_LO = 3 * CONV_WIDTH + HG_WIDTH
CTX_STATE_HI = 3 * CONV_WIDTH + 4 * HG_WIDTH
CHUNK = 16
N_GROUPS = 4
EXPERTS_PER_GROUP = 8
N_EXPERTS = N_GROUPS * EXPERTS_PER_GROUP
TOP_K = 2
D_EXPERT = 512
ROUTE_BLOCK = 128
N_MOD = 6
NORM_EPS = 1e-6

kernel_name = 'hybrid_conv_hgrn2_hmoe_dit'


def rms_norm(x, w):
    xf = x.astype(jnp.float32)
    y = xf * lax.rsqrt(jnp.mean(xf * xf, axis=-1, keepdims=True) + NORM_EPS)
    return (y * w.astype(jnp.float32)).astype(x.dtype)


def modulate(x, shift, scale):
    return x * (1 + scale) + shift


def heads(a):
    return a.reshape(a.shape[0], a.shape[1], HG_HEADS, HG_HEAD_DIM)


def conv3_seq(u, w):
    up = jnp.pad(u, ((0, 0), (1, 1), (0, 0)))
    return w[0] * up[:, :-2] + w[1] * up[:, 1:-1] + w[2] * up[:, 2:]


def conv3_grid(u, w, rows):
    bsz, t_len, ch = u.shape
    half = ch // 2
    g = u.reshape(bsz, rows, GRID_W, ch)
    gh = jnp.pad(g[..., :half], ((0, 0), (0, 0), (1, 1), (0, 0)))
    wh = w[:, :half]
    yh = wh[0] * gh[:, :, :-2] + wh[1] * gh[:, :, 1:-1] + wh[2] * gh[:, :, 2:]
    gv = jnp.pad(g[..., half:], ((0, 0), (1, 1), (0, 0), (0, 0)))
    wv = w[:, half:]
    yv = wv[0] * gv[:, :-2] + wv[1] * gv[:, 1:-1] + wv[2] * gv[:, 2:]
    return jnp.concatenate([yh, yv], axis=-1).reshape(bsz, t_len, ch)


def hgrn2_lower_bounds(lb_raw):
    p = jax.nn.softmax(lb_raw.astype(jnp.float32), axis=1)
    cs = jnp.cumsum(p, axis=1)
    return cs - cs[:, :1]


def hgrn2_forget(zf, lb):
    zf = zf.astype(jnp.float32)
    logf = jnp.logaddexp(jnp.log(lb), jnp.log1p(-lb) + jax.nn.log_sigmoid(zf))
    return heads(logf), heads(-jnp.expm1(logf))


def gla_chunked(q, k, v, logf, s0):
    bsz, t_len, n_h, d_k = q.shape
    d_v = v.shape[-1]
    n_c = t_len // CHUNK
    q, k, logf = [a.astype(jnp.float32).reshape(bsz, n_c, CHUNK, n_h, d_k) for a in (q, k, logf)]
    v = v.astype(jnp.float32).reshape(bsz, n_c, CHUNK, n_h, d_v)
    b = jnp.cumsum(logf, axis=2)
    order = jnp.tril(jnp.ones((CHUNK, CHUNK), dtype=bool))[None, None, :, :, None, None]
    diff = b[:, :, :, None] - b[:, :, None, :]
    decay = jnp.exp(jnp.where(order, diff, -jnp.inf))
    scores = jnp.einsum('bnthk,bnshk,bntshk->bnhts', q, k, decay)
    o_intra = jnp.einsum('bnhts,bnshv->bnthv', scores, v)
    b_last = b[:, :, -1:]
    q_in = q * jnp.exp(b)
    k_out = k * jnp.exp(b_last - b)
    d_chunk = jnp.exp(b_last[:, :, 0])

    def step(state, inp):
        q_c, k_c, v_c, d_c = inp
        o_c = jnp.einsum('bthk,bhkv->bthv', q_c, state)
        state = d_c[..., None] * state + jnp.einsum('bthk,bthv->bhkv', k_c, v_c)
        return state, o_c

    xs = tuple(jnp.moveaxis(a, 1, 0) for a in (q_in, k_out, v, d_chunk))
    s_fin, o_inter = lax.scan(step, s0.astype(jnp.float32), xs)
    o = o_intra + jnp.moveaxis(o_inter, 0, 1)
    return o.reshape(bsz, t_len, n_h, d_v), s_fin


def gla_final_state(k, logf, v):
    b = jnp.cumsum(logf, axis=1)
    return jnp.einsum('bthk,bthv->bhkv', k * jnp.exp(b[:, -1:] - b), v.astype(jnp.float32))


def hgrn2_mixer(q_raw, zf_f, zf_b, i_raw, g_raw, lb_f, lb_b, norm_w, s0_f, s0_b):
    q = heads(jax.nn.silu(q_raw.astype(jnp.float32)))
    v = heads(i_raw.astype(jnp.float32))
    logf_f, k_f = hgrn2_forget(zf_f, lb_f)
    logf_b, k_b = hgrn2_forget(zf_b, lb_b)
    o_f, s_f = gla_chunked(q, k_f, v, logf_f, s0_f)
    rev = lambda a: jnp.flip(a, axis=1)
    o_b, s_b = gla_chunked(rev(q), rev(k_b), rev(v), rev(logf_b), s0_b)
    o = rms_norm(o_f + rev(o_b), norm_w) * jax.nn.silu(heads(g_raw.astype(jnp.float32)))
    return o.reshape(q_raw.shape[0], q_raw.shape[1], HG_WIDTH).astype(q_raw.dtype), s_f, s_b


def hgrn2_context_states(zf_f, zf_b, i_raw, lb_f, lb_b):
    v = heads(i_raw.astype(jnp.float32))
    logf_f, k_f = hgrn2_forget(zf_f, lb_f)
    logf_b, k_b = hgrn2_forget(zf_b, lb_b)
    rev = lambda a: jnp.flip(a, axis=1)
    return gla_final_state(k_f, logf_f, v), gla_final_state(rev(k_b), rev(logf_b), rev(v))


def token_mixer(h, w_in_l, conv_w_l, conv_norm_w_l, lb_f, lb_b, hg_norm_w_l, s0_f, s0_b, conv_fn):
    p = h @ w_in_l
    bg, cg, hv, q, zf_f, zf_b, iv, g = jnp.split(p, PROJ_SPLITS, axis=-1)
    y_conv = rms_norm(bg * conv_fn(cg * hv, conv_w_l), conv_norm_w_l)
    y_rec, s_f, s_b = hgrn2_mixer(q, zf_f, zf_b, iv, g, lb_f, lb_b, hg_norm_w_l, s0_f, s0_b)
    return jnp.concatenate([y_conv, y_rec], axis=-1), s_f, s_b


def hier_moe(t, w_rg, b_rg, w_re, b_re, w_gu, w_down):
    n_tok, d = t.shape
    tf = t.astype(jnp.float32)
    g_logits = tf @ w_rg.astype(jnp.float32) + b_rg.astype(jnp.float32)
    g_sel = jnp.argmax(g_logits, axis=-1)
    p_group = jnp.take_along_axis(jax.nn.softmax(g_logits, axis=-1), g_sel[:, None], axis=-1)
    e_logits = (tf @ w_re.astype(jnp.float32) + b_re.astype(jnp.float32)).reshape(n_tok, N_GROUPS, EXPERTS_PER_GROUP)
    e_logits = jnp.take_along_axis(e_logits, g_sel[:, None, None], axis=1)[:, 0]
    top_p, top_i = lax.top_k(jax.nn.softmax(e_logits, axis=-1), TOP_K)
    gate = p_group * top_p / jnp.sum(top_p, axis=-1, keepdims=True)
    expert_id = g_sel[:, None].astype(jnp.int32) * EXPERTS_PER_GROUP + top_i.astype(jnp.int32)
    n_assign = n_tok * TOP_K
    flat_e = expert_id.reshape(-1)
    flat_tok = jnp.repeat(jnp.arange(n_tok, dtype=jnp.int32), TOP_K)
    flat_gate = gate.reshape(-1)
    order = jnp.argsort(flat_e)
    sorted_e = flat_e[order]
    counts = jnp.bincount(flat_e, length=N_EXPERTS)
    starts = jnp.cumsum(counts) - counts
    padded = (counts + ROUTE_BLOCK - 1) // ROUTE_BLOCK * ROUTE_BLOCK
    pad_ends = jnp.cumsum(padded)
    pad_starts = pad_ends - padded
    dest = pad_starts[sorted_e] + jnp.arange(n_assign, dtype=jnp.int32) - starts[sorted_e]
    n_blocks = -(-(n_assign + N_EXPERTS * (ROUTE_BLOCK - 1)) // ROUTE_BLOCK)
    n_rows = n_blocks * ROUTE_BLOCK
    row_tok = jnp.full((n_rows,), n_tok, dtype=jnp.int32).at[dest].set(flat_tok[order])
    row_gate = jnp.zeros((n_rows,), jnp.float32).at[dest].set(flat_gate[order])
    block_e = jnp.minimum(jnp.searchsorted(pad_ends, jnp.arange(n_blocks) * ROUTE_BLOCK, side='right'), N_EXPERTS - 1)
    t_pad = jnp.concatenate([t, jnp.zeros((1, d), t.dtype)], axis=0)
    xb = t_pad[row_tok].reshape(n_blocks, ROUTE_BLOCK, d)

    def expert_block(args):
        x_blk, e = args
        a, u = jnp.split(x_blk @ w_gu[e], 2, axis=-1)
        return (jax.nn.silu(a) * u) @ w_down[e]

    yb = lax.map(expert_block, (xb, block_e)).reshape(n_rows, d)
    out = jnp.zeros((n_tok + 1, d), t.dtype).at[row_tok].add((yb * row_gate[:, None]).astype(t.dtype))
    return out[:n_tok]


def setup_inputs(seed: int = 0) -> dict:
    key = jax.random.key(seed)
    ks = jax.random.split(key, 20)
    f32 = jnp.float32
    nrm = lambda k, shape, s: jax.random.normal(k, shape, f32) * s
    d = D_MODEL
    return {
        'x': nrm(ks[0], (BATCH, SEQ, d), 1.0),
        'c': nrm(ks[1], (BATCH, d), 1.0),
        'ctx': nrm(ks[2], (BATCH, CTX_LEN, d), 1.0),
        'c_ctx': nrm(ks[3], (d,), 1.0),
        'norm_w': 1.0 + nrm(ks[4], (DEPTH, 2, d), 0.02),
        'w_ada': nrm(ks[5], (DEPTH, d, N_MOD * d), 0.5 * d ** -0.5),
        'b_ada': nrm(ks[6], (DEPTH, N_MOD * d), 0.02),
        'w_in': nrm(ks[7], (DEPTH, d, PROJ_WIDTH), d ** -0.5),
        'conv_w': nrm(ks[8], (DEPTH, CONV_TAPS, CONV_WIDTH), CONV_TAPS ** -0.5),
        'conv_norm_w': 1.0 + nrm(ks[9], (DEPTH, CONV_WIDTH), 0.02),
        'hg_lb': nrm(ks[10], (2, DEPTH, HG_WIDTH), 1.0),
        'hg_norm_w': 1.0 + nrm(ks[11], (DEPTH, HG_HEAD_DIM), 0.02),
        'w_out': nrm(ks[12], (DEPTH, MIX_WIDTH, d), MIX_WIDTH ** -0.5),
        'w_rg': nrm(ks[13], (DEPTH, d, N_GROUPS), d ** -0.5),
        'b_rg': nrm(ks[14], (DEPTH, N_GROUPS), 0.01),
        'w_re': nrm(ks[15], (DEPTH, d, N_EXPERTS), d ** -0.5),
        'b_re': nrm(ks[16], (DEPTH, N_EXPERTS), 0.01),
        'w_e_gu': nrm(ks[17], (DEPTH, N_EXPERTS, d, 2 * D_EXPERT), d ** -0.5),
        'w_e_down': nrm(ks[18], (DEPTH, N_EXPERTS, D_EXPERT, d), D_EXPERT ** -0.5),
        'final_norm_w': 1.0 + nrm(ks[19], (d,), 0.02),
    }


def reference(x, c, ctx, c_ctx, norm_w, w_ada, b_ada, w_in, conv_w, conv_norm_w, hg_lb, hg_norm_w, w_out, w_rg, b_rg, w_re, b_re, w_e_gu, w_e_down, final_norm_w):
    bsz, t_len, d = x.shape
    rows = t_len // GRID_W
    lb = hgrn2_lower_bounds(hg_lb)
    sc = jax.nn.silu(c)
    scc = jax.nn.silu(c_ctx)
    latent_conv = lambda u, w: conv3_grid(u, w, rows)
    zero_state = jnp.zeros((bsz, HG_HEADS, HG_HEAD_DIM, HG_HEAD_DIM), jnp.float32)
    for l in range(DEPTH):
        last = l == DEPTH - 1
        mod = (sc @ w_ada[l] + b_ada[l]).reshape(bsz, N_MOD, 1, d)
        modc = (scc @ w_ada[l] + b_ada[l]).reshape(N_MOD, d)
        h = modulate(rms_norm(x, norm_w[l, 0]), mod[:, 0], mod[:, 1])
        hc = modulate(rms_norm(ctx, norm_w[l, 0]), modc[0], modc[1])
        if last:
            zf_f, zf_b, iv = jnp.split(hc @ w_in[l][:, CTX_STATE_LO:CTX_STATE_HI], 3, axis=-1)
            s_f, s_b = hgrn2_context_states(zf_f, zf_b, iv, lb[0, l], lb[1, l])
        else:
            yc, s_f, s_b = token_mixer(hc, w_in[l], conv_w[l], conv_norm_w[l], lb[0, l], lb[1, l], hg_norm_w[l], zero_state, zero_state, conv3_seq)
            ctx = ctx + modc[2] * (yc @ w_out[l])
        y, _, _ = token_mixer(h, w_in[l], conv_w[l], conv_norm_w[l], lb[0, l], lb[1, l], hg_norm_w[l], s_f, s_b, latent_conv)
        x = x + mod[:, 2] * (y @ w_out[l])
        h2 = modulate(rms_norm(x, norm_w[l, 1]), mod[:, 3], mod[:, 4])
        moe_w = (w_rg[l], b_rg[l], w_re[l], b_re[l], w_e_gu[l], w_e_down[l])
        if last:
            f = hier_moe(h2.reshape(bsz * t_len, d), *moe_w).reshape(bsz, t_len, d)
        else:
            hc2 = modulate(rms_norm(ctx, norm_w[l, 1]), modc[3], modc[4])
            n_lat = bsz * t_len
            f_all = hier_moe(jnp.concatenate([h2.reshape(n_lat, d), hc2.reshape(-1, d)], axis=0), *moe_w)
            f = f_all[:n_lat].reshape(bsz, t_len, d)
            ctx = ctx + modc[5] * f_all[n_lat:].reshape(ctx.shape)
        x = x + mod[:, 5] * f
    return rms_norm(x, final_norm_w)
```

```cpp
#include <hip/hip_runtime.h>
#include <stdint.h>
#include <stdio.h>

typedef unsigned short bf16_t;
typedef short bf16x8 __attribute__((ext_vector_type(8)));
typedef float f32x4 __attribute__((ext_vector_type(4)));
typedef unsigned u32x4 __attribute__((ext_vector_type(4)));
typedef unsigned u32x2 __attribute__((ext_vector_type(2)));
#define LAS __attribute__((address_space(3)))

constexpr int D = 1024, NB = 8, SEQ = 2048, DEPTH = 4, CTXL = 256;
constexpr int NLAT = NB * SEQ, NCTX = NB * CTXL, NTOK = NLAT + NCTX;
constexpr int PW = 4096;
constexpr int OFF_B = 0, OFF_C = 512, OFF_HV = 1024, OFF_Q = 1536, OFF_ZF = 2048, OFF_I = 3072, OFF_G = 3584;
constexpr int NEXP = 32;
constexpr int NCHUNK = NTOK / 16;
constexpr float EPS = 1e-6f;
constexpr int NMODP = 16;

constexpr size_t WS_CTL = 0, CTL_BYTES = 65536;
constexpr size_t WS_WIN = WS_CTL + CTL_BYTES;
constexpr size_t WS_WOUT = WS_WIN + (size_t)4 * 4096 * 1024 * 2;
constexpr size_t WS_WGU = WS_WOUT + (size_t)4 * 1024 * 1024 * 2;
constexpr size_t WS_WDN = WS_WGU + (size_t)4 * 32 * 1024 * 1024 * 2;
constexpr size_t WS_MODP = WS_WDN + (size_t)4 * 32 * 1024 * 512 * 2;
constexpr size_t WS_MOD = WS_MODP + (size_t)4 * NMODP * 9 * 6144 * 4;
constexpr size_t WS_X = WS_MOD + (size_t)4 * 9 * 6144 * 4;
constexpr size_t WS_H = WS_X + (size_t)NTOK * 1024 * 4;
constexpr size_t WS_P = WS_H + (size_t)NTOK * 1024 * 2;
constexpr size_t WS_Y = WS_P + (size_t)NTOK * 4096 * 2;
constexpr size_t WS_QIN = WS_Y + (size_t)NTOK * 1024 * 2;
constexpr size_t WS_KOUT = WS_QIN + (size_t)2 * NTOK * 512 * 2;
constexpr size_t WS_DCH = WS_KOUT + (size_t)2 * NTOK * 512 * 2;
constexpr size_t WS_OINTRA = WS_DCH + (size_t)2 * NCHUNK * 512 * 4;
constexpr size_t WS_OINTER = WS_OINTRA + (size_t)NTOK * 512 * 4;
constexpr size_t WS_LTOK = WS_OINTER + (size_t)2 * NTOK * 512 * 4;
constexpr size_t WS_LGATE = WS_LTOK + (size_t)32 * NTOK * 4;
constexpr int HID_ROWS = 2 * NTOK + 32 * 256;
constexpr size_t WS_HID = WS_LGATE + (size_t)32 * NTOK * 4;
constexpr size_t WS_YB = WS_HID + (size_t)HID_ROWS * 512 * 2;
constexpr size_t WS_END = WS_YB + (size_t)2 * NTOK * 1024 * 2;
constexpr int CW_BAR = 0;
constexpr int CW_CNT = 8192;

constexpr int LDS_BYTES = 147456;
constexpr int LDS_MISC = 143360;
constexpr int NPH = 2 + 9 * DEPTH + 1;

__device__ __forceinline__ float bf2f(bf16_t b) { return __uint_as_float(((unsigned)b) << 16); }
__device__ __forceinline__ unsigned f2bf(float f) { unsigned u = __float_as_uint(f); return (u + 0x7fffu + ((u >> 16) & 1u)) >> 16; }
__device__ __forceinline__ unsigned pk2(float lo, float hi) { return f2bf(lo) | (f2bf(hi) << 16); }
__device__ __forceinline__ float wave_sum(float v) {
#pragma unroll
    for (int o = 1; o < 64; o <<= 1) v += __shfl_xor(v, o);
    return v;
}
__device__ __forceinline__ float sigmoidf(float x) { return 1.0f / (1.0f + __expf(-x)); }
__device__ __forceinline__ float siluf(float x) { return x / (1.0f + __expf(-x)); }
__device__ __forceinline__ int mod_row(int r) { return r < NLAT ? (r >> 11) : 8; }
#define LDS_WAIT() asm volatile("s_waitcnt lgkmcnt(0)" ::: "memory")
__device__ __forceinline__ int otid() { int t = threadIdx.x; asm volatile("" : "+v"(t)); return t; }
__device__ __forceinline__ int obid() { int b = blockIdx.x; asm volatile("" : "+s"(b)); return b; }

#define XB_TMO      128
#define XB_XCNT(j)  (256  + 64 * (j))
#define XB_XSUB(j)  (1280 + 64 * (j))
#define XB_XGEN(j)  (2304 + 64 * (j))
#define XB_TOP      3328
#define XB_TOPGEN   3392
#define XCD_BAR_WORDS 3456
#define XB_SPIN_CAP (1u << 18)
__device__ __forceinline__ unsigned xb_ld(unsigned* p)              { return __hip_atomic_load(p, __ATOMIC_RELAXED, __HIP_MEMORY_SCOPE_AGENT); }
__device__ __forceinline__ unsigned xb_add(unsigned* p, unsigned v) { return __hip_atomic_fetch_add(p, v, __ATOMIC_RELAXED, __HIP_MEMORY_SCOPE_AGENT); }
__device__ __forceinline__ unsigned xb_xcc_id() { return (unsigned)__builtin_amdgcn_s_getreg((3 << 11) | 20) & 0xFu; }
#define XB_SPIN(cond, bar) do { unsigned _sp = 0; while (cond) { __builtin_amdgcn_s_sleep(1); \
    if ((++_sp & 255u) == 0u) { if (xb_ld(&(bar)[XB_TMO])) break; if (_sp > XB_SPIN_CAP) { atomicAdd(&(bar)[XB_TMO], 1u); break; } } } } while (0)
struct XcdBarrier { unsigned* bar; unsigned x; volatile LAS unsigned* st; };
__device__ __forceinline__ XcdBarrier xcd_barrier_post(unsigned* bar, volatile LAS unsigned* st) {
    XcdBarrier b; b.bar = bar; b.x = xb_xcc_id(); b.st = st;
    if (threadIdx.x == 0) (void)xb_add(&bar[XB_XCNT(b.x)], 1u);
    return b;
}
__device__ __forceinline__ void xcd_barrier_complete(unsigned* bar, unsigned x, unsigned& nloc, unsigned& nx) {
    const unsigned G = gridDim.x * gridDim.y * gridDim.z;
    unsigned sum, cnt, mine, sp = 0u;
    for (;;) {
        sum = 0u; cnt = 0u; mine = 0u;
#pragma unroll
        for (unsigned j = 0; j < 16; ++j) { const unsigned c = xb_ld(&bar[XB_XCNT(j)]); sum += c; cnt += (c > 0u) ? 1u : 0u; mine = (j == x) ? c : mine; }
        if (sum == G) break;
        __builtin_amdgcn_s_sleep(1);
        if ((++sp & 255u) == 0u) { if (xb_ld(&bar[XB_TMO])) break; if (sp > XB_SPIN_CAP) { atomicAdd(&bar[XB_TMO], 1u); break; } }
    }
    nloc = mine > 0u ? mine : 1u; nx = cnt > 0u ? cnt : 1u;
}
__device__ __forceinline__ void xcd_barrier(const XcdBarrier& b) {
    asm volatile("s_waitcnt vmcnt(0)" ::: "memory");
    __syncthreads();
    if (threadIdx.x == 0) {
        unsigned* bar = b.bar;
        __builtin_amdgcn_s_waitcnt(0);
        unsigned nloc = b.st[0], nx = b.st[1];
        if (nloc == 0u) { xcd_barrier_complete(bar, b.x, nloc, nx); b.st[0] = nloc; b.st[1] = nx; }
        const unsigned old = xb_add(&bar[XB_XSUB(b.x)], 1u);
        const unsigned gen = old / nloc;
        if (old + 1u == (gen + 1u) * nloc) {
            __builtin_amdgcn_fence(__ATOMIC_RELEASE, "agent");
            asm volatile("s_waitcnt vmcnt(0)" ::: "memory");
            const unsigned og = xb_add(&bar[XB_TOP], 1u);
            const unsigned tg = og / nx;
            if (og + 1u == (tg + 1u) * nx) xb_add(&bar[XB_TOPGEN], 1u);
            else XB_SPIN(xb_ld(&bar[XB_TOPGEN]) == tg, bar);
            __builtin_amdgcn_fence(__ATOMIC_ACQUIRE, "agent");
            xb_add(&bar[XB_XGEN(b.x)], 1u);
            asm volatile("s_waitcnt vmcnt(0)" ::: "memory");
        } else {
            XB_SPIN(xb_ld(&bar[XB_XGEN(b.x)]) == gen, bar);
            __builtin_amdgcn_fence(__ATOMIC_ACQUIRE, "agent");
            asm volatile("s_waitcnt vmcnt(0)" ::: "memory");
        }
    }
    __syncthreads();
}

struct Params {
    const float* in[20];
    float* out;
    unsigned char* ws;
    int ph_lo, ph_hi;
};

template <class ARow, class Epi>
__device__ __forceinline__ void gemm128(unsigned char* lds, const ARow& arow, const bf16_t* __restrict__ Bt, int K, const Epi& epi) {
    const int tid = otid(), lane = tid & 63, wid = tid >> 6, wr = wid >> 2, wc = wid & 3, fr = lane & 15, fq = lane >> 4;
    bf16_t* sA = (bf16_t*)lds;
    bf16_t* sB = (bf16_t*)(lds + 128 * 144);
    f32x4 acc[4][2];
#pragma unroll
    for (int m = 0; m < 4; ++m)
#pragma unroll
        for (int n = 0; n < 2; ++n) acc[m][n] = (f32x4){0.f, 0.f, 0.f, 0.f};
    const bf16_t* ap[2]; const bf16_t* bp[2]; int so[2];
#pragma unroll
    for (int i = 0; i < 2; ++i) {
        const int q = tid + 512 * i, row = q >> 3, seg = q & 7;
        ap[i] = arow(row) + seg * 8; bp[i] = Bt + (size_t)row * K + seg * 8; so[i] = row * 72 + seg * 8;
    }
    for (int k0 = 0; k0 < K; k0 += 64) {
        u32x4 va[2], vb[2];
#pragma unroll
        for (int i = 0; i < 2; ++i) { va[i] = *(const u32x4*)(ap[i] + k0); vb[i] = *(const u32x4*)(bp[i] + k0); }
        __syncthreads();
#pragma unroll
        for (int i = 0; i < 2; ++i) { *(u32x4*)(sA + so[i]) = va[i]; *(u32x4*)(sB + so[i]) = vb[i]; }
        __syncthreads();
#pragma unroll
        for (int kk = 0; kk < 2; ++kk) {
            bf16x8 a[4], b[2];
#pragma unroll
            for (int m = 0; m < 4; ++m) a[m] = *(const bf16x8*)(sA + (wr * 64 + m * 16 + fr) * 72 + kk * 32 + fq * 8);
#pragma unroll
            for (int n = 0; n < 2; ++n) b[n] = *(const bf16x8*)(sB + (wc * 32 + n * 16 + fr) * 72 + kk * 32 + fq * 8);
#pragma unroll
            for (int m = 0; m < 4; ++m)
#pragma unroll
                for (int n = 0; n < 2; ++n) acc[m][n] = __builtin_amdgcn_mfma_f32_16x16x32_bf16(b[n], a[m], acc[m][n], 0, 0, 0);
        }
    }
#pragma unroll
    for (int m = 0; m < 4; ++m)
#pragma unroll
        for (int n = 0; n < 2; ++n) epi(wr * 64 + m * 16 + fr, wc * 32 + n * 16 + fq * 4, acc[m][n]);
    __syncthreads();
}

struct ARowPlain { const bf16_t* A; int ld; __device__ __forceinline__ const bf16_t* operator()(int i) const { return A + (size_t)i * ld; } };
struct ARowGather { const bf16_t* A; const int* tok; int nvalid; __device__ __forceinline__ const bf16_t* operator()(int i) const { const int t = (i < nvalid) ? (tok[i] >> 1) : 0; return A + (size_t)t * 1024; } };

struct EpiP { bf16_t* P; __device__ __forceinline__ void operator()(int r, int c, f32x4 v) const {
    u32x2 w; w.x = pk2(v[0], v[1]); w.y = pk2(v[2], v[3]); *(u32x2*)(P + (size_t)r * PW + c) = w; } };
struct EpiRes { float* X; const float* gate; int m0; __device__ __forceinline__ void operator()(int r, int c, f32x4 v) const {
    const float* g = gate + (size_t)mod_row(m0 + r) * 6144 + c; float* xp = X + (size_t)r * 1024 + c;
    f32x4 x = *(f32x4*)xp; const f32x4 gv = *(const f32x4*)g; x += gv * v; *(f32x4*)xp = x; } };
struct EpiGU { bf16_t* H; __device__ __forceinline__ void operator()(int r, int c, f32x4 v) const {
    const float h0 = siluf(v[0]) * v[1], h1 = siluf(v[2]) * v[3]; *(unsigned*)(H + (size_t)r * 512 + (c >> 1)) = pk2(h0, h1); } };
struct EpiDown { bf16_t* YB; const int* tok; const float* gate; int nvalid; __device__ __forceinline__ void operator()(int r, int c, f32x4 v) const {
    if (r < nvalid) { const int e = tok[r]; const float g = gate[r]; u32x2 w; w.x = pk2(g * v[0], g * v[1]); w.y = pk2(g * v[2], g * v[3]); *(u32x2*)(YB + (size_t)e * 1024 + c) = w; } } };

__device__ __forceinline__ void transpose_item(const float* __restrict__ W, int K, int N, bf16_t* __restrict__ WT, int mode, float* scr, int item, int lane) {
    const int nblk = N / 32, kb = item / nblk, nb = item % nblk, k0 = 64 * kb, n0 = 32 * nb;
#pragma unroll 8
    for (int i = 0; i < 32; ++i) { const int kk = 2 * i + (lane >> 5); scr[kk * 33 + (lane & 31)] = W[(size_t)(k0 + kk) * N + n0 + (lane & 31)]; }
    LDS_WAIT();
    const int c = lane & 7;
#pragma unroll
    for (int j = 0; j < 4; ++j) {
        const int n = (lane >> 3) + 8 * j; const float* s = scr + (8 * c) * 33 + n;
        u32x4 o; o.x = pk2(s[0 * 33], s[1 * 33]); o.y = pk2(s[2 * 33], s[3 * 33]); o.z = pk2(s[4 * 33], s[5 * 33]); o.w = pk2(s[6 * 33], s[7 * 33]);
        const int nabs = n0 + n; const int orow = mode ? ((nabs < 512) ? 2 * nabs : 2 * (nabs - 512) + 1) : nabs;
        *(u32x4*)(WT + (size_t)orow * K + k0 + 8 * c) = o;
    }
    LDS_WAIT();
}

__device__ __forceinline__ void phase_prologue(const Params& p, unsigned char* lds) {
    const int tid = otid(), lane = tid & 63, wid = tid >> 6;
    float* scr = (float*)(lds + wid * 16384);
    const int gw = obid() * 8 + wid, NGW = gridDim.x * 8;
    bf16_t* win_t = (bf16_t*)(p.ws + WS_WIN); bf16_t* wout_t = (bf16_t*)(p.ws + WS_WOUT);
    bf16_t* wgu_t = (bf16_t*)(p.ws + WS_WGU); bf16_t* wdn_t = (bf16_t*)(p.ws + WS_WDN);
    constexpr int I_IN = 16 * 128, I_OUT = 16 * 32, I_GU = 16 * 32, I_DN = 8 * 32;
    constexpr int T_IN = 4 * I_IN, T_OUT = 4 * I_OUT, T_GU = 128 * I_GU, T_DN = 128 * I_DN;
    for (int it = gw; it < T_IN + T_OUT + T_GU + T_DN; it += NGW) {
        int r = it;
        if (r < T_IN) { const int m = r / I_IN; transpose_item(p.in[7] + (size_t)m * 1024 * 4096, 1024, 4096, win_t + (size_t)m * 4096 * 1024, 0, scr, r % I_IN, lane); continue; } r -= T_IN;
        if (r < T_OUT) { const int m = r / I_OUT; transpose_item(p.in[12] + (size_t)m * 1024 * 1024, 1024, 1024, wout_t + (size_t)m * 1024 * 1024, 0, scr, r % I_OUT, lane); continue; } r -= T_OUT;
        if (r < T_GU) { const int m = r / I_GU; transpose_item(p.in[17] + (size_t)m * 1024 * 1024, 1024, 1024, wgu_t + (size_t)m * 1024 * 1024, 1, scr, r % I_GU, lane); continue; } r -= T_GU;
        { const int m = r / I_DN; transpose_item(p.in[18] + (size_t)m * 512 * 1024, 512, 1024, wdn_t + (size_t)m * 1024 * 512, 0, scr, r % I_DN, lane); }
    }
    __syncthreads();
    float* modp = (float*)(p.ws + WS_MODP);
    float* sS = (float*)lds;
    for (int u = obid(); u < 4 * 24 * 8; u += gridDim.x) {
        const int l = u / 192, rem = u % 192, nb = rem / 8, ks = rem % 8;
        __syncthreads();
        for (int i = tid; i < 9 * 128; i += 512) { const int r = i >> 7, k = i & 127; const float cv = (r < 8) ? p.in[1][r * 1024 + ks * 128 + k] : p.in[3][ks * 128 + k]; sS[i] = siluf(cv); }
        __syncthreads();
        const int col = nb * 256 + (tid & 255), kh = tid >> 8;
        float acc[9];
#pragma unroll
        for (int r = 0; r < 9; ++r) acc[r] = 0.f;
        const float* w = p.in[5] + ((size_t)l * 1024 + ks * 128 + kh * 64) * 6144 + col;
        for (int k = 0; k < 64; ++k) {
            const float wv = w[(size_t)k * 6144];
#pragma unroll
            for (int r = 0; r < 9; ++r) acc[r] += sS[r * 128 + kh * 64 + k] * wv;
        }
#pragma unroll
        for (int r = 0; r < 9; ++r) modp[(((size_t)l * NMODP + ks * 2 + kh) * 9 + r) * 6144 + col] = acc[r];
    }
}

__device__ __forceinline__ void phase_modreduce(const Params& p) {
    const float* modp = (const float*)(p.ws + WS_MODP); float* modv = (float*)(p.ws + WS_MOD);
    for (int i = obid() * 512 + otid(); i < 4 * 9 * 6144; i += gridDim.x * 512) {
        const int l = i / (9 * 6144), rem = i % (9 * 6144), n = rem % 6144;
        float s = p.in[6][l * 6144 + n];
        for (int j = 0; j < NMODP; ++j) s += modp[((size_t)l * NMODP + j) * 9 * 6144 + rem];
        modv[i] = s;
    }
}

__device__ __forceinline__ void phase_norm1(const Params& p, int l) {
    const int lane = otid() & 63, wid = otid() >> 6;
    float* xws = (float*)(p.ws + WS_X); bf16_t* hb = (bf16_t*)(p.ws + WS_H); const bf16_t* yb = (const bf16_t*)(p.ws + WS_YB);
    const float* modv = (const float*)(p.ws + WS_MOD);
    const float* nw = p.in[4] + (size_t)(l * 2 + 0) * 1024;
    for (int r = obid() * 8 + wid; r < NTOK; r += gridDim.x * 8) {
        const int mr = mod_row(r);
        const float* src = (l == 0) ? (r < NLAT ? p.in[0] + (size_t)r * 1024 : p.in[2] + (size_t)(r - NLAT) * 1024) : xws + (size_t)r * 1024;
        f32x4 v[4];
#pragma unroll
        for (int j = 0; j < 4; ++j) v[j] = *(const f32x4*)(src + 4 * lane + 256 * j);
        if (l > 0) {
            const float* g5 = modv + ((size_t)(l - 1) * 9 + mr) * 6144 + 5 * 1024;
#pragma unroll
            for (int j = 0; j < 4; ++j) {
                const int c = 4 * lane + 256 * j;
                const u32x2 y0 = *(const u32x2*)(yb + (size_t)(2 * r) * 1024 + c), y1 = *(const u32x2*)(yb + (size_t)(2 * r + 1) * 1024 + c);
                const f32x4 gv = *(const f32x4*)(g5 + c);
                f32x4 f; f[0] = bf2f(y0.x & 0xffff) + bf2f(y1.x & 0xffff); f[1] = bf2f(y0.x >> 16) + bf2f(y1.x >> 16);
                f[2] = bf2f(y0.y & 0xffff) + bf2f(y1.y & 0xffff); f[3] = bf2f(y0.y >> 16) + bf2f(y1.y >> 16);
                v[j] += gv * f;
            }
        }
#pragma unroll
        for (int j = 0; j < 4; ++j) *(f32x4*)(xws + (size_t)r * 1024 + 4 * lane + 256 * j) = v[j];
        float ss = 0.f;
#pragma unroll
        for (int j = 0; j < 4; ++j) ss += (v[j][0] * v[j][0] + v[j][1] * v[j][1]) + (v[j][2] * v[j][2] + v[j][3] * v[j][3]);
        const float rstd = rsqrtf(wave_sum(ss) * (1.0f / 1024.0f) + EPS);
        const float* msh = modv + ((size_t)l * 9 + mr) * 6144; const float* msc = msh + 1024;
#pragma unroll
        for (int j = 0; j < 4; ++j) {
            const int c = 4 * lane + 256 * j;
            const f32x4 w = *(const f32x4*)(nw + c), sh = *(const f32x4*)(msh + c), sc = *(const f32x4*)(msc + c);
            const f32x4 h = (v[j] * rstd * w) * (1.0f + sc) + sh;
            u32x2 o; o.x = pk2(h[0], h[1]); o.y = pk2(h[2], h[3]);
            *(u32x2*)(hb + (size_t)r * 1024 + c) = o;
        }
    }
}

__device__ __forceinline__ void phase_final(const Params& p) {
    const int lane = otid() & 63, wid = otid() >> 6;
    const float* xws = (const float*)(p.ws + WS_X); const bf16_t* yb = (const bf16_t*)(p.ws + WS_YB);
    const float* modv = (const float*)(p.ws + WS_MOD); const float* nw = p.in[19];
    for (int r = obid() * 8 + wid; r < NLAT; r += gridDim.x * 8) {
        const int mr = mod_row(r);
        const float* g5 = modv + ((size_t)3 * 9 + mr) * 6144 + 5 * 1024;
        f32x4 v[4]; float ss = 0.f;
#pragma unroll
        for (int j = 0; j < 4; ++j) {
            const int c = 4 * lane + 256 * j;
            v[j] = *(const f32x4*)(xws + (size_t)r * 1024 + c);
            const u32x2 y0 = *(const u32x2*)(yb + (size_t)(2 * r) * 1024 + c), y1 = *(const u32x2*)(yb + (size_t)(2 * r + 1) * 1024 + c);
            const f32x4 gv = *(const f32x4*)(g5 + c);
            f32x4 f; f[0] = bf2f(y0.x & 0xffff) + bf2f(y1.x & 0xffff); f[1] = bf2f(y0.x >> 16) + bf2f(y1.x >> 16);
            f[2] = bf2f(y0.y & 0xffff) + bf2f(y1.y & 0xffff); f[3] = bf2f(y0.y >> 16) + bf2f(y1.y >> 16);
            v[j] += gv * f;
            ss += (v[j][0] * v[j][0] + v[j][1] * v[j][1]) + (v[j][2] * v[j][2] + v[j][3] * v[j][3]);
        }
        const float rstd = rsqrtf(wave_sum(ss) * (1.0f / 1024.0f) + EPS);
#pragma unroll
        for (int j = 0; j < 4; ++j) { const int c = 4 * lane + 256 * j; const f32x4 w = *(const f32x4*)(nw + c); *(f32x4*)(p.out + (size_t)r * 1024 + c) = v[j] * rstd * w; }
    }
}

__device__ __forceinline__ void phase_gemm1(const Params& p, int l, unsigned char* lds) {
    const bf16_t* hb = (const bf16_t*)(p.ws + WS_H); const bf16_t* wt = (const bf16_t*)(p.ws + WS_WIN) + (size_t)l * 4096 * 1024; bf16_t* pb = (bf16_t*)(p.ws + WS_P);
    constexpr int NT = PW / 128, MT = NTOK / 128;
    for (int u = obid(); u < MT * NT; u += gridDim.x) {
        const int mt = u / NT, nt = u % NT;
        ARowPlain ar{hb + (size_t)mt * 128 * 1024, 1024};
        EpiP ep{pb + (size_t)mt * 128 * PW + nt * 128};
        gemm128(lds, ar, wt + (size_t)nt * 128 * 1024, 1024, ep);
    }
}

__device__ __forceinline__ void unpack8(const u32x4 w, float (&f)[8]) {
    f[0] = bf2f(w.x & 0xffff); f[1] = bf2f(w.x >> 16); f[2] = bf2f(w.y & 0xffff); f[3] = bf2f(w.y >> 16);
    f[4] = bf2f(w.z & 0xffff); f[5] = bf2f(w.z >> 16); f[6] = bf2f(w.w & 0xffff); f[7] = bf2f(w.w >> 16);
}
__device__ __forceinline__ void conv_rows(const Params& p, int l) {
    const int lane = otid() & 63, wid = otid() >> 6;
    const bf16_t* pb = (const bf16_t*)(p.ws + WS_P); bf16_t* yb = (bf16_t*)(p.ws + WS_Y);
    const float* cw = p.in[8] + (size_t)l * 3 * 512; const float* cnw = p.in[9] + (size_t)l * 512;
    const int nrows = (l == DEPTH - 1) ? NLAT : NTOK;
    const int c0 = lane * 8;
    for (int r = obid() * 8 + wid; r < nrows; r += gridDim.x * 8) {
        int rm = -1, rp = -1;
        if (r < NLAT) {
            const int t = r & 2047;
            if (c0 < 256) { if ((t & 63) > 0) rm = r - 1; if ((t & 63) < 63) rp = r + 1; }
            else { if (t >= 64) rm = r - 64; if (t < SEQ - 64) rp = r + 64; }
        } else { const int tc = (r - NLAT) & 255; if (tc > 0) rm = r - 1; if (tc < 255) rp = r + 1; }
        float bg[8], u0[8], um[8], up[8], t1[8];
        unpack8(*(const u32x4*)(pb + (size_t)r * PW + OFF_B + c0), bg);
        unpack8(*(const u32x4*)(pb + (size_t)r * PW + OFF_C + c0), u0); unpack8(*(const u32x4*)(pb + (size_t)r * PW + OFF_HV + c0), t1);
#pragma unroll
        for (int j = 0; j < 8; ++j) u0[j] *= t1[j];
        if (rm >= 0) { unpack8(*(const u32x4*)(pb + (size_t)rm * PW + OFF_C + c0), um); unpack8(*(const u32x4*)(pb + (size_t)rm * PW + OFF_HV + c0), t1);
#pragma unroll
            for (int j = 0; j < 8; ++j) um[j] *= t1[j]; }
        else {
#pragma unroll
            for (int j = 0; j < 8; ++j) um[j] = 0.f; }
        if (rp >= 0) { unpack8(*(const u32x4*)(pb + (size_t)rp * PW + OFF_C + c0), up); unpack8(*(const u32x4*)(pb + (size_t)rp * PW + OFF_HV + c0), t1);
#pragma unroll
            for (int j = 0; j < 8; ++j) up[j] *= t1[j]; }
        else {
#pragma unroll
            for (int j = 0; j < 8; ++j) up[j] = 0.f; }
        float z[8]; float ss = 0.f;
#pragma unroll
        for (int j = 0; j < 8; ++j) { z[j] = bg[j] * (cw[c0 + j] * um[j] + cw[512 + c0 + j] * u0[j] + cw[1024 + c0 + j] * up[j]); ss += z[j] * z[j]; }
        const float rstd = rsqrtf(wave_sum(ss) * (1.0f / 512.0f) + EPS);
        u32x4 o;
        o.x = pk2(z[0] * rstd * cnw[c0 + 0], z[1] * rstd * cnw[c0 + 1]); o.y = pk2(z[2] * rstd * cnw[c0 + 2], z[3] * rstd * cnw[c0 + 3]);
        o.z = pk2(z[4] * rstd * cnw[c0 + 4], z[5] * rstd * cnw[c0 + 5]); o.w = pk2(z[6] * rstd * cnw[c0 + 6], z[7] * rstd * cnw[c0 + 7]);
        *(u32x4*)(yb + (size_t)r * 1024 + c0) = o;
    }
}

template <int DIR>
__device__ __forceinline__ void gla_pre_dir(const Params& p, int l, int chunk, float* sQ, float* sK, const float* sV, float* sA, float* sBq, float (&oacc)[16]) {
    const int ch = otid(), tid = otid(), R0 = chunk * 16;
    const bf16_t* pb = (const bf16_t*)(p.ws + WS_P);
    bf16_t* qin = (bf16_t*)(p.ws + WS_QIN); bf16_t* kout = (bf16_t*)(p.ws + WS_KOUT); float* dch = (float*)(p.ws + WS_DCH);
    float lbv = 0.f;
    {
        const float* lb = p.in[10] + (size_t)DIR * 4 * 512 + ch;
        const float z0 = lb[0], z1 = lb[512], z2 = lb[1024], z3 = lb[1536];
        const float mx = fmaxf(fmaxf(z0, z1), fmaxf(z2, z3));
        const float e0 = __expf(z0 - mx), e1 = __expf(z1 - mx), e2 = __expf(z2 - mx), e3 = __expf(z3 - mx);
        const float inv = 1.0f / (e0 + e1 + e2 + e3);
        lbv = ((l >= 1 ? e1 : 0.f) + (l >= 2 ? e2 : 0.f) + (l >= 3 ? e3 : 0.f)) * inv;
    }
    float b = 0.f;
#pragma unroll 1
    for (int i = 0; i < 16; ++i) {
        const int row = R0 + (DIR ? 15 - i : i);
        const float zf = bf2f(pb[(size_t)row * PW + OFF_ZF + DIR * 512 + ch]);
        const float sg = 1.0f / (1.0f + __expf(-zf)), sn = 1.0f / (1.0f + __expf(zf));
        const float f = fmaxf(lbv + (1.0f - lbv) * sg, 1e-30f);
        b += __logf(f);
        sBq[i * 512 + ch] = b; sK[i * 512 + ch] = (1.0f - lbv) * sn;
        sQ[i * 512 + ch] = siluf(bf2f(pb[(size_t)row * PW + OFF_Q + ch]));
    }
    const float blast = b;
#pragma unroll 1
    for (int i = 0; i < 16; ++i) {
        const int row = R0 + (DIR ? 15 - i : i);
        const float bi = sBq[i * 512 + ch], kq = sK[i * 512 + ch], qv = sQ[i * 512 + ch];
        const float qi = qv * __expf(bi), kt = kq * __expf(fminf(-bi, 80.0f)), ko = kq * __expf(blast - bi);
        sQ[i * 512 + ch] = qi; sK[i * 512 + ch] = kt;
        qin[((size_t)DIR * NTOK + row) * 512 + ch] = (bf16_t)f2bf(qi);
        kout[((size_t)DIR * NTOK + row) * 512 + ch] = (bf16_t)f2bf(ko);
    }
    dch[((size_t)DIR * NCHUNK + chunk) * 512 + ch] = __expf(blast);
    __syncthreads();
#pragma unroll 1
    for (int e2 = 0; e2 < 2; ++e2) {
        const int e = tid * 2 + e2, h = e >> 8, t = (e >> 4) & 15, s = e & 15;
        float sum = 0.f;
        const float* qp = sQ + t * 512 + h * 128; const float* kp = sK + s * 512 + h * 128;
#pragma unroll 8
        for (int k = 0; k < 128; ++k) sum += qp[k] * kp[k];
        sA[e] = (s <= t) ? sum : 0.f;
    }
    __syncthreads();
    const int h = ch >> 7;
#pragma unroll
    for (int t = 0; t < 16; ++t) {
        float o = 0.f;
#pragma unroll 1
        for (int s = 0; s <= t; ++s) o += sA[(h * 16 + t) * 16 + s] * sV[(DIR ? 15 - s : s) * 512 + ch];
        oacc[DIR ? 15 - t : t] += o;
    }
    __syncthreads();
}

__device__ __forceinline__ void phase_conv_glapre(const Params& p, int l, unsigned char* lds) {
    conv_rows(p, l);
    float* sQ = (float*)lds; float* sK = sQ + 16 * 512; float* sV = sK + 16 * 512; float* sBq = sV + 16 * 512; float* sA = sBq + 16 * 512;
    const bf16_t* pb = (const bf16_t*)(p.ws + WS_P); float* ointra = (float*)(p.ws + WS_OINTRA);
    const int ch = otid();
    for (int chunk = obid(); chunk < NCHUNK; chunk += gridDim.x) {
        const int R0 = chunk * 16;
        float oacc[16];
#pragma unroll
        for (int i = 0; i < 16; ++i) oacc[i] = 0.f;
        __syncthreads();
#pragma unroll
        for (int ro = 0; ro < 16; ++ro) sV[ro * 512 + ch] = bf2f(pb[(size_t)(R0 + ro) * PW + OFF_I + ch]);
        gla_pre_dir<0>(p, l, chunk, sQ, sK, sV, sA, sBq, oacc);
        gla_pre_dir<1>(p, l, chunk, sQ, sK, sV, sA, sBq, oacc);
#pragma unroll
        for (int ro = 0; ro < 16; ++ro) ointra[(size_t)(R0 + ro) * 512 + ch] = oacc[ro];
    }
}

__device__ __forceinline__ void phase_gla_seq(const Params& p, int l, unsigned char* lds) {
    const int tid = otid();
    float* S = (float*)lds;
    float* sQ = S + 128 * 32;
    float* sKo = sQ + 16 * 128;
    float* sV = sKo + 16 * 128;
    float* sD = sV + 16 * 32;
    const bf16_t* pb = (const bf16_t*)(p.ws + WS_P);
    const bf16_t* qin = (const bf16_t*)(p.ws + WS_QIN); const bf16_t* kout = (const bf16_t*)(p.ws + WS_KOUT); const float* dch = (const float*)(p.ws + WS_DCH);
    float* ointer = (float*)(p.ws + WS_OINTER);
    for (int u = obid(); u < 256; u += gridDim.x) {
        const int vblk = u & 3, dir = (u >> 2) & 1, chain = u >> 3, b = chain >> 2, h = chain & 3;
        __syncthreads();
        for (int i = tid; i < 128 * 32; i += 512) S[i] = 0.f;
        for (int c = 0; c < 144; ++c) {
            int R0;
            if (c < 16) { const int cm = dir ? 15 - c : c; R0 = NLAT + b * 256 + cm * 16; }
            else { const int cc = c - 16; const int cm = dir ? 127 - cc : cc; R0 = b * 2048 + cm * 16; }
            __syncthreads();
            for (int i = tid; i < 16 * 128; i += 512) {
                const int si = i >> 7, k = i & 127; const int row = R0 + (dir ? 15 - si : si);
                const size_t g = ((size_t)dir * NTOK + row) * 512 + h * 128 + k;
                sQ[i] = bf2f(qin[g]); sKo[i] = bf2f(kout[g]);
            }
            { const int si = tid >> 5, vv = tid & 31; const int row = R0 + (dir ? 15 - si : si); sV[tid] = bf2f(pb[(size_t)row * PW + OFF_I + h * 128 + vblk * 32 + vv]); }
            if (tid < 128) sD[tid] = dch[((size_t)dir * NCHUNK + (R0 >> 4)) * 512 + h * 128 + tid];
            __syncthreads();
            {
                const int si = tid >> 5, vv = tid & 31; const int row = R0 + (dir ? 15 - si : si);
                float o = 0.f;
                for (int k = 0; k < 128; ++k) o += sQ[si * 128 + k] * S[k * 32 + vv];
                ointer[((size_t)dir * NTOK + row) * 512 + h * 128 + vblk * 32 + vv] = o;
            }
            __syncthreads();
            {
                const int k = tid >> 2, v0 = (tid & 3) * 8; const float d = sD[k];
                float kk[16];
#pragma unroll
                for (int i = 0; i < 16; ++i) kk[i] = sKo[i * 128 + k];
#pragma unroll
                for (int j = 0; j < 8; ++j) {
                    float s = d * S[k * 32 + v0 + j];
#pragma unroll
                    for (int i = 0; i < 16; ++i) s += kk[i] * sV[i * 32 + v0 + j];
                    S[k * 32 + v0 + j] = s;
                }
            }
        }
    }
}

__device__ __forceinline__ void phase_gla_post(const Params& p, int l) {
    const int lane = otid() & 63, wid = otid() >> 6;
    const bf16_t* pb = (const bf16_t*)(p.ws + WS_P); bf16_t* yb = (bf16_t*)(p.ws + WS_Y);
    const float* oi = (const float*)(p.ws + WS_OINTRA); const float* oe = (const float*)(p.ws + WS_OINTER);
    const float* hnw = p.in[11] + (size_t)l * 128;
    const int nrows = (l == DEPTH - 1) ? NLAT : NTOK;
    const int c0 = lane * 8;
    for (int r = obid() * 8 + wid; r < nrows; r += gridDim.x * 8) {
        float o[8]; float ss = 0.f;
#pragma unroll
        for (int q = 0; q < 2; ++q) {
            const f32x4 a = *(const f32x4*)(oi + (size_t)r * 512 + c0 + 4 * q), b = *(const f32x4*)(oe + (size_t)r * 512 + c0 + 4 * q), c = *(const f32x4*)(oe + ((size_t)NTOK + r) * 512 + c0 + 4 * q);
#pragma unroll
            for (int j = 0; j < 4; ++j) { o[4 * q + j] = a[j] + b[j] + c[j]; ss += o[4 * q + j] * o[4 * q + j]; }
        }
        ss += __shfl_xor(ss, 1); ss += __shfl_xor(ss, 2); ss += __shfl_xor(ss, 4); ss += __shfl_xor(ss, 8);
        const float rstd = rsqrtf(ss * (1.0f / 128.0f) + EPS);
        float g[8]; unpack8(*(const u32x4*)(pb + (size_t)r * PW + OFF_G + c0), g);
        float y[8];
#pragma unroll
        for (int j = 0; j < 8; ++j) y[j] = o[j] * rstd * hnw[(c0 + j) & 127] * siluf(g[j]);
        u32x4 w; w.x = pk2(y[0], y[1]); w.y = pk2(y[2], y[3]); w.z = pk2(y[4], y[5]); w.w = pk2(y[6], y[7]);
        *(u32x4*)(yb + (size_t)r * 1024 + 512 + c0) = w;
    }
}

__device__ __forceinline__ void phase_gemm2(const Params& p, int l, unsigned char* lds) {
    const bf16_t* yb = (const bf16_t*)(p.ws + WS_Y); const bf16_t* wt = (const bf16_t*)(p.ws + WS_WOUT) + (size_t)l * 1024 * 1024;
    float* xws = (float*)(p.ws + WS_X); const float* modv = (const float*)(p.ws + WS_MOD);
    const int MT = ((l == DEPTH - 1) ? NLAT : NTOK) / 128; constexpr int NT = 8;
    for (int u = obid(); u < MT * NT; u += gridDim.x) {
        const int mt = u / NT, nt = u % NT;
        ARowPlain ar{yb + (size_t)mt * 128 * 1024, 1024};
        EpiRes ep{xws + (size_t)mt * 128 * 1024 + nt * 128, modv + (size_t)l * 9 * 6144 + 2 * 1024 + nt * 128, mt * 128};
        gemm128(lds, ar, wt + (size_t)nt * 128 * 1024, 1024, ep);
    }
}

__device__ __forceinline__ void phase_router(const Params& p, int l) {
    const int lane = otid() & 63, wid = otid() >> 6;
    const float* xws = (const float*)(p.ws + WS_X); bf16_t* hb = (bf16_t*)(p.ws + WS_H);
    const float* modv = (const float*)(p.ws + WS_MOD); const float* nw = p.in[4] + (size_t)(l * 2 + 1) * 1024;
    const float* wrg = p.in[13] + (size_t)l * 1024 * 4; const float* wre = p.in[15] + (size_t)l * 1024 * 32;
    const float* brg = p.in[14] + l * 4; const float* bre = p.in[16] + l * 32;
    unsigned* cnt = (unsigned*)(p.ws + WS_CTL) + CW_CNT + 64 * l;
    int* ltok = (int*)(p.ws + WS_LTOK); float* lgate = (float*)(p.ws + WS_LGATE);
    const int nrows = (l == DEPTH - 1) ? NLAT : NTOK;
    for (int r = obid() * 8 + wid; r < nrows; r += gridDim.x * 8) {
        const int mr = mod_row(r);
        float ss = 0.f;
#pragma unroll
        for (int j = 0; j < 4; ++j) { const f32x4 xv4 = *(const f32x4*)(xws + (size_t)r * 1024 + 4 * lane + 256 * j); ss += (xv4[0] * xv4[0] + xv4[1] * xv4[1]) + (xv4[2] * xv4[2] + xv4[3] * xv4[3]); }
        const float rstd = rsqrtf(wave_sum(ss) * (1.0f / 1024.0f) + EPS);
        const float* msh = modv + ((size_t)l * 9 + mr) * 6144 + 3 * 1024; const float* msc = msh + 1024;
        float lg[36];
#pragma unroll
        for (int i = 0; i < 36; ++i) lg[i] = 0.f;
#pragma unroll 1
        for (int j = 0; j < 4; ++j) {
            const int c = 4 * lane + 256 * j;
            const f32x4 xv4 = *(const f32x4*)(xws + (size_t)r * 1024 + c);
            const f32x4 w = *(const f32x4*)(nw + c), sh = *(const f32x4*)(msh + c), sc = *(const f32x4*)(msc + c);
            const f32x4 h = (xv4 * rstd * w) * (1.0f + sc) + sh;
            u32x2 o; o.x = pk2(h[0], h[1]); o.y = pk2(h[2], h[3]);
            *(u32x2*)(hb + (size_t)r * 1024 + c) = o;
#pragma unroll
            for (int e = 0; e < 4; ++e) {
                const float xv = h[e];
                const f32x4 wg = *(const f32x4*)(wrg + (size_t)(c + e) * 4);
                lg[0] += xv * wg[0]; lg[1] += xv * wg[1]; lg[2] += xv * wg[2]; lg[3] += xv * wg[3];
#pragma unroll
                for (int q = 0; q < 8; ++q) {
                    const f32x4 we = *(const f32x4*)(wre + (size_t)(c + e) * 32 + q * 4);
                    lg[4 + q * 4 + 0] += xv * we[0]; lg[4 + q * 4 + 1] += xv * we[1]; lg[4 + q * 4 + 2] += xv * we[2]; lg[4 + q * 4 + 3] += xv * we[3];
                }
            }
        }
#pragma unroll
        for (int i = 0; i < 36; ++i) lg[i] = wave_sum(lg[i]);
        float gl[4];
#pragma unroll
        for (int i = 0; i < 4; ++i) gl[i] = lg[i] + brg[i];
        int gsel = 0; float gmax = gl[0];
#pragma unroll
        for (int i = 1; i < 4; ++i) if (gl[i] > gmax) { gmax = gl[i]; gsel = i; }
        float gs = 0.f;
#pragma unroll
        for (int i = 0; i < 4; ++i) gs += __expf(gl[i] - gmax);
        const float pg = 1.0f / gs;
        float el[8];
#pragma unroll
        for (int j = 0; j < 8; ++j) {
            float t = lg[4 + j] + bre[j];
#pragma unroll
            for (int g = 1; g < 4; ++g) t = (gsel == g) ? (lg[4 + g * 8 + j] + bre[g * 8 + j]) : t;
            el[j] = t;
        }
        int i1 = 0; float v1 = el[0];
#pragma unroll
        for (int j = 1; j < 8; ++j) if (el[j] > v1) { v1 = el[j]; i1 = j; }
        int i2 = -1; float v2 = -3.0e38f;
#pragma unroll
        for (int j = 0; j < 8; ++j) if (j != i1 && el[j] > v2) { v2 = el[j]; i2 = j; }
        const float e2 = __expf(v2 - v1);
        const float g0 = pg / (1.0f + e2), g1 = pg * e2 / (1.0f + e2);
        if (lane == 0) {
            const int ea = gsel * 8 + i1, eb = gsel * 8 + i2;
            const unsigned pa = atomicAdd(cnt + ea, 1u); ltok[(size_t)ea * NTOK + pa] = r * 2 + 0; lgate[(size_t)ea * NTOK + pa] = g0;
            const unsigned pb2 = atomicAdd(cnt + eb, 1u); ltok[(size_t)eb * NTOK + pb2] = r * 2 + 1; lgate[(size_t)eb * NTOK + pb2] = g1;
        }
    }
}

__device__ __forceinline__ int moe_tables(const Params& p, int l, unsigned char* lds) {
    int* s_pref = (int*)(lds + LDS_MISC); int* s_cnt = s_pref + 40;
    unsigned* cnt = (unsigned*)(p.ws + WS_CTL) + CW_CNT + 64 * l;
    __syncthreads();
    if (otid() == 0) {
        int acc = 0;
        for (int e = 0; e < NEXP; ++e) { const int c = (int)__hip_atomic_load(cnt + e, __ATOMIC_RELAXED, __HIP_MEMORY_SCOPE_AGENT); s_cnt[e] = c; s_pref[e] = acc; acc += (c + 127) >> 7; }
        s_pref[NEXP] = acc;
    }
    __syncthreads();
    return s_pref[NEXP];
}
__device__ __forceinline__ void phase_moe_gu(const Params& p, int l, unsigned char* lds) {
    const int T = moe_tables(p, l, lds);
    const int* s_pref = (const int*)(lds + LDS_MISC); const int* s_cnt = s_pref + 40;
    const bf16_t* hb = (const bf16_t*)(p.ws + WS_H); bf16_t* hid = (bf16_t*)(p.ws + WS_HID);
    const int* ltok = (const int*)(p.ws + WS_LTOK);
    for (int u = obid(); u < T * 8; u += gridDim.x) {
        const int mtg = u >> 3, nt = u & 7;
        int e = 0;
        for (int q = 1; q < NEXP; ++q) if (s_pref[q] <= mtg) e = q;
        const int mt = mtg - s_pref[e]; const int nvalid = min(128, s_cnt[e] - mt * 128);
        ARowGather ar{hb, ltok + (size_t)e * NTOK + mt * 128, nvalid};
        EpiGU ep{hid + (size_t)mtg * 128 * 512 + nt * 64};
        gemm128(lds, ar, (const bf16_t*)(p.ws + WS_WGU) + ((size_t)(l * 32 + e) * 1024 + nt * 128) * 1024, 1024, ep);
    }
}
__device__ __forceinline__ void phase_moe_down(const Params& p, int l, unsigned char* lds) {
    const int T = moe_tables(p, l, lds);
    const int* s_pref = (const int*)(lds + LDS_MISC); const int* s_cnt = s_pref + 40;
    const bf16_t* hid = (const bf16_t*)(p.ws + WS_HID); bf16_t* yb = (bf16_t*)(p.ws + WS_YB);
    const int* ltok = (const int*)(p.ws + WS_LTOK); const float* lgate = (const float*)(p.ws + WS_LGATE);
    for (int u = obid(); u < T * 8; u += gridDim.x) {
        const int mtg = u >> 3, nt = u & 7;
        int e = 0;
        for (int q = 1; q < NEXP; ++q) if (s_pref[q] <= mtg) e = q;
        const int mt = mtg - s_pref[e]; const int nvalid = min(128, s_cnt[e] - mt * 128);
        ARowPlain ar{hid + (size_t)mtg * 128 * 512, 512};
        EpiDown ep{yb + nt * 128, ltok + (size_t)e * NTOK + mt * 128, lgate + (size_t)e * NTOK + mt * 128, nvalid};
        gemm128(lds, ar, (const bf16_t*)(p.ws + WS_WDN) + ((size_t)(l * 32 + e) * 1024 + nt * 128) * 512, 512, ep);
    }
}

__global__ void __launch_bounds__(512, 2) mk(Params p) {
    extern __shared__ __attribute__((aligned(16))) unsigned char lds[];
    const int lo = p.ph_lo, hi = p.ph_hi;
    volatile LAS unsigned* misc = (volatile LAS unsigned*)(lds + LDS_MISC + 1024);
    if (threadIdx.x < 4) misc[threadIdx.x] = 0u;
    __syncthreads();
    XcdBarrier bar; bar.bar = (unsigned*)(p.ws + WS_CTL) + CW_BAR; bar.x = 0; bar.st = misc;
    if (hi - lo > 1) bar = xcd_barrier_post((unsigned*)(p.ws + WS_CTL) + CW_BAR, misc);
#define IN(k) (lo <= (k) && (k) < hi)
#define SEAM(k) do { if (IN((k) + 1)) xcd_barrier(bar); } while (0)
    if (IN(0)) { phase_prologue(p, lds); SEAM(0); }
    if (IN(1)) { phase_modreduce(p); SEAM(1); }
    for (int l = 0; l < DEPTH; ++l) {
        const int pb = 2 + 9 * l;
        if (IN(pb + 0)) { phase_norm1(p, l); SEAM(pb + 0); }
        if (IN(pb + 1)) { phase_gemm1(p, l, lds); SEAM(pb + 1); }
        if (IN(pb + 2)) { phase_conv_glapre(p, l, lds); SEAM(pb + 2); }
        if (IN(pb + 3)) { phase_gla_seq(p, l, lds); SEAM(pb + 3); }
        if (IN(pb + 4)) { phase_gla_post(p, l); SEAM(pb + 4); }
        if (IN(pb + 5)) { phase_gemm2(p, l, lds); SEAM(pb + 5); }
        if (IN(pb + 6)) { phase_router(p, l); SEAM(pb + 6); }
        if (IN(pb + 7)) { phase_moe_gu(p, l, lds); SEAM(pb + 7); }
        if (IN(pb + 8)) { phase_moe_down(p, l, lds); SEAM(pb + 8); }
    }
    if (IN(NPH - 1)) phase_final(p);
#undef IN
#undef SEAM
}

#ifndef MK_LAUNCHES
#define MK_LAUNCHES NPH
#endif
extern "C" void kernel_launch(void* const* d_in, const int* in_sizes, int n_in, void* d_out, int out_size, void* d_ws, size_t ws_size, hipStream_t stream) {
    static int grid = 0;
    if (grid == 0) {
        int dev = 0, cus = 0;
        if (n_in != 20 || ws_size < WS_END) { fprintf(stderr, "kernel_launch: unexpected shapes (n_in %d, ws %zu < %zu)\n", n_in, ws_size, (size_t)WS_END); grid = -1; return; }
        if (hipGetDevice(&dev) != hipSuccess || hipDeviceGetAttribute(&cus, hipDeviceAttributeMultiprocessorCount, dev) != hipSuccess) { grid = -1; return; }
        if (hipFuncSetAttribute((const void*)mk, hipFuncAttributeMaxDynamicSharedMemorySize, LDS_BYTES) != hipSuccess) { fprintf(stderr, "kernel_launch: hipFuncSetAttribute failed\n"); grid = -1; return; }
        (void)hipGetLastError();
        grid = cus;
    }
    if (grid < 0) return;
    (void)hipMemsetAsync((char*)d_ws + WS_CTL, 0, CTL_BYTES, stream);
    Params p{};
    for (int i = 0; i < 20; ++i) p.in[i] = (const float*)d_in[i];
    p.out = (float*)d_out; p.ws = (unsigned char*)d_ws;
    if (MK_LAUNCHES == 1) { p.ph_lo = 0; p.ph_hi = NPH; hipLaunchKernelGGL(mk, dim3(grid), dim3(512), LDS_BYTES, stream, p); }
    else for (int ph = 0; ph < NPH; ++ph) { p.ph_lo = ph; p.ph_hi = ph + 1; hipLaunchKernelGGL(mk, dim3(grid), dim3(512), LDS_BYTES, stream, p); }
}
```

```cpp
#include <hip/hip_runtime.h>
#include <stdint.h>
#include <stdio.h>

typedef unsigned short bf16_t;
typedef short bf16x8 __attribute__((ext_vector_type(8)));
typedef float f32x4 __attribute__((ext_vector_type(4)));
typedef unsigned u32x4 __attribute__((ext_vector_type(4)));
typedef unsigned u32x2 __attribute__((ext_vector_type(2)));
typedef int i32x8 __attribute__((ext_vector_type(8)));
typedef int i32x4 __attribute__((ext_vector_type(4)));
typedef short s16x4 __attribute__((ext_vector_type(4)));
typedef float f32x2 __attribute__((ext_vector_type(2)));
#define LAS __attribute__((address_space(3)))
#define GAS __attribute__((address_space(1)))

#ifndef DUPK
#define DUPK -1
#endif
#ifndef MOE_FP8
#define MOE_FP8 1
#endif
constexpr int D = 1024, NB = 8, SEQ = 2048, DEPTH = 4, CTXL = 256;
constexpr int NLAT = NB * SEQ, NCTX = NB * CTXL, NTOK = NLAT + NCTX;
constexpr int PW = 4096;
constexpr int OFF_B = 0, OFF_C = 512, OFF_HV = 1024, OFF_Q = 1536, OFF_ZF = 2048, OFF_I = 3072, OFF_G = 3584;
constexpr int NEXP = 32;
constexpr int NCHUNK = NTOK / 16;
constexpr float EPS = 1e-6f;
constexpr int NMODP = 16;
constexpr int CV_ALL = 32 * (16 * 32 + 8 * 32), CV_B = 128 * 8 * 7, CV_F = 224 * 8 * 8;

constexpr size_t WS_CTL = 0, CTL_BYTES = 262144;
constexpr size_t WS_WIN = WS_CTL + CTL_BYTES;
constexpr size_t WS_WOUT = WS_WIN + (size_t)4 * 4096 * 1024 * 2;
constexpr size_t WS_WGU = WS_WOUT + (size_t)4 * 1024 * 1024 * 2;
constexpr size_t WS_WDN = WS_WGU + (size_t)4 * 32 * 1024 * 1024 * 2;
constexpr size_t WS_MODP = WS_WDN + (size_t)4 * 32 * 1024 * 512 * 2;
constexpr size_t WS_MOD = WS_MODP + (size_t)4 * NMODP * 9 * 6144 * 4;
constexpr size_t WS_X = WS_MOD + (size_t)4 * 9 * 6144 * 4;
constexpr size_t WS_H = WS_X + (size_t)NTOK * 1024 * 4;
constexpr size_t WS_P = WS_H + (size_t)NTOK * 1024 * 2;
constexpr size_t WS_Y = WS_P + (size_t)NTOK * 4096 * 2;
constexpr size_t WS_QIN = WS_Y + (size_t)NTOK * 1024 * 2;
constexpr size_t WS_KOUT = WS_QIN + (size_t)2 * NTOK * 512 * 2;
constexpr size_t WS_DCH = WS_KOUT + (size_t)2 * NTOK * 512 * 2;
constexpr size_t WS_OINTRA = WS_DCH + (size_t)2 * NCHUNK * 512 * 4;
constexpr size_t WS_OINTER = WS_OINTRA + (size_t)NTOK * 512 * 4;
constexpr size_t WS_LTOK = WS_OINTER + (size_t)2 * NTOK * 512 * 4;
constexpr size_t WS_LGATE = WS_LTOK + (size_t)32 * NTOK * 4;
constexpr int HID_ROWS = 2 * NTOK + 32 * 256;
constexpr size_t WS_HID = WS_LGATE + (size_t)32 * NTOK * 4;
constexpr size_t WS_YB = WS_HID + (size_t)HID_ROWS * 512 * 2;
constexpr int REC_BYTES = 9216, VREC_BYTES = 4096;
constexpr size_t WS_GREC = WS_YB + (size_t)2 * NTOK * 1024 * 2;
constexpr size_t WS_VREC = WS_GREC + (size_t)2 * NCHUNK * 4 * REC_BYTES;
constexpr size_t WS_WRH = WS_VREC + (size_t)NCHUNK * 4 * VREC_BYTES;
constexpr size_t WS_WRL = WS_WRH + (size_t)4 * 48 * 1024 * 2;
constexpr size_t WS_H8 = WS_WRL + (size_t)4 * 48 * 1024 * 2;
constexpr size_t WS_HID8 = WS_H8 + (size_t)NTOK * 1024;
constexpr size_t WS_WGU8 = WS_HID8 + (size_t)HID_ROWS * 512;
constexpr size_t WS_WDN8 = WS_WGU8 + (size_t)4 * 32 * 1024 * 1024;
constexpr size_t WS_YB8 = WS_WDN8 + (size_t)4 * 32 * 1024 * 512;
constexpr size_t WS_DELTA = WS_YB8 + (size_t)2 * NTOK * 1024;
constexpr size_t WS_END = WS_DELTA + (size_t)NTOK * 1024 * 2;
constexpr int CW_BAR = 0;
constexpr int CW_CNT = 8192;
constexpr int CW_HID = 16384;
constexpr int CW_TMO = 8000;

constexpr int LDS_BYTES = 147456;
constexpr int LDS_MISC = 143360;
constexpr int NPH = 2 + 9 * DEPTH + 1;

__device__ __forceinline__ float bf2f(bf16_t b) { return __uint_as_float(((unsigned)b) << 16); }
__device__ __forceinline__ unsigned f2bf(float f) { unsigned u = __float_as_uint(f); return (u + 0x7fffu + ((u >> 16) & 1u)) >> 16; }
__device__ __forceinline__ unsigned pk2(float lo, float hi) { return f2bf(lo) | (f2bf(hi) << 16); }
__device__ __forceinline__ float wave_sum(float v) {
#pragma unroll
    for (int o = 1; o < 64; o <<= 1) v += __shfl_xor(v, o);
    return v;
}
__device__ __forceinline__ float frcp(float x) { return __builtin_amdgcn_rcpf(x); }
__device__ __forceinline__ float sigmoidf(float x) { return frcp(1.0f + __expf(-x)); }
__device__ __forceinline__ float siluf(float x) { return x * frcp(1.0f + __expf(-x)); }
__device__ __forceinline__ float clamp8(float v) { return __builtin_amdgcn_fmed3f(v, -416.0f, 416.0f); }
__device__ __forceinline__ unsigned pk4_fp8_raw(float a, float b, float c, float d) { int r = __builtin_amdgcn_cvt_pk_fp8_f32(a, b, 0, false); r = __builtin_amdgcn_cvt_pk_fp8_f32(c, d, r, true); return (unsigned)r; }
__device__ __forceinline__ unsigned pk4_fp8(float a, float b, float c, float d) { int r = __builtin_amdgcn_cvt_pk_fp8_f32(clamp8(a), clamp8(b), 0, false); r = __builtin_amdgcn_cvt_pk_fp8_f32(clamp8(c), clamp8(d), r, true); return (unsigned)r; }
__device__ __forceinline__ f32x4 unpk4_fp8(unsigned w) { const f32x2 lo = __builtin_amdgcn_cvt_pk_f32_fp8((int)w, false), hi = __builtin_amdgcn_cvt_pk_f32_fp8((int)w, true); return (f32x4){lo.x, lo.y, hi.x, hi.y}; }
typedef __bf16 bf16x2_t __attribute__((ext_vector_type(2)));
__device__ __forceinline__ unsigned cvtpk(float lo, float hi) { const f32x2 v = {lo, hi}; const bf16x2_t r = __builtin_convertvector(v, bf16x2_t); return __builtin_bit_cast(unsigned, r); }
__device__ __forceinline__ int mod_row(int r) { return r < NLAT ? (r >> 11) : 8; }
#define LDS_WAIT() asm volatile("s_waitcnt lgkmcnt(0)" ::: "memory")
__device__ __forceinline__ int otid() { int t = threadIdx.x; asm volatile("" : "+v"(t)); return t; }
__device__ __forceinline__ int obid() { int b = blockIdx.x; asm volatile("" : "+s"(b)); return b; }

#define XB_TMO      128
#define XB_XCNT(j)  (256  + 64 * (j))
#define XB_XSUB(j)  (1280 + 64 * (j))
#define XB_XGEN(j)  (2304 + 64 * (j))
#define XB_TOP      3328
#define XB_TOPGEN   3392
#define XCD_BAR_WORDS 3456
#define XB_SPIN_CAP (1u << 18)
__device__ __forceinline__ unsigned xb_ld(unsigned* p)              { return __hip_atomic_load(p, __ATOMIC_RELAXED, __HIP_MEMORY_SCOPE_AGENT); }
__device__ __forceinline__ unsigned xb_add(unsigned* p, unsigned v) { return __hip_atomic_fetch_add(p, v, __ATOMIC_RELAXED, __HIP_MEMORY_SCOPE_AGENT); }
__device__ __forceinline__ unsigned xb_xcc_id() { return (unsigned)__builtin_amdgcn_s_getreg((3 << 11) | 20) & 0xFu; }
#define XB_SPIN(cond, bar) do { unsigned _sp = 0; while (cond) { __builtin_amdgcn_s_sleep(1); \
    if ((++_sp & 255u) == 0u) { if (xb_ld(&(bar)[XB_TMO])) break; if (_sp > XB_SPIN_CAP) { atomicAdd(&(bar)[XB_TMO], 1u); break; } } } } while (0)
struct XcdBarrier { unsigned* bar; unsigned x; volatile LAS unsigned* st; };
__device__ __forceinline__ XcdBarrier xcd_barrier_post(unsigned* bar, volatile LAS unsigned* st) {
    XcdBarrier b; b.bar = bar; b.x = xb_xcc_id(); b.st = st;
    if (threadIdx.x == 0) (void)xb_add(&bar[XB_XCNT(b.x)], 1u);
    return b;
}
__device__ __forceinline__ void xcd_barrier_complete(unsigned* bar, unsigned x, unsigned& nloc, unsigned& nx) {
    const unsigned G = gridDim.x * gridDim.y * gridDim.z;
    unsigned sum, cnt, mine, sp = 0u;
    for (;;) {
        sum = 0u; cnt = 0u; mine = 0u;
#pragma unroll
        for (unsigned j = 0; j < 16; ++j) { const unsigned c = xb_ld(&bar[XB_XCNT(j)]); sum += c; cnt += (c > 0u) ? 1u : 0u; mine = (j == x) ? c : mine; }
        if (sum == G) break;
        __builtin_amdgcn_s_sleep(1);
        if ((++sp & 255u) == 0u) { if (xb_ld(&bar[XB_TMO])) break; if (sp > XB_SPIN_CAP) { atomicAdd(&bar[XB_TMO], 1u); break; } }
    }
    nloc = mine > 0u ? mine : 1u; nx = cnt > 0u ? cnt : 1u;
}
__device__ __forceinline__ void xcd_barrier(const XcdBarrier& b) {
    asm volatile("s_waitcnt vmcnt(0)" ::: "memory");
    __syncthreads();
    if (threadIdx.x == 0) {
        unsigned* bar = b.bar;
        __builtin_amdgcn_s_waitcnt(0);
        unsigned nloc = b.st[0], nx = b.st[1];
        if (nloc == 0u) { xcd_barrier_complete(bar, b.x, nloc, nx); b.st[0] = nloc; b.st[1] = nx; }
        const unsigned old = xb_add(&bar[XB_XSUB(b.x)], 1u);
        const unsigned gen = old / nloc;
        if (old + 1u == (gen + 1u) * nloc) {
            __builtin_amdgcn_fence(__ATOMIC_RELEASE, "agent");
            asm volatile("s_waitcnt vmcnt(0)" ::: "memory");
            const unsigned og = xb_add(&bar[XB_TOP], 1u);
            const unsigned tg = og / nx;
            if (og + 1u == (tg + 1u) * nx) xb_add(&bar[XB_TOPGEN], 1u);
            else XB_SPIN(xb_ld(&bar[XB_TOPGEN]) == tg, bar);
            __builtin_amdgcn_fence(__ATOMIC_ACQUIRE, "agent");
            xb_add(&bar[XB_XGEN(b.x)], 1u);
            asm volatile("s_waitcnt vmcnt(0)" ::: "memory");
        } else {
            XB_SPIN(xb_ld(&bar[XB_XGEN(b.x)]) == gen, bar);
            __builtin_amdgcn_fence(__ATOMIC_ACQUIRE, "agent");
            asm volatile("s_waitcnt vmcnt(0)" ::: "memory");
        }
    }
    __syncthreads();
}

struct Params {
    const float* in[20];
    float* out;
    unsigned char* ws;
    int ph_lo, ph_hi;
};

__device__ __forceinline__ unsigned char* ows(const Params& p) { GAS unsigned char* w = (GAS unsigned char*)p.ws; asm volatile("" : "+s"(w)); return (unsigned char*)w; }
__device__ __forceinline__ const float* oin(const Params& p, int k) { const GAS float* q = (const GAS float*)p.in[k]; asm volatile("" : "+s"(q)); return (const float*)q; }

template <class ARow, class Epi>
__device__ __forceinline__ void gemm128(unsigned char* lds, const ARow& arow, const bf16_t* __restrict__ Bt, int K, const Epi& epi) {
    const int tid = otid(), lane = tid & 63, wid = tid >> 6, wr = wid >> 2, wc = wid & 3, fr = lane & 15, fq = lane >> 4;
    bf16_t* sA = (bf16_t*)lds;
    bf16_t* sB = (bf16_t*)(lds + 128 * 144);
    f32x4 acc[4][2];
#pragma unroll
    for (int m = 0; m < 4; ++m)
#pragma unroll
        for (int n = 0; n < 2; ++n) acc[m][n] = (f32x4){0.f, 0.f, 0.f, 0.f};
    const bf16_t* ap[2]; const bf16_t* bp[2]; int so[2];
#pragma unroll
    for (int i = 0; i < 2; ++i) {
        const int q = tid + 512 * i, row = q >> 3, seg = q & 7;
        ap[i] = arow(row) + seg * 8; bp[i] = Bt + (size_t)row * K + seg * 8; so[i] = row * 72 + seg * 8;
    }
    for (int k0 = 0; k0 < K; k0 += 64) {
        u32x4 va[2], vb[2];
#pragma unroll
        for (int i = 0; i < 2; ++i) { va[i] = *(const u32x4*)(ap[i] + k0); vb[i] = *(const u32x4*)(bp[i] + k0); }
        __syncthreads();
#pragma unroll
        for (int i = 0; i < 2; ++i) { *(u32x4*)(sA + so[i]) = va[i]; *(u32x4*)(sB + so[i]) = vb[i]; }
        __syncthreads();
#pragma unroll
        for (int kk = 0; kk < 2; ++kk) {
            bf16x8 a[4], b[2];
#pragma unroll
            for (int m = 0; m < 4; ++m) a[m] = *(const bf16x8*)(sA + (wr * 64 + m * 16 + fr) * 72 + kk * 32 + fq * 8);
#pragma unroll
            for (int n = 0; n < 2; ++n) b[n] = *(const bf16x8*)(sB + (wc * 32 + n * 16 + fr) * 72 + kk * 32 + fq * 8);
#pragma unroll
            for (int m = 0; m < 4; ++m)
#pragma unroll
                for (int n = 0; n < 2; ++n) acc[m][n] = __builtin_amdgcn_mfma_f32_16x16x32_bf16(b[n], a[m], acc[m][n], 0, 0, 0);
        }
    }
#pragma unroll
    for (int m = 0; m < 4; ++m)
#pragma unroll
        for (int n = 0; n < 2; ++n) epi(wr * 64 + m * 16 + fr, wc * 32 + n * 16 + fq * 4, acc[m][n]);
    __syncthreads();
}

struct ARowPlain { const bf16_t* A; int ld; __device__ __forceinline__ const bf16_t* operator()(int i) const { return A + (size_t)i * ld; } };
struct ARowGather { const bf16_t* A; const int* tok; int nvalid; __device__ __forceinline__ const bf16_t* operator()(int i) const { const int t = (i < nvalid) ? (tok[i] >> 1) : 0; return A + (size_t)t * 1024; } };

struct EpiP { bf16_t* P; __device__ __forceinline__ void operator()(int r, int c, f32x4 v) const {
    u32x2 w; w.x = pk2(v[0], v[1]); w.y = pk2(v[2], v[3]); *(u32x2*)(P + (size_t)r * PW + c) = w; } };
struct EpiRes { float* X; const float* gate; int m0; __device__ __forceinline__ void operator()(int r, int c, f32x4 v) const {
    const float* g = gate + (size_t)mod_row(m0 + r) * 6144 + c; float* xp = X + (size_t)r * 1024 + c;
    f32x4 x = *(f32x4*)xp; const f32x4 gv = *(const f32x4*)g; x += gv * v; *(f32x4*)xp = x; } };
struct EpiGU { bf16_t* H; __device__ __forceinline__ void operator()(int r, int c, f32x4 v) const {
    const float h0 = siluf(v[0]) * v[1], h1 = siluf(v[2]) * v[3]; *(unsigned*)(H + (size_t)r * 512 + (c >> 1)) = pk2(h0, h1); } };
struct EpiDown { bf16_t* YB; const int* tok; const float* gate; int nvalid; __device__ __forceinline__ void operator()(int r, int c, f32x4 v) const {
    if (r < nvalid) { const int e = tok[r]; const float g = gate[r]; u32x2 w; w.x = pk2(g * v[0], g * v[1]); w.y = pk2(g * v[2], g * v[3]); *(u32x2*)(YB + (size_t)e * 1024 + c) = w; } } };


namespace g8 {
constexpr int BM = 256, BK = 64, HALF = 128, HTB = HALF * BK * 2, NXCD = 8, WGM = 8;
__device__ __forceinline__ int lds_byte(int r, int c) { const int st = (r >> 4) * 2 + (c >> 5), rr = r & 15, cc = c & 31, ob = rr * 64 + cc * 2; return st * 1024 + (ob ^ (((ob >> 9) & 1) << 5)); }
__device__ __forceinline__ void stage_rc(int b, int& R, int& C) { const int st = b / 1024, sb = b % 1024, swz = sb ^ (((sb >> 9) & 1) << 5); R = (st >> 1) * 16 + swz / 64; C = (st & 1) * 32 + (swz % 64) / 2; }
__device__ __forceinline__ int perm32(int rho) { const int n = rho >> 4, i = rho & 15; return 8 * (i >> 2) + 4 * n + (i & 3); }
__device__ __forceinline__ unsigned cvt_pk_bf16(float lo, float hi) { return cvtpk(lo, hi); }

__device__ __forceinline__ int g8_ra(int tid, int i) { int R, C; stage_rc(tid * 16 + i * 8192, R, C); return R; }
__device__ __forceinline__ unsigned g8_ca(int tid, int i) { int R, C; stage_rc(tid * 16 + i * 8192, R, C); return (unsigned)C * 2u; }
#define G8_RA(i) g8_ra(otid(), (i))
#define G8_CA(i) g8_ca(otid(), (i))
template <class Epi, class Sched>
__device__ __forceinline__ void gemm_phase(LAS unsigned char* lds, const char* Abase, const int K, const Sched& S, const Epi& E) {
    const int tid = otid(), wid = __builtin_amdgcn_readfirstlane(tid >> 6), lane = tid & 63, wr = wid >> 2, wc = wid & 3, fr = lane & 15, fq = lane >> 4;
    const int nt = K / BK;
    unsigned voffB[2];
#pragma unroll
    for (int i = 0; i < 2; ++i) { int R, C; stage_rc(tid * 16 + i * 8192, R, C); const int Rb = Epi::PERM ? ((R & ~31) + perm32(R & 31)) : R;
        voffB[i] = (unsigned)(Rb * K + C) * 2u; }
    const unsigned rowb = (unsigned)K * 2u;
    const size_t kstep = (size_t)(BK * 2);
    const size_t hstep = (size_t)HALF * K * 2;
    const unsigned ldsw = (unsigned)wid * 1024u;
    const int aoff = lds_byte(wr * 64 + fr, fq * 8), boff = lds_byte(wc * 32 + fr, fq * 8);
#define G8_SA(b, h) (((b) * 2 + (h)) * HTB)
#define G8_SB(b, h) ((4 + (b) * 2 + (h)) * HTB)
#define G8_STAGE(bufoff, gbase, voff) do { _Pragma("unroll") for (int _i = 0; _i < 2; ++_i) \
        __builtin_amdgcn_global_load_lds((const unsigned*)((const char*)(gbase) + (voff)[_i]), (LAS unsigned*)(lds + (bufoff) + ldsw + _i * 8192), 16, 0, 0); } while (0)
#define G8_LDA(dst, b, h) do { _Pragma("unroll") for (int m = 0; m < 4; ++m) _Pragma("unroll") for (int k = 0; k < 2; ++k) dst[m][k] = *(const LAS bf16x8*)(lds + G8_SA(b, h) + aoff + m * 2048 + k * 1024); } while (0)
#define G8_LDB(dst, b, h) do { _Pragma("unroll") for (int n = 0; n < 2; ++n) _Pragma("unroll") for (int k = 0; k < 2; ++k) dst[n][k] = *(const LAS bf16x8*)(lds + G8_SB(b, h) + boff + n * 2048 + k * 1024); } while (0)
#define G8_MMA(ai, bj, At, Bt) do { __builtin_amdgcn_s_setprio(1); _Pragma("unroll") for (int m = 0; m < 4; ++m) _Pragma("unroll") for (int n = 0; n < 2; ++n) _Pragma("unroll") for (int k = 0; k < 2; ++k) \
        acc[ai][bj][m][n] = __builtin_amdgcn_mfma_f32_16x16x32_bf16(Bt[n][k], At[m][k], acc[ai][bj][m][n], 0, 0, 0); __builtin_amdgcn_s_setprio(0); } while (0)
#define G8_WAIT_V(n) asm volatile("s_waitcnt vmcnt(" #n ")" ::: "memory")
#define G8_WAIT_L(n) asm volatile("s_waitcnt lgkmcnt(" #n ")" ::: "memory")
#define G8_BAR __builtin_amdgcn_s_barrier()
#define G8_SCHED __builtin_amdgcn_sched_barrier(0)
    typename Sched::Unit cur, nxt; int ui = 0;
    if (!S.next(0, cur)) return;
    f32x4 acc[2][2][4][2];
#pragma unroll
    for (int a = 0; a < 2; ++a)
#pragma unroll
        for (int b = 0; b < 2; ++b)
#pragma unroll
            for (int m = 0; m < 4; ++m)
#pragma unroll
                for (int n = 0; n < 2; ++n) acc[a][b][m][n] = (f32x4){0.f, 0.f, 0.f, 0.f};
    bf16x8 At[4][2], B0[2][2], B1[2][2];
    unsigned vAc[2][2], vAn[2][2];
#pragma unroll
    for (int h = 0; h < 2; ++h)
#pragma unroll
        for (int i = 0; i < 2; ++i) vAc[h][i] = (Sched::AFFINE ? (unsigned)(h * HALF + G8_RA(i)) : (unsigned)S.a_row(cur, h * HALF + G8_RA(i))) * rowb + G8_CA(i);
    const char* cA = Sched::AFFINE ? Abase + (size_t)S.a_row(cur, 0) * rowb : Abase;
    const char* cB = S.b_base(cur);
    G8_STAGE(G8_SB(0, 0), cB, voffB); G8_STAGE(G8_SA(0, 0), cA, vAc[0]); G8_STAGE(G8_SB(0, 1), cB + hstep, voffB); G8_STAGE(G8_SA(0, 1), cA, vAc[1]);
    if (wr == 1) G8_BAR;
    G8_WAIT_V(4); G8_BAR;
    G8_STAGE(G8_SB(1, 0), cB + kstep, voffB); G8_STAGE(G8_SA(1, 0), cA + kstep, vAc[0]); G8_STAGE(G8_SB(1, 1), cB + hstep + kstep, voffB);
    G8_WAIT_V(6); G8_BAR;
    for (;;) {
        const bool has_next = S.next(ui + 1, nxt);
#pragma unroll
        for (int h = 0; h < 2; ++h)
#pragma unroll
            for (int i = 0; i < 2; ++i) vAn[h][i] = (has_next && !Sched::AFFINE) ? ((unsigned)S.a_row(nxt, h * HALF + G8_RA(i)) * rowb + G8_CA(i)) : vAc[h][i];
        const char* nA = (has_next && Sched::AFFINE) ? Abase + (size_t)S.a_row(nxt, 0) * rowb : cA;
        const char* nB = has_next ? S.b_base(nxt) : cB;
        for (int t = 0; t < nt; t += 2) {
            const bool last = (t == nt - 2);
            const char* a1 = cA + (size_t)(t + 1) * kstep;
            const char* a2 = last ? nA : cA + (size_t)(t + 2) * kstep; const char* b2 = last ? nB : cB + (size_t)(t + 2) * kstep;
            const char* a3 = a2 + kstep; const char* b3 = b2 + kstep;
            unsigned v2[2][2];
#pragma unroll
            for (int h = 0; h < 2; ++h)
#pragma unroll
                for (int i = 0; i < 2; ++i) v2[h][i] = last ? vAn[h][i] : vAc[h][i];
            G8_LDB(B0, 0, 0); G8_SCHED; G8_LDA(At, 0, 0); G8_STAGE(G8_SA(1, 1), a1, vAc[1]);
            G8_WAIT_L(8); G8_BAR; G8_WAIT_L(0); G8_MMA(0, 0, At, B0); G8_BAR; G8_SCHED;
            G8_LDB(B1, 0, 1); G8_STAGE(G8_SB(0, 0), b2, voffB);
            G8_BAR; G8_WAIT_L(0); G8_MMA(0, 1, At, B1); G8_BAR;
            G8_LDA(At, 0, 1); G8_STAGE(G8_SA(0, 0), a2, v2[0]);
            G8_BAR; G8_WAIT_L(0); G8_MMA(1, 0, At, B0); G8_BAR; G8_SCHED;
            G8_STAGE(G8_SB(0, 1), b2 + hstep, voffB);
            G8_WAIT_V(6); G8_BAR; G8_MMA(1, 1, At, B1); G8_BAR;
            G8_LDB(B0, 1, 0); G8_SCHED; G8_LDA(At, 1, 0); G8_STAGE(G8_SA(0, 1), a2, v2[1]);
            G8_WAIT_L(8); G8_BAR; G8_WAIT_L(0); G8_MMA(0, 0, At, B0); G8_BAR; G8_SCHED;
            G8_LDB(B1, 1, 1); G8_STAGE(G8_SB(1, 0), b3, voffB);
            G8_BAR; G8_WAIT_L(0); G8_MMA(0, 1, At, B1); G8_BAR;
            G8_LDA(At, 1, 1); G8_STAGE(G8_SA(1, 0), a3, v2[0]);
            G8_BAR; G8_WAIT_L(0); G8_MMA(1, 0, At, B0); G8_BAR; G8_SCHED;
            G8_STAGE(G8_SB(1, 1), b3 + hstep, voffB);
            G8_WAIT_V(6); G8_BAR; G8_MMA(1, 1, At, B1); G8_BAR;
        }
        E(acc, cur, wr, wc, fr, fq);
        if (!has_next) break;
#pragma unroll
        for (int a = 0; a < 2; ++a)
#pragma unroll
            for (int b = 0; b < 2; ++b)
#pragma unroll
                for (int m = 0; m < 4; ++m)
#pragma unroll
                    for (int n = 0; n < 2; ++n) acc[a][b][m][n] = (f32x4){0.f, 0.f, 0.f, 0.f};
        cur = nxt; cB = nB; cA = nA; ++ui;
#pragma unroll
        for (int h = 0; h < 2; ++h)
#pragma unroll
            for (int i = 0; i < 2; ++i) vAc[h][i] = vAn[h][i];
    }
    G8_WAIT_V(0);
    if (wr == 0) G8_BAR;
    G8_BAR;
#undef G8_SA
#undef G8_SB
#undef G8_STAGE
#undef G8_LDA
#undef G8_LDB
#undef G8_MMA
#undef G8_WAIT_V
#undef G8_WAIT_L
#undef G8_BAR
#undef G8_SCHED
}

template <int sclW, int sclA, class Epi, class Sched>
__device__ __forceinline__ void gemm_phase8(LAS unsigned char* lds, const char* Abase, const int K, const Sched& S, const Epi& E) {
    const int tid = otid(), wid = __builtin_amdgcn_readfirstlane(tid >> 6), lane = tid & 63, wr = wid >> 2, wc = wid & 3, fr = lane & 15, fq = lane >> 4;
    const int nt = K / 128;
    unsigned voffB[2];
#pragma unroll
    for (int i = 0; i < 2; ++i) { int R, C; stage_rc(tid * 16 + i * 8192, R, C); const int Rb = Epi::PERM ? ((R & ~31) + perm32(R & 31)) : R;
        voffB[i] = (unsigned)(Rb * K) + (unsigned)C * 2u; }
    const unsigned rowb = (unsigned)K;
    const size_t kstep = (size_t)(BK * 2);
    const size_t hstep = (size_t)HALF * K;
    const unsigned ldsw = (unsigned)wid * 1024u;
    const int fob = fr * 64 + ((2 * (fq & 1)) ^ (2 * (fr >> 3))) * 16 + (fq >> 1) * 1024;
    const int aoff = ((wr * 64) >> 4) * 2048 + fob, boff = ((wc * 32) >> 4) * 2048 + fob;
#define G8_SA(b, h) (((b) * 2 + (h)) * HTB)
#define G8_SB(b, h) ((4 + (b) * 2 + (h)) * HTB)
#define G8_STAGE(bufoff, gbase, voff) do { _Pragma("unroll") for (int _i = 0; _i < 2; ++_i) \
        __builtin_amdgcn_global_load_lds((const unsigned*)((const char*)(gbase) + (voff)[_i]), (LAS unsigned*)(lds + (bufoff) + ldsw + _i * 8192), 16, 0, 0); } while (0)
#define G8_LDA(dst, b, h) do { _Pragma("unroll") for (int m = 0; m < 4; ++m) { const i32x4 _lo = *(const LAS i32x4*)(lds + G8_SA(b, h) + aoff + m * 2048), _hi = *(const LAS i32x4*)(lds + G8_SA(b, h) + aoff + m * 2048 + 16); dst[m] = __builtin_shufflevector(_lo, _hi, 0, 1, 2, 3, 4, 5, 6, 7); } } while (0)
#define G8_LDB(dst, b, h) do { _Pragma("unroll") for (int n = 0; n < 2; ++n) { const i32x4 _lo = *(const LAS i32x4*)(lds + G8_SB(b, h) + boff + n * 2048), _hi = *(const LAS i32x4*)(lds + G8_SB(b, h) + boff + n * 2048 + 16); dst[n] = __builtin_shufflevector(_lo, _hi, 0, 1, 2, 3, 4, 5, 6, 7); } } while (0)
#define G8_MMA(ai, bj, At, Bt) do { __builtin_amdgcn_s_setprio(1); _Pragma("unroll") for (int m = 0; m < 4; ++m) _Pragma("unroll") for (int n = 0; n < 2; ++n) \
        acc[ai][bj][m][n] = __builtin_amdgcn_mfma_scale_f32_16x16x128_f8f6f4(Bt[n], At[m], acc[ai][bj][m][n], 0, 0, 0, sclW, 0, sclA); \
        _Pragma("unroll") for (int m = 0; m < 4; ++m) asm volatile("" : "+v"(acc[ai][bj][m][0]), "+v"(acc[ai][bj][m][1]));   \
        __builtin_amdgcn_s_setprio(0); } while (0)
#define G8_WAIT_V(n) asm volatile("s_waitcnt vmcnt(" #n ")" ::: "memory")
#define G8_WAIT_L(n) asm volatile("s_waitcnt lgkmcnt(" #n ")" ::: "memory")
#define G8_BAR __builtin_amdgcn_s_barrier()
#define G8_SCHED __builtin_amdgcn_sched_barrier(0)
    typename Sched::Unit cur, nxt; int ui = 0;
    if (!S.next(0, cur)) return;
    f32x4 acc[2][2][4][2];
#pragma unroll
    for (int a = 0; a < 2; ++a)
#pragma unroll
        for (int b = 0; b < 2; ++b)
#pragma unroll
            for (int m = 0; m < 4; ++m)
#pragma unroll
                for (int n = 0; n < 2; ++n) acc[a][b][m][n] = (f32x4){0.f, 0.f, 0.f, 0.f};
    i32x8 At[4], B0[2], B1[2];
    unsigned vAc[2][2], vAn[2][2];
#pragma unroll
    for (int h = 0; h < 2; ++h)
#pragma unroll
        for (int i = 0; i < 2; ++i) vAc[h][i] = (Sched::AFFINE ? (unsigned)(h * HALF + G8_RA(i)) : (unsigned)S.a_row(cur, h * HALF + G8_RA(i))) * rowb + G8_CA(i);
    const char* cA = Sched::AFFINE ? Abase + (size_t)S.a_row(cur, 0) * rowb : Abase;
    const char* cB = S.b_base(cur);
    S.a_ready(cur);
    G8_STAGE(G8_SB(0, 0), cB, voffB); G8_STAGE(G8_SA(0, 0), cA, vAc[0]); G8_STAGE(G8_SB(0, 1), cB + hstep, voffB); G8_STAGE(G8_SA(0, 1), cA, vAc[1]);
    if (wr == 1) G8_BAR;
    G8_WAIT_V(4); G8_BAR;
    G8_STAGE(G8_SB(1, 0), cB + kstep, voffB); G8_STAGE(G8_SA(1, 0), cA + kstep, vAc[0]); G8_STAGE(G8_SB(1, 1), cB + hstep + kstep, voffB);
    G8_WAIT_V(6); G8_BAR;
    for (;;) {
        const bool has_next = S.next(ui + 1, nxt);
#pragma unroll
        for (int h = 0; h < 2; ++h)
#pragma unroll
            for (int i = 0; i < 2; ++i) vAn[h][i] = (has_next && !Sched::AFFINE) ? ((unsigned)S.a_row(nxt, h * HALF + G8_RA(i)) * rowb + G8_CA(i)) : vAc[h][i];
        const char* nA = (has_next && Sched::AFFINE) ? Abase + (size_t)S.a_row(nxt, 0) * rowb : cA;
        const char* nB = has_next ? S.b_base(nxt) : cB;
#pragma unroll 1
        for (int t = 0; t < nt; t += 2) {
            const bool last = (t == nt - 2);
            if (last && has_next) S.a_ready(nxt);
            const char* a1 = cA + (size_t)(t + 1) * kstep;
            const char* a2 = last ? nA : cA + (size_t)(t + 2) * kstep; const char* b2 = last ? nB : cB + (size_t)(t + 2) * kstep;
            const char* a3 = a2 + kstep; const char* b3 = b2 + kstep;
            unsigned v2[2][2];
#pragma unroll
            for (int h = 0; h < 2; ++h)
#pragma unroll
                for (int i = 0; i < 2; ++i) v2[h][i] = last ? vAn[h][i] : vAc[h][i];
            G8_LDB(B0, 0, 0); G8_SCHED; G8_LDA(At, 0, 0); G8_STAGE(G8_SA(1, 1), a1, vAc[1]);
            G8_WAIT_L(8); G8_BAR; G8_WAIT_L(0); G8_MMA(0, 0, At, B0); G8_BAR; G8_SCHED;
            G8_LDB(B1, 0, 1); G8_STAGE(G8_SB(0, 0), b2, voffB);
            G8_BAR; G8_WAIT_L(0); G8_MMA(0, 1, At, B1); G8_BAR;
            G8_LDA(At, 0, 1); G8_STAGE(G8_SA(0, 0), a2, v2[0]);
            G8_BAR; G8_WAIT_L(0); G8_MMA(1, 0, At, B0); G8_BAR; G8_SCHED;
            G8_STAGE(G8_SB(0, 1), b2 + hstep, voffB);
            G8_WAIT_V(6); G8_BAR; G8_MMA(1, 1, At, B1); G8_BAR;
            G8_LDB(B0, 1, 0); G8_SCHED; G8_LDA(At, 1, 0); G8_STAGE(G8_SA(0, 1), a2, v2[1]);
            G8_WAIT_L(8); G8_BAR; G8_WAIT_L(0); G8_MMA(0, 0, At, B0); G8_BAR; G8_SCHED;
            G8_LDB(B1, 1, 1); G8_STAGE(G8_SB(1, 0), b3, voffB);
            G8_BAR; G8_WAIT_L(0); G8_MMA(0, 1, At, B1); G8_BAR;
            G8_LDA(At, 1, 1); G8_STAGE(G8_SA(1, 0), a3, v2[0]);
            G8_BAR; G8_WAIT_L(0); G8_MMA(1, 0, At, B0); G8_BAR; G8_SCHED;
            G8_STAGE(G8_SB(1, 1), b3 + hstep, voffB);
            G8_WAIT_V(6); G8_BAR; G8_MMA(1, 1, At, B1); G8_BAR;
        }
        E(acc, cur, wr, wc, fr, fq); S.done(cur);
        if (!has_next) break;
#pragma unroll
        for (int a = 0; a < 2; ++a)
#pragma unroll
            for (int b = 0; b < 2; ++b)
#pragma unroll
                for (int m = 0; m < 4; ++m)
#pragma unroll
                    for (int n = 0; n < 2; ++n) acc[a][b][m][n] = (f32x4){0.f, 0.f, 0.f, 0.f};
        cur = nxt; cB = nB; cA = nA; ++ui;
#pragma unroll
        for (int h = 0; h < 2; ++h)
#pragma unroll
            for (int i = 0; i < 2; ++i) vAc[h][i] = vAn[h][i];
    }
    G8_WAIT_V(0);
    if (wr == 0) G8_BAR;
    G8_BAR;
#undef G8_SA
#undef G8_SB
#undef G8_STAGE
#undef G8_LDA
#undef G8_LDB
#undef G8_MMA
#undef G8_WAIT_V
#undef G8_WAIT_L
#undef G8_BAR
#undef G8_SCHED
}

struct DUnit { int pm, pn; };
struct DenseOrder {
    typedef DUnit Unit; static constexpr bool AFFINE = true;
    __device__ __forceinline__ void a_ready(const Unit&) const {}
    __device__ __forceinline__ void done(const Unit&) const {}
    int nM, nN, nwg, G, c; const char* Bt; int K;
    __device__ __forceinline__ void init(int nM_, int nN_, int G_, int c_, const void* Bt_, int K_) { nM = nM_; nN = nN_; nwg = nM * nN; G = G_; c = c_; Bt = (const char*)Bt_; K = K_; }
    __device__ __forceinline__ bool next(int i, Unit& u) const {
        const long L = (long)i * G + c; if (L >= nwg) return false;
        int wgid = (int)L; { const int q = nwg / NXCD, r = nwg % NXCD, xcd = wgid % NXCD, off = wgid / NXCD; wgid = (xcd < r ? xcd * (q + 1) : r * (q + 1) + (xcd - r) * q) + off; }
        const int nig = WGM * nN, gid = wgid / nig, fm = gid * WGM, gsz = (nM - fm) < WGM ? (nM - fm) : WGM;
        u.pm = fm + ((wgid % nig) % gsz); u.pn = (wgid % nig) / gsz; return true;
    }
    __device__ __forceinline__ int a_row(const Unit& u, int r) const { return u.pm * BM + r; }
    __device__ __forceinline__ const char* b_base(const Unit& u) const { return Bt + (size_t)u.pn * BM * K * 2; }
};
struct MUnit { int pm, pn, e, nvalid, lbase, idx; };
constexpr int MOE_UTAB = 131072, MOE_RTOK = MOE_UTAB + 128, MOE_RGATE = MOE_RTOK + 4096;
template <bool GATHER> struct MoeOrder {
    typedef MUnit Unit; static constexpr bool AFFINE = !GATHER;
    const int* utab; const int* rtok; const char* W; int K; int bpe; unsigned* ready; unsigned* tmo;
    __device__ __forceinline__ void a_ready(const Unit& u) const {
        if (GATHER) return;
        if (otid() < 64) {
            unsigned polls = 0;
            while ((unsigned)__builtin_amdgcn_readfirstlane(__hip_atomic_load(ready + 64 * u.pm, __ATOMIC_RELAXED, __HIP_MEMORY_SCOPE_AGENT)) < 32u) {
                if ((++polls & 255u) == 0u && __builtin_amdgcn_readfirstlane(__hip_atomic_load(tmo, __ATOMIC_RELAXED, __HIP_MEMORY_SCOPE_AGENT)) != 0u) break;
                if (polls > (1u << 21)) { if (otid() == 0) __hip_atomic_store(tmo, 1u, __ATOMIC_RELAXED, __HIP_MEMORY_SCOPE_AGENT); break; }
                __builtin_amdgcn_s_sleep(2);
            }
            __builtin_amdgcn_fence(__ATOMIC_ACQUIRE, "agent");
            asm volatile("s_waitcnt vmcnt(0)" ::: "memory");
        }
        asm volatile("" ::: "memory"); __builtin_amdgcn_s_barrier(); asm volatile("" ::: "memory");
    }
    __device__ __forceinline__ void done(const Unit& u) const {
        if (!GATHER) return;
        asm volatile("s_waitcnt vmcnt(0)" ::: "memory");
        if ((otid() & 63) == 0) __hip_atomic_fetch_add(ready + 64 * u.pm, 1u, __ATOMIC_RELAXED, __HIP_MEMORY_SCOPE_AGENT);
    }
    __device__ __forceinline__ bool next(int i, Unit& u) const {
        if (i >= 4) return false;
        const int* t = utab + i * 8;
        if (t[5] == 0) return false;
        u.pm = t[0]; u.pn = t[1]; u.e = t[2]; u.nvalid = t[3]; u.lbase = t[4]; u.idx = i; return true;
    }
    __device__ __forceinline__ int a_row(const Unit& u, int r) const { if (GATHER) return rtok[u.idx * 256 + r] >> 1; else return u.pm * BM + r; }
    __device__ __forceinline__ const char* b_base(const Unit& u) const { return W + ((size_t)u.e * 1024 + u.pn * BM) * K * bpe; }
};

struct EpiP2 {
    static constexpr bool PERM = true;
    bf16_t* P;
    __device__ __forceinline__ void operator()(const f32x4 (&acc)[2][2][4][2], const DUnit& u, int wr, int wc, int fr, int fq) const {
        const int row0 = u.pm * BM + wr * 64 + fr, col0 = u.pn * BM + wc * 32 + 8 * fq;
#pragma unroll
        for (int ai = 0; ai < 2; ++ai)
#pragma unroll
            for (int m = 0; m < 4; ++m) { bf16_t* rowp = P + (size_t)(row0 + ai * HALF + m * 16) * PW + col0;
#pragma unroll
                for (int bj = 0; bj < 2; ++bj) { const f32x4 v0 = acc[ai][bj][m][0], v1 = acc[ai][bj][m][1];
                    u32x4 w; w.x = cvt_pk_bf16(v0[0], v0[1]); w.y = cvt_pk_bf16(v0[2], v0[3]); w.z = cvt_pk_bf16(v1[0], v1[1]); w.w = cvt_pk_bf16(v1[2], v1[3]);
                    *(u32x4*)(rowp + bj * HALF) = w; } }
    }
};
struct EpiRes2 {
    static constexpr bool PERM = false;
    float* X; const float* gate; float scl;
    __device__ __forceinline__ void operator()(const f32x4 (&acc)[2][2][4][2], const DUnit& u, int wr, int wc, int fr, int fq) const {
        const int row0 = u.pm * BM + wr * 64 + fr, col0 = u.pn * BM + wc * 32 + 4 * fq;
#pragma unroll
        for (int ai = 0; ai < 2; ++ai)
#pragma unroll
            for (int m = 0; m < 4; ++m) { const int r = row0 + ai * HALF + m * 16; float* rowp = X + (size_t)r * 1024 + col0; const float* gp = gate + (size_t)mod_row(r) * 6144 + col0;
#pragma unroll
                for (int bj = 0; bj < 2; ++bj)
#pragma unroll
                    for (int n = 0; n < 2; ++n) { const f32x4 gv = *(const f32x4*)(gp + bj * HALF + n * 16); f32x4 x = *(f32x4*)(rowp + bj * HALF + n * 16); x += (gv * scl) * acc[ai][bj][m][n]; *(f32x4*)(rowp + bj * HALF + n * 16) = x; }
                asm volatile("" ::: "memory"); }
    }
};
struct EpiDelta {
    static constexpr bool PERM = true;
    bf16_t* Dl; const float* gate; float scl;
    __device__ __forceinline__ void operator()(const f32x4 (&acc)[2][2][4][2], const DUnit& u, int wr, int wc, int fr, int fq) const {
        const int row0 = u.pm * BM + wr * 64 + fr, col0 = u.pn * BM + wc * 32 + 8 * fq;
#pragma unroll
        for (int ai = 0; ai < 2; ++ai)
#pragma unroll
            for (int m = 0; m < 4; ++m) { const int r = row0 + ai * HALF + m * 16; bf16_t* rowp = Dl + (size_t)r * 1024 + col0; const float* gp = gate + (size_t)mod_row(r) * 6144 + col0;
#pragma unroll
                for (int bj = 0; bj < 2; ++bj) { const f32x4 g0 = *(const f32x4*)(gp + bj * HALF) * scl, g1 = *(const f32x4*)(gp + bj * HALF + 4) * scl;
                    const f32x4 v0 = acc[ai][bj][m][0] * g0, v1 = acc[ai][bj][m][1] * g1;
                    u32x4 w; w.x = cvt_pk_bf16(v0[0], v0[1]); w.y = cvt_pk_bf16(v0[2], v0[3]); w.z = cvt_pk_bf16(v1[0], v1[1]); w.w = cvt_pk_bf16(v1[2], v1[3]);
                    *(u32x4*)(rowp + bj * HALF) = w; } }
    }
};
struct EpiGU2 {
    static constexpr bool PERM = true;
    bf16_t* H;
    __device__ __forceinline__ void operator()(const f32x4 (&acc)[2][2][4][2], const MUnit& u, int wr, int wc, int fr, int fq) const {
        const int row0 = u.pm * BM + wr * 64 + fr, col0 = u.pn * BM + wc * 32 + 8 * fq;
#pragma unroll
        for (int ai = 0; ai < 2; ++ai)
#pragma unroll
            for (int m = 0; m < 4; ++m) { bf16_t* rowp = H + (size_t)(row0 + ai * HALF + m * 16) * 512 + (col0 >> 1);
#pragma unroll
                for (int bj = 0; bj < 2; ++bj) { const f32x4 v0 = acc[ai][bj][m][0], v1 = acc[ai][bj][m][1];
                    u32x2 w; w.x = cvt_pk_bf16(siluf(v0[0]) * v0[1], siluf(v0[2]) * v0[3]); w.y = cvt_pk_bf16(siluf(v1[0]) * v1[1], siluf(v1[2]) * v1[3]);
                    *(u32x2*)(rowp + bj * (HALF / 2)) = w; } }
    }
};
struct EpiGU8 {
    static constexpr bool PERM = true;
    unsigned char* H;
    __device__ __forceinline__ void operator()(const f32x4 (&acc)[2][2][4][2], const MUnit& u, int wr, int wc, int fr, int fq) const {
        const int row0 = u.pm * BM + wr * 64 + fr, col0 = u.pn * BM + wc * 32 + 8 * fq;
#pragma unroll
        for (int ai = 0; ai < 2; ++ai)
#pragma unroll
            for (int m = 0; m < 4; ++m) { unsigned char* rowp = H + (size_t)(row0 + ai * HALF + m * 16) * 512 + (col0 >> 1);
#pragma unroll
                for (int bj = 0; bj < 2; ++bj) { const f32x4 v0 = acc[ai][bj][m][0], v1 = acc[ai][bj][m][1];
                    __hip_atomic_store((unsigned*)(rowp + bj * (HALF / 2)), pk4_fp8(2.0f * siluf(v0[0]) * v0[1], 2.0f * siluf(v0[2]) * v0[3], 2.0f * siluf(v1[0]) * v1[1], 2.0f * siluf(v1[2]) * v1[3]), __ATOMIC_RELAXED, __HIP_MEMORY_SCOPE_AGENT); } }
    }
};
struct EpiDown2 {
    static constexpr bool PERM = true;
    bf16_t* YB; const int* rtok; const float* rgate;
    __device__ __forceinline__ void operator()(const f32x4 (&acc)[2][2][4][2], const MUnit& u, int wr, int wc, int fr, int fq) const {
        const int r0 = wr * 64 + fr, col0 = u.pn * BM + wc * 32 + 8 * fq;
#pragma unroll
        for (int ai = 0; ai < 2; ++ai)
#pragma unroll
            for (int m = 0; m < 4; ++m) { const int rt = r0 + ai * HALF + m * 16;
                if (rt < u.nvalid) { const int ent = rtok[u.idx * 256 + rt]; const float g = rgate[u.idx * 256 + rt]; bf16_t* rowp = YB + (size_t)ent * 1024 + col0;
#pragma unroll
                    for (int bj = 0; bj < 2; ++bj) { const f32x4 v0 = acc[ai][bj][m][0] * g, v1 = acc[ai][bj][m][1] * g;
                        u32x4 w; w.x = cvt_pk_bf16(v0[0], v0[1]); w.y = cvt_pk_bf16(v0[2], v0[3]); w.z = cvt_pk_bf16(v1[0], v1[1]); w.w = cvt_pk_bf16(v1[2], v1[3]);
                        *(u32x4*)(rowp + bj * HALF) = w; } } }
    }
};
struct EpiDown8 {
    static constexpr bool PERM = true;
    unsigned char* YB; const int* rtok; const float* rgate;
    __device__ __forceinline__ void operator()(const f32x4 (&acc)[2][2][4][2], const MUnit& u, int wr, int wc, int fr, int fq) const {
        const int r0 = wr * 64 + fr, col0 = u.pn * BM + wc * 32 + 8 * fq;
#pragma unroll
        for (int ai = 0; ai < 2; ++ai)
#pragma unroll
            for (int m = 0; m < 4; ++m) { const int rt = r0 + ai * HALF + m * 16;
                if (rt < u.nvalid) { const int ent = rtok[u.idx * 256 + rt]; const float g = 64.0f * rgate[u.idx * 256 + rt]; unsigned char* rowp = YB + (size_t)ent * 1024 + col0;
#pragma unroll
                    for (int bj = 0; bj < 2; ++bj) { const f32x4 v0 = acc[ai][bj][m][0] * g, v1 = acc[ai][bj][m][1] * g;
                        u32x2 w; w.x = pk4_fp8(v0[0], v0[1], v0[2], v0[3]); w.y = pk4_fp8(v1[0], v1[1], v1[2], v1[3]);
                        *(u32x2*)(rowp + bj * HALF) = w; } } }
    }
};
}

__device__ __forceinline__ void transpose_item(const float* __restrict__ W, int K, int N, bf16_t* __restrict__ WT, int mode, float* scr, int item, int lane) {
    const int nblk = N / 32, kb = item / nblk, nb = item % nblk, k0 = 64 * kb, n0 = 32 * nb;
    float wv[32];
#pragma unroll
    for (int i = 0; i < 32; ++i) wv[i] = __builtin_nontemporal_load(W + (size_t)(k0 + 2 * i + (lane >> 5)) * N + n0 + (lane & 31));
#pragma unroll
    for (int i = 0; i < 32; ++i) scr[(2 * i + (lane >> 5)) * 33 + (lane & 31)] = wv[i];
    LDS_WAIT();
    const int c = lane & 7;
#pragma unroll
    for (int j = 0; j < 4; ++j) {
        const int n = (lane >> 3) + 8 * j; const float* s = scr + (8 * c) * 33 + n;
        u32x4 o; o.x = pk2(s[0 * 33], s[1 * 33]); o.y = pk2(s[2 * 33], s[3 * 33]); o.z = pk2(s[4 * 33], s[5 * 33]); o.w = pk2(s[6 * 33], s[7 * 33]);
        const int nabs = n0 + n; const int orow = mode ? ((nabs < 512) ? 2 * nabs : 2 * (nabs - 512) + 1) : nabs;
        *(u32x4*)(WT + (size_t)orow * K + k0 + 8 * c) = o;
    }
    LDS_WAIT();
}


__device__ __forceinline__ void transpose_item8(const float* __restrict__ W, int K, int N, unsigned char* __restrict__ WT, int mode, float scale, float* scr, int item, int lane) {
    const int nblk = N / 32, kb = item / nblk, nb = item % nblk, k0 = 64 * kb, n0 = 32 * nb;
    float wv[32];
#pragma unroll
    for (int i = 0; i < 32; ++i) wv[i] = __builtin_nontemporal_load(W + (size_t)(k0 + 2 * i + (lane >> 5)) * N + n0 + (lane & 31));
#pragma unroll
    for (int i = 0; i < 32; ++i) scr[(2 * i + (lane >> 5)) * 33 + (lane & 31)] = wv[i] * scale;
    LDS_WAIT();
    const int c = lane & 7;
#pragma unroll
    for (int j = 0; j < 4; ++j) {
        const int n = (lane >> 3) + 8 * j; const float* s = scr + (8 * c) * 33 + n;
        u32x2 o; o.x = pk4_fp8(s[0 * 33], s[1 * 33], s[2 * 33], s[3 * 33]); o.y = pk4_fp8(s[4 * 33], s[5 * 33], s[6 * 33], s[7 * 33]);
        const int nabs = n0 + n; const int orow = mode ? ((nabs < 512) ? 2 * nabs : 2 * (nabs - 512) + 1) : nabs;
        *(u32x2*)(WT + (size_t)orow * K + k0 + 8 * c) = o;
    }
    LDS_WAIT();
}

__device__ __forceinline__ void convert_experts(const Params& p, int l, float* scr, int widx, int nwv, int it0, int it1) {
    const int tid = otid(), lane = tid & 63;
    bf16_t* wgu_t = (bf16_t*)(ows(p) + WS_WGU) + (size_t)l * 32 * 1024 * 1024; bf16_t* wdn_t = (bf16_t*)(ows(p) + WS_WDN) + (size_t)l * 32 * 1024 * 512;
    const float* wgu = oin(p, 17) + (size_t)l * 32 * 1024 * 1024; const float* wdn = oin(p, 18) + (size_t)l * 32 * 512 * 1024;
    constexpr int I_GU = 16 * 32, I_DN = 8 * 32, T_GU = 32 * I_GU;
    unsigned char* wgu8 = ows(p) + WS_WGU8 + (size_t)l * 32 * 1024 * 1024; unsigned char* wdn8 = ows(p) + WS_WDN8 + (size_t)l * 32 * 1024 * 512;
    for (int it = it0 + widx; it < it1; it += nwv) {
        if (it < T_GU) { const int m = it / I_GU;
            if (MOE_FP8) transpose_item8(wgu + (size_t)m * 1024 * 1024, 1024, 1024, wgu8 + (size_t)m * 1024 * 1024, 1, 32.0f, scr, it % I_GU, lane);
            else transpose_item(wgu + (size_t)m * 1024 * 1024, 1024, 1024, wgu_t + (size_t)m * 1024 * 1024, 1, scr, it % I_GU, lane); }
        else { const int r = it - T_GU, m = r / I_DN;
            if (MOE_FP8) transpose_item8(wdn + (size_t)m * 512 * 1024, 512, 1024, wdn8 + (size_t)m * 1024 * 512, 0, 16.0f, scr, r % I_DN, lane);
            else transpose_item(wdn + (size_t)m * 512 * 1024, 512, 1024, wdn_t + (size_t)m * 1024 * 512, 0, scr, r % I_DN, lane); }
    }
}

__device__ __forceinline__ void phase_prologue(const Params& p, unsigned char* lds) {
    const int tid = otid(), lane = tid & 63, wid = tid >> 6;
    float* scr = (float*)(lds + wid * 16384);
    const int gw = obid() * 8 + wid, NGW = gridDim.x * 8;
    bf16_t* win_t = (bf16_t*)(ows(p) + WS_WIN); bf16_t* wout_t = (bf16_t*)(ows(p) + WS_WOUT);
    constexpr int I_IN = 16 * 128, I_OUT = 16 * 32;
    constexpr int T_IN = 4 * I_IN, T_OUT = 4 * I_OUT;
    for (int it = gw; it < T_IN + T_OUT; it += NGW) {
        int r = it;
        if (r < T_IN) { const int m = r / I_IN; transpose_item(oin(p, 7) + (size_t)m * 1024 * 4096, 1024, 4096, win_t + (size_t)m * 4096 * 1024, 0, scr, r % I_IN, lane); continue; } r -= T_IN;
        { const int m = r / I_OUT; transpose_item(oin(p, 12) + (size_t)m * 1024 * 1024, 1024, 1024, wout_t + (size_t)m * 1024 * 1024, 0, scr, r % I_OUT, lane); }
    }
    {
        bf16_t* wrh = (bf16_t*)(ows(p) + WS_WRH); bf16_t* wrl = (bf16_t*)(ows(p) + WS_WRL);
        for (int i = obid() * 512 + tid; i < 4 * 48 * 1024; i += gridDim.x * 512) {
            const int l = i / (48 * 1024), j = (i / 1024) % 48, k = i % 1024;
            float w = 0.f;
            if (j < 4) w = oin(p, 13)[((size_t)l * 1024 + k) * 4 + j]; else if (j < 36) w = oin(p, 15)[((size_t)l * 1024 + k) * 32 + (j - 4)];
            const unsigned hi = f2bf(w); const float rem = w - __uint_as_float(hi << 16);
            wrh[i] = (bf16_t)hi; wrl[i] = (bf16_t)f2bf(rem);
        }
    }
    __syncthreads();
    float* modp = (float*)(ows(p) + WS_MODP);
    float* sS = (float*)lds;
    for (int u = obid(); u < 4 * 24 * 8; u += gridDim.x) {
        const int l = u / 192, rem = u % 192, nb = rem / 8, ks = rem % 8;
        __syncthreads();
        for (int i = tid; i < 9 * 128; i += 512) { const int r = i >> 7, k = i & 127; const float cv = (r < 8) ? oin(p, 1)[r * 1024 + ks * 128 + k] : oin(p, 3)[ks * 128 + k]; sS[i] = siluf(cv); }
        __syncthreads();
        const int col = nb * 256 + (tid & 255), kh = tid >> 8;
        float acc[9];
#pragma unroll
        for (int r = 0; r < 9; ++r) acc[r] = 0.f;
        const float* w = oin(p, 5) + ((size_t)l * 1024 + ks * 128 + kh * 64) * 6144 + col;
        for (int k = 0; k < 64; ++k) {
            const float wv = w[(size_t)k * 6144];
#pragma unroll
            for (int r = 0; r < 9; ++r) acc[r] += sS[r * 128 + kh * 64 + k] * wv;
        }
#pragma unroll
        for (int r = 0; r < 9; ++r) modp[(((size_t)l * NMODP + ks * 2 + kh) * 9 + r) * 6144 + col] = acc[r];
    }
}

__device__ __forceinline__ void phase_modreduce(const Params& p) {
    const float* modp = (const float*)(ows(p) + WS_MODP); float* modv = (float*)(ows(p) + WS_MOD);
    for (int i = obid() * 512 + otid(); i < 4 * 9 * 6144; i += gridDim.x * 512) {
        const int l = i / (9 * 6144), rem = i % (9 * 6144), n = rem % 6144;
        float s = oin(p, 6)[l * 6144 + n];
        for (int j = 0; j < NMODP; ++j) s += modp[((size_t)l * NMODP + j) * 9 * 6144 + rem];
        modv[i] = s;
    }
}

__device__ __forceinline__ void phase_norm1(const Params& p, int l, float scl) {
    const int lane = otid() & 63, wid = otid() >> 6;
    float* xws = (float*)(ows(p) + WS_X); bf16_t* hb = (bf16_t*)(ows(p) + WS_H); const bf16_t* yb = (const bf16_t*)(ows(p) + WS_YB);
    const float* modv = (const float*)(ows(p) + WS_MOD);
    const float* nw = oin(p, 4) + (size_t)(l * 2 + 0) * 1024;
    for (int r = obid() * 8 + wid; r < NTOK; r += gridDim.x * 8) {
        const int mr = mod_row(r);
        const float* src = (l == 0) ? (r < NLAT ? oin(p, 0) + (size_t)r * 1024 : oin(p, 2) + (size_t)(r - NLAT) * 1024) : xws + (size_t)r * 1024;
        f32x4 v[4];
#pragma unroll
        for (int j = 0; j < 4; ++j) v[j] = *(const f32x4*)(src + 4 * lane + 256 * j);
        if (l > 0) {
            const float* g5 = modv + ((size_t)(l - 1) * 9 + mr) * 6144 + 5 * 1024;
#pragma unroll
            for (int j = 0; j < 4; ++j) {
                const int c = 4 * lane + 256 * j;
                const f32x4 gv = *(const f32x4*)(g5 + c);
                f32x4 f;
                if (MOE_FP8) { const unsigned char* y8 = ows(p) + WS_YB8; f = (unpk4_fp8(*(const unsigned*)(y8 + (size_t)(2 * r) * 1024 + c)) + unpk4_fp8(*(const unsigned*)(y8 + (size_t)(2 * r + 1) * 1024 + c))) * (1.0f / 64.0f); }
                else { const u32x2 y0 = *(const u32x2*)(yb + (size_t)(2 * r) * 1024 + c), y1 = *(const u32x2*)(yb + (size_t)(2 * r + 1) * 1024 + c);
                f[0] = bf2f(y0.x & 0xffff) + bf2f(y1.x & 0xffff); f[1] = bf2f(y0.x >> 16) + bf2f(y1.x >> 16);
                f[2] = bf2f(y0.y & 0xffff) + bf2f(y1.y & 0xffff); f[3] = bf2f(y0.y >> 16) + bf2f(y1.y >> 16); }
                v[j] += (gv * scl) * f;
            }
        }
#pragma unroll
        for (int j = 0; j < 4; ++j) *(f32x4*)(xws + (size_t)r * 1024 + 4 * lane + 256 * j) = v[j];
        float ss = 0.f;
#pragma unroll
        for (int j = 0; j < 4; ++j) ss += (v[j][0] * v[j][0] + v[j][1] * v[j][1]) + (v[j][2] * v[j][2] + v[j][3] * v[j][3]);
        const float rstd = rsqrtf(wave_sum(ss) * (1.0f / 1024.0f) + EPS);
        const float* msh = modv + ((size_t)l * 9 + mr) * 6144; const float* msc = msh + 1024;
#pragma unroll
        for (int j = 0; j < 4; ++j) {
            const int c = 4 * lane + 256 * j;
            const f32x4 w = *(const f32x4*)(nw + c), sh = *(const f32x4*)(msh + c), sc = *(const f32x4*)(msc + c);
            const f32x4 h = (v[j] * rstd * w) * (1.0f + sc) + sh;
            u32x2 o; o.x = pk2(h[0], h[1]); o.y = pk2(h[2], h[3]);
            *(u32x2*)(hb + (size_t)r * 1024 + c) = o;
        }
    }
}

__device__ __forceinline__ void phase_final(const Params& p) {
    const int lane = otid() & 63, wid = otid() >> 6;
    const float* xws = (const float*)(ows(p) + WS_X); const bf16_t* yb = (const bf16_t*)(ows(p) + WS_YB);
    const float* modv = (const float*)(ows(p) + WS_MOD); const float* nw = oin(p, 19);
    for (int r = obid() * 8 + wid; r < NLAT; r += gridDim.x * 8) {
        const int mr = mod_row(r);
        const float* g5 = modv + ((size_t)3 * 9 + mr) * 6144 + 5 * 1024;
        f32x4 v[4]; float ss = 0.f;
#pragma unroll
        for (int j = 0; j < 4; ++j) {
            const int c = 4 * lane + 256 * j;
            v[j] = *(const f32x4*)(xws + (size_t)r * 1024 + c);
            const f32x4 gv = *(const f32x4*)(g5 + c);
            f32x4 f;
            if (MOE_FP8) { const unsigned char* y8 = ows(p) + WS_YB8; f = (unpk4_fp8(*(const unsigned*)(y8 + (size_t)(2 * r) * 1024 + c)) + unpk4_fp8(*(const unsigned*)(y8 + (size_t)(2 * r + 1) * 1024 + c))) * (1.0f / 64.0f); }
            else { const u32x2 y0 = *(const u32x2*)(yb + (size_t)(2 * r) * 1024 + c), y1 = *(const u32x2*)(yb + (size_t)(2 * r + 1) * 1024 + c);
            f[0] = bf2f(y0.x & 0xffff) + bf2f(y1.x & 0xffff); f[1] = bf2f(y0.x >> 16) + bf2f(y1.x >> 16);
            f[2] = bf2f(y0.y & 0xffff) + bf2f(y1.y & 0xffff); f[3] = bf2f(y0.y >> 16) + bf2f(y1.y >> 16); }
            v[j] += gv * f;
            ss += (v[j][0] * v[j][0] + v[j][1] * v[j][1]) + (v[j][2] * v[j][2] + v[j][3] * v[j][3]);
        }
        const float rstd = rsqrtf(wave_sum(ss) * (1.0f / 1024.0f) + EPS);
#pragma unroll
        for (int j = 0; j < 4; ++j) { const int c = 4 * lane + 256 * j; const f32x4 w = *(const f32x4*)(nw + c); *(f32x4*)(p.out + (size_t)r * 1024 + c) = v[j] * rstd * w; }
    }
}

__device__ __forceinline__ void phase_gemm1(const Params& p, int l, unsigned char* lds) {
    const bf16_t* hb = (const bf16_t*)(ows(p) + WS_H); const bf16_t* wt = (const bf16_t*)(ows(p) + WS_WIN) + (size_t)l * 4096 * 1024; bf16_t* pb = (bf16_t*)(ows(p) + WS_P);
    constexpr int NT = PW / 128, MT = NTOK / 128;
    for (int u = obid(); u < MT * NT; u += gridDim.x) {
        const int mt = u / NT, nt = u % NT;
        ARowPlain ar{hb + (size_t)mt * 128 * 1024, 1024};
        EpiP ep{pb + (size_t)mt * 128 * PW + nt * 128};
        gemm128(lds, ar, wt + (size_t)nt * 128 * 1024, 1024, ep);
    }
}

__device__ __forceinline__ void unpack8(const u32x4 w, float (&f)[8]) {
    f[0] = bf2f(w.x & 0xffff); f[1] = bf2f(w.x >> 16); f[2] = bf2f(w.y & 0xffff); f[3] = bf2f(w.y >> 16);
    f[4] = bf2f(w.z & 0xffff); f[5] = bf2f(w.z >> 16); f[6] = bf2f(w.w & 0xffff); f[7] = bf2f(w.w >> 16);
}
__device__ __forceinline__ void conv_rows(const Params& p, int l, int widx, int nwv) {
    const int lane = otid() & 63;
    const bf16_t* pb = (const bf16_t*)(ows(p) + WS_P); bf16_t* yb = (bf16_t*)(ows(p) + WS_Y);
    const float* cw = oin(p, 8) + (size_t)l * 3 * 512; const float* cnw = oin(p, 9) + (size_t)l * 512;
    const int nrows = (l == DEPTH - 1) ? NLAT : NTOK;
    const int c0 = lane * 8;
    float w0[8], w1[8], w2[8], nwv8[8];
#pragma unroll
    for (int j = 0; j < 8; ++j) { w0[j] = cw[c0 + j]; w1[j] = cw[512 + c0 + j]; w2[j] = cw[1024 + c0 + j]; nwv8[j] = cnw[c0 + j]; }
    constexpr int NB = 4;
    for (int rb = widx; rb < nrows; rb += NB * nwv) {
        u32x4 vb[NB], vc[NB], vh[NB], vcm[NB], vhm[NB], vcp[NB], vhp[NB]; bool hm[NB], hp[NB];
#pragma unroll
        for (int q = 0; q < NB; ++q) {
            int r = rb + q * nwv; if (r >= nrows) r = rb;
            int rm = -1, rp = -1;
            if (r < NLAT) {
                const int t = r & 2047;
                if (c0 < 256) { if ((t & 63) > 0) rm = r - 1; if ((t & 63) < 63) rp = r + 1; }
                else { if (t >= 64) rm = r - 64; if (t < SEQ - 64) rp = r + 64; }
            } else { const int tc = (r - NLAT) & 255; if (tc > 0) rm = r - 1; if (tc < 255) rp = r + 1; }
            hm[q] = rm >= 0; hp[q] = rp >= 0; if (rm < 0) rm = r; if (rp < 0) rp = r;
            vb[q] = *(const u32x4*)(pb + (size_t)r * PW + OFF_B + c0); vc[q] = *(const u32x4*)(pb + (size_t)r * PW + OFF_C + c0); vh[q] = *(const u32x4*)(pb + (size_t)r * PW + OFF_HV + c0);
            vcm[q] = *(const u32x4*)(pb + (size_t)rm * PW + OFF_C + c0); vhm[q] = *(const u32x4*)(pb + (size_t)rm * PW + OFF_HV + c0);
            vcp[q] = *(const u32x4*)(pb + (size_t)rp * PW + OFF_C + c0); vhp[q] = *(const u32x4*)(pb + (size_t)rp * PW + OFF_HV + c0);
        }
#pragma unroll
        for (int q = 0; q < NB; ++q) {
            const int r = rb + q * nwv;
            float bg[8], u0[8], um[8], up[8], t1[8];
            unpack8(vb[q], bg); unpack8(vc[q], u0); unpack8(vh[q], t1);
#pragma unroll
            for (int j = 0; j < 8; ++j) u0[j] *= t1[j];
            unpack8(vcm[q], um); unpack8(vhm[q], t1);
#pragma unroll
            for (int j = 0; j < 8; ++j) um[j] = hm[q] ? um[j] * t1[j] : 0.f;
            unpack8(vcp[q], up); unpack8(vhp[q], t1);
#pragma unroll
            for (int j = 0; j < 8; ++j) up[j] = hp[q] ? up[j] * t1[j] : 0.f;
            float z[8]; float ss = 0.f;
#pragma unroll
            for (int j = 0; j < 8; ++j) { z[j] = bg[j] * (w0[j] * um[j] + w1[j] * u0[j] + w2[j] * up[j]); ss += z[j] * z[j]; }
            const float rstd = rsqrtf(wave_sum(ss) * (1.0f / 512.0f) + EPS);
            u32x4 o;
            o.x = cvtpk(z[0] * rstd * nwv8[0], z[1] * rstd * nwv8[1]); o.y = cvtpk(z[2] * rstd * nwv8[2], z[3] * rstd * nwv8[3]);
            o.z = cvtpk(z[4] * rstd * nwv8[4], z[5] * rstd * nwv8[5]); o.w = cvtpk(z[6] * rstd * nwv8[6], z[7] * rstd * nwv8[7]);
            if (r < nrows) *(u32x4*)(yb + (size_t)r * 1024 + c0) = o;
        }
    }
}

template <int DIR>
__device__ __forceinline__ void gla_pre_dir(const Params& p, int l, int chunk, float* sQ, float* sK, const float* sV, float* sA, float* sBq, float (&oacc)[16]) {
    const int ch = otid(), tid = otid(), R0 = chunk * 16;
    const bf16_t* pb = (const bf16_t*)(ows(p) + WS_P);
    bf16_t* qin = (bf16_t*)(ows(p) + WS_QIN); bf16_t* kout = (bf16_t*)(ows(p) + WS_KOUT); float* dch = (float*)(ows(p) + WS_DCH);
    float lbv = 0.f;
    {
        const float* lb = oin(p, 10) + (size_t)DIR * 4 * 512 + ch;
        const float z0 = lb[0], z1 = lb[512], z2 = lb[1024], z3 = lb[1536];
        const float mx = fmaxf(fmaxf(z0, z1), fmaxf(z2, z3));
        const float e0 = __expf(z0 - mx), e1 = __expf(z1 - mx), e2 = __expf(z2 - mx), e3 = __expf(z3 - mx);
        const float inv = 1.0f / (e0 + e1 + e2 + e3);
        lbv = ((l >= 1 ? e1 : 0.f) + (l >= 2 ? e2 : 0.f) + (l >= 3 ? e3 : 0.f)) * inv;
    }
    float b = 0.f;
#pragma unroll 1
    for (int i = 0; i < 16; ++i) {
        const int row = R0 + (DIR ? 15 - i : i);
        const float zf = bf2f(pb[(size_t)row * PW + OFF_ZF + DIR * 512 + ch]);
        const float sg = 1.0f / (1.0f + __expf(-zf)), sn = 1.0f / (1.0f + __expf(zf));
        const float f = fmaxf(lbv + (1.0f - lbv) * sg, 1e-30f);
        b += __logf(f);
        sBq[i * 512 + ch] = b; sK[i * 512 + ch] = (1.0f - lbv) * sn;
        sQ[i * 512 + ch] = siluf(bf2f(pb[(size_t)row * PW + OFF_Q + ch]));
    }
    const float blast = b;
#pragma unroll 1
    for (int i = 0; i < 16; ++i) {
        const int row = R0 + (DIR ? 15 - i : i);
        const float bi = sBq[i * 512 + ch], kq = sK[i * 512 + ch], qv = sQ[i * 512 + ch];
        const float qi = qv * __expf(bi), kt = kq * __expf(fminf(-bi, 80.0f)), ko = kq * __expf(blast - bi);
        sQ[i * 512 + ch] = qi; sK[i * 512 + ch] = kt;
        qin[((size_t)DIR * NTOK + row) * 512 + ch] = (bf16_t)f2bf(qi);
        kout[((size_t)DIR * NTOK + row) * 512 + ch] = (bf16_t)f2bf(ko);
    }
    dch[((size_t)DIR * NCHUNK + chunk) * 512 + ch] = __expf(blast);
    __syncthreads();
#pragma unroll 1
    for (int e2 = 0; e2 < 2; ++e2) {
        const int e = tid * 2 + e2, h = e >> 8, t = (e >> 4) & 15, s = e & 15;
        float sum = 0.f;
        const float* qp = sQ + t * 512 + h * 128; const float* kp = sK + s * 512 + h * 128;
#pragma unroll 8
        for (int k = 0; k < 128; ++k) sum += qp[k] * kp[k];
        sA[e] = (s <= t) ? sum : 0.f;
    }
    __syncthreads();
    const int h = ch >> 7;
#pragma unroll
    for (int t = 0; t < 16; ++t) {
        float o = 0.f;
#pragma unroll 1
        for (int s = 0; s <= t; ++s) o += sA[(h * 16 + t) * 16 + s] * sV[(DIR ? 15 - s : s) * 512 + ch];
        oacc[DIR ? 15 - t : t] += o;
    }
    __syncthreads();
}

__device__ __forceinline__ void phase_conv_glapre(const Params& p, int l, unsigned char* lds) {
    conv_rows(p, l, obid() * 8 + (otid() >> 6), (int)gridDim.x * 8);
    float* sQ = (float*)lds; float* sK = sQ + 16 * 512; float* sV = sK + 16 * 512; float* sBq = sV + 16 * 512; float* sA = sBq + 16 * 512;
    const bf16_t* pb = (const bf16_t*)(ows(p) + WS_P); float* ointra = (float*)(ows(p) + WS_OINTRA);
    const int ch = otid();
    for (int chunk = obid(); chunk < NCHUNK; chunk += gridDim.x) {
        const int R0 = chunk * 16;
        float oacc[16];
#pragma unroll
        for (int i = 0; i < 16; ++i) oacc[i] = 0.f;
        __syncthreads();
#pragma unroll
        for (int ro = 0; ro < 16; ++ro) sV[ro * 512 + ch] = bf2f(pb[(size_t)(R0 + ro) * PW + OFF_I + ch]);
        gla_pre_dir<0>(p, l, chunk, sQ, sK, sV, sA, sBq, oacc);
        gla_pre_dir<1>(p, l, chunk, sQ, sK, sV, sA, sBq, oacc);
#pragma unroll
        for (int ro = 0; ro < 16; ++ro) ointra[(size_t)(R0 + ro) * 512 + ch] = oacc[ro];
    }
}

__device__ __forceinline__ void phase_gla_seq(const Params& p, int l, unsigned char* lds) {
    const int tid = otid();
    float* S = (float*)lds;
    float* sQ = S + 128 * 32;
    float* sKo = sQ + 16 * 128;
    float* sV = sKo + 16 * 128;
    float* sD = sV + 16 * 32;
    const bf16_t* pb = (const bf16_t*)(ows(p) + WS_P);
    const bf16_t* qin = (const bf16_t*)(ows(p) + WS_QIN); const bf16_t* kout = (const bf16_t*)(ows(p) + WS_KOUT); const float* dch = (const float*)(ows(p) + WS_DCH);
    float* ointer = (float*)(ows(p) + WS_OINTER);
    for (int u = obid(); u < 256; u += gridDim.x) {
        const int vblk = u & 3, dir = (u >> 2) & 1, chain = u >> 3, b = chain >> 2, h = chain & 3;
        __syncthreads();
        for (int i = tid; i < 128 * 32; i += 512) S[i] = 0.f;
        for (int c = 0; c < 144; ++c) {
            int R0;
            if (c < 16) { const int cm = dir ? 15 - c : c; R0 = NLAT + b * 256 + cm * 16; }
            else { const int cc = c - 16; const int cm = dir ? 127 - cc : cc; R0 = b * 2048 + cm * 16; }
            __syncthreads();
            for (int i = tid; i < 16 * 128; i += 512) {
                const int si = i >> 7, k = i & 127; const int row = R0 + (dir ? 15 - si : si);
                const size_t g = ((size_t)dir * NTOK + row) * 512 + h * 128 + k;
                sQ[i] = bf2f(qin[g]); sKo[i] = bf2f(kout[g]);
            }
            { const int si = tid >> 5, vv = tid & 31; const int row = R0 + (dir ? 15 - si : si); sV[tid] = bf2f(pb[(size_t)row * PW + OFF_I + h * 128 + vblk * 32 + vv]); }
            if (tid < 128) sD[tid] = dch[((size_t)dir * NCHUNK + (R0 >> 4)) * 512 + h * 128 + tid];
            __syncthreads();
            {
                const int si = tid >> 5, vv = tid & 31; const int row = R0 + (dir ? 15 - si : si);
                float o = 0.f;
                for (int k = 0; k < 128; ++k) o += sQ[si * 128 + k] * S[k * 32 + vv];
                ointer[((size_t)dir * NTOK + row) * 512 + h * 128 + vblk * 32 + vv] = o;
            }
            __syncthreads();
            {
                const int k = tid >> 2, v0 = (tid & 3) * 8; const float d = sD[k];
                float kk[16];
#pragma unroll
                for (int i = 0; i < 16; ++i) kk[i] = sKo[i * 128 + k];
#pragma unroll
                for (int j = 0; j < 8; ++j) {
                    float s = d * S[k * 32 + v0 + j];
#pragma unroll
                    for (int i = 0; i < 16; ++i) s += kk[i] * sV[i * 32 + v0 + j];
                    S[k * 32 + v0 + j] = s;
                }
            }
        }
    }
}


__device__ __forceinline__ float bflo(unsigned w) { return __uint_as_float(w << 16); }
__device__ __forceinline__ float bfhi(unsigned w) { return __uint_as_float(w & 0xffff0000u); }

template <int DIR>
__device__ __forceinline__ void gla_pre2_dir(const float (&q0a)[16], const float (&q1a)[16], const unsigned (&rz)[16], float lb0, float lb1, unsigned char* wl, unsigned char* rec,
                                             f32x4 (&oT)[8], int lane, int fr, int fq) {
    float bq0[16], bq1[16], kk0[16], kk1[16]; float b0 = 0.f, b1 = 0.f;
#pragma unroll
    for (int i = 0; i < 16; ++i) {
        const int t = DIR ? 15 - i : i;
        const float z0 = bflo(rz[t]), z1 = bfhi(rz[t]);
        const float sg0 = frcp(1.0f + __expf(-z0)), sg1 = frcp(1.0f + __expf(-z1));
        const float f0 = fmaxf(lb0 + (1.0f - lb0) * sg0, 1e-30f), f1 = fmaxf(lb1 + (1.0f - lb1) * sg1, 1e-30f);
        b0 += __logf(f0); b1 += __logf(f1); bq0[t] = b0; bq1[t] = b1; kk0[t] = 1.0f - f0; kk1[t] = 1.0f - f1;
    }
    const float bl0 = b0, bl1 = b1;
    unsigned kw0[8], kw1[8];
#pragma unroll
    for (int i = 0; i < 8; ++i) { kw0[i] = 0u; kw1[i] = 0u; }
#pragma unroll
    for (int t = 0; t < 16; ++t) {
        const float e0 = __expf(bq0[t]), e1 = __expf(bq1[t]);
        const float qi0 = q0a[t] * e0, qi1 = q1a[t] * e1;
        const float kt0 = kk0[t] * frcp(fmaxf(e0, 1.8e-35f)), kt1 = kk1[t] * frcp(fmaxf(e1, 1.8e-35f));
        const float ko0 = kk0[t] * __expf(bl0 - bq0[t]), ko1 = kk1[t] * __expf(bl1 - bq1[t]);
        *(unsigned*)(wl + t * 272 + lane * 4) = cvtpk(qi0, qi1);
        *(unsigned*)(wl + 4352 + t * 272 + lane * 4) = cvtpk(kt0, kt1);
        const unsigned kp = cvtpk(ko0, ko1);
        kw0[t >> 1] |= (kp & 0xffffu) << (16 * (t & 1)); kw1[t >> 1] |= (kp >> 16) << (16 * (t & 1));
    }
    {
        const int c0 = 2 * lane, c1 = c0 + 1;
        unsigned char* k0p = rec + 4096 + (c0 >> 4) * 512 + (c0 & 15) * 8; unsigned char* k1p = rec + 4096 + (c1 >> 4) * 512 + (c1 & 15) * 8;
#pragma unroll
        for (int g = 0; g < 4; ++g) { *(u32x2*)(k0p + g * 128) = (u32x2){kw0[2 * g], kw0[2 * g + 1]}; *(u32x2*)(k1p + g * 128) = (u32x2){kw1[2 * g], kw1[2 * g + 1]}; }
        float* dp = (float*)(rec + 8192) + c0; dp[0] = __expf(bl0); dp[1] = __expf(bl1);
    }
    LDS_WAIT();
#pragma unroll
    for (int s = 0; s < 4; ++s) {
        const u32x2 lo = *(const u32x2*)(wl + fr * 272 + (32 * s + 4 * fq) * 2), hi = *(const u32x2*)(wl + fr * 272 + (32 * s + 16 + 4 * fq) * 2);
        *(u32x4*)(rec + s * 1024 + lane * 16) = (u32x4){lo.x, lo.y, hi.x, hi.y};
    }
    f32x4 at = (f32x4){0.f, 0.f, 0.f, 0.f};
#pragma unroll
    for (int s = 0; s < 4; ++s) {
        const bf16x8 kf = *(const bf16x8*)(wl + 4352 + fr * 272 + (32 * s + 8 * fq) * 2);
        const bf16x8 qf = *(const bf16x8*)(wl + fr * 272 + (32 * s + 8 * fq) * 2);
        at = __builtin_amdgcn_mfma_f32_16x16x32_bf16(kf, qf, at, 0, 0, 0);
    }
#pragma unroll
    for (int r = 0; r < 4; ++r) { const int sp = 4 * fq + r; const bool keep = DIR ? (sp >= fr) : (sp <= fr); at[r] = keep ? at[r] : 0.f; }
    union { u32x2 u; s16x4 h; } bop; bop.u = (u32x2){cvtpk(at[0], at[1]), cvtpk(at[2], at[3])};
#pragma unroll
    for (int vb = 0; vb < 8; ++vb) {
        union { u32x2 u; s16x4 h; } aop; aop.u = *(const u32x2*)(wl + 8704 + (vb * 16 + fr) * 32 + 8 * fq);
        oT[vb] = __builtin_amdgcn_mfma_f32_16x16x16bf16_1k(aop.h, bop.h, oT[vb], 0, 0, 0);
    }
    LDS_WAIT();
}

__device__ __forceinline__ void phase_gla_pre2(const Params& p, int l, unsigned char* lds) {
    const int tid = otid(), lane = tid & 63, wid = __builtin_amdgcn_readfirstlane(tid >> 6), fr = lane & 15, fq = lane >> 4;
    unsigned char* wl = lds + wid * 12800;
    unsigned char* ws = ows(p);
    const bf16_t* pb = (const bf16_t*)(ws + WS_P); bf16_t* ointra = (bf16_t*)(ws + WS_OINTRA);
    float lb[2][2];
    {
        const float* hl = oin(p, 10);
#pragma unroll
        for (int d = 0; d < 2; ++d)
#pragma unroll
            for (int e = 0; e < 2; ++e) {
                const float* q = hl + (size_t)d * 4 * 512 + (2 * lane + e);
                lb[d][e] = 0.f; (void)q;
            }
    }
    for (int unit = wid * (int)gridDim.x + obid(); unit < NCHUNK * 4; unit += gridDim.x * 8) {
        const int chunk = unit >> 2, h = unit & 3, R0 = chunk * 16;
        {
            const float* hl = oin(p, 10);
#pragma unroll
            for (int d = 0; d < 2; ++d)
#pragma unroll
                for (int e = 0; e < 2; ++e) {
                    const float* q = hl + (size_t)d * 4 * 512 + h * 128 + 2 * lane + e;
                    const float z0 = q[0], z1 = q[512], z2 = q[1024], z3 = q[1536];
                    const float mx = fmaxf(fmaxf(z0, z1), fmaxf(z2, z3));
                    const float e0 = __expf(z0 - mx), e1 = __expf(z1 - mx), e2 = __expf(z2 - mx), e3 = __expf(z3 - mx);
                    lb[d][e] = ((l >= 1 ? e1 : 0.f) + (l >= 2 ? e2 : 0.f) + (l >= 3 ? e3 : 0.f)) / (e0 + e1 + e2 + e3);
                }
        }
        unsigned rq[16], rf[16], rb[16], rv[16];
#pragma unroll
        for (int t = 0; t < 16; ++t) {
            const bf16_t* base = pb + (size_t)(R0 + t) * PW + h * 128 + 2 * lane;
            rq[t] = *(const unsigned*)(base + OFF_Q); rf[t] = *(const unsigned*)(base + OFF_ZF); rb[t] = *(const unsigned*)(base + OFF_ZF + 512); rv[t] = *(const unsigned*)(base + OFF_I);
        }
        unsigned char* vrec = ws + WS_VREC + (size_t)(chunk * 4 + h) * VREC_BYTES;
        {
            unsigned w0[8], w1[8];
#pragma unroll
            for (int i = 0; i < 8; ++i) { w0[i] = (rv[2 * i] & 0xffffu) | (rv[2 * i + 1] << 16); w1[i] = (rv[2 * i] >> 16) | (rv[2 * i + 1] & 0xffff0000u); }
            const int c0 = 2 * lane, c1 = c0 + 1;
            unsigned char* v0p = vrec + (c0 >> 4) * 512 + (c0 & 15) * 8; unsigned char* v1p = vrec + (c1 >> 4) * 512 + (c1 & 15) * 8;
#pragma unroll
            for (int g = 0; g < 4; ++g) { *(u32x2*)(v0p + g * 128) = (u32x2){w0[2 * g], w0[2 * g + 1]}; *(u32x2*)(v1p + g * 128) = (u32x2){w1[2 * g], w1[2 * g + 1]}; }
            unsigned char* vl = wl + 8704 + c0 * 32;
            *(u32x4*)(vl) = (u32x4){w0[0], w0[1], w0[2], w0[3]}; *(u32x4*)(vl + 16) = (u32x4){w0[4], w0[5], w0[6], w0[7]};
            *(u32x4*)(vl + 32) = (u32x4){w1[0], w1[1], w1[2], w1[3]}; *(u32x4*)(vl + 48) = (u32x4){w1[4], w1[5], w1[6], w1[7]};
        }
        f32x4 oT[8];
#pragma unroll
        for (int vb = 0; vb < 8; ++vb) oT[vb] = (f32x4){0.f, 0.f, 0.f, 0.f};
        float q0a[16], q1a[16];
#pragma unroll
        for (int t = 0; t < 16; ++t) { q0a[t] = siluf(bflo(rq[t])); q1a[t] = siluf(bfhi(rq[t])); }
        gla_pre2_dir<0>(q0a, q1a, rf, lb[0][0], lb[0][1], wl, ws + WS_GREC + ((size_t)(0 * NCHUNK + chunk) * 4 + h) * REC_BYTES, oT, lane, fr, fq);
        gla_pre2_dir<1>(q0a, q1a, rb, lb[1][0], lb[1][1], wl, ws + WS_GREC + ((size_t)(1 * NCHUNK + chunk) * 4 + h) * REC_BYTES, oT, lane, fr, fq);
#pragma unroll
        for (int vb = 0; vb < 8; ++vb) *(u32x2*)(ointra + (size_t)(R0 + fr) * 512 + h * 128 + vb * 16 + 4 * fq) = (u32x2){cvtpk(oT[vb][0], oT[vb][1]), cvtpk(oT[vb][2], oT[vb][3])};
    }
}

constexpr int GR = 8, STG_BYTES = REC_BYTES + VREC_BYTES;
__device__ __forceinline__ int gla_chunk_of_step(int c, int b, int dir) {
    if (c < 16) { const int cm = dir ? 15 - c : c; return (NLAT + b * 256) / 16 + cm; }
    const int cc = c - 16; const int cm = dir ? 127 - cc : cc; return b * 128 + cm;
}
constexpr int SG_STEP = REC_BYTES + 1024, SG_GRP = 2 * SG_STEP, SG_NG = 5;
constexpr int SG_FLAGS = LDS_MISC + 2048;
constexpr int SG_OBUF = SG_NG * SG_GRP, SG_NS = 8;
constexpr int SG_SCR = SG_OBUF + SG_NS * 2048;
constexpr unsigned SG_SPIN = 1u << 22;
#define SG_WAIT(cond) do { unsigned _sp = 0; while ((cond) && ++_sp < SG_SPIN) __builtin_amdgcn_s_sleep(1); asm volatile("" ::: "memory"); } while (0)
__device__ __forceinline__ void gla_scan_unit(const Params& p, int l, unsigned char* lds_, int chain, int vq, int side_idx, int side_n, int pm) {
    LAS unsigned char* lds = (LAS unsigned char*)lds_;
    const int tid = otid(), lane = tid & 63, wid = __builtin_amdgcn_readfirstlane(tid >> 6), fr = lane & 15, fq = lane >> 4;
    unsigned char* ws = ows(p);
    const int b = chain >> 3, h = (chain >> 1) & 3, dir = chain & 1;
    const unsigned char* grec = ws + WS_GREC + (size_t)dir * NCHUNK * 4 * REC_BYTES + (size_t)h * REC_BYTES;
    const unsigned char* vrec = ws + WS_VREC + (size_t)h * VREC_BYTES + vq * 1024;
    volatile LAS unsigned* flg = (volatile LAS unsigned*)(lds + SG_FLAGS);
    __syncthreads();
    if (tid < 16) flg[tid] = 0u;
    __syncthreads();
    if (pm == 4 && wid >= 4) {
        const int mm = wid - 4, m = mm & 1, s1 = mm >> 1;
#define GSEQ_ISSUE4(gi) do { const int _g = (gi); const int _s = s1; \
            const int _c = 2 * _g + _s; const int _cc = _c < 144 ? _c : 143; const int _ch = gla_chunk_of_step(_cc, b, dir); \
            const unsigned* _src = (const unsigned*)(grec + (size_t)_ch * 4 * REC_BYTES + m * 1024 + lane * 16); \
            LAS unsigned* _dst = (LAS unsigned*)(lds + (unsigned)(_g % SG_NG) * SG_GRP + _s * SG_STEP + m * 1024); \
            __builtin_amdgcn_global_load_lds(_src, _dst, 16, 0, 0); __builtin_amdgcn_global_load_lds(_src, _dst, 16, 2048, 0); \
            __builtin_amdgcn_global_load_lds(_src + 1024, _dst + 1024, 16, 0, 0); __builtin_amdgcn_global_load_lds(_src + 1024, _dst + 1024, 16, 2048, 0); \
            if (m == 0) __builtin_amdgcn_global_load_lds(_src + 2048, _dst + 2048, 16, 0, 0); \
            else __builtin_amdgcn_global_load_lds((const unsigned*)(vrec + (size_t)_ch * 4 * VREC_BYTES + lane * 16), (LAS unsigned*)(lds + (unsigned)(_g % SG_NG) * SG_GRP + _s * SG_STEP + REC_BYTES), 16, 0, 0); } while (0)
#pragma unroll 1
        for (int g = 0; g < SG_NG - 1; ++g) GSEQ_ISSUE4(g);
#pragma unroll 1
        for (int g = 0; g < 72; ++g) {
            asm volatile("s_waitcnt vmcnt(15)" ::: "memory");
            if (lane == 0) flg[10 + mm] = (unsigned)(g + 1);
            asm volatile("s_waitcnt lgkmcnt(0)" ::: "memory");
            SG_WAIT(flg[2] < (unsigned)g || flg[3] < (unsigned)g || flg[4] < (unsigned)g || flg[5] < (unsigned)g);
            GSEQ_ISSUE4(g + SG_NG - 1);
        }
        asm volatile("s_waitcnt vmcnt(0)" ::: "memory");
#undef GSEQ_ISSUE4
    } else if (wid == 4 || wid == 5) {
        const int m = wid - 4;
#define GSEQ_ISSUE(gi) do { const int _g = (gi); _Pragma("unroll") for (int _s = 0; _s < 2; ++_s) { \
            const int _c = 2 * _g + _s; const int _cc = _c < 144 ? _c : 143; const int _ch = gla_chunk_of_step(_cc, b, dir); \
            const unsigned* _src = (const unsigned*)(grec + (size_t)_ch * 4 * REC_BYTES + m * 1024 + lane * 16); \
            LAS unsigned* _dst = (LAS unsigned*)(lds + (unsigned)(_g % SG_NG) * SG_GRP + _s * SG_STEP + m * 1024); \
            __builtin_amdgcn_global_load_lds(_src, _dst, 16, 0, 0); __builtin_amdgcn_global_load_lds(_src, _dst, 16, 2048, 0); \
            __builtin_amdgcn_global_load_lds(_src + 1024, _dst + 1024, 16, 0, 0); __builtin_amdgcn_global_load_lds(_src + 1024, _dst + 1024, 16, 2048, 0); \
            if (m == 0) __builtin_amdgcn_global_load_lds(_src + 2048, _dst + 2048, 16, 0, 0); \
            else __builtin_amdgcn_global_load_lds((const unsigned*)(vrec + (size_t)_ch * 4 * VREC_BYTES + lane * 16), (LAS unsigned*)(lds + (unsigned)(_g % SG_NG) * SG_GRP + _s * SG_STEP + REC_BYTES), 16, 0, 0); } } while (0)
#pragma unroll 1
        for (int g = 0; g < SG_NG - 1; ++g) GSEQ_ISSUE(g);
#pragma unroll 1
        for (int g = 0; g < 72; ++g) {
            asm volatile("s_waitcnt vmcnt(30)" ::: "memory");
            if (lane == 0) flg[m] = (unsigned)(g + 1);
            asm volatile("s_waitcnt lgkmcnt(0)" ::: "memory");
            SG_WAIT(flg[2] < (unsigned)g || flg[3] < (unsigned)g || flg[4] < (unsigned)g || flg[5] < (unsigned)g);
            GSEQ_ISSUE(g + SG_NG - 1);
        }
        asm volatile("s_waitcnt vmcnt(0)" ::: "memory");
#undef GSEQ_ISSUE
    } else if (wid >= 6 && pm != 4) {
        const int sidx = wid - 6;
        if (side_n > 0) {
            conv_rows(p, l, side_idx * 2 + sidx, side_n * 2);
            convert_experts(p, l, (float*)(lds_ + SG_SCR + sidx * 8448), side_idx * 2 + sidx, side_n * 2, (gridDim.x == 256) ? ((l == DEPTH - 1) ? CV_B : CV_B + CV_F) : 0, CV_ALL);
        }
    } else {
        const int vt = wid & 1, kh = wid >> 1;
        bf16_t* ointer = (bf16_t*)(ws + (pm ? WS_HID : WS_OINTER)) + (size_t)(pm ? 0 : dir) * NTOK * 512 + h * 128 + (vq * 2 + vt) * 16 + fr;
        f32x4 acc[4];
#pragma unroll
        for (int j = 0; j < 4; ++j) acc[j] = (f32x4){0.f, 0.f, 0.f, 0.f};
        union { u32x4 u; bf16x8 h; } sb[2];
        sb[0].u = (u32x4){0u, 0u, 0u, 0u}; sb[1].u = (u32x4){0u, 0u, 0u, 0u};
        f32x4 oprev = (f32x4){0.f, 0.f, 0.f, 0.f}; int chprev = 0;
        LAS unsigned char* obuf = lds + SG_OBUF + vt * 1024 + lane * 16;
#pragma unroll 1
        for (int g = 0; g < 72; ++g) {
            if (pm == 4) SG_WAIT(flg[10] < (unsigned)(g + 1) || flg[11] < (unsigned)(g + 1) || flg[12] < (unsigned)(g + 1) || flg[13] < (unsigned)(g + 1));
            else SG_WAIT(flg[0] < (unsigned)(g + 1) || flg[1] < (unsigned)(g + 1));
#pragma unroll
            for (int s2 = 0; s2 < 2; ++s2) {
                const int c = 2 * g + s2;
                const LAS unsigned char* st = lds + (unsigned)(g % SG_NG) * SG_GRP + s2 * SG_STEP;
                const int chunk = gla_chunk_of_step(c, b, dir);
                bf16x8 qa[2]; f32x4 dv[4];
                union { u32x2 u; s16x4 h; } ka[4], vb;
#pragma unroll
                for (int j = 0; j < 2; ++j) qa[j] = *(const LAS bf16x8*)(st + (2 * kh + j) * 1024 + lane * 16);
                vb.u = *(const LAS u32x2*)(st + REC_BYTES + vt * 512 + lane * 8);
#pragma unroll
                for (int j = 0; j < 4; ++j) { ka[j].u = *(const LAS u32x2*)(st + 4096 + (4 * kh + j) * 512 + lane * 8); dv[j] = *(const LAS f32x4*)(st + 8192 + ((4 * kh + j) * 16 + 4 * fq) * 4); }
                f32x4 o0 = (f32x4){0.f, 0.f, 0.f, 0.f}, o1 = (f32x4){0.f, 0.f, 0.f, 0.f};
                o0 = __builtin_amdgcn_mfma_f32_16x16x32_bf16(qa[0], sb[0].h, o0, 0, 0, 0); o1 = __builtin_amdgcn_mfma_f32_16x16x32_bf16(qa[1], sb[1].h, o1, 0, 0, 0);
                if (pm != 3) {
#pragma unroll
                for (int j = 0; j < 4; ++j) {
                    acc[j] = acc[j] * dv[j];
                    acc[j] = __builtin_amdgcn_mfma_f32_16x16x16bf16_1k(ka[j].h, vb.h, acc[j], 0, 0, 0);
                } } else { asm volatile("" :: "v"(ka[0].u), "v"(ka[1].u), "v"(ka[2].u), "v"(ka[3].u), "v"(dv[0]), "v"(dv[1]), "v"(dv[2]), "v"(dv[3]), "v"(vb.u)); }
                const f32x4 o = o0 + o1;
                if (pm == 2) { if (kh == 0) { bf16_t* op = ointer + (size_t)(chunk * 16 + 4 * fq) * 512; op[0] = (bf16_t)f2bf(o[0]); op[512] = (bf16_t)f2bf(o[1]); op[1024] = (bf16_t)f2bf(o[2]); op[1536] = (bf16_t)f2bf(o[3]); } }
                else if (kh == 1) {
                    if (c >= SG_NS) SG_WAIT(flg[8 + vt] < (unsigned)(c - SG_NS + 1));
                    *(LAS f32x4*)(obuf + (c % SG_NS) * 2048) = o;
                    asm volatile("s_waitcnt lgkmcnt(0)" ::: "memory");
                    if (lane == 0) flg[6 + vt] = (unsigned)(c + 1);
                } else {
                    if (c > 0) {
                        SG_WAIT(flg[6 + vt] < (unsigned)c);
                        const f32x4 po = *(const LAS f32x4*)(obuf + ((c - 1) % SG_NS) * 2048);
                        const f32x4 os = oprev + po;
                        bf16_t* op = ointer + (size_t)(chprev * 16 + 4 * fq) * 512;
                        { const unsigned w01 = cvtpk(os[0], os[1]), w23 = cvtpk(os[2], os[3]); op[0] = (bf16_t)(w01 & 0xffffu); op[512] = (bf16_t)(w01 >> 16); op[1024] = (bf16_t)(w23 & 0xffffu); op[1536] = (bf16_t)(w23 >> 16); }
                        asm volatile("s_waitcnt lgkmcnt(0)" ::: "memory");
                        if (lane == 0) flg[8 + vt] = (unsigned)c;
                    }
                    oprev = o; chprev = chunk;
                }
                sb[0].u = (u32x4){cvtpk(acc[0][0], acc[0][1]), cvtpk(acc[0][2], acc[0][3]), cvtpk(acc[1][0], acc[1][1]), cvtpk(acc[1][2], acc[1][3])};
                sb[1].u = (u32x4){cvtpk(acc[2][0], acc[2][1]), cvtpk(acc[2][2], acc[2][3]), cvtpk(acc[3][0], acc[3][1]), cvtpk(acc[3][2], acc[3][3])};
            }
            asm volatile("s_waitcnt lgkmcnt(0)" ::: "memory");
            if (lane == 0) flg[2 + wid] = (unsigned)(g + 1);
        }
        if (kh == 0 && pm != 2) {
            SG_WAIT(flg[6 + vt] < 144u);
            const f32x4 po = *(const LAS f32x4*)(obuf + (143 % SG_NS) * 2048);
            const f32x4 os = oprev + po;
            bf16_t* op = ointer + (size_t)(chprev * 16 + 4 * fq) * 512;
            { const unsigned w01 = cvtpk(os[0], os[1]), w23 = cvtpk(os[2], os[3]); op[0] = (bf16_t)(w01 & 0xffffu); op[512] = (bf16_t)(w01 >> 16); op[1024] = (bf16_t)(w23 & 0xffffu); op[1536] = (bf16_t)(w23 >> 16); }
        }
    }
    asm volatile("s_waitcnt vmcnt(0) lgkmcnt(0)" ::: "memory");
    __syncthreads();
}
__device__ __forceinline__ void phase_gla_seq2(const Params& p, int l, unsigned char* lds) {
    const int G = (int)gridDim.x;
    for (int rep = 0; rep < ((DUPK == 50 || (DUPK >= 52 && DUPK <= 56)) ? 2 : 1); ++rep) {
        int first = (DUPK >= 52 && DUPK <= 56 && rep == 1) ? 0 : 1;
        const int pm = (rep == 1 && DUPK >= 53 && DUPK <= 56) ? DUPK - 52 : 0;
        for (int u = obid(); u < 256; u += G) {
            const int x = u & 7, jj = u >> 3, vq = jj & 3, chain = x + 8 * (jj >> 2);
            gla_scan_unit(p, l, lds, chain, vq, obid(), first ? G : 0, pm);
            first = 0;
        }
    }
}

__device__ __forceinline__ void phase_gla_post(const Params& p, int l) {
    const int lane = otid() & 63, wid = otid() >> 6;
    const bf16_t* pb = (const bf16_t*)(ows(p) + WS_P); bf16_t* yb = (bf16_t*)(ows(p) + WS_Y);
    const bf16_t* oi = (const bf16_t*)(ows(p) + WS_OINTRA); const bf16_t* oe = (const bf16_t*)(ows(p) + WS_OINTER);
    const float* hnw = oin(p, 11) + (size_t)l * 128;
    const int nrows = (l == DEPTH - 1) ? NLAT : NTOK;
    const int c0 = lane * 8;
    for (int r = obid() * 8 + wid; r < nrows; r += gridDim.x * 8) {
        float o[8], t1[8], t2[8]; float ss = 0.f;
        unpack8(*(const u32x4*)(oi + (size_t)r * 512 + c0), o); unpack8(*(const u32x4*)(oe + (size_t)r * 512 + c0), t1); unpack8(*(const u32x4*)(oe + ((size_t)NTOK + r) * 512 + c0), t2);
#pragma unroll
        for (int j = 0; j < 8; ++j) { o[j] += t1[j] + t2[j]; ss += o[j] * o[j]; }
        ss += __shfl_xor(ss, 1); ss += __shfl_xor(ss, 2); ss += __shfl_xor(ss, 4); ss += __shfl_xor(ss, 8);
        const float rstd = rsqrtf(ss * (1.0f / 128.0f) + EPS);
        float g[8]; unpack8(*(const u32x4*)(pb + (size_t)r * PW + OFF_G + c0), g);
        float y[8];
#pragma unroll
        for (int j = 0; j < 8; ++j) y[j] = o[j] * rstd * hnw[(c0 + j) & 127] * siluf(g[j]);
        u32x4 w; w.x = pk2(y[0], y[1]); w.y = pk2(y[2], y[3]); w.z = pk2(y[4], y[5]); w.w = pk2(y[6], y[7]);
        *(u32x4*)(yb + (size_t)r * 1024 + 512 + c0) = w;
    }
}

__device__ __forceinline__ void phase_gemm2(const Params& p, int l, unsigned char* lds) {
    const bf16_t* yb = (const bf16_t*)(ows(p) + WS_Y); const bf16_t* wt = (const bf16_t*)(ows(p) + WS_WOUT) + (size_t)l * 1024 * 1024;
    float* xws = (float*)(ows(p) + WS_X); const float* modv = (const float*)(ows(p) + WS_MOD);
    const int MT = ((l == DEPTH - 1) ? NLAT : NTOK) / 128; constexpr int NT = 8;
    for (int u = obid(); u < MT * NT; u += gridDim.x) {
        const int mt = u / NT, nt = u % NT;
        ARowPlain ar{yb + (size_t)mt * 128 * 1024, 1024};
        EpiRes ep{xws + (size_t)mt * 128 * 1024 + nt * 128, modv + (size_t)l * 9 * 6144 + 2 * 1024 + nt * 128, mt * 128};
        gemm128(lds, ar, wt + (size_t)nt * 128 * 1024, 1024, ep);
    }
}

__device__ __forceinline__ void phase_router(const Params& p, int l) {
    const int lane = otid() & 63, wid = otid() >> 6;
    const float* xws = (const float*)(ows(p) + WS_X); bf16_t* hb = (bf16_t*)(ows(p) + WS_H);
    const float* modv = (const float*)(ows(p) + WS_MOD); const float* nw = oin(p, 4) + (size_t)(l * 2 + 1) * 1024;
    const float* wrg = oin(p, 13) + (size_t)l * 1024 * 4; const float* wre = oin(p, 15) + (size_t)l * 1024 * 32;
    const float* brg = oin(p, 14) + l * 4; const float* bre = oin(p, 16) + l * 32;
    unsigned* cnt = (unsigned*)(ows(p) + WS_CTL) + CW_CNT + 64 * l;
    int* ltok = (int*)(ows(p) + WS_LTOK); float* lgate = (float*)(ows(p) + WS_LGATE);
    const int nrows = (l == DEPTH - 1) ? NLAT : NTOK;
    for (int r = obid() * 8 + wid; r < nrows; r += gridDim.x * 8) {
        const int mr = mod_row(r);
        float ss = 0.f;
#pragma unroll
        for (int j = 0; j < 4; ++j) { const f32x4 xv4 = *(const f32x4*)(xws + (size_t)r * 1024 + 4 * lane + 256 * j); ss += (xv4[0] * xv4[0] + xv4[1] * xv4[1]) + (xv4[2] * xv4[2] + xv4[3] * xv4[3]); }
        const float rstd = rsqrtf(wave_sum(ss) * (1.0f / 1024.0f) + EPS);
        const float* msh = modv + ((size_t)l * 9 + mr) * 6144 + 3 * 1024; const float* msc = msh + 1024;
        float lg[36];
#pragma unroll
        for (int i = 0; i < 36; ++i) lg[i] = 0.f;
#pragma unroll 1
        for (int j = 0; j < 4; ++j) {
            const int c = 4 * lane + 256 * j;
            const f32x4 xv4 = *(const f32x4*)(xws + (size_t)r * 1024 + c);
            const f32x4 w = *(const f32x4*)(nw + c), sh = *(const f32x4*)(msh + c), sc = *(const f32x4*)(msc + c);
            const f32x4 h = (xv4 * rstd * w) * (1.0f + sc) + sh;
            u32x2 o; o.x = pk2(h[0], h[1]); o.y = pk2(h[2], h[3]);
            *(u32x2*)(hb + (size_t)r * 1024 + c) = o;
#pragma unroll
            for (int e = 0; e < 4; ++e) {
                const float xv = h[e];
                const f32x4 wg = *(const f32x4*)(wrg + (size_t)(c + e) * 4);
                lg[0] += xv * wg[0]; lg[1] += xv * wg[1]; lg[2] += xv * wg[2]; lg[3] += xv * wg[3];
#pragma unroll
                for (int q = 0; q < 8; ++q) {
                    const f32x4 we = *(const f32x4*)(wre + (size_t)(c + e) * 32 + q * 4);
                    lg[4 + q * 4 + 0] += xv * we[0]; lg[4 + q * 4 + 1] += xv * we[1]; lg[4 + q * 4 + 2] += xv * we[2]; lg[4 + q * 4 + 3] += xv * we[3];
                }
            }
        }
#pragma unroll
        for (int i = 0; i < 36; ++i) lg[i] = wave_sum(lg[i]);
        float gl[4];
#pragma unroll
        for (int i = 0; i < 4; ++i) gl[i] = lg[i] + brg[i];
        int gsel = 0; float gmax = gl[0];
#pragma unroll
        for (int i = 1; i < 4; ++i) if (gl[i] > gmax) { gmax = gl[i]; gsel = i; }
        float gs = 0.f;
#pragma unroll
        for (int i = 0; i < 4; ++i) gs += __expf(gl[i] - gmax);
        const float pg = 1.0f / gs;
        float el[8];
#pragma unroll
        for (int j = 0; j < 8; ++j) {
            float t = lg[4 + j] + bre[j];
#pragma unroll
            for (int g = 1; g < 4; ++g) t = (gsel == g) ? (lg[4 + g * 8 + j] + bre[g * 8 + j]) : t;
            el[j] = t;
        }
        int i1 = 0; float v1 = el[0];
#pragma unroll
        for (int j = 1; j < 8; ++j) if (el[j] > v1) { v1 = el[j]; i1 = j; }
        int i2 = -1; float v2 = -3.0e38f;
#pragma unroll
        for (int j = 0; j < 8; ++j) if (j != i1 && el[j] > v2) { v2 = el[j]; i2 = j; }
        const float e2 = __expf(v2 - v1);
        const float g0 = pg / (1.0f + e2), g1 = pg * e2 / (1.0f + e2);
        if (lane == 0) {
            const int ea = gsel * 8 + i1, eb = gsel * 8 + i2;
            const unsigned pa = atomicAdd(cnt + ea, 1u); ltok[(size_t)ea * NTOK + pa] = r * 2 + 0; lgate[(size_t)ea * NTOK + pa] = g0;
            const unsigned pb2 = atomicAdd(cnt + eb, 1u); ltok[(size_t)eb * NTOK + pb2] = r * 2 + 1; lgate[(size_t)eb * NTOK + pb2] = g1;
        }
    }
}


__device__ __forceinline__ void phase_router2(const Params& p, int l, unsigned char* lds, bool commit) {
    const int tid = otid(), lane = tid & 63, wid = __builtin_amdgcn_readfirstlane(tid >> 6), fr = lane & 15, fq = lane >> 4;
    unsigned char* ws = ows(p);
    const float* xws = (const float*)(ws + WS_X); float* xw = (float*)(ws + WS_X); const bf16_t* dlt = (const bf16_t*)(ws + WS_DELTA); bf16_t* hb = (bf16_t*)(ws + WS_H);
    const float* modv = (const float*)(ws + WS_MOD); const float* nw = oin(p, 4) + (size_t)(l * 2 + 1) * 1024;
    const float* brg = oin(p, 14) + l * 4; const float* bre = oin(p, 16) + l * 32;
    unsigned* gcnt = (unsigned*)(ws + WS_CTL) + CW_CNT + 64 * 32 * l;
    int* ltok = (int*)(ws + WS_LTOK); float* lgate = (float*)(ws + WS_LGATE);
    constexpr int WPITCH = 2064, WBYTES = 48 * WPITCH;
    unsigned char* wl = lds;
    float* tile = (float*)(lds + WBYTES + wid * 3328);
    int* s_cnt = (int*)(lds + WBYTES + 8 * 3328); int* s_base = s_cnt + 32;
    int* s_e = s_base + 32; int* s_rank = s_e + 256; int* s_tok = s_rank + 256; float* s_gate = (float*)(s_tok + 256);
    __syncthreads();
    {
        const bf16_t* wrh = (const bf16_t*)(ws + WS_WRH) + (size_t)l * 48 * 1024;
        for (int i = tid; i < 48 * 128; i += 512) { const int r = i >> 7, c = i & 127; *(u32x4*)(wl + r * WPITCH + c * 16) = *(const u32x4*)(wrh + (size_t)r * 1024 + c * 8); }
    }
    const int NG = ((l == DEPTH - 1) ? NLAT : NTOK) / 16;
    const int NWV = (int)gridDim.x * 8;
    for (int it = 0; it * NWV < NG; ++it) {
        const int g = it * NWV + wid * (int)gridDim.x + obid();
        __syncthreads();
        if (tid < 32) s_cnt[tid] = 0;
        if (tid < 256) s_e[tid] = -1;
        __syncthreads();
        if (g < NG) {
            const int R0 = g * 16, mr = mod_row(R0);
            float my_rstd = 0.f;
#pragma unroll
            for (int rb = 0; rb < 4; ++rb) {
                f32x4 xv[4][4]; u32x2 dl[4][4];
#pragma unroll
                for (int rr = 0; rr < 4; ++rr)
#pragma unroll
                    for (int j = 0; j < 4; ++j) { xv[rr][j] = *(const f32x4*)(xws + (size_t)(R0 + rb * 4 + rr) * 1024 + 4 * lane + 256 * j); dl[rr][j] = *(const u32x2*)(dlt + (size_t)(R0 + rb * 4 + rr) * 1024 + 4 * lane + 256 * j); }
#pragma unroll
                for (int rr = 0; rr < 4; ++rr) {
                    if (commit) {
#pragma unroll
                        for (int j = 0; j < 4; ++j) { xv[rr][j] += (f32x4){bflo(dl[rr][j].x), bfhi(dl[rr][j].x), bflo(dl[rr][j].y), bfhi(dl[rr][j].y)}; *(f32x4*)(xw + (size_t)(R0 + rb * 4 + rr) * 1024 + 4 * lane + 256 * j) = xv[rr][j]; }
                    }
                    float ss = 0.f;
#pragma unroll
                    for (int j = 0; j < 4; ++j) ss += (xv[rr][j][0] * xv[rr][j][0] + xv[rr][j][1] * xv[rr][j][1]) + (xv[rr][j][2] * xv[rr][j][2] + xv[rr][j][3] * xv[rr][j][3]);
                    const float rs = rsqrtf(wave_sum(ss) * (1.0f / 1024.0f) + EPS);
                    my_rstd = (rb * 4 + rr == fr) ? rs : my_rstd;
                }
            }
            asm volatile("s_waitcnt vmcnt(0)" ::: "memory");
            const float* msh = modv + ((size_t)l * 9 + mr) * 6144 + 3 * 1024 + 8 * fq; const float* msc = msh + 1024; const float* nwp = nw + 8 * fq;
            const float* xrow = xws + (size_t)(R0 + fr) * 1024 + 8 * fq; bf16_t* hrow = hb + (size_t)(R0 + fr) * 1024 + 8 * fq; unsigned char* h8row = ws + WS_H8 + (size_t)(R0 + fr) * 1024 + 8 * fq;
            f32x4 acc[3];
#pragma unroll
            for (int nt = 0; nt < 3; ++nt) acc[nt] = (f32x4){0.f, 0.f, 0.f, 0.f};
#pragma unroll 1
            for (int kq = 0; kq < 4; ++kq) {
                f32x4 xa[8][2];
#pragma unroll
                for (int u = 0; u < 8; ++u) { xa[u][0] = *(const f32x4*)(xrow + 256 * kq + 32 * u); xa[u][1] = *(const f32x4*)(xrow + 256 * kq + 32 * u + 4); }
#pragma unroll
                for (int u = 0; u < 8; ++u) {
                    const int k = 256 * kq + 32 * u;
                    float hv[8];
#pragma unroll
                    for (int q = 0; q < 2; ++q) {
                        const f32x4 w = *(const f32x4*)(nwp + k + 4 * q), sh = *(const f32x4*)(msh + k + 4 * q), sc = *(const f32x4*)(msc + k + 4 * q);
                        const f32x4 h = (xa[u][q] * my_rstd * w) * (1.0f + sc) + sh;
                        hv[4 * q + 0] = h[0]; hv[4 * q + 1] = h[1]; hv[4 * q + 2] = h[2]; hv[4 * q + 3] = h[3];
                    }
                    union { u32x4 u; bf16x8 h; } ah, al;
                    ah.u = (u32x4){cvtpk(hv[0], hv[1]), cvtpk(hv[2], hv[3]), cvtpk(hv[4], hv[5]), cvtpk(hv[6], hv[7])};
                    float lv[8];
#pragma unroll
                    for (int q = 0; q < 4; ++q) { const unsigned w2 = q == 0 ? ah.u.x : q == 1 ? ah.u.y : q == 2 ? ah.u.z : ah.u.w; lv[2 * q] = hv[2 * q] - __uint_as_float(w2 << 16); lv[2 * q + 1] = hv[2 * q + 1] - __uint_as_float(w2 & 0xffff0000u); }
                    al.u = (u32x4){cvtpk(lv[0], lv[1]), cvtpk(lv[2], lv[3]), cvtpk(lv[4], lv[5]), cvtpk(lv[6], lv[7])};
                    if (MOE_FP8) { u32x2 h8; h8.x = pk4_fp8(hv[0], hv[1], hv[2], hv[3]); h8.y = pk4_fp8(hv[4], hv[5], hv[6], hv[7]); *(u32x2*)(h8row + k) = h8; }
                    else *(u32x4*)(hrow + k) = ah.u;
#pragma unroll
                    for (int nt = 0; nt < 3; ++nt) {
                        const bf16x8 bh = *(const bf16x8*)(wl + (nt * 16 + fr) * WPITCH + (k + 8 * fq) * 2);
                        acc[nt] = __builtin_amdgcn_mfma_f32_16x16x32_bf16(ah.h, bh, acc[nt], 0, 0, 0);
                        acc[nt] = __builtin_amdgcn_mfma_f32_16x16x32_bf16(al.h, bh, acc[nt], 0, 0, 0);
                    }
                }
            }
#pragma unroll
            for (int nt = 0; nt < 3; ++nt)
#pragma unroll
                for (int r = 0; r < 4; ++r) tile[(4 * fq + r) * 52 + nt * 16 + fr] = acc[nt][r];
            LDS_WAIT();
            if (lane < 16) {
                const float* lg = tile + lane * 52;
                float gl[4];
#pragma unroll
                for (int i = 0; i < 4; ++i) gl[i] = lg[i] + brg[i];
                int gsel = 0; float gmax = gl[0];
#pragma unroll
                for (int i = 1; i < 4; ++i) if (gl[i] > gmax) { gmax = gl[i]; gsel = i; }
                float gs = 0.f;
#pragma unroll
                for (int i = 0; i < 4; ++i) gs += __expf(gl[i] - gmax);
                const float pg = 1.0f / gs;
                float el[8];
#pragma unroll
                for (int j = 0; j < 8; ++j) el[j] = lg[4 + gsel * 8 + j] + bre[gsel * 8 + j];
                int i1 = 0; float v1 = el[0];
#pragma unroll
                for (int j = 1; j < 8; ++j) if (el[j] > v1) { v1 = el[j]; i1 = j; }
                int i2 = -1; float v2 = -3.0e38f;
#pragma unroll
                for (int j = 0; j < 8; ++j) if (j != i1 && el[j] > v2) { v2 = el[j]; i2 = j; }
                const float e2 = __expf(v2 - v1);
                const float g0 = pg / (1.0f + e2), g1 = pg * e2 / (1.0f + e2);
                const int ea = gsel * 8 + i1, eb = gsel * 8 + i2, slot = (wid * 16 + lane) * 2, r = R0 + lane;
                s_e[slot] = ea; s_rank[slot] = atomicAdd(&s_cnt[ea], 1); s_tok[slot] = r * 2; s_gate[slot] = g0;
                s_e[slot + 1] = eb; s_rank[slot + 1] = atomicAdd(&s_cnt[eb], 1); s_tok[slot + 1] = r * 2 + 1; s_gate[slot + 1] = g1;
            }
        }
        __syncthreads();
        if (tid < 32) { const int c = s_cnt[tid]; s_base[tid] = (c > 0 && commit) ? (int)atomicAdd(gcnt + 64 * tid, (unsigned)c) : 0; }
        __syncthreads();
        if (tid < 256) { const int e = s_e[tid]; if (e >= 0 && commit) { const size_t pos = (size_t)e * NTOK + s_base[e] + s_rank[tid]; ltok[pos] = s_tok[tid]; lgate[pos] = s_gate[tid]; } }
    }
}

__device__ __forceinline__ int moe_tables(const Params& p, int l, unsigned char* lds) {
    int* s_pref = (int*)(lds + LDS_MISC); int* s_cnt = s_pref + 40;
    unsigned* cnt = (unsigned*)(ows(p) + WS_CTL) + CW_CNT + 64 * l;
    __syncthreads();
    if (otid() == 0) {
        int acc = 0;
        for (int e = 0; e < NEXP; ++e) { const int c = (int)__hip_atomic_load(cnt + e, __ATOMIC_RELAXED, __HIP_MEMORY_SCOPE_AGENT); s_cnt[e] = c; s_pref[e] = acc; acc += (c + 127) >> 7; }
        s_pref[NEXP] = acc;
    }
    __syncthreads();
    return s_pref[NEXP];
}
__device__ __forceinline__ void phase_moe_gu(const Params& p, int l, unsigned char* lds) {
    const int T = moe_tables(p, l, lds);
    const int* s_pref = (const int*)(lds + LDS_MISC); const int* s_cnt = s_pref + 40;
    const bf16_t* hb = (const bf16_t*)(ows(p) + WS_H); bf16_t* hid = (bf16_t*)(ows(p) + WS_HID);
    const int* ltok = (const int*)(ows(p) + WS_LTOK);
    for (int u = obid(); u < T * 8; u += gridDim.x) {
        const int mtg = u >> 3, nt = u & 7;
        int e = 0;
        for (int q = 1; q < NEXP; ++q) if (s_pref[q] <= mtg) e = q;
        const int mt = mtg - s_pref[e]; const int nvalid = min(128, s_cnt[e] - mt * 128);
        ARowGather ar{hb, ltok + (size_t)e * NTOK + mt * 128, nvalid};
        EpiGU ep{hid + (size_t)mtg * 128 * 512 + nt * 64};
        gemm128(lds, ar, (const bf16_t*)(ows(p) + WS_WGU) + ((size_t)(l * 32 + e) * 1024 + nt * 128) * 1024, 1024, ep);
    }
}
__device__ __forceinline__ void phase_moe_down(const Params& p, int l, unsigned char* lds) {
    const int T = moe_tables(p, l, lds);
    const int* s_pref = (const int*)(lds + LDS_MISC); const int* s_cnt = s_pref + 40;
    const bf16_t* hid = (const bf16_t*)(ows(p) + WS_HID); bf16_t* yb = (bf16_t*)(ows(p) + WS_YB);
    const int* ltok = (const int*)(ows(p) + WS_LTOK); const float* lgate = (const float*)(ows(p) + WS_LGATE);
    for (int u = obid(); u < T * 8; u += gridDim.x) {
        const int mtg = u >> 3, nt = u & 7;
        int e = 0;
        for (int q = 1; q < NEXP; ++q) if (s_pref[q] <= mtg) e = q;
        const int mt = mtg - s_pref[e]; const int nvalid = min(128, s_cnt[e] - mt * 128);
        ARowPlain ar{hid + (size_t)mtg * 128 * 512, 512};
        EpiDown ep{yb + nt * 128, ltok + (size_t)e * NTOK + mt * 128, lgate + (size_t)e * NTOK + mt * 128, nvalid};
        gemm128(lds, ar, (const bf16_t*)(ows(p) + WS_WDN) + ((size_t)(l * 32 + e) * 1024 + nt * 128) * 512, 512, ep);
    }
}


#ifndef FAST_G1
#define FAST_G1 1
#endif
#ifndef FAST_G2
#define FAST_G2 1
#endif
#ifndef FAST_MOE
#define FAST_MOE 1
#endif
#ifndef FAST_GLA
#define FAST_GLA 1
#endif
#ifndef FAST_RT
#define FAST_RT 1
#endif
__device__ __forceinline__ void phase_gemm1_fast(const Params& p, int l, unsigned char* lds) {
    g8::DenseOrder S; S.init(NTOK / 256, PW / 256, (int)gridDim.x, obid(), (const bf16_t*)(ows(p) + WS_WIN) + (size_t)l * 4096 * 1024, 1024);
    g8::EpiP2 E{(bf16_t*)(ows(p) + WS_P)};
    g8::gemm_phase((LAS unsigned char*)lds, (const char*)(ows(p) + WS_H), 1024, S, E);
    if (gridDim.x == 256 && obid() >= 128) { __syncthreads(); convert_experts(p, l, (float*)(lds + (otid() >> 6) * 16384), (obid() - 128) * 8 + (otid() >> 6), 128 * 8, 0, CV_B); }
}
__device__ __forceinline__ void phase_gemm2_fast(const Params& p, int l, unsigned char* lds, float scl) {
    g8::DenseOrder S; S.init(((l == DEPTH - 1) ? NLAT : NTOK) / 256, 4, (int)gridDim.x, obid(), (const bf16_t*)(ows(p) + WS_WOUT) + (size_t)l * 1024 * 1024, 1024);
    g8::EpiDelta E{(bf16_t*)(ows(p) + WS_DELTA), (const float*)(ows(p) + WS_MOD) + (size_t)l * 9 * 6144 + 2 * 1024, scl};
    g8::gemm_phase((LAS unsigned char*)lds, (const char*)(ows(p) + WS_Y), 1024, S, E);
    if (gridDim.x == 256 && l < DEPTH - 1 && obid() >= 32 && scl != 0.0f) { __syncthreads(); convert_experts(p, l, (float*)(lds + (otid() >> 6) * 16384), (obid() - 32) * 8 + (otid() >> 6), 224 * 8, CV_B, CV_B + CV_F); }
}
__device__ __forceinline__ int moe_tables256(const Params& p, int l, unsigned char* lds) {
    int* s_pref = (int*)(lds + LDS_MISC); int* s_cnt = s_pref + 40;
    unsigned* cnt = (unsigned*)(ows(p) + WS_CTL) + CW_CNT + 64 * 32 * l;
    __syncthreads();
    if (otid() == 0) {
        int acc = 0;
        for (int e = 0; e < NEXP; ++e) { const int c = (int)__hip_atomic_load(cnt + 64 * e, __ATOMIC_RELAXED, __HIP_MEMORY_SCOPE_AGENT); s_cnt[e] = c; s_pref[e] = acc; acc += (c + 255) >> 8; }
        s_pref[NEXP] = acc;
    }
    __syncthreads();
    return s_pref[NEXP];
}
__device__ __forceinline__ void moe_setup(const Params& p, int l, unsigned char* lds, int deal_shift) {
    const int T = moe_tables256(p, l, lds);
    const int* s_pref = (const int*)(lds + LDS_MISC); const int* s_cnt = s_pref + 40;
    int* utab = (int*)(lds + g8::MOE_UTAB); int* rtok = (int*)(lds + g8::MOE_RTOK); float* rgate = (float*)(lds + g8::MOE_RGATE);
    const int tid = otid(), G = (int)gridDim.x, c = (obid() + deal_shift) % G;
    if (tid < 4) {
        const int L = tid * G + c; int* t = utab + tid * 8;
        if (L < T * 4) {
            const int mtg = L >> 2; int e = 0;
            for (int q = 1; q < NEXP; ++q) if (s_pref[q] <= mtg) e = q;
            const int mt = mtg - s_pref[e];
            t[0] = mtg; t[1] = L & 3; t[2] = e; t[3] = min(256, s_cnt[e] - mt * 256); t[4] = e * NTOK + mt * 256; t[5] = 1;
        } else { t[0] = 0; t[1] = 0; t[2] = 0; t[3] = 0; t[4] = 0; t[5] = 0; }
    }
    __syncthreads();
    const int* ltok = (const int*)(ows(p) + WS_LTOK); const float* lgate = (const float*)(ows(p) + WS_LGATE);
    for (int idx = tid; idx < 1024; idx += 512) {
        const int i = idx >> 8, r = idx & 255; const int* t = utab + i * 8;
        const bool ok = t[5] != 0 && r < t[3];
        rtok[idx] = ok ? ltok[t[4] + r] : 0; rgate[idx] = ok ? lgate[t[4] + r] : 0.f;
    }
    __syncthreads();
}
__device__ __forceinline__ void phase_moe_gu_fast(const Params& p, int l, unsigned char* lds) {
    moe_setup(p, l, lds, 0);
    g8::MoeOrder<true> S; S.ready = (unsigned*)(ows(p) + WS_CTL) + CW_HID + 64 * 176 * l; S.tmo = (unsigned*)(ows(p) + WS_CTL) + CW_TMO; S.utab = (const int*)(lds + g8::MOE_UTAB); S.rtok = (const int*)(lds + g8::MOE_RTOK); S.K = 1024;
    if (MOE_FP8) {
        S.W = (const char*)(ows(p) + WS_WGU8) + (size_t)l * 32 * 1024 * 1024; S.bpe = 1;
        g8::EpiGU8 E{ows(p) + WS_HID8};
        g8::gemm_phase8<0x7A7A7A7A, 0x7F7F7F7F>((LAS unsigned char*)lds, (const char*)(ows(p) + WS_H8), 1024, S, E);
    } else {
        S.W = (const char*)(ows(p) + WS_WGU) + (size_t)l * 32 * 1024 * 1024 * 2; S.bpe = 2;
        g8::EpiGU2 E{(bf16_t*)(ows(p) + WS_HID)};
        g8::gemm_phase((LAS unsigned char*)lds, (const char*)(ows(p) + WS_H), 1024, S, E);
    }
}
__device__ __forceinline__ void phase_moe_down_fast(const Params& p, int l, unsigned char* lds) {
    moe_setup(p, l, lds, (int)gridDim.x / 2);
    g8::MoeOrder<false> S; S.ready = (unsigned*)(ows(p) + WS_CTL) + CW_HID + 64 * 176 * l; S.tmo = (unsigned*)(ows(p) + WS_CTL) + CW_TMO; S.utab = (const int*)(lds + g8::MOE_UTAB); S.rtok = (const int*)(lds + g8::MOE_RTOK); S.K = 512;
    g8::EpiDown2 E{(bf16_t*)(ows(p) + WS_YB), (const int*)(lds + g8::MOE_RTOK), (const float*)(lds + g8::MOE_RGATE)};
    if (MOE_FP8) {
        S.W = (const char*)(ows(p) + WS_WDN8) + (size_t)l * 32 * 1024 * 512; S.bpe = 1;
        g8::EpiDown8 E8{ows(p) + WS_YB8, (const int*)(lds + g8::MOE_RTOK), (const float*)(lds + g8::MOE_RGATE)};
        g8::gemm_phase8<0x7B7B7B7B, 0x7E7E7E7E>((LAS unsigned char*)lds, (const char*)(ows(p) + WS_HID8), 512, S, E8);
    } else {
        S.W = (const char*)(ows(p) + WS_WDN) + (size_t)l * 32 * 1024 * 512 * 2; S.bpe = 2;
        g8::gemm_phase((LAS unsigned char*)lds, (const char*)(ows(p) + WS_HID), 512, S, E);
    }
}

__device__ __forceinline__ void phase_c(const Params& p, int l, unsigned char* lds) {
    phase_gla_pre2(p, l, lds);
}

__global__ void __launch_bounds__(512, 2) mk(Params p) {
    extern __shared__ __attribute__((aligned(16))) unsigned char lds[];
    const int lo = p.ph_lo, hi = p.ph_hi;
    volatile LAS unsigned* misc = (volatile LAS unsigned*)(lds + LDS_MISC + 1024);
    if (threadIdx.x < 4) misc[threadIdx.x] = 0u;
    __syncthreads();
    XcdBarrier bar; bar.bar = (unsigned*)(p.ws + WS_CTL) + CW_BAR; bar.x = 0; bar.st = misc;
    if (hi - lo > 1) bar = xcd_barrier_post((unsigned*)(p.ws + WS_CTL) + CW_BAR, misc);
#define IN(k) (lo <= (k) && (k) < hi)
#define SEAM(k) do { if (IN((k) + 1)) { xcd_barrier(bar); if (DUPK == 20) xcd_barrier(bar); } } while (0)
#define REP(kind) for (int _rep = 0; _rep < ((DUPK == (kind)) ? 2 : 1); ++_rep)
    if (IN(0)) { REP(0) phase_prologue(p, lds); SEAM(0); }
    if (IN(1)) { REP(1) phase_modreduce(p); SEAM(1); }
    for (int l = 0; l < DEPTH; ++l) {
        const int pb = 2 + 9 * l;
        if (IN(pb + 0)) { if (DUPK == 2) phase_norm1(p, l, (float)(lo > 1000)); phase_norm1(p, l, 1.0f); SEAM(pb + 0); }
        if (IN(pb + 1)) { REP(3) { if (FAST_G1) phase_gemm1_fast(p, l, lds); else phase_gemm1(p, l, lds); } SEAM(pb + 1); }
        if (IN(pb + 2)) { REP(4) { phase_c(p, l, lds); } SEAM(pb + 2); }
        if (IN(pb + 3)) { REP(5) { phase_gla_seq2(p, l, lds); } SEAM(pb + 3); }
        if (IN(pb + 4)) { REP(6) phase_gla_post(p, l); SEAM(pb + 4); }
        if (IN(pb + 5)) { if (DUPK == 7) phase_gemm2_fast(p, l, lds, (float)(lo > 1000)); phase_gemm2_fast(p, l, lds, 1.0f); SEAM(pb + 5); }
        if (IN(pb + 6)) { if (DUPK == 8) phase_router2(p, l, lds, lo > 1000); phase_router2(p, l, lds, true); SEAM(pb + 6); }
        if (IN(pb + 7)) { phase_moe_gu_fast(p, l, lds); if (!IN(pb + 8)) SEAM(pb + 7); }
        if (IN(pb + 8)) { phase_moe_down_fast(p, l, lds); SEAM(pb + 8); }
    }
    if (IN(NPH - 1)) { REP(11) phase_final(p); }
#undef IN
#undef SEAM
}

#ifndef MK_LAUNCHES
#define MK_LAUNCHES 1
#endif
extern "C" void kernel_launch(void* const* d_in, const int* in_sizes, int n_in, void* d_out, int out_size, void* d_ws, size_t ws_size, hipStream_t stream) {
    static int grid = 0;
    if (grid == 0) {
        int dev = 0, cus = 0;
        if (n_in != 20 || ws_size < WS_END) { fprintf(stderr, "kernel_launch: unexpected shapes (n_in %d, ws %zu < %zu)\n", n_in, ws_size, (size_t)WS_END); grid = -1; return; }
        if (hipGetDevice(&dev) != hipSuccess || hipDeviceGetAttribute(&cus, hipDeviceAttributeMultiprocessorCount, dev) != hipSuccess) { grid = -1; return; }
        if (hipFuncSetAttribute((const void*)mk, hipFuncAttributeMaxDynamicSharedMemorySize, LDS_BYTES) != hipSuccess) { fprintf(stderr, "kernel_launch: hipFuncSetAttribute failed\n"); grid = -1; return; }
        (void)hipGetLastError();
        grid = cus;
    }
    if (grid < 0) return;
    (void)hipMemsetAsync((char*)d_ws + WS_CTL, 0, CTL_BYTES, stream);
    Params p{};
    for (int i = 0; i < 20; ++i) p.in[i] = (const float*)d_in[i];
    p.out = (float*)d_out; p.ws = (unsigned char*)d_ws;
    if (MK_LAUNCHES == 1) { p.ph_lo = 0; p.ph_hi = NPH; hipLaunchKernelGGL(mk, dim3(grid), dim3(512), LDS_BYTES, stream, p); }
    else for (int ph = 0; ph < NPH; ++ph) { p.ph_lo = ph; p.ph_hi = ph + 1; hipLaunchKernelGGL(mk, dim3(grid), dim3(512), LDS_BYTES, stream, p); }
}
```

```cpp
#include <hip/hip_runtime.h>
#include <stdint.h>
#include <stdio.h>

typedef unsigned short bf16_t;
typedef short bf16x8 __attribute__((ext_vector_type(8)));
typedef float f32x4 __attribute__((ext_vector_type(4)));
typedef unsigned u32x4 __attribute__((ext_vector_type(4)));
typedef unsigned u32x2 __attribute__((ext_vector_type(2)));
typedef int i32x8 __attribute__((ext_vector_type(8)));
typedef int i32x4 __attribute__((ext_vector_type(4)));
typedef short s16x4 __attribute__((ext_vector_type(4)));
typedef float f32x2 __attribute__((ext_vector_type(2)));
#define LAS __attribute__((address_space(3)))
#define GAS __attribute__((address_space(1)))

#ifndef DUPK
#define DUPK -1
#endif
#ifndef MOE_FP8
#define MOE_FP8 1
#endif
constexpr int D = 1024, NB = 8, SEQ = 2048, DEPTH = 4, CTXL = 256;
constexpr int NLAT = NB * SEQ, NCTX = NB * CTXL, NTOK = NLAT + NCTX;
constexpr int PW = 4096;
constexpr int OFF_B = 0, OFF_C = 512, OFF_HV = 1024, OFF_Q = 1536, OFF_ZF = 2048, OFF_I = 3072, OFF_G = 3584;
constexpr int NEXP = 32;
constexpr int NCHUNK = NTOK / 16;
constexpr float EPS = 1e-6f;
constexpr int NMODP = 16;
constexpr int CV_ALL = 32 * (16 * 32 + 8 * 32), CV_B = 128 * 8 * 7, CV_F = 224 * 8 * 8;

constexpr size_t WS_CTL = 0, CTL_BYTES = 65536;
constexpr size_t WS_WIN = WS_CTL + CTL_BYTES;
constexpr size_t WS_WOUT = WS_WIN + (size_t)4 * 4096 * 1024 * 2;
constexpr size_t WS_WGU = WS_WOUT + (size_t)4 * 1024 * 1024 * 2;
constexpr size_t WS_WDN = WS_WGU + (size_t)4 * 32 * 1024 * 1024 * 2;
constexpr size_t WS_MODP = WS_WDN + (size_t)4 * 32 * 1024 * 512 * 2;
constexpr size_t WS_MOD = WS_MODP + (size_t)4 * NMODP * 9 * 6144 * 4;
constexpr size_t WS_X = WS_MOD + (size_t)4 * 9 * 6144 * 4;
constexpr size_t WS_H = WS_X + (size_t)NTOK * 1024 * 4;
constexpr size_t WS_P = WS_H + (size_t)NTOK * 1024 * 2;
constexpr size_t WS_Y = WS_P + (size_t)NTOK * 4096 * 2;
constexpr size_t WS_QIN = WS_Y + (size_t)NTOK * 1024 * 2;
constexpr size_t WS_KOUT = WS_QIN + (size_t)2 * NTOK * 512 * 2;
constexpr size_t WS_DCH = WS_KOUT + (size_t)2 * NTOK * 512 * 2;
constexpr size_t WS_OINTRA = WS_DCH + (size_t)2 * NCHUNK * 512 * 4;
constexpr size_t WS_OINTER = WS_OINTRA + (size_t)NTOK * 512 * 4;
constexpr size_t WS_LTOK = WS_OINTER + (size_t)2 * NTOK * 512 * 4;
constexpr size_t WS_LGATE = WS_LTOK + (size_t)32 * NTOK * 4;
constexpr int HID_ROWS = 2 * NTOK + 32 * 256;
constexpr size_t WS_HID = WS_LGATE + (size_t)32 * NTOK * 4;
constexpr size_t WS_YB = WS_HID + (size_t)HID_ROWS * 512 * 2;
constexpr int REC_BYTES = 9216, VREC_BYTES = 4096;
constexpr size_t WS_GREC = WS_YB + (size_t)2 * NTOK * 1024 * 2;
constexpr size_t WS_VREC = WS_GREC + (size_t)2 * NCHUNK * 4 * REC_BYTES;
constexpr size_t WS_WRH = WS_VREC + (size_t)NCHUNK * 4 * VREC_BYTES;
constexpr size_t WS_WRL = WS_WRH + (size_t)4 * 48 * 1024 * 2;
constexpr size_t WS_H8 = WS_WRL + (size_t)4 * 48 * 1024 * 2;
constexpr size_t WS_HID8 = WS_H8 + (size_t)NTOK * 1024;
constexpr size_t WS_WGU8 = WS_HID8 + (size_t)HID_ROWS * 512;
constexpr size_t WS_WDN8 = WS_WGU8 + (size_t)4 * 32 * 1024 * 1024;
constexpr size_t WS_YB8 = WS_WDN8 + (size_t)4 * 32 * 1024 * 512;
constexpr size_t WS_DELTA = WS_YB8 + (size_t)2 * NTOK * 1024;
constexpr size_t WS_END = WS_DELTA + (size_t)NTOK * 1024 * 2;
constexpr int CW_BAR = 0;
constexpr int CW_CNT = 8192;

constexpr int LDS_BYTES = 147456;
constexpr int LDS_MISC = 143360;
constexpr int NPH = 2 + 9 * DEPTH + 1;

__device__ __forceinline__ float bf2f(bf16_t b) { return __uint_as_float(((unsigned)b) << 16); }
__device__ __forceinline__ unsigned f2bf(float f) { unsigned u = __float_as_uint(f); return (u + 0x7fffu + ((u >> 16) & 1u)) >> 16; }
__device__ __forceinline__ unsigned pk2(float lo, float hi) { return f2bf(lo) | (f2bf(hi) << 16); }
__device__ __forceinline__ float wave_sum(float v) {
#pragma unroll
    for (int o = 1; o < 64; o <<= 1) v += __shfl_xor(v, o);
    return v;
}
__device__ __forceinline__ float frcp(float x) { return __builtin_amdgcn_rcpf(x); }
__device__ __forceinline__ float sigmoidf(float x) { return frcp(1.0f + __expf(-x)); }
__device__ __forceinline__ float siluf(float x) { return x * frcp(1.0f + __expf(-x)); }
__device__ __forceinline__ float clamp8(float v) { return __builtin_amdgcn_fmed3f(v, -416.0f, 416.0f); }
__device__ __forceinline__ unsigned pk4_fp8_raw(float a, float b, float c, float d) { int r = __builtin_amdgcn_cvt_pk_fp8_f32(a, b, 0, false); r = __builtin_amdgcn_cvt_pk_fp8_f32(c, d, r, true); return (unsigned)r; }
__device__ __forceinline__ unsigned pk4_fp8(float a, float b, float c, float d) { int r = __builtin_amdgcn_cvt_pk_fp8_f32(clamp8(a), clamp8(b), 0, false); r = __builtin_amdgcn_cvt_pk_fp8_f32(clamp8(c), clamp8(d), r, true); return (unsigned)r; }
__device__ __forceinline__ f32x4 unpk4_fp8(unsigned w) { const f32x2 lo = __builtin_amdgcn_cvt_pk_f32_fp8((int)w, false), hi = __builtin_amdgcn_cvt_pk_f32_fp8((int)w, true); return (f32x4){lo.x, lo.y, hi.x, hi.y}; }
typedef __bf16 bf16x2_t __attribute__((ext_vector_type(2)));
__device__ __forceinline__ unsigned cvtpk(float lo, float hi) { const f32x2 v = {lo, hi}; const bf16x2_t r = __builtin_convertvector(v, bf16x2_t); return __builtin_bit_cast(unsigned, r); }
__device__ __forceinline__ int mod_row(int r) { return r < NLAT ? (r >> 11) : 8; }
#define LDS_WAIT() asm volatile("s_waitcnt lgkmcnt(0)" ::: "memory")
__device__ __forceinline__ int otid() { int t = threadIdx.x; asm volatile("" : "+v"(t)); return t; }
__device__ __forceinline__ int obid() { int b = blockIdx.x; asm volatile("" : "+s"(b)); return b; }

#define XB_TMO      128
#define XB_XCNT(j)  (256  + 64 * (j))
#define XB_XSUB(j)  (1280 + 64 * (j))
#define XB_XGEN(j)  (2304 + 64 * (j))
#define XB_TOP      3328
#define XB_TOPGEN   3392
#define XCD_BAR_WORDS 3456
#define XB_SPIN_CAP (1u << 18)
__device__ __forceinline__ unsigned xb_ld(unsigned* p)              { return __hip_atomic_load(p, __ATOMIC_RELAXED, __HIP_MEMORY_SCOPE_AGENT); }
__device__ __forceinline__ unsigned xb_add(unsigned* p, unsigned v) { return __hip_atomic_fetch_add(p, v, __ATOMIC_RELAXED, __HIP_MEMORY_SCOPE_AGENT); }
__device__ __forceinline__ unsigned xb_xcc_id() { return (unsigned)__builtin_amdgcn_s_getreg((3 << 11) | 20) & 0xFu; }
#define XB_SPIN(cond, bar) do { unsigned _sp = 0; while (cond) { __builtin_amdgcn_s_sleep(1); \
    if ((++_sp & 255u) == 0u) { if (xb_ld(&(bar)[XB_TMO])) break; if (_sp > XB_SPIN_CAP) { atomicAdd(&(bar)[XB_TMO], 1u); break; } } } } while (0)
struct XcdBarrier { unsigned* bar; unsigned x; volatile LAS unsigned* st; };
__device__ __forceinline__ XcdBarrier xcd_barrier_post(unsigned* bar, volatile LAS unsigned* st) {
    XcdBarrier b; b.bar = bar; b.x = xb_xcc_id(); b.st = st;
    if (threadIdx.x == 0) (void)xb_add(&bar[XB_XCNT(b.x)], 1u);
    return b;
}
__device__ __forceinline__ void xcd_barrier_complete(unsigned* bar, unsigned x, unsigned& nloc, unsigned& nx) {
    const unsigned G = gridDim.x * gridDim.y * gridDim.z;
    unsigned sum, cnt, mine, sp = 0u;
    for (;;) {
        sum = 0u; cnt = 0u; mine = 0u;
#pragma unroll
        for (unsigned j = 0; j < 16; ++j) { const unsigned c = xb_ld(&bar[XB_XCNT(j)]); sum += c; cnt += (c > 0u) ? 1u : 0u; mine = (j == x) ? c : mine; }
        if (sum == G) break;
        __builtin_amdgcn_s_sleep(1);
        if ((++sp & 255u) == 0u) { if (xb_ld(&bar[XB_TMO])) break; if (sp > XB_SPIN_CAP) { atomicAdd(&bar[XB_TMO], 1u); break; } }
    }
    nloc = mine > 0u ? mine : 1u; nx = cnt > 0u ? cnt : 1u;
}
__device__ __forceinline__ void xcd_barrier(const XcdBarrier& b) {
    asm volatile("s_waitcnt vmcnt(0)" ::: "memory");
    __syncthreads();
    if (threadIdx.x == 0) {
        unsigned* bar = b.bar;
        __builtin_amdgcn_s_waitcnt(0);
        unsigned nloc = b.st[0], nx = b.st[1];
        if (nloc == 0u) { xcd_barrier_complete(bar, b.x, nloc, nx); b.st[0] = nloc; b.st[1] = nx; }
        const unsigned old = xb_add(&bar[XB_XSUB(b.x)], 1u);
        const unsigned gen = old / nloc;
        if (old + 1u == (gen + 1u) * nloc) {
            __builtin_amdgcn_fence(__ATOMIC_RELEASE, "agent");
            asm volatile("s_waitcnt vmcnt(0)" ::: "memory");
            const unsigned og = xb_add(&bar[XB_TOP], 1u);
            const unsigned tg = og / nx;
            if (og + 1u == (tg + 1u) * nx) xb_add(&bar[XB_TOPGEN], 1u);
            else XB_SPIN(xb_ld(&bar[XB_TOPGEN]) == tg, bar);
            __builtin_amdgcn_fence(__ATOMIC_ACQUIRE, "agent");
            xb_add(&bar[XB_XGEN(b.x)], 1u);
            asm volatile("s_waitcnt vmcnt(0)" ::: "memory");
        } else {
            XB_SPIN(xb_ld(&bar[XB_XGEN(b.x)]) == gen, bar);
            __builtin_amdgcn_fence(__ATOMIC_ACQUIRE, "agent");
            asm volatile("s_waitcnt vmcnt(0)" ::: "memory");
        }
    }
    __syncthreads();
}

struct Params {
    const float* in[20];
    float* out;
    unsigned char* ws;
    int ph_lo, ph_hi;
};

__device__ __forceinline__ unsigned char* ows(const Params& p) { GAS unsigned char* w = (GAS unsigned char*)p.ws; asm volatile("" : "+s"(w)); return (unsigned char*)w; }
__device__ __forceinline__ const float* oin(const Params& p, int k) { const GAS float* q = (const GAS float*)p.in[k]; asm volatile("" : "+s"(q)); return (const float*)q; }

template <class ARow, class Epi>
__device__ __forceinline__ void gemm128(unsigned char* lds, const ARow& arow, const bf16_t* __restrict__ Bt, int K, const Epi& epi) {
    const int tid = otid(), lane = tid & 63, wid = tid >> 6, wr = wid >> 2, wc = wid & 3, fr = lane & 15, fq = lane >> 4;
    bf16_t* sA = (bf16_t*)lds;
    bf16_t* sB = (bf16_t*)(lds + 128 * 144);
    f32x4 acc[4][2];
#pragma unroll
    for (int m = 0; m < 4; ++m)
#pragma unroll
        for (int n = 0; n < 2; ++n) acc[m][n] = (f32x4){0.f, 0.f, 0.f, 0.f};
    const bf16_t* ap[2]; const bf16_t* bp[2]; int so[2];
#pragma unroll
    for (int i = 0; i < 2; ++i) {
        const int q = tid + 512 * i, row = q >> 3, seg = q & 7;
        ap[i] = arow(row) + seg * 8; bp[i] = Bt + (size_t)row * K + seg * 8; so[i] = row * 72 + seg * 8;
    }
    for (int k0 = 0; k0 < K; k0 += 64) {
        u32x4 va[2], vb[2];
#pragma unroll
        for (int i = 0; i < 2; ++i) { va[i] = *(const u32x4*)(ap[i] + k0); vb[i] = *(const u32x4*)(bp[i] + k0); }
        __syncthreads();
#pragma unroll
        for (int i = 0; i < 2; ++i) { *(u32x4*)(sA + so[i]) = va[i]; *(u32x4*)(sB + so[i]) = vb[i]; }
        __syncthreads();
#pragma unroll
        for (int kk = 0; kk < 2; ++kk) {
            bf16x8 a[4], b[2];
#pragma unroll
            for (int m = 0; m < 4; ++m) a[m] = *(const bf16x8*)(sA + (wr * 64 + m * 16 + fr) * 72 + kk * 32 + fq * 8);
#pragma unroll
            for (int n = 0; n < 2; ++n) b[n] = *(const bf16x8*)(sB + (wc * 32 + n * 16 + fr) * 72 + kk * 32 + fq * 8);
#pragma unroll
            for (int m = 0; m < 4; ++m)
#pragma unroll
                for (int n = 0; n < 2; ++n) acc[m][n] = __builtin_amdgcn_mfma_f32_16x16x32_bf16(b[n], a[m], acc[m][n], 0, 0, 0);
        }
    }
#pragma unroll
    for (int m = 0; m < 4; ++m)
#pragma unroll
        for (int n = 0; n < 2; ++n) epi(wr * 64 + m * 16 + fr, wc * 32 + n * 16 + fq * 4, acc[m][n]);
    __syncthreads();
}

struct ARowPlain { const bf16_t* A; int ld; __device__ __forceinline__ const bf16_t* operator()(int i) const { return A + (size_t)i * ld; } };
struct ARowGather { const bf16_t* A; const int* tok; int nvalid; __device__ __forceinline__ const bf16_t* operator()(int i) const { const int t = (i < nvalid) ? (tok[i] >> 1) : 0; return A + (size_t)t * 1024; } };

struct EpiP { bf16_t* P; __device__ __forceinline__ void operator()(int r, int c, f32x4 v) const {
    u32x2 w; w.x = pk2(v[0], v[1]); w.y = pk2(v[2], v[3]); *(u32x2*)(P + (size_t)r * PW + c) = w; } };
struct EpiRes { float* X; const float* gate; int m0; __device__ __forceinline__ void operator()(int r, int c, f32x4 v) const {
    const float* g = gate + (size_t)mod_row(m0 + r) * 6144 + c; float* xp = X + (size_t)r * 1024 + c;
    f32x4 x = *(f32x4*)xp; const f32x4 gv = *(const f32x4*)g; x += gv * v; *(f32x4*)xp = x; } };
struct EpiGU { bf16_t* H; __device__ __forceinline__ void operator()(int r, int c, f32x4 v) const {
    const float h0 = siluf(v[0]) * v[1], h1 = siluf(v[2]) * v[3]; *(unsigned*)(H + (size_t)r * 512 + (c >> 1)) = pk2(h0, h1); } };
struct EpiDown { bf16_t* YB; const int* tok; const float* gate; int nvalid; __device__ __forceinline__ void operator()(int r, int c, f32x4 v) const {
    if (r < nvalid) { const int e = tok[r]; const float g = gate[r]; u32x2 w; w.x = pk2(g * v[0], g * v[1]); w.y = pk2(g * v[2], g * v[3]); *(u32x2*)(YB + (size_t)e * 1024 + c) = w; } } };


namespace g8 {
constexpr int BM = 256, BK = 64, HALF = 128, HTB = HALF * BK * 2, NXCD = 8, WGM = 8;
__device__ __forceinline__ int lds_byte(int r, int c) { const int st = (r >> 4) * 2 + (c >> 5), rr = r & 15, cc = c & 31, ob = rr * 64 + cc * 2; return st * 1024 + (ob ^ (((ob >> 9) & 1) << 5)); }
__device__ __forceinline__ void stage_rc(int b, int& R, int& C) { const int st = b / 1024, sb = b % 1024, swz = sb ^ (((sb >> 9) & 1) << 5); R = (st >> 1) * 16 + swz / 64; C = (st & 1) * 32 + (swz % 64) / 2; }
__device__ __forceinline__ int perm32(int rho) { const int n = rho >> 4, i = rho & 15; return 8 * (i >> 2) + 4 * n + (i & 3); }
__device__ __forceinline__ unsigned cvt_pk_bf16(float lo, float hi) { return cvtpk(lo, hi); }

__device__ __forceinline__ int g8_ra(int tid, int i) { int R, C; stage_rc(tid * 16 + i * 8192, R, C); return R; }
__device__ __forceinline__ unsigned g8_ca(int tid, int i) { int R, C; stage_rc(tid * 16 + i * 8192, R, C); return (unsigned)C * 2u; }
#define G8_RA(i) g8_ra(otid(), (i))
#define G8_CA(i) g8_ca(otid(), (i))
template <class Epi, class Sched>
__device__ __forceinline__ void gemm_phase(LAS unsigned char* lds, const char* Abase, const int K, const Sched& S, const Epi& E) {
    const int tid = otid(), wid = __builtin_amdgcn_readfirstlane(tid >> 6), lane = tid & 63, wr = wid >> 2, wc = wid & 3, fr = lane & 15, fq = lane >> 4;
    const int nt = K / BK;
    unsigned voffB[2];
#pragma unroll
    for (int i = 0; i < 2; ++i) { int R, C; stage_rc(tid * 16 + i * 8192, R, C); const int Rb = Epi::PERM ? ((R & ~31) + perm32(R & 31)) : R;
        voffB[i] = (unsigned)(Rb * K + C) * 2u; }
    const unsigned rowb = (unsigned)K * 2u;
    const size_t kstep = (size_t)(BK * 2);
    const size_t hstep = (size_t)HALF * K * 2;
    const unsigned ldsw = (unsigned)wid * 1024u;
    const int aoff = lds_byte(wr * 64 + fr, fq * 8), boff = lds_byte(wc * 32 + fr, fq * 8);
#define G8_SA(b, h) (((b) * 2 + (h)) * HTB)
#define G8_SB(b, h) ((4 + (b) * 2 + (h)) * HTB)
#define G8_STAGE(bufoff, gbase, voff) do { _Pragma("unroll") for (int _i = 0; _i < 2; ++_i) \
        __builtin_amdgcn_global_load_lds((const unsigned*)((const char*)(gbase) + (voff)[_i]), (LAS unsigned*)(lds + (bufoff) + ldsw + _i * 8192), 16, 0, 0); } while (0)
#define G8_LDA(dst, b, h) do { _Pragma("unroll") for (int m = 0; m < 4; ++m) _Pragma("unroll") for (int k = 0; k < 2; ++k) dst[m][k] = *(const LAS bf16x8*)(lds + G8_SA(b, h) + aoff + m * 2048 + k * 1024); } while (0)
#define G8_LDB(dst, b, h) do { _Pragma("unroll") for (int n = 0; n < 2; ++n) _Pragma("unroll") for (int k = 0; k < 2; ++k) dst[n][k] = *(const LAS bf16x8*)(lds + G8_SB(b, h) + boff + n * 2048 + k * 1024); } while (0)
#define G8_MMA(ai, bj, At, Bt) do { __builtin_amdgcn_s_setprio(1); _Pragma("unroll") for (int m = 0; m < 4; ++m) _Pragma("unroll") for (int n = 0; n < 2; ++n) _Pragma("unroll") for (int k = 0; k < 2; ++k) \
        acc[ai][bj][m][n] = __builtin_amdgcn_mfma_f32_16x16x32_bf16(Bt[n][k], At[m][k], acc[ai][bj][m][n], 0, 0, 0); __builtin_amdgcn_s_setprio(0); } while (0)
#define G8_WAIT_V(n) asm volatile("s_waitcnt vmcnt(" #n ")" ::: "memory")
#define G8_WAIT_L(n) asm volatile("s_waitcnt lgkmcnt(" #n ")" ::: "memory")
#define G8_BAR __builtin_amdgcn_s_barrier()
#define G8_SCHED __builtin_amdgcn_sched_barrier(0)
    typename Sched::Unit cur, nxt; int ui = 0;
    if (!S.next(0, cur)) return;
    f32x4 acc[2][2][4][2];
#pragma unroll
    for (int a = 0; a < 2; ++a)
#pragma unroll
        for (int b = 0; b < 2; ++b)
#pragma unroll
            for (int m = 0; m < 4; ++m)
#pragma unroll
                for (int n = 0; n < 2; ++n) acc[a][b][m][n] = (f32x4){0.f, 0.f, 0.f, 0.f};
    bf16x8 At[4][2], B0[2][2], B1[2][2];
    unsigned vAc[2][2], vAn[2][2];
#pragma unroll
    for (int h = 0; h < 2; ++h)
#pragma unroll
        for (int i = 0; i < 2; ++i) vAc[h][i] = (Sched::AFFINE ? (unsigned)(h * HALF + G8_RA(i)) : (unsigned)S.a_row(cur, h * HALF + G8_RA(i))) * rowb + G8_CA(i);
    const char* cA = Sched::AFFINE ? Abase + (size_t)S.a_row(cur, 0) * rowb : Abase;
    const char* cB = S.b_base(cur);
    G8_STAGE(G8_SB(0, 0), cB, voffB); G8_STAGE(G8_SA(0, 0), cA, vAc[0]); G8_STAGE(G8_SB(0, 1), cB + hstep, voffB); G8_STAGE(G8_SA(0, 1), cA, vAc[1]);
    if (wr == 1) G8_BAR;
    G8_WAIT_V(4); G8_BAR;
    G8_STAGE(G8_SB(1, 0), cB + kstep, voffB); G8_STAGE(G8_SA(1, 0), cA + kstep, vAc[0]); G8_STAGE(G8_SB(1, 1), cB + hstep + kstep, voffB);
    G8_WAIT_V(6); G8_BAR;
    for (;;) {
        const bool has_next = S.next(ui + 1, nxt);
#pragma unroll
        for (int h = 0; h < 2; ++h)
#pragma unroll
            for (int i = 0; i < 2; ++i) vAn[h][i] = (has_next && !Sched::AFFINE) ? ((unsigned)S.a_row(nxt, h * HALF + G8_RA(i)) * rowb + G8_CA(i)) : vAc[h][i];
        const char* nA = (has_next && Sched::AFFINE) ? Abase + (size_t)S.a_row(nxt, 0) * rowb : cA;
        const char* nB = has_next ? S.b_base(nxt) : cB;
        for (int t = 0; t < nt; t += 2) {
            const bool last = (t == nt - 2);
            const char* a1 = cA + (size_t)(t + 1) * kstep;
            const char* a2 = last ? nA : cA + (size_t)(t + 2) * kstep; const char* b2 = last ? nB : cB + (size_t)(t + 2) * kstep;
            const char* a3 = a2 + kstep; const char* b3 = b2 + kstep;
            unsigned v2[2][2];
#pragma unroll
            for (int h = 0; h < 2; ++h)
#pragma unroll
                for (int i = 0; i < 2; ++i) v2[h][i] = last ? vAn[h][i] : vAc[h][i];
            G8_LDB(B0, 0, 0); G8_SCHED; G8_LDA(At, 0, 0); G8_STAGE(G8_SA(1, 1), a1, vAc[1]);
            G8_WAIT_L(8); G8_BAR; G8_WAIT_L(0); G8_MMA(0, 0, At, B0); G8_BAR; G8_SCHED;
            G8_LDB(B1, 0, 1); G8_STAGE(G8_SB(0, 0), b2, voffB);
            G8_BAR; G8_WAIT_L(0); G8_MMA(0, 1, At, B1); G8_BAR;
            G8_LDA(At, 0, 1); G8_STAGE(G8_SA(0, 0), a2, v2[0]);
            G8_BAR; G8_WAIT_L(0); G8_MMA(1, 0, At, B0); G8_BAR; G8_SCHED;
            G8_STAGE(G8_SB(0, 1), b2 + hstep, voffB);
            G8_WAIT_V(6); G8_BAR; G8_MMA(1, 1, At, B1); G8_BAR;
            G8_LDB(B0, 1, 0); G8_SCHED; G8_LDA(At, 1, 0); G8_STAGE(G8_SA(0, 1), a2, v2[1]);
            G8_WAIT_L(8); G8_BAR; G8_WAIT_L(0); G8_MMA(0, 0, At, B0); G8_BAR; G8_SCHED;
            G8_LDB(B1, 1, 1); G8_STAGE(G8_SB(1, 0), b3, voffB);
            G8_BAR; G8_WAIT_L(0); G8_MMA(0, 1, At, B1); G8_BAR;
            G8_LDA(At, 1, 1); G8_STAGE(G8_SA(1, 0), a3, v2[0]);
            G8_BAR; G8_WAIT_L(0); G8_MMA(1, 0, At, B0); G8_BAR; G8_SCHED;
            G8_STAGE(G8_SB(1, 1), b3 + hstep, voffB);
            G8_WAIT_V(6); G8_BAR; G8_MMA(1, 1, At, B1); G8_BAR;
        }
        E(acc, cur, wr, wc, fr, fq);
        if (!has_next) break;
#pragma unroll
        for (int a = 0; a < 2; ++a)
#pragma unroll
            for (int b = 0; b < 2; ++b)
#pragma unroll
                for (int m = 0; m < 4; ++m)
#pragma unroll
                    for (int n = 0; n < 2; ++n) acc[a][b][m][n] = (f32x4){0.f, 0.f, 0.f, 0.f};
        cur = nxt; cB = nB; cA = nA; ++ui;
#pragma unroll
        for (int h = 0; h < 2; ++h)
#pragma unroll
            for (int i = 0; i < 2; ++i) vAc[h][i] = vAn[h][i];
    }
    G8_WAIT_V(0);
    if (wr == 0) G8_BAR;
    G8_BAR;
#undef G8_SA
#undef G8_SB
#undef G8_STAGE
#undef G8_LDA
#undef G8_LDB
#undef G8_MMA
#undef G8_WAIT_V
#undef G8_WAIT_L
#undef G8_BAR
#undef G8_SCHED
}

template <int sclW, int sclA, class Epi, class Sched>
__device__ __forceinline__ void gemm_phase8(LAS unsigned char* lds, const char* Abase, const int K, const Sched& S, const Epi& E) {
    const int tid = otid(), wid = __builtin_amdgcn_readfirstlane(tid >> 6), lane = tid & 63, wr = wid >> 2, wc = wid & 3, fr = lane & 15, fq = lane >> 4;
    const int nt = K / 128;
    unsigned voffB[2];
#pragma unroll
    for (int i = 0; i < 2; ++i) { int R, C; stage_rc(tid * 16 + i * 8192, R, C); const int Rb = Epi::PERM ? ((R & ~31) + perm32(R & 31)) : R;
        voffB[i] = (unsigned)(Rb * K) + (unsigned)C * 2u; }
    const unsigned rowb = (unsigned)K;
    const size_t kstep = (size_t)(BK * 2);
    const size_t hstep = (size_t)HALF * K;
    const unsigned ldsw = (unsigned)wid * 1024u;
    const int fob = fr * 64 + ((2 * (fq & 1)) ^ (2 * (fr >> 3))) * 16 + (fq >> 1) * 1024;
    const int aoff = ((wr * 64) >> 4) * 2048 + fob, boff = ((wc * 32) >> 4) * 2048 + fob;
#define G8_SA(b, h) (((b) * 2 + (h)) * HTB)
#define G8_SB(b, h) ((4 + (b) * 2 + (h)) * HTB)
#define G8_STAGE(bufoff, gbase, voff) do { _Pragma("unroll") for (int _i = 0; _i < 2; ++_i) \
        __builtin_amdgcn_global_load_lds((const unsigned*)((const char*)(gbase) + (voff)[_i]), (LAS unsigned*)(lds + (bufoff) + ldsw + _i * 8192), 16, 0, 0); } while (0)
#define G8_LDA(dst, b, h) do { _Pragma("unroll") for (int m = 0; m < 4; ++m) { const i32x4 _lo = *(const LAS i32x4*)(lds + G8_SA(b, h) + aoff + m * 2048), _hi = *(const LAS i32x4*)(lds + G8_SA(b, h) + aoff + m * 2048 + 16); dst[m] = __builtin_shufflevector(_lo, _hi, 0, 1, 2, 3, 4, 5, 6, 7); } } while (0)
#define G8_LDB(dst, b, h) do { _Pragma("unroll") for (int n = 0; n < 2; ++n) { const i32x4 _lo = *(const LAS i32x4*)(lds + G8_SB(b, h) + boff + n * 2048), _hi = *(const LAS i32x4*)(lds + G8_SB(b, h) + boff + n * 2048 + 16); dst[n] = __builtin_shufflevector(_lo, _hi, 0, 1, 2, 3, 4, 5, 6, 7); } } while (0)
#define G8_MMA(ai, bj, At, Bt) do { __builtin_amdgcn_s_setprio(1); _Pragma("unroll") for (int m = 0; m < 4; ++m) _Pragma("unroll") for (int n = 0; n < 2; ++n) \
        acc[ai][bj][m][n] = __builtin_amdgcn_mfma_scale_f32_16x16x128_f8f6f4(Bt[n], At[m], acc[ai][bj][m][n], 0, 0, 0, sclW, 0, sclA); \
        _Pragma("unroll") for (int m = 0; m < 4; ++m) asm volatile("" : "+v"(acc[ai][bj][m][0]), "+v"(acc[ai][bj][m][1]));   \
        __builtin_amdgcn_s_setprio(0); } while (0)
#define G8_WAIT_V(n) asm volatile("s_waitcnt vmcnt(" #n ")" ::: "memory")
#define G8_WAIT_L(n) asm volatile("s_waitcnt lgkmcnt(" #n ")" ::: "memory")
#define G8_BAR __builtin_amdgcn_s_barrier()
#define G8_SCHED __builtin_amdgcn_sched_barrier(0)
    typename Sched::Unit cur, nxt; int ui = 0;
    if (!S.next(0, cur)) return;
    f32x4 acc[2][2][4][2];
#pragma unroll
    for (int a = 0; a < 2; ++a)
#pragma unroll
        for (int b = 0; b < 2; ++b)
#pragma unroll
            for (int m = 0; m < 4; ++m)
#pragma unroll
                for (int n = 0; n < 2; ++n) acc[a][b][m][n] = (f32x4){0.f, 0.f, 0.f, 0.f};
    i32x8 At[4], B0[2], B1[2];
    unsigned vAc[2][2], vAn[2][2];
#pragma unroll
    for (int h = 0; h < 2; ++h)
#pragma unroll
        for (int i = 0; i < 2; ++i) vAc[h][i] = (Sched::AFFINE ? (unsigned)(h * HALF + G8_RA(i)) : (unsigned)S.a_row(cur, h * HALF + G8_RA(i))) * rowb + G8_CA(i);
    const char* cA = Sched::AFFINE ? Abase + (size_t)S.a_row(cur, 0) * rowb : Abase;
    const char* cB = S.b_base(cur);
    G8_STAGE(G8_SB(0, 0), cB, voffB); G8_STAGE(G8_SA(0, 0), cA, vAc[0]); G8_STAGE(G8_SB(0, 1), cB + hstep, voffB); G8_STAGE(G8_SA(0, 1), cA, vAc[1]);
    if (wr == 1) G8_BAR;
    G8_WAIT_V(4); G8_BAR;
    G8_STAGE(G8_SB(1, 0), cB + kstep, voffB); G8_STAGE(G8_SA(1, 0), cA + kstep, vAc[0]); G8_STAGE(G8_SB(1, 1), cB + hstep + kstep, voffB);
    G8_WAIT_V(6); G8_BAR;
    for (;;) {
        const bool has_next = S.next(ui + 1, nxt);
#pragma unroll
        for (int h = 0; h < 2; ++h)
#pragma unroll
            for (int i = 0; i < 2; ++i) vAn[h][i] = (has_next && !Sched::AFFINE) ? ((unsigned)S.a_row(nxt, h * HALF + G8_RA(i)) * rowb + G8_CA(i)) : vAc[h][i];
        const char* nA = (has_next && Sched::AFFINE) ? Abase + (size_t)S.a_row(nxt, 0) * rowb : cA;
        const char* nB = has_next ? S.b_base(nxt) : cB;
#pragma unroll 1
        for (int t = 0; t < nt; t += 2) {
            const bool last = (t == nt - 2);
            const char* a1 = cA + (size_t)(t + 1) * kstep;
            const char* a2 = last ? nA : cA + (size_t)(t + 2) * kstep; const char* b2 = last ? nB : cB + (size_t)(t + 2) * kstep;
            const char* a3 = a2 + kstep; const char* b3 = b2 + kstep;
            unsigned v2[2][2];
#pragma unroll
            for (int h = 0; h < 2; ++h)
#pragma unroll
                for (int i = 0; i < 2; ++i) v2[h][i] = last ? vAn[h][i] : vAc[h][i];
            G8_LDB(B0, 0, 0); G8_SCHED; G8_LDA(At, 0, 0); G8_STAGE(G8_SA(1, 1), a1, vAc[1]);
            G8_WAIT_L(8); G8_BAR; G8_WAIT_L(0); G8_MMA(0, 0, At, B0); G8_BAR; G8_SCHED;
            G8_LDB(B1, 0, 1); G8_STAGE(G8_SB(0, 0), b2, voffB);
            G8_BAR; G8_WAIT_L(0); G8_MMA(0, 1, At, B1); G8_BAR;
            G8_LDA(At, 0, 1); G8_STAGE(G8_SA(0, 0), a2, v2[0]);
            G8_BAR; G8_WAIT_L(0); G8_MMA(1, 0, At, B0); G8_BAR; G8_SCHED;
            G8_STAGE(G8_SB(0, 1), b2 + hstep, voffB);
            G8_WAIT_V(6); G8_BAR; G8_MMA(1, 1, At, B1); G8_BAR;
            G8_LDB(B0, 1, 0); G8_SCHED; G8_LDA(At, 1, 0); G8_STAGE(G8_SA(0, 1), a2, v2[1]);
            G8_WAIT_L(8); G8_BAR; G8_WAIT_L(0); G8_MMA(0, 0, At, B0); G8_BAR; G8_SCHED;
            G8_LDB(B1, 1, 1); G8_STAGE(G8_SB(1, 0), b3, voffB);
            G8_BAR; G8_WAIT_L(0); G8_MMA(0, 1, At, B1); G8_BAR;
            G8_LDA(At, 1, 1); G8_STAGE(G8_SA(1, 0), a3, v2[0]);
            G8_BAR; G8_WAIT_L(0); G8_MMA(1, 0, At, B0); G8_BAR; G8_SCHED;
            G8_STAGE(G8_SB(1, 1), b3 + hstep, voffB);
            G8_WAIT_V(6); G8_BAR; G8_MMA(1, 1, At, B1); G8_BAR;
        }
        E(acc, cur, wr, wc, fr, fq);
        if (!has_next) break;
#pragma unroll
        for (int a = 0; a < 2; ++a)
#pragma unroll
            for (int b = 0; b < 2; ++b)
#pragma unroll
                for (int m = 0; m < 4; ++m)
#pragma unroll
                    for (int n = 0; n < 2; ++n) acc[a][b][m][n] = (f32x4){0.f, 0.f, 0.f, 0.f};
        cur = nxt; cB = nB; cA = nA; ++ui;
#pragma unroll
        for (int h = 0; h < 2; ++h)
#pragma unroll
            for (int i = 0; i < 2; ++i) vAc[h][i] = vAn[h][i];
    }
    G8_WAIT_V(0);
    if (wr == 0) G8_BAR;
    G8_BAR;
#undef G8_SA
#undef G8_SB
#undef G8_STAGE
#undef G8_LDA
#undef G8_LDB
#undef G8_MMA
#undef G8_WAIT_V
#undef G8_WAIT_L
#undef G8_BAR
#undef G8_SCHED
}

struct DUnit { int pm, pn; };
struct DenseOrder {
    typedef DUnit Unit; static constexpr bool AFFINE = true;
    int nM, nN, nwg, G, c; const char* Bt; int K;
    __device__ __forceinline__ void init(int nM_, int nN_, int G_, int c_, const void* Bt_, int K_) { nM = nM_; nN = nN_; nwg = nM * nN; G = G_; c = c_; Bt = (const char*)Bt_; K = K_; }
    __device__ __forceinline__ bool next(int i, Unit& u) const {
        const long L = (long)i * G + c; if (L >= nwg) return false;
        int wgid = (int)L; { const int q = nwg / NXCD, r = nwg % NXCD, xcd = wgid % NXCD, off = wgid / NXCD; wgid = (xcd < r ? xcd * (q + 1) : r * (q + 1) + (xcd - r) * q) + off; }
        const int nig = WGM * nN, gid = wgid / nig, fm = gid * WGM, gsz = (nM - fm) < WGM ? (nM - fm) : WGM;
        u.pm = fm + ((wgid % nig) % gsz); u.pn = (wgid % nig) / gsz; return true;
    }
    __device__ __forceinline__ int a_row(const Unit& u, int r) const { return u.pm * BM + r; }
    __device__ __forceinline__ const char* b_base(const Unit& u) const { return Bt + (size_t)u.pn * BM * K * 2; }
};
struct MUnit { int pm, pn, e, nvalid, lbase, idx; };
constexpr int MOE_UTAB = 131072, MOE_RTOK = MOE_UTAB + 128, MOE_RGATE = MOE_RTOK + 4096;
template <bool GATHER> struct MoeOrder {
    typedef MUnit Unit; static constexpr bool AFFINE = !GATHER;
    const int* utab; const int* rtok; const char* W; int K; int bpe;
    __device__ __forceinline__ bool next(int i, Unit& u) const {
        if (i >= 4) return false;
        const int* t = utab + i * 8;
        if (t[5] == 0) return false;
        u.pm = t[0]; u.pn = t[1]; u.e = t[2]; u.nvalid = t[3]; u.lbase = t[4]; u.idx = i; return true;
    }
    __device__ __forceinline__ int a_row(const Unit& u, int r) const { if (GATHER) return rtok[u.idx * 256 + r] >> 1; else return u.pm * BM + r; }
    __device__ __forceinline__ const char* b_base(const Unit& u) const { return W + ((size_t)u.e * 1024 + u.pn * BM) * K * bpe; }
};

struct EpiP2 {
    static constexpr bool PERM = true;
    bf16_t* P;
    __device__ __forceinline__ void operator()(const f32x4 (&acc)[2][2][4][2], const DUnit& u, int wr, int wc, int fr, int fq) const {
        const int row0 = u.pm * BM + wr * 64 + fr, col0 = u.pn * BM + wc * 32 + 8 * fq;
#pragma unroll
        for (int ai = 0; ai < 2; ++ai)
#pragma unroll
            for (int m = 0; m < 4; ++m) { bf16_t* rowp = P + (size_t)(row0 + ai * HALF + m * 16) * PW + col0;
#pragma unroll
                for (int bj = 0; bj < 2; ++bj) { const f32x4 v0 = acc[ai][bj][m][0], v1 = acc[ai][bj][m][1];
                    u32x4 w; w.x = cvt_pk_bf16(v0[0], v0[1]); w.y = cvt_pk_bf16(v0[2], v0[3]); w.z = cvt_pk_bf16(v1[0], v1[1]); w.w = cvt_pk_bf16(v1[2], v1[3]);
                    *(u32x4*)(rowp + bj * HALF) = w; } }
    }
};
struct EpiRes2 {
    static constexpr bool PERM = false;
    float* X; const float* gate; float scl;
    __device__ __forceinline__ void operator()(const f32x4 (&acc)[2][2][4][2], const DUnit& u, int wr, int wc, int fr, int fq) const {
        const int row0 = u.pm * BM + wr * 64 + fr, col0 = u.pn * BM + wc * 32 + 4 * fq;
#pragma unroll
        for (int ai = 0; ai < 2; ++ai)
#pragma unroll
            for (int m = 0; m < 4; ++m) { const int r = row0 + ai * HALF + m * 16; float* rowp = X + (size_t)r * 1024 + col0; const float* gp = gate + (size_t)mod_row(r) * 6144 + col0;
#pragma unroll
                for (int bj = 0; bj < 2; ++bj)
#pragma unroll
                    for (int n = 0; n < 2; ++n) { const f32x4 gv = *(const f32x4*)(gp + bj * HALF + n * 16); f32x4 x = *(f32x4*)(rowp + bj * HALF + n * 16); x += (gv * scl) * acc[ai][bj][m][n]; *(f32x4*)(rowp + bj * HALF + n * 16) = x; }
                asm volatile("" ::: "memory"); }
    }
};
struct EpiDelta {
    static constexpr bool PERM = true;
    bf16_t* Dl; const float* gate; float scl;
    __device__ __forceinline__ void operator()(const f32x4 (&acc)[2][2][4][2], const DUnit& u, int wr, int wc, int fr, int fq) const {
        const int row0 = u.pm * BM + wr * 64 + fr, col0 = u.pn * BM + wc * 32 + 8 * fq;
#pragma unroll
        for (int ai = 0; ai < 2; ++ai)
#pragma unroll
            for (int m = 0; m < 4; ++m) { const int r = row0 + ai * HALF + m * 16; bf16_t* rowp = Dl + (size_t)r * 1024 + col0; const float* gp = gate + (size_t)mod_row(r) * 6144 + col0;
#pragma unroll
                for (int bj = 0; bj < 2; ++bj) { const f32x4 g0 = *(const f32x4*)(gp + bj * HALF) * scl, g1 = *(const f32x4*)(gp + bj * HALF + 4) * scl;
                    const f32x4 v0 = acc[ai][bj][m][0] * g0, v1 = acc[ai][bj][m][1] * g1;
                    u32x4 w; w.x = cvt_pk_bf16(v0[0], v0[1]); w.y = cvt_pk_bf16(v0[2], v0[3]); w.z = cvt_pk_bf16(v1[0], v1[1]); w.w = cvt_pk_bf16(v1[2], v1[3]);
                    *(u32x4*)(rowp + bj * HALF) = w; } }
    }
};
struct EpiGU2 {
    static constexpr bool PERM = true;
    bf16_t* H;
    __device__ __forceinline__ void operator()(const f32x4 (&acc)[2][2][4][2], const MUnit& u, int wr, int wc, int fr, int fq) const {
        const int row0 = u.pm * BM + wr * 64 + fr, col0 = u.pn * BM + wc * 32 + 8 * fq;
#pragma unroll
        for (int ai = 0; ai < 2; ++ai)
#pragma unroll
            for (int m = 0; m < 4; ++m) { bf16_t* rowp = H + (size_t)(row0 + ai * HALF + m * 16) * 512 + (col0 >> 1);
#pragma unroll
                for (int bj = 0; bj < 2; ++bj) { const f32x4 v0 = acc[ai][bj][m][0], v1 = acc[ai][bj][m][1];
                    u32x2 w; w.x = cvt_pk_bf16(siluf(v0[0]) * v0[1], siluf(v0[2]) * v0[3]); w.y = cvt_pk_bf16(siluf(v1[0]) * v1[1], siluf(v1[2]) * v1[3]);
                    *(u32x2*)(rowp + bj * (HALF / 2)) = w; } }
    }
};
struct EpiGU8 {
    static constexpr bool PERM = true;
    unsigned char* H;
    __device__ __forceinline__ void operator()(const f32x4 (&acc)[2][2][4][2], const MUnit& u, int wr, int wc, int fr, int fq) const {
        const int row0 = u.pm * BM + wr * 64 + fr, col0 = u.pn * BM + wc * 32 + 8 * fq;
#pragma unroll
        for (int ai = 0; ai < 2; ++ai)
#pragma unroll
            for (int m = 0; m < 4; ++m) { unsigned char* rowp = H + (size_t)(row0 + ai * HALF + m * 16) * 512 + (col0 >> 1);
#pragma unroll
                for (int bj = 0; bj < 2; ++bj) { const f32x4 v0 = acc[ai][bj][m][0], v1 = acc[ai][bj][m][1];
                    *(unsigned*)(rowp + bj * (HALF / 2)) = pk4_fp8(2.0f * siluf(v0[0]) * v0[1], 2.0f * siluf(v0[2]) * v0[3], 2.0f * siluf(v1[0]) * v1[1], 2.0f * siluf(v1[2]) * v1[3]); } }
    }
};
struct EpiDown2 {
    static constexpr bool PERM = true;
    bf16_t* YB; const int* rtok; const float* rgate;
    __device__ __forceinline__ void operator()(const f32x4 (&acc)[2][2][4][2], const MUnit& u, int wr, int wc, int fr, int fq) const {
        const int r0 = wr * 64 + fr, col0 = u.pn * BM + wc * 32 + 8 * fq;
#pragma unroll
        for (int ai = 0; ai < 2; ++ai)
#pragma unroll
            for (int m = 0; m < 4; ++m) { const int rt = r0 + ai * HALF + m * 16;
                if (rt < u.nvalid) { const int ent = rtok[u.idx * 256 + rt]; const float g = rgate[u.idx * 256 + rt]; bf16_t* rowp = YB + (size_t)ent * 1024 + col0;
#pragma unroll
                    for (int bj = 0; bj < 2; ++bj) { const f32x4 v0 = acc[ai][bj][m][0] * g, v1 = acc[ai][bj][m][1] * g;
                        u32x4 w; w.x = cvt_pk_bf16(v0[0], v0[1]); w.y = cvt_pk_bf16(v0[2], v0[3]); w.z = cvt_pk_bf16(v1[0], v1[1]); w.w = cvt_pk_bf16(v1[2], v1[3]);
                        *(u32x4*)(rowp + bj * HALF) = w; } } }
    }
};
struct EpiDown8 {
    static constexpr bool PERM = true;
    unsigned char* YB; const int* rtok; const float* rgate;
    __device__ __forceinline__ void operator()(const f32x4 (&acc)[2][2][4][2], const MUnit& u, int wr, int wc, int fr, int fq) const {
        const int r0 = wr * 64 + fr, col0 = u.pn * BM + wc * 32 + 8 * fq;
#pragma unroll
        for (int ai = 0; ai < 2; ++ai)
#pragma unroll
            for (int m = 0; m < 4; ++m) { const int rt = r0 + ai * HALF + m * 16;
                if (rt < u.nvalid) { const int ent = rtok[u.idx * 256 + rt]; const float g = 64.0f * rgate[u.idx * 256 + rt]; unsigned char* rowp = YB + (size_t)ent * 1024 + col0;
#pragma unroll
                    for (int bj = 0; bj < 2; ++bj) { const f32x4 v0 = acc[ai][bj][m][0] * g, v1 = acc[ai][bj][m][1] * g;
                        u32x2 w; w.x = pk4_fp8(v0[0], v0[1], v0[2], v0[3]); w.y = pk4_fp8(v1[0], v1[1], v1[2], v1[3]);
                        *(u32x2*)(rowp + bj * HALF) = w; } } }
    }
};
}

__device__ __forceinline__ void transpose_item(const float* __restrict__ W, int K, int N, bf16_t* __restrict__ WT, int mode, float* scr, int item, int lane) {
    const int nblk = N / 32, kb = item / nblk, nb = item % nblk, k0 = 64 * kb, n0 = 32 * nb;
    float wv[32];
#pragma unroll
    for (int i = 0; i < 32; ++i) wv[i] = __builtin_nontemporal_load(W + (size_t)(k0 + 2 * i + (lane >> 5)) * N + n0 + (lane & 31));
#pragma unroll
    for (int i = 0; i < 32; ++i) scr[(2 * i + (lane >> 5)) * 33 + (lane & 31)] = wv[i];
    LDS_WAIT();
    const int c = lane & 7;
#pragma unroll
    for (int j = 0; j < 4; ++j) {
        const int n = (lane >> 3) + 8 * j; const float* s = scr + (8 * c) * 33 + n;
        u32x4 o; o.x = pk2(s[0 * 33], s[1 * 33]); o.y = pk2(s[2 * 33], s[3 * 33]); o.z = pk2(s[4 * 33], s[5 * 33]); o.w = pk2(s[6 * 33], s[7 * 33]);
        const int nabs = n0 + n; const int orow = mode ? ((nabs < 512) ? 2 * nabs : 2 * (nabs - 512) + 1) : nabs;
        *(u32x4*)(WT + (size_t)orow * K + k0 + 8 * c) = o;
    }
    LDS_WAIT();
}


__device__ __forceinline__ void transpose_item8(const float* __restrict__ W, int K, int N, unsigned char* __restrict__ WT, int mode, float scale, float* scr, int item, int lane) {
    const int nblk = N / 32, kb = item / nblk, nb = item % nblk, k0 = 64 * kb, n0 = 32 * nb;
    float wv[32];
#pragma unroll
    for (int i = 0; i < 32; ++i) wv[i] = __builtin_nontemporal_load(W + (size_t)(k0 + 2 * i + (lane >> 5)) * N + n0 + (lane & 31));
#pragma unroll
    for (int i = 0; i < 32; ++i) scr[(2 * i + (lane >> 5)) * 33 + (lane & 31)] = wv[i] * scale;
    LDS_WAIT();
    const int c = lane & 7;
#pragma unroll
    for (int j = 0; j < 4; ++j) {
        const int n = (lane >> 3) + 8 * j; const float* s = scr + (8 * c) * 33 + n;
        u32x2 o; o.x = pk4_fp8(s[0 * 33], s[1 * 33], s[2 * 33], s[3 * 33]); o.y = pk4_fp8(s[4 * 33], s[5 * 33], s[6 * 33], s[7 * 33]);
        const int nabs = n0 + n; const int orow = mode ? ((nabs < 512) ? 2 * nabs : 2 * (nabs - 512) + 1) : nabs;
        *(u32x2*)(WT + (size_t)orow * K + k0 + 8 * c) = o;
    }
    LDS_WAIT();
}

__device__ __forceinline__ void convert_experts(const Params& p, int l, float* scr, int widx, int nwv, int it0, int it1) {
    const int tid = otid(), lane = tid & 63;
    bf16_t* wgu_t = (bf16_t*)(ows(p) + WS_WGU) + (size_t)l * 32 * 1024 * 1024; bf16_t* wdn_t = (bf16_t*)(ows(p) + WS_WDN) + (size_t)l * 32 * 1024 * 512;
    const float* wgu = oin(p, 17) + (size_t)l * 32 * 1024 * 1024; const float* wdn = oin(p, 18) + (size_t)l * 32 * 512 * 1024;
    constexpr int I_GU = 16 * 32, I_DN = 8 * 32, T_GU = 32 * I_GU;
    unsigned char* wgu8 = ows(p) + WS_WGU8 + (size_t)l * 32 * 1024 * 1024; unsigned char* wdn8 = ows(p) + WS_WDN8 + (size_t)l * 32 * 1024 * 512;
    for (int it = it0 + widx; it < it1; it += nwv) {
        if (it < T_GU) { const int m = it / I_GU;
            if (MOE_FP8) transpose_item8(wgu + (size_t)m * 1024 * 1024, 1024, 1024, wgu8 + (size_t)m * 1024 * 1024, 1, 32.0f, scr, it % I_GU, lane);
            else transpose_item(wgu + (size_t)m * 1024 * 1024, 1024, 1024, wgu_t + (size_t)m * 1024 * 1024, 1, scr, it % I_GU, lane); }
        else { const int r = it - T_GU, m = r / I_DN;
            if (MOE_FP8) transpose_item8(wdn + (size_t)m * 512 * 1024, 512, 1024, wdn8 + (size_t)m * 1024 * 512, 0, 16.0f, scr, r % I_DN, lane);
            else transpose_item(wdn + (size_t)m * 512 * 1024, 512, 1024, wdn_t + (size_t)m * 1024 * 512, 0, scr, r % I_DN, lane); }
    }
}

__device__ __forceinline__ void phase_prologue(const Params& p, unsigned char* lds) {
    const int tid = otid(), lane = tid & 63, wid = tid >> 6;
    float* scr = (float*)(lds + wid * 16384);
    const int gw = obid() * 8 + wid, NGW = gridDim.x * 8;
    bf16_t* win_t = (bf16_t*)(ows(p) + WS_WIN); bf16_t* wout_t = (bf16_t*)(ows(p) + WS_WOUT);
    constexpr int I_IN = 16 * 128, I_OUT = 16 * 32;
    constexpr int T_IN = 4 * I_IN, T_OUT = 4 * I_OUT;
    for (int it = gw; it < T_IN + T_OUT; it += NGW) {
        int r = it;
        if (r < T_IN) { const int m = r / I_IN; transpose_item(oin(p, 7) + (size_t)m * 1024 * 4096, 1024, 4096, win_t + (size_t)m * 4096 * 1024, 0, scr, r % I_IN, lane); continue; } r -= T_IN;
        { const int m = r / I_OUT; transpose_item(oin(p, 12) + (size_t)m * 1024 * 1024, 1024, 1024, wout_t + (size_t)m * 1024 * 1024, 0, scr, r % I_OUT, lane); }
    }
    {
        bf16_t* wrh = (bf16_t*)(ows(p) + WS_WRH); bf16_t* wrl = (bf16_t*)(ows(p) + WS_WRL);
        for (int i = obid() * 512 + tid; i < 4 * 48 * 1024; i += gridDim.x * 512) {
            const int l = i / (48 * 1024), j = (i / 1024) % 48, k = i % 1024;
            float w = 0.f;
            if (j < 4) w = oin(p, 13)[((size_t)l * 1024 + k) * 4 + j]; else if (j < 36) w = oin(p, 15)[((size_t)l * 1024 + k) * 32 + (j - 4)];
            const unsigned hi = f2bf(w); const float rem = w - __uint_as_float(hi << 16);
            wrh[i] = (bf16_t)hi; wrl[i] = (bf16_t)f2bf(rem);
        }
    }
    __syncthreads();
    float* modp = (float*)(ows(p) + WS_MODP);
    float* sS = (float*)lds;
    for (int u = obid(); u < 4 * 24 * 8; u += gridDim.x) {
        const int l = u / 192, rem = u % 192, nb = rem / 8, ks = rem % 8;
        __syncthreads();
        for (int i = tid; i < 9 * 128; i += 512) { const int r = i >> 7, k = i & 127; const float cv = (r < 8) ? oin(p, 1)[r * 1024 + ks * 128 + k] : oin(p, 3)[ks * 128 + k]; sS[i] = siluf(cv); }
        __syncthreads();
        const int col = nb * 256 + (tid & 255), kh = tid >> 8;
        float acc[9];
#pragma unroll
        for (int r = 0; r < 9; ++r) acc[r] = 0.f;
        const float* w = oin(p, 5) + ((size_t)l * 1024 + ks * 128 + kh * 64) * 6144 + col;
        for (int k = 0; k < 64; ++k) {
            const float wv = w[(size_t)k * 6144];
#pragma unroll
            for (int r = 0; r < 9; ++r) acc[r] += sS[r * 128 + kh * 64 + k] * wv;
        }
#pragma unroll
        for (int r = 0; r < 9; ++r) modp[(((size_t)l * NMODP + ks * 2 + kh) * 9 + r) * 6144 + col] = acc[r];
    }
}

__device__ __forceinline__ void phase_modreduce(const Params& p) {
    const float* modp = (const float*)(ows(p) + WS_MODP); float* modv = (float*)(ows(p) + WS_MOD);
    for (int i = obid() * 512 + otid(); i < 4 * 9 * 6144; i += gridDim.x * 512) {
        const int l = i / (9 * 6144), rem = i % (9 * 6144), n = rem % 6144;
        float s = oin(p, 6)[l * 6144 + n];
        for (int j = 0; j < NMODP; ++j) s += modp[((size_t)l * NMODP + j) * 9 * 6144 + rem];
        modv[i] = s;
    }
}

__device__ __forceinline__ void phase_norm1(const Params& p, int l, float scl) {
    const int lane = otid() & 63, wid = otid() >> 6;
    float* xws = (float*)(ows(p) + WS_X); bf16_t* hb = (bf16_t*)(ows(p) + WS_H); const bf16_t* yb = (const bf16_t*)(ows(p) + WS_YB);
    const float* modv = (const float*)(ows(p) + WS_MOD);
    const float* nw = oin(p, 4) + (size_t)(l * 2 + 0) * 1024;
    for (int r = obid() * 8 + wid; r < NTOK; r += gridDim.x * 8) {
        const int mr = mod_row(r);
        const float* src = (l == 0) ? (r < NLAT ? oin(p, 0) + (size_t)r * 1024 : oin(p, 2) + (size_t)(r - NLAT) * 1024) : xws + (size_t)r * 1024;
        f32x4 v[4];
#pragma unroll
        for (int j = 0; j < 4; ++j) v[j] = *(const f32x4*)(src + 4 * lane + 256 * j);
        if (l > 0) {
            const float* g5 = modv + ((size_t)(l - 1) * 9 + mr) * 6144 + 5 * 1024;
#pragma unroll
            for (int j = 0; j < 4; ++j) {
                const int c = 4 * lane + 256 * j;
                const f32x4 gv = *(const f32x4*)(g5 + c);
                f32x4 f;
                if (MOE_FP8) { const unsigned char* y8 = ows(p) + WS_YB8; f = (unpk4_fp8(*(const unsigned*)(y8 + (size_t)(2 * r) * 1024 + c)) + unpk4_fp8(*(const unsigned*)(y8 + (size_t)(2 * r + 1) * 1024 + c))) * (1.0f / 64.0f); }
                else { const u32x2 y0 = *(const u32x2*)(yb + (size_t)(2 * r) * 1024 + c), y1 = *(const u32x2*)(yb + (size_t)(2 * r + 1) * 1024 + c);
                f[0] = bf2f(y0.x & 0xffff) + bf2f(y1.x & 0xffff); f[1] = bf2f(y0.x >> 16) + bf2f(y1.x >> 16);
                f[2] = bf2f(y0.y & 0xffff) + bf2f(y1.y & 0xffff); f[3] = bf2f(y0.y >> 16) + bf2f(y1.y >> 16); }
                v[j] += (gv * scl) * f;
            }
        }
#pragma unroll
        for (int j = 0; j < 4; ++j) *(f32x4*)(xws + (size_t)r * 1024 + 4 * lane + 256 * j) = v[j];
        float ss = 0.f;
#pragma unroll
        for (int j = 0; j < 4; ++j) ss += (v[j][0] * v[j][0] + v[j][1] * v[j][1]) + (v[j][2] * v[j][2] + v[j][3] * v[j][3]);
        const float rstd = rsqrtf(wave_sum(ss) * (1.0f / 1024.0f) + EPS);
        const float* msh = modv + ((size_t)l * 9 + mr) * 6144; const float* msc = msh + 1024;
#pragma unroll
        for (int j = 0; j < 4; ++j) {
            const int c = 4 * lane + 256 * j;
            const f32x4 w = *(const f32x4*)(nw + c), sh = *(const f32x4*)(msh + c), sc = *(const f32x4*)(msc + c);
            const f32x4 h = (v[j] * rstd * w) * (1.0f + sc) + sh;
            u32x2 o; o.x = pk2(h[0], h[1]); o.y = pk2(h[2], h[3]);
            *(u32x2*)(hb + (size_t)r * 1024 + c) = o;
        }
    }
}

__device__ __forceinline__ void phase_final(const Params& p) {
    const int lane = otid() & 63, wid = otid() >> 6;
    const float* xws = (const float*)(ows(p) + WS_X); const bf16_t* yb = (const bf16_t*)(ows(p) + WS_YB);
    const float* modv = (const float*)(ows(p) + WS_MOD); const float* nw = oin(p, 19);
    for (int r = obid() * 8 + wid; r < NLAT; r += gridDim.x * 8) {
        const int mr = mod_row(r);
        const float* g5 = modv + ((size_t)3 * 9 + mr) * 6144 + 5 * 1024;
        f32x4 v[4]; float ss = 0.f;
#pragma unroll
        for (int j = 0; j < 4; ++j) {
            const int c = 4 * lane + 256 * j;
            v[j] = *(const f32x4*)(xws + (size_t)r * 1024 + c);
            const f32x4 gv = *(const f32x4*)(g5 + c);
            f32x4 f;
            if (MOE_FP8) { const unsigned char* y8 = ows(p) + WS_YB8; f = (unpk4_fp8(*(const unsigned*)(y8 + (size_t)(2 * r) * 1024 + c)) + unpk4_fp8(*(const unsigned*)(y8 + (size_t)(2 * r + 1) * 1024 + c))) * (1.0f / 64.0f); }
            else { const u32x2 y0 = *(const u32x2*)(yb + (size_t)(2 * r) * 1024 + c), y1 = *(const u32x2*)(yb + (size_t)(2 * r + 1) * 1024 + c);
            f[0] = bf2f(y0.x & 0xffff) + bf2f(y1.x & 0xffff); f[1] = bf2f(y0.x >> 16) + bf2f(y1.x >> 16);
            f[2] = bf2f(y0.y & 0xffff) + bf2f(y1.y & 0xffff); f[3] = bf2f(y0.y >> 16) + bf2f(y1.y >> 16); }
            v[j] += gv * f;
            ss += (v[j][0] * v[j][0] + v[j][1] * v[j][1]) + (v[j][2] * v[j][2] + v[j][3] * v[j][3]);
        }
        const float rstd = rsqrtf(wave_sum(ss) * (1.0f / 1024.0f) + EPS);
#pragma unroll
        for (int j = 0; j < 4; ++j) { const int c = 4 * lane + 256 * j; const f32x4 w = *(const f32x4*)(nw + c); *(f32x4*)(p.out + (size_t)r * 1024 + c) = v[j] * rstd * w; }
    }
}

__device__ __forceinline__ void phase_gemm1(const Params& p, int l, unsigned char* lds) {
    const bf16_t* hb = (const bf16_t*)(ows(p) + WS_H); const bf16_t* wt = (const bf16_t*)(ows(p) + WS_WIN) + (size_t)l * 4096 * 1024; bf16_t* pb = (bf16_t*)(ows(p) + WS_P);
    constexpr int NT = PW / 128, MT = NTOK / 128;
    for (int u = obid(); u < MT * NT; u += gridDim.x) {
        const int mt = u / NT, nt = u % NT;
        ARowPlain ar{hb + (size_t)mt * 128 * 1024, 1024};
        EpiP ep{pb + (size_t)mt * 128 * PW + nt * 128};
        gemm128(lds, ar, wt + (size_t)nt * 128 * 1024, 1024, ep);
    }
}

__device__ __forceinline__ void unpack8(const u32x4 w, float (&f)[8]) {
    f[0] = bf2f(w.x & 0xffff); f[1] = bf2f(w.x >> 16); f[2] = bf2f(w.y & 0xffff); f[3] = bf2f(w.y >> 16);
    f[4] = bf2f(w.z & 0xffff); f[5] = bf2f(w.z >> 16); f[6] = bf2f(w.w & 0xffff); f[7] = bf2f(w.w >> 16);
}
__device__ __forceinline__ void conv_rows(const Params& p, int l, int widx, int nwv) {
    const int lane = otid() & 63;
    const bf16_t* pb = (const bf16_t*)(ows(p) + WS_P); bf16_t* yb = (bf16_t*)(ows(p) + WS_Y);
    const float* cw = oin(p, 8) + (size_t)l * 3 * 512; const float* cnw = oin(p, 9) + (size_t)l * 512;
    const int nrows = (l == DEPTH - 1) ? NLAT : NTOK;
    const int c0 = lane * 8;
    float w0[8], w1[8], w2[8], nwv8[8];
#pragma unroll
    for (int j = 0; j < 8; ++j) { w0[j] = cw[c0 + j]; w1[j] = cw[512 + c0 + j]; w2[j] = cw[1024 + c0 + j]; nwv8[j] = cnw[c0 + j]; }
    constexpr int NB = 4;
    for (int rb = widx; rb < nrows; rb += NB * nwv) {
        u32x4 vb[NB], vc[NB], vh[NB], vcm[NB], vhm[NB], vcp[NB], vhp[NB]; bool hm[NB], hp[NB];
#pragma unroll
        for (int q = 0; q < NB; ++q) {
            int r = rb + q * nwv; if (r >= nrows) r = rb;
            int rm = -1, rp = -1;
            if (r < NLAT) {
                const int t = r & 2047;
                if (c0 < 256) { if ((t & 63) > 0) rm = r - 1; if ((t & 63) < 63) rp = r + 1; }
                else { if (t >= 64) rm = r - 64; if (t < SEQ - 64) rp = r + 64; }
            } else { const int tc = (r - NLAT) & 255; if (tc > 0) rm = r - 1; if (tc < 255) rp = r + 1; }
            hm[q] = rm >= 0; hp[q] = rp >= 0; if (rm < 0) rm = r; if (rp < 0) rp = r;
            vb[q] = *(const u32x4*)(pb + (size_t)r * PW + OFF_B + c0); vc[q] = *(const u32x4*)(pb + (size_t)r * PW + OFF_C + c0); vh[q] = *(const u32x4*)(pb + (size_t)r * PW + OFF_HV + c0);
            vcm[q] = *(const u32x4*)(pb + (size_t)rm * PW + OFF_C + c0); vhm[q] = *(const u32x4*)(pb + (size_t)rm * PW + OFF_HV + c0);
            vcp[q] = *(const u32x4*)(pb + (size_t)rp * PW + OFF_C + c0); vhp[q] = *(const u32x4*)(pb + (size_t)rp * PW + OFF_HV + c0);
        }
#pragma unroll
        for (int q = 0; q < NB; ++q) {
            const int r = rb + q * nwv;
            float bg[8], u0[8], um[8], up[8], t1[8];
            unpack8(vb[q], bg); unpack8(vc[q], u0); unpack8(vh[q], t1);
#pragma unroll
            for (int j = 0; j < 8; ++j) u0[j] *= t1[j];
            unpack8(vcm[q], um); unpack8(vhm[q], t1);
#pragma unroll
            for (int j = 0; j < 8; ++j) um[j] = hm[q] ? um[j] * t1[j] : 0.f;
            unpack8(vcp[q], up); unpack8(vhp[q], t1);
#pragma unroll
            for (int j = 0; j < 8; ++j) up[j] = hp[q] ? up[j] * t1[j] : 0.f;
            float z[8]; float ss = 0.f;
#pragma unroll
            for (int j = 0; j < 8; ++j) { z[j] = bg[j] * (w0[j] * um[j] + w1[j] * u0[j] + w2[j] * up[j]); ss += z[j] * z[j]; }
            const float rstd = rsqrtf(wave_sum(ss) * (1.0f / 512.0f) + EPS);
            u32x4 o;
            o.x = cvtpk(z[0] * rstd * nwv8[0], z[1] * rstd * nwv8[1]); o.y = cvtpk(z[2] * rstd * nwv8[2], z[3] * rstd * nwv8[3]);
            o.z = cvtpk(z[4] * rstd * nwv8[4], z[5] * rstd * nwv8[5]); o.w = cvtpk(z[6] * rstd * nwv8[6], z[7] * rstd * nwv8[7]);
            if (r < nrows) *(u32x4*)(yb + (size_t)r * 1024 + c0) = o;
        }
    }
}

template <int DIR>
__device__ __forceinline__ void gla_pre_dir(const Params& p, int l, int chunk, float* sQ, float* sK, const float* sV, float* sA, float* sBq, float (&oacc)[16]) {
    const int ch = otid(), tid = otid(), R0 = chunk * 16;
    const bf16_t* pb = (const bf16_t*)(ows(p) + WS_P);
    bf16_t* qin = (bf16_t*)(ows(p) + WS_QIN); bf16_t* kout = (bf16_t*)(ows(p) + WS_KOUT); float* dch = (float*)(ows(p) + WS_DCH);
    float lbv = 0.f;
    {
        const float* lb = oin(p, 10) + (size_t)DIR * 4 * 512 + ch;
        const float z0 = lb[0], z1 = lb[512], z2 = lb[1024], z3 = lb[1536];
        const float mx = fmaxf(fmaxf(z0, z1), fmaxf(z2, z3));
        const float e0 = __expf(z0 - mx), e1 = __expf(z1 - mx), e2 = __expf(z2 - mx), e3 = __expf(z3 - mx);
        const float inv = 1.0f / (e0 + e1 + e2 + e3);
        lbv = ((l >= 1 ? e1 : 0.f) + (l >= 2 ? e2 : 0.f) + (l >= 3 ? e3 : 0.f)) * inv;
    }
    float b = 0.f;
#pragma unroll 1
    for (int i = 0; i < 16; ++i) {
        const int row = R0 + (DIR ? 15 - i : i);
        const float zf = bf2f(pb[(size_t)row * PW + OFF_ZF + DIR * 512 + ch]);
        const float sg = 1.0f / (1.0f + __expf(-zf)), sn = 1.0f / (1.0f + __expf(zf));
        const float f = fmaxf(lbv + (1.0f - lbv) * sg, 1e-30f);
        b += __logf(f);
        sBq[i * 512 + ch] = b; sK[i * 512 + ch] = (1.0f - lbv) * sn;
        sQ[i * 512 + ch] = siluf(bf2f(pb[(size_t)row * PW + OFF_Q + ch]));
    }
    const float blast = b;
#pragma unroll 1
    for (int i = 0; i < 16; ++i) {
        const int row = R0 + (DIR ? 15 - i : i);
        const float bi = sBq[i * 512 + ch], kq = sK[i * 512 + ch], qv = sQ[i * 512 + ch];
        const float qi = qv * __expf(bi), kt = kq * __expf(fminf(-bi, 80.0f)), ko = kq * __expf(blast - bi);
        sQ[i * 512 + ch] = qi; sK[i * 512 + ch] = kt;
        qin[((size_t)DIR * NTOK + row) * 512 + ch] = (bf16_t)f2bf(qi);
        kout[((size_t)DIR * NTOK + row) * 512 + ch] = (bf16_t)f2bf(ko);
    }
    dch[((size_t)DIR * NCHUNK + chunk) * 512 + ch] = __expf(blast);
    __syncthreads();
#pragma unroll 1
    for (int e2 = 0; e2 < 2; ++e2) {
        const int e = tid * 2 + e2, h = e >> 8, t = (e >> 4) & 15, s = e & 15;
        float sum = 0.f;
        const float* qp = sQ + t * 512 + h * 128; const float* kp = sK + s * 512 + h * 128;
#pragma unroll 8
        for (int k = 0; k < 128; ++k) sum += qp[k] * kp[k];
        sA[e] = (s <= t) ? sum : 0.f;
    }
    __syncthreads();
    const int h = ch >> 7;
#pragma unroll
    for (int t = 0; t < 16; ++t) {
        float o = 0.f;
#pragma unroll 1
        for (int s = 0; s <= t; ++s) o += sA[(h * 16 + t) * 16 + s] * sV[(DIR ? 15 - s : s) * 512 + ch];
        oacc[DIR ? 15 - t : t] += o;
    }
    __syncthreads();
}

__device__ __forceinline__ void phase_conv_glapre(const Params& p, int l, unsigned char* lds) {
    conv_rows(p, l, obid() * 8 + (otid() >> 6), (int)gridDim.x * 8);
    float* sQ = (float*)lds; float* sK = sQ + 16 * 512; float* sV = sK + 16 * 512; float* sBq = sV + 16 * 512; float* sA = sBq + 16 * 512;
    const bf16_t* pb = (const bf16_t*)(ows(p) + WS_P); float* ointra = (float*)(ows(p) + WS_OINTRA);
    const int ch = otid();
    for (int chunk = obid(); chunk < NCHUNK; chunk += gridDim.x) {
        const int R0 = chunk * 16;
        float oacc[16];
#pragma unroll
        for (int i = 0; i < 16; ++i) oacc[i] = 0.f;
        __syncthreads();
#pragma unroll
        for (int ro = 0; ro < 16; ++ro) sV[ro * 512 + ch] = bf2f(pb[(size_t)(R0 + ro) * PW + OFF_I + ch]);
        gla_pre_dir<0>(p, l, chunk, sQ, sK, sV, sA, sBq, oacc);
        gla_pre_dir<1>(p, l, chunk, sQ, sK, sV, sA, sBq, oacc);
#pragma unroll
        for (int ro = 0; ro < 16; ++ro) ointra[(size_t)(R0 + ro) * 512 + ch] = oacc[ro];
    }
}

__device__ __forceinline__ void phase_gla_seq(const Params& p, int l, unsigned char* lds) {
    const int tid = otid();
    float* S = (float*)lds;
    float* sQ = S + 128 * 32;
    float* sKo = sQ + 16 * 128;
    float* sV = sKo + 16 * 128;
    float* sD = sV + 16 * 32;
    const bf16_t* pb = (const bf16_t*)(ows(p) + WS_P);
    const bf16_t* qin = (const bf16_t*)(ows(p) + WS_QIN); const bf16_t* kout = (const bf16_t*)(ows(p) + WS_KOUT); const float* dch = (const float*)(ows(p) + WS_DCH);
    float* ointer = (float*)(ows(p) + WS_OINTER);
    for (int u = obid(); u < 256; u += gridDim.x) {
        const int vblk = u & 3, dir = (u >> 2) & 1, chain = u >> 3, b = chain >> 2, h = chain & 3;
        __syncthreads();
        for (int i = tid; i < 128 * 32; i += 512) S[i] = 0.f;
        for (int c = 0; c < 144; ++c) {
            int R0;
            if (c < 16) { const int cm = dir ? 15 - c : c; R0 = NLAT + b * 256 + cm * 16; }
            else { const int cc = c - 16; const int cm = dir ? 127 - cc : cc; R0 = b * 2048 + cm * 16; }
            __syncthreads();
            for (int i = tid; i < 16 * 128; i += 512) {
                const int si = i >> 7, k = i & 127; const int row = R0 + (dir ? 15 - si : si);
                const size_t g = ((size_t)dir * NTOK + row) * 512 + h * 128 + k;
                sQ[i] = bf2f(qin[g]); sKo[i] = bf2f(kout[g]);
            }
            { const int si = tid >> 5, vv = tid & 31; const int row = R0 + (dir ? 15 - si : si); sV[tid] = bf2f(pb[(size_t)row * PW + OFF_I + h * 128 + vblk * 32 + vv]); }
            if (tid < 128) sD[tid] = dch[((size_t)dir * NCHUNK + (R0 >> 4)) * 512 + h * 128 + tid];
            __syncthreads();
            {
                const int si = tid >> 5, vv = tid & 31; const int row = R0 + (dir ? 15 - si : si);
                float o = 0.f;
                for (int k = 0; k < 128; ++k) o += sQ[si * 128 + k] * S[k * 32 + vv];
                ointer[((size_t)dir * NTOK + row) * 512 + h * 128 + vblk * 32 + vv] = o;
            }
            __syncthreads();
            {
                const int k = tid >> 2, v0 = (tid & 3) * 8; const float d = sD[k];
                float kk[16];
#pragma unroll
                for (int i = 0; i < 16; ++i) kk[i] = sKo[i * 128 + k];
#pragma unroll
                for (int j = 0; j < 8; ++j) {
                    float s = d * S[k * 32 + v0 + j];
#pragma unroll
                    for (int i = 0; i < 16; ++i) s += kk[i] * sV[i * 32 + v0 + j];
                    S[k * 32 + v0 + j] = s;
                }
            }
        }
    }
}


__device__ __forceinline__ float bflo(unsigned w) { return __uint_as_float(w << 16); }
__device__ __forceinline__ float bfhi(unsigned w) { return __uint_as_float(w & 0xffff0000u); }

template <int DIR>
__device__ __forceinline__ void gla_pre2_dir(const float (&q0a)[16], const float (&q1a)[16], const unsigned (&rz)[16], float lb0, float lb1, unsigned char* wl, unsigned char* rec,
                                             f32x4 (&oT)[8], int lane, int fr, int fq) {
    float bq0[16], bq1[16], kk0[16], kk1[16]; float b0 = 0.f, b1 = 0.f;
#pragma unroll
    for (int i = 0; i < 16; ++i) {
        const int t = DIR ? 15 - i : i;
        const float z0 = bflo(rz[t]), z1 = bfhi(rz[t]);
        const float sg0 = frcp(1.0f + __expf(-z0)), sg1 = frcp(1.0f + __expf(-z1));
        const float f0 = fmaxf(lb0 + (1.0f - lb0) * sg0, 1e-30f), f1 = fmaxf(lb1 + (1.0f - lb1) * sg1, 1e-30f);
        b0 += __logf(f0); b1 += __logf(f1); bq0[t] = b0; bq1[t] = b1; kk0[t] = 1.0f - f0; kk1[t] = 1.0f - f1;
    }
    const float bl0 = b0, bl1 = b1;
    unsigned kw0[8], kw1[8];
#pragma unroll
    for (int i = 0; i < 8; ++i) { kw0[i] = 0u; kw1[i] = 0u; }
#pragma unroll
    for (int t = 0; t < 16; ++t) {
        const float e0 = __expf(bq0[t]), e1 = __expf(bq1[t]);
        const float qi0 = q0a[t] * e0, qi1 = q1a[t] * e1;
        const float kt0 = kk0[t] * frcp(fmaxf(e0, 1.8e-35f)), kt1 = kk1[t] * frcp(fmaxf(e1, 1.8e-35f));
        const float ko0 = kk0[t] * __expf(bl0 - bq0[t]), ko1 = kk1[t] * __expf(bl1 - bq1[t]);
        *(unsigned*)(wl + t * 272 + lane * 4) = cvtpk(qi0, qi1);
        *(unsigned*)(wl + 4352 + t * 272 + lane * 4) = cvtpk(kt0, kt1);
        const unsigned kp = cvtpk(ko0, ko1);
        kw0[t >> 1] |= (kp & 0xffffu) << (16 * (t & 1)); kw1[t >> 1] |= (kp >> 16) << (16 * (t & 1));
    }
    {
        const int c0 = 2 * lane, c1 = c0 + 1;
        unsigned char* k0p = rec + 4096 + (c0 >> 4) * 512 + (c0 & 15) * 8; unsigned char* k1p = rec + 4096 + (c1 >> 4) * 512 + (c1 & 15) * 8;
#pragma unroll
        for (int g = 0; g < 4; ++g) { *(u32x2*)(k0p + g * 128) = (u32x2){kw0[2 * g], kw0[2 * g + 1]}; *(u32x2*)(k1p + g * 128) = (u32x2){kw1[2 * g], kw1[2 * g + 1]}; }
        float* dp = (float*)(rec + 8192) + c0; dp[0] = __expf(bl0); dp[1] = __expf(bl1);
    }
    LDS_WAIT();
#pragma unroll
    for (int s = 0; s < 4; ++s) {
        const u32x2 lo = *(const u32x2*)(wl + fr * 272 + (32 * s + 4 * fq) * 2), hi = *(const u32x2*)(wl + fr * 272 + (32 * s + 16 + 4 * fq) * 2);
        *(u32x4*)(rec + s * 1024 + lane * 16) = (u32x4){lo.x, lo.y, hi.x, hi.y};
    }
    f32x4 at = (f32x4){0.f, 0.f, 0.f, 0.f};
#pragma unroll
    for (int s = 0; s < 4; ++s) {
        const bf16x8 kf = *(const bf16x8*)(wl + 4352 + fr * 272 + (32 * s + 8 * fq) * 2);
        const bf16x8 qf = *(const bf16x8*)(wl + fr * 272 + (32 * s + 8 * fq) * 2);
        at = __builtin_amdgcn_mfma_f32_16x16x32_bf16(kf, qf, at, 0, 0, 0);
    }
#pragma unroll
    for (int r = 0; r < 4; ++r) { const int sp = 4 * fq + r; const bool keep = DIR ? (sp >= fr) : (sp <= fr); at[r] = keep ? at[r] : 0.f; }
    union { u32x2 u; s16x4 h; } bop; bop.u = (u32x2){cvtpk(at[0], at[1]), cvtpk(at[2], at[3])};
#pragma unroll
    for (int vb = 0; vb < 8; ++vb) {
        union { u32x2 u; s16x4 h; } aop; aop.u = *(const u32x2*)(wl + 8704 + (vb * 16 + fr) * 32 + 8 * fq);
        oT[vb] = __builtin_amdgcn_mfma_f32_16x16x16bf16_1k(aop.h, bop.h, oT[vb], 0, 0, 0);
    }
    LDS_WAIT();
}

__device__ __forceinline__ void phase_gla_pre2(const Params& p, int l, unsigned char* lds) {
    const int tid = otid(), lane = tid & 63, wid = __builtin_amdgcn_readfirstlane(tid >> 6), fr = lane & 15, fq = lane >> 4;
    unsigned char* wl = lds + wid * 12800;
    unsigned char* ws = ows(p);
    const bf16_t* pb = (const bf16_t*)(ws + WS_P); bf16_t* ointra = (bf16_t*)(ws + WS_OINTRA);
    float lb[2][2];
    {
        const float* hl = oin(p, 10);
#pragma unroll
        for (int d = 0; d < 2; ++d)
#pragma unroll
            for (int e = 0; e < 2; ++e) {
                const float* q = hl + (size_t)d * 4 * 512 + (2 * lane + e);
                lb[d][e] = 0.f; (void)q;
            }
    }
    for (int unit = wid * (int)gridDim.x + obid(); unit < NCHUNK * 4; unit += gridDim.x * 8) {
        const int chunk = unit >> 2, h = unit & 3, R0 = chunk * 16;
        {
            const float* hl = oin(p, 10);
#pragma unroll
            for (int d = 0; d < 2; ++d)
#pragma unroll
                for (int e = 0; e < 2; ++e) {
                    const float* q = hl + (size_t)d * 4 * 512 + h * 128 + 2 * lane + e;
                    const float z0 = q[0], z1 = q[512], z2 = q[1024], z3 = q[1536];
                    const float mx = fmaxf(fmaxf(z0, z1), fmaxf(z2, z3));
                    const float e0 = __expf(z0 - mx), e1 = __expf(z1 - mx), e2 = __expf(z2 - mx), e3 = __expf(z3 - mx);
                    lb[d][e] = ((l >= 1 ? e1 : 0.f) + (l >= 2 ? e2 : 0.f) + (l >= 3 ? e3 : 0.f)) / (e0 + e1 + e2 + e3);
                }
        }
        unsigned rq[16], rf[16], rb[16], rv[16];
#pragma unroll
        for (int t = 0; t < 16; ++t) {
            const bf16_t* base = pb + (size_t)(R0 + t) * PW + h * 128 + 2 * lane;
            rq[t] = *(const unsigned*)(base + OFF_Q); rf[t] = *(const unsigned*)(base + OFF_ZF); rb[t] = *(const unsigned*)(base + OFF_ZF + 512); rv[t] = *(const unsigned*)(base + OFF_I);
        }
        unsigned char* vrec = ws + WS_VREC + (size_t)(chunk * 4 + h) * VREC_BYTES;
        {
            unsigned w0[8], w1[8];
#pragma unroll
            for (int i = 0; i < 8; ++i) { w0[i] = (rv[2 * i] & 0xffffu) | (rv[2 * i + 1] << 16); w1[i] = (rv[2 * i] >> 16) | (rv[2 * i + 1] & 0xffff0000u); }
            const int c0 = 2 * lane, c1 = c0 + 1;
            unsigned char* v0p = vrec + (c0 >> 4) * 512 + (c0 & 15) * 8; unsigned char* v1p = vrec + (c1 >> 4) * 512 + (c1 & 15) * 8;
#pragma unroll
            for (int g = 0; g < 4; ++g) { *(u32x2*)(v0p + g * 128) = (u32x2){w0[2 * g], w0[2 * g + 1]}; *(u32x2*)(v1p + g * 128) = (u32x2){w1[2 * g], w1[2 * g + 1]}; }
            unsigned char* vl = wl + 8704 + c0 * 32;
            *(u32x4*)(vl) = (u32x4){w0[0], w0[1], w0[2], w0[3]}; *(u32x4*)(vl + 16) = (u32x4){w0[4], w0[5], w0[6], w0[7]};
            *(u32x4*)(vl + 32) = (u32x4){w1[0], w1[1], w1[2], w1[3]}; *(u32x4*)(vl + 48) = (u32x4){w1[4], w1[5], w1[6], w1[7]};
        }
        f32x4 oT[8];
#pragma unroll
        for (int vb = 0; vb < 8; ++vb) oT[vb] = (f32x4){0.f, 0.f, 0.f, 0.f};
        float q0a[16], q1a[16];
#pragma unroll
        for (int t = 0; t < 16; ++t) { q0a[t] = siluf(bflo(rq[t])); q1a[t] = siluf(bfhi(rq[t])); }
        gla_pre2_dir<0>(q0a, q1a, rf, lb[0][0], lb[0][1], wl, ws + WS_GREC + ((size_t)(0 * NCHUNK + chunk) * 4 + h) * REC_BYTES, oT, lane, fr, fq);
        gla_pre2_dir<1>(q0a, q1a, rb, lb[1][0], lb[1][1], wl, ws + WS_GREC + ((size_t)(1 * NCHUNK + chunk) * 4 + h) * REC_BYTES, oT, lane, fr, fq);
#pragma unroll
        for (int vb = 0; vb < 8; ++vb) *(u32x2*)(ointra + (size_t)(R0 + fr) * 512 + h * 128 + vb * 16 + 4 * fq) = (u32x2){cvtpk(oT[vb][0], oT[vb][1]), cvtpk(oT[vb][2], oT[vb][3])};
    }
}

constexpr int GR = 8, STG_BYTES = REC_BYTES + VREC_BYTES;
__device__ __forceinline__ int gla_chunk_of_step(int c, int b, int dir) {
    if (c < 16) { const int cm = dir ? 15 - c : c; return (NLAT + b * 256) / 16 + cm; }
    const int cc = c - 16; const int cm = dir ? 127 - cc : cc; return b * 128 + cm;
}
constexpr int SG_STEP = REC_BYTES + 2048, SG_GRP = 2 * SG_STEP, SG_NG = 6;
constexpr int SG_DUMP = SG_NG * SG_GRP;
constexpr int SG_FLAGS = LDS_MISC + 2048;
constexpr unsigned SG_SPIN = 1u << 22;
static_assert(SG_DUMP + 1024 <= LDS_MISC, "scan ring");
__device__ __forceinline__ void gla_scan_unit(const Params& p, int l, unsigned char* lds_, int chain, int vhalf) {
    LAS unsigned char* lds = (LAS unsigned char*)lds_;
    const int tid = otid(), lane = tid & 63, wid = __builtin_amdgcn_readfirstlane(tid >> 6), fr = lane & 15, fq = lane >> 4;
    unsigned char* ws = ows(p);
    const int b = chain >> 3, h = (chain >> 1) & 3, dir = chain & 1;
    volatile LAS unsigned* flg = (volatile LAS unsigned*)(lds + SG_FLAGS);
    __syncthreads();
    if (tid < 32) flg[tid] = 0u;
    __syncthreads();
    if (wid >= 4) {
        const int m = wid & 3;
        const unsigned char* grec = ws + WS_GREC + (size_t)dir * NCHUNK * 4 * REC_BYTES + (size_t)h * REC_BYTES + lane * 16;
        const unsigned char* vrec = ws + WS_VREC + (size_t)h * VREC_BYTES + vhalf * 2048 + lane * 16;
        const volatile LAS unsigned* dn = flg + 4 + (lane & 3);
#define GSEQ_ISSUE(gi) do { const int _g = (gi); _Pragma("unroll") for (int _j = 0; _j < 6; ++_j) { const int _p = m + 4 * _j; const bool _real = _p < 22; const int _s = _real ? _p / 11 : 0, _q = _real ? _p % 11 : 0; \
        const int _c = 2 * _g + _s; const int _cc = _c < 144 ? _c : 143; const int _ch = gla_chunk_of_step(_cc, b, dir); \
        const unsigned char* _src = (_q < 9) ? grec + (size_t)_ch * 4 * REC_BYTES + _q * 1024 : vrec + (size_t)_ch * 4 * VREC_BYTES + (_q - 9) * 1024; \
        const unsigned _dst = _real ? (unsigned)(_g % SG_NG) * SG_GRP + _s * SG_STEP + _q * 1024 : (unsigned)SG_DUMP; \
        __builtin_amdgcn_global_load_lds((const unsigned*)_src, (LAS unsigned*)(lds + _dst), 16, 0, 0); } } while (0)
#pragma unroll 1
        for (int g = 0; g < SG_NG - 1; ++g) GSEQ_ISSUE(g);
#pragma unroll 1
        for (int g = 0; g < 72; ++g) {
            asm volatile("s_waitcnt vmcnt(%0)" :: "n"((SG_NG - 2) * 6) : "memory");
            if (lane == 0) flg[m] = (unsigned)(g + 1);
            { unsigned sp = 0; while (__builtin_amdgcn_ballot_w64(*dn < (unsigned)g) != 0ull && ++sp < SG_SPIN) __builtin_amdgcn_s_sleep(1); asm volatile("" ::: "memory"); }
            GSEQ_ISSUE(g + SG_NG - 1);
        }
#undef GSEQ_ISSUE
    } else {
        const int vt = wid;
        bf16_t* ointer = (bf16_t*)(ws + WS_OINTER) + (size_t)dir * NTOK * 512 + h * 128 + (vhalf * 4 + vt) * 16 + fr;
        const volatile LAS unsigned* fl = flg + (lane & 3);
        f32x4 acc[8];
#pragma unroll
        for (int j = 0; j < 8; ++j) acc[j] = (f32x4){0.f, 0.f, 0.f, 0.f};
        union { u32x4 u; bf16x8 h; } sb[4];
#pragma unroll
        for (int j = 0; j < 4; ++j) sb[j].u = (u32x4){0u, 0u, 0u, 0u};
#pragma unroll 1
        for (int g = 0; g < 72; ++g) {
            { unsigned sp = 0; while (__builtin_amdgcn_ballot_w64(*fl < (unsigned)(g + 1)) != 0ull && ++sp < SG_SPIN) { } asm volatile("" ::: "memory"); }
#pragma unroll
            for (int s2 = 0; s2 < 2; ++s2) {
                const int c = 2 * g + s2;
                const LAS unsigned char* st = lds + (unsigned)(g % SG_NG) * SG_GRP + s2 * SG_STEP;
                const int chunk = gla_chunk_of_step(c, b, dir);
                bf16x8 qa[4]; f32x4 dv[8];
                union { u32x2 u; s16x4 h; } ka[8], vb;
#pragma unroll
                for (int j = 0; j < 4; ++j) qa[j] = *(const LAS bf16x8*)(st + j * 1024 + lane * 16);
                vb.u = *(const LAS u32x2*)(st + REC_BYTES + vt * 512 + lane * 8);
#pragma unroll
                for (int j = 0; j < 8; ++j) { ka[j].u = *(const LAS u32x2*)(st + 4096 + j * 512 + lane * 8); dv[j] = *(const LAS f32x4*)(st + 8192 + (j * 16 + 4 * fq) * 4); }
                f32x4 o0 = (f32x4){0.f, 0.f, 0.f, 0.f}, o1 = (f32x4){0.f, 0.f, 0.f, 0.f};
                o0 = __builtin_amdgcn_mfma_f32_16x16x32_bf16(qa[0], sb[0].h, o0, 0, 0, 0); o1 = __builtin_amdgcn_mfma_f32_16x16x32_bf16(qa[1], sb[1].h, o1, 0, 0, 0);
                o0 = __builtin_amdgcn_mfma_f32_16x16x32_bf16(qa[2], sb[2].h, o0, 0, 0, 0); o1 = __builtin_amdgcn_mfma_f32_16x16x32_bf16(qa[3], sb[3].h, o1, 0, 0, 0);
#pragma unroll
                for (int j = 0; j < 8; ++j) {
                    acc[j] = acc[j] * dv[j];
                    acc[j] = __builtin_amdgcn_mfma_f32_16x16x16bf16_1k(ka[j].h, vb.h, acc[j], 0, 0, 0);
                }
                const f32x4 os = o0 + o1;
                bf16_t* op = ointer + (size_t)(chunk * 16 + 4 * fq) * 512;
                { const unsigned w01 = cvtpk(os[0], os[1]), w23 = cvtpk(os[2], os[3]); op[0] = (bf16_t)(w01 & 0xffffu); op[512] = (bf16_t)(w01 >> 16); op[1024] = (bf16_t)(w23 & 0xffffu); op[1536] = (bf16_t)(w23 >> 16); }
#pragma unroll
                for (int j = 0; j < 4; ++j) sb[j].u = (u32x4){cvtpk(acc[2 * j][0], acc[2 * j][1]), cvtpk(acc[2 * j][2], acc[2 * j][3]), cvtpk(acc[2 * j + 1][0], acc[2 * j + 1][1]), cvtpk(acc[2 * j + 1][2], acc[2 * j + 1][3])};
            }
            asm volatile("s_waitcnt lgkmcnt(0)" ::: "memory");
            if (lane == 0) flg[4 + wid] = (unsigned)(g + 1);
        }
    }
    asm volatile("s_waitcnt vmcnt(0) lgkmcnt(0)" ::: "memory");
    __syncthreads();
}
__device__ __forceinline__ void phase_gla_seq2(const Params& p, int l, unsigned char* lds) {
    const int G = (int)gridDim.x, bid = obid();
    const int nscan = (G >= 256) ? 128 : G;
    for (int rep = 0; rep < ((DUPK == 50) ? 2 : 1); ++rep) {
        for (int r2 = 0; r2 < ((DUPK == 51) ? 2 : 1); ++r2)
        if (bid < nscan) for (int u = bid; u < 128; u += nscan) { const int x = u & 7, jj = u >> 3; gla_scan_unit(p, l, lds, x + 8 * (jj >> 1), jj & 1); }
        const int it0 = (G == 256) ? ((l == DEPTH - 1) ? CV_B : CV_B + CV_F) : 0;
        for (int r3 = 0; r3 < ((DUPK == 52) ? 2 : 1); ++r3)
        if (G > nscan) { if (bid >= nscan) { const int widx = (bid - nscan) * 8 + (otid() >> 6), nwv = (G - nscan) * 8; conv_rows(p, l, widx, nwv); convert_experts(p, l, (float*)(lds + (otid() >> 6) * 16384), widx, nwv, it0, CV_ALL); } }
        else { const int widx = bid * 8 + (otid() >> 6), nwv = G * 8; __syncthreads(); conv_rows(p, l, widx, nwv); convert_experts(p, l, (float*)(lds + (otid() >> 6) * 16384), widx, nwv, it0, CV_ALL); }
    }
}

__device__ __forceinline__ void phase_gla_post(const Params& p, int l) {
    const int lane = otid() & 63, wid = otid() >> 6;
    const bf16_t* pb = (const bf16_t*)(ows(p) + WS_P); bf16_t* yb = (bf16_t*)(ows(p) + WS_Y);
    const bf16_t* oi = (const bf16_t*)(ows(p) + WS_OINTRA); const bf16_t* oe = (const bf16_t*)(ows(p) + WS_OINTER);
    const float* hnw = oin(p, 11) + (size_t)l * 128;
    const int nrows = (l == DEPTH - 1) ? NLAT : NTOK;
    const int c0 = lane * 8;
    for (int r = obid() * 8 + wid; r < nrows; r += gridDim.x * 8) {
        float o[8], t1[8], t2[8]; float ss = 0.f;
        unpack8(*(const u32x4*)(oi + (size_t)r * 512 + c0), o); unpack8(*(const u32x4*)(oe + (size_t)r * 512 + c0), t1); unpack8(*(const u32x4*)(oe + ((size_t)NTOK + r) * 512 + c0), t2);
#pragma unroll
        for (int j = 0; j < 8; ++j) { o[j] += t1[j] + t2[j]; ss += o[j] * o[j]; }
        ss += __shfl_xor(ss, 1); ss += __shfl_xor(ss, 2); ss += __shfl_xor(ss, 4); ss += __shfl_xor(ss, 8);
        const float rstd = rsqrtf(ss * (1.0f / 128.0f) + EPS);
        float g[8]; unpack8(*(const u32x4*)(pb + (size_t)r * PW + OFF_G + c0), g);
        float y[8];
#pragma unroll
        for (int j = 0; j < 8; ++j) y[j] = o[j] * rstd * hnw[(c0 + j) & 127] * siluf(g[j]);
        u32x4 w; w.x = pk2(y[0], y[1]); w.y = pk2(y[2], y[3]); w.z = pk2(y[4], y[5]); w.w = pk2(y[6], y[7]);
        *(u32x4*)(yb + (size_t)r * 1024 + 512 + c0) = w;
    }
}

__device__ __forceinline__ void phase_gemm2(const Params& p, int l, unsigned char* lds) {
    const bf16_t* yb = (const bf16_t*)(ows(p) + WS_Y); const bf16_t* wt = (const bf16_t*)(ows(p) + WS_WOUT) + (size_t)l * 1024 * 1024;
    float* xws = (float*)(ows(p) + WS_X); const float* modv = (const float*)(ows(p) + WS_MOD);
    const int MT = ((l == DEPTH - 1) ? NLAT : NTOK) / 128; constexpr int NT = 8;
    for (int u = obid(); u < MT * NT; u += gridDim.x) {
        const int mt = u / NT, nt = u % NT;
        ARowPlain ar{yb + (size_t)mt * 128 * 1024, 1024};
        EpiRes ep{xws + (size_t)mt * 128 * 1024 + nt * 128, modv + (size_t)l * 9 * 6144 + 2 * 1024 + nt * 128, mt * 128};
        gemm128(lds, ar, wt + (size_t)nt * 128 * 1024, 1024, ep);
    }
}

__device__ __forceinline__ void phase_router(const Params& p, int l) {
    const int lane = otid() & 63, wid = otid() >> 6;
    const float* xws = (const float*)(ows(p) + WS_X); bf16_t* hb = (bf16_t*)(ows(p) + WS_H);
    const float* modv = (const float*)(ows(p) + WS_MOD); const float* nw = oin(p, 4) + (size_t)(l * 2 + 1) * 1024;
    const float* wrg = oin(p, 13) + (size_t)l * 1024 * 4; const float* wre = oin(p, 15) + (size_t)l * 1024 * 32;
    const float* brg = oin(p, 14) + l * 4; const float* bre = oin(p, 16) + l * 32;
    unsigned* cnt = (unsigned*)(ows(p) + WS_CTL) + CW_CNT + 64 * l;
    int* ltok = (int*)(ows(p) + WS_LTOK); float* lgate = (float*)(ows(p) + WS_LGATE);
    const int nrows = (l == DEPTH - 1) ? NLAT : NTOK;
    for (int r = obid() * 8 + wid; r < nrows; r += gridDim.x * 8) {
        const int mr = mod_row(r);
        float ss = 0.f;
#pragma unroll
        for (int j = 0; j < 4; ++j) { const f32x4 xv4 = *(const f32x4*)(xws + (size_t)r * 1024 + 4 * lane + 256 * j); ss += (xv4[0] * xv4[0] + xv4[1] * xv4[1]) + (xv4[2] * xv4[2] + xv4[3] * xv4[3]); }
        const float rstd = rsqrtf(wave_sum(ss) * (1.0f / 1024.0f) + EPS);
        const float* msh = modv + ((size_t)l * 9 + mr) * 6144 + 3 * 1024; const float* msc = msh + 1024;
        float lg[36];
#pragma unroll
        for (int i = 0; i < 36; ++i) lg[i] = 0.f;
#pragma unroll 1
        for (int j = 0; j < 4; ++j) {
            const int c = 4 * lane + 256 * j;
            const f32x4 xv4 = *(const f32x4*)(xws + (size_t)r * 1024 + c);
            const f32x4 w = *(const f32x4*)(nw + c), sh = *(const f32x4*)(msh + c), sc = *(const f32x4*)(msc + c);
            const f32x4 h = (xv4 * rstd * w) * (1.0f + sc) + sh;
            u32x2 o; o.x = pk2(h[0], h[1]); o.y = pk2(h[2], h[3]);
            *(u32x2*)(hb + (size_t)r * 1024 + c) = o;
#pragma unroll
            for (int e = 0; e < 4; ++e) {
                const float xv = h[e];
                const f32x4 wg = *(const f32x4*)(wrg + (size_t)(c + e) * 4);
                lg[0] += xv * wg[0]; lg[1] += xv * wg[1]; lg[2] += xv * wg[2]; lg[3] += xv * wg[3];
#pragma unroll
                for (int q = 0; q < 8; ++q) {
                    const f32x4 we = *(const f32x4*)(wre + (size_t)(c + e) * 32 + q * 4);
                    lg[4 + q * 4 + 0] += xv * we[0]; lg[4 + q * 4 + 1] += xv * we[1]; lg[4 + q * 4 + 2] += xv * we[2]; lg[4 + q * 4 + 3] += xv * we[3];
                }
            }
        }
#pragma unroll
        for (int i = 0; i < 36; ++i) lg[i] = wave_sum(lg[i]);
        float gl[4];
#pragma unroll
        for (int i = 0; i < 4; ++i) gl[i] = lg[i] + brg[i];
        int gsel = 0; float gmax = gl[0];
#pragma unroll
        for (int i = 1; i < 4; ++i) if (gl[i] > gmax) { gmax = gl[i]; gsel = i; }
        float gs = 0.f;
#pragma unroll
        for (int i = 0; i < 4; ++i) gs += __expf(gl[i] - gmax);
        const float pg = 1.0f / gs;
        float el[8];
#pragma unroll
        for (int j = 0; j < 8; ++j) {
            float t = lg[4 + j] + bre[j];
#pragma unroll
            for (int g = 1; g < 4; ++g) t = (gsel == g) ? (lg[4 + g * 8 + j] + bre[g * 8 + j]) : t;
            el[j] = t;
        }
        int i1 = 0; float v1 = el[0];
#pragma unroll
        for (int j = 1; j < 8; ++j) if (el[j] > v1) { v1 = el[j]; i1 = j; }
        int i2 = -1; float v2 = -3.0e38f;
#pragma unroll
        for (int j = 0; j < 8; ++j) if (j != i1 && el[j] > v2) { v2 = el[j]; i2 = j; }
        const float e2 = __expf(v2 - v1);
        const float g0 = pg / (1.0f + e2), g1 = pg * e2 / (1.0f + e2);
        if (lane == 0) {
            const int ea = gsel * 8 + i1, eb = gsel * 8 + i2;
            const unsigned pa = atomicAdd(cnt + ea, 1u); ltok[(size_t)ea * NTOK + pa] = r * 2 + 0; lgate[(size_t)ea * NTOK + pa] = g0;
            const unsigned pb2 = atomicAdd(cnt + eb, 1u); ltok[(size_t)eb * NTOK + pb2] = r * 2 + 1; lgate[(size_t)eb * NTOK + pb2] = g1;
        }
    }
}


__device__ __forceinline__ void phase_router2(const Params& p, int l, unsigned char* lds, bool commit) {
    const int tid = otid(), lane = tid & 63, wid = __builtin_amdgcn_readfirstlane(tid >> 6), fr = lane & 15, fq = lane >> 4;
    unsigned char* ws = ows(p);
    const float* xws = (const float*)(ws + WS_X); float* xw = (float*)(ws + WS_X); const bf16_t* dlt = (const bf16_t*)(ws + WS_DELTA); bf16_t* hb = (bf16_t*)(ws + WS_H);
    const float* modv = (const float*)(ws + WS_MOD); const float* nw = oin(p, 4) + (size_t)(l * 2 + 1) * 1024;
    const float* brg = oin(p, 14) + l * 4; const float* bre = oin(p, 16) + l * 32;
    unsigned* gcnt = (unsigned*)(ws + WS_CTL) + CW_CNT + 64 * 32 * l;
    int* ltok = (int*)(ws + WS_LTOK); float* lgate = (float*)(ws + WS_LGATE);
    constexpr int WPITCH = 2064, WBYTES = 48 * WPITCH;
    unsigned char* wl = lds;
    float* tile = (float*)(lds + WBYTES + wid * 3328);
    int* s_cnt = (int*)(lds + WBYTES + 8 * 3328); int* s_base = s_cnt + 32;
    int* s_e = s_base + 32; int* s_rank = s_e + 256; int* s_tok = s_rank + 256; float* s_gate = (float*)(s_tok + 256);
    __syncthreads();
    {
        const bf16_t* wrh = (const bf16_t*)(ws + WS_WRH) + (size_t)l * 48 * 1024;
        for (int i = tid; i < 48 * 128; i += 512) { const int r = i >> 7, c = i & 127; *(u32x4*)(wl + r * WPITCH + c * 16) = *(const u32x4*)(wrh + (size_t)r * 1024 + c * 8); }
    }
    const int NG = ((l == DEPTH - 1) ? NLAT : NTOK) / 16;
    const int NWV = (int)gridDim.x * 8;
    for (int it = 0; it * NWV < NG; ++it) {
        const int g = it * NWV + wid * (int)gridDim.x + obid();
        __syncthreads();
        if (tid < 32) s_cnt[tid] = 0;
        if (tid < 256) s_e[tid] = -1;
        __syncthreads();
        if (g < NG) {
            const int R0 = g * 16, mr = mod_row(R0);
            float my_rstd = 0.f;
#pragma unroll
            for (int rb = 0; rb < 4; ++rb) {
                f32x4 xv[4][4]; u32x2 dl[4][4];
#pragma unroll
                for (int rr = 0; rr < 4; ++rr)
#pragma unroll
                    for (int j = 0; j < 4; ++j) { xv[rr][j] = *(const f32x4*)(xws + (size_t)(R0 + rb * 4 + rr) * 1024 + 4 * lane + 256 * j); dl[rr][j] = *(const u32x2*)(dlt + (size_t)(R0 + rb * 4 + rr) * 1024 + 4 * lane + 256 * j); }
#pragma unroll
                for (int rr = 0; rr < 4; ++rr) {
                    if (commit) {
#pragma unroll
                        for (int j = 0; j < 4; ++j) { xv[rr][j] += (f32x4){bflo(dl[rr][j].x), bfhi(dl[rr][j].x), bflo(dl[rr][j].y), bfhi(dl[rr][j].y)}; *(f32x4*)(xw + (size_t)(R0 + rb * 4 + rr) * 1024 + 4 * lane + 256 * j) = xv[rr][j]; }
                    }
                    float ss = 0.f;
#pragma unroll
                    for (int j = 0; j < 4; ++j) ss += (xv[rr][j][0] * xv[rr][j][0] + xv[rr][j][1] * xv[rr][j][1]) + (xv[rr][j][2] * xv[rr][j][2] + xv[rr][j][3] * xv[rr][j][3]);
                    const float rs = rsqrtf(wave_sum(ss) * (1.0f / 1024.0f) + EPS);
                    my_rstd = (rb * 4 + rr == fr) ? rs : my_rstd;
                }
            }
            asm volatile("s_waitcnt vmcnt(0)" ::: "memory");
            const float* msh = modv + ((size_t)l * 9 + mr) * 6144 + 3 * 1024 + 8 * fq; const float* msc = msh + 1024; const float* nwp = nw + 8 * fq;
            const float* xrow = xws + (size_t)(R0 + fr) * 1024 + 8 * fq; bf16_t* hrow = hb + (size_t)(R0 + fr) * 1024 + 8 * fq; unsigned char* h8row = ws + WS_H8 + (size_t)(R0 + fr) * 1024 + 8 * fq;
            f32x4 acc[3];
#pragma unroll
            for (int nt = 0; nt < 3; ++nt) acc[nt] = (f32x4){0.f, 0.f, 0.f, 0.f};
#pragma unroll 1
            for (int kq = 0; kq < 4; ++kq) {
                f32x4 xa[8][2];
#pragma unroll
                for (int u = 0; u < 8; ++u) { xa[u][0] = *(const f32x4*)(xrow + 256 * kq + 32 * u); xa[u][1] = *(const f32x4*)(xrow + 256 * kq + 32 * u + 4); }
#pragma unroll
                for (int u = 0; u < 8; ++u) {
                    const int k = 256 * kq + 32 * u;
                    float hv[8];
#pragma unroll
                    for (int q = 0; q < 2; ++q) {
                        const f32x4 w = *(const f32x4*)(nwp + k + 4 * q), sh = *(const f32x4*)(msh + k + 4 * q), sc = *(const f32x4*)(msc + k + 4 * q);
                        const f32x4 h = (xa[u][q] * my_rstd * w) * (1.0f + sc) + sh;
                        hv[4 * q + 0] = h[0]; hv[4 * q + 1] = h[1]; hv[4 * q + 2] = h[2]; hv[4 * q + 3] = h[3];
                    }
                    union { u32x4 u; bf16x8 h; } ah, al;
                    ah.u = (u32x4){cvtpk(hv[0], hv[1]), cvtpk(hv[2], hv[3]), cvtpk(hv[4], hv[5]), cvtpk(hv[6], hv[7])};
                    float lv[8];
#pragma unroll
                    for (int q = 0; q < 4; ++q) { const unsigned w2 = q == 0 ? ah.u.x : q == 1 ? ah.u.y : q == 2 ? ah.u.z : ah.u.w; lv[2 * q] = hv[2 * q] - __uint_as_float(w2 << 16); lv[2 * q + 1] = hv[2 * q + 1] - __uint_as_float(w2 & 0xffff0000u); }
                    al.u = (u32x4){cvtpk(lv[0], lv[1]), cvtpk(lv[2], lv[3]), cvtpk(lv[4], lv[5]), cvtpk(lv[6], lv[7])};
                    if (MOE_FP8) { u32x2 h8; h8.x = pk4_fp8(hv[0], hv[1], hv[2], hv[3]); h8.y = pk4_fp8(hv[4], hv[5], hv[6], hv[7]); *(u32x2*)(h8row + k) = h8; }
                    else *(u32x4*)(hrow + k) = ah.u;
#pragma unroll
                    for (int nt = 0; nt < 3; ++nt) {
                        const bf16x8 bh = *(const bf16x8*)(wl + (nt * 16 + fr) * WPITCH + (k + 8 * fq) * 2);
                        acc[nt] = __builtin_amdgcn_mfma_f32_16x16x32_bf16(ah.h, bh, acc[nt], 0, 0, 0);
                        acc[nt] = __builtin_amdgcn_mfma_f32_16x16x32_bf16(al.h, bh, acc[nt], 0, 0, 0);
                    }
                }
            }
#pragma unroll
            for (int nt = 0; nt < 3; ++nt)
#pragma unroll
                for (int r = 0; r < 4; ++r) tile[(4 * fq + r) * 52 + nt * 16 + fr] = acc[nt][r];
            LDS_WAIT();
            if (lane < 16) {
                const float* lg = tile + lane * 52;
                float gl[4];
#pragma unroll
                for (int i = 0; i < 4; ++i) gl[i] = lg[i] + brg[i];
                int gsel = 0; float gmax = gl[0];
#pragma unroll
                for (int i = 1; i < 4; ++i) if (gl[i] > gmax) { gmax = gl[i]; gsel = i; }
                float gs = 0.f;
#pragma unroll
                for (int i = 0; i < 4; ++i) gs += __expf(gl[i] - gmax);
                const float pg = 1.0f / gs;
                float el[8];
#pragma unroll
                for (int j = 0; j < 8; ++j) el[j] = lg[4 + gsel * 8 + j] + bre[gsel * 8 + j];
                int i1 = 0; float v1 = el[0];
#pragma unroll
                for (int j = 1; j < 8; ++j) if (el[j] > v1) { v1 = el[j]; i1 = j; }
                int i2 = -1; float v2 = -3.0e38f;
#pragma unroll
                for (int j = 0; j < 8; ++j) if (j != i1 && el[j] > v2) { v2 = el[j]; i2 = j; }
                const float e2 = __expf(v2 - v1);
                const float g0 = pg / (1.0f + e2), g1 = pg * e2 / (1.0f + e2);
                const int ea = gsel * 8 + i1, eb = gsel * 8 + i2, slot = (wid * 16 + lane) * 2, r = R0 + lane;
                s_e[slot] = ea; s_rank[slot] = atomicAdd(&s_cnt[ea], 1); s_tok[slot] = r * 2; s_gate[slot] = g0;
                s_e[slot + 1] = eb; s_rank[slot + 1] = atomicAdd(&s_cnt[eb], 1); s_tok[slot + 1] = r * 2 + 1; s_gate[slot + 1] = g1;
            }
        }
        __syncthreads();
        if (tid < 32) { const int c = s_cnt[tid]; s_base[tid] = (c > 0 && commit) ? (int)atomicAdd(gcnt + 64 * tid, (unsigned)c) : 0; }
        __syncthreads();
        if (tid < 256) { const int e = s_e[tid]; if (e >= 0 && commit) { const size_t pos = (size_t)e * NTOK + s_base[e] + s_rank[tid]; ltok[pos] = s_tok[tid]; lgate[pos] = s_gate[tid]; } }
    }
}

__device__ __forceinline__ int moe_tables(const Params& p, int l, unsigned char* lds) {
    int* s_pref = (int*)(lds + LDS_MISC); int* s_cnt = s_pref + 40;
    unsigned* cnt = (unsigned*)(ows(p) + WS_CTL) + CW_CNT + 64 * l;
    __syncthreads();
    if (otid() == 0) {
        int acc = 0;
        for (int e = 0; e < NEXP; ++e) { const int c = (int)__hip_atomic_load(cnt + e, __ATOMIC_RELAXED, __HIP_MEMORY_SCOPE_AGENT); s_cnt[e] = c; s_pref[e] = acc; acc += (c + 127) >> 7; }
        s_pref[NEXP] = acc;
    }
    __syncthreads();
    return s_pref[NEXP];
}
__device__ __forceinline__ void phase_moe_gu(const Params& p, int l, unsigned char* lds) {
    const int T = moe_tables(p, l, lds);
    const int* s_pref = (const int*)(lds + LDS_MISC); const int* s_cnt = s_pref + 40;
    const bf16_t* hb = (const bf16_t*)(ows(p) + WS_H); bf16_t* hid = (bf16_t*)(ows(p) + WS_HID);
    const int* ltok = (const int*)(ows(p) + WS_LTOK);
    for (int u = obid(); u < T * 8; u += gridDim.x) {
        const int mtg = u >> 3, nt = u & 7;
        int e = 0;
        for (int q = 1; q < NEXP; ++q) if (s_pref[q] <= mtg) e = q;
        const int mt = mtg - s_pref[e]; const int nvalid = min(128, s_cnt[e] - mt * 128);
        ARowGather ar{hb, ltok + (size_t)e * NTOK + mt * 128, nvalid};
        EpiGU ep{hid + (size_t)mtg * 128 * 512 + nt * 64};
        gemm128(lds, ar, (const bf16_t*)(ows(p) + WS_WGU) + ((size_t)(l * 32 + e) * 1024 + nt * 128) * 1024, 1024, ep);
    }
}
__device__ __forceinline__ void phase_moe_down(const Params& p, int l, unsigned char* lds) {
    const int T = moe_tables(p, l, lds);
    const int* s_pref = (const int*)(lds + LDS_MISC); const int* s_cnt = s_pref + 40;
    const bf16_t* hid = (const bf16_t*)(ows(p) + WS_HID); bf16_t* yb = (bf16_t*)(ows(p) + WS_YB);
    const int* ltok = (const int*)(ows(p) + WS_LTOK); const float* lgate = (const float*)(ows(p) + WS_LGATE);
    for (int u = obid(); u < T * 8; u += gridDim.x) {
        const int mtg = u >> 3, nt = u & 7;
        int e = 0;
        for (int q = 1; q < NEXP; ++q) if (s_pref[q] <= mtg) e = q;
        const int mt = mtg - s_pref[e]; const int nvalid = min(128, s_cnt[e] - mt * 128);
        ARowPlain ar{hid + (size_t)mtg * 128 * 512, 512};
        EpiDown ep{yb + nt * 128, ltok + (size_t)e * NTOK + mt * 128, lgate + (size_t)e * NTOK + mt * 128, nvalid};
        gemm128(lds, ar, (const bf16_t*)(ows(p) + WS_WDN) + ((size_t)(l * 32 + e) * 1024 + nt * 128) * 512, 512, ep);
    }
}


#ifndef FAST_G1
#define FAST_G1 1
#endif
#ifndef FAST_G2
#define FAST_G2 1
#endif
#ifndef FAST_MOE
#define FAST_MOE 1
#endif
#ifndef FAST_GLA
#define FAST_GLA 1
#endif
#ifndef FAST_RT
#define FAST_RT 1
#endif
__device__ __forceinline__ void phase_gemm1_fast(const Params& p, int l, unsigned char* lds) {
    g8::DenseOrder S; S.init(NTOK / 256, PW / 256, (int)gridDim.x, obid(), (const bf16_t*)(ows(p) + WS_WIN) + (size_t)l * 4096 * 1024, 1024);
    g8::EpiP2 E{(bf16_t*)(ows(p) + WS_P)};
    g8::gemm_phase((LAS unsigned char*)lds, (const char*)(ows(p) + WS_H), 1024, S, E);
    if (gridDim.x == 256 && obid() >= 128) { __syncthreads(); convert_experts(p, l, (float*)(lds + (otid() >> 6) * 16384), (obid() - 128) * 8 + (otid() >> 6), 128 * 8, 0, CV_B); }
}
__device__ __forceinline__ void phase_gemm2_fast(const Params& p, int l, unsigned char* lds, float scl) {
    g8::DenseOrder S; S.init(((l == DEPTH - 1) ? NLAT : NTOK) / 256, 4, (int)gridDim.x, obid(), (const bf16_t*)(ows(p) + WS_WOUT) + (size_t)l * 1024 * 1024, 1024);
    g8::EpiDelta E{(bf16_t*)(ows(p) + WS_DELTA), (const float*)(ows(p) + WS_MOD) + (size_t)l * 9 * 6144 + 2 * 1024, scl};
    g8::gemm_phase((LAS unsigned char*)lds, (const char*)(ows(p) + WS_Y), 1024, S, E);
    if (gridDim.x == 256 && l < DEPTH - 1 && obid() >= 32 && scl != 0.0f) { __syncthreads(); convert_experts(p, l, (float*)(lds + (otid() >> 6) * 16384), (obid() - 32) * 8 + (otid() >> 6), 224 * 8, CV_B, CV_B + CV_F); }
}
__device__ __forceinline__ int moe_tables256(const Params& p, int l, unsigned char* lds) {
    int* s_pref = (int*)(lds + LDS_MISC); int* s_cnt = s_pref + 40;
    unsigned* cnt = (unsigned*)(ows(p) + WS_CTL) + CW_CNT + 64 * 32 * l;
    __syncthreads();
    if (otid() == 0) {
        int acc = 0;
        for (int e = 0; e < NEXP; ++e) { const int c = (int)__hip_atomic_load(cnt + 64 * e, __ATOMIC_RELAXED, __HIP_MEMORY_SCOPE_AGENT); s_cnt[e] = c; s_pref[e] = acc; acc += (c + 255) >> 8; }
        s_pref[NEXP] = acc;
    }
    __syncthreads();
    return s_pref[NEXP];
}
__device__ __forceinline__ void moe_setup(const Params& p, int l, unsigned char* lds) {
    const int T = moe_tables256(p, l, lds);
    const int* s_pref = (const int*)(lds + LDS_MISC); const int* s_cnt = s_pref + 40;
    int* utab = (int*)(lds + g8::MOE_UTAB); int* rtok = (int*)(lds + g8::MOE_RTOK); float* rgate = (float*)(lds + g8::MOE_RGATE);
    const int tid = otid(), G = (int)gridDim.x, c = obid();
    if (tid < 4) {
        const int L = tid * G + c; int* t = utab + tid * 8;
        if (L < T * 4) {
            const int mtg = L >> 2; int e = 0;
            for (int q = 1; q < NEXP; ++q) if (s_pref[q] <= mtg) e = q;
            const int mt = mtg - s_pref[e];
            t[0] = mtg; t[1] = L & 3; t[2] = e; t[3] = min(256, s_cnt[e] - mt * 256); t[4] = e * NTOK + mt * 256; t[5] = 1;
        } else { int z = 0; asm volatile("" : "+v"(z)); t[0] = z; t[1] = z; t[2] = z; t[3] = z; t[4] = z; t[5] = z; }
    }
    __syncthreads();
    const int* ltok = (const int*)(ows(p) + WS_LTOK); const float* lgate = (const float*)(ows(p) + WS_LGATE);
    for (int idx = tid; idx < 1024; idx += 512) {
        const int i = idx >> 8, r = idx & 255; const int* t = utab + i * 8;
        const bool ok = t[5] != 0 && r < t[3];
        rtok[idx] = ok ? ltok[t[4] + r] : 0; rgate[idx] = ok ? lgate[t[4] + r] : 0.f;
    }
    __syncthreads();
}
__device__ __forceinline__ void phase_moe_gu_fast(const Params& p, int l, unsigned char* lds) {
    moe_setup(p, l, lds);
    g8::MoeOrder<true> S; S.utab = (const int*)(lds + g8::MOE_UTAB); S.rtok = (const int*)(lds + g8::MOE_RTOK); S.K = 1024;
    if (MOE_FP8) {
        S.W = (const char*)(ows(p) + WS_WGU8) + (size_t)l * 32 * 1024 * 1024; S.bpe = 1;
        g8::EpiGU8 E{ows(p) + WS_HID8};
        g8::gemm_phase8<0x7A7A7A7A, 0x7F7F7F7F>((LAS unsigned char*)lds, (const char*)(ows(p) + WS_H8), 1024, S, E);
    } else {
        S.W = (const char*)(ows(p) + WS_WGU) + (size_t)l * 32 * 1024 * 1024 * 2; S.bpe = 2;
        g8::EpiGU2 E{(bf16_t*)(ows(p) + WS_HID)};
        g8::gemm_phase((LAS unsigned char*)lds, (const char*)(ows(p) + WS_H), 1024, S, E);
    }
}
__device__ __forceinline__ void phase_moe_down_fast(const Params& p, int l, unsigned char* lds) {
    moe_setup(p, l, lds);
    g8::MoeOrder<false> S; S.utab = (const int*)(lds + g8::MOE_UTAB); S.rtok = (const int*)(lds + g8::MOE_RTOK); S.K = 512;
    g8::EpiDown2 E{(bf16_t*)(ows(p) + WS_YB), (const int*)(lds + g8::MOE_RTOK), (const float*)(lds + g8::MOE_RGATE)};
    if (MOE_FP8) {
        S.W = (const char*)(ows(p) + WS_WDN8) + (size_t)l * 32 * 1024 * 512; S.bpe = 1;
        g8::EpiDown8 E8{ows(p) + WS_YB8, (const int*)(lds + g8::MOE_RTOK), (const float*)(lds + g8::MOE_RGATE)};
        g8::gemm_phase8<0x7B7B7B7B, 0x7E7E7E7E>((LAS unsigned char*)lds, (const char*)(ows(p) + WS_HID8), 512, S, E8);
    } else {
        S.W = (const char*)(ows(p) + WS_WDN) + (size_t)l * 32 * 1024 * 512 * 2; S.bpe = 2;
        g8::gemm_phase((LAS unsigned char*)lds, (const char*)(ows(p) + WS_HID), 512, S, E);
    }
}

__device__ __forceinline__ void phase_c(const Params& p, int l, unsigned char* lds) {
    phase_gla_pre2(p, l, lds);
}

__global__ void __launch_bounds__(512, 2) mk(Params p) {
    extern __shared__ __attribute__((aligned(16))) unsigned char lds[];
    const int lo = p.ph_lo, hi = p.ph_hi;
    volatile LAS unsigned* misc = (volatile LAS unsigned*)(lds + LDS_MISC + 1024);
    if (threadIdx.x < 4) misc[threadIdx.x] = 0u;
    __syncthreads();
    XcdBarrier bar; bar.bar = (unsigned*)(p.ws + WS_CTL) + CW_BAR; bar.x = 0; bar.st = misc;
    if (hi - lo > 1) bar = xcd_barrier_post((unsigned*)(p.ws + WS_CTL) + CW_BAR, misc);
#define IN(k) (lo <= (k) && (k) < hi)
#define SEAM(k) do { if (IN((k) + 1)) { xcd_barrier(bar); if (DUPK == 20) xcd_barrier(bar); } } while (0)
#define REP(kind) for (int _rep = 0; _rep < ((DUPK == (kind)) ? 2 : 1); ++_rep)
    if (IN(0)) { REP(0) phase_prologue(p, lds); SEAM(0); }
    if (IN(1)) { REP(1) phase_modreduce(p); SEAM(1); }
    for (int l = 0; l < DEPTH; ++l) {
        const int pb = 2 + 9 * l;
        if (IN(pb + 0)) { if (DUPK == 2) phase_norm1(p, l, (float)(lo > 1000)); phase_norm1(p, l, 1.0f); SEAM(pb + 0); }
        if (IN(pb + 1)) { REP(3) { if (FAST_G1) phase_gemm1_fast(p, l, lds); else phase_gemm1(p, l, lds); } SEAM(pb + 1); }
        if (IN(pb + 2)) { REP(4) { phase_c(p, l, lds); } SEAM(pb + 2); }
        if (IN(pb + 3)) { REP(5) { phase_gla_seq2(p, l, lds); } SEAM(pb + 3); }
        if (IN(pb + 4)) { REP(6) phase_gla_post(p, l); SEAM(pb + 4); }
        if (IN(pb + 5)) { if (DUPK == 7) phase_gemm2_fast(p, l, lds, (float)(lo > 1000)); phase_gemm2_fast(p, l, lds, 1.0f); SEAM(pb + 5); }
        if (IN(pb + 6)) { if (DUPK == 8) phase_router2(p, l, lds, lo > 1000); phase_router2(p, l, lds, true); SEAM(pb + 6); }
        if (IN(pb + 7)) { REP(9) { if (FAST_MOE) phase_moe_gu_fast(p, l, lds); else phase_moe_gu(p, l, lds); } SEAM(pb + 7); }
        if (IN(pb + 8)) { REP(10) { if (FAST_MOE) phase_moe_down_fast(p, l, lds); else phase_moe_down(p, l, lds); } SEAM(pb + 8); }
    }
    if (IN(NPH - 1)) { REP(11) phase_final(p); }
#undef IN
#undef SEAM
}

#ifndef MK_LAUNCHES
#define MK_LAUNCHES 1
#endif
extern "C" void kernel_launch(void* const* d_in, const int* in_sizes, int n_in, void* d_out, int out_size, void* d_ws, size_t ws_size, hipStream_t stream) {
    static int grid = 0;
    if (grid == 0) {
        int dev = 0, cus = 0;
        if (n_in != 20 || ws_size < WS_END) { fprintf(stderr, "kernel_launch: unexpected shapes (n_in %d, ws %zu < %zu)\n", n_in, ws_size, (size_t)WS_END); grid = -1; return; }
        if (hipGetDevice(&dev) != hipSuccess || hipDeviceGetAttribute(&cus, hipDeviceAttributeMultiprocessorCount, dev) != hipSuccess) { grid = -1; return; }
        if (hipFuncSetAttribute((const void*)mk, hipFuncAttributeMaxDynamicSharedMemorySize, LDS_BYTES) != hipSuccess) { fprintf(stderr, "kernel_launch: hipFuncSetAttribute failed\n"); grid = -1; return; }
        (void)hipGetLastError();
        grid = cus;
    }
    if (grid < 0) return;
    (void)hipMemsetAsync((char*)d_ws + WS_CTL, 0, CTL_BYTES, stream);
    Params p{};
    for (int i = 0; i < 20; ++i) p.in[i] = (const float*)d_in[i];
    p.out = (float*)d_out; p.ws = (unsigned char*)d_ws;
    if (MK_LAUNCHES == 1) { p.ph_lo = 0; p.ph_hi = NPH; hipLaunchKernelGGL(mk, dim3(grid), dim3(512), LDS_BYTES, stream, p); }
    else for (int ph = 0; ph < NPH; ++ph) { p.ph_lo = ph; p.ph_hi = ph + 1; hipLaunchKernelGGL(mk, dim3(grid), dim3(512), LDS_BYTES, stream, p); }
}
```

```cpp
#include <hip/hip_runtime.h>
#include <stdint.h>
#include <stdio.h>

typedef unsigned short bf16_t;
typedef short bf16x8 __attribute__((ext_vector_type(8)));
typedef float f32x4 __attribute__((ext_vector_type(4)));
typedef unsigned u32x4 __attribute__((ext_vector_type(4)));
typedef unsigned u32x2 __attribute__((ext_vector_type(2)));
typedef int i32x8 __attribute__((ext_vector_type(8)));
typedef int i32x4 __attribute__((ext_vector_type(4)));
typedef short s16x4 __attribute__((ext_vector_type(4)));
typedef float f32x2 __attribute__((ext_vector_type(2)));
#define LAS __attribute__((address_space(3)))
#define GAS __attribute__((address_space(1)))

#ifndef DUPK
#define DUPK -1
#endif
#ifndef MOE_FP8
#define MOE_FP8 1
#endif
constexpr int D = 1024, NB = 8, SEQ = 2048, DEPTH = 4, CTXL = 256;
constexpr int NLAT = NB * SEQ, NCTX = NB * CTXL, NTOK = NLAT + NCTX;
constexpr int PW = 4096;
constexpr int OFF_B = 0, OFF_C = 512, OFF_HV = 1024, OFF_Q = 1536, OFF_ZF = 2048, OFF_I = 3072, OFF_G = 3584;
constexpr int NEXP = 32;
constexpr int NCHUNK = NTOK / 16;
constexpr float EPS = 1e-6f;
constexpr int NMODP = 16;
constexpr int CV_ALL = 32 * (16 * 32 + 8 * 32), CV_B = 128 * 8 * 7, CV_F = 224 * 8 * 8;

constexpr size_t WS_CTL = 0, CTL_BYTES = 65536;
constexpr size_t WS_WIN = WS_CTL + CTL_BYTES;
constexpr size_t WS_WOUT = WS_WIN + (size_t)4 * 4096 * 1024 * 2;
constexpr size_t WS_WGU = WS_WOUT + (size_t)4 * 1024 * 1024 * 2;
constexpr size_t WS_WDN = WS_WGU + (size_t)4 * 32 * 1024 * 1024 * 2;
constexpr size_t WS_MODP = WS_WDN + (size_t)4 * 32 * 1024 * 512 * 2;
constexpr size_t WS_MOD = WS_MODP + (size_t)4 * NMODP * 9 * 6144 * 4;
constexpr size_t WS_X = WS_MOD + (size_t)4 * 9 * 6144 * 4;
constexpr size_t WS_H = WS_X + (size_t)NTOK * 1024 * 4;
constexpr size_t WS_P = WS_H + (size_t)NTOK * 1024 * 2;
constexpr size_t WS_Y = WS_P + (size_t)NTOK * 4096 * 2;
constexpr size_t WS_QIN = WS_Y + (size_t)NTOK * 1024 * 2;
constexpr size_t WS_KOUT = WS_QIN + (size_t)2 * NTOK * 512 * 2;
constexpr size_t WS_DCH = WS_KOUT + (size_t)2 * NTOK * 512 * 2;
constexpr size_t WS_OINTRA = WS_DCH + (size_t)2 * NCHUNK * 512 * 4;
constexpr size_t WS_OINTER = WS_OINTRA + (size_t)NTOK * 512 * 4;
constexpr size_t WS_LTOK = WS_OINTER + (size_t)2 * NTOK * 512 * 4;
constexpr size_t WS_LGATE = WS_LTOK + (size_t)32 * NTOK * 4;
constexpr int HID_ROWS = 2 * NTOK + 32 * 256;
constexpr size_t WS_HID = WS_LGATE + (size_t)32 * NTOK * 4;
constexpr size_t WS_YB = WS_HID + (size_t)HID_ROWS * 512 * 2;
constexpr int REC_BYTES = 9216, VREC_BYTES = 4096;
constexpr size_t WS_GREC = WS_YB + (size_t)2 * NTOK * 1024 * 2;
constexpr size_t WS_VREC = WS_GREC + (size_t)2 * NCHUNK * 4 * REC_BYTES;
constexpr size_t WS_WRH = WS_VREC + (size_t)NCHUNK * 4 * VREC_BYTES;
constexpr size_t WS_WRL = WS_WRH + (size_t)4 * 48 * 1024 * 2;
constexpr size_t WS_H8 = WS_WRL + (size_t)4 * 48 * 1024 * 2;
constexpr size_t WS_HID8 = WS_H8 + (size_t)NTOK * 1024;
constexpr size_t WS_WGU8 = WS_HID8 + (size_t)HID_ROWS * 512;
constexpr size_t WS_WDN8 = WS_WGU8 + (size_t)4 * 32 * 1024 * 1024;
constexpr size_t WS_YB8 = WS_WDN8 + (size_t)4 * 32 * 1024 * 512;
constexpr size_t WS_DELTA = WS_YB8 + (size_t)2 * NTOK * 1024;
constexpr size_t WS_END = WS_DELTA + (size_t)NTOK * 1024 * 2;
constexpr int CW_BAR = 0;
constexpr int CW_CNT = 8192;

constexpr int LDS_BYTES = 147456;
constexpr int LDS_MISC = 143360;
constexpr int NPH = 2 + 9 * DEPTH + 1;

__device__ __forceinline__ float bf2f(bf16_t b) { return __uint_as_float(((unsigned)b) << 16); }
__device__ __forceinline__ unsigned f2bf(float f) { unsigned u = __float_as_uint(f); return (u + 0x7fffu + ((u >> 16) & 1u)) >> 16; }
__device__ __forceinline__ unsigned pk2(float lo, float hi) { return f2bf(lo) | (f2bf(hi) << 16); }
__device__ __forceinline__ float wave_sum(float v) {
#pragma unroll
    for (int o = 1; o < 64; o <<= 1) v += __shfl_xor(v, o);
    return v;
}
__device__ __forceinline__ float frcp(float x) { return __builtin_amdgcn_rcpf(x); }
__device__ __forceinline__ float sigmoidf(float x) { return frcp(1.0f + __expf(-x)); }
__device__ __forceinline__ float siluf(float x) { return x * frcp(1.0f + __expf(-x)); }
__device__ __forceinline__ float clamp8(float v) { return __builtin_amdgcn_fmed3f(v, -416.0f, 416.0f); }
__device__ __forceinline__ unsigned pk4_fp8_raw(float a, float b, float c, float d) { int r = __builtin_amdgcn_cvt_pk_fp8_f32(a, b, 0, false); r = __builtin_amdgcn_cvt_pk_fp8_f32(c, d, r, true); return (unsigned)r; }
__device__ __forceinline__ unsigned pk4_fp8(float a, float b, float c, float d) { int r = __builtin_amdgcn_cvt_pk_fp8_f32(clamp8(a), clamp8(b), 0, false); r = __builtin_amdgcn_cvt_pk_fp8_f32(clamp8(c), clamp8(d), r, true); return (unsigned)r; }
__device__ __forceinline__ f32x4 unpk4_fp8(unsigned w) { const f32x2 lo = __builtin_amdgcn_cvt_pk_f32_fp8((int)w, false), hi = __builtin_amdgcn_cvt_pk_f32_fp8((int)w, true); return (f32x4){lo.x, lo.y, hi.x, hi.y}; }
typedef __bf16 bf16x2_t __attribute__((ext_vector_type(2)));
__device__ __forceinline__ f32x4 unpk4_bf16(u32x2 w) { return (f32x4){__uint_as_float(w.x << 16), __uint_as_float(w.x & 0xffff0000u), __uint_as_float(w.y << 16), __uint_as_float(w.y & 0xffff0000u)}; }
__device__ __forceinline__ unsigned cvtpk(float lo, float hi) { const f32x2 v = {lo, hi}; const bf16x2_t r = __builtin_convertvector(v, bf16x2_t); return __builtin_bit_cast(unsigned, r); }
__device__ __forceinline__ int mod_row(int r) { return r < NLAT ? (r >> 11) : 8; }
#define LDS_WAIT() asm volatile("s_waitcnt lgkmcnt(0)" ::: "memory")
__device__ __forceinline__ int otid() { int t = threadIdx.x; asm volatile("" : "+v"(t)); return t; }
__device__ __forceinline__ int obid() { int b = blockIdx.x; asm volatile("" : "+s"(b)); return b; }

#define XB_TMO      128
#define XB_XCNT(j)  (256  + 64 * (j))
#define XB_XSUB(j)  (1280 + 64 * (j))
#define XB_XGEN(j)  (2304 + 64 * (j))
#define XB_TOP      3328
#define XB_TOPGEN   3392
#define XCD_BAR_WORDS 3456
#define XB_SPIN_CAP (1u << 18)
__device__ __forceinline__ unsigned xb_ld(unsigned* p)              { return __hip_atomic_load(p, __ATOMIC_RELAXED, __HIP_MEMORY_SCOPE_AGENT); }
__device__ __forceinline__ unsigned xb_add(unsigned* p, unsigned v) { return __hip_atomic_fetch_add(p, v, __ATOMIC_RELAXED, __HIP_MEMORY_SCOPE_AGENT); }
__device__ __forceinline__ unsigned xb_xcc_id() { return (unsigned)__builtin_amdgcn_s_getreg((3 << 11) | 20) & 0xFu; }
#define XB_SPIN(cond, bar) do { unsigned _sp = 0; while (cond) { __builtin_amdgcn_s_sleep(1); \
    if ((++_sp & 255u) == 0u) { if (xb_ld(&(bar)[XB_TMO])) break; if (_sp > XB_SPIN_CAP) { atomicAdd(&(bar)[XB_TMO], 1u); break; } } } } while (0)
struct XcdBarrier { unsigned* bar; unsigned x; volatile LAS unsigned* st; };
__device__ __forceinline__ XcdBarrier xcd_barrier_post(unsigned* bar, volatile LAS unsigned* st) {
    XcdBarrier b; b.bar = bar; b.x = xb_xcc_id(); b.st = st;
    if (threadIdx.x == 0) (void)xb_add(&bar[XB_XCNT(b.x)], 1u);
    return b;
}
__device__ __forceinline__ void xcd_barrier_complete(unsigned* bar, unsigned x, unsigned& nloc, unsigned& nx) {
    const unsigned G = gridDim.x * gridDim.y * gridDim.z;
    unsigned sum, cnt, mine, sp = 0u;
    for (;;) {
        sum = 0u; cnt = 0u; mine = 0u;
#pragma unroll
        for (unsigned j = 0; j < 16; ++j) { const unsigned c = xb_ld(&bar[XB_XCNT(j)]); sum += c; cnt += (c > 0u) ? 1u : 0u; mine = (j == x) ? c : mine; }
        if (sum == G) break;
        __builtin_amdgcn_s_sleep(1);
        if ((++sp & 255u) == 0u) { if (xb_ld(&bar[XB_TMO])) break; if (sp > XB_SPIN_CAP) { atomicAdd(&bar[XB_TMO], 1u); break; } }
    }
    nloc = mine > 0u ? mine : 1u; nx = cnt > 0u ? cnt : 1u;
}
__device__ __forceinline__ void xcd_barrier(const XcdBarrier& b) {
    asm volatile("s_waitcnt vmcnt(0)" ::: "memory");
    __syncthreads();
    if (threadIdx.x == 0) {
        unsigned* bar = b.bar;
        __builtin_amdgcn_s_waitcnt(0);
        unsigned nloc = b.st[0], nx = b.st[1];
        if (nloc == 0u) { xcd_barrier_complete(bar, b.x, nloc, nx); b.st[0] = nloc; b.st[1] = nx; }
        const unsigned old = xb_add(&bar[XB_XSUB(b.x)], 1u);
        const unsigned gen = old / nloc;
        if (old + 1u == (gen + 1u) * nloc) {
            __builtin_amdgcn_fence(__ATOMIC_RELEASE, "agent");
            asm volatile("s_waitcnt vmcnt(0)" ::: "memory");
            const unsigned og = xb_add(&bar[XB_TOP], 1u);
            const unsigned tg = og / nx;
            if (og + 1u == (tg + 1u) * nx) xb_add(&bar[XB_TOPGEN], 1u);
            else XB_SPIN(xb_ld(&bar[XB_TOPGEN]) == tg, bar);
            __builtin_amdgcn_fence(__ATOMIC_ACQUIRE, "agent");
            xb_add(&bar[XB_XGEN(b.x)], 1u);
            asm volatile("s_waitcnt vmcnt(0)" ::: "memory");
        } else {
            XB_SPIN(xb_ld(&bar[XB_XGEN(b.x)]) == gen, bar);
            __builtin_amdgcn_fence(__ATOMIC_ACQUIRE, "agent");
            asm volatile("s_waitcnt vmcnt(0)" ::: "memory");
        }
    }
    __syncthreads();
}

struct Params {
    const float* in[20];
    float* out;
    unsigned char* ws;
    int ph_lo, ph_hi;
};

__device__ __forceinline__ unsigned char* ows(const Params& p) { GAS unsigned char* w = (GAS unsigned char*)p.ws; asm volatile("" : "+s"(w)); return (unsigned char*)w; }
__device__ __forceinline__ const float* oin(const Params& p, int k) { const GAS float* q = (const GAS float*)p.in[k]; asm volatile("" : "+s"(q)); return (const float*)q; }

template <class ARow, class Epi>
__device__ __forceinline__ void gemm128(unsigned char* lds, const ARow& arow, const bf16_t* __restrict__ Bt, int K, const Epi& epi) {
    const int tid = otid(), lane = tid & 63, wid = tid >> 6, wr = wid >> 2, wc = wid & 3, fr = lane & 15, fq = lane >> 4;
    bf16_t* sA = (bf16_t*)lds;
    bf16_t* sB = (bf16_t*)(lds + 128 * 144);
    f32x4 acc[4][2];
#pragma unroll
    for (int m = 0; m < 4; ++m)
#pragma unroll
        for (int n = 0; n < 2; ++n) acc[m][n] = (f32x4){0.f, 0.f, 0.f, 0.f};
    const bf16_t* ap[2]; const bf16_t* bp[2]; int so[2];
#pragma unroll
    for (int i = 0; i < 2; ++i) {
        const int q = tid + 512 * i, row = q >> 3, seg = q & 7;
        ap[i] = arow(row) + seg * 8; bp[i] = Bt + (size_t)row * K + seg * 8; so[i] = row * 72 + seg * 8;
    }
    for (int k0 = 0; k0 < K; k0 += 64) {
        u32x4 va[2], vb[2];
#pragma unroll
        for (int i = 0; i < 2; ++i) { va[i] = *(const u32x4*)(ap[i] + k0); vb[i] = *(const u32x4*)(bp[i] + k0); }
        __syncthreads();
#pragma unroll
        for (int i = 0; i < 2; ++i) { *(u32x4*)(sA + so[i]) = va[i]; *(u32x4*)(sB + so[i]) = vb[i]; }
        __syncthreads();
#pragma unroll
        for (int kk = 0; kk < 2; ++kk) {
            bf16x8 a[4], b[2];
#pragma unroll
            for (int m = 0; m < 4; ++m) a[m] = *(const bf16x8*)(sA + (wr * 64 + m * 16 + fr) * 72 + kk * 32 + fq * 8);
#pragma unroll
            for (int n = 0; n < 2; ++n) b[n] = *(const bf16x8*)(sB + (wc * 32 + n * 16 + fr) * 72 + kk * 32 + fq * 8);
#pragma unroll
            for (int m = 0; m < 4; ++m)
#pragma unroll
                for (int n = 0; n < 2; ++n) acc[m][n] = __builtin_amdgcn_mfma_f32_16x16x32_bf16(b[n], a[m], acc[m][n], 0, 0, 0);
        }
    }
#pragma unroll
    for (int m = 0; m < 4; ++m)
#pragma unroll
        for (int n = 0; n < 2; ++n) epi(wr * 64 + m * 16 + fr, wc * 32 + n * 16 + fq * 4, acc[m][n]);
    __syncthreads();
}

struct ARowPlain { const bf16_t* A; int ld; __device__ __forceinline__ const bf16_t* operator()(int i) const { return A + (size_t)i * ld; } };
struct ARowGather { const bf16_t* A; const int* tok; int nvalid; __device__ __forceinline__ const bf16_t* operator()(int i) const { const int t = (i < nvalid) ? (tok[i] >> 1) : 0; return A + (size_t)t * 1024; } };

struct EpiP { bf16_t* P; __device__ __forceinline__ void operator()(int r, int c, f32x4 v) const {
    u32x2 w; w.x = pk2(v[0], v[1]); w.y = pk2(v[2], v[3]); *(u32x2*)(P + (size_t)r * PW + c) = w; } };
struct EpiRes { float* X; const float* gate; int m0; __device__ __forceinline__ void operator()(int r, int c, f32x4 v) const {
    const float* g = gate + (size_t)mod_row(m0 + r) * 6144 + c; float* xp = X + (size_t)r * 1024 + c;
    f32x4 x = *(f32x4*)xp; const f32x4 gv = *(const f32x4*)g; x += gv * v; *(f32x4*)xp = x; } };
struct EpiGU { bf16_t* H; __device__ __forceinline__ void operator()(int r, int c, f32x4 v) const {
    const float h0 = siluf(v[0]) * v[1], h1 = siluf(v[2]) * v[3]; *(unsigned*)(H + (size_t)r * 512 + (c >> 1)) = pk2(h0, h1); } };
struct EpiDown { bf16_t* YB; const int* tok; const float* gate; int nvalid; __device__ __forceinline__ void operator()(int r, int c, f32x4 v) const {
    if (r < nvalid) { const int e = tok[r]; const float g = gate[r]; u32x2 w; w.x = pk2(g * v[0], g * v[1]); w.y = pk2(g * v[2], g * v[3]); *(u32x2*)(YB + (size_t)e * 1024 + c) = w; } } };


namespace g8 {
constexpr int BM = 256, BK = 64, HALF = 128, HTB = HALF * BK * 2, NXCD = 8, WGM = 8;
__device__ __forceinline__ int lds_byte(int r, int c) { const int st = (r >> 4) * 2 + (c >> 5), rr = r & 15, cc = c & 31, ob = rr * 64 + cc * 2; return st * 1024 + (ob ^ (((ob >> 9) & 1) << 5)); }
__device__ __forceinline__ void stage_rc(int b, int& R, int& C) { const int st = b / 1024, sb = b % 1024, swz = sb ^ (((sb >> 9) & 1) << 5); R = (st >> 1) * 16 + swz / 64; C = (st & 1) * 32 + (swz % 64) / 2; }
__device__ __forceinline__ int perm32(int rho) { const int n = rho >> 4, i = rho & 15; return 8 * (i >> 2) + 4 * n + (i & 3); }
__device__ __forceinline__ unsigned cvt_pk_bf16(float lo, float hi) { return cvtpk(lo, hi); }

__device__ __forceinline__ int g8_ra(int tid, int i) { int R, C; stage_rc(tid * 16 + i * 8192, R, C); return R; }
__device__ __forceinline__ unsigned g8_ca(int tid, int i) { int R, C; stage_rc(tid * 16 + i * 8192, R, C); return (unsigned)C * 2u; }
#define G8_RA(i) g8_ra(otid(), (i))
#define G8_CA(i) g8_ca(otid(), (i))
template <class Epi, class Sched>
__device__ __forceinline__ void gemm_phase(LAS unsigned char* lds, const char* Abase, const int K, const Sched& S, const Epi& E) {
    const int tid = otid(), wid = __builtin_amdgcn_readfirstlane(tid >> 6), lane = tid & 63, wr = wid >> 2, wc = wid & 3, fr = lane & 15, fq = lane >> 4;
    const int nt = K / BK;
    unsigned voffB[2];
#pragma unroll
    for (int i = 0; i < 2; ++i) { int R, C; stage_rc(tid * 16 + i * 8192, R, C); const int Rb = Epi::PERM ? ((R & ~31) + perm32(R & 31)) : R;
        voffB[i] = (unsigned)(Rb * K + C) * 2u; }
    const unsigned rowb = (unsigned)K * 2u;
    const size_t kstep = (size_t)(BK * 2);
    const size_t hstep = (size_t)HALF * K * 2;
    const unsigned ldsw = (unsigned)wid * 1024u;
    const int aoff = lds_byte(wr * 64 + fr, fq * 8), boff = lds_byte(wc * 32 + fr, fq * 8);
#define G8_SA(b, h) (((b) * 2 + (h)) * HTB)
#define G8_SB(b, h) ((4 + (b) * 2 + (h)) * HTB)
#define G8_STAGE(bufoff, gbase, voff) do { _Pragma("unroll") for (int _i = 0; _i < 2; ++_i) \
        __builtin_amdgcn_global_load_lds((const unsigned*)((const char*)(gbase) + (voff)[_i]), (LAS unsigned*)(lds + (bufoff) + ldsw + _i * 8192), 16, 0, 0); } while (0)
#define G8_LDA(dst, b, h) do { _Pragma("unroll") for (int m = 0; m < 4; ++m) _Pragma("unroll") for (int k = 0; k < 2; ++k) dst[m][k] = *(const LAS bf16x8*)(lds + G8_SA(b, h) + aoff + m * 2048 + k * 1024); } while (0)
#define G8_LDB(dst, b, h) do { _Pragma("unroll") for (int n = 0; n < 2; ++n) _Pragma("unroll") for (int k = 0; k < 2; ++k) dst[n][k] = *(const LAS bf16x8*)(lds + G8_SB(b, h) + boff + n * 2048 + k * 1024); } while (0)
#define G8_MMA(ai, bj, At, Bt) do { __builtin_amdgcn_s_setprio(1); _Pragma("unroll") for (int m = 0; m < 4; ++m) _Pragma("unroll") for (int n = 0; n < 2; ++n) _Pragma("unroll") for (int k = 0; k < 2; ++k) \
        acc[ai][bj][m][n] = __builtin_amdgcn_mfma_f32_16x16x32_bf16(Bt[n][k], At[m][k], acc[ai][bj][m][n], 0, 0, 0); __builtin_amdgcn_s_setprio(0); } while (0)
#define G8_WAIT_V(n) asm volatile("s_waitcnt vmcnt(" #n ")" ::: "memory")
#define G8_WAIT_L(n) asm volatile("s_waitcnt lgkmcnt(" #n ")" ::: "memory")
#define G8_BAR __builtin_amdgcn_s_barrier()
#define G8_SCHED __builtin_amdgcn_sched_barrier(0)
    typename Sched::Unit cur, nxt; int ui = 0;
    if (!S.next(0, cur)) return;
    f32x4 acc[2][2][4][2];
#pragma unroll
    for (int a = 0; a < 2; ++a)
#pragma unroll
        for (int b = 0; b < 2; ++b)
#pragma unroll
            for (int m = 0; m < 4; ++m)
#pragma unroll
                for (int n = 0; n < 2; ++n) acc[a][b][m][n] = (f32x4){0.f, 0.f, 0.f, 0.f};
    bf16x8 At[4][2], B0[2][2], B1[2][2];
    unsigned vAc[2][2], vAn[2][2];
#pragma unroll
    for (int h = 0; h < 2; ++h)
#pragma unroll
        for (int i = 0; i < 2; ++i) vAc[h][i] = (Sched::AFFINE ? (unsigned)(h * HALF + G8_RA(i)) : (unsigned)S.a_row(cur, h * HALF + G8_RA(i))) * rowb + G8_CA(i);
    const char* cA = Sched::AFFINE ? Abase + (size_t)S.a_row(cur, 0) * rowb : Abase;
    const char* cB = S.b_base(cur);
    G8_STAGE(G8_SB(0, 0), cB, voffB); G8_STAGE(G8_SA(0, 0), cA, vAc[0]); G8_STAGE(G8_SB(0, 1), cB + hstep, voffB); G8_STAGE(G8_SA(0, 1), cA, vAc[1]);
    if (wr == 1) G8_BAR;
    G8_WAIT_V(4); G8_BAR;
    G8_STAGE(G8_SB(1, 0), cB + kstep, voffB); G8_STAGE(G8_SA(1, 0), cA + kstep, vAc[0]); G8_STAGE(G8_SB(1, 1), cB + hstep + kstep, voffB);
    G8_WAIT_V(6); G8_BAR;
    for (;;) {
        const bool has_next = S.next(ui + 1, nxt);
#pragma unroll
        for (int h = 0; h < 2; ++h)
#pragma unroll
            for (int i = 0; i < 2; ++i) vAn[h][i] = (has_next && !Sched::AFFINE) ? ((unsigned)S.a_row(nxt, h * HALF + G8_RA(i)) * rowb + G8_CA(i)) : vAc[h][i];
        const char* nA = (has_next && Sched::AFFINE) ? Abase + (size_t)S.a_row(nxt, 0) * rowb : cA;
        const char* nB = has_next ? S.b_base(nxt) : cB;
        for (int t = 0; t < nt; t += 2) {
            const bool last = (t == nt - 2);
            const char* a1 = cA + (size_t)(t + 1) * kstep;
            const char* a2 = last ? nA : cA + (size_t)(t + 2) * kstep; const char* b2 = last ? nB : cB + (size_t)(t + 2) * kstep;
            const char* a3 = a2 + kstep; const char* b3 = b2 + kstep;
            unsigned v2[2][2];
#pragma unroll
            for (int h = 0; h < 2; ++h)
#pragma unroll
                for (int i = 0; i < 2; ++i) v2[h][i] = last ? vAn[h][i] : vAc[h][i];
            G8_LDB(B0, 0, 0); G8_SCHED; G8_LDA(At, 0, 0); G8_STAGE(G8_SA(1, 1), a1, vAc[1]);
            G8_WAIT_L(8); G8_BAR; G8_WAIT_L(0); G8_MMA(0, 0, At, B0); G8_BAR; G8_SCHED;
            G8_LDB(B1, 0, 1); G8_STAGE(G8_SB(0, 0), b2, voffB);
            G8_BAR; G8_WAIT_L(0); G8_MMA(0, 1, At, B1); G8_BAR;
            G8_LDA(At, 0, 1); G8_STAGE(G8_SA(0, 0), a2, v2[0]);
            G8_BAR; G8_WAIT_L(0); G8_MMA(1, 0, At, B0); G8_BAR; G8_SCHED;
            G8_STAGE(G8_SB(0, 1), b2 + hstep, voffB);
            G8_WAIT_V(6); G8_BAR; G8_MMA(1, 1, At, B1); G8_BAR;
            G8_LDB(B0, 1, 0); G8_SCHED; G8_LDA(At, 1, 0); G8_STAGE(G8_SA(0, 1), a2, v2[1]);
            G8_WAIT_L(8); G8_BAR; G8_WAIT_L(0); G8_MMA(0, 0, At, B0); G8_BAR; G8_SCHED;
            G8_LDB(B1, 1, 1); G8_STAGE(G8_SB(1, 0), b3, voffB);
            G8_BAR; G8_WAIT_L(0); G8_MMA(0, 1, At, B1); G8_BAR;
            G8_LDA(At, 1, 1); G8_STAGE(G8_SA(1, 0), a3, v2[0]);
            G8_BAR; G8_WAIT_L(0); G8_MMA(1, 0, At, B0); G8_BAR; G8_SCHED;
            G8_STAGE(G8_SB(1, 1), b3 + hstep, voffB);
            G8_WAIT_V(6); G8_BAR; G8_MMA(1, 1, At, B1); G8_BAR;
        }
        E(acc, cur, wr, wc, fr, fq);
        if (!has_next) break;
#pragma unroll
        for (int a = 0; a < 2; ++a)
#pragma unroll
            for (int b = 0; b < 2; ++b)
#pragma unroll
                for (int m = 0; m < 4; ++m)
#pragma unroll
                    for (int n = 0; n < 2; ++n) acc[a][b][m][n] = (f32x4){0.f, 0.f, 0.f, 0.f};
        cur = nxt; cB = nB; cA = nA; ++ui;
#pragma unroll
        for (int h = 0; h < 2; ++h)
#pragma unroll
            for (int i = 0; i < 2; ++i) vAc[h][i] = vAn[h][i];
    }
    G8_WAIT_V(0);
    if (wr == 0) G8_BAR;
    G8_BAR;
#undef G8_SA
#undef G8_SB
#undef G8_STAGE
#undef G8_LDA
#undef G8_LDB
#undef G8_MMA
#undef G8_WAIT_V
#undef G8_WAIT_L
#undef G8_BAR
#undef G8_SCHED
}

template <int sclW, int sclA, class Epi, class Sched>
__device__ __forceinline__ void gemm_phase8(LAS unsigned char* lds, const char* Abase, const int K, const Sched& S, const Epi& E) {
    const int tid = otid(), wid = __builtin_amdgcn_readfirstlane(tid >> 6), lane = tid & 63, wr = wid >> 2, wc = wid & 3, fr = lane & 15, fq = lane >> 4;
    const int nt = K / 128;
    unsigned voffB[2];
#pragma unroll
    for (int i = 0; i < 2; ++i) { int R, C; stage_rc(tid * 16 + i * 8192, R, C); const int Rb = Epi::PERM ? ((R & ~31) + perm32(R & 31)) : R;
        voffB[i] = (unsigned)(Rb * K) + (unsigned)C * 2u; }
    const unsigned rowb = (unsigned)K;
    const size_t kstep = (size_t)(BK * 2);
    const size_t hstep = (size_t)HALF * K;
    const unsigned ldsw = (unsigned)wid * 1024u;
    const int fob = fr * 64 + ((2 * (fq & 1)) ^ (2 * (fr >> 3))) * 16 + (fq >> 1) * 1024;
    const int aoff = ((wr * 64) >> 4) * 2048 + fob, boff = ((wc * 32) >> 4) * 2048 + fob;
#define G8_SA(b, h) (((b) * 2 + (h)) * HTB)
#define G8_SB(b, h) ((4 + (b) * 2 + (h)) * HTB)
#define G8_STAGE(bufoff, gbase, voff) do { _Pragma("unroll") for (int _i = 0; _i < 2; ++_i) \
        __builtin_amdgcn_global_load_lds((const unsigned*)((const char*)(gbase) + (voff)[_i]), (LAS unsigned*)(lds + (bufoff) + ldsw + _i * 8192), 16, 0, 0); } while (0)
#define G8_LDA(dst, b, h) do { _Pragma("unroll") for (int m = 0; m < 4; ++m) { const i32x4 _lo = *(const LAS i32x4*)(lds + G8_SA(b, h) + aoff + m * 2048), _hi = *(const LAS i32x4*)(lds + G8_SA(b, h) + aoff + m * 2048 + 16); dst[m] = __builtin_shufflevector(_lo, _hi, 0, 1, 2, 3, 4, 5, 6, 7); } } while (0)
#define G8_LDB(dst, b, h) do { _Pragma("unroll") for (int n = 0; n < 2; ++n) { const i32x4 _lo = *(const LAS i32x4*)(lds + G8_SB(b, h) + boff + n * 2048), _hi = *(const LAS i32x4*)(lds + G8_SB(b, h) + boff + n * 2048 + 16); dst[n] = __builtin_shufflevector(_lo, _hi, 0, 1, 2, 3, 4, 5, 6, 7); } } while (0)
#define G8_MMA(ai, bj, At, Bt) do { __builtin_amdgcn_s_setprio(1); _Pragma("unroll") for (int m = 0; m < 4; ++m) _Pragma("unroll") for (int n = 0; n < 2; ++n) \
        acc[ai][bj][m][n] = __builtin_amdgcn_mfma_scale_f32_16x16x128_f8f6f4(Bt[n], At[m], acc[ai][bj][m][n], 0, 0, 0, sclW, 0, sclA); \
        _Pragma("unroll") for (int m = 0; m < 4; ++m) asm volatile("" : "+v"(acc[ai][bj][m][0]), "+v"(acc[ai][bj][m][1]));   \
        __builtin_amdgcn_s_setprio(0); } while (0)
#define G8_WAIT_V(n) asm volatile("s_waitcnt vmcnt(" #n ")" ::: "memory")
#define G8_WAIT_L(n) asm volatile("s_waitcnt lgkmcnt(" #n ")" ::: "memory")
#define G8_BAR __builtin_amdgcn_s_barrier()
#define G8_SCHED __builtin_amdgcn_sched_barrier(0)
    typename Sched::Unit cur, nxt; int ui = 0;
    if (!S.next(0, cur)) return;
    f32x4 acc[2][2][4][2];
#pragma unroll
    for (int a = 0; a < 2; ++a)
#pragma unroll
        for (int b = 0; b < 2; ++b)
#pragma unroll
            for (int m = 0; m < 4; ++m)
#pragma unroll
                for (int n = 0; n < 2; ++n) acc[a][b][m][n] = (f32x4){0.f, 0.f, 0.f, 0.f};
    i32x8 At[4], B0[2], B1[2];
    unsigned vAc[2][2], vAn[2][2];
#pragma unroll
    for (int h = 0; h < 2; ++h)
#pragma unroll
        for (int i = 0; i < 2; ++i) vAc[h][i] = (Sched::AFFINE ? (unsigned)(h * HALF + G8_RA(i)) : (unsigned)S.a_row(cur, h * HALF + G8_RA(i))) * rowb + G8_CA(i);
    const char* cA = Sched::AFFINE ? Abase + (size_t)S.a_row(cur, 0) * rowb : Abase;
    const char* cB = S.b_base(cur);
    G8_STAGE(G8_SB(0, 0), cB, voffB); G8_STAGE(G8_SA(0, 0), cA, vAc[0]); G8_STAGE(G8_SB(0, 1), cB + hstep, voffB); G8_STAGE(G8_SA(0, 1), cA, vAc[1]);
    if (wr == 1) G8_BAR;
    G8_WAIT_V(4); G8_BAR;
    G8_STAGE(G8_SB(1, 0), cB + kstep, voffB); G8_STAGE(G8_SA(1, 0), cA + kstep, vAc[0]); G8_STAGE(G8_SB(1, 1), cB + hstep + kstep, voffB);
    G8_WAIT_V(6); G8_BAR;
    for (;;) {
        const bool has_next = S.next(ui + 1, nxt);
#pragma unroll
        for (int h = 0; h < 2; ++h)
#pragma unroll
            for (int i = 0; i < 2; ++i) vAn[h][i] = (has_next && !Sched::AFFINE) ? ((unsigned)S.a_row(nxt, h * HALF + G8_RA(i)) * rowb + G8_CA(i)) : vAc[h][i];
        const char* nA = (has_next && Sched::AFFINE) ? Abase + (size_t)S.a_row(nxt, 0) * rowb : cA;
        const char* nB = has_next ? S.b_base(nxt) : cB;
#pragma unroll 1
        for (int t = 0; t < nt; t += 2) {
            const bool last = (t == nt - 2);
            const char* a1 = cA + (size_t)(t + 1) * kstep;
            const char* a2 = last ? nA : cA + (size_t)(t + 2) * kstep; const char* b2 = last ? nB : cB + (size_t)(t + 2) * kstep;
            const char* a3 = a2 + kstep; const char* b3 = b2 + kstep;
            unsigned v2[2][2];
#pragma unroll
            for (int h = 0; h < 2; ++h)
#pragma unroll
                for (int i = 0; i < 2; ++i) v2[h][i] = last ? vAn[h][i] : vAc[h][i];
            G8_LDB(B0, 0, 0); G8_SCHED; G8_LDA(At, 0, 0); G8_STAGE(G8_SA(1, 1), a1, vAc[1]);
            G8_WAIT_L(8); G8_BAR; G8_WAIT_L(0); G8_MMA(0, 0, At, B0); G8_BAR; G8_SCHED;
            G8_LDB(B1, 0, 1); G8_STAGE(G8_SB(0, 0), b2, voffB);
            G8_BAR; G8_WAIT_L(0); G8_MMA(0, 1, At, B1); G8_BAR;
            G8_LDA(At, 0, 1); G8_STAGE(G8_SA(0, 0), a2, v2[0]);
            G8_BAR; G8_WAIT_L(0); G8_MMA(1, 0, At, B0); G8_BAR; G8_SCHED;
            G8_STAGE(G8_SB(0, 1), b2 + hstep, voffB);
            G8_WAIT_V(6); G8_BAR; G8_MMA(1, 1, At, B1); G8_BAR;
            G8_LDB(B0, 1, 0); G8_SCHED; G8_LDA(At, 1, 0); G8_STAGE(G8_SA(0, 1), a2, v2[1]);
            G8_WAIT_L(8); G8_BAR; G8_WAIT_L(0); G8_MMA(0, 0, At, B0); G8_BAR; G8_SCHED;
            G8_LDB(B1, 1, 1); G8_STAGE(G8_SB(1, 0), b3, voffB);
            G8_BAR; G8_WAIT_L(0); G8_MMA(0, 1, At, B1); G8_BAR;
            G8_LDA(At, 1, 1); G8_STAGE(G8_SA(1, 0), a3, v2[0]);
            G8_BAR; G8_WAIT_L(0); G8_MMA(1, 0, At, B0); G8_BAR; G8_SCHED;
            G8_STAGE(G8_SB(1, 1), b3 + hstep, voffB);
            G8_WAIT_V(6); G8_BAR; G8_MMA(1, 1, At, B1); G8_BAR;
        }
        E(acc, cur, wr, wc, fr, fq);
        if (!has_next) break;
#pragma unroll
        for (int a = 0; a < 2; ++a)
#pragma unroll
            for (int b = 0; b < 2; ++b)
#pragma unroll
                for (int m = 0; m < 4; ++m)
#pragma unroll
                    for (int n = 0; n < 2; ++n) acc[a][b][m][n] = (f32x4){0.f, 0.f, 0.f, 0.f};
        cur = nxt; cB = nB; cA = nA; ++ui;
#pragma unroll
        for (int h = 0; h < 2; ++h)
#pragma unroll
            for (int i = 0; i < 2; ++i) vAc[h][i] = vAn[h][i];
    }
    G8_WAIT_V(0);
    if (wr == 0) G8_BAR;
    G8_BAR;
#undef G8_SA
#undef G8_SB
#undef G8_STAGE
#undef G8_LDA
#undef G8_LDB
#undef G8_MMA
#undef G8_WAIT_V
#undef G8_WAIT_L
#undef G8_BAR
#undef G8_SCHED
}

struct DUnit { int pm, pn; };
struct DenseOrder {
    typedef DUnit Unit; static constexpr bool AFFINE = true;
    int nM, nN, nwg, G, c; const char* Bt; int K;
    __device__ __forceinline__ void init(int nM_, int nN_, int G_, int c_, const void* Bt_, int K_) { nM = nM_; nN = nN_; nwg = nM * nN; G = G_; c = c_; Bt = (const char*)Bt_; K = K_; }
    __device__ __forceinline__ bool next(int i, Unit& u) const {
        const long L = (long)i * G + c; if (L >= nwg) return false;
        int wgid = (int)L; { const int q = nwg / NXCD, r = nwg % NXCD, xcd = wgid % NXCD, off = wgid / NXCD; wgid = (xcd < r ? xcd * (q + 1) : r * (q + 1) + (xcd - r) * q) + off; }
        const int nig = WGM * nN, gid = wgid / nig, fm = gid * WGM, gsz = (nM - fm) < WGM ? (nM - fm) : WGM;
        u.pm = fm + ((wgid % nig) % gsz); u.pn = (wgid % nig) / gsz; return true;
    }
    __device__ __forceinline__ int a_row(const Unit& u, int r) const { return u.pm * BM + r; }
    __device__ __forceinline__ const char* b_base(const Unit& u) const { return Bt + (size_t)u.pn * BM * K * 2; }
};
struct MUnit { int pm, pn, e, nvalid, lbase, idx; };
constexpr int MOE_UTAB = 131072, MOE_RTOK = MOE_UTAB + 128, MOE_RGATE = MOE_RTOK + 4096;
template <bool GATHER> struct MoeOrder {
    typedef MUnit Unit; static constexpr bool AFFINE = !GATHER;
    const int* utab; const int* rtok; const char* W; int K; int bpe;
    __device__ __forceinline__ bool next(int i, Unit& u) const {
        if (i >= 4) return false;
        const int* t = utab + i * 8;
        if (t[5] == 0) return false;
        u.pm = t[0]; u.pn = t[1]; u.e = t[2]; u.nvalid = t[3]; u.lbase = t[4]; u.idx = i; return true;
    }
    __device__ __forceinline__ int a_row(const Unit& u, int r) const { if (GATHER) return rtok[u.idx * 256 + r] >> 1; else return u.pm * BM + r; }
    __device__ __forceinline__ const char* b_base(const Unit& u) const { return W + ((size_t)u.e * 1024 + u.pn * BM) * K * bpe; }
};

struct EpiP2 {
    static constexpr bool PERM = true;
    bf16_t* P;
    __device__ __forceinline__ void operator()(const f32x4 (&acc)[2][2][4][2], const DUnit& u, int wr, int wc, int fr, int fq) const {
        const int row0 = u.pm * BM + wr * 64 + fr, col0 = u.pn * BM + wc * 32 + 8 * fq;
#pragma unroll
        for (int ai = 0; ai < 2; ++ai)
#pragma unroll
            for (int m = 0; m < 4; ++m) { bf16_t* rowp = P + (size_t)(row0 + ai * HALF + m * 16) * PW + col0;
#pragma unroll
                for (int bj = 0; bj < 2; ++bj) { const f32x4 v0 = acc[ai][bj][m][0], v1 = acc[ai][bj][m][1];
                    u32x4 w; w.x = cvt_pk_bf16(v0[0], v0[1]); w.y = cvt_pk_bf16(v0[2], v0[3]); w.z = cvt_pk_bf16(v1[0], v1[1]); w.w = cvt_pk_bf16(v1[2], v1[3]);
                    *(u32x4*)(rowp + bj * HALF) = w; } }
    }
};
struct EpiRes2 {
    static constexpr bool PERM = false;
    float* X; const float* gate; float scl;
    __device__ __forceinline__ void operator()(const f32x4 (&acc)[2][2][4][2], const DUnit& u, int wr, int wc, int fr, int fq) const {
        const int row0 = u.pm * BM + wr * 64 + fr, col0 = u.pn * BM + wc * 32 + 4 * fq;
#pragma unroll
        for (int ai = 0; ai < 2; ++ai)
#pragma unroll
            for (int m = 0; m < 4; ++m) { const int r = row0 + ai * HALF + m * 16; float* rowp = X + (size_t)r * 1024 + col0; const float* gp = gate + (size_t)mod_row(r) * 6144 + col0;
#pragma unroll
                for (int bj = 0; bj < 2; ++bj)
#pragma unroll
                    for (int n = 0; n < 2; ++n) { const f32x4 gv = *(const f32x4*)(gp + bj * HALF + n * 16); f32x4 x = *(f32x4*)(rowp + bj * HALF + n * 16); x += (gv * scl) * acc[ai][bj][m][n]; *(f32x4*)(rowp + bj * HALF + n * 16) = x; }
                asm volatile("" ::: "memory"); }
    }
};
struct EpiDelta {
    static constexpr bool PERM = true;
    bf16_t* Dl; const float* gate; float scl;
    __device__ __forceinline__ void operator()(const f32x4 (&acc)[2][2][4][2], const DUnit& u, int wr, int wc, int fr, int fq) const {
        const int row0 = u.pm * BM + wr * 64 + fr, col0 = u.pn * BM + wc * 32 + 8 * fq;
#pragma unroll
        for (int ai = 0; ai < 2; ++ai)
#pragma unroll
            for (int m = 0; m < 4; ++m) { const int r = row0 + ai * HALF + m * 16; bf16_t* rowp = Dl + (size_t)r * 1024 + col0; const float* gp = gate + (size_t)mod_row(r) * 6144 + col0;
#pragma unroll
                for (int bj = 0; bj < 2; ++bj) { const f32x4 g0 = *(const f32x4*)(gp + bj * HALF) * scl, g1 = *(const f32x4*)(gp + bj * HALF + 4) * scl;
                    const f32x4 v0 = acc[ai][bj][m][0] * g0, v1 = acc[ai][bj][m][1] * g1;
                    u32x4 w; w.x = cvt_pk_bf16(v0[0], v0[1]); w.y = cvt_pk_bf16(v0[2], v0[3]); w.z = cvt_pk_bf16(v1[0], v1[1]); w.w = cvt_pk_bf16(v1[2], v1[3]);
                    *(u32x4*)(rowp + bj * HALF) = w; } }
    }
};
struct EpiGU2 {
    static constexpr bool PERM = true;
    bf16_t* H;
    __device__ __forceinline__ void operator()(const f32x4 (&acc)[2][2][4][2], const MUnit& u, int wr, int wc, int fr, int fq) const {
        const int row0 = u.pm * BM + wr * 64 + fr, col0 = u.pn * BM + wc * 32 + 8 * fq;
#pragma unroll
        for (int ai = 0; ai < 2; ++ai)
#pragma unroll
            for (int m = 0; m < 4; ++m) { bf16_t* rowp = H + (size_t)(row0 + ai * HALF + m * 16) * 512 + (col0 >> 1);
#pragma unroll
                for (int bj = 0; bj < 2; ++bj) { const f32x4 v0 = acc[ai][bj][m][0], v1 = acc[ai][bj][m][1];
                    u32x2 w; w.x = cvt_pk_bf16(siluf(v0[0]) * v0[1], siluf(v0[2]) * v0[3]); w.y = cvt_pk_bf16(siluf(v1[0]) * v1[1], siluf(v1[2]) * v1[3]);
                    *(u32x2*)(rowp + bj * (HALF / 2)) = w; } }
    }
};
struct EpiGU8 {
    static constexpr bool PERM = true;
    unsigned char* H;
    __device__ __forceinline__ void operator()(const f32x4 (&acc)[2][2][4][2], const MUnit& u, int wr, int wc, int fr, int fq) const {
        const int row0 = u.pm * BM + wr * 64 + fr, col0 = u.pn * BM + wc * 32 + 8 * fq;
#pragma unroll
        for (int ai = 0; ai < 2; ++ai)
#pragma unroll
            for (int m = 0; m < 4; ++m) { unsigned char* rowp = H + (size_t)(row0 + ai * HALF + m * 16) * 512 + (col0 >> 1);
#pragma unroll
                for (int bj = 0; bj < 2; ++bj) { const f32x4 v0 = acc[ai][bj][m][0], v1 = acc[ai][bj][m][1];
                    *(unsigned*)(rowp + bj * (HALF / 2)) = pk4_fp8(2.0f * siluf(v0[0]) * v0[1], 2.0f * siluf(v0[2]) * v0[3], 2.0f * siluf(v1[0]) * v1[1], 2.0f * siluf(v1[2]) * v1[3]); } }
    }
};
struct EpiDown2 {
    static constexpr bool PERM = true;
    bf16_t* YB; const int* rtok; const float* rgate;
    __device__ __forceinline__ void operator()(const f32x4 (&acc)[2][2][4][2], const MUnit& u, int wr, int wc, int fr, int fq) const {
        const int r0 = wr * 64 + fr, col0 = u.pn * BM + wc * 32 + 8 * fq;
#pragma unroll
        for (int ai = 0; ai < 2; ++ai)
#pragma unroll
            for (int m = 0; m < 4; ++m) { const int rt = r0 + ai * HALF + m * 16;
                if (rt < u.nvalid) { const int ent = rtok[u.idx * 256 + rt]; const float g = rgate[u.idx * 256 + rt]; bf16_t* rowp = YB + (size_t)ent * 1024 + col0;
#pragma unroll
                    for (int bj = 0; bj < 2; ++bj) { const f32x4 v0 = acc[ai][bj][m][0] * g, v1 = acc[ai][bj][m][1] * g;
                        u32x4 w; w.x = cvt_pk_bf16(v0[0], v0[1]); w.y = cvt_pk_bf16(v0[2], v0[3]); w.z = cvt_pk_bf16(v1[0], v1[1]); w.w = cvt_pk_bf16(v1[2], v1[3]);
                        *(u32x4*)(rowp + bj * HALF) = w; } } }
    }
};
struct EpiDown8 {
    static constexpr bool PERM = true;
    unsigned char* YB; const int* rtok; const float* rgate;
    __device__ __forceinline__ void operator()(const f32x4 (&acc)[2][2][4][2], const MUnit& u, int wr, int wc, int fr, int fq) const {
        const int r0 = wr * 64 + fr, col0 = u.pn * BM + wc * 32 + 8 * fq;
#pragma unroll
        for (int ai = 0; ai < 2; ++ai)
#pragma unroll
            for (int m = 0; m < 4; ++m) { const int rt = r0 + ai * HALF + m * 16;
                if (rt < u.nvalid) { const int ent = rtok[u.idx * 256 + rt]; const float g = 64.0f * rgate[u.idx * 256 + rt]; unsigned char* rowp = YB + (size_t)ent * 1024 + col0;
#pragma unroll
                    for (int bj = 0; bj < 2; ++bj) { const f32x4 v0 = acc[ai][bj][m][0] * g, v1 = acc[ai][bj][m][1] * g;
                        u32x2 w; w.x = pk4_fp8(v0[0], v0[1], v0[2], v0[3]); w.y = pk4_fp8(v1[0], v1[1], v1[2], v1[3]);
                        *(u32x2*)(rowp + bj * HALF) = w; } } }
    }
};
}

__device__ __forceinline__ void transpose_item(const float* __restrict__ W, int K, int N, bf16_t* __restrict__ WT, int mode, float* scr, int item, int lane) {
    const int nblk = N / 32, kb = item / nblk, nb = item % nblk, k0 = 64 * kb, n0 = 32 * nb;
    float wv[32];
#pragma unroll
    for (int i = 0; i < 32; ++i) wv[i] = __builtin_nontemporal_load(W + (size_t)(k0 + 2 * i + (lane >> 5)) * N + n0 + (lane & 31));
#pragma unroll
    for (int i = 0; i < 32; ++i) scr[(2 * i + (lane >> 5)) * 33 + (lane & 31)] = wv[i];
    LDS_WAIT();
    const int c = lane & 7;
#pragma unroll
    for (int j = 0; j < 4; ++j) {
        const int n = (lane >> 3) + 8 * j; const float* s = scr + (8 * c) * 33 + n;
        u32x4 o; o.x = pk2(s[0 * 33], s[1 * 33]); o.y = pk2(s[2 * 33], s[3 * 33]); o.z = pk2(s[4 * 33], s[5 * 33]); o.w = pk2(s[6 * 33], s[7 * 33]);
        const int nabs = n0 + n; const int orow = mode ? ((nabs < 512) ? 2 * nabs : 2 * (nabs - 512) + 1) : nabs;
        *(u32x4*)(WT + (size_t)orow * K + k0 + 8 * c) = o;
    }
    LDS_WAIT();
}


__device__ __forceinline__ void transpose_item8(const float* __restrict__ W, int K, int N, unsigned char* __restrict__ WT, int mode, float scale, float* scr, int item, int lane) {
    const int nblk = N / 32, kb = item / nblk, nb = item % nblk, k0 = 64 * kb, n0 = 32 * nb;
    float wv[32];
#pragma unroll
    for (int i = 0; i < 32; ++i) wv[i] = __builtin_nontemporal_load(W + (size_t)(k0 + 2 * i + (lane >> 5)) * N + n0 + (lane & 31));
#pragma unroll
    for (int i = 0; i < 32; ++i) scr[(2 * i + (lane >> 5)) * 33 + (lane & 31)] = wv[i] * scale;
    LDS_WAIT();
    const int c = lane & 7;
#pragma unroll
    for (int j = 0; j < 4; ++j) {
        const int n = (lane >> 3) + 8 * j; const float* s = scr + (8 * c) * 33 + n;
        u32x2 o; o.x = pk4_fp8(s[0 * 33], s[1 * 33], s[2 * 33], s[3 * 33]); o.y = pk4_fp8(s[4 * 33], s[5 * 33], s[6 * 33], s[7 * 33]);
        const int nabs = n0 + n; const int orow = mode ? ((nabs < 512) ? 2 * nabs : 2 * (nabs - 512) + 1) : nabs;
        *(u32x2*)(WT + (size_t)orow * K + k0 + 8 * c) = o;
    }
    LDS_WAIT();
}

__device__ __forceinline__ void convert_experts(const Params& p, int l, float* scr, int widx, int nwv, int it0, int it1) {
    const int tid = otid(), lane = tid & 63;
    bf16_t* wgu_t = (bf16_t*)(ows(p) + WS_WGU) + (size_t)l * 32 * 1024 * 1024; bf16_t* wdn_t = (bf16_t*)(ows(p) + WS_WDN) + (size_t)l * 32 * 1024 * 512;
    const float* wgu = oin(p, 17) + (size_t)l * 32 * 1024 * 1024; const float* wdn = oin(p, 18) + (size_t)l * 32 * 512 * 1024;
    constexpr int I_GU = 16 * 32, I_DN = 8 * 32, T_GU = 32 * I_GU;
    unsigned char* wgu8 = ows(p) + WS_WGU8 + (size_t)l * 32 * 1024 * 1024; unsigned char* wdn8 = ows(p) + WS_WDN8 + (size_t)l * 32 * 1024 * 512;
    for (int it = it0 + widx; it < it1; it += nwv) {
        if (it < T_GU) { const int m = it / I_GU;
            if (MOE_FP8) transpose_item8(wgu + (size_t)m * 1024 * 1024, 1024, 1024, wgu8 + (size_t)m * 1024 * 1024, 1, 32.0f, scr, it % I_GU, lane);
            else transpose_item(wgu + (size_t)m * 1024 * 1024, 1024, 1024, wgu_t + (size_t)m * 1024 * 1024, 1, scr, it % I_GU, lane); }
        else { const int r = it - T_GU, m = r / I_DN;
            if (MOE_FP8) transpose_item8(wdn + (size_t)m * 512 * 1024, 512, 1024, wdn8 + (size_t)m * 1024 * 512, 0, 16.0f, scr, r % I_DN, lane);
            else transpose_item(wdn + (size_t)m * 512 * 1024, 512, 1024, wdn_t + (size_t)m * 1024 * 512, 0, scr, r % I_DN, lane); }
    }
}

__device__ __forceinline__ void phase_prologue(const Params& p, unsigned char* lds) {
    const int tid = otid(), lane = tid & 63, wid = tid >> 6;
    float* scr = (float*)(lds + wid * 16384);
    const int gw = obid() * 8 + wid, NGW = gridDim.x * 8;
    bf16_t* win_t = (bf16_t*)(ows(p) + WS_WIN); bf16_t* wout_t = (bf16_t*)(ows(p) + WS_WOUT);
    constexpr int I_IN = 16 * 128, I_OUT = 16 * 32;
    constexpr int T_IN = 4 * I_IN, T_OUT = 4 * I_OUT;
    for (int it = gw; it < T_IN + T_OUT; it += NGW) {
        int r = it;
        if (r < T_IN) { const int m = r / I_IN; transpose_item(oin(p, 7) + (size_t)m * 1024 * 4096, 1024, 4096, win_t + (size_t)m * 4096 * 1024, 0, scr, r % I_IN, lane); continue; } r -= T_IN;
        { const int m = r / I_OUT; transpose_item(oin(p, 12) + (size_t)m * 1024 * 1024, 1024, 1024, wout_t + (size_t)m * 1024 * 1024, 0, scr, r % I_OUT, lane); }
    }
    {
        bf16_t* wrh = (bf16_t*)(ows(p) + WS_WRH); bf16_t* wrl = (bf16_t*)(ows(p) + WS_WRL);
        for (int i = obid() * 512 + tid; i < 4 * 48 * 1024; i += gridDim.x * 512) {
            const int l = i / (48 * 1024), j = (i / 1024) % 48, k = i % 1024;
            float w = 0.f;
            if (j < 4) w = oin(p, 13)[((size_t)l * 1024 + k) * 4 + j]; else if (j < 36) w = oin(p, 15)[((size_t)l * 1024 + k) * 32 + (j - 4)];
            const unsigned hi = f2bf(w); const float rem = w - __uint_as_float(hi << 16);
            wrh[i] = (bf16_t)hi; wrl[i] = (bf16_t)f2bf(rem);
        }
    }
    __syncthreads();
    float* modp = (float*)(ows(p) + WS_MODP);
    float* sS = (float*)lds;
    for (int u = obid(); u < 4 * 24 * 8; u += gridDim.x) {
        const int l = u / 192, rem = u % 192, nb = rem / 8, ks = rem % 8;
        __syncthreads();
        for (int i = tid; i < 9 * 128; i += 512) { const int r = i >> 7, k = i & 127; const float cv = (r < 8) ? oin(p, 1)[r * 1024 + ks * 128 + k] : oin(p, 3)[ks * 128 + k]; sS[i] = siluf(cv); }
        __syncthreads();
        const int col = nb * 256 + (tid & 255), kh = tid >> 8;
        float acc[9];
#pragma unroll
        for (int r = 0; r < 9; ++r) acc[r] = 0.f;
        const float* w = oin(p, 5) + ((size_t)l * 1024 + ks * 128 + kh * 64) * 6144 + col;
        for (int k = 0; k < 64; ++k) {
            const float wv = w[(size_t)k * 6144];
#pragma unroll
            for (int r = 0; r < 9; ++r) acc[r] += sS[r * 128 + kh * 64 + k] * wv;
        }
#pragma unroll
        for (int r = 0; r < 9; ++r) modp[(((size_t)l * NMODP + ks * 2 + kh) * 9 + r) * 6144 + col] = acc[r];
    }
}

__device__ __forceinline__ void phase_modreduce(const Params& p) {
    const float* modp = (const float*)(ows(p) + WS_MODP); float* modv = (float*)(ows(p) + WS_MOD);
    for (int i = obid() * 512 + otid(); i < 4 * 9 * 6144; i += gridDim.x * 512) {
        const int l = i / (9 * 6144), rem = i % (9 * 6144), n = rem % 6144;
        float s = oin(p, 6)[l * 6144 + n];
        for (int j = 0; j < NMODP; ++j) s += modp[((size_t)l * NMODP + j) * 9 * 6144 + rem];
        modv[i] = s;
    }
}

__device__ __forceinline__ void phase_norm1(const Params& p, int l, float scl) {
    const int lane = otid() & 63, wid = otid() >> 6;
    bf16_t* xws = (bf16_t*)(ows(p) + WS_X); bf16_t* hb = (bf16_t*)(ows(p) + WS_H); const bf16_t* yb = (const bf16_t*)(ows(p) + WS_YB);
    const float* modv = (const float*)(ows(p) + WS_MOD);
    const float* nw = oin(p, 4) + (size_t)(l * 2 + 0) * 1024;
    for (int r = obid() * 8 + wid; r < NTOK; r += gridDim.x * 8) {
        const int mr = mod_row(r);
        f32x4 v[4];
        if (l == 0) { const float* src = r < NLAT ? oin(p, 0) + (size_t)r * 1024 : oin(p, 2) + (size_t)(r - NLAT) * 1024;
#pragma unroll
            for (int j = 0; j < 4; ++j) v[j] = *(const f32x4*)(src + 4 * lane + 256 * j); }
        else {
#pragma unroll
            for (int j = 0; j < 4; ++j) v[j] = unpk4_bf16(*(const u32x2*)(xws + (size_t)r * 1024 + 4 * lane + 256 * j)); }
        if (l > 0) {
            const float* g5 = modv + ((size_t)(l - 1) * 9 + mr) * 6144 + 5 * 1024;
#pragma unroll
            for (int j = 0; j < 4; ++j) {
                const int c = 4 * lane + 256 * j;
                const f32x4 gv = *(const f32x4*)(g5 + c);
                f32x4 f;
                if (MOE_FP8) { const unsigned char* y8 = ows(p) + WS_YB8; f = (unpk4_fp8(*(const unsigned*)(y8 + (size_t)(2 * r) * 1024 + c)) + unpk4_fp8(*(const unsigned*)(y8 + (size_t)(2 * r + 1) * 1024 + c))) * (1.0f / 64.0f); }
                else { const u32x2 y0 = *(const u32x2*)(yb + (size_t)(2 * r) * 1024 + c), y1 = *(const u32x2*)(yb + (size_t)(2 * r + 1) * 1024 + c);
                f[0] = bf2f(y0.x & 0xffff) + bf2f(y1.x & 0xffff); f[1] = bf2f(y0.x >> 16) + bf2f(y1.x >> 16);
                f[2] = bf2f(y0.y & 0xffff) + bf2f(y1.y & 0xffff); f[3] = bf2f(y0.y >> 16) + bf2f(y1.y >> 16); }
                v[j] += (gv * scl) * f;
            }
        }
#pragma unroll
        for (int j = 0; j < 4; ++j) { u32x2 o; o.x = cvtpk(v[j][0], v[j][1]); o.y = cvtpk(v[j][2], v[j][3]); *(u32x2*)(xws + (size_t)r * 1024 + 4 * lane + 256 * j) = o; }
        float ss = 0.f;
#pragma unroll
        for (int j = 0; j < 4; ++j) ss += (v[j][0] * v[j][0] + v[j][1] * v[j][1]) + (v[j][2] * v[j][2] + v[j][3] * v[j][3]);
        const float rstd = rsqrtf(wave_sum(ss) * (1.0f / 1024.0f) + EPS);
        const float* msh = modv + ((size_t)l * 9 + mr) * 6144; const float* msc = msh + 1024;
#pragma unroll
        for (int j = 0; j < 4; ++j) {
            const int c = 4 * lane + 256 * j;
            const f32x4 w = *(const f32x4*)(nw + c), sh = *(const f32x4*)(msh + c), sc = *(const f32x4*)(msc + c);
            const f32x4 h = (v[j] * rstd * w) * (1.0f + sc) + sh;
            u32x2 o; o.x = pk2(h[0], h[1]); o.y = pk2(h[2], h[3]);
            *(u32x2*)(hb + (size_t)r * 1024 + c) = o;
        }
    }
}

__device__ __forceinline__ void phase_final(const Params& p) {
    const int lane = otid() & 63, wid = otid() >> 6;
    const bf16_t* xws = (const bf16_t*)(ows(p) + WS_X); const bf16_t* yb = (const bf16_t*)(ows(p) + WS_YB);
    const float* modv = (const float*)(ows(p) + WS_MOD); const float* nw = oin(p, 19);
    for (int r = obid() * 8 + wid; r < NLAT; r += gridDim.x * 8) {
        const int mr = mod_row(r);
        const float* g5 = modv + ((size_t)3 * 9 + mr) * 6144 + 5 * 1024;
        f32x4 v[4]; float ss = 0.f;
#pragma unroll
        for (int j = 0; j < 4; ++j) {
            const int c = 4 * lane + 256 * j;
            v[j] = unpk4_bf16(*(const u32x2*)(xws + (size_t)r * 1024 + c));
            const f32x4 gv = *(const f32x4*)(g5 + c);
            f32x4 f;
            if (MOE_FP8) { const unsigned char* y8 = ows(p) + WS_YB8; f = (unpk4_fp8(*(const unsigned*)(y8 + (size_t)(2 * r) * 1024 + c)) + unpk4_fp8(*(const unsigned*)(y8 + (size_t)(2 * r + 1) * 1024 + c))) * (1.0f / 64.0f); }
            else { const u32x2 y0 = *(const u32x2*)(yb + (size_t)(2 * r) * 1024 + c), y1 = *(const u32x2*)(yb + (size_t)(2 * r + 1) * 1024 + c);
            f[0] = bf2f(y0.x & 0xffff) + bf2f(y1.x & 0xffff); f[1] = bf2f(y0.x >> 16) + bf2f(y1.x >> 16);
            f[2] = bf2f(y0.y & 0xffff) + bf2f(y1.y & 0xffff); f[3] = bf2f(y0.y >> 16) + bf2f(y1.y >> 16); }
            v[j] += gv * f;
            ss += (v[j][0] * v[j][0] + v[j][1] * v[j][1]) + (v[j][2] * v[j][2] + v[j][3] * v[j][3]);
        }
        const float rstd = rsqrtf(wave_sum(ss) * (1.0f / 1024.0f) + EPS);
#pragma unroll
        for (int j = 0; j < 4; ++j) { const int c = 4 * lane + 256 * j; const f32x4 w = *(const f32x4*)(nw + c); *(f32x4*)(p.out + (size_t)r * 1024 + c) = v[j] * rstd * w; }
    }
}

__device__ __forceinline__ void phase_gemm1(const Params& p, int l, unsigned char* lds) {
    const bf16_t* hb = (const bf16_t*)(ows(p) + WS_H); const bf16_t* wt = (const bf16_t*)(ows(p) + WS_WIN) + (size_t)l * 4096 * 1024; bf16_t* pb = (bf16_t*)(ows(p) + WS_P);
    constexpr int NT = PW / 128, MT = NTOK / 128;
    for (int u = obid(); u < MT * NT; u += gridDim.x) {
        const int mt = u / NT, nt = u % NT;
        ARowPlain ar{hb + (size_t)mt * 128 * 1024, 1024};
        EpiP ep{pb + (size_t)mt * 128 * PW + nt * 128};
        gemm128(lds, ar, wt + (size_t)nt * 128 * 1024, 1024, ep);
    }
}

__device__ __forceinline__ void unpack8(const u32x4 w, float (&f)[8]) {
    f[0] = bf2f(w.x & 0xffff); f[1] = bf2f(w.x >> 16); f[2] = bf2f(w.y & 0xffff); f[3] = bf2f(w.y >> 16);
    f[4] = bf2f(w.z & 0xffff); f[5] = bf2f(w.z >> 16); f[6] = bf2f(w.w & 0xffff); f[7] = bf2f(w.w >> 16);
}
__device__ __forceinline__ void conv_rows(const Params& p, int l, int widx, int nwv) {
    const int lane = otid() & 63;
    const bf16_t* pb = (const bf16_t*)(ows(p) + WS_P); bf16_t* yb = (bf16_t*)(ows(p) + WS_Y);
    const float* cw = oin(p, 8) + (size_t)l * 3 * 512; const float* cnw = oin(p, 9) + (size_t)l * 512;
    const int nrows = (l == DEPTH - 1) ? NLAT : NTOK;
    const int c0 = lane * 8;
    float w0[8], w1[8], w2[8], nwv8[8];
#pragma unroll
    for (int j = 0; j < 8; ++j) { w0[j] = cw[c0 + j]; w1[j] = cw[512 + c0 + j]; w2[j] = cw[1024 + c0 + j]; nwv8[j] = cnw[c0 + j]; }
    constexpr int NB = 4;
    for (int rb = widx; rb < nrows; rb += NB * nwv) {
        u32x4 vb[NB], vc[NB], vh[NB], vcm[NB], vhm[NB], vcp[NB], vhp[NB]; bool hm[NB], hp[NB];
#pragma unroll
        for (int q = 0; q < NB; ++q) {
            int r = rb + q * nwv; if (r >= nrows) r = rb;
            int rm = -1, rp = -1;
            if (r < NLAT) {
                const int t = r & 2047;
                if (c0 < 256) { if ((t & 63) > 0) rm = r - 1; if ((t & 63) < 63) rp = r + 1; }
                else { if (t >= 64) rm = r - 64; if (t < SEQ - 64) rp = r + 64; }
            } else { const int tc = (r - NLAT) & 255; if (tc > 0) rm = r - 1; if (tc < 255) rp = r + 1; }
            hm[q] = rm >= 0; hp[q] = rp >= 0; if (rm < 0) rm = r; if (rp < 0) rp = r;
            vb[q] = *(const u32x4*)(pb + (size_t)r * PW + OFF_B + c0); vc[q] = *(const u32x4*)(pb + (size_t)r * PW + OFF_C + c0); vh[q] = *(const u32x4*)(pb + (size_t)r * PW + OFF_HV + c0);
            vcm[q] = *(const u32x4*)(pb + (size_t)rm * PW + OFF_C + c0); vhm[q] = *(const u32x4*)(pb + (size_t)rm * PW + OFF_HV + c0);
            vcp[q] = *(const u32x4*)(pb + (size_t)rp * PW + OFF_C + c0); vhp[q] = *(const u32x4*)(pb + (size_t)rp * PW + OFF_HV + c0);
        }
#pragma unroll
        for (int q = 0; q < NB; ++q) {
            const int r = rb + q * nwv;
            float bg[8], u0[8], um[8], up[8], t1[8];
            unpack8(vb[q], bg); unpack8(vc[q], u0); unpack8(vh[q], t1);
#pragma unroll
            for (int j = 0; j < 8; ++j) u0[j] *= t1[j];
            unpack8(vcm[q], um); unpack8(vhm[q], t1);
#pragma unroll
            for (int j = 0; j < 8; ++j) um[j] = hm[q] ? um[j] * t1[j] : 0.f;
            unpack8(vcp[q], up); unpack8(vhp[q], t1);
#pragma unroll
            for (int j = 0; j < 8; ++j) up[j] = hp[q] ? up[j] * t1[j] : 0.f;
            float z[8]; float ss = 0.f;
#pragma unroll
            for (int j = 0; j < 8; ++j) { z[j] = bg[j] * (w0[j] * um[j] + w1[j] * u0[j] + w2[j] * up[j]); ss += z[j] * z[j]; }
            const float rstd = rsqrtf(wave_sum(ss) * (1.0f / 512.0f) + EPS);
            u32x4 o;
            o.x = cvtpk(z[0] * rstd * nwv8[0], z[1] * rstd * nwv8[1]); o.y = cvtpk(z[2] * rstd * nwv8[2], z[3] * rstd * nwv8[3]);
            o.z = cvtpk(z[4] * rstd * nwv8[4], z[5] * rstd * nwv8[5]); o.w = cvtpk(z[6] * rstd * nwv8[6], z[7] * rstd * nwv8[7]);
            if (r < nrows) *(u32x4*)(yb + (size_t)r * 1024 + c0) = o;
        }
    }
}

template <int DIR>
__device__ __forceinline__ void gla_pre_dir(const Params& p, int l, int chunk, float* sQ, float* sK, const float* sV, float* sA, float* sBq, float (&oacc)[16]) {
    const int ch = otid(), tid = otid(), R0 = chunk * 16;
    const bf16_t* pb = (const bf16_t*)(ows(p) + WS_P);
    bf16_t* qin = (bf16_t*)(ows(p) + WS_QIN); bf16_t* kout = (bf16_t*)(ows(p) + WS_KOUT); float* dch = (float*)(ows(p) + WS_DCH);
    float lbv = 0.f;
    {
        const float* lb = oin(p, 10) + (size_t)DIR * 4 * 512 + ch;
        const float z0 = lb[0], z1 = lb[512], z2 = lb[1024], z3 = lb[1536];
        const float mx = fmaxf(fmaxf(z0, z1), fmaxf(z2, z3));
        const float e0 = __expf(z0 - mx), e1 = __expf(z1 - mx), e2 = __expf(z2 - mx), e3 = __expf(z3 - mx);
        const float inv = 1.0f / (e0 + e1 + e2 + e3);
        lbv = ((l >= 1 ? e1 : 0.f) + (l >= 2 ? e2 : 0.f) + (l >= 3 ? e3 : 0.f)) * inv;
    }
    float b = 0.f;
#pragma unroll 1
    for (int i = 0; i < 16; ++i) {
        const int row = R0 + (DIR ? 15 - i : i);
        const float zf = bf2f(pb[(size_t)row * PW + OFF_ZF + DIR * 512 + ch]);
        const float sg = 1.0f / (1.0f + __expf(-zf)), sn = 1.0f / (1.0f + __expf(zf));
        const float f = fmaxf(lbv + (1.0f - lbv) * sg, 1e-30f);
        b += __logf(f);
        sBq[i * 512 + ch] = b; sK[i * 512 + ch] = (1.0f - lbv) * sn;
        sQ[i * 512 + ch] = siluf(bf2f(pb[(size_t)row * PW + OFF_Q + ch]));
    }
    const float blast = b;
#pragma unroll 1
    for (int i = 0; i < 16; ++i) {
        const int row = R0 + (DIR ? 15 - i : i);
        const float bi = sBq[i * 512 + ch], kq = sK[i * 512 + ch], qv = sQ[i * 512 + ch];
        const float qi = qv * __expf(bi), kt = kq * __expf(fminf(-bi, 80.0f)), ko = kq * __expf(blast - bi);
        sQ[i * 512 + ch] = qi; sK[i * 512 + ch] = kt;
        qin[((size_t)DIR * NTOK + row) * 512 + ch] = (bf16_t)f2bf(qi);
        kout[((size_t)DIR * NTOK + row) * 512 + ch] = (bf16_t)f2bf(ko);
    }
    dch[((size_t)DIR * NCHUNK + chunk) * 512 + ch] = __expf(blast);
    __syncthreads();
#pragma unroll 1
    for (int e2 = 0; e2 < 2; ++e2) {
        const int e = tid * 2 + e2, h = e >> 8, t = (e >> 4) & 15, s = e & 15;
        float sum = 0.f;
        const float* qp = sQ + t * 512 + h * 128; const float* kp = sK + s * 512 + h * 128;
#pragma unroll 8
        for (int k = 0; k < 128; ++k) sum += qp[k] * kp[k];
        sA[e] = (s <= t) ? sum : 0.f;
    }
    __syncthreads();
    const int h = ch >> 7;
#pragma unroll
    for (int t = 0; t < 16; ++t) {
        float o = 0.f;
#pragma unroll 1
        for (int s = 0; s <= t; ++s) o += sA[(h * 16 + t) * 16 + s] * sV[(DIR ? 15 - s : s) * 512 + ch];
        oacc[DIR ? 15 - t : t] += o;
    }
    __syncthreads();
}

__device__ __forceinline__ void phase_conv_glapre(const Params& p, int l, unsigned char* lds) {
    conv_rows(p, l, obid() * 8 + (otid() >> 6), (int)gridDim.x * 8);
    float* sQ = (float*)lds; float* sK = sQ + 16 * 512; float* sV = sK + 16 * 512; float* sBq = sV + 16 * 512; float* sA = sBq + 16 * 512;
    const bf16_t* pb = (const bf16_t*)(ows(p) + WS_P); float* ointra = (float*)(ows(p) + WS_OINTRA);
    const int ch = otid();
    for (int chunk = obid(); chunk < NCHUNK; chunk += gridDim.x) {
        const int R0 = chunk * 16;
        float oacc[16];
#pragma unroll
        for (int i = 0; i < 16; ++i) oacc[i] = 0.f;
        __syncthreads();
#pragma unroll
        for (int ro = 0; ro < 16; ++ro) sV[ro * 512 + ch] = bf2f(pb[(size_t)(R0 + ro) * PW + OFF_I + ch]);
        gla_pre_dir<0>(p, l, chunk, sQ, sK, sV, sA, sBq, oacc);
        gla_pre_dir<1>(p, l, chunk, sQ, sK, sV, sA, sBq, oacc);
#pragma unroll
        for (int ro = 0; ro < 16; ++ro) ointra[(size_t)(R0 + ro) * 512 + ch] = oacc[ro];
    }
}

__device__ __forceinline__ void phase_gla_seq(const Params& p, int l, unsigned char* lds) {
    const int tid = otid();
    float* S = (float*)lds;
    float* sQ = S + 128 * 32;
    float* sKo = sQ + 16 * 128;
    float* sV = sKo + 16 * 128;
    float* sD = sV + 16 * 32;
    const bf16_t* pb = (const bf16_t*)(ows(p) + WS_P);
    const bf16_t* qin = (const bf16_t*)(ows(p) + WS_QIN); const bf16_t* kout = (const bf16_t*)(ows(p) + WS_KOUT); const float* dch = (const float*)(ows(p) + WS_DCH);
    float* ointer = (float*)(ows(p) + WS_OINTER);
    for (int u = obid(); u < 256; u += gridDim.x) {
        const int vblk = u & 3, dir = (u >> 2) & 1, chain = u >> 3, b = chain >> 2, h = chain & 3;
        __syncthreads();
        for (int i = tid; i < 128 * 32; i += 512) S[i] = 0.f;
        for (int c = 0; c < 144; ++c) {
            int R0;
            if (c < 16) { const int cm = dir ? 15 - c : c; R0 = NLAT + b * 256 + cm * 16; }
            else { const int cc = c - 16; const int cm = dir ? 127 - cc : cc; R0 = b * 2048 + cm * 16; }
            __syncthreads();
            for (int i = tid; i < 16 * 128; i += 512) {
                const int si = i >> 7, k = i & 127; const int row = R0 + (dir ? 15 - si : si);
                const size_t g = ((size_t)dir * NTOK + row) * 512 + h * 128 + k;
                sQ[i] = bf2f(qin[g]); sKo[i] = bf2f(kout[g]);
            }
            { const int si = tid >> 5, vv = tid & 31; const int row = R0 + (dir ? 15 - si : si); sV[tid] = bf2f(pb[(size_t)row * PW + OFF_I + h * 128 + vblk * 32 + vv]); }
            if (tid < 128) sD[tid] = dch[((size_t)dir * NCHUNK + (R0 >> 4)) * 512 + h * 128 + tid];
            __syncthreads();
            {
                const int si = tid >> 5, vv = tid & 31; const int row = R0 + (dir ? 15 - si : si);
                float o = 0.f;
                for (int k = 0; k < 128; ++k) o += sQ[si * 128 + k] * S[k * 32 + vv];
                ointer[((size_t)dir * NTOK + row) * 512 + h * 128 + vblk * 32 + vv] = o;
            }
            __syncthreads();
            {
                const int k = tid >> 2, v0 = (tid & 3) * 8; const float d = sD[k];
                float kk[16];
#pragma unroll
                for (int i = 0; i < 16; ++i) kk[i] = sKo[i * 128 + k];
#pragma unroll
                for (int j = 0; j < 8; ++j) {
                    float s = d * S[k * 32 + v0 + j];
#pragma unroll
                    for (int i = 0; i < 16; ++i) s += kk[i] * sV[i * 32 + v0 + j];
                    S[k * 32 + v0 + j] = s;
                }
            }
        }
    }
}


__device__ __forceinline__ float bflo(unsigned w) { return __uint_as_float(w << 16); }
__device__ __forceinline__ float bfhi(unsigned w) { return __uint_as_float(w & 0xffff0000u); }

template <int DIR>
__device__ __forceinline__ void gla_pre2_dir(const float (&q0a)[16], const float (&q1a)[16], const unsigned (&rz)[16], float lb0, float lb1, unsigned char* wl, unsigned char* rec,
                                             f32x4 (&oT)[8], int lane, int fr, int fq) {
    float bq0[16], bq1[16], kk0[16], kk1[16]; float b0 = 0.f, b1 = 0.f;
#pragma unroll
    for (int i = 0; i < 16; ++i) {
        const int t = DIR ? 15 - i : i;
        const float z0 = bflo(rz[t]), z1 = bfhi(rz[t]);
        const float sg0 = frcp(1.0f + __expf(-z0)), sg1 = frcp(1.0f + __expf(-z1));
        const float f0 = fmaxf(lb0 + (1.0f - lb0) * sg0, 1e-30f), f1 = fmaxf(lb1 + (1.0f - lb1) * sg1, 1e-30f);
        b0 += __logf(f0); b1 += __logf(f1); bq0[t] = b0; bq1[t] = b1; kk0[t] = 1.0f - f0; kk1[t] = 1.0f - f1;
    }
    const float bl0 = b0, bl1 = b1;
    unsigned kw0[8], kw1[8];
#pragma unroll
    for (int i = 0; i < 8; ++i) { kw0[i] = 0u; kw1[i] = 0u; }
#pragma unroll
    for (int t = 0; t < 16; ++t) {
        const float e0 = __expf(bq0[t]), e1 = __expf(bq1[t]);
        const float qi0 = q0a[t] * e0, qi1 = q1a[t] * e1;
        const float kt0 = kk0[t] * frcp(fmaxf(e0, 1.8e-35f)), kt1 = kk1[t] * frcp(fmaxf(e1, 1.8e-35f));
        const float ko0 = kk0[t] * __expf(bl0 - bq0[t]), ko1 = kk1[t] * __expf(bl1 - bq1[t]);
        *(unsigned*)(wl + t * 272 + lane * 4) = cvtpk(qi0, qi1);
        *(unsigned*)(wl + 4352 + t * 272 + lane * 4) = cvtpk(kt0, kt1);
        const unsigned kp = cvtpk(ko0, ko1);
        kw0[t >> 1] |= (kp & 0xffffu) << (16 * (t & 1)); kw1[t >> 1] |= (kp >> 16) << (16 * (t & 1));
    }
    {
        const int c0 = 2 * lane, c1 = c0 + 1;
        unsigned char* k0p = rec + 4096 + (c0 >> 4) * 512 + (c0 & 15) * 8; unsigned char* k1p = rec + 4096 + (c1 >> 4) * 512 + (c1 & 15) * 8;
#pragma unroll
        for (int g = 0; g < 4; ++g) { *(u32x2*)(k0p + g * 128) = (u32x2){kw0[2 * g], kw0[2 * g + 1]}; *(u32x2*)(k1p + g * 128) = (u32x2){kw1[2 * g], kw1[2 * g + 1]}; }
        float* dp = (float*)(rec + 8192) + c0; dp[0] = __expf(bl0); dp[1] = __expf(bl1);
    }
    LDS_WAIT();
#pragma unroll
    for (int s = 0; s < 4; ++s) {
        const u32x2 lo = *(const u32x2*)(wl + fr * 272 + (32 * s + 4 * fq) * 2), hi = *(const u32x2*)(wl + fr * 272 + (32 * s + 16 + 4 * fq) * 2);
        *(u32x4*)(rec + s * 1024 + lane * 16) = (u32x4){lo.x, lo.y, hi.x, hi.y};
    }
    f32x4 at = (f32x4){0.f, 0.f, 0.f, 0.f};
#pragma unroll
    for (int s = 0; s < 4; ++s) {
        const bf16x8 kf = *(const bf16x8*)(wl + 4352 + fr * 272 + (32 * s + 8 * fq) * 2);
        const bf16x8 qf = *(const bf16x8*)(wl + fr * 272 + (32 * s + 8 * fq) * 2);
        at = __builtin_amdgcn_mfma_f32_16x16x32_bf16(kf, qf, at, 0, 0, 0);
    }
#pragma unroll
    for (int r = 0; r < 4; ++r) { const int sp = 4 * fq + r; const bool keep = DIR ? (sp >= fr) : (sp <= fr); at[r] = keep ? at[r] : 0.f; }
    union { u32x2 u; s16x4 h; } bop; bop.u = (u32x2){cvtpk(at[0], at[1]), cvtpk(at[2], at[3])};
#pragma unroll
    for (int vb = 0; vb < 8; ++vb) {
        union { u32x2 u; s16x4 h; } aop; aop.u = *(const u32x2*)(wl + 8704 + (vb * 16 + fr) * 32 + 8 * fq);
        oT[vb] = __builtin_amdgcn_mfma_f32_16x16x16bf16_1k(aop.h, bop.h, oT[vb], 0, 0, 0);
    }
    LDS_WAIT();
}

__device__ __forceinline__ void phase_gla_pre2(const Params& p, int l, unsigned char* lds) {
    const int tid = otid(), lane = tid & 63, wid = __builtin_amdgcn_readfirstlane(tid >> 6), fr = lane & 15, fq = lane >> 4;
    unsigned char* wl = lds + wid * 12800;
    unsigned char* ws = ows(p);
    const bf16_t* pb = (const bf16_t*)(ws + WS_P); bf16_t* ointra = (bf16_t*)(ws + WS_OINTRA);
    float lb[2][2];
    {
        const float* hl = oin(p, 10);
#pragma unroll
        for (int d = 0; d < 2; ++d)
#pragma unroll
            for (int e = 0; e < 2; ++e) {
                const float* q = hl + (size_t)d * 4 * 512 + (2 * lane + e);
                lb[d][e] = 0.f; (void)q;
            }
    }
    for (int unit = wid * (int)gridDim.x + obid(); unit < NCHUNK * 4; unit += gridDim.x * 8) {
        const int chunk = unit >> 2, h = unit & 3, R0 = chunk * 16;
        {
            const float* hl = oin(p, 10);
#pragma unroll
            for (int d = 0; d < 2; ++d)
#pragma unroll
                for (int e = 0; e < 2; ++e) {
                    const float* q = hl + (size_t)d * 4 * 512 + h * 128 + 2 * lane + e;
                    const float z0 = q[0], z1 = q[512], z2 = q[1024], z3 = q[1536];
                    const float mx = fmaxf(fmaxf(z0, z1), fmaxf(z2, z3));
                    const float e0 = __expf(z0 - mx), e1 = __expf(z1 - mx), e2 = __expf(z2 - mx), e3 = __expf(z3 - mx);
                    lb[d][e] = ((l >= 1 ? e1 : 0.f) + (l >= 2 ? e2 : 0.f) + (l >= 3 ? e3 : 0.f)) / (e0 + e1 + e2 + e3);
                }
        }
        unsigned rq[16], rf[16], rb[16], rv[16];
#pragma unroll
        for (int t = 0; t < 16; ++t) {
            const bf16_t* base = pb + (size_t)(R0 + t) * PW + h * 128 + 2 * lane;
            rq[t] = *(const unsigned*)(base + OFF_Q); rf[t] = *(const unsigned*)(base + OFF_ZF); rb[t] = *(const unsigned*)(base + OFF_ZF + 512); rv[t] = *(const unsigned*)(base + OFF_I);
        }
        unsigned char* vrec = ws + WS_VREC + (size_t)(chunk * 4 + h) * VREC_BYTES;
        {
            unsigned w0[8], w1[8];
#pragma unroll
            for (int i = 0; i < 8; ++i) { w0[i] = (rv[2 * i] & 0xffffu) | (rv[2 * i + 1] << 16); w1[i] = (rv[2 * i] >> 16) | (rv[2 * i + 1] & 0xffff0000u); }
            const int c0 = 2 * lane, c1 = c0 + 1;
            unsigned char* v0p = vrec + (c0 >> 4) * 512 + (c0 & 15) * 8; unsigned char* v1p = vrec + (c1 >> 4) * 512 + (c1 & 15) * 8;
#pragma unroll
            for (int g = 0; g < 4; ++g) { *(u32x2*)(v0p + g * 128) = (u32x2){w0[2 * g], w0[2 * g + 1]}; *(u32x2*)(v1p + g * 128) = (u32x2){w1[2 * g], w1[2 * g + 1]}; }
            unsigned char* vl = wl + 8704 + c0 * 32;
            *(u32x4*)(vl) = (u32x4){w0[0], w0[1], w0[2], w0[3]}; *(u32x4*)(vl + 16) = (u32x4){w0[4], w0[5], w0[6], w0[7]};
            *(u32x4*)(vl + 32) = (u32x4){w1[0], w1[1], w1[2], w1[3]}; *(u32x4*)(vl + 48) = (u32x4){w1[4], w1[5], w1[6], w1[7]};
        }
        f32x4 oT[8];
#pragma unroll
        for (int vb = 0; vb < 8; ++vb) oT[vb] = (f32x4){0.f, 0.f, 0.f, 0.f};
        float q0a[16], q1a[16];
#pragma unroll
        for (int t = 0; t < 16; ++t) { q0a[t] = siluf(bflo(rq[t])); q1a[t] = siluf(bfhi(rq[t])); }
        gla_pre2_dir<0>(q0a, q1a, rf, lb[0][0], lb[0][1], wl, ws + WS_GREC + ((size_t)(0 * NCHUNK + chunk) * 4 + h) * REC_BYTES, oT, lane, fr, fq);
        gla_pre2_dir<1>(q0a, q1a, rb, lb[1][0], lb[1][1], wl, ws + WS_GREC + ((size_t)(1 * NCHUNK + chunk) * 4 + h) * REC_BYTES, oT, lane, fr, fq);
#pragma unroll
        for (int vb = 0; vb < 8; ++vb) *(u32x2*)(ointra + (size_t)(R0 + fr) * 512 + h * 128 + vb * 16 + 4 * fq) = (u32x2){cvtpk(oT[vb][0], oT[vb][1]), cvtpk(oT[vb][2], oT[vb][3])};
    }
}

constexpr int GR = 8, STG_BYTES = REC_BYTES + VREC_BYTES;
__device__ __forceinline__ int gla_chunk_of_step(int c, int b, int dir) {
    if (c < 16) { const int cm = dir ? 15 - c : c; return (NLAT + b * 256) / 16 + cm; }
    const int cc = c - 16; const int cm = dir ? 127 - cc : cc; return b * 128 + cm;
}
constexpr int SG_STEP = REC_BYTES + 2048, SG_GRP = 2 * SG_STEP, SG_NG = 6;
constexpr int SG_DUMP = SG_NG * SG_GRP;
constexpr int SG_FLAGS = LDS_MISC + 2048;
constexpr unsigned SG_SPIN = 1u << 22;
static_assert(SG_DUMP + 1024 <= LDS_MISC, "scan ring");
__device__ __forceinline__ void gla_scan_unit(const Params& p, int l, unsigned char* lds_, int chain, int vhalf) {
    LAS unsigned char* lds = (LAS unsigned char*)lds_;
    const int tid = otid(), lane = tid & 63, wid = __builtin_amdgcn_readfirstlane(tid >> 6), fr = lane & 15, fq = lane >> 4;
    unsigned char* ws = ows(p);
    const int b = chain >> 3, h = (chain >> 1) & 3, dir = chain & 1;
    volatile LAS unsigned* flg = (volatile LAS unsigned*)(lds + SG_FLAGS);
    __syncthreads();
    if (tid < 32) flg[tid] = 0u;
    __syncthreads();
    if (wid >= 4) {
        const int m = wid & 3;
        const unsigned char* grec = ws + WS_GREC + (size_t)dir * NCHUNK * 4 * REC_BYTES + (size_t)h * REC_BYTES + lane * 16;
        const unsigned char* vrec = ws + WS_VREC + (size_t)h * VREC_BYTES + vhalf * 2048 + lane * 16;
        const volatile LAS unsigned* dn = flg + 4 + (lane & 3);
#define GSEQ_ISSUE(gi) do { const int _g = (gi); _Pragma("unroll") for (int _j = 0; _j < 6; ++_j) { const int _p = m + 4 * _j; const bool _real = _p < 22; const int _s = _real ? _p / 11 : 0, _q = _real ? _p % 11 : 0; \
        const int _c = 2 * _g + _s; const int _cc = _c < 144 ? _c : 143; const int _ch = gla_chunk_of_step(_cc, b, dir); \
        const unsigned char* _src = (_q < 9) ? grec + (size_t)_ch * 4 * REC_BYTES + _q * 1024 : vrec + (size_t)_ch * 4 * VREC_BYTES + (_q - 9) * 1024; \
        const unsigned _dst = _real ? (unsigned)(_g % SG_NG) * SG_GRP + _s * SG_STEP + _q * 1024 : (unsigned)SG_DUMP; \
        __builtin_amdgcn_global_load_lds((const unsigned*)_src, (LAS unsigned*)(lds + _dst), 16, 0, 0); } } while (0)
#pragma unroll 1
        for (int g = 0; g < SG_NG - 1; ++g) GSEQ_ISSUE(g);
#pragma unroll 1
        for (int g = 0; g < 72; ++g) {
            asm volatile("s_waitcnt vmcnt(%0)" :: "n"((SG_NG - 2) * 6) : "memory");
            if (lane == 0) flg[m] = (unsigned)(g + 1);
            { unsigned sp = 0; while (__builtin_amdgcn_ballot_w64(*dn < (unsigned)g) != 0ull && ++sp < SG_SPIN) __builtin_amdgcn_s_sleep(1); asm volatile("" ::: "memory"); }
            GSEQ_ISSUE(g + SG_NG - 1);
        }
#undef GSEQ_ISSUE
    } else {
        const int vt = wid;
        bf16_t* ointer = (bf16_t*)(ws + WS_OINTER) + (size_t)dir * NTOK * 512 + h * 128 + (vhalf * 4 + vt) * 16 + fr;
        const volatile LAS unsigned* fl = flg + (lane & 3);
        f32x4 acc[8];
#pragma unroll
        for (int j = 0; j < 8; ++j) acc[j] = (f32x4){0.f, 0.f, 0.f, 0.f};
        union { u32x4 u; bf16x8 h; } sb[4];
#pragma unroll
        for (int j = 0; j < 4; ++j) sb[j].u = (u32x4){0u, 0u, 0u, 0u};
#pragma unroll 1
        for (int g = 0; g < 72; ++g) {
            { unsigned sp = 0; while (__builtin_amdgcn_ballot_w64(*fl < (unsigned)(g + 1)) != 0ull && ++sp < SG_SPIN) { } asm volatile("" ::: "memory"); }
#pragma unroll
            for (int s2 = 0; s2 < 2; ++s2) {
                const int c = 2 * g + s2;
                const LAS unsigned char* st = lds + (unsigned)(g % SG_NG) * SG_GRP + s2 * SG_STEP;
                const int chunk = gla_chunk_of_step(c, b, dir);
                bf16x8 qa[4]; f32x4 dv[8];
                union { u32x2 u; s16x4 h; } ka[8], vb;
#pragma unroll
                for (int j = 0; j < 4; ++j) qa[j] = *(const LAS bf16x8*)(st + j * 1024 + lane * 16);
                vb.u = *(const LAS u32x2*)(st + REC_BYTES + vt * 512 + lane * 8);
#pragma unroll
                for (int j = 0; j < 8; ++j) { ka[j].u = *(const LAS u32x2*)(st + 4096 + j * 512 + lane * 8); dv[j] = *(const LAS f32x4*)(st + 8192 + (j * 16 + 4 * fq) * 4); }
                f32x4 o0 = (f32x4){0.f, 0.f, 0.f, 0.f}, o1 = (f32x4){0.f, 0.f, 0.f, 0.f};
                o0 = __builtin_amdgcn_mfma_f32_16x16x32_bf16(qa[0], sb[0].h, o0, 0, 0, 0); o1 = __builtin_amdgcn_mfma_f32_16x16x32_bf16(qa[1], sb[1].h, o1, 0, 0, 0);
                o0 = __builtin_amdgcn_mfma_f32_16x16x32_bf16(qa[2], sb[2].h, o0, 0, 0, 0); o1 = __builtin_amdgcn_mfma_f32_16x16x32_bf16(qa[3], sb[3].h, o1, 0, 0, 0);
#pragma unroll
                for (int j = 0; j < 8; ++j) {
                    acc[j] = acc[j] * dv[j];
                    acc[j] = __builtin_amdgcn_mfma_f32_16x16x16bf16_1k(ka[j].h, vb.h, acc[j], 0, 0, 0);
                }
                const f32x4 os = o0 + o1;
                bf16_t* op = ointer + (size_t)(chunk * 16 + 4 * fq) * 512;
                { const unsigned w01 = cvtpk(os[0], os[1]), w23 = cvtpk(os[2], os[3]); op[0] = (bf16_t)(w01 & 0xffffu); op[512] = (bf16_t)(w01 >> 16); op[1024] = (bf16_t)(w23 & 0xffffu); op[1536] = (bf16_t)(w23 >> 16); }
#pragma unroll
                for (int j = 0; j < 4; ++j) sb[j].u = (u32x4){cvtpk(acc[2 * j][0], acc[2 * j][1]), cvtpk(acc[2 * j][2], acc[2 * j][3]), cvtpk(acc[2 * j + 1][0], acc[2 * j + 1][1]), cvtpk(acc[2 * j + 1][2], acc[2 * j + 1][3])};
            }
            asm volatile("s_waitcnt lgkmcnt(0)" ::: "memory");
            if (lane == 0) flg[4 + wid] = (unsigned)(g + 1);
        }
    }
    asm volatile("s_waitcnt vmcnt(0) lgkmcnt(0)" ::: "memory");
    __syncthreads();
}
__device__ __forceinline__ void phase_gla_seq2(const Params& p, int l, unsigned char* lds) {
    const int G = (int)gridDim.x, bid = obid();
    const int nscan = (G >= 256) ? 128 : G;
    for (int rep = 0; rep < ((DUPK == 50) ? 2 : 1); ++rep) {
        for (int r2 = 0; r2 < ((DUPK == 51) ? 2 : 1); ++r2)
        if (bid < nscan) for (int u = bid; u < 128; u += nscan) { const int x = u & 7, jj = u >> 3; gla_scan_unit(p, l, lds, x + 8 * (jj >> 1), jj & 1); }
        const int it0 = (G == 256) ? ((l == DEPTH - 1) ? CV_B : CV_B + CV_F) : 0;
        for (int r3 = 0; r3 < ((DUPK == 52) ? 2 : 1); ++r3)
        if (G > nscan) { if (bid >= nscan) { const int widx = (bid - nscan) * 8 + (otid() >> 6), nwv = (G - nscan) * 8; conv_rows(p, l, widx, nwv); convert_experts(p, l, (float*)(lds + (otid() >> 6) * 16384), widx, nwv, it0, CV_ALL); } }
        else { const int widx = bid * 8 + (otid() >> 6), nwv = G * 8; __syncthreads(); conv_rows(p, l, widx, nwv); convert_experts(p, l, (float*)(lds + (otid() >> 6) * 16384), widx, nwv, it0, CV_ALL); }
    }
}

__device__ __forceinline__ void phase_gla_post(const Params& p, int l) {
    const int lane = otid() & 63, wid = otid() >> 6;
    const bf16_t* pb = (const bf16_t*)(ows(p) + WS_P); bf16_t* yb = (bf16_t*)(ows(p) + WS_Y);
    const bf16_t* oi = (const bf16_t*)(ows(p) + WS_OINTRA); const bf16_t* oe = (const bf16_t*)(ows(p) + WS_OINTER);
    const float* hnw = oin(p, 11) + (size_t)l * 128;
    const int nrows = (l == DEPTH - 1) ? NLAT : NTOK;
    const int c0 = lane * 8;
    for (int r = obid() * 8 + wid; r < nrows; r += gridDim.x * 8) {
        float o[8], t1[8], t2[8]; float ss = 0.f;
        unpack8(*(const u32x4*)(oi + (size_t)r * 512 + c0), o); unpack8(*(const u32x4*)(oe + (size_t)r * 512 + c0), t1); unpack8(*(const u32x4*)(oe + ((size_t)NTOK + r) * 512 + c0), t2);
#pragma unroll
        for (int j = 0; j < 8; ++j) { o[j] += t1[j] + t2[j]; ss += o[j] * o[j]; }
        ss += __shfl_xor(ss, 1); ss += __shfl_xor(ss, 2); ss += __shfl_xor(ss, 4); ss += __shfl_xor(ss, 8);
        const float rstd = rsqrtf(ss * (1.0f / 128.0f) + EPS);
        float g[8]; unpack8(*(const u32x4*)(pb + (size_t)r * PW + OFF_G + c0), g);
        float y[8];
#pragma unroll
        for (int j = 0; j < 8; ++j) y[j] = o[j] * rstd * hnw[(c0 + j) & 127] * siluf(g[j]);
        u32x4 w; w.x = pk2(y[0], y[1]); w.y = pk2(y[2], y[3]); w.z = pk2(y[4], y[5]); w.w = pk2(y[6], y[7]);
        *(u32x4*)(yb + (size_t)r * 1024 + 512 + c0) = w;
    }
}

__device__ __forceinline__ void phase_gemm2(const Params& p, int l, unsigned char* lds) {
    const bf16_t* yb = (const bf16_t*)(ows(p) + WS_Y); const bf16_t* wt = (const bf16_t*)(ows(p) + WS_WOUT) + (size_t)l * 1024 * 1024;
    float* xws = (float*)(ows(p) + WS_X); const float* modv = (const float*)(ows(p) + WS_MOD);
    const int MT = ((l == DEPTH - 1) ? NLAT : NTOK) / 128; constexpr int NT = 8;
    for (int u = obid(); u < MT * NT; u += gridDim.x) {
        const int mt = u / NT, nt = u % NT;
        ARowPlain ar{yb + (size_t)mt * 128 * 1024, 1024};
        EpiRes ep{xws + (size_t)mt * 128 * 1024 + nt * 128, modv + (size_t)l * 9 * 6144 + 2 * 1024 + nt * 128, mt * 128};
        gemm128(lds, ar, wt + (size_t)nt * 128 * 1024, 1024, ep);
    }
}

__device__ __forceinline__ void phase_router(const Params& p, int l) {
    const int lane = otid() & 63, wid = otid() >> 6;
    const float* xws = (const float*)(ows(p) + WS_X); bf16_t* hb = (bf16_t*)(ows(p) + WS_H);
    const float* modv = (const float*)(ows(p) + WS_MOD); const float* nw = oin(p, 4) + (size_t)(l * 2 + 1) * 1024;
    const float* wrg = oin(p, 13) + (size_t)l * 1024 * 4; const float* wre = oin(p, 15) + (size_t)l * 1024 * 32;
    const float* brg = oin(p, 14) + l * 4; const float* bre = oin(p, 16) + l * 32;
    unsigned* cnt = (unsigned*)(ows(p) + WS_CTL) + CW_CNT + 64 * l;
    int* ltok = (int*)(ows(p) + WS_LTOK); float* lgate = (float*)(ows(p) + WS_LGATE);
    const int nrows = (l == DEPTH - 1) ? NLAT : NTOK;
    for (int r = obid() * 8 + wid; r < nrows; r += gridDim.x * 8) {
        const int mr = mod_row(r);
        float ss = 0.f;
#pragma unroll
        for (int j = 0; j < 4; ++j) { const f32x4 xv4 = *(const f32x4*)(xws + (size_t)r * 1024 + 4 * lane + 256 * j); ss += (xv4[0] * xv4[0] + xv4[1] * xv4[1]) + (xv4[2] * xv4[2] + xv4[3] * xv4[3]); }
        const float rstd = rsqrtf(wave_sum(ss) * (1.0f / 1024.0f) + EPS);
        const float* msh = modv + ((size_t)l * 9 + mr) * 6144 + 3 * 1024; const float* msc = msh + 1024;
        float lg[36];
#pragma unroll
        for (int i = 0; i < 36; ++i) lg[i] = 0.f;
#pragma unroll 1
        for (int j = 0; j < 4; ++j) {
            const int c = 4 * lane + 256 * j;
            const f32x4 xv4 = *(const f32x4*)(xws + (size_t)r * 1024 + c);
            const f32x4 w = *(const f32x4*)(nw + c), sh = *(const f32x4*)(msh + c), sc = *(const f32x4*)(msc + c);
            const f32x4 h = (xv4 * rstd * w) * (1.0f + sc) + sh;
            u32x2 o; o.x = pk2(h[0], h[1]); o.y = pk2(h[2], h[3]);
            *(u32x2*)(hb + (size_t)r * 1024 + c) = o;
#pragma unroll
            for (int e = 0; e < 4; ++e) {
                const float xv = h[e];
                const f32x4 wg = *(const f32x4*)(wrg + (size_t)(c + e) * 4);
                lg[0] += xv * wg[0]; lg[1] += xv * wg[1]; lg[2] += xv * wg[2]; lg[3] += xv * wg[3];
#pragma unroll
                for (int q = 0; q < 8; ++q) {
                    const f32x4 we = *(const f32x4*)(wre + (size_t)(c + e) * 32 + q * 4);
                    lg[4 + q * 4 + 0] += xv * we[0]; lg[4 + q * 4 + 1] += xv * we[1]; lg[4 + q * 4 + 2] += xv * we[2]; lg[4 + q * 4 + 3] += xv * we[3];
                }
            }
        }
#pragma unroll
        for (int i = 0; i < 36; ++i) lg[i] = wave_sum(lg[i]);
        float gl[4];
#pragma unroll
        for (int i = 0; i < 4; ++i) gl[i] = lg[i] + brg[i];
        int gsel = 0; float gmax = gl[0];
#pragma unroll
        for (int i = 1; i < 4; ++i) if (gl[i] > gmax) { gmax = gl[i]; gsel = i; }
        float gs = 0.f;
#pragma unroll
        for (int i = 0; i < 4; ++i) gs += __expf(gl[i] - gmax);
        const float pg = 1.0f / gs;
        float el[8];
#pragma unroll
        for (int j = 0; j < 8; ++j) {
            float t = lg[4 + j] + bre[j];
#pragma unroll
            for (int g = 1; g < 4; ++g) t = (gsel == g) ? (lg[4 + g * 8 + j] + bre[g * 8 + j]) : t;
            el[j] = t;
        }
        int i1 = 0; float v1 = el[0];
#pragma unroll
        for (int j = 1; j < 8; ++j) if (el[j] > v1) { v1 = el[j]; i1 = j; }
        int i2 = -1; float v2 = -3.0e38f;
#pragma unroll
        for (int j = 0; j < 8; ++j) if (j != i1 && el[j] > v2) { v2 = el[j]; i2 = j; }
        const float e2 = __expf(v2 - v1);
        const float g0 = pg / (1.0f + e2), g1 = pg * e2 / (1.0f + e2);
        if (lane == 0) {
            const int ea = gsel * 8 + i1, eb = gsel * 8 + i2;
            const unsigned pa = atomicAdd(cnt + ea, 1u); ltok[(size_t)ea * NTOK + pa] = r * 2 + 0; lgate[(size_t)ea * NTOK + pa] = g0;
            const unsigned pb2 = atomicAdd(cnt + eb, 1u); ltok[(size_t)eb * NTOK + pb2] = r * 2 + 1; lgate[(size_t)eb * NTOK + pb2] = g1;
        }
    }
}


__device__ __forceinline__ void phase_router2(const Params& p, int l, unsigned char* lds, bool commit) {
    const int tid = otid(), lane = tid & 63, wid = __builtin_amdgcn_readfirstlane(tid >> 6), fr = lane & 15, fq = lane >> 4;
    unsigned char* ws = ows(p);
    const bf16_t* xws = (const bf16_t*)(ws + WS_X); bf16_t* xw = (bf16_t*)(ws + WS_X); const bf16_t* dlt = (const bf16_t*)(ws + WS_DELTA); bf16_t* hb = (bf16_t*)(ws + WS_H);
    const float* modv = (const float*)(ws + WS_MOD); const float* nw = oin(p, 4) + (size_t)(l * 2 + 1) * 1024;
    const float* brg = oin(p, 14) + l * 4; const float* bre = oin(p, 16) + l * 32;
    unsigned* gcnt = (unsigned*)(ws + WS_CTL) + CW_CNT + 64 * 32 * l;
    int* ltok = (int*)(ws + WS_LTOK); float* lgate = (float*)(ws + WS_LGATE);
    constexpr int WPITCH = 2064, WBYTES = 48 * WPITCH;
    unsigned char* wl = lds;
    float* tile = (float*)(lds + WBYTES + wid * 3328);
    int* s_cnt = (int*)(lds + WBYTES + 8 * 3328); int* s_base = s_cnt + 32;
    int* s_e = s_base + 32; int* s_rank = s_e + 256; int* s_tok = s_rank + 256; float* s_gate = (float*)(s_tok + 256);
    __syncthreads();
    {
        const bf16_t* wrh = (const bf16_t*)(ws + WS_WRH) + (size_t)l * 48 * 1024;
        for (int i = tid; i < 48 * 128; i += 512) { const int r = i >> 7, c = i & 127; *(u32x4*)(wl + r * WPITCH + c * 16) = *(const u32x4*)(wrh + (size_t)r * 1024 + c * 8); }
    }
    const int NG = ((l == DEPTH - 1) ? NLAT : NTOK) / 16;
    const int NWV = (int)gridDim.x * 8;
    for (int it = 0; it * NWV < NG; ++it) {
        const int g = it * NWV + wid * (int)gridDim.x + obid();
        __syncthreads();
        if (tid < 32) s_cnt[tid] = 0;
        if (tid < 256) s_e[tid] = -1;
        __syncthreads();
        if (g < NG) {
            const int R0 = g * 16, mr = mod_row(R0);
            float my_rstd = 0.f;
#pragma unroll
            for (int rb = 0; rb < 4; ++rb) {
                f32x4 xv[4][4]; u32x2 dl[4][4], xr[4][4];
#pragma unroll
                for (int rr = 0; rr < 4; ++rr)
#pragma unroll
                    for (int j = 0; j < 4; ++j) { xr[rr][j] = *(const u32x2*)(xws + (size_t)(R0 + rb * 4 + rr) * 1024 + 4 * lane + 256 * j); dl[rr][j] = *(const u32x2*)(dlt + (size_t)(R0 + rb * 4 + rr) * 1024 + 4 * lane + 256 * j); }
#pragma unroll
                for (int rr = 0; rr < 4; ++rr) {
#pragma unroll
                    for (int j = 0; j < 4; ++j) xv[rr][j] = unpk4_bf16(xr[rr][j]);
                    if (commit) {
#pragma unroll
                        for (int j = 0; j < 4; ++j) { xv[rr][j] += unpk4_bf16(dl[rr][j]); u32x2 o; o.x = cvtpk(xv[rr][j][0], xv[rr][j][1]); o.y = cvtpk(xv[rr][j][2], xv[rr][j][3]); *(u32x2*)(xw + (size_t)(R0 + rb * 4 + rr) * 1024 + 4 * lane + 256 * j) = o;
                            xv[rr][j] = unpk4_bf16(o); }
                    }
                    float ss = 0.f;
#pragma unroll
                    for (int j = 0; j < 4; ++j) ss += (xv[rr][j][0] * xv[rr][j][0] + xv[rr][j][1] * xv[rr][j][1]) + (xv[rr][j][2] * xv[rr][j][2] + xv[rr][j][3] * xv[rr][j][3]);
                    const float rs = rsqrtf(wave_sum(ss) * (1.0f / 1024.0f) + EPS);
                    my_rstd = (rb * 4 + rr == fr) ? rs : my_rstd;
                }
            }
            asm volatile("s_waitcnt vmcnt(0)" ::: "memory");
            const float* msh = modv + ((size_t)l * 9 + mr) * 6144 + 3 * 1024 + 8 * fq; const float* msc = msh + 1024; const float* nwp = nw + 8 * fq;
            const bf16_t* xrow = xws + (size_t)(R0 + fr) * 1024 + 8 * fq; bf16_t* hrow = hb + (size_t)(R0 + fr) * 1024 + 8 * fq; unsigned char* h8row = ws + WS_H8 + (size_t)(R0 + fr) * 1024 + 8 * fq;
            f32x4 acc[3];
#pragma unroll
            for (int nt = 0; nt < 3; ++nt) acc[nt] = (f32x4){0.f, 0.f, 0.f, 0.f};
#pragma unroll 1
            for (int kq = 0; kq < 4; ++kq) {
                u32x4 xab[8];
#pragma unroll
                for (int u = 0; u < 8; ++u) xab[u] = *(const u32x4*)(xrow + 256 * kq + 32 * u);
#pragma unroll
                for (int u = 0; u < 8; ++u) {
                    const int k = 256 * kq + 32 * u;
                    float hv[8];
                    const f32x4 xaq[2] = {unpk4_bf16((u32x2){xab[u].x, xab[u].y}), unpk4_bf16((u32x2){xab[u].z, xab[u].w})};
#pragma unroll
                    for (int q = 0; q < 2; ++q) {
                        const f32x4 w = *(const f32x4*)(nwp + k + 4 * q), sh = *(const f32x4*)(msh + k + 4 * q), sc = *(const f32x4*)(msc + k + 4 * q);
                        const f32x4 h = (xaq[q] * my_rstd * w) * (1.0f + sc) + sh;
                        hv[4 * q + 0] = h[0]; hv[4 * q + 1] = h[1]; hv[4 * q + 2] = h[2]; hv[4 * q + 3] = h[3];
                    }
                    union { u32x4 u; bf16x8 h; } ah, al;
                    ah.u = (u32x4){cvtpk(hv[0], hv[1]), cvtpk(hv[2], hv[3]), cvtpk(hv[4], hv[5]), cvtpk(hv[6], hv[7])};
                    float lv[8];
#pragma unroll
                    for (int q = 0; q < 4; ++q) { const unsigned w2 = q == 0 ? ah.u.x : q == 1 ? ah.u.y : q == 2 ? ah.u.z : ah.u.w; lv[2 * q] = hv[2 * q] - __uint_as_float(w2 << 16); lv[2 * q + 1] = hv[2 * q + 1] - __uint_as_float(w2 & 0xffff0000u); }
                    al.u = (u32x4){cvtpk(lv[0], lv[1]), cvtpk(lv[2], lv[3]), cvtpk(lv[4], lv[5]), cvtpk(lv[6], lv[7])};
                    if (MOE_FP8) { u32x2 h8; h8.x = pk4_fp8(hv[0], hv[1], hv[2], hv[3]); h8.y = pk4_fp8(hv[4], hv[5], hv[6], hv[7]); *(u32x2*)(h8row + k) = h8; }
                    else *(u32x4*)(hrow + k) = ah.u;
#pragma unroll
                    for (int nt = 0; nt < 3; ++nt) {
                        const bf16x8 bh = *(const bf16x8*)(wl + (nt * 16 + fr) * WPITCH + (k + 8 * fq) * 2);
                        acc[nt] = __builtin_amdgcn_mfma_f32_16x16x32_bf16(ah.h, bh, acc[nt], 0, 0, 0);
                        acc[nt] = __builtin_amdgcn_mfma_f32_16x16x32_bf16(al.h, bh, acc[nt], 0, 0, 0);
                    }
                }
            }
#pragma unroll
            for (int nt = 0; nt < 3; ++nt)
#pragma unroll
                for (int r = 0; r < 4; ++r) tile[(4 * fq + r) * 52 + nt * 16 + fr] = acc[nt][r];
            LDS_WAIT();
            if (lane < 16) {
                const float* lg = tile + lane * 52;
                float gl[4];
#pragma unroll
                for (int i = 0; i < 4; ++i) gl[i] = lg[i] + brg[i];
                int gsel = 0; float gmax = gl[0];
#pragma unroll
                for (int i = 1; i < 4; ++i) if (gl[i] > gmax) { gmax = gl[i]; gsel = i; }
                float gs = 0.f;
#pragma unroll
                for (int i = 0; i < 4; ++i) gs += __expf(gl[i] - gmax);
                const float pg = 1.0f / gs;
                float el[8];
#pragma unroll
                for (int j = 0; j < 8; ++j) el[j] = lg[4 + gsel * 8 + j] + bre[gsel * 8 + j];
                int i1 = 0; float v1 = el[0];
#pragma unroll
                for (int j = 1; j < 8; ++j) if (el[j] > v1) { v1 = el[j]; i1 = j; }
                int i2 = -1; float v2 = -3.0e38f;
#pragma unroll
                for (int j = 0; j < 8; ++j) if (j != i1 && el[j] > v2) { v2 = el[j]; i2 = j; }
                const float e2 = __expf(v2 - v1);
                const float g0 = pg / (1.0f + e2), g1 = pg * e2 / (1.0f + e2);
                const int ea = gsel * 8 + i1, eb = gsel * 8 + i2, slot = (wid * 16 + lane) * 2, r = R0 + lane;
                s_e[slot] = ea; s_rank[slot] = atomicAdd(&s_cnt[ea], 1); s_tok[slot] = r * 2; s_gate[slot] = g0;
                s_e[slot + 1] = eb; s_rank[slot + 1] = atomicAdd(&s_cnt[eb], 1); s_tok[slot + 1] = r * 2 + 1; s_gate[slot + 1] = g1;
            }
        }
        __syncthreads();
        if (tid < 32) { const int c = s_cnt[tid]; s_base[tid] = (c > 0 && commit) ? (int)atomicAdd(gcnt + 64 * tid, (unsigned)c) : 0; }
        __syncthreads();
        if (tid < 256) { const int e = s_e[tid]; if (e >= 0 && commit) { const size_t pos = (size_t)e * NTOK + s_base[e] + s_rank[tid]; ltok[pos] = s_tok[tid]; lgate[pos] = s_gate[tid]; } }
    }
}

__device__ __forceinline__ int moe_tables(const Params& p, int l, unsigned char* lds) {
    int* s_pref = (int*)(lds + LDS_MISC); int* s_cnt = s_pref + 40;
    unsigned* cnt = (unsigned*)(ows(p) + WS_CTL) + CW_CNT + 64 * l;
    __syncthreads();
    if (otid() == 0) {
        int acc = 0;
        for (int e = 0; e < NEXP; ++e) { const int c = (int)__hip_atomic_load(cnt + e, __ATOMIC_RELAXED, __HIP_MEMORY_SCOPE_AGENT); s_cnt[e] = c; s_pref[e] = acc; acc += (c + 127) >> 7; }
        s_pref[NEXP] = acc;
    }
    __syncthreads();
    return s_pref[NEXP];
}
__device__ __forceinline__ void phase_moe_gu(const Params& p, int l, unsigned char* lds) {
    const int T = moe_tables(p, l, lds);
    const int* s_pref = (const int*)(lds + LDS_MISC); const int* s_cnt = s_pref + 40;
    const bf16_t* hb = (const bf16_t*)(ows(p) + WS_H); bf16_t* hid = (bf16_t*)(ows(p) + WS_HID);
    const int* ltok = (const int*)(ows(p) + WS_LTOK);
    for (int u = obid(); u < T * 8; u += gridDim.x) {
        const int mtg = u >> 3, nt = u & 7;
        int e = 0;
        for (int q = 1; q < NEXP; ++q) if (s_pref[q] <= mtg) e = q;
        const int mt = mtg - s_pref[e]; const int nvalid = min(128, s_cnt[e] - mt * 128);
        ARowGather ar{hb, ltok + (size_t)e * NTOK + mt * 128, nvalid};
        EpiGU ep{hid + (size_t)mtg * 128 * 512 + nt * 64};
        gemm128(lds, ar, (const bf16_t*)(ows(p) + WS_WGU) + ((size_t)(l * 32 + e) * 1024 + nt * 128) * 1024, 1024, ep);
    }
}
__device__ __forceinline__ void phase_moe_down(const Params& p, int l, unsigned char* lds) {
    const int T = moe_tables(p, l, lds);
    const int* s_pref = (const int*)(lds + LDS_MISC); const int* s_cnt = s_pref + 40;
    const bf16_t* hid = (const bf16_t*)(ows(p) + WS_HID); bf16_t* yb = (bf16_t*)(ows(p) + WS_YB);
    const int* ltok = (const int*)(ows(p) + WS_LTOK); const float* lgate = (const float*)(ows(p) + WS_LGATE);
    for (int u = obid(); u < T * 8; u += gridDim.x) {
        const int mtg = u >> 3, nt = u & 7;
        int e = 0;
        for (int q = 1; q < NEXP; ++q) if (s_pref[q] <= mtg) e = q;
        const int mt = mtg - s_pref[e]; const int nvalid = min(128, s_cnt[e] - mt * 128);
        ARowPlain ar{hid + (size_t)mtg * 128 * 512, 512};
        EpiDown ep{yb + nt * 128, ltok + (size_t)e * NTOK + mt * 128, lgate + (size_t)e * NTOK + mt * 128, nvalid};
        gemm128(lds, ar, (const bf16_t*)(ows(p) + WS_WDN) + ((size_t)(l * 32 + e) * 1024 + nt * 128) * 512, 512, ep);
    }
}


#ifndef FAST_G1
#define FAST_G1 1
#endif
#ifndef FAST_G2
#define FAST_G2 1
#endif
#ifndef FAST_MOE
#define FAST_MOE 1
#endif
#ifndef FAST_GLA
#define FAST_GLA 1
#endif
#ifndef FAST_RT
#define FAST_RT 1
#endif
__device__ __forceinline__ void phase_gemm1_fast(const Params& p, int l, unsigned char* lds) {
    g8::DenseOrder S; S.init(NTOK / 256, PW / 256, (int)gridDim.x, obid(), (const bf16_t*)(ows(p) + WS_WIN) + (size_t)l * 4096 * 1024, 1024);
    g8::EpiP2 E{(bf16_t*)(ows(p) + WS_P)};
    g8::gemm_phase((LAS unsigned char*)lds, (const char*)(ows(p) + WS_H), 1024, S, E);
    if (gridDim.x == 256 && obid() >= 128) { __syncthreads(); convert_experts(p, l, (float*)(lds + (otid() >> 6) * 16384), (obid() - 128) * 8 + (otid() >> 6), 128 * 8, 0, CV_B); }
}
__device__ __forceinline__ void phase_gemm2_fast(const Params& p, int l, unsigned char* lds, float scl) {
    g8::DenseOrder S; S.init(((l == DEPTH - 1) ? NLAT : NTOK) / 256, 4, (int)gridDim.x, obid(), (const bf16_t*)(ows(p) + WS_WOUT) + (size_t)l * 1024 * 1024, 1024);
    g8::EpiDelta E{(bf16_t*)(ows(p) + WS_DELTA), (const float*)(ows(p) + WS_MOD) + (size_t)l * 9 * 6144 + 2 * 1024, scl};
    g8::gemm_phase((LAS unsigned char*)lds, (const char*)(ows(p) + WS_Y), 1024, S, E);
    if (gridDim.x == 256 && l < DEPTH - 1 && obid() >= 32 && scl != 0.0f) { __syncthreads(); convert_experts(p, l, (float*)(lds + (otid() >> 6) * 16384), (obid() - 32) * 8 + (otid() >> 6), 224 * 8, CV_B, CV_B + CV_F); }
}
__device__ __forceinline__ int moe_tables256(const Params& p, int l, unsigned char* lds) {
    int* s_pref = (int*)(lds + LDS_MISC); int* s_cnt = s_pref + 40;
    unsigned* cnt = (unsigned*)(ows(p) + WS_CTL) + CW_CNT + 64 * 32 * l;
    __syncthreads();
    if (otid() == 0) {
        int acc = 0;
        for (int e = 0; e < NEXP; ++e) { const int c = (int)__hip_atomic_load(cnt + 64 * e, __ATOMIC_RELAXED, __HIP_MEMORY_SCOPE_AGENT); s_cnt[e] = c; s_pref[e] = acc; acc += (c + 255) >> 8; }
        s_pref[NEXP] = acc;
    }
    __syncthreads();
    return s_pref[NEXP];
}
__device__ __forceinline__ void moe_setup(const Params& p, int l, unsigned char* lds) {
    const int T = moe_tables256(p, l, lds);
    const int* s_pref = (const int*)(lds + LDS_MISC); const int* s_cnt = s_pref + 40;
    int* utab = (int*)(lds + g8::MOE_UTAB); int* rtok = (int*)(lds + g8::MOE_RTOK); float* rgate = (float*)(lds + g8::MOE_RGATE);
    const int tid = otid(), G = (int)gridDim.x, c = obid();
    if (tid < 4) {
        const int L = tid * G + c; int* t = utab + tid * 8;
        if (L < T * 4) {
            const int mtg = L >> 2; int e = 0;
            for (int q = 1; q < NEXP; ++q) if (s_pref[q] <= mtg) e = q;
            const int mt = mtg - s_pref[e];
            t[0] = mtg; t[1] = L & 3; t[2] = e; t[3] = min(256, s_cnt[e] - mt * 256); t[4] = e * NTOK + mt * 256; t[5] = 1;
        } else { int z = 0; asm volatile("" : "+v"(z)); t[0] = z; t[1] = z; t[2] = z; t[3] = z; t[4] = z; t[5] = z; }
    }
    __syncthreads();
    const int* ltok = (const int*)(ows(p) + WS_LTOK); const float* lgate = (const float*)(ows(p) + WS_LGATE);
    for (int idx = tid; idx < 1024; idx += 512) {
        const int i = idx >> 8, r = idx & 255; const int* t = utab + i * 8;
        const bool ok = t[5] != 0 && r < t[3];
        rtok[idx] = ok ? ltok[t[4] + r] : 0; rgate[idx] = ok ? lgate[t[4] + r] : 0.f;
    }
    __syncthreads();
}
__device__ __forceinline__ void phase_moe_gu_fast(const Params& p, int l, unsigned char* lds) {
    moe_setup(p, l, lds);
    g8::MoeOrder<true> S; S.utab = (const int*)(lds + g8::MOE_UTAB); S.rtok = (const int*)(lds + g8::MOE_RTOK); S.K = 1024;
    if (MOE_FP8) {
        S.W = (const char*)(ows(p) + WS_WGU8) + (size_t)l * 32 * 1024 * 1024; S.bpe = 1;
        g8::EpiGU8 E{ows(p) + WS_HID8};
        g8::gemm_phase8<0x7A7A7A7A, 0x7F7F7F7F>((LAS unsigned char*)lds, (const char*)(ows(p) + WS_H8), 1024, S, E);
    } else {
        S.W = (const char*)(ows(p) + WS_WGU) + (size_t)l * 32 * 1024 * 1024 * 2; S.bpe = 2;
        g8::EpiGU2 E{(bf16_t*)(ows(p) + WS_HID)};
        g8::gemm_phase((LAS unsigned char*)lds, (const char*)(ows(p) + WS_H), 1024, S, E);
    }
}
__device__ __forceinline__ void phase_moe_down_fast(const Params& p, int l, unsigned char* lds) {
    moe_setup(p, l, lds);
    g8::MoeOrder<false> S; S.utab = (const int*)(lds + g8::MOE_UTAB); S.rtok = (const int*)(lds + g8::MOE_RTOK); S.K = 512;
    g8::EpiDown2 E{(bf16_t*)(ows(p) + WS_YB), (const int*)(lds + g8::MOE_RTOK), (const float*)(lds + g8::MOE_RGATE)};
    if (MOE_FP8) {
        S.W = (const char*)(ows(p) + WS_WDN8) + (size_t)l * 32 * 1024 * 512; S.bpe = 1;
        g8::EpiDown8 E8{ows(p) + WS_YB8, (const int*)(lds + g8::MOE_RTOK), (const float*)(lds + g8::MOE_RGATE)};
        g8::gemm_phase8<0x7B7B7B7B, 0x7E7E7E7E>((LAS unsigned char*)lds, (const char*)(ows(p) + WS_HID8), 512, S, E8);
    } else {
        S.W = (const char*)(ows(p) + WS_WDN) + (size_t)l * 32 * 1024 * 512 * 2; S.bpe = 2;
        g8::gemm_phase((LAS unsigned char*)lds, (const char*)(ows(p) + WS_HID), 512, S, E);
    }
}

__device__ __forceinline__ void phase_c(const Params& p, int l, unsigned char* lds) {
    phase_gla_pre2(p, l, lds);
}

__global__ void __launch_bounds__(512, 2) mk(Params p) {
    extern __shared__ __attribute__((aligned(16))) unsigned char lds[];
    const int lo = p.ph_lo, hi = p.ph_hi;
    volatile LAS unsigned* misc = (volatile LAS unsigned*)(lds + LDS_MISC + 1024);
    if (threadIdx.x < 4) misc[threadIdx.x] = 0u;
    __syncthreads();
    XcdBarrier bar; bar.bar = (unsigned*)(p.ws + WS_CTL) + CW_BAR; bar.x = 0; bar.st = misc;
    if (hi - lo > 1) bar = xcd_barrier_post((unsigned*)(p.ws + WS_CTL) + CW_BAR, misc);
#define IN(k) (lo <= (k) && (k) < hi)
#define SEAM(k) do { if (IN((k) + 1)) { xcd_barrier(bar); if (DUPK == 20) xcd_barrier(bar); } } while (0)
#define REP(kind) for (int _rep = 0; _rep < ((DUPK == (kind)) ? 2 : 1); ++_rep)
    if (IN(0)) { REP(0) phase_prologue(p, lds); SEAM(0); }
    if (IN(1)) { REP(1) phase_modreduce(p); SEAM(1); }
    for (int l = 0; l < DEPTH; ++l) {
        const int pb = 2 + 9 * l;
        if (IN(pb + 0)) { if (DUPK == 2) phase_norm1(p, l, (float)(lo > 1000)); phase_norm1(p, l, 1.0f); SEAM(pb + 0); }
        if (IN(pb + 1)) { REP(3) { if (FAST_G1) phase_gemm1_fast(p, l, lds); else phase_gemm1(p, l, lds); } SEAM(pb + 1); }
        if (IN(pb + 2)) { REP(4) { phase_c(p, l, lds); } SEAM(pb + 2); }
        if (IN(pb + 3)) { REP(5) { phase_gla_seq2(p, l, lds); } SEAM(pb + 3); }
        if (IN(pb + 4)) { REP(6) phase_gla_post(p, l); SEAM(pb + 4); }
        if (IN(pb + 5)) { if (DUPK == 7) phase_gemm2_fast(p, l, lds, (float)(lo > 1000)); phase_gemm2_fast(p, l, lds, 1.0f); SEAM(pb + 5); }
        if (IN(pb + 6)) { if (DUPK == 8) phase_router2(p, l, lds, lo > 1000); phase_router2(p, l, lds, true); SEAM(pb + 6); }
        if (IN(pb + 7)) { REP(9) { if (FAST_MOE) phase_moe_gu_fast(p, l, lds); else phase_moe_gu(p, l, lds); } SEAM(pb + 7); }
        if (IN(pb + 8)) { REP(10) { if (FAST_MOE) phase_moe_down_fast(p, l, lds); else phase_moe_down(p, l, lds); } SEAM(pb + 8); }
    }
    if (IN(NPH - 1)) { REP(11) phase_final(p); }
#undef IN
#undef SEAM
}

#ifndef MK_LAUNCHES
#define MK_LAUNCHES 1
#endif
extern "C" void kernel_launch(void* const* d_in, const int* in_sizes, int n_in, void* d_out, int out_size, void* d_ws, size_t ws_size, hipStream_t stream) {
    static int grid = 0;
    if (grid == 0) {
        int dev = 0, cus = 0;
        if (n_in != 20 || ws_size < WS_END) { fprintf(stderr, "kernel_launch: unexpected shapes (n_in %d, ws %zu < %zu)\n", n_in, ws_size, (size_t)WS_END); grid = -1; return; }
        if (hipGetDevice(&dev) != hipSuccess || hipDeviceGetAttribute(&cus, hipDeviceAttributeMultiprocessorCount, dev) != hipSuccess) { grid = -1; return; }
        if (hipFuncSetAttribute((const void*)mk, hipFuncAttributeMaxDynamicSharedMemorySize, LDS_BYTES) != hipSuccess) { fprintf(stderr, "kernel_launch: hipFuncSetAttribute failed\n"); grid = -1; return; }
        (void)hipGetLastError();
        grid = cus;
    }
    if (grid < 0) return;
    (void)hipMemsetAsync((char*)d_ws + WS_CTL, 0, CTL_BYTES, stream);
    Params p{};
    for (int i = 0; i < 20; ++i) p.in[i] = (const float*)d_in[i];
    p.out = (float*)d_out; p.ws = (unsigned char*)d_ws;
    if (MK_LAUNCHES == 1) { p.ph_lo = 0; p.ph_hi = NPH; hipLaunchKernelGGL(mk, dim3(grid), dim3(512), LDS_BYTES, stream, p); }
    else for (int ph = 0; ph < NPH; ++ph) { p.ph_lo = ph; p.ph_hi = ph + 1; hipLaunchKernelGGL(mk, dim3(grid), dim3(512), LDS_BYTES, stream, p); }
}
```

```cpp
#include <hip/hip_runtime.h>
#include <stdint.h>
#include <stdio.h>

typedef unsigned short bf16_t;
typedef short bf16x8 __attribute__((ext_vector_type(8)));
typedef float f32x4 __attribute__((ext_vector_type(4)));
typedef unsigned u32x4 __attribute__((ext_vector_type(4)));
typedef unsigned u32x2 __attribute__((ext_vector_type(2)));
typedef int i32x8 __attribute__((ext_vector_type(8)));
typedef int i32x4 __attribute__((ext_vector_type(4)));
typedef short s16x4 __attribute__((ext_vector_type(4)));
typedef float f32x2 __attribute__((ext_vector_type(2)));
#define LAS __attribute__((address_space(3)))
#define GAS __attribute__((address_space(1)))

#ifndef G2_FP8
#define G2_FP8 1
#endif
#ifndef DUPK
#define DUPK -1
#endif
#ifndef MOE_FP8
#define MOE_FP8 1
#endif
constexpr int D = 1024, NB = 8, SEQ = 2048, DEPTH = 4, CTXL = 256;
constexpr int NLAT = NB * SEQ, NCTX = NB * CTXL, NTOK = NLAT + NCTX;
constexpr int PW = 4096;
constexpr int OFF_B = 0, OFF_C = 512, OFF_HV = 1024, OFF_Q = 1536, OFF_ZF = 2048, OFF_I = 3072, OFF_G = 3584;
constexpr int NEXP = 32;
constexpr int NCHUNK = NTOK / 16;
constexpr float EPS = 1e-6f;
constexpr int NMODP = 16;
constexpr int CV_ALL = 32 * (16 * 32 + 8 * 32), CV_B = 128 * 8 * 7, CV_F = 224 * 8 * 8;

constexpr size_t WS_CTL = 0, CTL_BYTES = 65536;
constexpr size_t WS_WIN = WS_CTL + CTL_BYTES;
constexpr size_t WS_WOUT = WS_WIN + (size_t)4 * 4096 * 1024 * 2;
constexpr size_t WS_WGU = WS_WOUT + (size_t)4 * 1024 * 1024 * 2;
constexpr size_t WS_WDN = WS_WGU + (size_t)4 * 32 * 1024 * 1024 * 2;
constexpr size_t WS_MODP = WS_WDN + (size_t)4 * 32 * 1024 * 512 * 2;
constexpr size_t WS_MOD = WS_MODP + (size_t)4 * NMODP * 9 * 6144 * 4;
constexpr size_t WS_X = WS_MOD + (size_t)4 * 9 * 6144 * 4;
constexpr size_t WS_H = WS_X + (size_t)NTOK * 1024 * 4;
constexpr size_t WS_P = WS_H + (size_t)NTOK * 1024 * 2;
constexpr size_t WS_Y = WS_P + (size_t)NTOK * 4096 * 2;
constexpr size_t WS_QIN = WS_Y + (size_t)NTOK * 1024 * 2;
constexpr size_t WS_KOUT = WS_QIN + (size_t)2 * NTOK * 512 * 2;
constexpr size_t WS_DCH = WS_KOUT + (size_t)2 * NTOK * 512 * 2;
constexpr size_t WS_OINTRA = WS_DCH + (size_t)2 * NCHUNK * 512 * 4;
constexpr size_t WS_OINTER = WS_OINTRA + (size_t)NTOK * 512 * 4;
constexpr size_t WS_LTOK = WS_OINTER + (size_t)2 * NTOK * 512 * 4;
constexpr size_t WS_LGATE = WS_LTOK + (size_t)32 * NTOK * 4;
constexpr int HID_ROWS = 2 * NTOK + 32 * 256;
constexpr size_t WS_HID = WS_LGATE + (size_t)32 * NTOK * 4;
constexpr size_t WS_YB = WS_HID + (size_t)HID_ROWS * 512 * 2;
constexpr int REC_BYTES = 9216, VREC_BYTES = 4096;
constexpr size_t WS_GREC = WS_YB + (size_t)2 * NTOK * 1024 * 2;
constexpr size_t WS_VREC = WS_GREC + (size_t)2 * NCHUNK * 4 * REC_BYTES;
constexpr size_t WS_WRH = WS_VREC + (size_t)NCHUNK * 4 * VREC_BYTES;
constexpr size_t WS_WRL = WS_WRH + (size_t)4 * 48 * 1024 * 2;
constexpr size_t WS_H8 = WS_WRL + (size_t)4 * 48 * 1024 * 2;
constexpr size_t WS_HID8 = WS_H8 + (size_t)NTOK * 1024;
constexpr size_t WS_WGU8 = WS_HID8 + (size_t)HID_ROWS * 512;
constexpr size_t WS_WDN8 = WS_WGU8 + (size_t)4 * 32 * 1024 * 1024;
constexpr size_t WS_YB8 = WS_WDN8 + (size_t)4 * 32 * 1024 * 512;
constexpr size_t WS_DELTA = WS_YB8 + (size_t)2 * NTOK * 1024;
constexpr size_t WS_END = WS_DELTA + (size_t)NTOK * 1024 * 2;
constexpr int CW_BAR = 0;
constexpr int CW_CNT = 8192;

constexpr int LDS_BYTES = 147456;
constexpr int LDS_MISC = 143360;
constexpr int NPH = 2 + 9 * DEPTH + 1;

__device__ __forceinline__ float bf2f(bf16_t b) { return __uint_as_float(((unsigned)b) << 16); }
__device__ __forceinline__ unsigned f2bf(float f) { unsigned u = __float_as_uint(f); return (u + 0x7fffu + ((u >> 16) & 1u)) >> 16; }
__device__ __forceinline__ unsigned pk2(float lo, float hi) { return f2bf(lo) | (f2bf(hi) << 16); }
__device__ __forceinline__ float wave_sum(float v) {
#pragma unroll
    for (int o = 1; o < 64; o <<= 1) v += __shfl_xor(v, o);
    return v;
}
__device__ __forceinline__ float frcp(float x) { return __builtin_amdgcn_rcpf(x); }
__device__ __forceinline__ float sigmoidf(float x) { return frcp(1.0f + __expf(-x)); }
__device__ __forceinline__ float siluf(float x) { return x * frcp(1.0f + __expf(-x)); }
__device__ __forceinline__ float clamp8(float v) { return __builtin_amdgcn_fmed3f(v, -416.0f, 416.0f); }
__device__ __forceinline__ unsigned pk4_fp8_raw(float a, float b, float c, float d) { int r = __builtin_amdgcn_cvt_pk_fp8_f32(a, b, 0, false); r = __builtin_amdgcn_cvt_pk_fp8_f32(c, d, r, true); return (unsigned)r; }
__device__ __forceinline__ unsigned pk4_fp8(float a, float b, float c, float d) { int r = __builtin_amdgcn_cvt_pk_fp8_f32(clamp8(a), clamp8(b), 0, false); r = __builtin_amdgcn_cvt_pk_fp8_f32(clamp8(c), clamp8(d), r, true); return (unsigned)r; }
__device__ __forceinline__ f32x4 unpk4_fp8(unsigned w) { const f32x2 lo = __builtin_amdgcn_cvt_pk_f32_fp8((int)w, false), hi = __builtin_amdgcn_cvt_pk_f32_fp8((int)w, true); return (f32x4){lo.x, lo.y, hi.x, hi.y}; }
typedef __bf16 bf16x2_t __attribute__((ext_vector_type(2)));
__device__ __forceinline__ f32x4 unpk4_bf16(u32x2 w) { return (f32x4){__uint_as_float(w.x << 16), __uint_as_float(w.x & 0xffff0000u), __uint_as_float(w.y << 16), __uint_as_float(w.y & 0xffff0000u)}; }
__device__ __forceinline__ unsigned cvtpk(float lo, float hi) { const f32x2 v = {lo, hi}; const bf16x2_t r = __builtin_convertvector(v, bf16x2_t); return __builtin_bit_cast(unsigned, r); }
__device__ __forceinline__ int mod_row(int r) { return r < NLAT ? (r >> 11) : 8; }
#define LDS_WAIT() asm volatile("s_waitcnt lgkmcnt(0)" ::: "memory")
__device__ __forceinline__ int otid() { int t = threadIdx.x; asm volatile("" : "+v"(t)); return t; }
__device__ __forceinline__ int obid() { int b = blockIdx.x; asm volatile("" : "+s"(b)); return b; }

#define XB_TMO      128
#define XB_XCNT(j)  (256  + 64 * (j))
#define XB_XSUB(j)  (1280 + 64 * (j))
#define XB_XGEN(j)  (2304 + 64 * (j))
#define XB_TOP      3328
#define XB_TOPGEN   3392
#define XCD_BAR_WORDS 3456
#define XB_SPIN_CAP (1u << 18)
__device__ __forceinline__ unsigned xb_ld(unsigned* p)              { return __hip_atomic_load(p, __ATOMIC_RELAXED, __HIP_MEMORY_SCOPE_AGENT); }
__device__ __forceinline__ unsigned xb_add(unsigned* p, unsigned v) { return __hip_atomic_fetch_add(p, v, __ATOMIC_RELAXED, __HIP_MEMORY_SCOPE_AGENT); }
__device__ __forceinline__ unsigned xb_xcc_id() { return (unsigned)__builtin_amdgcn_s_getreg((3 << 11) | 20) & 0xFu; }
#define XB_SPIN(cond, bar) do { unsigned _sp = 0; while (cond) { __builtin_amdgcn_s_sleep(1); \
    if ((++_sp & 255u) == 0u) { if (xb_ld(&(bar)[XB_TMO])) break; if (_sp > XB_SPIN_CAP) { atomicAdd(&(bar)[XB_TMO], 1u); break; } } } } while (0)
struct XcdBarrier { unsigned* bar; unsigned x; volatile LAS unsigned* st; };
__device__ __forceinline__ XcdBarrier xcd_barrier_post(unsigned* bar, volatile LAS unsigned* st) {
    XcdBarrier b; b.bar = bar; b.x = xb_xcc_id(); b.st = st;
    if (threadIdx.x == 0) (void)xb_add(&bar[XB_XCNT(b.x)], 1u);
    return b;
}
__device__ __forceinline__ void xcd_barrier_complete(unsigned* bar, unsigned x, unsigned& nloc, unsigned& nx) {
    const unsigned G = gridDim.x * gridDim.y * gridDim.z;
    unsigned sum, cnt, mine, sp = 0u;
    for (;;) {
        sum = 0u; cnt = 0u; mine = 0u;
#pragma unroll
        for (unsigned j = 0; j < 16; ++j) { const unsigned c = xb_ld(&bar[XB_XCNT(j)]); sum += c; cnt += (c > 0u) ? 1u : 0u; mine = (j == x) ? c : mine; }
        if (sum == G) break;
        __builtin_amdgcn_s_sleep(1);
        if ((++sp & 255u) == 0u) { if (xb_ld(&bar[XB_TMO])) break; if (sp > XB_SPIN_CAP) { atomicAdd(&bar[XB_TMO], 1u); break; } }
    }
    nloc = mine > 0u ? mine : 1u; nx = cnt > 0u ? cnt : 1u;
}
__device__ __forceinline__ void xcd_barrier(const XcdBarrier& b) {
    asm volatile("s_waitcnt vmcnt(0)" ::: "memory");
    __syncthreads();
    if (threadIdx.x == 0) {
        unsigned* bar = b.bar;
        __builtin_amdgcn_s_waitcnt(0);
        unsigned nloc = b.st[0], nx = b.st[1];
        if (nloc == 0u) { xcd_barrier_complete(bar, b.x, nloc, nx); b.st[0] = nloc; b.st[1] = nx; }
        const unsigned old = xb_add(&bar[XB_XSUB(b.x)], 1u);
        const unsigned gen = old / nloc;
        if (old + 1u == (gen + 1u) * nloc) {
            __builtin_amdgcn_fence(__ATOMIC_RELEASE, "agent");
            asm volatile("s_waitcnt vmcnt(0)" ::: "memory");
            const unsigned og = xb_add(&bar[XB_TOP], 1u);
            const unsigned tg = og / nx;
            if (og + 1u == (tg + 1u) * nx) xb_add(&bar[XB_TOPGEN], 1u);
            else XB_SPIN(xb_ld(&bar[XB_TOPGEN]) == tg, bar);
            __builtin_amdgcn_fence(__ATOMIC_ACQUIRE, "agent");
            xb_add(&bar[XB_XGEN(b.x)], 1u);
            asm volatile("s_waitcnt vmcnt(0)" ::: "memory");
        } else {
            XB_SPIN(xb_ld(&bar[XB_XGEN(b.x)]) == gen, bar);
            __builtin_amdgcn_fence(__ATOMIC_ACQUIRE, "agent");
            asm volatile("s_waitcnt vmcnt(0)" ::: "memory");
        }
    }
    __syncthreads();
}

struct Params {
    const float* in[20];
    float* out;
    unsigned char* ws;
    int ph_lo, ph_hi;
};

__device__ __forceinline__ unsigned char* ows(const Params& p) { GAS unsigned char* w = (GAS unsigned char*)p.ws; asm volatile("" : "+s"(w)); return (unsigned char*)w; }
__device__ __forceinline__ const float* oin(const Params& p, int k) { const GAS float* q = (const GAS float*)p.in[k]; asm volatile("" : "+s"(q)); return (const float*)q; }

template <class ARow, class Epi>
__device__ __forceinline__ void gemm128(unsigned char* lds, const ARow& arow, const bf16_t* __restrict__ Bt, int K, const Epi& epi) {
    const int tid = otid(), lane = tid & 63, wid = tid >> 6, wr = wid >> 2, wc = wid & 3, fr = lane & 15, fq = lane >> 4;
    bf16_t* sA = (bf16_t*)lds;
    bf16_t* sB = (bf16_t*)(lds + 128 * 144);
    f32x4 acc[4][2];
#pragma unroll
    for (int m = 0; m < 4; ++m)
#pragma unroll
        for (int n = 0; n < 2; ++n) acc[m][n] = (f32x4){0.f, 0.f, 0.f, 0.f};
    const bf16_t* ap[2]; const bf16_t* bp[2]; int so[2];
#pragma unroll
    for (int i = 0; i < 2; ++i) {
        const int q = tid + 512 * i, row = q >> 3, seg = q & 7;
        ap[i] = arow(row) + seg * 8; bp[i] = Bt + (size_t)row * K + seg * 8; so[i] = row * 72 + seg * 8;
    }
    for (int k0 = 0; k0 < K; k0 += 64) {
        u32x4 va[2], vb[2];
#pragma unroll
        for (int i = 0; i < 2; ++i) { va[i] = *(const u32x4*)(ap[i] + k0); vb[i] = *(const u32x4*)(bp[i] + k0); }
        __syncthreads();
#pragma unroll
        for (int i = 0; i < 2; ++i) { *(u32x4*)(sA + so[i]) = va[i]; *(u32x4*)(sB + so[i]) = vb[i]; }
        __syncthreads();
#pragma unroll
        for (int kk = 0; kk < 2; ++kk) {
            bf16x8 a[4], b[2];
#pragma unroll
            for (int m = 0; m < 4; ++m) a[m] = *(const bf16x8*)(sA + (wr * 64 + m * 16 + fr) * 72 + kk * 32 + fq * 8);
#pragma unroll
            for (int n = 0; n < 2; ++n) b[n] = *(const bf16x8*)(sB + (wc * 32 + n * 16 + fr) * 72 + kk * 32 + fq * 8);
#pragma unroll
            for (int m = 0; m < 4; ++m)
#pragma unroll
                for (int n = 0; n < 2; ++n) acc[m][n] = __builtin_amdgcn_mfma_f32_16x16x32_bf16(b[n], a[m], acc[m][n], 0, 0, 0);
        }
    }
#pragma unroll
    for (int m = 0; m < 4; ++m)
#pragma unroll
        for (int n = 0; n < 2; ++n) epi(wr * 64 + m * 16 + fr, wc * 32 + n * 16 + fq * 4, acc[m][n]);
    __syncthreads();
}

struct ARowPlain { const bf16_t* A; int ld; __device__ __forceinline__ const bf16_t* operator()(int i) const { return A + (size_t)i * ld; } };
struct ARowGather { const bf16_t* A; const int* tok; int nvalid; __device__ __forceinline__ const bf16_t* operator()(int i) const { const int t = (i < nvalid) ? (tok[i] >> 1) : 0; return A + (size_t)t * 1024; } };

struct EpiP { bf16_t* P; __device__ __forceinline__ void operator()(int r, int c, f32x4 v) const {
    u32x2 w; w.x = pk2(v[0], v[1]); w.y = pk2(v[2], v[3]); *(u32x2*)(P + (size_t)r * PW + c) = w; } };
struct EpiRes { float* X; const float* gate; int m0; __device__ __forceinline__ void operator()(int r, int c, f32x4 v) const {
    const float* g = gate + (size_t)mod_row(m0 + r) * 6144 + c; float* xp = X + (size_t)r * 1024 + c;
    f32x4 x = *(f32x4*)xp; const f32x4 gv = *(const f32x4*)g; x += gv * v; *(f32x4*)xp = x; } };
struct EpiGU { bf16_t* H; __device__ __forceinline__ void operator()(int r, int c, f32x4 v) const {
    const float h0 = siluf(v[0]) * v[1], h1 = siluf(v[2]) * v[3]; *(unsigned*)(H + (size_t)r * 512 + (c >> 1)) = pk2(h0, h1); } };
struct EpiDown { bf16_t* YB; const int* tok; const float* gate; int nvalid; __device__ __forceinline__ void operator()(int r, int c, f32x4 v) const {
    if (r < nvalid) { const int e = tok[r]; const float g = gate[r]; u32x2 w; w.x = pk2(g * v[0], g * v[1]); w.y = pk2(g * v[2], g * v[3]); *(u32x2*)(YB + (size_t)e * 1024 + c) = w; } } };


namespace g8 {
constexpr int BM = 256, BK = 64, HALF = 128, HTB = HALF * BK * 2, NXCD = 8, WGM = 8;
__device__ __forceinline__ int lds_byte(int r, int c) { const int st = (r >> 4) * 2 + (c >> 5), rr = r & 15, cc = c & 31, ob = rr * 64 + cc * 2; return st * 1024 + (ob ^ (((ob >> 9) & 1) << 5)); }
__device__ __forceinline__ void stage_rc(int b, int& R, int& C) { const int st = b / 1024, sb = b % 1024, swz = sb ^ (((sb >> 9) & 1) << 5); R = (st >> 1) * 16 + swz / 64; C = (st & 1) * 32 + (swz % 64) / 2; }
__device__ __forceinline__ int perm32(int rho) { const int n = rho >> 4, i = rho & 15; return 8 * (i >> 2) + 4 * n + (i & 3); }
__device__ __forceinline__ unsigned cvt_pk_bf16(float lo, float hi) { return cvtpk(lo, hi); }

__device__ __forceinline__ int g8_ra(int tid, int i) { int R, C; stage_rc(tid * 16 + i * 8192, R, C); return R; }
__device__ __forceinline__ unsigned g8_ca(int tid, int i) { int R, C; stage_rc(tid * 16 + i * 8192, R, C); return (unsigned)C * 2u; }
#define G8_RA(i) g8_ra(otid(), (i))
#define G8_CA(i) g8_ca(otid(), (i))
template <class Epi, class Sched>
__device__ __forceinline__ void gemm_phase(LAS unsigned char* lds, const char* Abase, const int K, const Sched& S, const Epi& E) {
    const int tid = otid(), wid = __builtin_amdgcn_readfirstlane(tid >> 6), lane = tid & 63, wr = wid >> 2, wc = wid & 3, fr = lane & 15, fq = lane >> 4;
    const int nt = K / BK;
    unsigned voffB[2];
#pragma unroll
    for (int i = 0; i < 2; ++i) { int R, C; stage_rc(tid * 16 + i * 8192, R, C); const int Rb = Epi::PERM ? ((R & ~31) + perm32(R & 31)) : R;
        voffB[i] = (unsigned)(Rb * K + C) * 2u; }
    const unsigned rowb = (unsigned)K * 2u;
    const size_t kstep = (size_t)(BK * 2);
    const size_t hstep = (size_t)HALF * K * 2;
    const unsigned ldsw = (unsigned)wid * 1024u;
    const int aoff = lds_byte(wr * 64 + fr, fq * 8), boff = lds_byte(wc * 32 + fr, fq * 8);
#define G8_SA(b, h) (((b) * 2 + (h)) * HTB)
#define G8_SB(b, h) ((4 + (b) * 2 + (h)) * HTB)
#define G8_STAGE(bufoff, gbase, voff) do { _Pragma("unroll") for (int _i = 0; _i < 2; ++_i) \
        __builtin_amdgcn_global_load_lds((const unsigned*)((const char*)(gbase) + (voff)[_i]), (LAS unsigned*)(lds + (bufoff) + ldsw + _i * 8192), 16, 0, 0); } while (0)
#define G8_LDA(dst, b, h) do { _Pragma("unroll") for (int m = 0; m < 4; ++m) _Pragma("unroll") for (int k = 0; k < 2; ++k) dst[m][k] = *(const LAS bf16x8*)(lds + G8_SA(b, h) + aoff + m * 2048 + k * 1024); } while (0)
#define G8_LDB(dst, b, h) do { _Pragma("unroll") for (int n = 0; n < 2; ++n) _Pragma("unroll") for (int k = 0; k < 2; ++k) dst[n][k] = *(const LAS bf16x8*)(lds + G8_SB(b, h) + boff + n * 2048 + k * 1024); } while (0)
#define G8_MMA(ai, bj, At, Bt) do { __builtin_amdgcn_s_setprio(1); _Pragma("unroll") for (int m = 0; m < 4; ++m) _Pragma("unroll") for (int n = 0; n < 2; ++n) _Pragma("unroll") for (int k = 0; k < 2; ++k) \
        acc[ai][bj][m][n] = __builtin_amdgcn_mfma_f32_16x16x32_bf16(Bt[n][k], At[m][k], acc[ai][bj][m][n], 0, 0, 0); __builtin_amdgcn_s_setprio(0); } while (0)
#define G8_WAIT_V(n) asm volatile("s_waitcnt vmcnt(" #n ")" ::: "memory")
#define G8_WAIT_L(n) asm volatile("s_waitcnt lgkmcnt(" #n ")" ::: "memory")
#define G8_BAR __builtin_amdgcn_s_barrier()
#define G8_SCHED __builtin_amdgcn_sched_barrier(0)
    typename Sched::Unit cur, nxt; int ui = 0;
    if (!S.next(0, cur)) return;
    f32x4 acc[2][2][4][2];
#pragma unroll
    for (int a = 0; a < 2; ++a)
#pragma unroll
        for (int b = 0; b < 2; ++b)
#pragma unroll
            for (int m = 0; m < 4; ++m)
#pragma unroll
                for (int n = 0; n < 2; ++n) acc[a][b][m][n] = (f32x4){0.f, 0.f, 0.f, 0.f};
    bf16x8 At[4][2], B0[2][2], B1[2][2];
    unsigned vAc[2][2], vAn[2][2];
#pragma unroll
    for (int h = 0; h < 2; ++h)
#pragma unroll
        for (int i = 0; i < 2; ++i) vAc[h][i] = (Sched::AFFINE ? (unsigned)(h * HALF + G8_RA(i)) : (unsigned)S.a_row(cur, h * HALF + G8_RA(i))) * rowb + G8_CA(i);
    const char* cA = Sched::AFFINE ? Abase + (size_t)S.a_row(cur, 0) * rowb : Abase;
    const char* cB = S.b_base(cur);
    G8_STAGE(G8_SB(0, 0), cB, voffB); G8_STAGE(G8_SA(0, 0), cA, vAc[0]); G8_STAGE(G8_SB(0, 1), cB + hstep, voffB); G8_STAGE(G8_SA(0, 1), cA, vAc[1]);
    if (wr == 1) G8_BAR;
    G8_WAIT_V(4); G8_BAR;
    G8_STAGE(G8_SB(1, 0), cB + kstep, voffB); G8_STAGE(G8_SA(1, 0), cA + kstep, vAc[0]); G8_STAGE(G8_SB(1, 1), cB + hstep + kstep, voffB);
    G8_WAIT_V(6); G8_BAR;
    for (;;) {
        const bool has_next = S.next(ui + 1, nxt);
#pragma unroll
        for (int h = 0; h < 2; ++h)
#pragma unroll
            for (int i = 0; i < 2; ++i) vAn[h][i] = (has_next && !Sched::AFFINE) ? ((unsigned)S.a_row(nxt, h * HALF + G8_RA(i)) * rowb + G8_CA(i)) : vAc[h][i];
        const char* nA = (has_next && Sched::AFFINE) ? Abase + (size_t)S.a_row(nxt, 0) * rowb : cA;
        const char* nB = has_next ? S.b_base(nxt) : cB;
        for (int t = 0; t < nt; t += 2) {
            const bool last = (t == nt - 2);
            const char* a1 = cA + (size_t)(t + 1) * kstep;
            const char* a2 = last ? nA : cA + (size_t)(t + 2) * kstep; const char* b2 = last ? nB : cB + (size_t)(t + 2) * kstep;
            const char* a3 = a2 + kstep; const char* b3 = b2 + kstep;
            unsigned v2[2][2];
#pragma unroll
            for (int h = 0; h < 2; ++h)
#pragma unroll
                for (int i = 0; i < 2; ++i) v2[h][i] = last ? vAn[h][i] : vAc[h][i];
            G8_LDB(B0, 0, 0); G8_SCHED; G8_LDA(At, 0, 0); G8_STAGE(G8_SA(1, 1), a1, vAc[1]);
            G8_WAIT_L(8); G8_BAR; G8_WAIT_L(0); G8_MMA(0, 0, At, B0); G8_BAR; G8_SCHED;
            G8_LDB(B1, 0, 1); G8_STAGE(G8_SB(0, 0), b2, voffB);
            G8_BAR; G8_WAIT_L(0); G8_MMA(0, 1, At, B1); G8_BAR;
            G8_LDA(At, 0, 1); G8_STAGE(G8_SA(0, 0), a2, v2[0]);
            G8_BAR; G8_WAIT_L(0); G8_MMA(1, 0, At, B0); G8_BAR; G8_SCHED;
            G8_STAGE(G8_SB(0, 1), b2 + hstep, voffB);
            G8_WAIT_V(6); G8_BAR; G8_MMA(1, 1, At, B1); G8_BAR;
            G8_LDB(B0, 1, 0); G8_SCHED; G8_LDA(At, 1, 0); G8_STAGE(G8_SA(0, 1), a2, v2[1]);
            G8_WAIT_L(8); G8_BAR; G8_WAIT_L(0); G8_MMA(0, 0, At, B0); G8_BAR; G8_SCHED;
            G8_LDB(B1, 1, 1); G8_STAGE(G8_SB(1, 0), b3, voffB);
            G8_BAR; G8_WAIT_L(0); G8_MMA(0, 1, At, B1); G8_BAR;
            G8_LDA(At, 1, 1); G8_STAGE(G8_SA(1, 0), a3, v2[0]);
            G8_BAR; G8_WAIT_L(0); G8_MMA(1, 0, At, B0); G8_BAR; G8_SCHED;
            G8_STAGE(G8_SB(1, 1), b3 + hstep, voffB);
            G8_WAIT_V(6); G8_BAR; G8_MMA(1, 1, At, B1); G8_BAR;
        }
        E(acc, cur, wr, wc, fr, fq);
        if (!has_next) break;
#pragma unroll
        for (int a = 0; a < 2; ++a)
#pragma unroll
            for (int b = 0; b < 2; ++b)
#pragma unroll
                for (int m = 0; m < 4; ++m)
#pragma unroll
                    for (int n = 0; n < 2; ++n) acc[a][b][m][n] = (f32x4){0.f, 0.f, 0.f, 0.f};
        cur = nxt; cB = nB; cA = nA; ++ui;
#pragma unroll
        for (int h = 0; h < 2; ++h)
#pragma unroll
            for (int i = 0; i < 2; ++i) vAc[h][i] = vAn[h][i];
    }
    G8_WAIT_V(0);
    if (wr == 0) G8_BAR;
    G8_BAR;
#undef G8_SA
#undef G8_SB
#undef G8_STAGE
#undef G8_LDA
#undef G8_LDB
#undef G8_MMA
#undef G8_WAIT_V
#undef G8_WAIT_L
#undef G8_BAR
#undef G8_SCHED
}

template <int sclW, int sclA, class Epi, class Sched>
__device__ __forceinline__ void gemm_phase8(LAS unsigned char* lds, const char* Abase, const int K, const Sched& S, const Epi& E) {
    const int tid = otid(), wid = __builtin_amdgcn_readfirstlane(tid >> 6), lane = tid & 63, wr = wid >> 2, wc = wid & 3, fr = lane & 15, fq = lane >> 4;
    const int nt = K / 128;
    unsigned voffB[2];
#pragma unroll
    for (int i = 0; i < 2; ++i) { int R, C; stage_rc(tid * 16 + i * 8192, R, C); const int Rb = Epi::PERM ? ((R & ~31) + perm32(R & 31)) : R;
        voffB[i] = (unsigned)(Rb * K) + (unsigned)C * 2u; }
    const unsigned rowb = (unsigned)K;
    const size_t kstep = (size_t)(BK * 2);
    const size_t hstep = (size_t)HALF * K;
    const unsigned ldsw = (unsigned)wid * 1024u;
    const int fob = fr * 64 + ((2 * (fq & 1)) ^ (2 * (fr >> 3))) * 16 + (fq >> 1) * 1024;
    const int aoff = ((wr * 64) >> 4) * 2048 + fob, boff = ((wc * 32) >> 4) * 2048 + fob;
#define G8_SA(b, h) (((b) * 2 + (h)) * HTB)
#define G8_SB(b, h) ((4 + (b) * 2 + (h)) * HTB)
#define G8_STAGE(bufoff, gbase, voff) do { _Pragma("unroll") for (int _i = 0; _i < 2; ++_i) \
        __builtin_amdgcn_global_load_lds((const unsigned*)((const char*)(gbase) + (voff)[_i]), (LAS unsigned*)(lds + (bufoff) + ldsw + _i * 8192), 16, 0, 0); } while (0)
#define G8_LDA(dst, b, h) do { _Pragma("unroll") for (int m = 0; m < 4; ++m) { const i32x4 _lo = *(const LAS i32x4*)(lds + G8_SA(b, h) + aoff + m * 2048), _hi = *(const LAS i32x4*)(lds + G8_SA(b, h) + aoff + m * 2048 + 16); dst[m] = __builtin_shufflevector(_lo, _hi, 0, 1, 2, 3, 4, 5, 6, 7); } } while (0)
#define G8_LDB(dst, b, h) do { _Pragma("unroll") for (int n = 0; n < 2; ++n) { const i32x4 _lo = *(const LAS i32x4*)(lds + G8_SB(b, h) + boff + n * 2048), _hi = *(const LAS i32x4*)(lds + G8_SB(b, h) + boff + n * 2048 + 16); dst[n] = __builtin_shufflevector(_lo, _hi, 0, 1, 2, 3, 4, 5, 6, 7); } } while (0)
#define G8_MMA(ai, bj, At, Bt) do { __builtin_amdgcn_s_setprio(1); _Pragma("unroll") for (int m = 0; m < 4; ++m) _Pragma("unroll") for (int n = 0; n < 2; ++n) \
        acc[ai][bj][m][n] = __builtin_amdgcn_mfma_scale_f32_16x16x128_f8f6f4(Bt[n], At[m], acc[ai][bj][m][n], 0, 0, 0, sclW, 0, sclA); \
        _Pragma("unroll") for (int m = 0; m < 4; ++m) asm volatile("" : "+v"(acc[ai][bj][m][0]), "+v"(acc[ai][bj][m][1]));   \
        __builtin_amdgcn_s_setprio(0); } while (0)
#define G8_WAIT_V(n) asm volatile("s_waitcnt vmcnt(" #n ")" ::: "memory")
#define G8_WAIT_L(n) asm volatile("s_waitcnt lgkmcnt(" #n ")" ::: "memory")
#define G8_BAR __builtin_amdgcn_s_barrier()
#define G8_SCHED __builtin_amdgcn_sched_barrier(0)
    typename Sched::Unit cur, nxt; int ui = 0;
    if (!S.next(0, cur)) return;
    f32x4 acc[2][2][4][2];
#pragma unroll
    for (int a = 0; a < 2; ++a)
#pragma unroll
        for (int b = 0; b < 2; ++b)
#pragma unroll
            for (int m = 0; m < 4; ++m)
#pragma unroll
                for (int n = 0; n < 2; ++n) acc[a][b][m][n] = (f32x4){0.f, 0.f, 0.f, 0.f};
    i32x8 At[4], B0[2], B1[2];
    unsigned vAc[2][2], vAn[2][2];
#pragma unroll
    for (int h = 0; h < 2; ++h)
#pragma unroll
        for (int i = 0; i < 2; ++i) vAc[h][i] = (Sched::AFFINE ? (unsigned)(h * HALF + G8_RA(i)) : (unsigned)S.a_row(cur, h * HALF + G8_RA(i))) * rowb + G8_CA(i);
    const char* cA = Sched::AFFINE ? Abase + (size_t)S.a_row(cur, 0) * rowb : Abase;
    const char* cB = S.b_base(cur);
    G8_STAGE(G8_SB(0, 0), cB, voffB); G8_STAGE(G8_SA(0, 0), cA, vAc[0]); G8_STAGE(G8_SB(0, 1), cB + hstep, voffB); G8_STAGE(G8_SA(0, 1), cA, vAc[1]);
    if (wr == 1) G8_BAR;
    G8_WAIT_V(4); G8_BAR;
    G8_STAGE(G8_SB(1, 0), cB + kstep, voffB); G8_STAGE(G8_SA(1, 0), cA + kstep, vAc[0]); G8_STAGE(G8_SB(1, 1), cB + hstep + kstep, voffB);
    G8_WAIT_V(6); G8_BAR;
    for (;;) {
        const bool has_next = S.next(ui + 1, nxt);
#pragma unroll
        for (int h = 0; h < 2; ++h)
#pragma unroll
            for (int i = 0; i < 2; ++i) vAn[h][i] = (has_next && !Sched::AFFINE) ? ((unsigned)S.a_row(nxt, h * HALF + G8_RA(i)) * rowb + G8_CA(i)) : vAc[h][i];
        const char* nA = (has_next && Sched::AFFINE) ? Abase + (size_t)S.a_row(nxt, 0) * rowb : cA;
        const char* nB = has_next ? S.b_base(nxt) : cB;
#pragma unroll 1
        for (int t = 0; t < nt; t += 2) {
            const bool last = (t == nt - 2);
            const char* a1 = cA + (size_t)(t + 1) * kstep;
            const char* a2 = last ? nA : cA + (size_t)(t + 2) * kstep; const char* b2 = last ? nB : cB + (size_t)(t + 2) * kstep;
            const char* a3 = a2 + kstep; const char* b3 = b2 + kstep;
            unsigned v2[2][2];
#pragma unroll
            for (int h = 0; h < 2; ++h)
#pragma unroll
                for (int i = 0; i < 2; ++i) v2[h][i] = last ? vAn[h][i] : vAc[h][i];
            G8_LDB(B0, 0, 0); G8_SCHED; G8_LDA(At, 0, 0); G8_STAGE(G8_SA(1, 1), a1, vAc[1]);
            G8_WAIT_L(8); G8_BAR; G8_WAIT_L(0); G8_MMA(0, 0, At, B0); G8_BAR; G8_SCHED;
            G8_LDB(B1, 0, 1); G8_STAGE(G8_SB(0, 0), b2, voffB);
            G8_BAR; G8_WAIT_L(0); G8_MMA(0, 1, At, B1); G8_BAR;
            G8_LDA(At, 0, 1); G8_STAGE(G8_SA(0, 0), a2, v2[0]);
            G8_BAR; G8_WAIT_L(0); G8_MMA(1, 0, At, B0); G8_BAR; G8_SCHED;
            G8_STAGE(G8_SB(0, 1), b2 + hstep, voffB);
            G8_WAIT_V(6); G8_BAR; G8_MMA(1, 1, At, B1); G8_BAR;
            G8_LDB(B0, 1, 0); G8_SCHED; G8_LDA(At, 1, 0); G8_STAGE(G8_SA(0, 1), a2, v2[1]);
            G8_WAIT_L(8); G8_BAR; G8_WAIT_L(0); G8_MMA(0, 0, At, B0); G8_BAR; G8_SCHED;
            G8_LDB(B1, 1, 1); G8_STAGE(G8_SB(1, 0), b3, voffB);
            G8_BAR; G8_WAIT_L(0); G8_MMA(0, 1, At, B1); G8_BAR;
            G8_LDA(At, 1, 1); G8_STAGE(G8_SA(1, 0), a3, v2[0]);
            G8_BAR; G8_WAIT_L(0); G8_MMA(1, 0, At, B0); G8_BAR; G8_SCHED;
            G8_STAGE(G8_SB(1, 1), b3 + hstep, voffB);
            G8_WAIT_V(6); G8_BAR; G8_MMA(1, 1, At, B1); G8_BAR;
        }
        E(acc, cur, wr, wc, fr, fq);
        if (!has_next) break;
#pragma unroll
        for (int a = 0; a < 2; ++a)
#pragma unroll
            for (int b = 0; b < 2; ++b)
#pragma unroll
                for (int m = 0; m < 4; ++m)
#pragma unroll
                    for (int n = 0; n < 2; ++n) acc[a][b][m][n] = (f32x4){0.f, 0.f, 0.f, 0.f};
        cur = nxt; cB = nB; cA = nA; ++ui;
#pragma unroll
        for (int h = 0; h < 2; ++h)
#pragma unroll
            for (int i = 0; i < 2; ++i) vAc[h][i] = vAn[h][i];
    }
    G8_WAIT_V(0);
    if (wr == 0) G8_BAR;
    G8_BAR;
#undef G8_SA
#undef G8_SB
#undef G8_STAGE
#undef G8_LDA
#undef G8_LDB
#undef G8_MMA
#undef G8_WAIT_V
#undef G8_WAIT_L
#undef G8_BAR
#undef G8_SCHED
}

struct DUnit { int pm, pn; };
struct DenseOrder {
    typedef DUnit Unit; static constexpr bool AFFINE = true;
    int nM, nN, nwg, G, c; const char* Bt; int K; int bpe;
    __device__ __forceinline__ void init(int nM_, int nN_, int G_, int c_, const void* Bt_, int K_, int bpe_ = 2) { nM = nM_; nN = nN_; nwg = nM * nN; G = G_; c = c_; Bt = (const char*)Bt_; K = K_; bpe = bpe_; }
    __device__ __forceinline__ bool next(int i, Unit& u) const {
        const long L = (long)i * G + c; if (L >= nwg) return false;
        int wgid = (int)L; { const int q = nwg / NXCD, r = nwg % NXCD, xcd = wgid % NXCD, off = wgid / NXCD; wgid = (xcd < r ? xcd * (q + 1) : r * (q + 1) + (xcd - r) * q) + off; }
        const int nig = WGM * nN, gid = wgid / nig, fm = gid * WGM, gsz = (nM - fm) < WGM ? (nM - fm) : WGM;
        u.pm = fm + ((wgid % nig) % gsz); u.pn = (wgid % nig) / gsz; return true;
    }
    __device__ __forceinline__ int a_row(const Unit& u, int r) const { return u.pm * BM + r; }
    __device__ __forceinline__ const char* b_base(const Unit& u) const { return Bt + (size_t)u.pn * BM * K * bpe; }
};
struct MUnit { int pm, pn, e, nvalid, lbase, idx; };
constexpr int MOE_UTAB = 131072, MOE_RTOK = MOE_UTAB + 128, MOE_RGATE = MOE_RTOK + 4096;
template <bool GATHER> struct MoeOrder {
    typedef MUnit Unit; static constexpr bool AFFINE = !GATHER;
    const int* utab; const int* rtok; const char* W; int K; int bpe;
    __device__ __forceinline__ bool next(int i, Unit& u) const {
        if (i >= 4) return false;
        const int* t = utab + i * 8;
        if (t[5] == 0) return false;
        u.pm = t[0]; u.pn = t[1]; u.e = t[2]; u.nvalid = t[3]; u.lbase = t[4]; u.idx = i; return true;
    }
    __device__ __forceinline__ int a_row(const Unit& u, int r) const { if (GATHER) return rtok[u.idx * 256 + r] >> 1; else return u.pm * BM + r; }
    __device__ __forceinline__ const char* b_base(const Unit& u) const { return W + ((size_t)u.e * 1024 + u.pn * BM) * K * bpe; }
};

struct EpiP2 {
    static constexpr bool PERM = true;
    bf16_t* P;
    __device__ __forceinline__ void operator()(const f32x4 (&acc)[2][2][4][2], const DUnit& u, int wr, int wc, int fr, int fq) const {
        const int row0 = u.pm * BM + wr * 64 + fr, col0 = u.pn * BM + wc * 32 + 8 * fq;
#pragma unroll
        for (int ai = 0; ai < 2; ++ai)
#pragma unroll
            for (int m = 0; m < 4; ++m) { bf16_t* rowp = P + (size_t)(row0 + ai * HALF + m * 16) * PW + col0;
#pragma unroll
                for (int bj = 0; bj < 2; ++bj) { const f32x4 v0 = acc[ai][bj][m][0], v1 = acc[ai][bj][m][1];
                    u32x4 w; w.x = cvt_pk_bf16(v0[0], v0[1]); w.y = cvt_pk_bf16(v0[2], v0[3]); w.z = cvt_pk_bf16(v1[0], v1[1]); w.w = cvt_pk_bf16(v1[2], v1[3]);
                    *(u32x4*)(rowp + bj * HALF) = w; } }
    }
};
struct EpiRes2 {
    static constexpr bool PERM = false;
    float* X; const float* gate; float scl;
    __device__ __forceinline__ void operator()(const f32x4 (&acc)[2][2][4][2], const DUnit& u, int wr, int wc, int fr, int fq) const {
        const int row0 = u.pm * BM + wr * 64 + fr, col0 = u.pn * BM + wc * 32 + 4 * fq;
#pragma unroll
        for (int ai = 0; ai < 2; ++ai)
#pragma unroll
            for (int m = 0; m < 4; ++m) { const int r = row0 + ai * HALF + m * 16; float* rowp = X + (size_t)r * 1024 + col0; const float* gp = gate + (size_t)mod_row(r) * 6144 + col0;
#pragma unroll
                for (int bj = 0; bj < 2; ++bj)
#pragma unroll
                    for (int n = 0; n < 2; ++n) { const f32x4 gv = *(const f32x4*)(gp + bj * HALF + n * 16); f32x4 x = *(f32x4*)(rowp + bj * HALF + n * 16); x += (gv * scl) * acc[ai][bj][m][n]; *(f32x4*)(rowp + bj * HALF + n * 16) = x; }
                asm volatile("" ::: "memory"); }
    }
};
struct EpiDelta {
    static constexpr bool PERM = true;
    bf16_t* Dl; const float* gate; float scl;
    __device__ __forceinline__ void operator()(const f32x4 (&acc)[2][2][4][2], const DUnit& u, int wr, int wc, int fr, int fq) const {
        const int row0 = u.pm * BM + wr * 64 + fr, col0 = u.pn * BM + wc * 32 + 8 * fq;
#pragma unroll
        for (int ai = 0; ai < 2; ++ai)
#pragma unroll
            for (int m = 0; m < 4; ++m) { const int r = row0 + ai * HALF + m * 16; bf16_t* rowp = Dl + (size_t)r * 1024 + col0; const float* gp = gate + (size_t)mod_row(r) * 6144 + col0;
#pragma unroll
                for (int bj = 0; bj < 2; ++bj) { const f32x4 g0 = *(const f32x4*)(gp + bj * HALF) * scl, g1 = *(const f32x4*)(gp + bj * HALF + 4) * scl;
                    const f32x4 v0 = acc[ai][bj][m][0] * g0, v1 = acc[ai][bj][m][1] * g1;
                    u32x4 w; w.x = cvt_pk_bf16(v0[0], v0[1]); w.y = cvt_pk_bf16(v0[2], v0[3]); w.z = cvt_pk_bf16(v1[0], v1[1]); w.w = cvt_pk_bf16(v1[2], v1[3]);
                    *(u32x4*)(rowp + bj * HALF) = w; } }
    }
};
struct EpiGU2 {
    static constexpr bool PERM = true;
    bf16_t* H;
    __device__ __forceinline__ void operator()(const f32x4 (&acc)[2][2][4][2], const MUnit& u, int wr, int wc, int fr, int fq) const {
        const int row0 = u.pm * BM + wr * 64 + fr, col0 = u.pn * BM + wc * 32 + 8 * fq;
#pragma unroll
        for (int ai = 0; ai < 2; ++ai)
#pragma unroll
            for (int m = 0; m < 4; ++m) { bf16_t* rowp = H + (size_t)(row0 + ai * HALF + m * 16) * 512 + (col0 >> 1);
#pragma unroll
                for (int bj = 0; bj < 2; ++bj) { const f32x4 v0 = acc[ai][bj][m][0], v1 = acc[ai][bj][m][1];
                    u32x2 w; w.x = cvt_pk_bf16(siluf(v0[0]) * v0[1], siluf(v0[2]) * v0[3]); w.y = cvt_pk_bf16(siluf(v1[0]) * v1[1], siluf(v1[2]) * v1[3]);
                    *(u32x2*)(rowp + bj * (HALF / 2)) = w; } }
    }
};
struct EpiGU8 {
    static constexpr bool PERM = true;
    unsigned char* H;
    __device__ __forceinline__ void operator()(const f32x4 (&acc)[2][2][4][2], const MUnit& u, int wr, int wc, int fr, int fq) const {
        const int row0 = u.pm * BM + wr * 64 + fr, col0 = u.pn * BM + wc * 32 + 8 * fq;
#pragma unroll
        for (int ai = 0; ai < 2; ++ai)
#pragma unroll
            for (int m = 0; m < 4; ++m) { unsigned char* rowp = H + (size_t)(row0 + ai * HALF + m * 16) * 512 + (col0 >> 1);
#pragma unroll
                for (int bj = 0; bj < 2; ++bj) { const f32x4 v0 = acc[ai][bj][m][0], v1 = acc[ai][bj][m][1];
                    *(unsigned*)(rowp + bj * (HALF / 2)) = pk4_fp8(2.0f * siluf(v0[0]) * v0[1], 2.0f * siluf(v0[2]) * v0[3], 2.0f * siluf(v1[0]) * v1[1], 2.0f * siluf(v1[2]) * v1[3]); } }
    }
};
struct EpiDown2 {
    static constexpr bool PERM = true;
    bf16_t* YB; const int* rtok; const float* rgate;
    __device__ __forceinline__ void operator()(const f32x4 (&acc)[2][2][4][2], const MUnit& u, int wr, int wc, int fr, int fq) const {
        const int r0 = wr * 64 + fr, col0 = u.pn * BM + wc * 32 + 8 * fq;
#pragma unroll
        for (int ai = 0; ai < 2; ++ai)
#pragma unroll
            for (int m = 0; m < 4; ++m) { const int rt = r0 + ai * HALF + m * 16;
                if (rt < u.nvalid) { const int ent = rtok[u.idx * 256 + rt]; const float g = rgate[u.idx * 256 + rt]; bf16_t* rowp = YB + (size_t)ent * 1024 + col0;
#pragma unroll
                    for (int bj = 0; bj < 2; ++bj) { const f32x4 v0 = acc[ai][bj][m][0] * g, v1 = acc[ai][bj][m][1] * g;
                        u32x4 w; w.x = cvt_pk_bf16(v0[0], v0[1]); w.y = cvt_pk_bf16(v0[2], v0[3]); w.z = cvt_pk_bf16(v1[0], v1[1]); w.w = cvt_pk_bf16(v1[2], v1[3]);
                        *(u32x4*)(rowp + bj * HALF) = w; } } }
    }
};
struct EpiDown8 {
    static constexpr bool PERM = true;
    unsigned char* YB; const int* rtok; const float* rgate;
    __device__ __forceinline__ void operator()(const f32x4 (&acc)[2][2][4][2], const MUnit& u, int wr, int wc, int fr, int fq) const {
        const int r0 = wr * 64 + fr, col0 = u.pn * BM + wc * 32 + 8 * fq;
#pragma unroll
        for (int ai = 0; ai < 2; ++ai)
#pragma unroll
            for (int m = 0; m < 4; ++m) { const int rt = r0 + ai * HALF + m * 16;
                if (rt < u.nvalid) { const int ent = rtok[u.idx * 256 + rt]; const float g = 64.0f * rgate[u.idx * 256 + rt]; unsigned char* rowp = YB + (size_t)ent * 1024 + col0;
#pragma unroll
                    for (int bj = 0; bj < 2; ++bj) { const f32x4 v0 = acc[ai][bj][m][0] * g, v1 = acc[ai][bj][m][1] * g;
                        u32x2 w; w.x = pk4_fp8(v0[0], v0[1], v0[2], v0[3]); w.y = pk4_fp8(v1[0], v1[1], v1[2], v1[3]);
                        *(u32x2*)(rowp + bj * HALF) = w; } } }
    }
};
}

__device__ __forceinline__ void transpose_item(const float* __restrict__ W, int K, int N, bf16_t* __restrict__ WT, int mode, float* scr, int item, int lane) {
    const int nblk = N / 32, kb = item / nblk, nb = item % nblk, k0 = 64 * kb, n0 = 32 * nb;
    float wv[32];
#pragma unroll
    for (int i = 0; i < 32; ++i) wv[i] = __builtin_nontemporal_load(W + (size_t)(k0 + 2 * i + (lane >> 5)) * N + n0 + (lane & 31));
#pragma unroll
    for (int i = 0; i < 32; ++i) scr[(2 * i + (lane >> 5)) * 33 + (lane & 31)] = wv[i];
    LDS_WAIT();
    const int c = lane & 7;
#pragma unroll
    for (int j = 0; j < 4; ++j) {
        const int n = (lane >> 3) + 8 * j; const float* s = scr + (8 * c) * 33 + n;
        u32x4 o; o.x = pk2(s[0 * 33], s[1 * 33]); o.y = pk2(s[2 * 33], s[3 * 33]); o.z = pk2(s[4 * 33], s[5 * 33]); o.w = pk2(s[6 * 33], s[7 * 33]);
        const int nabs = n0 + n; const int orow = mode ? ((nabs < 512) ? 2 * nabs : 2 * (nabs - 512) + 1) : nabs;
        *(u32x4*)(WT + (size_t)orow * K + k0 + 8 * c) = o;
    }
    LDS_WAIT();
}


__device__ __forceinline__ void transpose_item8(const float* __restrict__ W, int K, int N, unsigned char* __restrict__ WT, int mode, float scale, float* scr, int item, int lane) {
    const int nblk = N / 32, kb = item / nblk, nb = item % nblk, k0 = 64 * kb, n0 = 32 * nb;
    float wv[32];
#pragma unroll
    for (int i = 0; i < 32; ++i) wv[i] = __builtin_nontemporal_load(W + (size_t)(k0 + 2 * i + (lane >> 5)) * N + n0 + (lane & 31));
#pragma unroll
    for (int i = 0; i < 32; ++i) scr[(2 * i + (lane >> 5)) * 33 + (lane & 31)] = wv[i] * scale;
    LDS_WAIT();
    const int c = lane & 7;
#pragma unroll
    for (int j = 0; j < 4; ++j) {
        const int n = (lane >> 3) + 8 * j; const float* s = scr + (8 * c) * 33 + n;
        u32x2 o; o.x = pk4_fp8(s[0 * 33], s[1 * 33], s[2 * 33], s[3 * 33]); o.y = pk4_fp8(s[4 * 33], s[5 * 33], s[6 * 33], s[7 * 33]);
        const int nabs = n0 + n; const int orow = mode ? ((nabs < 512) ? 2 * nabs : 2 * (nabs - 512) + 1) : nabs;
        *(u32x2*)(WT + (size_t)orow * K + k0 + 8 * c) = o;
    }
    LDS_WAIT();
}

__device__ __forceinline__ void convert_experts(const Params& p, int l, float* scr, int widx, int nwv, int it0, int it1) {
    const int tid = otid(), lane = tid & 63;
    bf16_t* wgu_t = (bf16_t*)(ows(p) + WS_WGU) + (size_t)l * 32 * 1024 * 1024; bf16_t* wdn_t = (bf16_t*)(ows(p) + WS_WDN) + (size_t)l * 32 * 1024 * 512;
    const float* wgu = oin(p, 17) + (size_t)l * 32 * 1024 * 1024; const float* wdn = oin(p, 18) + (size_t)l * 32 * 512 * 1024;
    constexpr int I_GU = 16 * 32, I_DN = 8 * 32, T_GU = 32 * I_GU;
    unsigned char* wgu8 = ows(p) + WS_WGU8 + (size_t)l * 32 * 1024 * 1024; unsigned char* wdn8 = ows(p) + WS_WDN8 + (size_t)l * 32 * 1024 * 512;
    for (int it = it0 + widx; it < it1; it += nwv) {
        if (it < T_GU) { const int m = it / I_GU;
            if (MOE_FP8) transpose_item8(wgu + (size_t)m * 1024 * 1024, 1024, 1024, wgu8 + (size_t)m * 1024 * 1024, 1, 32.0f, scr, it % I_GU, lane);
            else transpose_item(wgu + (size_t)m * 1024 * 1024, 1024, 1024, wgu_t + (size_t)m * 1024 * 1024, 1, scr, it % I_GU, lane); }
        else { const int r = it - T_GU, m = r / I_DN;
            if (MOE_FP8) transpose_item8(wdn + (size_t)m * 512 * 1024, 512, 1024, wdn8 + (size_t)m * 1024 * 512, 0, 16.0f, scr, r % I_DN, lane);
            else transpose_item(wdn + (size_t)m * 512 * 1024, 512, 1024, wdn_t + (size_t)m * 1024 * 512, 0, scr, r % I_DN, lane); }
    }
}

__device__ __forceinline__ void phase_prologue(const Params& p, unsigned char* lds) {
    const int tid = otid(), lane = tid & 63, wid = tid >> 6;
    float* scr = (float*)(lds + wid * 16384);
    const int gw = obid() * 8 + wid, NGW = gridDim.x * 8;
    bf16_t* win_t = (bf16_t*)(ows(p) + WS_WIN); bf16_t* wout_t = (bf16_t*)(ows(p) + WS_WOUT);
    constexpr int I_IN = 16 * 128, I_OUT = 16 * 32;
    constexpr int T_IN = 4 * I_IN, T_OUT = 4 * I_OUT;
    for (int it = gw; it < T_IN + T_OUT; it += NGW) {
        int r = it;
        if (r < T_IN) { const int m = r / I_IN; transpose_item(oin(p, 7) + (size_t)m * 1024 * 4096, 1024, 4096, win_t + (size_t)m * 4096 * 1024, 0, scr, r % I_IN, lane); continue; } r -= T_IN;
        { const int m = r / I_OUT;
          if (G2_FP8) transpose_item8(oin(p, 12) + (size_t)m * 1024 * 1024, 1024, 1024, (unsigned char*)wout_t + (size_t)m * 1024 * 1024, 0, 32.0f, scr, r % I_OUT, lane);
          else transpose_item(oin(p, 12) + (size_t)m * 1024 * 1024, 1024, 1024, wout_t + (size_t)m * 1024 * 1024, 0, scr, r % I_OUT, lane); }
    }
    {
        bf16_t* wrh = (bf16_t*)(ows(p) + WS_WRH); bf16_t* wrl = (bf16_t*)(ows(p) + WS_WRL);
        for (int i = obid() * 512 + tid; i < 4 * 48 * 1024; i += gridDim.x * 512) {
            const int l = i / (48 * 1024), j = (i / 1024) % 48, k = i % 1024;
            float w = 0.f;
            if (j < 4) w = oin(p, 13)[((size_t)l * 1024 + k) * 4 + j]; else if (j < 36) w = oin(p, 15)[((size_t)l * 1024 + k) * 32 + (j - 4)];
            const unsigned hi = f2bf(w); const float rem = w - __uint_as_float(hi << 16);
            wrh[i] = (bf16_t)hi; wrl[i] = (bf16_t)f2bf(rem);
        }
    }
    __syncthreads();
    float* modp = (float*)(ows(p) + WS_MODP);
    float* sS = (float*)lds;
    for (int u = obid(); u < 4 * 24 * 8; u += gridDim.x) {
        const int l = u / 192, rem = u % 192, nb = rem / 8, ks = rem % 8;
        __syncthreads();
        for (int i = tid; i < 9 * 128; i += 512) { const int r = i >> 7, k = i & 127; const float cv = (r < 8) ? oin(p, 1)[r * 1024 + ks * 128 + k] : oin(p, 3)[ks * 128 + k]; sS[i] = siluf(cv); }
        __syncthreads();
        const int col = nb * 256 + (tid & 255), kh = tid >> 8;
        float acc[9];
#pragma unroll
        for (int r = 0; r < 9; ++r) acc[r] = 0.f;
        const float* w = oin(p, 5) + ((size_t)l * 1024 + ks * 128 + kh * 64) * 6144 + col;
        for (int k = 0; k < 64; ++k) {
            const float wv = w[(size_t)k * 6144];
#pragma unroll
            for (int r = 0; r < 9; ++r) acc[r] += sS[r * 128 + kh * 64 + k] * wv;
        }
#pragma unroll
        for (int r = 0; r < 9; ++r) modp[(((size_t)l * NMODP + ks * 2 + kh) * 9 + r) * 6144 + col] = acc[r];
    }
}

__device__ __forceinline__ void phase_modreduce(const Params& p) {
    const float* modp = (const float*)(ows(p) + WS_MODP); float* modv = (float*)(ows(p) + WS_MOD);
    for (int i = obid() * 512 + otid(); i < 4 * 9 * 6144; i += gridDim.x * 512) {
        const int l = i / (9 * 6144), rem = i % (9 * 6144), n = rem % 6144;
        float s = oin(p, 6)[l * 6144 + n];
        for (int j = 0; j < NMODP; ++j) s += modp[((size_t)l * NMODP + j) * 9 * 6144 + rem];
        modv[i] = s;
    }
}

__device__ __forceinline__ void phase_norm1(const Params& p, int l, float scl) {
    const int lane = otid() & 63, wid = otid() >> 6;
    bf16_t* xws = (bf16_t*)(ows(p) + WS_X); bf16_t* hb = (bf16_t*)(ows(p) + WS_H); const bf16_t* yb = (const bf16_t*)(ows(p) + WS_YB);
    const float* modv = (const float*)(ows(p) + WS_MOD);
    const float* nw = oin(p, 4) + (size_t)(l * 2 + 0) * 1024;
    for (int r = obid() * 8 + wid; r < NTOK; r += gridDim.x * 8) {
        const int mr = mod_row(r);
        f32x4 v[4];
        if (l == 0) { const float* src = r < NLAT ? oin(p, 0) + (size_t)r * 1024 : oin(p, 2) + (size_t)(r - NLAT) * 1024;
#pragma unroll
            for (int j = 0; j < 4; ++j) v[j] = *(const f32x4*)(src + 4 * lane + 256 * j); }
        else {
#pragma unroll
            for (int j = 0; j < 4; ++j) v[j] = unpk4_bf16(*(const u32x2*)(xws + (size_t)r * 1024 + 4 * lane + 256 * j)); }
        if (l > 0) {
            const float* g5 = modv + ((size_t)(l - 1) * 9 + mr) * 6144 + 5 * 1024;
#pragma unroll
            for (int j = 0; j < 4; ++j) {
                const int c = 4 * lane + 256 * j;
                const f32x4 gv = *(const f32x4*)(g5 + c);
                f32x4 f;
                if (MOE_FP8) { const unsigned char* y8 = ows(p) + WS_YB8; f = (unpk4_fp8(*(const unsigned*)(y8 + (size_t)(2 * r) * 1024 + c)) + unpk4_fp8(*(const unsigned*)(y8 + (size_t)(2 * r + 1) * 1024 + c))) * (1.0f / 64.0f); }
                else { const u32x2 y0 = *(const u32x2*)(yb + (size_t)(2 * r) * 1024 + c), y1 = *(const u32x2*)(yb + (size_t)(2 * r + 1) * 1024 + c);
                f[0] = bf2f(y0.x & 0xffff) + bf2f(y1.x & 0xffff); f[1] = bf2f(y0.x >> 16) + bf2f(y1.x >> 16);
                f[2] = bf2f(y0.y & 0xffff) + bf2f(y1.y & 0xffff); f[3] = bf2f(y0.y >> 16) + bf2f(y1.y >> 16); }
                v[j] += (gv * scl) * f;
            }
        }
#pragma unroll
        for (int j = 0; j < 4; ++j) { u32x2 o; o.x = cvtpk(v[j][0], v[j][1]); o.y = cvtpk(v[j][2], v[j][3]); *(u32x2*)(xws + (size_t)r * 1024 + 4 * lane + 256 * j) = o; }
        float ss = 0.f;
#pragma unroll
        for (int j = 0; j < 4; ++j) ss += (v[j][0] * v[j][0] + v[j][1] * v[j][1]) + (v[j][2] * v[j][2] + v[j][3] * v[j][3]);
        const float rstd = rsqrtf(wave_sum(ss) * (1.0f / 1024.0f) + EPS);
        const float* msh = modv + ((size_t)l * 9 + mr) * 6144; const float* msc = msh + 1024;
#pragma unroll
        for (int j = 0; j < 4; ++j) {
            const int c = 4 * lane + 256 * j;
            const f32x4 w = *(const f32x4*)(nw + c), sh = *(const f32x4*)(msh + c), sc = *(const f32x4*)(msc + c);
            const f32x4 h = (v[j] * rstd * w) * (1.0f + sc) + sh;
            u32x2 o; o.x = pk2(h[0], h[1]); o.y = pk2(h[2], h[3]);
            *(u32x2*)(hb + (size_t)r * 1024 + c) = o;
        }
    }
}

__device__ __forceinline__ void phase_final(const Params& p) {
    const int lane = otid() & 63, wid = otid() >> 6;
    const bf16_t* xws = (const bf16_t*)(ows(p) + WS_X); const bf16_t* yb = (const bf16_t*)(ows(p) + WS_YB);
    const float* modv = (const float*)(ows(p) + WS_MOD); const float* nw = oin(p, 19);
    for (int r = obid() * 8 + wid; r < NLAT; r += gridDim.x * 8) {
        const int mr = mod_row(r);
        const float* g5 = modv + ((size_t)3 * 9 + mr) * 6144 + 5 * 1024;
        f32x4 v[4]; float ss = 0.f;
#pragma unroll
        for (int j = 0; j < 4; ++j) {
            const int c = 4 * lane + 256 * j;
            v[j] = unpk4_bf16(*(const u32x2*)(xws + (size_t)r * 1024 + c));
            const f32x4 gv = *(const f32x4*)(g5 + c);
            f32x4 f;
            if (MOE_FP8) { const unsigned char* y8 = ows(p) + WS_YB8; f = (unpk4_fp8(*(const unsigned*)(y8 + (size_t)(2 * r) * 1024 + c)) + unpk4_fp8(*(const unsigned*)(y8 + (size_t)(2 * r + 1) * 1024 + c))) * (1.0f / 64.0f); }
            else { const u32x2 y0 = *(const u32x2*)(yb + (size_t)(2 * r) * 1024 + c), y1 = *(const u32x2*)(yb + (size_t)(2 * r + 1) * 1024 + c);
            f[0] = bf2f(y0.x & 0xffff) + bf2f(y1.x & 0xffff); f[1] = bf2f(y0.x >> 16) + bf2f(y1.x >> 16);
            f[2] = bf2f(y0.y & 0xffff) + bf2f(y1.y & 0xffff); f[3] = bf2f(y0.y >> 16) + bf2f(y1.y >> 16); }
            v[j] += gv * f;
            ss += (v[j][0] * v[j][0] + v[j][1] * v[j][1]) + (v[j][2] * v[j][2] + v[j][3] * v[j][3]);
        }
        const float rstd = rsqrtf(wave_sum(ss) * (1.0f / 1024.0f) + EPS);
#pragma unroll
        for (int j = 0; j < 4; ++j) { const int c = 4 * lane + 256 * j; const f32x4 w = *(const f32x4*)(nw + c); *(f32x4*)(p.out + (size_t)r * 1024 + c) = v[j] * rstd * w; }
    }
}

__device__ __forceinline__ void phase_gemm1(const Params& p, int l, unsigned char* lds) {
    const bf16_t* hb = (const bf16_t*)(ows(p) + WS_H); const bf16_t* wt = (const bf16_t*)(ows(p) + WS_WIN) + (size_t)l * 4096 * 1024; bf16_t* pb = (bf16_t*)(ows(p) + WS_P);
    constexpr int NT = PW / 128, MT = NTOK / 128;
    for (int u = obid(); u < MT * NT; u += gridDim.x) {
        const int mt = u / NT, nt = u % NT;
        ARowPlain ar{hb + (size_t)mt * 128 * 1024, 1024};
        EpiP ep{pb + (size_t)mt * 128 * PW + nt * 128};
        gemm128(lds, ar, wt + (size_t)nt * 128 * 1024, 1024, ep);
    }
}

__device__ __forceinline__ void unpack8(const u32x4 w, float (&f)[8]) {
    f[0] = bf2f(w.x & 0xffff); f[1] = bf2f(w.x >> 16); f[2] = bf2f(w.y & 0xffff); f[3] = bf2f(w.y >> 16);
    f[4] = bf2f(w.z & 0xffff); f[5] = bf2f(w.z >> 16); f[6] = bf2f(w.w & 0xffff); f[7] = bf2f(w.w >> 16);
}
__device__ __forceinline__ void conv_rows(const Params& p, int l, int widx, int nwv) {
    const int lane = otid() & 63;
    const bf16_t* pb = (const bf16_t*)(ows(p) + WS_P); bf16_t* yb = (bf16_t*)(ows(p) + WS_Y);
    const float* cw = oin(p, 8) + (size_t)l * 3 * 512; const float* cnw = oin(p, 9) + (size_t)l * 512;
    const int nrows = (l == DEPTH - 1) ? NLAT : NTOK;
    const int c0 = lane * 8;
    float w0[8], w1[8], w2[8], nwv8[8];
#pragma unroll
    for (int j = 0; j < 8; ++j) { w0[j] = cw[c0 + j]; w1[j] = cw[512 + c0 + j]; w2[j] = cw[1024 + c0 + j]; nwv8[j] = cnw[c0 + j]; }
    constexpr int NB = 4;
    for (int rb = widx; rb < nrows; rb += NB * nwv) {
        u32x4 vb[NB], vc[NB], vh[NB], vcm[NB], vhm[NB], vcp[NB], vhp[NB]; bool hm[NB], hp[NB];
#pragma unroll
        for (int q = 0; q < NB; ++q) {
            int r = rb + q * nwv; if (r >= nrows) r = rb;
            int rm = -1, rp = -1;
            if (r < NLAT) {
                const int t = r & 2047;
                if (c0 < 256) { if ((t & 63) > 0) rm = r - 1; if ((t & 63) < 63) rp = r + 1; }
                else { if (t >= 64) rm = r - 64; if (t < SEQ - 64) rp = r + 64; }
            } else { const int tc = (r - NLAT) & 255; if (tc > 0) rm = r - 1; if (tc < 255) rp = r + 1; }
            hm[q] = rm >= 0; hp[q] = rp >= 0; if (rm < 0) rm = r; if (rp < 0) rp = r;
            vb[q] = *(const u32x4*)(pb + (size_t)r * PW + OFF_B + c0); vc[q] = *(const u32x4*)(pb + (size_t)r * PW + OFF_C + c0); vh[q] = *(const u32x4*)(pb + (size_t)r * PW + OFF_HV + c0);
            vcm[q] = *(const u32x4*)(pb + (size_t)rm * PW + OFF_C + c0); vhm[q] = *(const u32x4*)(pb + (size_t)rm * PW + OFF_HV + c0);
            vcp[q] = *(const u32x4*)(pb + (size_t)rp * PW + OFF_C + c0); vhp[q] = *(const u32x4*)(pb + (size_t)rp * PW + OFF_HV + c0);
        }
#pragma unroll
        for (int q = 0; q < NB; ++q) {
            const int r = rb + q * nwv;
            float bg[8], u0[8], um[8], up[8], t1[8];
            unpack8(vb[q], bg); unpack8(vc[q], u0); unpack8(vh[q], t1);
#pragma unroll
            for (int j = 0; j < 8; ++j) u0[j] *= t1[j];
            unpack8(vcm[q], um); unpack8(vhm[q], t1);
#pragma unroll
            for (int j = 0; j < 8; ++j) um[j] = hm[q] ? um[j] * t1[j] : 0.f;
            unpack8(vcp[q], up); unpack8(vhp[q], t1);
#pragma unroll
            for (int j = 0; j < 8; ++j) up[j] = hp[q] ? up[j] * t1[j] : 0.f;
            float z[8]; float ss = 0.f;
#pragma unroll
            for (int j = 0; j < 8; ++j) { z[j] = bg[j] * (w0[j] * um[j] + w1[j] * u0[j] + w2[j] * up[j]); ss += z[j] * z[j]; }
            const float rstd = rsqrtf(wave_sum(ss) * (1.0f / 512.0f) + EPS);
            if (G2_FP8) {
                const float rs8 = rstd * 8.0f; u32x2 o8;
                o8.x = pk4_fp8(z[0] * rs8 * nwv8[0], z[1] * rs8 * nwv8[1], z[2] * rs8 * nwv8[2], z[3] * rs8 * nwv8[3]); o8.y = pk4_fp8(z[4] * rs8 * nwv8[4], z[5] * rs8 * nwv8[5], z[6] * rs8 * nwv8[6], z[7] * rs8 * nwv8[7]);
                if (r < nrows) *(u32x2*)((unsigned char*)yb + (size_t)r * 1024 + c0) = o8;
            } else {
            u32x4 o;
            o.x = cvtpk(z[0] * rstd * nwv8[0], z[1] * rstd * nwv8[1]); o.y = cvtpk(z[2] * rstd * nwv8[2], z[3] * rstd * nwv8[3]);
            o.z = cvtpk(z[4] * rstd * nwv8[4], z[5] * rstd * nwv8[5]); o.w = cvtpk(z[6] * rstd * nwv8[6], z[7] * rstd * nwv8[7]);
            if (r < nrows) *(u32x4*)(yb + (size_t)r * 1024 + c0) = o; }
        }
    }
}

template <int DIR>
__device__ __forceinline__ void gla_pre_dir(const Params& p, int l, int chunk, float* sQ, float* sK, const float* sV, float* sA, float* sBq, float (&oacc)[16]) {
    const int ch = otid(), tid = otid(), R0 = chunk * 16;
    const bf16_t* pb = (const bf16_t*)(ows(p) + WS_P);
    bf16_t* qin = (bf16_t*)(ows(p) + WS_QIN); bf16_t* kout = (bf16_t*)(ows(p) + WS_KOUT); float* dch = (float*)(ows(p) + WS_DCH);
    float lbv = 0.f;
    {
        const float* lb = oin(p, 10) + (size_t)DIR * 4 * 512 + ch;
        const float z0 = lb[0], z1 = lb[512], z2 = lb[1024], z3 = lb[1536];
        const float mx = fmaxf(fmaxf(z0, z1), fmaxf(z2, z3));
        const float e0 = __expf(z0 - mx), e1 = __expf(z1 - mx), e2 = __expf(z2 - mx), e3 = __expf(z3 - mx);
        const float inv = 1.0f / (e0 + e1 + e2 + e3);
        lbv = ((l >= 1 ? e1 : 0.f) + (l >= 2 ? e2 : 0.f) + (l >= 3 ? e3 : 0.f)) * inv;
    }
    float b = 0.f;
#pragma unroll 1
    for (int i = 0; i < 16; ++i) {
        const int row = R0 + (DIR ? 15 - i : i);
        const float zf = bf2f(pb[(size_t)row * PW + OFF_ZF + DIR * 512 + ch]);
        const float sg = 1.0f / (1.0f + __expf(-zf)), sn = 1.0f / (1.0f + __expf(zf));
        const float f = fmaxf(lbv + (1.0f - lbv) * sg, 1e-30f);
        b += __logf(f);
        sBq[i * 512 + ch] = b; sK[i * 512 + ch] = (1.0f - lbv) * sn;
        sQ[i * 512 + ch] = siluf(bf2f(pb[(size_t)row * PW + OFF_Q + ch]));
    }
    const float blast = b;
#pragma unroll 1
    for (int i = 0; i < 16; ++i) {
        const int row = R0 + (DIR ? 15 - i : i);
        const float bi = sBq[i * 512 + ch], kq = sK[i * 512 + ch], qv = sQ[i * 512 + ch];
        const float qi = qv * __expf(bi), kt = kq * __expf(fminf(-bi, 80.0f)), ko = kq * __expf(blast - bi);
        sQ[i * 512 + ch] = qi; sK[i * 512 + ch] = kt;
        qin[((size_t)DIR * NTOK + row) * 512 + ch] = (bf16_t)f2bf(qi);
        kout[((size_t)DIR * NTOK + row) * 512 + ch] = (bf16_t)f2bf(ko);
    }
    dch[((size_t)DIR * NCHUNK + chunk) * 512 + ch] = __expf(blast);
    __syncthreads();
#pragma unroll 1
    for (int e2 = 0; e2 < 2; ++e2) {
        const int e = tid * 2 + e2, h = e >> 8, t = (e >> 4) & 15, s = e & 15;
        float sum = 0.f;
        const float* qp = sQ + t * 512 + h * 128; const float* kp = sK + s * 512 + h * 128;
#pragma unroll 8
        for (int k = 0; k < 128; ++k) sum += qp[k] * kp[k];
        sA[e] = (s <= t) ? sum : 0.f;
    }
    __syncthreads();
    const int h = ch >> 7;
#pragma unroll
    for (int t = 0; t < 16; ++t) {
        float o = 0.f;
#pragma unroll 1
        for (int s = 0; s <= t; ++s) o += sA[(h * 16 + t) * 16 + s] * sV[(DIR ? 15 - s : s) * 512 + ch];
        oacc[DIR ? 15 - t : t] += o;
    }
    __syncthreads();
}

__device__ __forceinline__ void phase_conv_glapre(const Params& p, int l, unsigned char* lds) {
    conv_rows(p, l, obid() * 8 + (otid() >> 6), (int)gridDim.x * 8);
    float* sQ = (float*)lds; float* sK = sQ + 16 * 512; float* sV = sK + 16 * 512; float* sBq = sV + 16 * 512; float* sA = sBq + 16 * 512;
    const bf16_t* pb = (const bf16_t*)(ows(p) + WS_P); float* ointra = (float*)(ows(p) + WS_OINTRA);
    const int ch = otid();
    for (int chunk = obid(); chunk < NCHUNK; chunk += gridDim.x) {
        const int R0 = chunk * 16;
        float oacc[16];
#pragma unroll
        for (int i = 0; i < 16; ++i) oacc[i] = 0.f;
        __syncthreads();
#pragma unroll
        for (int ro = 0; ro < 16; ++ro) sV[ro * 512 + ch] = bf2f(pb[(size_t)(R0 + ro) * PW + OFF_I + ch]);
        gla_pre_dir<0>(p, l, chunk, sQ, sK, sV, sA, sBq, oacc);
        gla_pre_dir<1>(p, l, chunk, sQ, sK, sV, sA, sBq, oacc);
#pragma unroll
        for (int ro = 0; ro < 16; ++ro) ointra[(size_t)(R0 + ro) * 512 + ch] = oacc[ro];
    }
}

__device__ __forceinline__ void phase_gla_seq(const Params& p, int l, unsigned char* lds) {
    const int tid = otid();
    float* S = (float*)lds;
    float* sQ = S + 128 * 32;
    float* sKo = sQ + 16 * 128;
    float* sV = sKo + 16 * 128;
    float* sD = sV + 16 * 32;
    const bf16_t* pb = (const bf16_t*)(ows(p) + WS_P);
    const bf16_t* qin = (const bf16_t*)(ows(p) + WS_QIN); const bf16_t* kout = (const bf16_t*)(ows(p) + WS_KOUT); const float* dch = (const float*)(ows(p) + WS_DCH);
    float* ointer = (float*)(ows(p) + WS_OINTER);
    for (int u = obid(); u < 256; u += gridDim.x) {
        const int vblk = u & 3, dir = (u >> 2) & 1, chain = u >> 3, b = chain >> 2, h = chain & 3;
        __syncthreads();
        for (int i = tid; i < 128 * 32; i += 512) S[i] = 0.f;
        for (int c = 0; c < 144; ++c) {
            int R0;
            if (c < 16) { const int cm = dir ? 15 - c : c; R0 = NLAT + b * 256 + cm * 16; }
            else { const int cc = c - 16; const int cm = dir ? 127 - cc : cc; R0 = b * 2048 + cm * 16; }
            __syncthreads();
            for (int i = tid; i < 16 * 128; i += 512) {
                const int si = i >> 7, k = i & 127; const int row = R0 + (dir ? 15 - si : si);
                const size_t g = ((size_t)dir * NTOK + row) * 512 + h * 128 + k;
                sQ[i] = bf2f(qin[g]); sKo[i] = bf2f(kout[g]);
            }
            { const int si = tid >> 5, vv = tid & 31; const int row = R0 + (dir ? 15 - si : si); sV[tid] = bf2f(pb[(size_t)row * PW + OFF_I + h * 128 + vblk * 32 + vv]); }
            if (tid < 128) sD[tid] = dch[((size_t)dir * NCHUNK + (R0 >> 4)) * 512 + h * 128 + tid];
            __syncthreads();
            {
                const int si = tid >> 5, vv = tid & 31; const int row = R0 + (dir ? 15 - si : si);
                float o = 0.f;
                for (int k = 0; k < 128; ++k) o += sQ[si * 128 + k] * S[k * 32 + vv];
                ointer[((size_t)dir * NTOK + row) * 512 + h * 128 + vblk * 32 + vv] = o;
            }
            __syncthreads();
            {
                const int k = tid >> 2, v0 = (tid & 3) * 8; const float d = sD[k];
                float kk[16];
#pragma unroll
                for (int i = 0; i < 16; ++i) kk[i] = sKo[i * 128 + k];
#pragma unroll
                for (int j = 0; j < 8; ++j) {
                    float s = d * S[k * 32 + v0 + j];
#pragma unroll
                    for (int i = 0; i < 16; ++i) s += kk[i] * sV[i * 32 + v0 + j];
                    S[k * 32 + v0 + j] = s;
                }
            }
        }
    }
}


__device__ __forceinline__ float bflo(unsigned w) { return __uint_as_float(w << 16); }
__device__ __forceinline__ float bfhi(unsigned w) { return __uint_as_float(w & 0xffff0000u); }

template <int DIR>
__device__ __forceinline__ void gla_pre2_dir(const float (&q0a)[16], const float (&q1a)[16], const unsigned (&rz)[16], float lb0, float lb1, unsigned char* wl, unsigned char* rec,
                                             f32x4 (&oT)[8], int lane, int fr, int fq) {
    float bq0[16], bq1[16], kk0[16], kk1[16]; float b0 = 0.f, b1 = 0.f;
#pragma unroll
    for (int i = 0; i < 16; ++i) {
        const int t = DIR ? 15 - i : i;
        const float z0 = bflo(rz[t]), z1 = bfhi(rz[t]);
        const float sg0 = frcp(1.0f + __expf(-z0)), sg1 = frcp(1.0f + __expf(-z1));
        const float f0 = fmaxf(lb0 + (1.0f - lb0) * sg0, 1e-30f), f1 = fmaxf(lb1 + (1.0f - lb1) * sg1, 1e-30f);
        b0 += __logf(f0); b1 += __logf(f1); bq0[t] = b0; bq1[t] = b1; kk0[t] = 1.0f - f0; kk1[t] = 1.0f - f1;
    }
    const float bl0 = b0, bl1 = b1;
    unsigned kw0[8], kw1[8];
#pragma unroll
    for (int i = 0; i < 8; ++i) { kw0[i] = 0u; kw1[i] = 0u; }
#pragma unroll
    for (int t = 0; t < 16; ++t) {
        const float e0 = __expf(bq0[t]), e1 = __expf(bq1[t]);
        const float qi0 = q0a[t] * e0, qi1 = q1a[t] * e1;
        const float kt0 = kk0[t] * frcp(fmaxf(e0, 1.8e-35f)), kt1 = kk1[t] * frcp(fmaxf(e1, 1.8e-35f));
        const float ko0 = kk0[t] * __expf(bl0 - bq0[t]), ko1 = kk1[t] * __expf(bl1 - bq1[t]);
        *(unsigned*)(wl + t * 272 + lane * 4) = cvtpk(qi0, qi1);
        *(unsigned*)(wl + 4352 + t * 272 + lane * 4) = cvtpk(kt0, kt1);
        const unsigned kp = cvtpk(ko0, ko1);
        kw0[t >> 1] |= (kp & 0xffffu) << (16 * (t & 1)); kw1[t >> 1] |= (kp >> 16) << (16 * (t & 1));
    }
    {
        const int c0 = 2 * lane, c1 = c0 + 1;
        unsigned char* k0p = rec + 4096 + (c0 >> 4) * 512 + (c0 & 15) * 8; unsigned char* k1p = rec + 4096 + (c1 >> 4) * 512 + (c1 & 15) * 8;
#pragma unroll
        for (int g = 0; g < 4; ++g) { *(u32x2*)(k0p + g * 128) = (u32x2){kw0[2 * g], kw0[2 * g + 1]}; *(u32x2*)(k1p + g * 128) = (u32x2){kw1[2 * g], kw1[2 * g + 1]}; }
        float* dp = (float*)(rec + 8192) + c0; dp[0] = __expf(bl0); dp[1] = __expf(bl1);
    }
    LDS_WAIT();
#pragma unroll
    for (int s = 0; s < 4; ++s) {
        const u32x2 lo = *(const u32x2*)(wl + fr * 272 + (32 * s + 4 * fq) * 2), hi = *(const u32x2*)(wl + fr * 272 + (32 * s + 16 + 4 * fq) * 2);
        *(u32x4*)(rec + s * 1024 + lane * 16) = (u32x4){lo.x, lo.y, hi.x, hi.y};
    }
    f32x4 at = (f32x4){0.f, 0.f, 0.f, 0.f};
#pragma unroll
    for (int s = 0; s < 4; ++s) {
        const bf16x8 kf = *(const bf16x8*)(wl + 4352 + fr * 272 + (32 * s + 8 * fq) * 2);
        const bf16x8 qf = *(const bf16x8*)(wl + fr * 272 + (32 * s + 8 * fq) * 2);
        at = __builtin_amdgcn_mfma_f32_16x16x32_bf16(kf, qf, at, 0, 0, 0);
    }
#pragma unroll
    for (int r = 0; r < 4; ++r) { const int sp = 4 * fq + r; const bool keep = DIR ? (sp >= fr) : (sp <= fr); at[r] = keep ? at[r] : 0.f; }
    union { u32x2 u; s16x4 h; } bop; bop.u = (u32x2){cvtpk(at[0], at[1]), cvtpk(at[2], at[3])};
#pragma unroll
    for (int vb = 0; vb < 8; ++vb) {
        union { u32x2 u; s16x4 h; } aop; aop.u = *(const u32x2*)(wl + 8704 + (vb * 16 + fr) * 32 + 8 * fq);
        oT[vb] = __builtin_amdgcn_mfma_f32_16x16x16bf16_1k(aop.h, bop.h, oT[vb], 0, 0, 0);
    }
    LDS_WAIT();
}

__device__ __forceinline__ void phase_gla_pre2(const Params& p, int l, unsigned char* lds) {
    const int tid = otid(), lane = tid & 63, wid = __builtin_amdgcn_readfirstlane(tid >> 6), fr = lane & 15, fq = lane >> 4;
    unsigned char* wl = lds + wid * 12800;
    unsigned char* ws = ows(p);
    const bf16_t* pb = (const bf16_t*)(ws + WS_P); bf16_t* ointra = (bf16_t*)(ws + WS_OINTRA);
    float lb[2][2];
    {
        const float* hl = oin(p, 10);
#pragma unroll
        for (int d = 0; d < 2; ++d)
#pragma unroll
            for (int e = 0; e < 2; ++e) {
                const float* q = hl + (size_t)d * 4 * 512 + (2 * lane + e);
                lb[d][e] = 0.f; (void)q;
            }
    }
    for (int unit = wid * (int)gridDim.x + obid(); unit < NCHUNK * 4; unit += gridDim.x * 8) {
        const int chunk = unit >> 2, h = unit & 3, R0 = chunk * 16;
        {
            const float* hl = oin(p, 10);
#pragma unroll
            for (int d = 0; d < 2; ++d)
#pragma unroll
                for (int e = 0; e < 2; ++e) {
                    const float* q = hl + (size_t)d * 4 * 512 + h * 128 + 2 * lane + e;
                    const float z0 = q[0], z1 = q[512], z2 = q[1024], z3 = q[1536];
                    const float mx = fmaxf(fmaxf(z0, z1), fmaxf(z2, z3));
                    const float e0 = __expf(z0 - mx), e1 = __expf(z1 - mx), e2 = __expf(z2 - mx), e3 = __expf(z3 - mx);
                    lb[d][e] = ((l >= 1 ? e1 : 0.f) + (l >= 2 ? e2 : 0.f) + (l >= 3 ? e3 : 0.f)) / (e0 + e1 + e2 + e3);
                }
        }
        unsigned rq[16], rf[16], rb[16], rv[16];
#pragma unroll
        for (int t = 0; t < 16; ++t) {
            const bf16_t* base = pb + (size_t)(R0 + t) * PW + h * 128 + 2 * lane;
            rq[t] = *(const unsigned*)(base + OFF_Q); rf[t] = *(const unsigned*)(base + OFF_ZF); rb[t] = *(const unsigned*)(base + OFF_ZF + 512); rv[t] = *(const unsigned*)(base + OFF_I);
        }
        unsigned char* vrec = ws + WS_VREC + (size_t)(chunk * 4 + h) * VREC_BYTES;
        {
            unsigned w0[8], w1[8];
#pragma unroll
            for (int i = 0; i < 8; ++i) { w0[i] = (rv[2 * i] & 0xffffu) | (rv[2 * i + 1] << 16); w1[i] = (rv[2 * i] >> 16) | (rv[2 * i + 1] & 0xffff0000u); }
            const int c0 = 2 * lane, c1 = c0 + 1;
            unsigned char* v0p = vrec + (c0 >> 4) * 512 + (c0 & 15) * 8; unsigned char* v1p = vrec + (c1 >> 4) * 512 + (c1 & 15) * 8;
#pragma unroll
            for (int g = 0; g < 4; ++g) { *(u32x2*)(v0p + g * 128) = (u32x2){w0[2 * g], w0[2 * g + 1]}; *(u32x2*)(v1p + g * 128) = (u32x2){w1[2 * g], w1[2 * g + 1]}; }
            unsigned char* vl = wl + 8704 + c0 * 32;
            *(u32x4*)(vl) = (u32x4){w0[0], w0[1], w0[2], w0[3]}; *(u32x4*)(vl + 16) = (u32x4){w0[4], w0[5], w0[6], w0[7]};
            *(u32x4*)(vl + 32) = (u32x4){w1[0], w1[1], w1[2], w1[3]}; *(u32x4*)(vl + 48) = (u32x4){w1[4], w1[5], w1[6], w1[7]};
        }
        f32x4 oT[8];
#pragma unroll
        for (int vb = 0; vb < 8; ++vb) oT[vb] = (f32x4){0.f, 0.f, 0.f, 0.f};
        float q0a[16], q1a[16];
#pragma unroll
        for (int t = 0; t < 16; ++t) { q0a[t] = siluf(bflo(rq[t])); q1a[t] = siluf(bfhi(rq[t])); }
        gla_pre2_dir<0>(q0a, q1a, rf, lb[0][0], lb[0][1], wl, ws + WS_GREC + ((size_t)(0 * NCHUNK + chunk) * 4 + h) * REC_BYTES, oT, lane, fr, fq);
        gla_pre2_dir<1>(q0a, q1a, rb, lb[1][0], lb[1][1], wl, ws + WS_GREC + ((size_t)(1 * NCHUNK + chunk) * 4 + h) * REC_BYTES, oT, lane, fr, fq);
#pragma unroll
        for (int vb = 0; vb < 8; ++vb) *(u32x2*)(ointra + (size_t)(R0 + fr) * 512 + h * 128 + vb * 16 + 4 * fq) = (u32x2){cvtpk(oT[vb][0], oT[vb][1]), cvtpk(oT[vb][2], oT[vb][3])};
    }
}

constexpr int GR = 8, STG_BYTES = REC_BYTES + VREC_BYTES;
__device__ __forceinline__ int gla_chunk_of_step(int c, int b, int dir) {
    if (c < 16) { const int cm = dir ? 15 - c : c; return (NLAT + b * 256) / 16 + cm; }
    const int cc = c - 16; const int cm = dir ? 127 - cc : cc; return b * 128 + cm;
}
constexpr int SG_STEP = REC_BYTES + 2048, SG_GRP = 2 * SG_STEP, SG_NG = 6;
constexpr int SG_DUMP = SG_NG * SG_GRP;
constexpr int SG_FLAGS = LDS_MISC + 2048;
constexpr unsigned SG_SPIN = 1u << 22;
static_assert(SG_DUMP + 1024 <= LDS_MISC, "scan ring");
__device__ __forceinline__ void gla_scan_unit(const Params& p, int l, unsigned char* lds_, int chain, int vhalf) {
    LAS unsigned char* lds = (LAS unsigned char*)lds_;
    const int tid = otid(), lane = tid & 63, wid = __builtin_amdgcn_readfirstlane(tid >> 6), fr = lane & 15, fq = lane >> 4;
    unsigned char* ws = ows(p);
    const int b = chain >> 3, h = (chain >> 1) & 3, dir = chain & 1;
    volatile LAS unsigned* flg = (volatile LAS unsigned*)(lds + SG_FLAGS);
    __syncthreads();
    if (tid < 32) flg[tid] = 0u;
    __syncthreads();
    if (wid >= 4) {
        const int m = wid & 3;
        const unsigned char* grec = ws + WS_GREC + (size_t)dir * NCHUNK * 4 * REC_BYTES + (size_t)h * REC_BYTES + lane * 16;
        const unsigned char* vrec = ws + WS_VREC + (size_t)h * VREC_BYTES + vhalf * 2048 + lane * 16;
        const volatile LAS unsigned* dn = flg + 4 + (lane & 3);
#define GSEQ_ISSUE(gi) do { const int _g = (gi); _Pragma("unroll") for (int _j = 0; _j < 6; ++_j) { const int _p = m + 4 * _j; const bool _real = _p < 22; const int _s = _real ? _p / 11 : 0, _q = _real ? _p % 11 : 0; \
        const int _c = 2 * _g + _s; const int _cc = _c < 144 ? _c : 143; const int _ch = gla_chunk_of_step(_cc, b, dir); \
        const unsigned char* _src = (_q < 9) ? grec + (size_t)_ch * 4 * REC_BYTES + _q * 1024 : vrec + (size_t)_ch * 4 * VREC_BYTES + (_q - 9) * 1024; \
        const unsigned _dst = _real ? (unsigned)(_g % SG_NG) * SG_GRP + _s * SG_STEP + _q * 1024 : (unsigned)SG_DUMP; \
        __builtin_amdgcn_global_load_lds((const unsigned*)_src, (LAS unsigned*)(lds + _dst), 16, 0, 0); } } while (0)
#pragma unroll 1
        for (int g = 0; g < SG_NG - 1; ++g) GSEQ_ISSUE(g);
#pragma unroll 1
        for (int g = 0; g < 72; ++g) {
            asm volatile("s_waitcnt vmcnt(%0)" :: "n"((SG_NG - 2) * 6) : "memory");
            if (lane == 0) flg[m] = (unsigned)(g + 1);
            { unsigned sp = 0; while (__builtin_amdgcn_ballot_w64(*dn < (unsigned)g) != 0ull && ++sp < SG_SPIN) __builtin_amdgcn_s_sleep(1); asm volatile("" ::: "memory"); }
            GSEQ_ISSUE(g + SG_NG - 1);
        }
#undef GSEQ_ISSUE
    } else {
        const int vt = wid;
        bf16_t* ointer = (bf16_t*)(ws + WS_OINTER) + (size_t)dir * NTOK * 512 + h * 128 + (vhalf * 4 + vt) * 16 + fr;
        const volatile LAS unsigned* fl = flg + (lane & 3);
        f32x4 acc[8];
#pragma unroll
        for (int j = 0; j < 8; ++j) acc[j] = (f32x4){0.f, 0.f, 0.f, 0.f};
        union { u32x4 u; bf16x8 h; } sb[4];
#pragma unroll
        for (int j = 0; j < 4; ++j) sb[j].u = (u32x4){0u, 0u, 0u, 0u};
#pragma unroll 1
        for (int g = 0; g < 72; ++g) {
            { unsigned sp = 0; while (__builtin_amdgcn_ballot_w64(*fl < (unsigned)(g + 1)) != 0ull && ++sp < SG_SPIN) { } asm volatile("" ::: "memory"); }
#pragma unroll
            for (int s2 = 0; s2 < 2; ++s2) {
                const int c = 2 * g + s2;
                const LAS unsigned char* st = lds + (unsigned)(g % SG_NG) * SG_GRP + s2 * SG_STEP;
                const int chunk = gla_chunk_of_step(c, b, dir);
                bf16x8 qa[4]; f32x4 dv[8];
                union { u32x2 u; s16x4 h; } ka[8], vb;
#pragma unroll
                for (int j = 0; j < 4; ++j) qa[j] = *(const LAS bf16x8*)(st + j * 1024 + lane * 16);
                vb.u = *(const LAS u32x2*)(st + REC_BYTES + vt * 512 + lane * 8);
#pragma unroll
                for (int j = 0; j < 8; ++j) { ka[j].u = *(const LAS u32x2*)(st + 4096 + j * 512 + lane * 8); dv[j] = *(const LAS f32x4*)(st + 8192 + (j * 16 + 4 * fq) * 4); }
                f32x4 o0 = (f32x4){0.f, 0.f, 0.f, 0.f}, o1 = (f32x4){0.f, 0.f, 0.f, 0.f};
                o0 = __builtin_amdgcn_mfma_f32_16x16x32_bf16(qa[0], sb[0].h, o0, 0, 0, 0); o1 = __builtin_amdgcn_mfma_f32_16x16x32_bf16(qa[1], sb[1].h, o1, 0, 0, 0);
                o0 = __builtin_amdgcn_mfma_f32_16x16x32_bf16(qa[2], sb[2].h, o0, 0, 0, 0); o1 = __builtin_amdgcn_mfma_f32_16x16x32_bf16(qa[3], sb[3].h, o1, 0, 0, 0);
#pragma unroll
                for (int j = 0; j < 8; ++j) {
                    acc[j] = acc[j] * dv[j];
                    acc[j] = __builtin_amdgcn_mfma_f32_16x16x16bf16_1k(ka[j].h, vb.h, acc[j], 0, 0, 0);
                }
                const f32x4 os = o0 + o1;
                bf16_t* op = ointer + (size_t)(chunk * 16 + 4 * fq) * 512;
                { const unsigned w01 = cvtpk(os[0], os[1]), w23 = cvtpk(os[2], os[3]); op[0] = (bf16_t)(w01 & 0xffffu); op[512] = (bf16_t)(w01 >> 16); op[1024] = (bf16_t)(w23 & 0xffffu); op[1536] = (bf16_t)(w23 >> 16); }
#pragma unroll
                for (int j = 0; j < 4; ++j) sb[j].u = (u32x4){cvtpk(acc[2 * j][0], acc[2 * j][1]), cvtpk(acc[2 * j][2], acc[2 * j][3]), cvtpk(acc[2 * j + 1][0], acc[2 * j + 1][1]), cvtpk(acc[2 * j + 1][2], acc[2 * j + 1][3])};
            }
            asm volatile("s_waitcnt lgkmcnt(0)" ::: "memory");
            if (lane == 0) flg[4 + wid] = (unsigned)(g + 1);
        }
    }
    asm volatile("s_waitcnt vmcnt(0) lgkmcnt(0)" ::: "memory");
    __syncthreads();
}
__device__ __forceinline__ void phase_gla_seq2(const Params& p, int l, unsigned char* lds) {
    const int G = (int)gridDim.x, bid = obid();
    const int nscan = (G >= 256) ? 128 : G;
    for (int rep = 0; rep < ((DUPK == 50) ? 2 : 1); ++rep) {
        for (int r2 = 0; r2 < ((DUPK == 51) ? 2 : 1); ++r2)
        if (bid < nscan) for (int u = bid; u < 128; u += nscan) { const int x = u & 7, jj = u >> 3; gla_scan_unit(p, l, lds, x + 8 * (jj >> 1), jj & 1); }
        const int it0 = (G == 256) ? ((l == DEPTH - 1) ? CV_B : CV_B + CV_F) : 0;
        for (int r3 = 0; r3 < ((DUPK == 52) ? 2 : 1); ++r3)
        if (G > nscan) { if (bid >= nscan) { const int widx = (bid - nscan) * 8 + (otid() >> 6), nwv = (G - nscan) * 8; conv_rows(p, l, widx, nwv); convert_experts(p, l, (float*)(lds + (otid() >> 6) * 16384), widx, nwv, it0, CV_ALL); } }
        else { const int widx = bid * 8 + (otid() >> 6), nwv = G * 8; __syncthreads(); conv_rows(p, l, widx, nwv); convert_experts(p, l, (float*)(lds + (otid() >> 6) * 16384), widx, nwv, it0, CV_ALL); }
    }
}

__device__ __forceinline__ void phase_gla_post(const Params& p, int l) {
    const int lane = otid() & 63, wid = otid() >> 6;
    const bf16_t* pb = (const bf16_t*)(ows(p) + WS_P); bf16_t* yb = (bf16_t*)(ows(p) + WS_Y);
    const bf16_t* oi = (const bf16_t*)(ows(p) + WS_OINTRA); const bf16_t* oe = (const bf16_t*)(ows(p) + WS_OINTER);
    const float* hnw = oin(p, 11) + (size_t)l * 128;
    const int nrows = (l == DEPTH - 1) ? NLAT : NTOK;
    const int c0 = lane * 8;
    for (int r = obid() * 8 + wid; r < nrows; r += gridDim.x * 8) {
        float o[8], t1[8], t2[8]; float ss = 0.f;
        unpack8(*(const u32x4*)(oi + (size_t)r * 512 + c0), o); unpack8(*(const u32x4*)(oe + (size_t)r * 512 + c0), t1); unpack8(*(const u32x4*)(oe + ((size_t)NTOK + r) * 512 + c0), t2);
#pragma unroll
        for (int j = 0; j < 8; ++j) { o[j] += t1[j] + t2[j]; ss += o[j] * o[j]; }
        ss += __shfl_xor(ss, 1); ss += __shfl_xor(ss, 2); ss += __shfl_xor(ss, 4); ss += __shfl_xor(ss, 8);
        const float rstd = rsqrtf(ss * (1.0f / 128.0f) + EPS);
        float g[8]; unpack8(*(const u32x4*)(pb + (size_t)r * PW + OFF_G + c0), g);
        float y[8];
#pragma unroll
        for (int j = 0; j < 8; ++j) y[j] = o[j] * rstd * hnw[(c0 + j) & 127] * siluf(g[j]);
        if (G2_FP8) { u32x2 w8; w8.x = pk4_fp8(8.0f * y[0], 8.0f * y[1], 8.0f * y[2], 8.0f * y[3]); w8.y = pk4_fp8(8.0f * y[4], 8.0f * y[5], 8.0f * y[6], 8.0f * y[7]); *(u32x2*)((unsigned char*)yb + (size_t)r * 1024 + 512 + c0) = w8; }
        else { u32x4 w; w.x = pk2(y[0], y[1]); w.y = pk2(y[2], y[3]); w.z = pk2(y[4], y[5]); w.w = pk2(y[6], y[7]);
        *(u32x4*)(yb + (size_t)r * 1024 + 512 + c0) = w; }
    }
}

__device__ __forceinline__ void phase_gemm2(const Params& p, int l, unsigned char* lds) {
    const bf16_t* yb = (const bf16_t*)(ows(p) + WS_Y); const bf16_t* wt = (const bf16_t*)(ows(p) + WS_WOUT) + (size_t)l * 1024 * 1024;
    float* xws = (float*)(ows(p) + WS_X); const float* modv = (const float*)(ows(p) + WS_MOD);
    const int MT = ((l == DEPTH - 1) ? NLAT : NTOK) / 128; constexpr int NT = 8;
    for (int u = obid(); u < MT * NT; u += gridDim.x) {
        const int mt = u / NT, nt = u % NT;
        ARowPlain ar{yb + (size_t)mt * 128 * 1024, 1024};
        EpiRes ep{xws + (size_t)mt * 128 * 1024 + nt * 128, modv + (size_t)l * 9 * 6144 + 2 * 1024 + nt * 128, mt * 128};
        gemm128(lds, ar, wt + (size_t)nt * 128 * 1024, 1024, ep);
    }
}

__device__ __forceinline__ void phase_router(const Params& p, int l) {
    const int lane = otid() & 63, wid = otid() >> 6;
    const float* xws = (const float*)(ows(p) + WS_X); bf16_t* hb = (bf16_t*)(ows(p) + WS_H);
    const float* modv = (const float*)(ows(p) + WS_MOD); const float* nw = oin(p, 4) + (size_t)(l * 2 + 1) * 1024;
    const float* wrg = oin(p, 13) + (size_t)l * 1024 * 4; const float* wre = oin(p, 15) + (size_t)l * 1024 * 32;
    const float* brg = oin(p, 14) + l * 4; const float* bre = oin(p, 16) + l * 32;
    unsigned* cnt = (unsigned*)(ows(p) + WS_CTL) + CW_CNT + 64 * l;
    int* ltok = (int*)(ows(p) + WS_LTOK); float* lgate = (float*)(ows(p) + WS_LGATE);
    const int nrows = (l == DEPTH - 1) ? NLAT : NTOK;
    for (int r = obid() * 8 + wid; r < nrows; r += gridDim.x * 8) {
        const int mr = mod_row(r);
        float ss = 0.f;
#pragma unroll
        for (int j = 0; j < 4; ++j) { const f32x4 xv4 = *(const f32x4*)(xws + (size_t)r * 1024 + 4 * lane + 256 * j); ss += (xv4[0] * xv4[0] + xv4[1] * xv4[1]) + (xv4[2] * xv4[2] + xv4[3] * xv4[3]); }
        const float rstd = rsqrtf(wave_sum(ss) * (1.0f / 1024.0f) + EPS);
        const float* msh = modv + ((size_t)l * 9 + mr) * 6144 + 3 * 1024; const float* msc = msh + 1024;
        float lg[36];
#pragma unroll
        for (int i = 0; i < 36; ++i) lg[i] = 0.f;
#pragma unroll 1
        for (int j = 0; j < 4; ++j) {
            const int c = 4 * lane + 256 * j;
            const f32x4 xv4 = *(const f32x4*)(xws + (size_t)r * 1024 + c);
            const f32x4 w = *(const f32x4*)(nw + c), sh = *(const f32x4*)(msh + c), sc = *(const f32x4*)(msc + c);
            const f32x4 h = (xv4 * rstd * w) * (1.0f + sc) + sh;
            u32x2 o; o.x = pk2(h[0], h[1]); o.y = pk2(h[2], h[3]);
            *(u32x2*)(hb + (size_t)r * 1024 + c) = o;
#pragma unroll
            for (int e = 0; e < 4; ++e) {
                const float xv = h[e];
                const f32x4 wg = *(const f32x4*)(wrg + (size_t)(c + e) * 4);
                lg[0] += xv * wg[0]; lg[1] += xv * wg[1]; lg[2] += xv * wg[2]; lg[3] += xv * wg[3];
#pragma unroll
                for (int q = 0; q < 8; ++q) {
                    const f32x4 we = *(const f32x4*)(wre + (size_t)(c + e) * 32 + q * 4);
                    lg[4 + q * 4 + 0] += xv * we[0]; lg[4 + q * 4 + 1] += xv * we[1]; lg[4 + q * 4 + 2] += xv * we[2]; lg[4 + q * 4 + 3] += xv * we[3];
                }
            }
        }
#pragma unroll
        for (int i = 0; i < 36; ++i) lg[i] = wave_sum(lg[i]);
        float gl[4];
#pragma unroll
        for (int i = 0; i < 4; ++i) gl[i] = lg[i] + brg[i];
        int gsel = 0; float gmax = gl[0];
#pragma unroll
        for (int i = 1; i < 4; ++i) if (gl[i] > gmax) { gmax = gl[i]; gsel = i; }
        float gs = 0.f;
#pragma unroll
        for (int i = 0; i < 4; ++i) gs += __expf(gl[i] - gmax);
        const float pg = 1.0f / gs;
        float el[8];
#pragma unroll
        for (int j = 0; j < 8; ++j) {
            float t = lg[4 + j] + bre[j];
#pragma unroll
            for (int g = 1; g < 4; ++g) t = (gsel == g) ? (lg[4 + g * 8 + j] + bre[g * 8 + j]) : t;
            el[j] = t;
        }
        int i1 = 0; float v1 = el[0];
#pragma unroll
        for (int j = 1; j < 8; ++j) if (el[j] > v1) { v1 = el[j]; i1 = j; }
        int i2 = -1; float v2 = -3.0e38f;
#pragma unroll
        for (int j = 0; j < 8; ++j) if (j != i1 && el[j] > v2) { v2 = el[j]; i2 = j; }
        const float e2 = __expf(v2 - v1);
        const float g0 = pg / (1.0f + e2), g1 = pg * e2 / (1.0f + e2);
        if (lane == 0) {
            const int ea = gsel * 8 + i1, eb = gsel * 8 + i2;
            const unsigned pa = atomicAdd(cnt + ea, 1u); ltok[(size_t)ea * NTOK + pa] = r * 2 + 0; lgate[(size_t)ea * NTOK + pa] = g0;
            const unsigned pb2 = atomicAdd(cnt + eb, 1u); ltok[(size_t)eb * NTOK + pb2] = r * 2 + 1; lgate[(size_t)eb * NTOK + pb2] = g1;
        }
    }
}


__device__ __forceinline__ void phase_router2(const Params& p, int l, unsigned char* lds, bool commit) {
    const int tid = otid(), lane = tid & 63, wid = __builtin_amdgcn_readfirstlane(tid >> 6), fr = lane & 15, fq = lane >> 4;
    unsigned char* ws = ows(p);
    const bf16_t* xws = (const bf16_t*)(ws + WS_X); bf16_t* xw = (bf16_t*)(ws + WS_X); const bf16_t* dlt = (const bf16_t*)(ws + WS_DELTA); bf16_t* hb = (bf16_t*)(ws + WS_H);
    const float* modv = (const float*)(ws + WS_MOD); const float* nw = oin(p, 4) + (size_t)(l * 2 + 1) * 1024;
    const float* brg = oin(p, 14) + l * 4; const float* bre = oin(p, 16) + l * 32;
    unsigned* gcnt = (unsigned*)(ws + WS_CTL) + CW_CNT + 64 * 32 * l;
    int* ltok = (int*)(ws + WS_LTOK); float* lgate = (float*)(ws + WS_LGATE);
    constexpr int WPITCH = 2064, WBYTES = 48 * WPITCH;
    unsigned char* wl = lds;
    float* tile = (float*)(lds + WBYTES + wid * 3328);
    int* s_cnt = (int*)(lds + WBYTES + 8 * 3328); int* s_base = s_cnt + 32;
    int* s_e = s_base + 32; int* s_rank = s_e + 256; int* s_tok = s_rank + 256; float* s_gate = (float*)(s_tok + 256);
    __syncthreads();
    {
        const bf16_t* wrh = (const bf16_t*)(ws + WS_WRH) + (size_t)l * 48 * 1024;
        for (int i = tid; i < 48 * 128; i += 512) { const int r = i >> 7, c = i & 127; *(u32x4*)(wl + r * WPITCH + c * 16) = *(const u32x4*)(wrh + (size_t)r * 1024 + c * 8); }
    }
    const int NG = ((l == DEPTH - 1) ? NLAT : NTOK) / 16;
    const int NWV = (int)gridDim.x * 8;
    for (int it = 0; it * NWV < NG; ++it) {
        const int g = it * NWV + wid * (int)gridDim.x + obid();
        __syncthreads();
        if (tid < 32) s_cnt[tid] = 0;
        if (tid < 256) s_e[tid] = -1;
        __syncthreads();
        if (g < NG) {
            const int R0 = g * 16, mr = mod_row(R0);
            float my_rstd = 0.f;
#pragma unroll
            for (int rb = 0; rb < 4; ++rb) {
                f32x4 xv[4][4]; u32x2 dl[4][4], xr[4][4];
#pragma unroll
                for (int rr = 0; rr < 4; ++rr)
#pragma unroll
                    for (int j = 0; j < 4; ++j) { xr[rr][j] = *(const u32x2*)(xws + (size_t)(R0 + rb * 4 + rr) * 1024 + 4 * lane + 256 * j); dl[rr][j] = *(const u32x2*)(dlt + (size_t)(R0 + rb * 4 + rr) * 1024 + 4 * lane + 256 * j); }
#pragma unroll
                for (int rr = 0; rr < 4; ++rr) {
#pragma unroll
                    for (int j = 0; j < 4; ++j) xv[rr][j] = unpk4_bf16(xr[rr][j]);
                    if (commit) {
#pragma unroll
                        for (int j = 0; j < 4; ++j) { xv[rr][j] += unpk4_bf16(dl[rr][j]); u32x2 o; o.x = cvtpk(xv[rr][j][0], xv[rr][j][1]); o.y = cvtpk(xv[rr][j][2], xv[rr][j][3]); *(u32x2*)(xw + (size_t)(R0 + rb * 4 + rr) * 1024 + 4 * lane + 256 * j) = o;
                            xv[rr][j] = unpk4_bf16(o); }
                    }
                    float ss = 0.f;
#pragma unroll
                    for (int j = 0; j < 4; ++j) ss += (xv[rr][j][0] * xv[rr][j][0] + xv[rr][j][1] * xv[rr][j][1]) + (xv[rr][j][2] * xv[rr][j][2] + xv[rr][j][3] * xv[rr][j][3]);
                    const float rs = rsqrtf(wave_sum(ss) * (1.0f / 1024.0f) + EPS);
                    my_rstd = (rb * 4 + rr == fr) ? rs : my_rstd;
                }
            }
            asm volatile("s_waitcnt vmcnt(0)" ::: "memory");
            const float* msh = modv + ((size_t)l * 9 + mr) * 6144 + 3 * 1024 + 8 * fq; const float* msc = msh + 1024; const float* nwp = nw + 8 * fq;
            const bf16_t* xrow = xws + (size_t)(R0 + fr) * 1024 + 8 * fq; bf16_t* hrow = hb + (size_t)(R0 + fr) * 1024 + 8 * fq; unsigned char* h8row = ws + WS_H8 + (size_t)(R0 + fr) * 1024 + 8 * fq;
            f32x4 acc[3];
#pragma unroll
            for (int nt = 0; nt < 3; ++nt) acc[nt] = (f32x4){0.f, 0.f, 0.f, 0.f};
#pragma unroll 1
            for (int kq = 0; kq < 4; ++kq) {
                u32x4 xab[8];
#pragma unroll
                for (int u = 0; u < 8; ++u) xab[u] = *(const u32x4*)(xrow + 256 * kq + 32 * u);
#pragma unroll
                for (int u = 0; u < 8; ++u) {
                    const int k = 256 * kq + 32 * u;
                    float hv[8];
                    const f32x4 xaq[2] = {unpk4_bf16((u32x2){xab[u].x, xab[u].y}), unpk4_bf16((u32x2){xab[u].z, xab[u].w})};
#pragma unroll
                    for (int q = 0; q < 2; ++q) {
                        const f32x4 w = *(const f32x4*)(nwp + k + 4 * q), sh = *(const f32x4*)(msh + k + 4 * q), sc = *(const f32x4*)(msc + k + 4 * q);
                        const f32x4 h = (xaq[q] * my_rstd * w) * (1.0f + sc) + sh;
                        hv[4 * q + 0] = h[0]; hv[4 * q + 1] = h[1]; hv[4 * q + 2] = h[2]; hv[4 * q + 3] = h[3];
                    }
                    union { u32x4 u; bf16x8 h; } ah, al;
                    ah.u = (u32x4){cvtpk(hv[0], hv[1]), cvtpk(hv[2], hv[3]), cvtpk(hv[4], hv[5]), cvtpk(hv[6], hv[7])};
                    float lv[8];
#pragma unroll
                    for (int q = 0; q < 4; ++q) { const unsigned w2 = q == 0 ? ah.u.x : q == 1 ? ah.u.y : q == 2 ? ah.u.z : ah.u.w; lv[2 * q] = hv[2 * q] - __uint_as_float(w2 << 16); lv[2 * q + 1] = hv[2 * q + 1] - __uint_as_float(w2 & 0xffff0000u); }
                    al.u = (u32x4){cvtpk(lv[0], lv[1]), cvtpk(lv[2], lv[3]), cvtpk(lv[4], lv[5]), cvtpk(lv[6], lv[7])};
                    if (MOE_FP8) { u32x2 h8; h8.x = pk4_fp8(hv[0], hv[1], hv[2], hv[3]); h8.y = pk4_fp8(hv[4], hv[5], hv[6], hv[7]); *(u32x2*)(h8row + k) = h8; }
                    else *(u32x4*)(hrow + k) = ah.u;
#pragma unroll
                    for (int nt = 0; nt < 3; ++nt) {
                        const bf16x8 bh = *(const bf16x8*)(wl + (nt * 16 + fr) * WPITCH + (k + 8 * fq) * 2);
                        acc[nt] = __builtin_amdgcn_mfma_f32_16x16x32_bf16(ah.h, bh, acc[nt], 0, 0, 0);
                        acc[nt] = __builtin_amdgcn_mfma_f32_16x16x32_bf16(al.h, bh, acc[nt], 0, 0, 0);
                    }
                }
            }
#pragma unroll
            for (int nt = 0; nt < 3; ++nt)
#pragma unroll
                for (int r = 0; r < 4; ++r) tile[(4 * fq + r) * 52 + nt * 16 + fr] = acc[nt][r];
            LDS_WAIT();
            if (lane < 16) {
                const float* lg = tile + lane * 52;
                float gl[4];
#pragma unroll
                for (int i = 0; i < 4; ++i) gl[i] = lg[i] + brg[i];
                int gsel = 0; float gmax = gl[0];
#pragma unroll
                for (int i = 1; i < 4; ++i) if (gl[i] > gmax) { gmax = gl[i]; gsel = i; }
                float gs = 0.f;
#pragma unroll
                for (int i = 0; i < 4; ++i) gs += __expf(gl[i] - gmax);
                const float pg = 1.0f / gs;
                float el[8];
#pragma unroll
                for (int j = 0; j < 8; ++j) el[j] = lg[4 + gsel * 8 + j] + bre[gsel * 8 + j];
                int i1 = 0; float v1 = el[0];
#pragma unroll
                for (int j = 1; j < 8; ++j) if (el[j] > v1) { v1 = el[j]; i1 = j; }
                int i2 = -1; float v2 = -3.0e38f;
#pragma unroll
                for (int j = 0; j < 8; ++j) if (j != i1 && el[j] > v2) { v2 = el[j]; i2 = j; }
                const float e2 = __expf(v2 - v1);
                const float g0 = pg / (1.0f + e2), g1 = pg * e2 / (1.0f + e2);
                const int ea = gsel * 8 + i1, eb = gsel * 8 + i2, slot = (wid * 16 + lane) * 2, r = R0 + lane;
                s_e[slot] = ea; s_rank[slot] = atomicAdd(&s_cnt[ea], 1); s_tok[slot] = r * 2; s_gate[slot] = g0;
                s_e[slot + 1] = eb; s_rank[slot + 1] = atomicAdd(&s_cnt[eb], 1); s_tok[slot + 1] = r * 2 + 1; s_gate[slot + 1] = g1;
            }
        }
        __syncthreads();
        if (tid < 32) { const int c = s_cnt[tid]; s_base[tid] = (c > 0 && commit) ? (int)atomicAdd(gcnt + 64 * tid, (unsigned)c) : 0; }
        __syncthreads();
        if (tid < 256) { const int e = s_e[tid]; if (e >= 0 && commit) { const size_t pos = (size_t)e * NTOK + s_base[e] + s_rank[tid]; ltok[pos] = s_tok[tid]; lgate[pos] = s_gate[tid]; } }
    }
}

__device__ __forceinline__ int moe_tables(const Params& p, int l, unsigned char* lds) {
    int* s_pref = (int*)(lds + LDS_MISC); int* s_cnt = s_pref + 40;
    unsigned* cnt = (unsigned*)(ows(p) + WS_CTL) + CW_CNT + 64 * l;
    __syncthreads();
    if (otid() == 0) {
        int acc = 0;
        for (int e = 0; e < NEXP; ++e) { const int c = (int)__hip_atomic_load(cnt + e, __ATOMIC_RELAXED, __HIP_MEMORY_SCOPE_AGENT); s_cnt[e] = c; s_pref[e] = acc; acc += (c + 127) >> 7; }
        s_pref[NEXP] = acc;
    }
    __syncthreads();
    return s_pref[NEXP];
}
__device__ __forceinline__ void phase_moe_gu(const Params& p, int l, unsigned char* lds) {
    const int T = moe_tables(p, l, lds);
    const int* s_pref = (const int*)(lds + LDS_MISC); const int* s_cnt = s_pref + 40;
    const bf16_t* hb = (const bf16_t*)(ows(p) + WS_H); bf16_t* hid = (bf16_t*)(ows(p) + WS_HID);
    const int* ltok = (const int*)(ows(p) + WS_LTOK);
    for (int u = obid(); u < T * 8; u += gridDim.x) {
        const int mtg = u >> 3, nt = u & 7;
        int e = 0;
        for (int q = 1; q < NEXP; ++q) if (s_pref[q] <= mtg) e = q;
        const int mt = mtg - s_pref[e]; const int nvalid = min(128, s_cnt[e] - mt * 128);
        ARowGather ar{hb, ltok + (size_t)e * NTOK + mt * 128, nvalid};
        EpiGU ep{hid + (size_t)mtg * 128 * 512 + nt * 64};
        gemm128(lds, ar, (const bf16_t*)(ows(p) + WS_WGU) + ((size_t)(l * 32 + e) * 1024 + nt * 128) * 1024, 1024, ep);
    }
}
__device__ __forceinline__ void phase_moe_down(const Params& p, int l, unsigned char* lds) {
    const int T = moe_tables(p, l, lds);
    const int* s_pref = (const int*)(lds + LDS_MISC); const int* s_cnt = s_pref + 40;
    const bf16_t* hid = (const bf16_t*)(ows(p) + WS_HID); bf16_t* yb = (bf16_t*)(ows(p) + WS_YB);
    const int* ltok = (const int*)(ows(p) + WS_LTOK); const float* lgate = (const float*)(ows(p) + WS_LGATE);
    for (int u = obid(); u < T * 8; u += gridDim.x) {
        const int mtg = u >> 3, nt = u & 7;
        int e = 0;
        for (int q = 1; q < NEXP; ++q) if (s_pref[q] <= mtg) e = q;
        const int mt = mtg - s_pref[e]; const int nvalid = min(128, s_cnt[e] - mt * 128);
        ARowPlain ar{hid + (size_t)mtg * 128 * 512, 512};
        EpiDown ep{yb + nt * 128, ltok + (size_t)e * NTOK + mt * 128, lgate + (size_t)e * NTOK + mt * 128, nvalid};
        gemm128(lds, ar, (const bf16_t*)(ows(p) + WS_WDN) + ((size_t)(l * 32 + e) * 1024 + nt * 128) * 512, 512, ep);
    }
}


#ifndef FAST_G1
#define FAST_G1 1
#endif
#ifndef FAST_G2
#define FAST_G2 1
#endif
#ifndef FAST_MOE
#define FAST_MOE 1
#endif
#ifndef FAST_GLA
#define FAST_GLA 1
#endif
#ifndef FAST_RT
#define FAST_RT 1
#endif
__device__ __forceinline__ void phase_gemm1_fast(const Params& p, int l, unsigned char* lds) {
    g8::DenseOrder S; S.init(NTOK / 256, PW / 256, (int)gridDim.x, obid(), (const bf16_t*)(ows(p) + WS_WIN) + (size_t)l * 4096 * 1024, 1024);
    g8::EpiP2 E{(bf16_t*)(ows(p) + WS_P)};
    g8::gemm_phase((LAS unsigned char*)lds, (const char*)(ows(p) + WS_H), 1024, S, E);
    if (gridDim.x == 256 && obid() >= 128) { __syncthreads(); convert_experts(p, l, (float*)(lds + (otid() >> 6) * 16384), (obid() - 128) * 8 + (otid() >> 6), 128 * 8, 0, CV_B); }
}
__device__ __forceinline__ void phase_gemm2_fast(const Params& p, int l, unsigned char* lds, float scl) {
    g8::DenseOrder S; g8::EpiDelta E{(bf16_t*)(ows(p) + WS_DELTA), (const float*)(ows(p) + WS_MOD) + (size_t)l * 9 * 6144 + 2 * 1024, scl};
    if (G2_FP8) {
        S.init(((l == DEPTH - 1) ? NLAT : NTOK) / 256, 4, (int)gridDim.x, obid(), ows(p) + WS_WOUT + (size_t)l * 1024 * 1024, 1024, 1);
        g8::gemm_phase8<0x7A7A7A7A, 0x7C7C7C7C>((LAS unsigned char*)lds, (const char*)(ows(p) + WS_Y), 1024, S, E);
    } else {
        S.init(((l == DEPTH - 1) ? NLAT : NTOK) / 256, 4, (int)gridDim.x, obid(), (const bf16_t*)(ows(p) + WS_WOUT) + (size_t)l * 1024 * 1024, 1024);
        g8::gemm_phase((LAS unsigned char*)lds, (const char*)(ows(p) + WS_Y), 1024, S, E);
    }
    if (gridDim.x == 256 && l < DEPTH - 1 && obid() >= 32 && scl != 0.0f) { __syncthreads(); convert_experts(p, l, (float*)(lds + (otid() >> 6) * 16384), (obid() - 32) * 8 + (otid() >> 6), 224 * 8, CV_B, CV_B + CV_F); }
}
__device__ __forceinline__ int moe_tables256(const Params& p, int l, unsigned char* lds) {
    int* s_pref = (int*)(lds + LDS_MISC); int* s_cnt = s_pref + 40;
    unsigned* cnt = (unsigned*)(ows(p) + WS_CTL) + CW_CNT + 64 * 32 * l;
    __syncthreads();
    if (otid() == 0) {
        int acc = 0;
        for (int e = 0; e < NEXP; ++e) { const int c = (int)__hip_atomic_load(cnt + 64 * e, __ATOMIC_RELAXED, __HIP_MEMORY_SCOPE_AGENT); s_cnt[e] = c; s_pref[e] = acc; acc += (c + 255) >> 8; }
        s_pref[NEXP] = acc;
    }
    __syncthreads();
    return s_pref[NEXP];
}
__device__ __forceinline__ void moe_setup(const Params& p, int l, unsigned char* lds) {
    const int T = moe_tables256(p, l, lds);
    const int* s_pref = (const int*)(lds + LDS_MISC); const int* s_cnt = s_pref + 40;
    int* utab = (int*)(lds + g8::MOE_UTAB); int* rtok = (int*)(lds + g8::MOE_RTOK); float* rgate = (float*)(lds + g8::MOE_RGATE);
    const int tid = otid(), G = (int)gridDim.x, c = obid();
    if (tid < 4) {
        const int L = tid * G + c; int* t = utab + tid * 8;
        if (L < T * 4) {
            const int mtg = L >> 2; int e = 0;
            for (int q = 1; q < NEXP; ++q) if (s_pref[q] <= mtg) e = q;
            const int mt = mtg - s_pref[e];
            t[0] = mtg; t[1] = L & 3; t[2] = e; t[3] = min(256, s_cnt[e] - mt * 256); t[4] = e * NTOK + mt * 256; t[5] = 1;
        } else { int z = 0; asm volatile("" : "+v"(z)); t[0] = z; t[1] = z; t[2] = z; t[3] = z; t[4] = z; t[5] = z; }
    }
    __syncthreads();
    const int* ltok = (const int*)(ows(p) + WS_LTOK); const float* lgate = (const float*)(ows(p) + WS_LGATE);
    for (int idx = tid; idx < 1024; idx += 512) {
        const int i = idx >> 8, r = idx & 255; const int* t = utab + i * 8;
        const bool ok = t[5] != 0 && r < t[3];
        rtok[idx] = ok ? ltok[t[4] + r] : 0; rgate[idx] = ok ? lgate[t[4] + r] : 0.f;
    }
    __syncthreads();
}
__device__ __forceinline__ void phase_moe_gu_fast(const Params& p, int l, unsigned char* lds) {
    moe_setup(p, l, lds);
    g8::MoeOrder<true> S; S.utab = (const int*)(lds + g8::MOE_UTAB); S.rtok = (const int*)(lds + g8::MOE_RTOK); S.K = 1024;
    if (MOE_FP8) {
        S.W = (const char*)(ows(p) + WS_WGU8) + (size_t)l * 32 * 1024 * 1024; S.bpe = 1;
        g8::EpiGU8 E{ows(p) + WS_HID8};
        g8::gemm_phase8<0x7A7A7A7A, 0x7F7F7F7F>((LAS unsigned char*)lds, (const char*)(ows(p) + WS_H8), 1024, S, E);
    } else {
        S.W = (const char*)(ows(p) + WS_WGU) + (size_t)l * 32 * 1024 * 1024 * 2; S.bpe = 2;
        g8::EpiGU2 E{(bf16_t*)(ows(p) + WS_HID)};
        g8::gemm_phase((LAS unsigned char*)lds, (const char*)(ows(p) + WS_H), 1024, S, E);
    }
}
__device__ __forceinline__ void phase_moe_down_fast(const Params& p, int l, unsigned char* lds) {
    moe_setup(p, l, lds);
    g8::MoeOrder<false> S; S.utab = (const int*)(lds + g8::MOE_UTAB); S.rtok = (const int*)(lds + g8::MOE_RTOK); S.K = 512;
    g8::EpiDown2 E{(bf16_t*)(ows(p) + WS_YB), (const int*)(lds + g8::MOE_RTOK), (const float*)(lds + g8::MOE_RGATE)};
    if (MOE_FP8) {
        S.W = (const char*)(ows(p) + WS_WDN8) + (size_t)l * 32 * 1024 * 512; S.bpe = 1;
        g8::EpiDown8 E8{ows(p) + WS_YB8, (const int*)(lds + g8::MOE_RTOK), (const float*)(lds + g8::MOE_RGATE)};
        g8::gemm_phase8<0x7B7B7B7B, 0x7E7E7E7E>((LAS unsigned char*)lds, (const char*)(ows(p) + WS_HID8), 512, S, E8);
    } else {
        S.W = (const char*)(ows(p) + WS_WDN) + (size_t)l * 32 * 1024 * 512 * 2; S.bpe = 2;
        g8::gemm_phase((LAS unsigned char*)lds, (const char*)(ows(p) + WS_HID), 512, S, E);
    }
}

__device__ __forceinline__ void phase_c(const Params& p, int l, unsigned char* lds) {
    phase_gla_pre2(p, l, lds);
}

__global__ void __launch_bounds__(512, 2) mk(Params p) {
    extern __shared__ __attribute__((aligned(16))) unsigned char lds[];
    const int lo = p.ph_lo, hi = p.ph_hi;
    volatile LAS unsigned* misc = (volatile LAS unsigned*)(lds + LDS_MISC + 1024);
    if (threadIdx.x < 4) misc[threadIdx.x] = 0u;
    __syncthreads();
    XcdBarrier bar; bar.bar = (unsigned*)(p.ws + WS_CTL) + CW_BAR; bar.x = 0; bar.st = misc;
    if (hi - lo > 1) bar = xcd_barrier_post((unsigned*)(p.ws + WS_CTL) + CW_BAR, misc);
#define IN(k) (lo <= (k) && (k) < hi)
#define SEAM(k) do { if (IN((k) + 1)) { xcd_barrier(bar); if (DUPK == 20) xcd_barrier(bar); } } while (0)
#define REP(kind) for (int _rep = 0; _rep < ((DUPK == (kind)) ? 2 : 1); ++_rep)
    if (IN(0)) { REP(0) phase_prologue(p, lds); SEAM(0); }
    if (IN(1)) { REP(1) phase_modreduce(p); SEAM(1); }
    for (int l = 0; l < DEPTH; ++l) {
        const int pb = 2 + 9 * l;
        if (IN(pb + 0)) { if (DUPK == 2) phase_norm1(p, l, (float)(lo > 1000)); phase_norm1(p, l, 1.0f); SEAM(pb + 0); }
        if (IN(pb + 1)) { REP(3) { if (FAST_G1) phase_gemm1_fast(p, l, lds); else phase_gemm1(p, l, lds); } SEAM(pb + 1); }
        if (IN(pb + 2)) { REP(4) { phase_c(p, l, lds); } SEAM(pb + 2); }
        if (IN(pb + 3)) { REP(5) { phase_gla_seq2(p, l, lds); } SEAM(pb + 3); }
        if (IN(pb + 4)) { REP(6) phase_gla_post(p, l); SEAM(pb + 4); }
        if (IN(pb + 5)) { if (DUPK == 7) phase_gemm2_fast(p, l, lds, (float)(lo > 1000)); phase_gemm2_fast(p, l, lds, 1.0f); SEAM(pb + 5); }
        if (IN(pb + 6)) { if (DUPK == 8) phase_router2(p, l, lds, lo > 1000); phase_router2(p, l, lds, true); SEAM(pb + 6); }
        if (IN(pb + 7)) { REP(9) { if (FAST_MOE) phase_moe_gu_fast(p, l, lds); else phase_moe_gu(p, l, lds); } SEAM(pb + 7); }
        if (IN(pb + 8)) { REP(10) { if (FAST_MOE) phase_moe_down_fast(p, l, lds); else phase_moe_down(p, l, lds); } SEAM(pb + 8); }
    }
    if (IN(NPH - 1)) { REP(11) phase_final(p); }
#undef IN
#undef SEAM
}

#ifndef MK_LAUNCHES
#define MK_LAUNCHES 1
#endif
extern "C" void kernel_launch(void* const* d_in, const int* in_sizes, int n_in, void* d_out, int out_size, void* d_ws, size_t ws_size, hipStream_t stream) {
    static int grid = 0;
    if (grid == 0) {
        int dev = 0, cus = 0;
        if (n_in != 20 || ws_size < WS_END) { fprintf(stderr, "kernel_launch: unexpected shapes (n_in %d, ws %zu < %zu)\n", n_in, ws_size, (size_t)WS_END); grid = -1; return; }
        if (hipGetDevice(&dev) != hipSuccess || hipDeviceGetAttribute(&cus, hipDeviceAttributeMultiprocessorCount, dev) != hipSuccess) { grid = -1; return; }
        if (hipFuncSetAttribute((const void*)mk, hipFuncAttributeMaxDynamicSharedMemorySize, LDS_BYTES) != hipSuccess) { fprintf(stderr, "kernel_launch: hipFuncSetAttribute failed\n"); grid = -1; return; }
        (void)hipGetLastError();
        grid = cus;
    }
    if (grid < 0) return;
    (void)hipMemsetAsync((char*)d_ws + WS_CTL, 0, CTL_BYTES, stream);
    Params p{};
    for (int i = 0; i < 20; ++i) p.in[i] = (const float*)d_in[i];
    p.out = (float*)d_out; p.ws = (unsigned char*)d_ws;
    if (MK_LAUNCHES == 1) { p.ph_lo = 0; p.ph_hi = NPH; hipLaunchKernelGGL(mk, dim3(grid), dim3(512), LDS_BYTES, stream, p); }
    else for (int ph = 0; ph < NPH; ++ph) { p.ph_lo = ph; p.ph_hi = ph + 1; hipLaunchKernelGGL(mk, dim3(grid), dim3(512), LDS_BYTES, stream, p); }
}
```

```cpp
#include <hip/hip_runtime.h>
#include <stdint.h>
#include <stdio.h>

typedef unsigned short bf16_t;
typedef short bf16x8 __attribute__((ext_vector_type(8)));
typedef float f32x4 __attribute__((ext_vector_type(4)));
typedef unsigned u32x4 __attribute__((ext_vector_type(4)));
typedef unsigned u32x2 __attribute__((ext_vector_type(2)));
typedef int i32x8 __attribute__((ext_vector_type(8)));
typedef int i32x4 __attribute__((ext_vector_type(4)));
typedef short s16x4 __attribute__((ext_vector_type(4)));
typedef float f32x2 __attribute__((ext_vector_type(2)));
#define LAS __attribute__((address_space(3)))
#define GAS __attribute__((address_space(1)))

#ifndef G2_FP8
#define G2_FP8 1
#endif
#ifndef DUPK
#define DUPK -1
#endif
#ifndef MOE_FP8
#define MOE_FP8 1
#endif
constexpr int D = 1024, NB = 8, SEQ = 2048, DEPTH = 4, CTXL = 256;
constexpr int NLAT = NB * SEQ, NCTX = NB * CTXL, NTOK = NLAT + NCTX;
constexpr int PW = 4096;
constexpr int OFF_B = 0, OFF_C = 512, OFF_HV = 1024, OFF_Q = 1536, OFF_ZF = 2048, OFF_I = 3072, OFF_G = 3584;
constexpr int NEXP = 32;
constexpr int NCHUNK = NTOK / 16;
constexpr float EPS = 1e-6f;
constexpr int NMODP = 16;
constexpr int CV_ALL = 32 * (16 * 32 + 8 * 32), CV_B = 128 * 8 * 7, CV_F = 224 * 8 * 6;
constexpr int CV_S = (4 * CV_ALL - 4 * CV_B - 3 * CV_F) / 4, CV_LAYER = CV_B + CV_S + CV_F;
static_assert(4 * CV_B + 4 * CV_S + 3 * CV_F == 4 * CV_ALL, "conversion schedule");
static_assert(CV_LAYER >= CV_ALL && 3 * CV_LAYER + CV_B + CV_S == 4 * CV_ALL, "conversion schedule");

constexpr size_t WS_CTL = 0, CTL_BYTES = 65536;
constexpr size_t WS_WIN = WS_CTL + CTL_BYTES;
constexpr size_t WS_WOUT = WS_WIN + (size_t)4 * 4096 * 1024 * 2;
constexpr size_t WS_WGU = WS_WOUT + (size_t)4 * 1024 * 1024 * 2;
constexpr size_t WS_WDN = WS_WGU + (size_t)4 * 32 * 1024 * 1024 * 2;
constexpr size_t WS_MODP = WS_WDN + (size_t)4 * 32 * 1024 * 512 * 2;
constexpr size_t WS_MOD = WS_MODP + (size_t)4 * NMODP * 9 * 6144 * 4;
constexpr size_t WS_X = WS_MOD + (size_t)4 * 9 * 6144 * 4;
constexpr size_t WS_H = WS_X + (size_t)NTOK * 1024 * 4;
constexpr size_t WS_P = WS_H + (size_t)NTOK * 1024 * 2;
constexpr size_t WS_Y = WS_P + (size_t)NTOK * 4096 * 2;
constexpr size_t WS_QIN = WS_Y + (size_t)NTOK * 1024 * 2;
constexpr size_t WS_KOUT = WS_QIN + (size_t)2 * NTOK * 512 * 2;
constexpr size_t WS_DCH = WS_KOUT + (size_t)2 * NTOK * 512 * 2;
constexpr size_t WS_OINTRA = WS_DCH + (size_t)2 * NCHUNK * 512 * 4;
constexpr size_t WS_OINTER = WS_OINTRA + (size_t)NTOK * 512 * 4;
constexpr size_t WS_LTOK = WS_OINTER + (size_t)2 * NTOK * 512 * 4;
constexpr size_t WS_LGATE = WS_LTOK + (size_t)32 * NTOK * 4;
constexpr int HID_ROWS = 2 * NTOK + 32 * 256;
constexpr size_t WS_HID = WS_LGATE + (size_t)32 * NTOK * 4;
constexpr size_t WS_YB = WS_HID + (size_t)HID_ROWS * 512 * 2;
constexpr int REC_BYTES = 9216, VREC_BYTES = 4096;
constexpr size_t WS_GREC = WS_YB + (size_t)2 * NTOK * 1024 * 2;
constexpr size_t WS_VREC = WS_GREC + (size_t)2 * NCHUNK * 4 * REC_BYTES;
constexpr size_t WS_WRH = WS_VREC + (size_t)NCHUNK * 4 * VREC_BYTES;
constexpr size_t WS_WRL = WS_WRH + (size_t)4 * 48 * 1024 * 2;
constexpr size_t WS_H8 = WS_WRL + (size_t)4 * 48 * 1024 * 2;
constexpr size_t WS_HID8 = WS_H8 + (size_t)NTOK * 1024;
constexpr size_t WS_WGU8 = WS_HID8 + (size_t)HID_ROWS * 512;
constexpr size_t WS_WDN8 = WS_WGU8 + (size_t)4 * 32 * 1024 * 1024;
constexpr size_t WS_YB8 = WS_WDN8 + (size_t)4 * 32 * 1024 * 512;
constexpr size_t WS_DELTA = WS_YB8 + (size_t)2 * NTOK * 1024;
constexpr size_t WS_END = WS_DELTA + (size_t)NTOK * 1024 * 2;
constexpr int CW_BAR = 0;
constexpr int CW_CNT = 8192;

constexpr int LDS_BYTES = 147456;
constexpr int LDS_MISC = 143360;
constexpr int NPH = 2 + 9 * DEPTH + 1;

__device__ __forceinline__ float bf2f(bf16_t b) { return __uint_as_float(((unsigned)b) << 16); }
__device__ __forceinline__ unsigned f2bf(float f) { unsigned u = __float_as_uint(f); return (u + 0x7fffu + ((u >> 16) & 1u)) >> 16; }
__device__ __forceinline__ unsigned pk2(float lo, float hi) { return f2bf(lo) | (f2bf(hi) << 16); }
__device__ __forceinline__ float wave_sum(float v) {
#pragma unroll
    for (int o = 1; o < 64; o <<= 1) v += __shfl_xor(v, o);
    return v;
}
__device__ __forceinline__ float frcp(float x) { return __builtin_amdgcn_rcpf(x); }
__device__ __forceinline__ float sigmoidf(float x) { return frcp(1.0f + __expf(-x)); }
__device__ __forceinline__ float siluf(float x) { return x * frcp(1.0f + __expf(-x)); }
__device__ __forceinline__ float clamp8(float v) { return __builtin_amdgcn_fmed3f(v, -416.0f, 416.0f); }
__device__ __forceinline__ unsigned pk4_fp8_raw(float a, float b, float c, float d) { int r = __builtin_amdgcn_cvt_pk_fp8_f32(a, b, 0, false); r = __builtin_amdgcn_cvt_pk_fp8_f32(c, d, r, true); return (unsigned)r; }
__device__ __forceinline__ unsigned pk4_fp8(float a, float b, float c, float d) { int r = __builtin_amdgcn_cvt_pk_fp8_f32(clamp8(a), clamp8(b), 0, false); r = __builtin_amdgcn_cvt_pk_fp8_f32(clamp8(c), clamp8(d), r, true); return (unsigned)r; }
__device__ __forceinline__ f32x4 unpk4_fp8(unsigned w) { const f32x2 lo = __builtin_amdgcn_cvt_pk_f32_fp8((int)w, false), hi = __builtin_amdgcn_cvt_pk_f32_fp8((int)w, true); return (f32x4){lo.x, lo.y, hi.x, hi.y}; }
typedef __bf16 bf16x2_t __attribute__((ext_vector_type(2)));
__device__ __forceinline__ f32x4 unpk4_bf16(u32x2 w) { return (f32x4){__uint_as_float(w.x << 16), __uint_as_float(w.x & 0xffff0000u), __uint_as_float(w.y << 16), __uint_as_float(w.y & 0xffff0000u)}; }
__device__ __forceinline__ unsigned cvtpk(float lo, float hi) { const f32x2 v = {lo, hi}; const bf16x2_t r = __builtin_convertvector(v, bf16x2_t); return __builtin_bit_cast(unsigned, r); }
__device__ __forceinline__ int mod_row(int r) { return r < NLAT ? (r >> 11) : 8; }
#define LDS_WAIT() asm volatile("s_waitcnt lgkmcnt(0)" ::: "memory")
__device__ __forceinline__ int otid() { int t = threadIdx.x; asm volatile("" : "+v"(t)); return t; }
__device__ __forceinline__ int obid() { int b = blockIdx.x; asm volatile("" : "+s"(b)); return b; }

#define XB_TMO      128
#define XB_XCNT(j)  (256  + 64 * (j))
#define XB_XSUB(j)  (1280 + 64 * (j))
#define XB_XGEN(j)  (2304 + 64 * (j))
#define XB_TOP      3328
#define XB_TOPGEN   3392
#define XCD_BAR_WORDS 3456
#define XB_SPIN_CAP (1u << 18)
__device__ __forceinline__ unsigned xb_ld(unsigned* p)              { return __hip_atomic_load(p, __ATOMIC_RELAXED, __HIP_MEMORY_SCOPE_AGENT); }
__device__ __forceinline__ unsigned xb_add(unsigned* p, unsigned v) { return __hip_atomic_fetch_add(p, v, __ATOMIC_RELAXED, __HIP_MEMORY_SCOPE_AGENT); }
__device__ __forceinline__ unsigned xb_xcc_id() { return (unsigned)__builtin_amdgcn_s_getreg((3 << 11) | 20) & 0xFu; }
#define XB_SPIN(cond, bar) do { unsigned _sp = 0; while (cond) { __builtin_amdgcn_s_sleep(1); \
    if ((++_sp & 255u) == 0u) { if (xb_ld(&(bar)[XB_TMO])) break; if (_sp > XB_SPIN_CAP) { atomicAdd(&(bar)[XB_TMO], 1u); break; } } } } while (0)
struct XcdBarrier { unsigned* bar; unsigned x; volatile LAS unsigned* st; };
__device__ __forceinline__ XcdBarrier xcd_barrier_post(unsigned* bar, volatile LAS unsigned* st) {
    XcdBarrier b; b.bar = bar; b.x = xb_xcc_id(); b.st = st;
    if (threadIdx.x == 0) (void)xb_add(&bar[XB_XCNT(b.x)], 1u);
    return b;
}
__device__ __forceinline__ void xcd_barrier_complete(unsigned* bar, unsigned x, unsigned& nloc, unsigned& nx) {
    const unsigned G = gridDim.x * gridDim.y * gridDim.z;
    unsigned sum, cnt, mine, sp = 0u;
    for (;;) {
        sum = 0u; cnt = 0u; mine = 0u;
#pragma unroll
        for (unsigned j = 0; j < 16; ++j) { const unsigned c = xb_ld(&bar[XB_XCNT(j)]); sum += c; cnt += (c > 0u) ? 1u : 0u; mine = (j == x) ? c : mine; }
        if (sum == G) break;
        __builtin_amdgcn_s_sleep(1);
        if ((++sp & 255u) == 0u) { if (xb_ld(&bar[XB_TMO])) break; if (sp > XB_SPIN_CAP) { atomicAdd(&bar[XB_TMO], 1u); break; } }
    }
    nloc = mine > 0u ? mine : 1u; nx = cnt > 0u ? cnt : 1u;
}
__device__ __forceinline__ void xcd_barrier(const XcdBarrier& b) {
    asm volatile("s_waitcnt vmcnt(0)" ::: "memory");
    __syncthreads();
    if (threadIdx.x == 0) {
        unsigned* bar = b.bar;
        __builtin_amdgcn_s_waitcnt(0);
        unsigned nloc = b.st[0], nx = b.st[1];
        if (nloc == 0u) { xcd_barrier_complete(bar, b.x, nloc, nx); b.st[0] = nloc; b.st[1] = nx; }
        const unsigned old = xb_add(&bar[XB_XSUB(b.x)], 1u);
        const unsigned gen = old / nloc;
        if (old + 1u == (gen + 1u) * nloc) {
            __builtin_amdgcn_fence(__ATOMIC_RELEASE, "agent");
            asm volatile("s_waitcnt vmcnt(0)" ::: "memory");
            const unsigned og = xb_add(&bar[XB_TOP], 1u);
            const unsigned tg = og / nx;
            if (og + 1u == (tg + 1u) * nx) xb_add(&bar[XB_TOPGEN], 1u);
            else XB_SPIN(xb_ld(&bar[XB_TOPGEN]) == tg, bar);
            __builtin_amdgcn_fence(__ATOMIC_ACQUIRE, "agent");
            xb_add(&bar[XB_XGEN(b.x)], 1u);
            asm volatile("s_waitcnt vmcnt(0)" ::: "memory");
        } else {
            XB_SPIN(xb_ld(&bar[XB_XGEN(b.x)]) == gen, bar);
            __builtin_amdgcn_fence(__ATOMIC_ACQUIRE, "agent");
            asm volatile("s_waitcnt vmcnt(0)" ::: "memory");
        }
    }
    __syncthreads();
}

struct Params {
    const float* in[20];
    float* out;
    unsigned char* ws;
    int ph_lo, ph_hi;
};

__device__ __forceinline__ unsigned char* ows(const Params& p) { GAS unsigned char* w = (GAS unsigned char*)p.ws; asm volatile("" : "+s"(w)); return (unsigned char*)w; }
__device__ __forceinline__ const float* oin(const Params& p, int k) { const GAS float* q = (const GAS float*)p.in[k]; asm volatile("" : "+s"(q)); return (const float*)q; }

template <class ARow, class Epi>
__device__ __forceinline__ void gemm128(unsigned char* lds, const ARow& arow, const bf16_t* __restrict__ Bt, int K, const Epi& epi) {
    const int tid = otid(), lane = tid & 63, wid = tid >> 6, wr = wid >> 2, wc = wid & 3, fr = lane & 15, fq = lane >> 4;
    bf16_t* sA = (bf16_t*)lds;
    bf16_t* sB = (bf16_t*)(lds + 128 * 144);
    f32x4 acc[4][2];
#pragma unroll
    for (int m = 0; m < 4; ++m)
#pragma unroll
        for (int n = 0; n < 2; ++n) acc[m][n] = (f32x4){0.f, 0.f, 0.f, 0.f};
    const bf16_t* ap[2]; const bf16_t* bp[2]; int so[2];
#pragma unroll
    for (int i = 0; i < 2; ++i) {
        const int q = tid + 512 * i, row = q >> 3, seg = q & 7;
        ap[i] = arow(row) + seg * 8; bp[i] = Bt + (size_t)row * K + seg * 8; so[i] = row * 72 + seg * 8;
    }
    for (int k0 = 0; k0 < K; k0 += 64) {
        u32x4 va[2], vb[2];
#pragma unroll
        for (int i = 0; i < 2; ++i) { va[i] = *(const u32x4*)(ap[i] + k0); vb[i] = *(const u32x4*)(bp[i] + k0); }
        __syncthreads();
#pragma unroll
        for (int i = 0; i < 2; ++i) { *(u32x4*)(sA + so[i]) = va[i]; *(u32x4*)(sB + so[i]) = vb[i]; }
        __syncthreads();
#pragma unroll
        for (int kk = 0; kk < 2; ++kk) {
            bf16x8 a[4], b[2];
#pragma unroll
            for (int m = 0; m < 4; ++m) a[m] = *(const bf16x8*)(sA + (wr * 64 + m * 16 + fr) * 72 + kk * 32 + fq * 8);
#pragma unroll
            for (int n = 0; n < 2; ++n) b[n] = *(const bf16x8*)(sB + (wc * 32 + n * 16 + fr) * 72 + kk * 32 + fq * 8);
#pragma unroll
            for (int m = 0; m < 4; ++m)
#pragma unroll
                for (int n = 0; n < 2; ++n) acc[m][n] = __builtin_amdgcn_mfma_f32_16x16x32_bf16(b[n], a[m], acc[m][n], 0, 0, 0);
        }
    }
#pragma unroll
    for (int m = 0; m < 4; ++m)
#pragma unroll
        for (int n = 0; n < 2; ++n) epi(wr * 64 + m * 16 + fr, wc * 32 + n * 16 + fq * 4, acc[m][n]);
    __syncthreads();
}

struct ARowPlain { const bf16_t* A; int ld; __device__ __forceinline__ const bf16_t* operator()(int i) const { return A + (size_t)i * ld; } };
struct ARowGather { const bf16_t* A; const int* tok; int nvalid; __device__ __forceinline__ const bf16_t* operator()(int i) const { const int t = (i < nvalid) ? (tok[i] >> 1) : 0; return A + (size_t)t * 1024; } };

struct EpiP { bf16_t* P; __device__ __forceinline__ void operator()(int r, int c, f32x4 v) const {
    u32x2 w; w.x = pk2(v[0], v[1]); w.y = pk2(v[2], v[3]); *(u32x2*)(P + (size_t)r * PW + c) = w; } };
struct EpiRes { float* X; const float* gate; int m0; __device__ __forceinline__ void operator()(int r, int c, f32x4 v) const {
    const float* g = gate + (size_t)mod_row(m0 + r) * 6144 + c; float* xp = X + (size_t)r * 1024 + c;
    f32x4 x = *(f32x4*)xp; const f32x4 gv = *(const f32x4*)g; x += gv * v; *(f32x4*)xp = x; } };
struct EpiGU { bf16_t* H; __device__ __forceinline__ void operator()(int r, int c, f32x4 v) const {
    const float h0 = siluf(v[0]) * v[1], h1 = siluf(v[2]) * v[3]; *(unsigned*)(H + (size_t)r * 512 + (c >> 1)) = pk2(h0, h1); } };
struct EpiDown { bf16_t* YB; const int* tok; const float* gate; int nvalid; __device__ __forceinline__ void operator()(int r, int c, f32x4 v) const {
    if (r < nvalid) { const int e = tok[r]; const float g = gate[r]; u32x2 w; w.x = pk2(g * v[0], g * v[1]); w.y = pk2(g * v[2], g * v[3]); *(u32x2*)(YB + (size_t)e * 1024 + c) = w; } } };


namespace g8 {
constexpr int BM = 256, BK = 64, HALF = 128, HTB = HALF * BK * 2, NXCD = 8, WGM = 8;
__device__ __forceinline__ int lds_byte(int r, int c) { const int st = (r >> 4) * 2 + (c >> 5), rr = r & 15, cc = c & 31, ob = rr * 64 + cc * 2; return st * 1024 + (ob ^ (((ob >> 9) & 1) << 5)); }
__device__ __forceinline__ void stage_rc(int b, int& R, int& C) { const int st = b / 1024, sb = b % 1024, swz = sb ^ (((sb >> 9) & 1) << 5); R = (st >> 1) * 16 + swz / 64; C = (st & 1) * 32 + (swz % 64) / 2; }
__device__ __forceinline__ int perm32(int rho) { const int n = rho >> 4, i = rho & 15; return 8 * (i >> 2) + 4 * n + (i & 3); }
__device__ __forceinline__ unsigned cvt_pk_bf16(float lo, float hi) { return cvtpk(lo, hi); }

__device__ __forceinline__ int g8_ra(int tid, int i) { int R, C; stage_rc(tid * 16 + i * 8192, R, C); return R; }
__device__ __forceinline__ unsigned g8_ca(int tid, int i) { int R, C; stage_rc(tid * 16 + i * 8192, R, C); return (unsigned)C * 2u; }
#define G8_RA(i) g8_ra(otid(), (i))
#define G8_CA(i) g8_ca(otid(), (i))
template <class Epi, class Sched>
__device__ __forceinline__ void gemm_phase(LAS unsigned char* lds, const char* Abase, const int K, const Sched& S, const Epi& E) {
    const int tid = otid(), wid = __builtin_amdgcn_readfirstlane(tid >> 6), lane = tid & 63, wr = wid >> 2, wc = wid & 3, fr = lane & 15, fq = lane >> 4;
    const int nt = K / BK;
    unsigned voffB[2];
#pragma unroll
    for (int i = 0; i < 2; ++i) { int R, C; stage_rc(tid * 16 + i * 8192, R, C); const int Rb = Epi::PERM ? ((R & ~31) + perm32(R & 31)) : R;
        voffB[i] = (unsigned)(Rb * K + C) * 2u; }
    const unsigned rowb = (unsigned)K * 2u;
    const size_t kstep = (size_t)(BK * 2);
    const size_t hstep = (size_t)HALF * K * 2;
    const unsigned ldsw = (unsigned)wid * 1024u;
    const int aoff = lds_byte(wr * 64 + fr, fq * 8), boff = lds_byte(wc * 32 + fr, fq * 8);
#define G8_SA(b, h) (((b) * 2 + (h)) * HTB)
#define G8_SB(b, h) ((4 + (b) * 2 + (h)) * HTB)
#define G8_STAGE(bufoff, gbase, voff) do { _Pragma("unroll") for (int _i = 0; _i < 2; ++_i) \
        __builtin_amdgcn_global_load_lds((const unsigned*)((const char*)(gbase) + (voff)[_i]), (LAS unsigned*)(lds + (bufoff) + ldsw + _i * 8192), 16, 0, 0); } while (0)
#define G8_LDA(dst, b, h) do { _Pragma("unroll") for (int m = 0; m < 4; ++m) _Pragma("unroll") for (int k = 0; k < 2; ++k) dst[m][k] = *(const LAS bf16x8*)(lds + G8_SA(b, h) + aoff + m * 2048 + k * 1024); } while (0)
#define G8_LDB(dst, b, h) do { _Pragma("unroll") for (int n = 0; n < 2; ++n) _Pragma("unroll") for (int k = 0; k < 2; ++k) dst[n][k] = *(const LAS bf16x8*)(lds + G8_SB(b, h) + boff + n * 2048 + k * 1024); } while (0)
#define G8_MMA(ai, bj, At, Bt) do { __builtin_amdgcn_s_setprio(1); _Pragma("unroll") for (int m = 0; m < 4; ++m) _Pragma("unroll") for (int n = 0; n < 2; ++n) _Pragma("unroll") for (int k = 0; k < 2; ++k) \
        acc[ai][bj][m][n] = __builtin_amdgcn_mfma_f32_16x16x32_bf16(Bt[n][k], At[m][k], acc[ai][bj][m][n], 0, 0, 0); __builtin_amdgcn_s_setprio(0); } while (0)
#define G8_WAIT_V(n) asm volatile("s_waitcnt vmcnt(" #n ")" ::: "memory")
#define G8_WAIT_L(n) asm volatile("s_waitcnt lgkmcnt(" #n ")" ::: "memory")
#define G8_BAR __builtin_amdgcn_s_barrier()
#define G8_SCHED __builtin_amdgcn_sched_barrier(0)
    typename Sched::Unit cur, nxt; int ui = 0;
    if (!S.next(0, cur)) return;
    f32x4 acc[2][2][4][2];
#pragma unroll
    for (int a = 0; a < 2; ++a)
#pragma unroll
        for (int b = 0; b < 2; ++b)
#pragma unroll
            for (int m = 0; m < 4; ++m)
#pragma unroll
                for (int n = 0; n < 2; ++n) acc[a][b][m][n] = (f32x4){0.f, 0.f, 0.f, 0.f};
    bf16x8 At[4][2], B0[2][2], B1[2][2];
    unsigned vAc[2][2], vAn[2][2];
#pragma unroll
    for (int h = 0; h < 2; ++h)
#pragma unroll
        for (int i = 0; i < 2; ++i) vAc[h][i] = (Sched::AFFINE ? (unsigned)(h * HALF + G8_RA(i)) : (unsigned)S.a_row(cur, h * HALF + G8_RA(i))) * rowb + G8_CA(i);
    const char* cA = Sched::AFFINE ? Abase + (size_t)S.a_row(cur, 0) * rowb : Abase;
    const char* cB = S.b_base(cur);
    G8_STAGE(G8_SB(0, 0), cB, voffB); G8_STAGE(G8_SA(0, 0), cA, vAc[0]); G8_STAGE(G8_SB(0, 1), cB + hstep, voffB); G8_STAGE(G8_SA(0, 1), cA, vAc[1]);
    if (wr == 1) G8_BAR;
    G8_WAIT_V(4); G8_BAR;
    G8_STAGE(G8_SB(1, 0), cB + kstep, voffB); G8_STAGE(G8_SA(1, 0), cA + kstep, vAc[0]); G8_STAGE(G8_SB(1, 1), cB + hstep + kstep, voffB);
    G8_WAIT_V(6); G8_BAR;
    for (;;) {
        const bool has_next = S.next(ui + 1, nxt);
#pragma unroll
        for (int h = 0; h < 2; ++h)
#pragma unroll
            for (int i = 0; i < 2; ++i) vAn[h][i] = (has_next && !Sched::AFFINE) ? ((unsigned)S.a_row(nxt, h * HALF + G8_RA(i)) * rowb + G8_CA(i)) : vAc[h][i];
        const char* nA = (has_next && Sched::AFFINE) ? Abase + (size_t)S.a_row(nxt, 0) * rowb : cA;
        const char* nB = has_next ? S.b_base(nxt) : cB;
        for (int t = 0; t < nt; t += 2) {
            const bool last = (t == nt - 2);
            const char* a1 = cA + (size_t)(t + 1) * kstep;
            const char* a2 = last ? nA : cA + (size_t)(t + 2) * kstep; const char* b2 = last ? nB : cB + (size_t)(t + 2) * kstep;
            const char* a3 = a2 + kstep; const char* b3 = b2 + kstep;
            unsigned v2[2][2];
#pragma unroll
            for (int h = 0; h < 2; ++h)
#pragma unroll
                for (int i = 0; i < 2; ++i) v2[h][i] = last ? vAn[h][i] : vAc[h][i];
            G8_LDB(B0, 0, 0); G8_SCHED; G8_LDA(At, 0, 0); G8_STAGE(G8_SA(1, 1), a1, vAc[1]);
            G8_WAIT_L(8); G8_BAR; G8_WAIT_L(0); G8_MMA(0, 0, At, B0); G8_BAR; G8_SCHED;
            G8_LDB(B1, 0, 1); G8_STAGE(G8_SB(0, 0), b2, voffB);
            G8_BAR; G8_WAIT_L(0); G8_MMA(0, 1, At, B1); G8_BAR;
            G8_LDA(At, 0, 1); G8_STAGE(G8_SA(0, 0), a2, v2[0]);
            G8_BAR; G8_WAIT_L(0); G8_MMA(1, 0, At, B0); G8_BAR; G8_SCHED;
            G8_STAGE(G8_SB(0, 1), b2 + hstep, voffB);
            G8_WAIT_V(6); G8_BAR; G8_MMA(1, 1, At, B1); G8_BAR;
            G8_LDB(B0, 1, 0); G8_SCHED; G8_LDA(At, 1, 0); G8_STAGE(G8_SA(0, 1), a2, v2[1]);
            G8_WAIT_L(8); G8_BAR; G8_WAIT_L(0); G8_MMA(0, 0, At, B0); G8_BAR; G8_SCHED;
            G8_LDB(B1, 1, 1); G8_STAGE(G8_SB(1, 0), b3, voffB);
            G8_BAR; G8_WAIT_L(0); G8_MMA(0, 1, At, B1); G8_BAR;
            G8_LDA(At, 1, 1); G8_STAGE(G8_SA(1, 0), a3, v2[0]);
            G8_BAR; G8_WAIT_L(0); G8_MMA(1, 0, At, B0); G8_BAR; G8_SCHED;
            G8_STAGE(G8_SB(1, 1), b3 + hstep, voffB);
            G8_WAIT_V(6); G8_BAR; G8_MMA(1, 1, At, B1); G8_BAR;
        }
        E(acc, cur, wr, wc, fr, fq);
        if (!has_next) break;
#pragma unroll
        for (int a = 0; a < 2; ++a)
#pragma unroll
            for (int b = 0; b < 2; ++b)
#pragma unroll
                for (int m = 0; m < 4; ++m)
#pragma unroll
                    for (int n = 0; n < 2; ++n) acc[a][b][m][n] = (f32x4){0.f, 0.f, 0.f, 0.f};
        cur = nxt; cB = nB; cA = nA; ++ui;
#pragma unroll
        for (int h = 0; h < 2; ++h)
#pragma unroll
            for (int i = 0; i < 2; ++i) vAc[h][i] = vAn[h][i];
    }
    G8_WAIT_V(0);
    if (wr == 0) G8_BAR;
    G8_BAR;
#undef G8_SA
#undef G8_SB
#undef G8_STAGE
#undef G8_LDA
#undef G8_LDB
#undef G8_MMA
#undef G8_WAIT_V
#undef G8_WAIT_L
#undef G8_BAR
#undef G8_SCHED
}

template <int sclW, int sclA, class Epi, class Sched>
__device__ __forceinline__ void gemm_phase8(LAS unsigned char* lds, const char* Abase, const int K, const Sched& S, const Epi& E) {
    const int tid = otid(), wid = __builtin_amdgcn_readfirstlane(tid >> 6), lane = tid & 63, wr = wid >> 2, wc = wid & 3, fr = lane & 15, fq = lane >> 4;
    const int nt = K / 128;
    unsigned voffB[2];
#pragma unroll
    for (int i = 0; i < 2; ++i) { int R, C; stage_rc(tid * 16 + i * 8192, R, C); const int Rb = Epi::PERM ? ((R & ~31) + perm32(R & 31)) : R;
        voffB[i] = (unsigned)(Rb * K) + (unsigned)C * 2u; }
    const unsigned rowb = (unsigned)K;
    const size_t kstep = (size_t)(BK * 2);
    const size_t hstep = (size_t)HALF * K;
    const unsigned ldsw = (unsigned)wid * 1024u;
    const int fob = fr * 64 + ((2 * (fq & 1)) ^ (2 * (fr >> 3))) * 16 + (fq >> 1) * 1024;
    const int aoff = ((wr * 64) >> 4) * 2048 + fob, boff = ((wc * 32) >> 4) * 2048 + fob;
#define G8_SA(b, h) (((b) * 2 + (h)) * HTB)
#define G8_SB(b, h) ((4 + (b) * 2 + (h)) * HTB)
#define G8_STAGE(bufoff, gbase, voff) do { _Pragma("unroll") for (int _i = 0; _i < 2; ++_i) \
        __builtin_amdgcn_global_load_lds((const unsigned*)((const char*)(gbase) + (voff)[_i]), (LAS unsigned*)(lds + (bufoff) + ldsw + _i * 8192), 16, 0, 0); } while (0)
#define G8_LDA(dst, b, h) do { _Pragma("unroll") for (int m = 0; m < 4; ++m) { const i32x4 _lo = *(const LAS i32x4*)(lds + G8_SA(b, h) + aoff + m * 2048), _hi = *(const LAS i32x4*)(lds + G8_SA(b, h) + aoff + m * 2048 + 16); dst[m] = __builtin_shufflevector(_lo, _hi, 0, 1, 2, 3, 4, 5, 6, 7); } } while (0)
#define G8_LDB(dst, b, h) do { _Pragma("unroll") for (int n = 0; n < 2; ++n) { const i32x4 _lo = *(const LAS i32x4*)(lds + G8_SB(b, h) + boff + n * 2048), _hi = *(const LAS i32x4*)(lds + G8_SB(b, h) + boff + n * 2048 + 16); dst[n] = __builtin_shufflevector(_lo, _hi, 0, 1, 2, 3, 4, 5, 6, 7); } } while (0)
#define G8_MMA(ai, bj, At, Bt) do { __builtin_amdgcn_s_setprio(1); _Pragma("unroll") for (int m = 0; m < 4; ++m) _Pragma("unroll") for (int n = 0; n < 2; ++n) \
        acc[ai][bj][m][n] = __builtin_amdgcn_mfma_scale_f32_16x16x128_f8f6f4(Bt[n], At[m], acc[ai][bj][m][n], 0, 0, 0, sclW, 0, sclA); \
        _Pragma("unroll") for (int m = 0; m < 4; ++m) asm volatile("" : "+v"(acc[ai][bj][m][0]), "+v"(acc[ai][bj][m][1]));   \
        __builtin_amdgcn_s_setprio(0); } while (0)
#define G8_WAIT_V(n) asm volatile("s_waitcnt vmcnt(" #n ")" ::: "memory")
#define G8_WAIT_L(n) asm volatile("s_waitcnt lgkmcnt(" #n ")" ::: "memory")
#define G8_BAR __builtin_amdgcn_s_barrier()
#define G8_SCHED __builtin_amdgcn_sched_barrier(0)
    typename Sched::Unit cur, nxt; int ui = 0;
    if (!S.next(0, cur)) return;
    f32x4 acc[2][2][4][2];
#pragma unroll
    for (int a = 0; a < 2; ++a)
#pragma unroll
        for (int b = 0; b < 2; ++b)
#pragma unroll
            for (int m = 0; m < 4; ++m)
#pragma unroll
                for (int n = 0; n < 2; ++n) acc[a][b][m][n] = (f32x4){0.f, 0.f, 0.f, 0.f};
    i32x8 At[4], B0[2], B1[2];
    unsigned vAc[2][2], vAn[2][2];
#pragma unroll
    for (int h = 0; h < 2; ++h)
#pragma unroll
        for (int i = 0; i < 2; ++i) vAc[h][i] = (Sched::AFFINE ? (unsigned)(h * HALF + G8_RA(i)) : (unsigned)S.a_row(cur, h * HALF + G8_RA(i))) * rowb + G8_CA(i);
    const char* cA = Sched::AFFINE ? Abase + (size_t)S.a_row(cur, 0) * rowb : Abase;
    const char* cB = S.b_base(cur);
    G8_STAGE(G8_SB(0, 0), cB, voffB); G8_STAGE(G8_SA(0, 0), cA, vAc[0]); G8_STAGE(G8_SB(0, 1), cB + hstep, voffB); G8_STAGE(G8_SA(0, 1), cA, vAc[1]);
    if (wr == 1) G8_BAR;
    G8_WAIT_V(4); G8_BAR;
    G8_STAGE(G8_SB(1, 0), cB + kstep, voffB); G8_STAGE(G8_SA(1, 0), cA + kstep, vAc[0]); G8_STAGE(G8_SB(1, 1), cB + hstep + kstep, voffB);
    G8_WAIT_V(6); G8_BAR;
    for (;;) {
        const bool has_next = S.next(ui + 1, nxt);
#pragma unroll
        for (int h = 0; h < 2; ++h)
#pragma unroll
            for (int i = 0; i < 2; ++i) vAn[h][i] = (has_next && !Sched::AFFINE) ? ((unsigned)S.a_row(nxt, h * HALF + G8_RA(i)) * rowb + G8_CA(i)) : vAc[h][i];
        const char* nA = (has_next && Sched::AFFINE) ? Abase + (size_t)S.a_row(nxt, 0) * rowb : cA;
        const char* nB = has_next ? S.b_base(nxt) : cB;
#pragma unroll 1
        for (int t = 0; t < nt; t += 2) {
            const bool last = (t == nt - 2);
            const char* a1 = cA + (size_t)(t + 1) * kstep;
            const char* a2 = last ? nA : cA + (size_t)(t + 2) * kstep; const char* b2 = last ? nB : cB + (size_t)(t + 2) * kstep;
            const char* a3 = a2 + kstep; const char* b3 = b2 + kstep;
            unsigned v2[2][2];
#pragma unroll
            for (int h = 0; h < 2; ++h)
#pragma unroll
                for (int i = 0; i < 2; ++i) v2[h][i] = last ? vAn[h][i] : vAc[h][i];
            G8_LDB(B0, 0, 0); G8_SCHED; G8_LDA(At, 0, 0); G8_STAGE(G8_SA(1, 1), a1, vAc[1]);
            G8_WAIT_L(8); G8_BAR; G8_WAIT_L(0); G8_MMA(0, 0, At, B0); G8_BAR; G8_SCHED;
            G8_LDB(B1, 0, 1); G8_STAGE(G8_SB(0, 0), b2, voffB);
            G8_BAR; G8_WAIT_L(0); G8_MMA(0, 1, At, B1); G8_BAR;
            G8_LDA(At, 0, 1); G8_STAGE(G8_SA(0, 0), a2, v2[0]);
            G8_BAR; G8_WAIT_L(0); G8_MMA(1, 0, At, B0); G8_BAR; G8_SCHED;
            G8_STAGE(G8_SB(0, 1), b2 + hstep, voffB);
            G8_WAIT_V(6); G8_BAR; G8_MMA(1, 1, At, B1); G8_BAR;
            G8_LDB(B0, 1, 0); G8_SCHED; G8_LDA(At, 1, 0); G8_STAGE(G8_SA(0, 1), a2, v2[1]);
            G8_WAIT_L(8); G8_BAR; G8_WAIT_L(0); G8_MMA(0, 0, At, B0); G8_BAR; G8_SCHED;
            G8_LDB(B1, 1, 1); G8_STAGE(G8_SB(1, 0), b3, voffB);
            G8_BAR; G8_WAIT_L(0); G8_MMA(0, 1, At, B1); G8_BAR;
            G8_LDA(At, 1, 1); G8_STAGE(G8_SA(1, 0), a3, v2[0]);
            G8_BAR; G8_WAIT_L(0); G8_MMA(1, 0, At, B0); G8_BAR; G8_SCHED;
            G8_STAGE(G8_SB(1, 1), b3 + hstep, voffB);
            G8_WAIT_V(6); G8_BAR; G8_MMA(1, 1, At, B1); G8_BAR;
        }
        E(acc, cur, wr, wc, fr, fq);
        if (!has_next) break;
#pragma unroll
        for (int a = 0; a < 2; ++a)
#pragma unroll
            for (int b = 0; b < 2; ++b)
#pragma unroll
                for (int m = 0; m < 4; ++m)
#pragma unroll
                    for (int n = 0; n < 2; ++n) acc[a][b][m][n] = (f32x4){0.f, 0.f, 0.f, 0.f};
        cur = nxt; cB = nB; cA = nA; ++ui;
#pragma unroll
        for (int h = 0; h < 2; ++h)
#pragma unroll
            for (int i = 0; i < 2; ++i) vAc[h][i] = vAn[h][i];
    }
    G8_WAIT_V(0);
    if (wr == 0) G8_BAR;
    G8_BAR;
#undef G8_SA
#undef G8_SB
#undef G8_STAGE
#undef G8_LDA
#undef G8_LDB
#undef G8_MMA
#undef G8_WAIT_V
#undef G8_WAIT_L
#undef G8_BAR
#undef G8_SCHED
}

struct DUnit { int pm, pn; };
struct DenseOrder {
    typedef DUnit Unit; static constexpr bool AFFINE = true;
    int nM, nN, nwg, G, c; const char* Bt; int K; int bpe;
    __device__ __forceinline__ void init(int nM_, int nN_, int G_, int c_, const void* Bt_, int K_, int bpe_ = 2) { nM = nM_; nN = nN_; nwg = nM * nN; G = G_; c = c_; Bt = (const char*)Bt_; K = K_; bpe = bpe_; }
    __device__ __forceinline__ bool next(int i, Unit& u) const {
        const long L = (long)i * G + c; if (L >= nwg) return false;
        int wgid = (int)L; { const int q = nwg / NXCD, r = nwg % NXCD, xcd = wgid % NXCD, off = wgid / NXCD; wgid = (xcd < r ? xcd * (q + 1) : r * (q + 1) + (xcd - r) * q) + off; }
        const int nig = WGM * nN, gid = wgid / nig, fm = gid * WGM, gsz = (nM - fm) < WGM ? (nM - fm) : WGM;
        u.pm = fm + ((wgid % nig) % gsz); u.pn = (wgid % nig) / gsz; return true;
    }
    __device__ __forceinline__ int a_row(const Unit& u, int r) const { return u.pm * BM + r; }
    __device__ __forceinline__ const char* b_base(const Unit& u) const { return Bt + (size_t)u.pn * BM * K * bpe; }
};
struct MUnit { int pm, pn, e, nvalid, lbase, idx; };
constexpr int MOE_UTAB = 131072, MOE_RTOK = MOE_UTAB + 128, MOE_RGATE = MOE_RTOK + 4096;
template <bool GATHER> struct MoeOrder {
    typedef MUnit Unit; static constexpr bool AFFINE = !GATHER;
    const int* utab; const int* rtok; const char* W; int K; int bpe;
    __device__ __forceinline__ bool next(int i, Unit& u) const {
        if (i >= 4) return false;
        const int* t = utab + i * 8;
        if (t[5] == 0) return false;
        u.pm = t[0]; u.pn = t[1]; u.e = t[2]; u.nvalid = t[3]; u.lbase = t[4]; u.idx = i; return true;
    }
    __device__ __forceinline__ int a_row(const Unit& u, int r) const { if (GATHER) return rtok[u.idx * 256 + r] >> 1; else return u.pm * BM + r; }
    __device__ __forceinline__ const char* b_base(const Unit& u) const { return W + ((size_t)u.e * 1024 + u.pn * BM) * K * bpe; }
};

struct EpiP2 {
    static constexpr bool PERM = true;
    bf16_t* P;
    __device__ __forceinline__ void operator()(const f32x4 (&acc)[2][2][4][2], const DUnit& u, int wr, int wc, int fr, int fq) const {
        const int row0 = u.pm * BM + wr * 64 + fr, col0 = u.pn * BM + wc * 32 + 8 * fq;
#pragma unroll
        for (int ai = 0; ai < 2; ++ai)
#pragma unroll
            for (int m = 0; m < 4; ++m) { bf16_t* rowp = P + (size_t)(row0 + ai * HALF + m * 16) * PW + col0;
#pragma unroll
                for (int bj = 0; bj < 2; ++bj) { const f32x4 v0 = acc[ai][bj][m][0], v1 = acc[ai][bj][m][1];
                    u32x4 w; w.x = cvt_pk_bf16(v0[0], v0[1]); w.y = cvt_pk_bf16(v0[2], v0[3]); w.z = cvt_pk_bf16(v1[0], v1[1]); w.w = cvt_pk_bf16(v1[2], v1[3]);
                    *(u32x4*)(rowp + bj * HALF) = w; } }
    }
};
struct EpiRes2 {
    static constexpr bool PERM = false;
    float* X; const float* gate; float scl;
    __device__ __forceinline__ void operator()(const f32x4 (&acc)[2][2][4][2], const DUnit& u, int wr, int wc, int fr, int fq) const {
        const int row0 = u.pm * BM + wr * 64 + fr, col0 = u.pn * BM + wc * 32 + 4 * fq;
#pragma unroll
        for (int ai = 0; ai < 2; ++ai)
#pragma unroll
            for (int m = 0; m < 4; ++m) { const int r = row0 + ai * HALF + m * 16; float* rowp = X + (size_t)r * 1024 + col0; const float* gp = gate + (size_t)mod_row(r) * 6144 + col0;
#pragma unroll
                for (int bj = 0; bj < 2; ++bj)
#pragma unroll
                    for (int n = 0; n < 2; ++n) { const f32x4 gv = *(const f32x4*)(gp + bj * HALF + n * 16); f32x4 x = *(f32x4*)(rowp + bj * HALF + n * 16); x += (gv * scl) * acc[ai][bj][m][n]; *(f32x4*)(rowp + bj * HALF + n * 16) = x; }
                asm volatile("" ::: "memory"); }
    }
};
struct EpiDelta {
    static constexpr bool PERM = true;
    bf16_t* Dl; const float* gate; float scl;
    __device__ __forceinline__ void operator()(const f32x4 (&acc)[2][2][4][2], const DUnit& u, int wr, int wc, int fr, int fq) const {
        const int row0 = u.pm * BM + wr * 64 + fr, col0 = u.pn * BM + wc * 32 + 8 * fq;
#pragma unroll
        for (int ai = 0; ai < 2; ++ai)
#pragma unroll
            for (int m = 0; m < 4; ++m) { const int r = row0 + ai * HALF + m * 16; bf16_t* rowp = Dl + (size_t)r * 1024 + col0; const float* gp = gate + (size_t)mod_row(r) * 6144 + col0;
#pragma unroll
                for (int bj = 0; bj < 2; ++bj) { const f32x4 g0 = *(const f32x4*)(gp + bj * HALF) * scl, g1 = *(const f32x4*)(gp + bj * HALF + 4) * scl;
                    const f32x4 v0 = acc[ai][bj][m][0] * g0, v1 = acc[ai][bj][m][1] * g1;
                    u32x4 w; w.x = cvt_pk_bf16(v0[0], v0[1]); w.y = cvt_pk_bf16(v0[2], v0[3]); w.z = cvt_pk_bf16(v1[0], v1[1]); w.w = cvt_pk_bf16(v1[2], v1[3]);
                    *(u32x4*)(rowp + bj * HALF) = w; } }
    }
};
struct EpiGU2 {
    static constexpr bool PERM = true;
    bf16_t* H;
    __device__ __forceinline__ void operator()(const f32x4 (&acc)[2][2][4][2], const MUnit& u, int wr, int wc, int fr, int fq) const {
        const int row0 = u.pm * BM + wr * 64 + fr, col0 = u.pn * BM + wc * 32 + 8 * fq;
#pragma unroll
        for (int ai = 0; ai < 2; ++ai)
#pragma unroll
            for (int m = 0; m < 4; ++m) { bf16_t* rowp = H + (size_t)(row0 + ai * HALF + m * 16) * 512 + (col0 >> 1);
#pragma unroll
                for (int bj = 0; bj < 2; ++bj) { const f32x4 v0 = acc[ai][bj][m][0], v1 = acc[ai][bj][m][1];
                    u32x2 w; w.x = cvt_pk_bf16(siluf(v0[0]) * v0[1], siluf(v0[2]) * v0[3]); w.y = cvt_pk_bf16(siluf(v1[0]) * v1[1], siluf(v1[2]) * v1[3]);
                    *(u32x2*)(rowp + bj * (HALF / 2)) = w; } }
    }
};
struct EpiGU8 {
    static constexpr bool PERM = true;
    unsigned char* H;
    __device__ __forceinline__ void operator()(const f32x4 (&acc)[2][2][4][2], const MUnit& u, int wr, int wc, int fr, int fq) const {
        const int row0 = u.pm * BM + wr * 64 + fr, col0 = u.pn * BM + wc * 32 + 8 * fq;
#pragma unroll
        for (int ai = 0; ai < 2; ++ai)
#pragma unroll
            for (int m = 0; m < 4; ++m) { unsigned char* rowp = H + (size_t)(row0 + ai * HALF + m * 16) * 512 + (col0 >> 1);
#pragma unroll
                for (int bj = 0; bj < 2; ++bj) { const f32x4 v0 = acc[ai][bj][m][0], v1 = acc[ai][bj][m][1];
                    *(unsigned*)(rowp + bj * (HALF / 2)) = pk4_fp8(2.0f * siluf(v0[0]) * v0[1], 2.0f * siluf(v0[2]) * v0[3], 2.0f * siluf(v1[0]) * v1[1], 2.0f * siluf(v1[2]) * v1[3]); } }
    }
};
struct EpiDown2 {
    static constexpr bool PERM = true;
    bf16_t* YB; const int* rtok; const float* rgate;
    __device__ __forceinline__ void operator()(const f32x4 (&acc)[2][2][4][2], const MUnit& u, int wr, int wc, int fr, int fq) const {
        const int r0 = wr * 64 + fr, col0 = u.pn * BM + wc * 32 + 8 * fq;
#pragma unroll
        for (int ai = 0; ai < 2; ++ai)
#pragma unroll
            for (int m = 0; m < 4; ++m) { const int rt = r0 + ai * HALF + m * 16;
                if (rt < u.nvalid) { const int ent = rtok[u.idx * 256 + rt]; const float g = rgate[u.idx * 256 + rt]; bf16_t* rowp = YB + (size_t)ent * 1024 + col0;
#pragma unroll
                    for (int bj = 0; bj < 2; ++bj) { const f32x4 v0 = acc[ai][bj][m][0] * g, v1 = acc[ai][bj][m][1] * g;
                        u32x4 w; w.x = cvt_pk_bf16(v0[0], v0[1]); w.y = cvt_pk_bf16(v0[2], v0[3]); w.z = cvt_pk_bf16(v1[0], v1[1]); w.w = cvt_pk_bf16(v1[2], v1[3]);
                        *(u32x4*)(rowp + bj * HALF) = w; } } }
    }
};
struct EpiDown8 {
    static constexpr bool PERM = true;
    unsigned char* YB; const int* rtok; const float* rgate;
    __device__ __forceinline__ void operator()(const f32x4 (&acc)[2][2][4][2], const MUnit& u, int wr, int wc, int fr, int fq) const {
        const int r0 = wr * 64 + fr, col0 = u.pn * BM + wc * 32 + 8 * fq;
#pragma unroll
        for (int ai = 0; ai < 2; ++ai)
#pragma unroll
            for (int m = 0; m < 4; ++m) { const int rt = r0 + ai * HALF + m * 16;
                if (rt < u.nvalid) { const int ent = rtok[u.idx * 256 + rt]; const float g = 64.0f * rgate[u.idx * 256 + rt]; unsigned char* rowp = YB + (size_t)ent * 1024 + col0;
#pragma unroll
                    for (int bj = 0; bj < 2; ++bj) { const f32x4 v0 = acc[ai][bj][m][0] * g, v1 = acc[ai][bj][m][1] * g;
                        u32x2 w; w.x = pk4_fp8(v0[0], v0[1], v0[2], v0[3]); w.y = pk4_fp8(v1[0], v1[1], v1[2], v1[3]);
                        *(u32x2*)(rowp + bj * HALF) = w; } } }
    }
};
}

__device__ __forceinline__ void transpose_item(const float* __restrict__ W, int K, int N, bf16_t* __restrict__ WT, int mode, float* scr, int item, int lane) {
    const int nblk = N / 32, kb = item / nblk, nb = item % nblk, k0 = 64 * kb, n0 = 32 * nb;
    float wv[32];
#pragma unroll
    for (int i = 0; i < 32; ++i) wv[i] = __builtin_nontemporal_load(W + (size_t)(k0 + 2 * i + (lane >> 5)) * N + n0 + (lane & 31));
#pragma unroll
    for (int i = 0; i < 32; ++i) scr[(2 * i + (lane >> 5)) * 33 + (lane & 31)] = wv[i];
    LDS_WAIT();
    const int c = lane & 7;
#pragma unroll
    for (int j = 0; j < 4; ++j) {
        const int n = (lane >> 3) + 8 * j; const float* s = scr + (8 * c) * 33 + n;
        u32x4 o; o.x = pk2(s[0 * 33], s[1 * 33]); o.y = pk2(s[2 * 33], s[3 * 33]); o.z = pk2(s[4 * 33], s[5 * 33]); o.w = pk2(s[6 * 33], s[7 * 33]);
        const int nabs = n0 + n; const int orow = mode ? ((nabs < 512) ? 2 * nabs : 2 * (nabs - 512) + 1) : nabs;
        *(u32x4*)(WT + (size_t)orow * K + k0 + 8 * c) = o;
    }
    LDS_WAIT();
}


__device__ __forceinline__ void transpose_item8(const float* __restrict__ W, int K, int N, unsigned char* __restrict__ WT, int mode, float scale, float* scr, int item, int lane) {
    const int nblk = N / 32, kb = item / nblk, nb = item % nblk, k0 = 64 * kb, n0 = 32 * nb;
    float wv[32];
#pragma unroll
    for (int i = 0; i < 32; ++i) wv[i] = __builtin_nontemporal_load(W + (size_t)(k0 + 2 * i + (lane >> 5)) * N + n0 + (lane & 31));
#pragma unroll
    for (int i = 0; i < 32; ++i) scr[(2 * i + (lane >> 5)) * 33 + (lane & 31)] = wv[i] * scale;
    LDS_WAIT();
    const int c = lane & 7;
#pragma unroll
    for (int j = 0; j < 4; ++j) {
        const int n = (lane >> 3) + 8 * j; const float* s = scr + (8 * c) * 33 + n;
        u32x2 o; o.x = pk4_fp8(s[0 * 33], s[1 * 33], s[2 * 33], s[3 * 33]); o.y = pk4_fp8(s[4 * 33], s[5 * 33], s[6 * 33], s[7 * 33]);
        const int nabs = n0 + n; const int orow = mode ? ((nabs < 512) ? 2 * nabs : 2 * (nabs - 512) + 1) : nabs;
        *(u32x2*)(WT + (size_t)orow * K + k0 + 8 * c) = o;
    }
    LDS_WAIT();
}

__device__ __forceinline__ void convert_experts(const Params& p, int l, float* scr, int widx, int nwv, int it0, int it1) {
    const int tid = otid(), lane = tid & 63;
    bf16_t* wgu_t = (bf16_t*)(ows(p) + WS_WGU) + (size_t)l * 32 * 1024 * 1024; bf16_t* wdn_t = (bf16_t*)(ows(p) + WS_WDN) + (size_t)l * 32 * 1024 * 512;
    const float* wgu = oin(p, 17) + (size_t)l * 32 * 1024 * 1024; const float* wdn = oin(p, 18) + (size_t)l * 32 * 512 * 1024;
    constexpr int I_GU = 16 * 32, I_DN = 8 * 32, T_GU = 32 * I_GU;
    unsigned char* wgu8 = ows(p) + WS_WGU8 + (size_t)l * 32 * 1024 * 1024; unsigned char* wdn8 = ows(p) + WS_WDN8 + (size_t)l * 32 * 1024 * 512;
    for (int it = it0 + widx; it < it1; it += nwv) {
        if (it < T_GU) { const int m = it / I_GU;
            if (MOE_FP8) transpose_item8(wgu + (size_t)m * 1024 * 1024, 1024, 1024, wgu8 + (size_t)m * 1024 * 1024, 1, 32.0f, scr, it % I_GU, lane);
            else transpose_item(wgu + (size_t)m * 1024 * 1024, 1024, 1024, wgu_t + (size_t)m * 1024 * 1024, 1, scr, it % I_GU, lane); }
        else { const int r = it - T_GU, m = r / I_DN;
            if (MOE_FP8) transpose_item8(wdn + (size_t)m * 512 * 1024, 512, 1024, wdn8 + (size_t)m * 1024 * 512, 0, 16.0f, scr, r % I_DN, lane);
            else transpose_item(wdn + (size_t)m * 512 * 1024, 512, 1024, wdn_t + (size_t)m * 1024 * 512, 0, scr, r % I_DN, lane); }
    }
}

__device__ __forceinline__ void convert_range(const Params& p, float* scr, int widx, int nwv, int g0, int g1) {
    for (int l = g0 / CV_ALL; l < DEPTH && l * CV_ALL < g1; ++l) {
        const int a = max(g0, l * CV_ALL) - l * CV_ALL, b = min(g1, (l + 1) * CV_ALL) - l * CV_ALL;
        convert_experts(p, l, scr, widx, nwv, a, b);
    }
}

__device__ __forceinline__ void phase_prologue(const Params& p, unsigned char* lds) {
    const int tid = otid(), lane = tid & 63, wid = tid >> 6;
    float* scr = (float*)(lds + wid * 16384);
    const int gw = obid() * 8 + wid, NGW = gridDim.x * 8;
    bf16_t* win_t = (bf16_t*)(ows(p) + WS_WIN); bf16_t* wout_t = (bf16_t*)(ows(p) + WS_WOUT);
    constexpr int I_IN = 16 * 128, I_OUT = 16 * 32;
    constexpr int T_IN = 4 * I_IN, T_OUT = 4 * I_OUT;
    for (int it = gw; it < T_IN + T_OUT; it += NGW) {
        int r = it;
        if (r < T_IN) { const int m = r / I_IN; transpose_item(oin(p, 7) + (size_t)m * 1024 * 4096, 1024, 4096, win_t + (size_t)m * 4096 * 1024, 0, scr, r % I_IN, lane); continue; } r -= T_IN;
        { const int m = r / I_OUT;
          if (G2_FP8) transpose_item8(oin(p, 12) + (size_t)m * 1024 * 1024, 1024, 1024, (unsigned char*)wout_t + (size_t)m * 1024 * 1024, 0, 32.0f, scr, r % I_OUT, lane);
          else transpose_item(oin(p, 12) + (size_t)m * 1024 * 1024, 1024, 1024, wout_t + (size_t)m * 1024 * 1024, 0, scr, r % I_OUT, lane); }
    }
    {
        bf16_t* wrh = (bf16_t*)(ows(p) + WS_WRH); bf16_t* wrl = (bf16_t*)(ows(p) + WS_WRL);
        for (int i = obid() * 512 + tid; i < 4 * 48 * 1024; i += gridDim.x * 512) {
            const int l = i / (48 * 1024), j = (i / 1024) % 48, k = i % 1024;
            float w = 0.f;
            if (j < 4) w = oin(p, 13)[((size_t)l * 1024 + k) * 4 + j]; else if (j < 36) w = oin(p, 15)[((size_t)l * 1024 + k) * 32 + (j - 4)];
            const unsigned hi = f2bf(w); const float rem = w - __uint_as_float(hi << 16);
            wrh[i] = (bf16_t)hi; wrl[i] = (bf16_t)f2bf(rem);
        }
    }
    __syncthreads();
    float* modp = (float*)(ows(p) + WS_MODP);
    float* sS = (float*)lds;
    for (int u = obid(); u < 4 * 24 * 8; u += gridDim.x) {
        const int l = u / 192, rem = u % 192, nb = rem / 8, ks = rem % 8;
        __syncthreads();
        for (int i = tid; i < 9 * 128; i += 512) { const int r = i >> 7, k = i & 127; const float cv = (r < 8) ? oin(p, 1)[r * 1024 + ks * 128 + k] : oin(p, 3)[ks * 128 + k]; sS[i] = siluf(cv); }
        __syncthreads();
        const int col = nb * 256 + (tid & 255), kh = tid >> 8;
        float acc[9];
#pragma unroll
        for (int r = 0; r < 9; ++r) acc[r] = 0.f;
        const float* w = oin(p, 5) + ((size_t)l * 1024 + ks * 128 + kh * 64) * 6144 + col;
        for (int k = 0; k < 64; ++k) {
            const float wv = w[(size_t)k * 6144];
#pragma unroll
            for (int r = 0; r < 9; ++r) acc[r] += sS[r * 128 + kh * 64 + k] * wv;
        }
#pragma unroll
        for (int r = 0; r < 9; ++r) modp[(((size_t)l * NMODP + ks * 2 + kh) * 9 + r) * 6144 + col] = acc[r];
    }
}

__device__ __forceinline__ void phase_modreduce(const Params& p) {
    const float* modp = (const float*)(ows(p) + WS_MODP); float* modv = (float*)(ows(p) + WS_MOD);
    for (int i = obid() * 512 + otid(); i < 4 * 9 * 6144; i += gridDim.x * 512) {
        const int l = i / (9 * 6144), rem = i % (9 * 6144), n = rem % 6144;
        float s = oin(p, 6)[l * 6144 + n];
        for (int j = 0; j < NMODP; ++j) s += modp[((size_t)l * NMODP + j) * 9 * 6144 + rem];
        modv[i] = s;
    }
}

__device__ __forceinline__ void phase_norm1(const Params& p, int l, float scl) {
    const int lane = otid() & 63, wid = otid() >> 6;
    bf16_t* xws = (bf16_t*)(ows(p) + WS_X); bf16_t* hb = (bf16_t*)(ows(p) + WS_H); const bf16_t* yb = (const bf16_t*)(ows(p) + WS_YB);
    const float* modv = (const float*)(ows(p) + WS_MOD);
    const float* nw = oin(p, 4) + (size_t)(l * 2 + 0) * 1024;
    for (int r = obid() * 8 + wid; r < NTOK; r += gridDim.x * 8) {
        const int mr = mod_row(r);
        f32x4 v[4];
        if (l == 0) { const float* src = r < NLAT ? oin(p, 0) + (size_t)r * 1024 : oin(p, 2) + (size_t)(r - NLAT) * 1024;
#pragma unroll
            for (int j = 0; j < 4; ++j) v[j] = *(const f32x4*)(src + 4 * lane + 256 * j); }
        else {
#pragma unroll
            for (int j = 0; j < 4; ++j) v[j] = unpk4_bf16(*(const u32x2*)(xws + (size_t)r * 1024 + 4 * lane + 256 * j)); }
        if (l > 0) {
            const float* g5 = modv + ((size_t)(l - 1) * 9 + mr) * 6144 + 5 * 1024;
#pragma unroll
            for (int j = 0; j < 4; ++j) {
                const int c = 4 * lane + 256 * j;
                const f32x4 gv = *(const f32x4*)(g5 + c);
                f32x4 f;
                if (MOE_FP8) { const unsigned char* y8 = ows(p) + WS_YB8; f = (unpk4_fp8(*(const unsigned*)(y8 + (size_t)(2 * r) * 1024 + c)) + unpk4_fp8(*(const unsigned*)(y8 + (size_t)(2 * r + 1) * 1024 + c))) * (1.0f / 64.0f); }
                else { const u32x2 y0 = *(const u32x2*)(yb + (size_t)(2 * r) * 1024 + c), y1 = *(const u32x2*)(yb + (size_t)(2 * r + 1) * 1024 + c);
                f[0] = bf2f(y0.x & 0xffff) + bf2f(y1.x & 0xffff); f[1] = bf2f(y0.x >> 16) + bf2f(y1.x >> 16);
                f[2] = bf2f(y0.y & 0xffff) + bf2f(y1.y & 0xffff); f[3] = bf2f(y0.y >> 16) + bf2f(y1.y >> 16); }
                v[j] += (gv * scl) * f;
            }
        }
#pragma unroll
        for (int j = 0; j < 4; ++j) { u32x2 o; o.x = cvtpk(v[j][0], v[j][1]); o.y = cvtpk(v[j][2], v[j][3]); *(u32x2*)(xws + (size_t)r * 1024 + 4 * lane + 256 * j) = o; }
        float ss = 0.f;
#pragma unroll
        for (int j = 0; j < 4; ++j) ss += (v[j][0] * v[j][0] + v[j][1] * v[j][1]) + (v[j][2] * v[j][2] + v[j][3] * v[j][3]);
        const float rstd = rsqrtf(wave_sum(ss) * (1.0f / 1024.0f) + EPS);
        const float* msh = modv + ((size_t)l * 9 + mr) * 6144; const float* msc = msh + 1024;
#pragma unroll
        for (int j = 0; j < 4; ++j) {
            const int c = 4 * lane + 256 * j;
            const f32x4 w = *(const f32x4*)(nw + c), sh = *(const f32x4*)(msh + c), sc = *(const f32x4*)(msc + c);
            const f32x4 h = (v[j] * rstd * w) * (1.0f + sc) + sh;
            u32x2 o; o.x = pk2(h[0], h[1]); o.y = pk2(h[2], h[3]);
            *(u32x2*)(hb + (size_t)r * 1024 + c) = o;
        }
    }
}

__device__ __forceinline__ void phase_final(const Params& p) {
    const int lane = otid() & 63, wid = otid() >> 6;
    const bf16_t* xws = (const bf16_t*)(ows(p) + WS_X); const bf16_t* yb = (const bf16_t*)(ows(p) + WS_YB);
    const float* modv = (const float*)(ows(p) + WS_MOD); const float* nw = oin(p, 19);
    for (int r = obid() * 8 + wid; r < NLAT; r += gridDim.x * 8) {
        const int mr = mod_row(r);
        const float* g5 = modv + ((size_t)3 * 9 + mr) * 6144 + 5 * 1024;
        f32x4 v[4]; float ss = 0.f;
#pragma unroll
        for (int j = 0; j < 4; ++j) {
            const int c = 4 * lane + 256 * j;
            v[j] = unpk4_bf16(*(const u32x2*)(xws + (size_t)r * 1024 + c));
            const f32x4 gv = *(const f32x4*)(g5 + c);
            f32x4 f;
            if (MOE_FP8) { const unsigned char* y8 = ows(p) + WS_YB8; f = (unpk4_fp8(*(const unsigned*)(y8 + (size_t)(2 * r) * 1024 + c)) + unpk4_fp8(*(const unsigned*)(y8 + (size_t)(2 * r + 1) * 1024 + c))) * (1.0f / 64.0f); }
            else { const u32x2 y0 = *(const u32x2*)(yb + (size_t)(2 * r) * 1024 + c), y1 = *(const u32x2*)(yb + (size_t)(2 * r + 1) * 1024 + c);
            f[0] = bf2f(y0.x & 0xffff) + bf2f(y1.x & 0xffff); f[1] = bf2f(y0.x >> 16) + bf2f(y1.x >> 16);
            f[2] = bf2f(y0.y & 0xffff) + bf2f(y1.y & 0xffff); f[3] = bf2f(y0.y >> 16) + bf2f(y1.y >> 16); }
            v[j] += gv * f;
            ss += (v[j][0] * v[j][0] + v[j][1] * v[j][1]) + (v[j][2] * v[j][2] + v[j][3] * v[j][3]);
        }
        const float rstd = rsqrtf(wave_sum(ss) * (1.0f / 1024.0f) + EPS);
#pragma unroll
        for (int j = 0; j < 4; ++j) { const int c = 4 * lane + 256 * j; const f32x4 w = *(const f32x4*)(nw + c); *(f32x4*)(p.out + (size_t)r * 1024 + c) = v[j] * rstd * w; }
    }
}

__device__ __forceinline__ void phase_gemm1(const Params& p, int l, unsigned char* lds) {
    const bf16_t* hb = (const bf16_t*)(ows(p) + WS_H); const bf16_t* wt = (const bf16_t*)(ows(p) + WS_WIN) + (size_t)l * 4096 * 1024; bf16_t* pb = (bf16_t*)(ows(p) + WS_P);
    constexpr int NT = PW / 128, MT = NTOK / 128;
    for (int u = obid(); u < MT * NT; u += gridDim.x) {
        const int mt = u / NT, nt = u % NT;
        ARowPlain ar{hb + (size_t)mt * 128 * 1024, 1024};
        EpiP ep{pb + (size_t)mt * 128 * PW + nt * 128};
        gemm128(lds, ar, wt + (size_t)nt * 128 * 1024, 1024, ep);
    }
}

__device__ __forceinline__ void unpack8(const u32x4 w, float (&f)[8]) {
    f[0] = bf2f(w.x & 0xffff); f[1] = bf2f(w.x >> 16); f[2] = bf2f(w.y & 0xffff); f[3] = bf2f(w.y >> 16);
    f[4] = bf2f(w.z & 0xffff); f[5] = bf2f(w.z >> 16); f[6] = bf2f(w.w & 0xffff); f[7] = bf2f(w.w >> 16);
}
__device__ __forceinline__ void conv_rows(const Params& p, int l, int widx, int nwv) {
    const int lane = otid() & 63;
    const bf16_t* pb = (const bf16_t*)(ows(p) + WS_P); bf16_t* yb = (bf16_t*)(ows(p) + WS_Y);
    const float* cw = oin(p, 8) + (size_t)l * 3 * 512; const float* cnw = oin(p, 9) + (size_t)l * 512;
    const int nrows = (l == DEPTH - 1) ? NLAT : NTOK;
    const int c0 = lane * 8;
    float w0[8], w1[8], w2[8], nwv8[8];
#pragma unroll
    for (int j = 0; j < 8; ++j) { w0[j] = cw[c0 + j]; w1[j] = cw[512 + c0 + j]; w2[j] = cw[1024 + c0 + j]; nwv8[j] = cnw[c0 + j]; }
    constexpr int NB = 4;
    for (int rb = widx; rb < nrows; rb += NB * nwv) {
        u32x4 vb[NB], vc[NB], vh[NB], vcm[NB], vhm[NB], vcp[NB], vhp[NB]; bool hm[NB], hp[NB];
#pragma unroll
        for (int q = 0; q < NB; ++q) {
            int r = rb + q * nwv; if (r >= nrows) r = rb;
            int rm = -1, rp = -1;
            if (r < NLAT) {
                const int t = r & 2047;
                if (c0 < 256) { if ((t & 63) > 0) rm = r - 1; if ((t & 63) < 63) rp = r + 1; }
                else { if (t >= 64) rm = r - 64; if (t < SEQ - 64) rp = r + 64; }
            } else { const int tc = (r - NLAT) & 255; if (tc > 0) rm = r - 1; if (tc < 255) rp = r + 1; }
            hm[q] = rm >= 0; hp[q] = rp >= 0; if (rm < 0) rm = r; if (rp < 0) rp = r;
            vb[q] = *(const u32x4*)(pb + (size_t)r * PW + OFF_B + c0); vc[q] = *(const u32x4*)(pb + (size_t)r * PW + OFF_C + c0); vh[q] = *(const u32x4*)(pb + (size_t)r * PW + OFF_HV + c0);
            vcm[q] = *(const u32x4*)(pb + (size_t)rm * PW + OFF_C + c0); vhm[q] = *(const u32x4*)(pb + (size_t)rm * PW + OFF_HV + c0);
            vcp[q] = *(const u32x4*)(pb + (size_t)rp * PW + OFF_C + c0); vhp[q] = *(const u32x4*)(pb + (size_t)rp * PW + OFF_HV + c0);
        }
#pragma unroll
        for (int q = 0; q < NB; ++q) {
            const int r = rb + q * nwv;
            float bg[8], u0[8], um[8], up[8], t1[8];
            unpack8(vb[q], bg); unpack8(vc[q], u0); unpack8(vh[q], t1);
#pragma unroll
            for (int j = 0; j < 8; ++j) u0[j] *= t1[j];
            unpack8(vcm[q], um); unpack8(vhm[q], t1);
#pragma unroll
            for (int j = 0; j < 8; ++j) um[j] = hm[q] ? um[j] * t1[j] : 0.f;
            unpack8(vcp[q], up); unpack8(vhp[q], t1);
#pragma unroll
            for (int j = 0; j < 8; ++j) up[j] = hp[q] ? up[j] * t1[j] : 0.f;
            float z[8]; float ss = 0.f;
#pragma unroll
            for (int j = 0; j < 8; ++j) { z[j] = bg[j] * (w0[j] * um[j] + w1[j] * u0[j] + w2[j] * up[j]); ss += z[j] * z[j]; }
            const float rstd = rsqrtf(wave_sum(ss) * (1.0f / 512.0f) + EPS);
            if (G2_FP8) {
                const float rs8 = rstd * 8.0f; u32x2 o8;
                o8.x = pk4_fp8(z[0] * rs8 * nwv8[0], z[1] * rs8 * nwv8[1], z[2] * rs8 * nwv8[2], z[3] * rs8 * nwv8[3]); o8.y = pk4_fp8(z[4] * rs8 * nwv8[4], z[5] * rs8 * nwv8[5], z[6] * rs8 * nwv8[6], z[7] * rs8 * nwv8[7]);
                if (r < nrows) *(u32x2*)((unsigned char*)yb + (size_t)r * 1024 + c0) = o8;
            } else {
            u32x4 o;
            o.x = cvtpk(z[0] * rstd * nwv8[0], z[1] * rstd * nwv8[1]); o.y = cvtpk(z[2] * rstd * nwv8[2], z[3] * rstd * nwv8[3]);
            o.z = cvtpk(z[4] * rstd * nwv8[4], z[5] * rstd * nwv8[5]); o.w = cvtpk(z[6] * rstd * nwv8[6], z[7] * rstd * nwv8[7]);
            if (r < nrows) *(u32x4*)(yb + (size_t)r * 1024 + c0) = o; }
        }
    }
}

template <int DIR>
__device__ __forceinline__ void gla_pre_dir(const Params& p, int l, int chunk, float* sQ, float* sK, const float* sV, float* sA, float* sBq, float (&oacc)[16]) {
    const int ch = otid(), tid = otid(), R0 = chunk * 16;
    const bf16_t* pb = (const bf16_t*)(ows(p) + WS_P);
    bf16_t* qin = (bf16_t*)(ows(p) + WS_QIN); bf16_t* kout = (bf16_t*)(ows(p) + WS_KOUT); float* dch = (float*)(ows(p) + WS_DCH);
    float lbv = 0.f;
    {
        const float* lb = oin(p, 10) + (size_t)DIR * 4 * 512 + ch;
        const float z0 = lb[0], z1 = lb[512], z2 = lb[1024], z3 = lb[1536];
        const float mx = fmaxf(fmaxf(z0, z1), fmaxf(z2, z3));
        const float e0 = __expf(z0 - mx), e1 = __expf(z1 - mx), e2 = __expf(z2 - mx), e3 = __expf(z3 - mx);
        const float inv = 1.0f / (e0 + e1 + e2 + e3);
        lbv = ((l >= 1 ? e1 : 0.f) + (l >= 2 ? e2 : 0.f) + (l >= 3 ? e3 : 0.f)) * inv;
    }
    float b = 0.f;
#pragma unroll 1
    for (int i = 0; i < 16; ++i) {
        const int row = R0 + (DIR ? 15 - i : i);
        const float zf = bf2f(pb[(size_t)row * PW + OFF_ZF + DIR * 512 + ch]);
        const float sg = 1.0f / (1.0f + __expf(-zf)), sn = 1.0f / (1.0f + __expf(zf));
        const float f = fmaxf(lbv + (1.0f - lbv) * sg, 1e-30f);
        b += __logf(f);
        sBq[i * 512 + ch] = b; sK[i * 512 + ch] = (1.0f - lbv) * sn;
        sQ[i * 512 + ch] = siluf(bf2f(pb[(size_t)row * PW + OFF_Q + ch]));
    }
    const float blast = b;
#pragma unroll 1
    for (int i = 0; i < 16; ++i) {
        const int row = R0 + (DIR ? 15 - i : i);
        const float bi = sBq[i * 512 + ch], kq = sK[i * 512 + ch], qv = sQ[i * 512 + ch];
        const float qi = qv * __expf(bi), kt = kq * __expf(fminf(-bi, 80.0f)), ko = kq * __expf(blast - bi);
        sQ[i * 512 + ch] = qi; sK[i * 512 + ch] = kt;
        qin[((size_t)DIR * NTOK + row) * 512 + ch] = (bf16_t)f2bf(qi);
        kout[((size_t)DIR * NTOK + row) * 512 + ch] = (bf16_t)f2bf(ko);
    }
    dch[((size_t)DIR * NCHUNK + chunk) * 512 + ch] = __expf(blast);
    __syncthreads();
#pragma unroll 1
    for (int e2 = 0; e2 < 2; ++e2) {
        const int e = tid * 2 + e2, h = e >> 8, t = (e >> 4) & 15, s = e & 15;
        float sum = 0.f;
        const float* qp = sQ + t * 512 + h * 128; const float* kp = sK + s * 512 + h * 128;
#pragma unroll 8
        for (int k = 0; k < 128; ++k) sum += qp[k] * kp[k];
        sA[e] = (s <= t) ? sum : 0.f;
    }
    __syncthreads();
    const int h = ch >> 7;
#pragma unroll
    for (int t = 0; t < 16; ++t) {
        float o = 0.f;
#pragma unroll 1
        for (int s = 0; s <= t; ++s) o += sA[(h * 16 + t) * 16 + s] * sV[(DIR ? 15 - s : s) * 512 + ch];
        oacc[DIR ? 15 - t : t] += o;
    }
    __syncthreads();
}

__device__ __forceinline__ void phase_conv_glapre(const Params& p, int l, unsigned char* lds) {
    conv_rows(p, l, obid() * 8 + (otid() >> 6), (int)gridDim.x * 8);
    float* sQ = (float*)lds; float* sK = sQ + 16 * 512; float* sV = sK + 16 * 512; float* sBq = sV + 16 * 512; float* sA = sBq + 16 * 512;
    const bf16_t* pb = (const bf16_t*)(ows(p) + WS_P); float* ointra = (float*)(ows(p) + WS_OINTRA);
    const int ch = otid();
    for (int chunk = obid(); chunk < NCHUNK; chunk += gridDim.x) {
        const int R0 = chunk * 16;
        float oacc[16];
#pragma unroll
        for (int i = 0; i < 16; ++i) oacc[i] = 0.f;
        __syncthreads();
#pragma unroll
        for (int ro = 0; ro < 16; ++ro) sV[ro * 512 + ch] = bf2f(pb[(size_t)(R0 + ro) * PW + OFF_I + ch]);
        gla_pre_dir<0>(p, l, chunk, sQ, sK, sV, sA, sBq, oacc);
        gla_pre_dir<1>(p, l, chunk, sQ, sK, sV, sA, sBq, oacc);
#pragma unroll
        for (int ro = 0; ro < 16; ++ro) ointra[(size_t)(R0 + ro) * 512 + ch] = oacc[ro];
    }
}

__device__ __forceinline__ void phase_gla_seq(const Params& p, int l, unsigned char* lds) {
    const int tid = otid();
    float* S = (float*)lds;
    float* sQ = S + 128 * 32;
    float* sKo = sQ + 16 * 128;
    float* sV = sKo + 16 * 128;
    float* sD = sV + 16 * 32;
    const bf16_t* pb = (const bf16_t*)(ows(p) + WS_P);
    const bf16_t* qin = (const bf16_t*)(ows(p) + WS_QIN); const bf16_t* kout = (const bf16_t*)(ows(p) + WS_KOUT); const float* dch = (const float*)(ows(p) + WS_DCH);
    float* ointer = (float*)(ows(p) + WS_OINTER);
    for (int u = obid(); u < 256; u += gridDim.x) {
        const int vblk = u & 3, dir = (u >> 2) & 1, chain = u >> 3, b = chain >> 2, h = chain & 3;
        __syncthreads();
        for (int i = tid; i < 128 * 32; i += 512) S[i] = 0.f;
        for (int c = 0; c < 144; ++c) {
            int R0;
            if (c < 16) { const int cm = dir ? 15 - c : c; R0 = NLAT + b * 256 + cm * 16; }
            else { const int cc = c - 16; const int cm = dir ? 127 - cc : cc; R0 = b * 2048 + cm * 16; }
            __syncthreads();
            for (int i = tid; i < 16 * 128; i += 512) {
                const int si = i >> 7, k = i & 127; const int row = R0 + (dir ? 15 - si : si);
                const size_t g = ((size_t)dir * NTOK + row) * 512 + h * 128 + k;
                sQ[i] = bf2f(qin[g]); sKo[i] = bf2f(kout[g]);
            }
            { const int si = tid >> 5, vv = tid & 31; const int row = R0 + (dir ? 15 - si : si); sV[tid] = bf2f(pb[(size_t)row * PW + OFF_I + h * 128 + vblk * 32 + vv]); }
            if (tid < 128) sD[tid] = dch[((size_t)dir * NCHUNK + (R0 >> 4)) * 512 + h * 128 + tid];
            __syncthreads();
            {
                const int si = tid >> 5, vv = tid & 31; const int row = R0 + (dir ? 15 - si : si);
                float o = 0.f;
                for (int k = 0; k < 128; ++k) o += sQ[si * 128 + k] * S[k * 32 + vv];
                ointer[((size_t)dir * NTOK + row) * 512 + h * 128 + vblk * 32 + vv] = o;
            }
            __syncthreads();
            {
                const int k = tid >> 2, v0 = (tid & 3) * 8; const float d = sD[k];
                float kk[16];
#pragma unroll
                for (int i = 0; i < 16; ++i) kk[i] = sKo[i * 128 + k];
#pragma unroll
                for (int j = 0; j < 8; ++j) {
                    float s = d * S[k * 32 + v0 + j];
#pragma unroll
                    for (int i = 0; i < 16; ++i) s += kk[i] * sV[i * 32 + v0 + j];
                    S[k * 32 + v0 + j] = s;
                }
            }
        }
    }
}


__device__ __forceinline__ float bflo(unsigned w) { return __uint_as_float(w << 16); }
__device__ __forceinline__ float bfhi(unsigned w) { return __uint_as_float(w & 0xffff0000u); }

template <int DIR>
__device__ __forceinline__ void gla_pre2_dir(const float (&q0a)[16], const float (&q1a)[16], const unsigned (&rz)[16], float lb0, float lb1, unsigned char* wl, unsigned char* rec,
                                             f32x4 (&oT)[8], int lane, int fr, int fq) {
    float bq0[16], bq1[16], kk0[16], kk1[16]; float b0 = 0.f, b1 = 0.f;
#pragma unroll
    for (int i = 0; i < 16; ++i) {
        const int t = DIR ? 15 - i : i;
        const float z0 = bflo(rz[t]), z1 = bfhi(rz[t]);
        const float sg0 = frcp(1.0f + __expf(-z0)), sg1 = frcp(1.0f + __expf(-z1));
        const float f0 = fmaxf(lb0 + (1.0f - lb0) * sg0, 1e-30f), f1 = fmaxf(lb1 + (1.0f - lb1) * sg1, 1e-30f);
        b0 += __logf(f0); b1 += __logf(f1); bq0[t] = b0; bq1[t] = b1; kk0[t] = 1.0f - f0; kk1[t] = 1.0f - f1;
    }
    const float bl0 = b0, bl1 = b1;
    unsigned kw0[8], kw1[8];
#pragma unroll
    for (int i = 0; i < 8; ++i) { kw0[i] = 0u; kw1[i] = 0u; }
#pragma unroll
    for (int t = 0; t < 16; ++t) {
        const float e0 = __expf(bq0[t]), e1 = __expf(bq1[t]);
        const float qi0 = q0a[t] * e0, qi1 = q1a[t] * e1;
        const float kt0 = kk0[t] * frcp(fmaxf(e0, 1.8e-35f)), kt1 = kk1[t] * frcp(fmaxf(e1, 1.8e-35f));
        const float ko0 = kk0[t] * __expf(bl0 - bq0[t]), ko1 = kk1[t] * __expf(bl1 - bq1[t]);
        *(unsigned*)(wl + t * 272 + lane * 4) = cvtpk(qi0, qi1);
        *(unsigned*)(wl + 4352 + t * 272 + lane * 4) = cvtpk(kt0, kt1);
        const unsigned kp = cvtpk(ko0, ko1);
        kw0[t >> 1] |= (kp & 0xffffu) << (16 * (t & 1)); kw1[t >> 1] |= (kp >> 16) << (16 * (t & 1));
    }
    {
        const int c0 = 2 * lane, c1 = c0 + 1;
        unsigned char* k0p = rec + 4096 + (c0 >> 4) * 512 + (c0 & 15) * 8; unsigned char* k1p = rec + 4096 + (c1 >> 4) * 512 + (c1 & 15) * 8;
#pragma unroll
        for (int g = 0; g < 4; ++g) { *(u32x2*)(k0p + g * 128) = (u32x2){kw0[2 * g], kw0[2 * g + 1]}; *(u32x2*)(k1p + g * 128) = (u32x2){kw1[2 * g], kw1[2 * g + 1]}; }
        float* dp = (float*)(rec + 8192) + c0; dp[0] = __expf(bl0); dp[1] = __expf(bl1);
    }
    LDS_WAIT();
#pragma unroll
    for (int s = 0; s < 4; ++s) {
        const u32x2 lo = *(const u32x2*)(wl + fr * 272 + (32 * s + 4 * fq) * 2), hi = *(const u32x2*)(wl + fr * 272 + (32 * s + 16 + 4 * fq) * 2);
        *(u32x4*)(rec + s * 1024 + lane * 16) = (u32x4){lo.x, lo.y, hi.x, hi.y};
    }
    f32x4 at = (f32x4){0.f, 0.f, 0.f, 0.f};
#pragma unroll
    for (int s = 0; s < 4; ++s) {
        const bf16x8 kf = *(const bf16x8*)(wl + 4352 + fr * 272 + (32 * s + 8 * fq) * 2);
        const bf16x8 qf = *(const bf16x8*)(wl + fr * 272 + (32 * s + 8 * fq) * 2);
        at = __builtin_amdgcn_mfma_f32_16x16x32_bf16(kf, qf, at, 0, 0, 0);
    }
#pragma unroll
    for (int r = 0; r < 4; ++r) { const int sp = 4 * fq + r; const bool keep = DIR ? (sp >= fr) : (sp <= fr); at[r] = keep ? at[r] : 0.f; }
    union { u32x2 u; s16x4 h; } bop; bop.u = (u32x2){cvtpk(at[0], at[1]), cvtpk(at[2], at[3])};
#pragma unroll
    for (int vb = 0; vb < 8; ++vb) {
        union { u32x2 u; s16x4 h; } aop; aop.u = *(const u32x2*)(wl + 8704 + (vb * 16 + fr) * 32 + 8 * fq);
        oT[vb] = __builtin_amdgcn_mfma_f32_16x16x16bf16_1k(aop.h, bop.h, oT[vb], 0, 0, 0);
    }
    LDS_WAIT();
}

__device__ __forceinline__ void phase_gla_pre2(const Params& p, int l, unsigned char* lds) {
    const int tid = otid(), lane = tid & 63, wid = __builtin_amdgcn_readfirstlane(tid >> 6), fr = lane & 15, fq = lane >> 4;
    unsigned char* wl = lds + wid * 12800;
    unsigned char* ws = ows(p);
    const bf16_t* pb = (const bf16_t*)(ws + WS_P); bf16_t* ointra = (bf16_t*)(ws + WS_OINTRA);
    float lb[2][2];
    {
        const float* hl = oin(p, 10);
#pragma unroll
        for (int d = 0; d < 2; ++d)
#pragma unroll
            for (int e = 0; e < 2; ++e) {
                const float* q = hl + (size_t)d * 4 * 512 + (2 * lane + e);
                lb[d][e] = 0.f; (void)q;
            }
    }
    for (int unit = wid * (int)gridDim.x + obid(); unit < NCHUNK * 4; unit += gridDim.x * 8) {
        const int chunk = unit >> 2, h = unit & 3, R0 = chunk * 16;
        {
            const float* hl = oin(p, 10);
#pragma unroll
            for (int d = 0; d < 2; ++d)
#pragma unroll
                for (int e = 0; e < 2; ++e) {
                    const float* q = hl + (size_t)d * 4 * 512 + h * 128 + 2 * lane + e;
                    const float z0 = q[0], z1 = q[512], z2 = q[1024], z3 = q[1536];
                    const float mx = fmaxf(fmaxf(z0, z1), fmaxf(z2, z3));
                    const float e0 = __expf(z0 - mx), e1 = __expf(z1 - mx), e2 = __expf(z2 - mx), e3 = __expf(z3 - mx);
                    lb[d][e] = ((l >= 1 ? e1 : 0.f) + (l >= 2 ? e2 : 0.f) + (l >= 3 ? e3 : 0.f)) / (e0 + e1 + e2 + e3);
                }
        }
        unsigned rq[16], rf[16], rb[16], rv[16];
#pragma unroll
        for (int t = 0; t < 16; ++t) {
            const bf16_t* base = pb + (size_t)(R0 + t) * PW + h * 128 + 2 * lane;
            rq[t] = *(const unsigned*)(base + OFF_Q); rf[t] = *(const unsigned*)(base + OFF_ZF); rb[t] = *(const unsigned*)(base + OFF_ZF + 512); rv[t] = *(const unsigned*)(base + OFF_I);
        }
        unsigned char* vrec = ws + WS_VREC + (size_t)(chunk * 4 + h) * VREC_BYTES;
        {
            unsigned w0[8], w1[8];
#pragma unroll
            for (int i = 0; i < 8; ++i) { w0[i] = (rv[2 * i] & 0xffffu) | (rv[2 * i + 1] << 16); w1[i] = (rv[2 * i] >> 16) | (rv[2 * i + 1] & 0xffff0000u); }
            const int c0 = 2 * lane, c1 = c0 + 1;
            unsigned char* v0p = vrec + (c0 >> 4) * 512 + (c0 & 15) * 8; unsigned char* v1p = vrec + (c1 >> 4) * 512 + (c1 & 15) * 8;
#pragma unroll
            for (int g = 0; g < 4; ++g) { *(u32x2*)(v0p + g * 128) = (u32x2){w0[2 * g], w0[2 * g + 1]}; *(u32x2*)(v1p + g * 128) = (u32x2){w1[2 * g], w1[2 * g + 1]}; }
            unsigned char* vl = wl + 8704 + c0 * 32;
            *(u32x4*)(vl) = (u32x4){w0[0], w0[1], w0[2], w0[3]}; *(u32x4*)(vl + 16) = (u32x4){w0[4], w0[5], w0[6], w0[7]};
            *(u32x4*)(vl + 32) = (u32x4){w1[0], w1[1], w1[2], w1[3]}; *(u32x4*)(vl + 48) = (u32x4){w1[4], w1[5], w1[6], w1[7]};
        }
        f32x4 oT[8];
#pragma unroll
        for (int vb = 0; vb < 8; ++vb) oT[vb] = (f32x4){0.f, 0.f, 0.f, 0.f};
        float q0a[16], q1a[16];
#pragma unroll
        for (int t = 0; t < 16; ++t) { q0a[t] = siluf(bflo(rq[t])); q1a[t] = siluf(bfhi(rq[t])); }
        gla_pre2_dir<0>(q0a, q1a, rf, lb[0][0], lb[0][1], wl, ws + WS_GREC + ((size_t)(0 * NCHUNK + chunk) * 4 + h) * REC_BYTES, oT, lane, fr, fq);
        gla_pre2_dir<1>(q0a, q1a, rb, lb[1][0], lb[1][1], wl, ws + WS_GREC + ((size_t)(1 * NCHUNK + chunk) * 4 + h) * REC_BYTES, oT, lane, fr, fq);
#pragma unroll
        for (int vb = 0; vb < 8; ++vb) *(u32x2*)(ointra + (size_t)(R0 + fr) * 512 + h * 128 + vb * 16 + 4 * fq) = (u32x2){cvtpk(oT[vb][0], oT[vb][1]), cvtpk(oT[vb][2], oT[vb][3])};
    }
}

constexpr int GR = 8, STG_BYTES = REC_BYTES + VREC_BYTES;
__device__ __forceinline__ int gla_chunk_of_step(int c, int b, int dir) {
    if (c < 16) { const int cm = dir ? 15 - c : c; return (NLAT + b * 256) / 16 + cm; }
    const int cc = c - 16; const int cm = dir ? 127 - cc : cc; return b * 128 + cm;
}
constexpr int SG_STEP = REC_BYTES + 2048, SG_GRP = 2 * SG_STEP, SG_NG = 6;
constexpr int SG_DUMP = SG_NG * SG_GRP;
constexpr int SG_FLAGS = LDS_MISC + 2048;
constexpr unsigned SG_SPIN = 1u << 22;
static_assert(SG_DUMP + 1024 <= LDS_MISC, "scan ring");
__device__ __forceinline__ void gla_scan_unit(const Params& p, int l, unsigned char* lds_, int chain, int vhalf) {
    LAS unsigned char* lds = (LAS unsigned char*)lds_;
    const int tid = otid(), lane = tid & 63, wid = __builtin_amdgcn_readfirstlane(tid >> 6), fr = lane & 15, fq = lane >> 4;
    unsigned char* ws = ows(p);
    const int b = chain >> 3, h = (chain >> 1) & 3, dir = chain & 1;
    volatile LAS unsigned* flg = (volatile LAS unsigned*)(lds + SG_FLAGS);
    __syncthreads();
    if (tid < 32) flg[tid] = 0u;
    __syncthreads();
    if (wid >= 4) {
        const int m = wid & 3;
        const unsigned char* grec = ws + WS_GREC + (size_t)dir * NCHUNK * 4 * REC_BYTES + (size_t)h * REC_BYTES + lane * 16;
        const unsigned char* vrec = ws + WS_VREC + (size_t)h * VREC_BYTES + vhalf * 2048 + lane * 16;
        const volatile LAS unsigned* dn = flg + 4 + (lane & 3);
#define GSEQ_ISSUE(gi) do { const int _g = (gi); _Pragma("unroll") for (int _j = 0; _j < 6; ++_j) { const int _p = m + 4 * _j; const bool _real = _p < 22; const int _s = _real ? _p / 11 : 0, _q = _real ? _p % 11 : 0; \
        const int _c = 2 * _g + _s; const int _cc = _c < 144 ? _c : 143; const int _ch = gla_chunk_of_step(_cc, b, dir); \
        const unsigned char* _src = (_q < 9) ? grec + (size_t)_ch * 4 * REC_BYTES + _q * 1024 : vrec + (size_t)_ch * 4 * VREC_BYTES + (_q - 9) * 1024; \
        const unsigned _dst = _real ? (unsigned)(_g % SG_NG) * SG_GRP + _s * SG_STEP + _q * 1024 : (unsigned)SG_DUMP; \
        __builtin_amdgcn_global_load_lds((const unsigned*)_src, (LAS unsigned*)(lds + _dst), 16, 0, 0); } } while (0)
#pragma unroll 1
        for (int g = 0; g < SG_NG - 1; ++g) GSEQ_ISSUE(g);
#pragma unroll 1
        for (int g = 0; g < 72; ++g) {
            asm volatile("s_waitcnt vmcnt(%0)" :: "n"((SG_NG - 2) * 6) : "memory");
            if (lane == 0) flg[m] = (unsigned)(g + 1);
            { unsigned sp = 0; while (__builtin_amdgcn_ballot_w64(*dn < (unsigned)g) != 0ull && ++sp < SG_SPIN) __builtin_amdgcn_s_sleep(1); asm volatile("" ::: "memory"); }
            GSEQ_ISSUE(g + SG_NG - 1);
        }
#undef GSEQ_ISSUE
    } else {
        const int vt = wid;
        bf16_t* ointer = (bf16_t*)(ws + WS_OINTER) + (size_t)dir * NTOK * 512 + h * 128 + (vhalf * 4 + vt) * 16 + fr;
        const volatile LAS unsigned* fl = flg + (lane & 3);
        f32x4 acc[8];
#pragma unroll
        for (int j = 0; j < 8; ++j) acc[j] = (f32x4){0.f, 0.f, 0.f, 0.f};
        union { u32x4 u; bf16x8 h; } sb[4];
#pragma unroll
        for (int j = 0; j < 4; ++j) sb[j].u = (u32x4){0u, 0u, 0u, 0u};
#pragma unroll 1
        for (int g = 0; g < 72; ++g) {
            { unsigned sp = 0; while (__builtin_amdgcn_ballot_w64(*fl < (unsigned)(g + 1)) != 0ull && ++sp < SG_SPIN) { } asm volatile("" ::: "memory"); }
#pragma unroll
            for (int s2 = 0; s2 < 2; ++s2) {
                const int c = 2 * g + s2;
                const LAS unsigned char* st = lds + (unsigned)(g % SG_NG) * SG_GRP + s2 * SG_STEP;
                const int chunk = gla_chunk_of_step(c, b, dir);
                bf16x8 qa[4]; f32x4 dv[8];
                union { u32x2 u; s16x4 h; } ka[8], vb;
#pragma unroll
                for (int j = 0; j < 4; ++j) qa[j] = *(const LAS bf16x8*)(st + j * 1024 + lane * 16);
                vb.u = *(const LAS u32x2*)(st + REC_BYTES + vt * 512 + lane * 8);
#pragma unroll
                for (int j = 0; j < 8; ++j) { ka[j].u = *(const LAS u32x2*)(st + 4096 + j * 512 + lane * 8); dv[j] = *(const LAS f32x4*)(st + 8192 + (j * 16 + 4 * fq) * 4); }
                f32x4 o0 = (f32x4){0.f, 0.f, 0.f, 0.f}, o1 = (f32x4){0.f, 0.f, 0.f, 0.f};
                o0 = __builtin_amdgcn_mfma_f32_16x16x32_bf16(qa[0], sb[0].h, o0, 0, 0, 0); o1 = __builtin_amdgcn_mfma_f32_16x16x32_bf16(qa[1], sb[1].h, o1, 0, 0, 0);
                o0 = __builtin_amdgcn_mfma_f32_16x16x32_bf16(qa[2], sb[2].h, o0, 0, 0, 0); o1 = __builtin_amdgcn_mfma_f32_16x16x32_bf16(qa[3], sb[3].h, o1, 0, 0, 0);
#pragma unroll
                for (int j = 0; j < 8; ++j) {
                    acc[j] = acc[j] * dv[j];
                    acc[j] = __builtin_amdgcn_mfma_f32_16x16x16bf16_1k(ka[j].h, vb.h, acc[j], 0, 0, 0);
                }
                const f32x4 os = o0 + o1;
                bf16_t* op = ointer + (size_t)(chunk * 16 + 4 * fq) * 512;
                { const unsigned w01 = cvtpk(os[0], os[1]), w23 = cvtpk(os[2], os[3]); op[0] = (bf16_t)(w01 & 0xffffu); op[512] = (bf16_t)(w01 >> 16); op[1024] = (bf16_t)(w23 & 0xffffu); op[1536] = (bf16_t)(w23 >> 16); }
#pragma unroll
                for (int j = 0; j < 4; ++j) sb[j].u = (u32x4){cvtpk(acc[2 * j][0], acc[2 * j][1]), cvtpk(acc[2 * j][2], acc[2 * j][3]), cvtpk(acc[2 * j + 1][0], acc[2 * j + 1][1]), cvtpk(acc[2 * j + 1][2], acc[2 * j + 1][3])};
            }
            asm volatile("s_waitcnt lgkmcnt(0)" ::: "memory");
            if (lane == 0) flg[4 + wid] = (unsigned)(g + 1);
        }
    }
    asm volatile("s_waitcnt vmcnt(0) lgkmcnt(0)" ::: "memory");
    __syncthreads();
}
__device__ __forceinline__ void phase_gla_seq2(const Params& p, int l, unsigned char* lds) {
    const int G = (int)gridDim.x, bid = obid();
    const int nscan = (G >= 256) ? 128 : G;
    for (int rep = 0; rep < ((DUPK == 50) ? 2 : 1); ++rep) {
        for (int r2 = 0; r2 < ((DUPK == 51) ? 2 : 1); ++r2)
        if (bid < nscan) for (int u = bid; u < 128; u += nscan) { const int x = u & 7, jj = u >> 3; gla_scan_unit(p, l, lds, x + 8 * (jj >> 1), jj & 1); }
        const int cg0 = (G == 256) ? l * CV_LAYER + CV_B : l * CV_ALL, cg1 = (G == 256) ? l * CV_LAYER + CV_B + CV_S : (l + 1) * CV_ALL;
        for (int r3 = 0; r3 < ((DUPK == 52) ? 2 : 1); ++r3)
        if (G > nscan) { if (bid >= nscan) { const int widx = (bid - nscan) * 8 + (otid() >> 6), nwv = (G - nscan) * 8; conv_rows(p, l, widx, nwv); convert_range(p, (float*)(lds + (otid() >> 6) * 16384), widx, nwv, cg0, cg1); } }
        else { const int widx = bid * 8 + (otid() >> 6), nwv = G * 8; __syncthreads(); conv_rows(p, l, widx, nwv); convert_range(p, (float*)(lds + (otid() >> 6) * 16384), widx, nwv, cg0, cg1); }
    }
}

__device__ __forceinline__ void phase_gla_post(const Params& p, int l) {
    const int lane = otid() & 63, wid = otid() >> 6;
    const bf16_t* pb = (const bf16_t*)(ows(p) + WS_P); bf16_t* yb = (bf16_t*)(ows(p) + WS_Y);
    const bf16_t* oi = (const bf16_t*)(ows(p) + WS_OINTRA); const bf16_t* oe = (const bf16_t*)(ows(p) + WS_OINTER);
    const float* hnw = oin(p, 11) + (size_t)l * 128;
    const int nrows = (l == DEPTH - 1) ? NLAT : NTOK;
    const int c0 = lane * 8;
    for (int r = obid() * 8 + wid; r < nrows; r += gridDim.x * 8) {
        float o[8], t1[8], t2[8]; float ss = 0.f;
        unpack8(*(const u32x4*)(oi + (size_t)r * 512 + c0), o); unpack8(*(const u32x4*)(oe + (size_t)r * 512 + c0), t1); unpack8(*(const u32x4*)(oe + ((size_t)NTOK + r) * 512 + c0), t2);
#pragma unroll
        for (int j = 0; j < 8; ++j) { o[j] += t1[j] + t2[j]; ss += o[j] * o[j]; }
        ss += __shfl_xor(ss, 1); ss += __shfl_xor(ss, 2); ss += __shfl_xor(ss, 4); ss += __shfl_xor(ss, 8);
        const float rstd = rsqrtf(ss * (1.0f / 128.0f) + EPS);
        float g[8]; unpack8(*(const u32x4*)(pb + (size_t)r * PW + OFF_G + c0), g);
        float y[8];
#pragma unroll
        for (int j = 0; j < 8; ++j) y[j] = o[j] * rstd * hnw[(c0 + j) & 127] * siluf(g[j]);
        if (G2_FP8) { u32x2 w8; w8.x = pk4_fp8(8.0f * y[0], 8.0f * y[1], 8.0f * y[2], 8.0f * y[3]); w8.y = pk4_fp8(8.0f * y[4], 8.0f * y[5], 8.0f * y[6], 8.0f * y[7]); *(u32x2*)((unsigned char*)yb + (size_t)r * 1024 + 512 + c0) = w8; }
        else { u32x4 w; w.x = pk2(y[0], y[1]); w.y = pk2(y[2], y[3]); w.z = pk2(y[4], y[5]); w.w = pk2(y[6], y[7]);
        *(u32x4*)(yb + (size_t)r * 1024 + 512 + c0) = w; }
    }
}

__device__ __forceinline__ void phase_gemm2(const Params& p, int l, unsigned char* lds) {
    const bf16_t* yb = (const bf16_t*)(ows(p) + WS_Y); const bf16_t* wt = (const bf16_t*)(ows(p) + WS_WOUT) + (size_t)l * 1024 * 1024;
    float* xws = (float*)(ows(p) + WS_X); const float* modv = (const float*)(ows(p) + WS_MOD);
    const int MT = ((l == DEPTH - 1) ? NLAT : NTOK) / 128; constexpr int NT = 8;
    for (int u = obid(); u < MT * NT; u += gridDim.x) {
        const int mt = u / NT, nt = u % NT;
        ARowPlain ar{yb + (size_t)mt * 128 * 1024, 1024};
        EpiRes ep{xws + (size_t)mt * 128 * 1024 + nt * 128, modv + (size_t)l * 9 * 6144 + 2 * 1024 + nt * 128, mt * 128};
        gemm128(lds, ar, wt + (size_t)nt * 128 * 1024, 1024, ep);
    }
}

__device__ __forceinline__ void phase_router(const Params& p, int l) {
    const int lane = otid() & 63, wid = otid() >> 6;
    const float* xws = (const float*)(ows(p) + WS_X); bf16_t* hb = (bf16_t*)(ows(p) + WS_H);
    const float* modv = (const float*)(ows(p) + WS_MOD); const float* nw = oin(p, 4) + (size_t)(l * 2 + 1) * 1024;
    const float* wrg = oin(p, 13) + (size_t)l * 1024 * 4; const float* wre = oin(p, 15) + (size_t)l * 1024 * 32;
    const float* brg = oin(p, 14) + l * 4; const float* bre = oin(p, 16) + l * 32;
    unsigned* cnt = (unsigned*)(ows(p) + WS_CTL) + CW_CNT + 64 * l;
    int* ltok = (int*)(ows(p) + WS_LTOK); float* lgate = (float*)(ows(p) + WS_LGATE);
    const int nrows = (l == DEPTH - 1) ? NLAT : NTOK;
    for (int r = obid() * 8 + wid; r < nrows; r += gridDim.x * 8) {
        const int mr = mod_row(r);
        float ss = 0.f;
#pragma unroll
        for (int j = 0; j < 4; ++j) { const f32x4 xv4 = *(const f32x4*)(xws + (size_t)r * 1024 + 4 * lane + 256 * j); ss += (xv4[0] * xv4[0] + xv4[1] * xv4[1]) + (xv4[2] * xv4[2] + xv4[3] * xv4[3]); }
        const float rstd = rsqrtf(wave_sum(ss) * (1.0f / 1024.0f) + EPS);
        const float* msh = modv + ((size_t)l * 9 + mr) * 6144 + 3 * 1024; const float* msc = msh + 1024;
        float lg[36];
#pragma unroll
        for (int i = 0; i < 36; ++i) lg[i] = 0.f;
#pragma unroll 1
        for (int j = 0; j < 4; ++j) {
            const int c = 4 * lane + 256 * j;
            const f32x4 xv4 = *(const f32x4*)(xws + (size_t)r * 1024 + c);
            const f32x4 w = *(const f32x4*)(nw + c), sh = *(const f32x4*)(msh + c), sc = *(const f32x4*)(msc + c);
            const f32x4 h = (xv4 * rstd * w) * (1.0f + sc) + sh;
            u32x2 o; o.x = pk2(h[0], h[1]); o.y = pk2(h[2], h[3]);
            *(u32x2*)(hb + (size_t)r * 1024 + c) = o;
#pragma unroll
            for (int e = 0; e < 4; ++e) {
                const float xv = h[e];
                const f32x4 wg = *(const f32x4*)(wrg + (size_t)(c + e) * 4);
                lg[0] += xv * wg[0]; lg[1] += xv * wg[1]; lg[2] += xv * wg[2]; lg[3] += xv * wg[3];
#pragma unroll
                for (int q = 0; q < 8; ++q) {
                    const f32x4 we = *(const f32x4*)(wre + (size_t)(c + e) * 32 + q * 4);
                    lg[4 + q * 4 + 0] += xv * we[0]; lg[4 + q * 4 + 1] += xv * we[1]; lg[4 + q * 4 + 2] += xv * we[2]; lg[4 + q * 4 + 3] += xv * we[3];
                }
            }
        }
#pragma unroll
        for (int i = 0; i < 36; ++i) lg[i] = wave_sum(lg[i]);
        float gl[4];
#pragma unroll
        for (int i = 0; i < 4; ++i) gl[i] = lg[i] + brg[i];
        int gsel = 0; float gmax = gl[0];
#pragma unroll
        for (int i = 1; i < 4; ++i) if (gl[i] > gmax) { gmax = gl[i]; gsel = i; }
        float gs = 0.f;
#pragma unroll
        for (int i = 0; i < 4; ++i) gs += __expf(gl[i] - gmax);
        const float pg = 1.0f / gs;
        float el[8];
#pragma unroll
        for (int j = 0; j < 8; ++j) {
            float t = lg[4 + j] + bre[j];
#pragma unroll
            for (int g = 1; g < 4; ++g) t = (gsel == g) ? (lg[4 + g * 8 + j] + bre[g * 8 + j]) : t;
            el[j] = t;
        }
        int i1 = 0; float v1 = el[0];
#pragma unroll
        for (int j = 1; j < 8; ++j) if (el[j] > v1) { v1 = el[j]; i1 = j; }
        int i2 = -1; float v2 = -3.0e38f;
#pragma unroll
        for (int j = 0; j < 8; ++j) if (j != i1 && el[j] > v2) { v2 = el[j]; i2 = j; }
        const float e2 = __expf(v2 - v1);
        const float g0 = pg / (1.0f + e2), g1 = pg * e2 / (1.0f + e2);
        if (lane == 0) {
            const int ea = gsel * 8 + i1, eb = gsel * 8 + i2;
            const unsigned pa = atomicAdd(cnt + ea, 1u); ltok[(size_t)ea * NTOK + pa] = r * 2 + 0; lgate[(size_t)ea * NTOK + pa] = g0;
            const unsigned pb2 = atomicAdd(cnt + eb, 1u); ltok[(size_t)eb * NTOK + pb2] = r * 2 + 1; lgate[(size_t)eb * NTOK + pb2] = g1;
        }
    }
}


__device__ __forceinline__ void phase_router2(const Params& p, int l, unsigned char* lds, bool commit) {
    const int tid = otid(), lane = tid & 63, wid = __builtin_amdgcn_readfirstlane(tid >> 6), fr = lane & 15, fq = lane >> 4;
    unsigned char* ws = ows(p);
    const bf16_t* xws = (const bf16_t*)(ws + WS_X); bf16_t* xw = (bf16_t*)(ws + WS_X); const bf16_t* dlt = (const bf16_t*)(ws + WS_DELTA); bf16_t* hb = (bf16_t*)(ws + WS_H);
    const float* modv = (const float*)(ws + WS_MOD); const float* nw = oin(p, 4) + (size_t)(l * 2 + 1) * 1024;
    const float* brg = oin(p, 14) + l * 4; const float* bre = oin(p, 16) + l * 32;
    unsigned* gcnt = (unsigned*)(ws + WS_CTL) + CW_CNT + 64 * 32 * l;
    int* ltok = (int*)(ws + WS_LTOK); float* lgate = (float*)(ws + WS_LGATE);
    constexpr int WPITCH = 2064, WBYTES = 48 * WPITCH;
    unsigned char* wl = lds;
    float* tile = (float*)(lds + WBYTES + wid * 3328);
    int* s_cnt = (int*)(lds + WBYTES + 8 * 3328); int* s_base = s_cnt + 32;
    int* s_e = s_base + 32; int* s_rank = s_e + 256; int* s_tok = s_rank + 256; float* s_gate = (float*)(s_tok + 256);
    __syncthreads();
    {
        const bf16_t* wrh = (const bf16_t*)(ws + WS_WRH) + (size_t)l * 48 * 1024;
        for (int i = tid; i < 48 * 128; i += 512) { const int r = i >> 7, c = i & 127; *(u32x4*)(wl + r * WPITCH + c * 16) = *(const u32x4*)(wrh + (size_t)r * 1024 + c * 8); }
    }
    const int NG = ((l == DEPTH - 1) ? NLAT : NTOK) / 16;
    const int NWV = (int)gridDim.x * 8;
    for (int it = 0; it * NWV < NG; ++it) {
        const int g = it * NWV + wid * (int)gridDim.x + obid();
        __syncthreads();
        if (tid < 32) s_cnt[tid] = 0;
        if (tid < 256) s_e[tid] = -1;
        __syncthreads();
        if (g < NG) {
            const int R0 = g * 16, mr = mod_row(R0);
            float my_rstd = 0.f;
#pragma unroll
            for (int rb = 0; rb < 4; ++rb) {
                f32x4 xv[4][4]; u32x2 dl[4][4], xr[4][4];
#pragma unroll
                for (int rr = 0; rr < 4; ++rr)
#pragma unroll
                    for (int j = 0; j < 4; ++j) { xr[rr][j] = *(const u32x2*)(xws + (size_t)(R0 + rb * 4 + rr) * 1024 + 4 * lane + 256 * j); dl[rr][j] = *(const u32x2*)(dlt + (size_t)(R0 + rb * 4 + rr) * 1024 + 4 * lane + 256 * j); }
#pragma unroll
                for (int rr = 0; rr < 4; ++rr) {
#pragma unroll
                    for (int j = 0; j < 4; ++j) xv[rr][j] = unpk4_bf16(xr[rr][j]);
                    if (commit) {
#pragma unroll
                        for (int j = 0; j < 4; ++j) { xv[rr][j] += unpk4_bf16(dl[rr][j]); u32x2 o; o.x = cvtpk(xv[rr][j][0], xv[rr][j][1]); o.y = cvtpk(xv[rr][j][2], xv[rr][j][3]); *(u32x2*)(xw + (size_t)(R0 + rb * 4 + rr) * 1024 + 4 * lane + 256 * j) = o;
                            xv[rr][j] = unpk4_bf16(o); }
                    }
                    float ss = 0.f;
#pragma unroll
                    for (int j = 0; j < 4; ++j) ss += (xv[rr][j][0] * xv[rr][j][0] + xv[rr][j][1] * xv[rr][j][1]) + (xv[rr][j][2] * xv[rr][j][2] + xv[rr][j][3] * xv[rr][j][3]);
                    const float rs = rsqrtf(wave_sum(ss) * (1.0f / 1024.0f) + EPS);
                    my_rstd = (rb * 4 + rr == fr) ? rs : my_rstd;
                }
            }
            asm volatile("s_waitcnt vmcnt(0)" ::: "memory");
            const float* msh = modv + ((size_t)l * 9 + mr) * 6144 + 3 * 1024 + 8 * fq; const float* msc = msh + 1024; const float* nwp = nw + 8 * fq;
            const bf16_t* xrow = xws + (size_t)(R0 + fr) * 1024 + 8 * fq; bf16_t* hrow = hb + (size_t)(R0 + fr) * 1024 + 8 * fq; unsigned char* h8row = ws + WS_H8 + (size_t)(R0 + fr) * 1024 + 8 * fq;
            f32x4 acc[3];
#pragma unroll
            for (int nt = 0; nt < 3; ++nt) acc[nt] = (f32x4){0.f, 0.f, 0.f, 0.f};
#pragma unroll 1
            for (int kq = 0; kq < 4; ++kq) {
                u32x4 xab[8];
#pragma unroll
                for (int u = 0; u < 8; ++u) xab[u] = *(const u32x4*)(xrow + 256 * kq + 32 * u);
#pragma unroll
                for (int u = 0; u < 8; ++u) {
                    const int k = 256 * kq + 32 * u;
                    float hv[8];
                    const f32x4 xaq[2] = {unpk4_bf16((u32x2){xab[u].x, xab[u].y}), unpk4_bf16((u32x2){xab[u].z, xab[u].w})};
#pragma unroll
                    for (int q = 0; q < 2; ++q) {
                        const f32x4 w = *(const f32x4*)(nwp + k + 4 * q), sh = *(const f32x4*)(msh + k + 4 * q), sc = *(const f32x4*)(msc + k + 4 * q);
                        const f32x4 h = (xaq[q] * my_rstd * w) * (1.0f + sc) + sh;
                        hv[4 * q + 0] = h[0]; hv[4 * q + 1] = h[1]; hv[4 * q + 2] = h[2]; hv[4 * q + 3] = h[3];
                    }
                    union { u32x4 u; bf16x8 h; } ah, al;
                    ah.u = (u32x4){cvtpk(hv[0], hv[1]), cvtpk(hv[2], hv[3]), cvtpk(hv[4], hv[5]), cvtpk(hv[6], hv[7])};
                    float lv[8];
#pragma unroll
                    for (int q = 0; q < 4; ++q) { const unsigned w2 = q == 0 ? ah.u.x : q == 1 ? ah.u.y : q == 2 ? ah.u.z : ah.u.w; lv[2 * q] = hv[2 * q] - __uint_as_float(w2 << 16); lv[2 * q + 1] = hv[2 * q + 1] - __uint_as_float(w2 & 0xffff0000u); }
                    al.u = (u32x4){cvtpk(lv[0], lv[1]), cvtpk(lv[2], lv[3]), cvtpk(lv[4], lv[5]), cvtpk(lv[6], lv[7])};
                    if (MOE_FP8) { u32x2 h8; h8.x = pk4_fp8(hv[0], hv[1], hv[2], hv[3]); h8.y = pk4_fp8(hv[4], hv[5], hv[6], hv[7]); *(u32x2*)(h8row + k) = h8; }
                    else *(u32x4*)(hrow + k) = ah.u;
#pragma unroll
                    for (int nt = 0; nt < 3; ++nt) {
                        const bf16x8 bh = *(const bf16x8*)(wl + (nt * 16 + fr) * WPITCH + (k + 8 * fq) * 2);
                        acc[nt] = __builtin_amdgcn_mfma_f32_16x16x32_bf16(ah.h, bh, acc[nt], 0, 0, 0);
                        acc[nt] = __builtin_amdgcn_mfma_f32_16x16x32_bf16(al.h, bh, acc[nt], 0, 0, 0);
                    }
                }
            }
#pragma unroll
            for (int nt = 0; nt < 3; ++nt)
#pragma unroll
                for (int r = 0; r < 4; ++r) tile[(4 * fq + r) * 52 + nt * 16 + fr] = acc[nt][r];
            LDS_WAIT();
            if (lane < 16) {
                const float* lg = tile + lane * 52;
                float gl[4];
#pragma unroll
                for (int i = 0; i < 4; ++i) gl[i] = lg[i] + brg[i];
                int gsel = 0; float gmax = gl[0];
#pragma unroll
                for (int i = 1; i < 4; ++i) if (gl[i] > gmax) { gmax = gl[i]; gsel = i; }
                float gs = 0.f;
#pragma unroll
                for (int i = 0; i < 4; ++i) gs += __expf(gl[i] - gmax);
                const float pg = 1.0f / gs;
                float el[8];
#pragma unroll
                for (int j = 0; j < 8; ++j) el[j] = lg[4 + gsel * 8 + j] + bre[gsel * 8 + j];
                int i1 = 0; float v1 = el[0];
#pragma unroll
                for (int j = 1; j < 8; ++j) if (el[j] > v1) { v1 = el[j]; i1 = j; }
                int i2 = -1; float v2 = -3.0e38f;
#pragma unroll
                for (int j = 0; j < 8; ++j) if (j != i1 && el[j] > v2) { v2 = el[j]; i2 = j; }
                const float e2 = __expf(v2 - v1);
                const float g0 = pg / (1.0f + e2), g1 = pg * e2 / (1.0f + e2);
                const int ea = gsel * 8 + i1, eb = gsel * 8 + i2, slot = (wid * 16 + lane) * 2, r = R0 + lane;
                s_e[slot] = ea; s_rank[slot] = atomicAdd(&s_cnt[ea], 1); s_tok[slot] = r * 2; s_gate[slot] = g0;
                s_e[slot + 1] = eb; s_rank[slot + 1] = atomicAdd(&s_cnt[eb], 1); s_tok[slot + 1] = r * 2 + 1; s_gate[slot + 1] = g1;
            }
        }
        __syncthreads();
        if (tid < 32) { const int c = s_cnt[tid]; s_base[tid] = (c > 0 && commit) ? (int)atomicAdd(gcnt + 64 * tid, (unsigned)c) : 0; }
        __syncthreads();
        if (tid < 256) { const int e = s_e[tid]; if (e >= 0 && commit) { const size_t pos = (size_t)e * NTOK + s_base[e] + s_rank[tid]; ltok[pos] = s_tok[tid]; lgate[pos] = s_gate[tid]; } }
    }
}

__device__ __forceinline__ int moe_tables(const Params& p, int l, unsigned char* lds) {
    int* s_pref = (int*)(lds + LDS_MISC); int* s_cnt = s_pref + 40;
    unsigned* cnt = (unsigned*)(ows(p) + WS_CTL) + CW_CNT + 64 * l;
    __syncthreads();
    if (otid() == 0) {
        int acc = 0;
        for (int e = 0; e < NEXP; ++e) { const int c = (int)__hip_atomic_load(cnt + e, __ATOMIC_RELAXED, __HIP_MEMORY_SCOPE_AGENT); s_cnt[e] = c; s_pref[e] = acc; acc += (c + 127) >> 7; }
        s_pref[NEXP] = acc;
    }
    __syncthreads();
    return s_pref[NEXP];
}
__device__ __forceinline__ void phase_moe_gu(const Params& p, int l, unsigned char* lds) {
    const int T = moe_tables(p, l, lds);
    const int* s_pref = (const int*)(lds + LDS_MISC); const int* s_cnt = s_pref + 40;
    const bf16_t* hb = (const bf16_t*)(ows(p) + WS_H); bf16_t* hid = (bf16_t*)(ows(p) + WS_HID);
    const int* ltok = (const int*)(ows(p) + WS_LTOK);
    for (int u = obid(); u < T * 8; u += gridDim.x) {
        const int mtg = u >> 3, nt = u & 7;
        int e = 0;
        for (int q = 1; q < NEXP; ++q) if (s_pref[q] <= mtg) e = q;
        const int mt = mtg - s_pref[e]; const int nvalid = min(128, s_cnt[e] - mt * 128);
        ARowGather ar{hb, ltok + (size_t)e * NTOK + mt * 128, nvalid};
        EpiGU ep{hid + (size_t)mtg * 128 * 512 + nt * 64};
        gemm128(lds, ar, (const bf16_t*)(ows(p) + WS_WGU) + ((size_t)(l * 32 + e) * 1024 + nt * 128) * 1024, 1024, ep);
    }
}
__device__ __forceinline__ void phase_moe_down(const Params& p, int l, unsigned char* lds) {
    const int T = moe_tables(p, l, lds);
    const int* s_pref = (const int*)(lds + LDS_MISC); const int* s_cnt = s_pref + 40;
    const bf16_t* hid = (const bf16_t*)(ows(p) + WS_HID); bf16_t* yb = (bf16_t*)(ows(p) + WS_YB);
    const int* ltok = (const int*)(ows(p) + WS_LTOK); const float* lgate = (const float*)(ows(p) + WS_LGATE);
    for (int u = obid(); u < T * 8; u += gridDim.x) {
        const int mtg = u >> 3, nt = u & 7;
        int e = 0;
        for (int q = 1; q < NEXP; ++q) if (s_pref[q] <= mtg) e = q;
        const int mt = mtg - s_pref[e]; const int nvalid = min(128, s_cnt[e] - mt * 128);
        ARowPlain ar{hid + (size_t)mtg * 128 * 512, 512};
        EpiDown ep{yb + nt * 128, ltok + (size_t)e * NTOK + mt * 128, lgate + (size_t)e * NTOK + mt * 128, nvalid};
        gemm128(lds, ar, (const bf16_t*)(ows(p) + WS_WDN) + ((size_t)(l * 32 + e) * 1024 + nt * 128) * 512, 512, ep);
    }
}


#ifndef FAST_G1
#define FAST_G1 1
#endif
#ifndef FAST_G2
#define FAST_G2 1
#endif
#ifndef FAST_MOE
#define FAST_MOE 1
#endif
#ifndef FAST_GLA
#define FAST_GLA 1
#endif
#ifndef FAST_RT
#define FAST_RT 1
#endif
__device__ __forceinline__ void phase_gemm1_fast(const Params& p, int l, unsigned char* lds) {
    g8::DenseOrder S; S.init(NTOK / 256, PW / 256, (int)gridDim.x, obid(), (const bf16_t*)(ows(p) + WS_WIN) + (size_t)l * 4096 * 1024, 1024);
    g8::EpiP2 E{(bf16_t*)(ows(p) + WS_P)};
    g8::gemm_phase((LAS unsigned char*)lds, (const char*)(ows(p) + WS_H), 1024, S, E);
    if (gridDim.x == 256 && obid() >= 128) { __syncthreads(); convert_range(p, (float*)(lds + (otid() >> 6) * 16384), (obid() - 128) * 8 + (otid() >> 6), 128 * 8, l * CV_LAYER, l * CV_LAYER + CV_B); }
}
__device__ __forceinline__ void phase_gemm2_fast(const Params& p, int l, unsigned char* lds, float scl) {
    g8::DenseOrder S; g8::EpiDelta E{(bf16_t*)(ows(p) + WS_DELTA), (const float*)(ows(p) + WS_MOD) + (size_t)l * 9 * 6144 + 2 * 1024, scl};
    if (G2_FP8) {
        S.init(((l == DEPTH - 1) ? NLAT : NTOK) / 256, 4, (int)gridDim.x, obid(), ows(p) + WS_WOUT + (size_t)l * 1024 * 1024, 1024, 1);
        g8::gemm_phase8<0x7A7A7A7A, 0x7C7C7C7C>((LAS unsigned char*)lds, (const char*)(ows(p) + WS_Y), 1024, S, E);
    } else {
        S.init(((l == DEPTH - 1) ? NLAT : NTOK) / 256, 4, (int)gridDim.x, obid(), (const bf16_t*)(ows(p) + WS_WOUT) + (size_t)l * 1024 * 1024, 1024);
        g8::gemm_phase((LAS unsigned char*)lds, (const char*)(ows(p) + WS_Y), 1024, S, E);
    }
    if (gridDim.x == 256 && l < DEPTH - 1 && obid() >= 32 && scl != 0.0f) { __syncthreads(); convert_range(p, (float*)(lds + (otid() >> 6) * 16384), (obid() - 32) * 8 + (otid() >> 6), 224 * 8, l * CV_LAYER + CV_B + CV_S, (l + 1) * CV_LAYER); }
}
__device__ __forceinline__ int moe_tables256(const Params& p, int l, unsigned char* lds) {
    int* s_pref = (int*)(lds + LDS_MISC); int* s_cnt = s_pref + 40;
    unsigned* cnt = (unsigned*)(ows(p) + WS_CTL) + CW_CNT + 64 * 32 * l;
    __syncthreads();
    if (otid() == 0) {
        int acc = 0;
        for (int e = 0; e < NEXP; ++e) { const int c = (int)__hip_atomic_load(cnt + 64 * e, __ATOMIC_RELAXED, __HIP_MEMORY_SCOPE_AGENT); s_cnt[e] = c; s_pref[e] = acc; acc += (c + 255) >> 8; }
        s_pref[NEXP] = acc;
    }
    __syncthreads();
    return s_pref[NEXP];
}
__device__ __forceinline__ void moe_setup(const Params& p, int l, unsigned char* lds) {
    const int T = moe_tables256(p, l, lds);
    const int* s_pref = (const int*)(lds + LDS_MISC); const int* s_cnt = s_pref + 40;
    int* utab = (int*)(lds + g8::MOE_UTAB); int* rtok = (int*)(lds + g8::MOE_RTOK); float* rgate = (float*)(lds + g8::MOE_RGATE);
    const int tid = otid(), G = (int)gridDim.x, c = obid();
    if (tid < 4) {
        const int L = tid * G + c; int* t = utab + tid * 8;
        if (L < T * 4) {
            const int mtg = L >> 2; int e = 0;
            for (int q = 1; q < NEXP; ++q) if (s_pref[q] <= mtg) e = q;
            const int mt = mtg - s_pref[e];
            t[0] = mtg; t[1] = L & 3; t[2] = e; t[3] = min(256, s_cnt[e] - mt * 256); t[4] = e * NTOK + mt * 256; t[5] = 1;
        } else { int z = 0; asm volatile("" : "+v"(z)); t[0] = z; t[1] = z; t[2] = z; t[3] = z; t[4] = z; t[5] = z; }
    }
    __syncthreads();
    const int* ltok = (const int*)(ows(p) + WS_LTOK); const float* lgate = (const float*)(ows(p) + WS_LGATE);
    for (int idx = tid; idx < 1024; idx += 512) {
        const int i = idx >> 8, r = idx & 255; const int* t = utab + i * 8;
        const bool ok = t[5] != 0 && r < t[3];
        rtok[idx] = ok ? ltok[t[4] + r] : 0; rgate[idx] = ok ? lgate[t[4] + r] : 0.f;
    }
    __syncthreads();
}
__device__ __forceinline__ void phase_moe_gu_fast(const Params& p, int l, unsigned char* lds) {
    moe_setup(p, l, lds);
    g8::MoeOrder<true> S; S.utab = (const int*)(lds + g8::MOE_UTAB); S.rtok = (const int*)(lds + g8::MOE_RTOK); S.K = 1024;
    if (MOE_FP8) {
        S.W = (const char*)(ows(p) + WS_WGU8) + (size_t)l * 32 * 1024 * 1024; S.bpe = 1;
        g8::EpiGU8 E{ows(p) + WS_HID8};
        g8::gemm_phase8<0x7A7A7A7A, 0x7F7F7F7F>((LAS unsigned char*)lds, (const char*)(ows(p) + WS_H8), 1024, S, E);
    } else {
        S.W = (const char*)(ows(p) + WS_WGU) + (size_t)l * 32 * 1024 * 1024 * 2; S.bpe = 2;
        g8::EpiGU2 E{(bf16_t*)(ows(p) + WS_HID)};
        g8::gemm_phase((LAS unsigned char*)lds, (const char*)(ows(p) + WS_H), 1024, S, E);
    }
}
__device__ __forceinline__ void phase_moe_down_fast(const Params& p, int l, unsigned char* lds) {
    moe_setup(p, l, lds);
    g8::MoeOrder<false> S; S.utab = (const int*)(lds + g8::MOE_UTAB); S.rtok = (const int*)(lds + g8::MOE_RTOK); S.K = 512;
    g8::EpiDown2 E{(bf16_t*)(ows(p) + WS_YB), (const int*)(lds + g8::MOE_RTOK), (const float*)(lds + g8::MOE_RGATE)};
    if (MOE_FP8) {
        S.W = (const char*)(ows(p) + WS_WDN8) + (size_t)l * 32 * 1024 * 512; S.bpe = 1;
        g8::EpiDown8 E8{ows(p) + WS_YB8, (const int*)(lds + g8::MOE_RTOK), (const float*)(lds + g8::MOE_RGATE)};
        g8::gemm_phase8<0x7B7B7B7B, 0x7E7E7E7E>((LAS unsigned char*)lds, (const char*)(ows(p) + WS_HID8), 512, S, E8);
    } else {
        S.W = (const char*)(ows(p) + WS_WDN) + (size_t)l * 32 * 1024 * 512 * 2; S.bpe = 2;
        g8::gemm_phase((LAS unsigned char*)lds, (const char*)(ows(p) + WS_HID), 512, S, E);
    }
}

__device__ __forceinline__ void phase_c(const Params& p, int l, unsigned char* lds) {
    phase_gla_pre2(p, l, lds);
}

__global__ void __launch_bounds__(512, 2) mk(Params p) {
    extern __shared__ __attribute__((aligned(16))) unsigned char lds[];
    const int lo = p.ph_lo, hi = p.ph_hi;
    volatile LAS unsigned* misc = (volatile LAS unsigned*)(lds + LDS_MISC + 1024);
    if (threadIdx.x < 4) misc[threadIdx.x] = 0u;
    __syncthreads();
    XcdBarrier bar; bar.bar = (unsigned*)(p.ws + WS_CTL) + CW_BAR; bar.x = 0; bar.st = misc;
    if (hi - lo > 1) bar = xcd_barrier_post((unsigned*)(p.ws + WS_CTL) + CW_BAR, misc);
#define IN(k) (lo <= (k) && (k) < hi)
#define SEAM(k) do { if (IN((k) + 1)) { xcd_barrier(bar); if (DUPK == 20) xcd_barrier(bar); } } while (0)
#define REP(kind) for (int _rep = 0; _rep < ((DUPK == (kind)) ? 2 : 1); ++_rep)
    if (IN(0)) { REP(0) phase_prologue(p, lds); SEAM(0); }
    if (IN(1)) { REP(1) phase_modreduce(p); SEAM(1); }
    for (int l = 0; l < DEPTH; ++l) {
        const int pb = 2 + 9 * l;
        if (IN(pb + 0)) { if (DUPK == 2) phase_norm1(p, l, (float)(lo > 1000)); phase_norm1(p, l, 1.0f); SEAM(pb + 0); }
        if (IN(pb + 1)) { REP(3) { if (FAST_G1) phase_gemm1_fast(p, l, lds); else phase_gemm1(p, l, lds); } SEAM(pb + 1); }
        if (IN(pb + 2)) { REP(4) { phase_c(p, l, lds); } SEAM(pb + 2); }
        if (IN(pb + 3)) { REP(5) { phase_gla_seq2(p, l, lds); } SEAM(pb + 3); }
        if (IN(pb + 4)) { REP(6) phase_gla_post(p, l); SEAM(pb + 4); }
        if (IN(pb + 5)) { if (DUPK == 7) phase_gemm2_fast(p, l, lds, (float)(lo > 1000)); phase_gemm2_fast(p, l, lds, 1.0f); SEAM(pb + 5); }
        if (IN(pb + 6)) { if (DUPK == 8) phase_router2(p, l, lds, lo > 1000); phase_router2(p, l, lds, true); SEAM(pb + 6); }
        if (IN(pb + 7)) { REP(9) { if (FAST_MOE) phase_moe_gu_fast(p, l, lds); else phase_moe_gu(p, l, lds); } SEAM(pb + 7); }
        if (IN(pb + 8)) { REP(10) { if (FAST_MOE) phase_moe_down_fast(p, l, lds); else phase_moe_down(p, l, lds); } SEAM(pb + 8); }
    }
    if (IN(NPH - 1)) { REP(11) phase_final(p); }
#undef IN
#undef SEAM
}

#ifndef MK_LAUNCHES
#define MK_LAUNCHES 1
#endif
extern "C" void kernel_launch(void* const* d_in, const int* in_sizes, int n_in, void* d_out, int out_size, void* d_ws, size_t ws_size, hipStream_t stream) {
    static int grid = 0;
    if (grid == 0) {
        int dev = 0, cus = 0;
        if (n_in != 20 || ws_size < WS_END) { fprintf(stderr, "kernel_launch: unexpected shapes (n_in %d, ws %zu < %zu)\n", n_in, ws_size, (size_t)WS_END); grid = -1; return; }
        if (hipGetDevice(&dev) != hipSuccess || hipDeviceGetAttribute(&cus, hipDeviceAttributeMultiprocessorCount, dev) != hipSuccess) { grid = -1; return; }
        if (hipFuncSetAttribute((const void*)mk, hipFuncAttributeMaxDynamicSharedMemorySize, LDS_BYTES) != hipSuccess) { fprintf(stderr, "kernel_launch: hipFuncSetAttribute failed\n"); grid = -1; return; }
        (void)hipGetLastError();
        grid = cus;
    }
    if (grid < 0) return;
    (void)hipMemsetAsync((char*)d_ws + WS_CTL, 0, CTL_BYTES, stream);
    Params p{};
    for (int i = 0; i < 20; ++i) p.in[i] = (const float*)d_in[i];
    p.out = (float*)d_out; p.ws = (unsigned char*)d_ws;
    if (MK_LAUNCHES == 1) { p.ph_lo = 0; p.ph_hi = NPH; hipLaunchKernelGGL(mk, dim3(grid), dim3(512), LDS_BYTES, stream, p); }
    else for (int ph = 0; ph < NPH; ++ph) { p.ph_lo = ph; p.ph_hi = ph + 1; hipLaunchKernelGGL(mk, dim3(grid), dim3(512), LDS_BYTES, stream, p); }
}
```

```cpp
#include <hip/hip_runtime.h>
#include <stdint.h>
#include <stdio.h>

typedef unsigned short bf16_t;
typedef short bf16x8 __attribute__((ext_vector_type(8)));
typedef float f32x4 __attribute__((ext_vector_type(4)));
typedef unsigned u32x4 __attribute__((ext_vector_type(4)));
typedef unsigned u32x2 __attribute__((ext_vector_type(2)));
typedef int i32x8 __attribute__((ext_vector_type(8)));
typedef int i32x4 __attribute__((ext_vector_type(4)));
typedef short s16x4 __attribute__((ext_vector_type(4)));
typedef float f32x2 __attribute__((ext_vector_type(2)));
#define LAS __attribute__((address_space(3)))
#define GAS __attribute__((address_space(1)))

#ifndef G2_FP8
#define G2_FP8 1
#endif
#ifndef DUPK
#define DUPK -1
#endif
#ifndef MOE_FP8
#define MOE_FP8 1
#endif
constexpr int D = 1024, NB = 8, SEQ = 2048, DEPTH = 4, CTXL = 256;
constexpr int NLAT = NB * SEQ, NCTX = NB * CTXL, NTOK = NLAT + NCTX;
constexpr int PW = 4096;
constexpr int OFF_B = 0, OFF_C = 512, OFF_HV = 1024, OFF_Q = 1536, OFF_ZF = 2048, OFF_I = 3072, OFF_G = 3584;
constexpr int NEXP = 32;
constexpr int NCHUNK = NTOK / 16;
constexpr float EPS = 1e-6f;
constexpr int NMODP = 16;
constexpr int CV_ALL = 32 * (16 * 32 + 8 * 32), CV_B = 128 * 8 * 7, CV_F = 224 * 8 * 6;
constexpr int CV_S = (4 * CV_ALL - 4 * CV_B - 3 * CV_F) / 4, CV_LAYER = CV_B + CV_S + CV_F;
static_assert(4 * CV_B + 4 * CV_S + 3 * CV_F == 4 * CV_ALL, "conversion schedule");
static_assert(CV_LAYER >= CV_ALL && 3 * CV_LAYER + CV_B + CV_S == 4 * CV_ALL, "conversion schedule");

constexpr size_t WS_CTL = 0, CTL_BYTES = 65536;
constexpr size_t WS_WIN = WS_CTL + CTL_BYTES;
constexpr size_t WS_WOUT = WS_WIN + (size_t)4 * 4096 * 1024 * 2;
constexpr size_t WS_WGU = WS_WOUT + (size_t)4 * 1024 * 1024 * 2;
constexpr size_t WS_WDN = WS_WGU + (size_t)4 * 32 * 1024 * 1024 * 2;
constexpr size_t WS_MODP = WS_WDN + (size_t)4 * 32 * 1024 * 512 * 2;
constexpr size_t WS_MOD = WS_MODP + (size_t)4 * NMODP * 9 * 6144 * 4;
constexpr size_t WS_X = WS_MOD + (size_t)4 * 9 * 6144 * 4;
constexpr size_t WS_H = WS_X + (size_t)NTOK * 1024 * 4;
constexpr size_t WS_P = WS_H + (size_t)NTOK * 1024 * 2;
constexpr size_t WS_Y = WS_P + (size_t)NTOK * 4096 * 2;
constexpr size_t WS_QIN = WS_Y + (size_t)NTOK * 1024 * 2;
constexpr size_t WS_KOUT = WS_QIN + (size_t)2 * NTOK * 512 * 2;
constexpr size_t WS_DCH = WS_KOUT + (size_t)2 * NTOK * 512 * 2;
constexpr size_t WS_OINTRA = WS_DCH + (size_t)2 * NCHUNK * 512 * 4;
constexpr size_t WS_OINTER = WS_OINTRA + (size_t)NTOK * 512 * 4;
constexpr size_t WS_LTOK = WS_OINTER + (size_t)2 * NTOK * 512 * 4;
constexpr size_t WS_LGATE = WS_LTOK + (size_t)32 * NTOK * 4;
constexpr int HID_ROWS = 2 * NTOK + 32 * 256;
constexpr size_t WS_HID = WS_LGATE + (size_t)32 * NTOK * 4;
constexpr size_t WS_YB = WS_HID + (size_t)HID_ROWS * 512 * 2;
constexpr int REC_BYTES = 9216, VREC_BYTES = 4096;
constexpr size_t WS_GREC = WS_YB + (size_t)2 * NTOK * 1024 * 2;
constexpr size_t WS_VREC = WS_GREC + (size_t)2 * NCHUNK * 4 * REC_BYTES;
constexpr size_t WS_WRH = WS_VREC + (size_t)NCHUNK * 4 * VREC_BYTES;
constexpr size_t WS_WRL = WS_WRH + (size_t)4 * 48 * 1024 * 2;
constexpr size_t WS_H8 = WS_WRL + (size_t)4 * 48 * 1024 * 2;
constexpr size_t WS_HID8 = WS_H8 + (size_t)NTOK * 1024;
constexpr size_t WS_WGU8 = WS_HID8 + (size_t)HID_ROWS * 512;
constexpr size_t WS_WDN8 = WS_WGU8 + (size_t)4 * 32 * 1024 * 1024;
constexpr size_t WS_YB8 = WS_WDN8 + (size_t)4 * 32 * 1024 * 512;
constexpr size_t WS_DELTA = WS_YB8 + (size_t)2 * NTOK * 1024;
constexpr size_t WS_END = WS_DELTA + (size_t)NTOK * 1024 * 2;
constexpr int CW_BAR = 0;
constexpr int CW_CNT = 8192;

constexpr int LDS_BYTES = 147456;
constexpr int LDS_MISC = 143360;
constexpr int NPH = 2 + 9 * DEPTH + 1;

__device__ __forceinline__ float bf2f(bf16_t b) { return __uint_as_float(((unsigned)b) << 16); }
__device__ __forceinline__ unsigned f2bf(float f) { unsigned u = __float_as_uint(f); return (u + 0x7fffu + ((u >> 16) & 1u)) >> 16; }
__device__ __forceinline__ unsigned pk2(float lo, float hi) { return f2bf(lo) | (f2bf(hi) << 16); }
__device__ __forceinline__ float wave_sum(float v) {
#pragma unroll
    for (int o = 1; o < 64; o <<= 1) v += __shfl_xor(v, o);
    return v;
}
__device__ __forceinline__ float frcp(float x) { return __builtin_amdgcn_rcpf(x); }
__device__ __forceinline__ float sigmoidf(float x) { return frcp(1.0f + __expf(-x)); }
__device__ __forceinline__ float siluf(float x) { return x * frcp(1.0f + __expf(-x)); }
__device__ __forceinline__ float clamp8(float v) { return __builtin_amdgcn_fmed3f(v, -416.0f, 416.0f); }
__device__ __forceinline__ unsigned pk4_fp8_raw(float a, float b, float c, float d) { int r = __builtin_amdgcn_cvt_pk_fp8_f32(a, b, 0, false); r = __builtin_amdgcn_cvt_pk_fp8_f32(c, d, r, true); return (unsigned)r; }
__device__ __forceinline__ unsigned pk4_fp8(float a, float b, float c, float d) { int r = __builtin_amdgcn_cvt_pk_fp8_f32(clamp8(a), clamp8(b), 0, false); r = __builtin_amdgcn_cvt_pk_fp8_f32(clamp8(c), clamp8(d), r, true); return (unsigned)r; }
__device__ __forceinline__ f32x4 unpk4_fp8(unsigned w) { const f32x2 lo = __builtin_amdgcn_cvt_pk_f32_fp8((int)w, false), hi = __builtin_amdgcn_cvt_pk_f32_fp8((int)w, true); return (f32x4){lo.x, lo.y, hi.x, hi.y}; }
typedef __bf16 bf16x2_t __attribute__((ext_vector_type(2)));
__device__ __forceinline__ f32x4 unpk4_bf16(u32x2 w) { return (f32x4){__uint_as_float(w.x << 16), __uint_as_float(w.x & 0xffff0000u), __uint_as_float(w.y << 16), __uint_as_float(w.y & 0xffff0000u)}; }
__device__ __forceinline__ unsigned cvtpk(float lo, float hi) { const f32x2 v = {lo, hi}; const bf16x2_t r = __builtin_convertvector(v, bf16x2_t); return __builtin_bit_cast(unsigned, r); }
__device__ __forceinline__ int mod_row(int r) { return r < NLAT ? (r >> 11) : 8; }
#define LDS_WAIT() asm volatile("s_waitcnt lgkmcnt(0)" ::: "memory")
__device__ __forceinline__ int otid() { int t = threadIdx.x; asm volatile("" : "+v"(t)); return t; }
__device__ __forceinline__ int obid() { int b = blockIdx.x; asm volatile("" : "+s"(b)); return b; }

#define XB_TMO      128
#define XB_XCNT(j)  (256  + 64 * (j))
#define XB_XSUB(j)  (1280 + 64 * (j))
#define XB_XGEN(j)  (2304 + 64 * (j))
#define XB_TOP      3328
#define XB_TOPGEN   3392
#define XCD_BAR_WORDS 3456
#define XB_SPIN_CAP (1u << 18)
__device__ __forceinline__ unsigned xb_ld(unsigned* p)              { return __hip_atomic_load(p, __ATOMIC_RELAXED, __HIP_MEMORY_SCOPE_AGENT); }
__device__ __forceinline__ unsigned xb_add(unsigned* p, unsigned v) { return __hip_atomic_fetch_add(p, v, __ATOMIC_RELAXED, __HIP_MEMORY_SCOPE_AGENT); }
__device__ __forceinline__ unsigned xb_xcc_id() { return (unsigned)__builtin_amdgcn_s_getreg((3 << 11) | 20) & 0xFu; }
#define XB_SPIN(cond, bar) do { unsigned _sp = 0; while (cond) { __builtin_amdgcn_s_sleep(1); \
    if ((++_sp & 255u) == 0u) { if (xb_ld(&(bar)[XB_TMO])) break; if (_sp > XB_SPIN_CAP) { atomicAdd(&(bar)[XB_TMO], 1u); break; } } } } while (0)
struct XcdBarrier { unsigned* bar; unsigned x; volatile LAS unsigned* st; };
__device__ __forceinline__ XcdBarrier xcd_barrier_post(unsigned* bar, volatile LAS unsigned* st) {
    XcdBarrier b; b.bar = bar; b.x = xb_xcc_id(); b.st = st;
    if (threadIdx.x == 0) (void)xb_add(&bar[XB_XCNT(b.x)], 1u);
    return b;
}
__device__ __forceinline__ void xcd_barrier_complete(unsigned* bar, unsigned x, unsigned& nloc, unsigned& nx) {
    const unsigned G = gridDim.x * gridDim.y * gridDim.z;
    unsigned sum, cnt, mine, sp = 0u;
    for (;;) {
        sum = 0u; cnt = 0u; mine = 0u;
#pragma unroll
        for (unsigned j = 0; j < 16; ++j) { const unsigned c = xb_ld(&bar[XB_XCNT(j)]); sum += c; cnt += (c > 0u) ? 1u : 0u; mine = (j == x) ? c : mine; }
        if (sum == G) break;
        __builtin_amdgcn_s_sleep(1);
        if ((++sp & 255u) == 0u) { if (xb_ld(&bar[XB_TMO])) break; if (sp > XB_SPIN_CAP) { atomicAdd(&bar[XB_TMO], 1u); break; } }
    }
    nloc = mine > 0u ? mine : 1u; nx = cnt > 0u ? cnt : 1u;
}
__device__ __forceinline__ void xcd_barrier(const XcdBarrier& b) {
    asm volatile("s_waitcnt vmcnt(0)" ::: "memory");
    __syncthreads();
    if (threadIdx.x == 0) {
        unsigned* bar = b.bar;
        __builtin_amdgcn_s_waitcnt(0);
        unsigned nloc = b.st[0], nx = b.st[1];
        if (nloc == 0u) { xcd_barrier_complete(bar, b.x, nloc, nx); b.st[0] = nloc; b.st[1] = nx; }
        const unsigned old = xb_add(&bar[XB_XSUB(b.x)], 1u);
        const unsigned gen = old / nloc;
        if (old + 1u == (gen + 1u) * nloc) {
            __builtin_amdgcn_fence(__ATOMIC_RELEASE, "agent");
            asm volatile("s_waitcnt vmcnt(0)" ::: "memory");
            const unsigned og = xb_add(&bar[XB_TOP], 1u);
            const unsigned tg = og / nx;
            if (og + 1u == (tg + 1u) * nx) xb_add(&bar[XB_TOPGEN], 1u);
            else XB_SPIN(xb_ld(&bar[XB_TOPGEN]) == tg, bar);
            __builtin_amdgcn_fence(__ATOMIC_ACQUIRE, "agent");
            xb_add(&bar[XB_XGEN(b.x)], 1u);
            asm volatile("s_waitcnt vmcnt(0)" ::: "memory");
        } else {
            XB_SPIN(xb_ld(&bar[XB_XGEN(b.x)]) == gen, bar);
            __builtin_amdgcn_fence(__ATOMIC_ACQUIRE, "agent");
            asm volatile("s_waitcnt vmcnt(0)" ::: "memory");
        }
    }
    __syncthreads();
}

struct Params {
    const float* in[20];
    float* out;
    unsigned char* ws;
    int ph_lo, ph_hi;
};

__device__ __forceinline__ unsigned char* ows(const Params& p) { GAS unsigned char* w = (GAS unsigned char*)p.ws; asm volatile("" : "+s"(w)); return (unsigned char*)w; }
__device__ __forceinline__ const float* oin(const Params& p, int k) { const GAS float* q = (const GAS float*)p.in[k]; asm volatile("" : "+s"(q)); return (const float*)q; }

template <class ARow, class Epi>
__device__ __forceinline__ void gemm128(unsigned char* lds, const ARow& arow, const bf16_t* __restrict__ Bt, int K, const Epi& epi) {
    const int tid = otid(), lane = tid & 63, wid = tid >> 6, wr = wid >> 2, wc = wid & 3, fr = lane & 15, fq = lane >> 4;
    bf16_t* sA = (bf16_t*)lds;
    bf16_t* sB = (bf16_t*)(lds + 128 * 144);
    f32x4 acc[4][2];
#pragma unroll
    for (int m = 0; m < 4; ++m)
#pragma unroll
        for (int n = 0; n < 2; ++n) acc[m][n] = (f32x4){0.f, 0.f, 0.f, 0.f};
    const bf16_t* ap[2]; const bf16_t* bp[2]; int so[2];
#pragma unroll
    for (int i = 0; i < 2; ++i) {
        const int q = tid + 512 * i, row = q >> 3, seg = q & 7;
        ap[i] = arow(row) + seg * 8; bp[i] = Bt + (size_t)row * K + seg * 8; so[i] = row * 72 + seg * 8;
    }
    for (int k0 = 0; k0 < K; k0 += 64) {
        u32x4 va[2], vb[2];
#pragma unroll
        for (int i = 0; i < 2; ++i) { va[i] = *(const u32x4*)(ap[i] + k0); vb[i] = *(const u32x4*)(bp[i] + k0); }
        __syncthreads();
#pragma unroll
        for (int i = 0; i < 2; ++i) { *(u32x4*)(sA + so[i]) = va[i]; *(u32x4*)(sB + so[i]) = vb[i]; }
        __syncthreads();
#pragma unroll
        for (int kk = 0; kk < 2; ++kk) {
            bf16x8 a[4], b[2];
#pragma unroll
            for (int m = 0; m < 4; ++m) a[m] = *(const bf16x8*)(sA + (wr * 64 + m * 16 + fr) * 72 + kk * 32 + fq * 8);
#pragma unroll
            for (int n = 0; n < 2; ++n) b[n] = *(const bf16x8*)(sB + (wc * 32 + n * 16 + fr) * 72 + kk * 32 + fq * 8);
#pragma unroll
            for (int m = 0; m < 4; ++m)
#pragma unroll
                for (int n = 0; n < 2; ++n) acc[m][n] = __builtin_amdgcn_mfma_f32_16x16x32_bf16(b[n], a[m], acc[m][n], 0, 0, 0);
        }
    }
#pragma unroll
    for (int m = 0; m < 4; ++m)
#pragma unroll
        for (int n = 0; n < 2; ++n) epi(wr * 64 + m * 16 + fr, wc * 32 + n * 16 + fq * 4, acc[m][n]);
    __syncthreads();
}

struct ARowPlain { const bf16_t* A; int ld; __device__ __forceinline__ const bf16_t* operator()(int i) const { return A + (size_t)i * ld; } };
struct ARowGather { const bf16_t* A; const int* tok; int nvalid; __device__ __forceinline__ const bf16_t* operator()(int i) const { const int t = (i < nvalid) ? (tok[i] >> 1) : 0; return A + (size_t)t * 1024; } };

struct EpiP { bf16_t* P; __device__ __forceinline__ void operator()(int r, int c, f32x4 v) const {
    u32x2 w; w.x = pk2(v[0], v[1]); w.y = pk2(v[2], v[3]); *(u32x2*)(P + (size_t)r * PW + c) = w; } };
struct EpiRes { float* X; const float* gate; int m0; __device__ __forceinline__ void operator()(int r, int c, f32x4 v) const {
    const float* g = gate + (size_t)mod_row(m0 + r) * 6144 + c; float* xp = X + (size_t)r * 1024 + c;
    f32x4 x = *(f32x4*)xp; const f32x4 gv = *(const f32x4*)g; x += gv * v; *(f32x4*)xp = x; } };
struct EpiGU { bf16_t* H; __device__ __forceinline__ void operator()(int r, int c, f32x4 v) const {
    const float h0 = siluf(v[0]) * v[1], h1 = siluf(v[2]) * v[3]; *(unsigned*)(H + (size_t)r * 512 + (c >> 1)) = pk2(h0, h1); } };
struct EpiDown { bf16_t* YB; const int* tok; const float* gate; int nvalid; __device__ __forceinline__ void operator()(int r, int c, f32x4 v) const {
    if (r < nvalid) { const int e = tok[r]; const float g = gate[r]; u32x2 w; w.x = pk2(g * v[0], g * v[1]); w.y = pk2(g * v[2], g * v[3]); *(u32x2*)(YB + (size_t)e * 1024 + c) = w; } } };


namespace g8 {
constexpr int BM = 256, BK = 64, HALF = 128, HTB = HALF * BK * 2, NXCD = 8, WGM = 8;
__device__ __forceinline__ int lds_byte(int r, int c) { const int st = (r >> 4) * 2 + (c >> 5), rr = r & 15, cc = c & 31, ob = rr * 64 + cc * 2; return st * 1024 + (ob ^ (((ob >> 9) & 1) << 5)); }
__device__ __forceinline__ void stage_rc(int b, int& R, int& C) { const int st = b / 1024, sb = b % 1024, swz = sb ^ (((sb >> 9) & 1) << 5); R = (st >> 1) * 16 + swz / 64; C = (st & 1) * 32 + (swz % 64) / 2; }
__device__ __forceinline__ int perm32(int rho) { const int n = rho >> 4, i = rho & 15; return 8 * (i >> 2) + 4 * n + (i & 3); }
__device__ __forceinline__ unsigned cvt_pk_bf16(float lo, float hi) { return cvtpk(lo, hi); }

__device__ __forceinline__ int g8_ra(int tid, int i) { int R, C; stage_rc(tid * 16 + i * 8192, R, C); return R; }
__device__ __forceinline__ unsigned g8_ca(int tid, int i) { int R, C; stage_rc(tid * 16 + i * 8192, R, C); return (unsigned)C * 2u; }
#define G8_RA(i) g8_ra(otid(), (i))
#define G8_CA(i) g8_ca(otid(), (i))
template <class Epi, class Sched>
__device__ __forceinline__ void gemm_phase(LAS unsigned char* lds, const char* Abase, const int K, const Sched& S, const Epi& E) {
    const int tid = otid(), wid = __builtin_amdgcn_readfirstlane(tid >> 6), lane = tid & 63, wr = wid >> 2, wc = wid & 3, fr = lane & 15, fq = lane >> 4;
    const int nt = K / BK;
    unsigned voffB[2];
#pragma unroll
    for (int i = 0; i < 2; ++i) { int R, C; stage_rc(tid * 16 + i * 8192, R, C); const int Rb = Epi::PERM ? ((R & ~31) + perm32(R & 31)) : R;
        voffB[i] = (unsigned)(Rb * K + C) * 2u; }
    const unsigned rowb = (unsigned)K * 2u;
    const size_t kstep = (size_t)(BK * 2);
    const size_t hstep = (size_t)HALF * K * 2;
    const unsigned ldsw = (unsigned)wid * 1024u;
    const int aoff = lds_byte(wr * 64 + fr, fq * 8), boff = lds_byte(wc * 32 + fr, fq * 8);
#define G8_SA(b, h) (((b) * 2 + (h)) * HTB)
#define G8_SB(b, h) ((4 + (b) * 2 + (h)) * HTB)
#define G8_STAGE(bufoff, gbase, voff) do { _Pragma("unroll") for (int _i = 0; _i < 2; ++_i) \
        __builtin_amdgcn_global_load_lds((const unsigned*)((const char*)(gbase) + (voff)[_i]), (LAS unsigned*)(lds + (bufoff) + ldsw + _i * 8192), 16, 0, 0); } while (0)
#define G8_LDA(dst, b, h) do { _Pragma("unroll") for (int m = 0; m < 4; ++m) _Pragma("unroll") for (int k = 0; k < 2; ++k) dst[m][k] = *(const LAS bf16x8*)(lds + G8_SA(b, h) + aoff + m * 2048 + k * 1024); } while (0)
#define G8_LDB(dst, b, h) do { _Pragma("unroll") for (int n = 0; n < 2; ++n) _Pragma("unroll") for (int k = 0; k < 2; ++k) dst[n][k] = *(const LAS bf16x8*)(lds + G8_SB(b, h) + boff + n * 2048 + k * 1024); } while (0)
#define G8_MMA(ai, bj, At, Bt) do { __builtin_amdgcn_s_setprio(1); _Pragma("unroll") for (int m = 0; m < 4; ++m) _Pragma("unroll") for (int n = 0; n < 2; ++n) _Pragma("unroll") for (int k = 0; k < 2; ++k) \
        acc[ai][bj][m][n] = __builtin_amdgcn_mfma_f32_16x16x32_bf16(Bt[n][k], At[m][k], acc[ai][bj][m][n], 0, 0, 0); __builtin_amdgcn_s_setprio(0); } while (0)
#define G8_WAIT_V(n) asm volatile("s_waitcnt vmcnt(" #n ")" ::: "memory")
#define G8_WAIT_L(n) asm volatile("s_waitcnt lgkmcnt(" #n ")" ::: "memory")
#define G8_BAR __builtin_amdgcn_s_barrier()
#define G8_SCHED __builtin_amdgcn_sched_barrier(0)
    typename Sched::Unit cur, nxt; int ui = 0;
    if (!S.next(0, cur)) return;
    f32x4 acc[2][2][4][2];
#pragma unroll
    for (int a = 0; a < 2; ++a)
#pragma unroll
        for (int b = 0; b < 2; ++b)
#pragma unroll
            for (int m = 0; m < 4; ++m)
#pragma unroll
                for (int n = 0; n < 2; ++n) acc[a][b][m][n] = (f32x4){0.f, 0.f, 0.f, 0.f};
    bf16x8 At[4][2], B0[2][2], B1[2][2];
    unsigned vAc[2][2], vAn[2][2];
#pragma unroll
    for (int h = 0; h < 2; ++h)
#pragma unroll
        for (int i = 0; i < 2; ++i) vAc[h][i] = (Sched::AFFINE ? (unsigned)(h * HALF + G8_RA(i)) : (unsigned)S.a_row(cur, h * HALF + G8_RA(i))) * rowb + G8_CA(i);
    const char* cA = Sched::AFFINE ? Abase + (size_t)S.a_row(cur, 0) * rowb : Abase;
    const char* cB = S.b_base(cur);
    G8_STAGE(G8_SB(0, 0), cB, voffB); G8_STAGE(G8_SA(0, 0), cA, vAc[0]); G8_STAGE(G8_SB(0, 1), cB + hstep, voffB); G8_STAGE(G8_SA(0, 1), cA, vAc[1]);
    if (wr == 1) G8_BAR;
    G8_WAIT_V(4); G8_BAR;
    G8_STAGE(G8_SB(1, 0), cB + kstep, voffB); G8_STAGE(G8_SA(1, 0), cA + kstep, vAc[0]); G8_STAGE(G8_SB(1, 1), cB + hstep + kstep, voffB);
    G8_WAIT_V(6); G8_BAR;
    for (;;) {
        const bool has_next = S.next(ui + 1, nxt);
#pragma unroll
        for (int h = 0; h < 2; ++h)
#pragma unroll
            for (int i = 0; i < 2; ++i) vAn[h][i] = (has_next && !Sched::AFFINE) ? ((unsigned)S.a_row(nxt, h * HALF + G8_RA(i)) * rowb + G8_CA(i)) : vAc[h][i];
        const char* nA = (has_next && Sched::AFFINE) ? Abase + (size_t)S.a_row(nxt, 0) * rowb : cA;
        const char* nB = has_next ? S.b_base(nxt) : cB;
        for (int t = 0; t < nt; t += 2) {
            const bool last = (t == nt - 2);
            const char* a1 = cA + (size_t)(t + 1) * kstep;
            const char* a2 = last ? nA : cA + (size_t)(t + 2) * kstep; const char* b2 = last ? nB : cB + (size_t)(t + 2) * kstep;
            const char* a3 = a2 + kstep; const char* b3 = b2 + kstep;
            unsigned v2[2][2];
#pragma unroll
            for (int h = 0; h < 2; ++h)
#pragma unroll
                for (int i = 0; i < 2; ++i) v2[h][i] = last ? vAn[h][i] : vAc[h][i];
            G8_LDB(B0, 0, 0); G8_SCHED; G8_LDA(At, 0, 0); G8_STAGE(G8_SA(1, 1), a1, vAc[1]);
            G8_WAIT_L(8); G8_BAR; G8_WAIT_L(0); G8_MMA(0, 0, At, B0); G8_BAR; G8_SCHED;
            G8_LDB(B1, 0, 1); G8_STAGE(G8_SB(0, 0), b2, voffB);
            G8_BAR; G8_WAIT_L(0); G8_MMA(0, 1, At, B1); G8_BAR;
            G8_LDA(At, 0, 1); G8_STAGE(G8_SA(0, 0), a2, v2[0]);
            G8_BAR; G8_WAIT_L(0); G8_MMA(1, 0, At, B0); G8_BAR; G8_SCHED;
            G8_STAGE(G8_SB(0, 1), b2 + hstep, voffB);
            G8_WAIT_V(6); G8_BAR; G8_MMA(1, 1, At, B1); G8_BAR;
            G8_LDB(B0, 1, 0); G8_SCHED; G8_LDA(At, 1, 0); G8_STAGE(G8_SA(0, 1), a2, v2[1]);
            G8_WAIT_L(8); G8_BAR; G8_WAIT_L(0); G8_MMA(0, 0, At, B0); G8_BAR; G8_SCHED;
            G8_LDB(B1, 1, 1); G8_STAGE(G8_SB(1, 0), b3, voffB);
            G8_BAR; G8_WAIT_L(0); G8_MMA(0, 1, At, B1); G8_BAR;
            G8_LDA(At, 1, 1); G8_STAGE(G8_SA(1, 0), a3, v2[0]);
            G8_BAR; G8_WAIT_L(0); G8_MMA(1, 0, At, B0); G8_BAR; G8_SCHED;
            G8_STAGE(G8_SB(1, 1), b3 + hstep, voffB);
            G8_WAIT_V(6); G8_BAR; G8_MMA(1, 1, At, B1); G8_BAR;
        }
        E(acc, cur, wr, wc, fr, fq);
        if (!has_next) break;
#pragma unroll
        for (int a = 0; a < 2; ++a)
#pragma unroll
            for (int b = 0; b < 2; ++b)
#pragma unroll
                for (int m = 0; m < 4; ++m)
#pragma unroll
                    for (int n = 0; n < 2; ++n) acc[a][b][m][n] = (f32x4){0.f, 0.f, 0.f, 0.f};
        cur = nxt; cB = nB; cA = nA; ++ui;
#pragma unroll
        for (int h = 0; h < 2; ++h)
#pragma unroll
            for (int i = 0; i < 2; ++i) vAc[h][i] = vAn[h][i];
    }
    G8_WAIT_V(0);
    if (wr == 0) G8_BAR;
    G8_BAR;
#undef G8_SA
#undef G8_SB
#undef G8_STAGE
#undef G8_LDA
#undef G8_LDB
#undef G8_MMA
#undef G8_WAIT_V
#undef G8_WAIT_L
#undef G8_BAR
#undef G8_SCHED
}

template <int sclW, int sclA, class Epi, class Sched>
__device__ __forceinline__ void gemm_phase8(LAS unsigned char* lds, const char* Abase, const int K, const Sched& S, const Epi& E) {
    const int tid = otid(), wid = __builtin_amdgcn_readfirstlane(tid >> 6), lane = tid & 63, wr = wid >> 2, wc = wid & 3, fr = lane & 15, fq = lane >> 4;
    const int nt = K / 128;
    unsigned voffB[2];
#pragma unroll
    for (int i = 0; i < 2; ++i) { int R, C; stage_rc(tid * 16 + i * 8192, R, C); const int Rb = Epi::PERM ? ((R & ~31) + perm32(R & 31)) : R;
        voffB[i] = (unsigned)(Rb * K) + (unsigned)C * 2u; }
    const unsigned rowb = (unsigned)K;
    const size_t kstep = (size_t)(BK * 2);
    const size_t hstep = (size_t)HALF * K;
    const unsigned ldsw = (unsigned)wid * 1024u;
    const int fob = fr * 64 + ((2 * (fq & 1)) ^ (2 * (fr >> 3))) * 16 + (fq >> 1) * 1024;
    const int aoff = ((wr * 64) >> 4) * 2048 + fob, boff = ((wc * 32) >> 4) * 2048 + fob;
#define G8_SA(b, h) (((b) * 2 + (h)) * HTB)
#define G8_SB(b, h) ((4 + (b) * 2 + (h)) * HTB)
#define G8_STAGE(bufoff, gbase, voff) do { _Pragma("unroll") for (int _i = 0; _i < 2; ++_i) \
        __builtin_amdgcn_global_load_lds((const unsigned*)((const char*)(gbase) + (voff)[_i]), (LAS unsigned*)(lds + (bufoff) + ldsw + _i * 8192), 16, 0, 0); } while (0)
#define G8_LDA(dst, b, h) do { _Pragma("unroll") for (int m = 0; m < 4; ++m) { const i32x4 _lo = *(const LAS i32x4*)(lds + G8_SA(b, h) + aoff + m * 2048), _hi = *(const LAS i32x4*)(lds + G8_SA(b, h) + aoff + m * 2048 + 16); dst[m] = __builtin_shufflevector(_lo, _hi, 0, 1, 2, 3, 4, 5, 6, 7); } } while (0)
#define G8_LDB(dst, b, h) do { _Pragma("unroll") for (int n = 0; n < 2; ++n) { const i32x4 _lo = *(const LAS i32x4*)(lds + G8_SB(b, h) + boff + n * 2048), _hi = *(const LAS i32x4*)(lds + G8_SB(b, h) + boff + n * 2048 + 16); dst[n] = __builtin_shufflevector(_lo, _hi, 0, 1, 2, 3, 4, 5, 6, 7); } } while (0)
#define G8_MMA(ai, bj, At, Bt) do { __builtin_amdgcn_s_setprio(1); _Pragma("unroll") for (int m = 0; m < 4; ++m) _Pragma("unroll") for (int n = 0; n < 2; ++n) \
        acc[ai][bj][m][n] = __builtin_amdgcn_mfma_scale_f32_16x16x128_f8f6f4(Bt[n], At[m], acc[ai][bj][m][n], 0, 0, 0, sclW, 0, sclA); \
        _Pragma("unroll") for (int m = 0; m < 4; ++m) asm volatile("" : "+v"(acc[ai][bj][m][0]), "+v"(acc[ai][bj][m][1]));   \
        __builtin_amdgcn_s_setprio(0); } while (0)
#define G8_WAIT_V(n) asm volatile("s_waitcnt vmcnt(" #n ")" ::: "memory")
#define G8_WAIT_L(n) asm volatile("s_waitcnt lgkmcnt(" #n ")" ::: "memory")
#define G8_BAR __builtin_amdgcn_s_barrier()
#define G8_SCHED __builtin_amdgcn_sched_barrier(0)
    typename Sched::Unit cur, nxt; int ui = 0;
    if (!S.next(0, cur)) return;
    f32x4 acc[2][2][4][2];
#pragma unroll
    for (int a = 0; a < 2; ++a)
#pragma unroll
        for (int b = 0; b < 2; ++b)
#pragma unroll
            for (int m = 0; m < 4; ++m)
#pragma unroll
                for (int n = 0; n < 2; ++n) acc[a][b][m][n] = (f32x4){0.f, 0.f, 0.f, 0.f};
    i32x8 At[4], B0[2], B1[2];
    unsigned vAc[2][2], vAn[2][2];
#pragma unroll
    for (int h = 0; h < 2; ++h)
#pragma unroll
        for (int i = 0; i < 2; ++i) vAc[h][i] = (Sched::AFFINE ? (unsigned)(h * HALF + G8_RA(i)) : (unsigned)S.a_row(cur, h * HALF + G8_RA(i))) * rowb + G8_CA(i);
    const char* cA = Sched::AFFINE ? Abase + (size_t)S.a_row(cur, 0) * rowb : Abase;
    const char* cB = S.b_base(cur);
    G8_STAGE(G8_SB(0, 0), cB, voffB); G8_STAGE(G8_SA(0, 0), cA, vAc[0]); G8_STAGE(G8_SB(0, 1), cB + hstep, voffB); G8_STAGE(G8_SA(0, 1), cA, vAc[1]);
    if (wr == 1) G8_BAR;
    G8_WAIT_V(4); G8_BAR;
    G8_STAGE(G8_SB(1, 0), cB + kstep, voffB); G8_STAGE(G8_SA(1, 0), cA + kstep, vAc[0]); G8_STAGE(G8_SB(1, 1), cB + hstep + kstep, voffB);
    G8_WAIT_V(6); G8_BAR;
    for (;;) {
        const bool has_next = S.next(ui + 1, nxt);
#pragma unroll
        for (int h = 0; h < 2; ++h)
#pragma unroll
            for (int i = 0; i < 2; ++i) vAn[h][i] = (has_next && !Sched::AFFINE) ? ((unsigned)S.a_row(nxt, h * HALF + G8_RA(i)) * rowb + G8_CA(i)) : vAc[h][i];
        const char* nA = (has_next && Sched::AFFINE) ? Abase + (size_t)S.a_row(nxt, 0) * rowb : cA;
        const char* nB = has_next ? S.b_base(nxt) : cB;
#pragma unroll 1
        for (int t = 0; t < nt; t += 2) {
            const bool last = (t == nt - 2);
            const char* a1 = cA + (size_t)(t + 1) * kstep;
            const char* a2 = last ? nA : cA + (size_t)(t + 2) * kstep; const char* b2 = last ? nB : cB + (size_t)(t + 2) * kstep;
            const char* a3 = a2 + kstep; const char* b3 = b2 + kstep;
            unsigned v2[2][2];
#pragma unroll
            for (int h = 0; h < 2; ++h)
#pragma unroll
                for (int i = 0; i < 2; ++i) v2[h][i] = last ? vAn[h][i] : vAc[h][i];
            G8_LDB(B0, 0, 0); G8_SCHED; G8_LDA(At, 0, 0); G8_STAGE(G8_SA(1, 1), a1, vAc[1]);
            G8_WAIT_L(8); G8_BAR; G8_WAIT_L(0); G8_MMA(0, 0, At, B0); G8_BAR; G8_SCHED;
            G8_LDB(B1, 0, 1); G8_STAGE(G8_SB(0, 0), b2, voffB);
            G8_BAR; G8_WAIT_L(0); G8_MMA(0, 1, At, B1); G8_BAR;
            G8_LDA(At, 0, 1); G8_STAGE(G8_SA(0, 0), a2, v2[0]);
            G8_BAR; G8_WAIT_L(0); G8_MMA(1, 0, At, B0); G8_BAR; G8_SCHED;
            G8_STAGE(G8_SB(0, 1), b2 + hstep, voffB);
            G8_WAIT_V(6); G8_BAR; G8_MMA(1, 1, At, B1); G8_BAR;
            G8_LDB(B0, 1, 0); G8_SCHED; G8_LDA(At, 1, 0); G8_STAGE(G8_SA(0, 1), a2, v2[1]);
            G8_WAIT_L(8); G8_BAR; G8_WAIT_L(0); G8_MMA(0, 0, At, B0); G8_BAR; G8_SCHED;
            G8_LDB(B1, 1, 1); G8_STAGE(G8_SB(1, 0), b3, voffB);
            G8_BAR; G8_WAIT_L(0); G8_MMA(0, 1, At, B1); G8_BAR;
            G8_LDA(At, 1, 1); G8_STAGE(G8_SA(1, 0), a3, v2[0]);
            G8_BAR; G8_WAIT_L(0); G8_MMA(1, 0, At, B0); G8_BAR; G8_SCHED;
            G8_STAGE(G8_SB(1, 1), b3 + hstep, voffB);
            G8_WAIT_V(6); G8_BAR; G8_MMA(1, 1, At, B1); G8_BAR;
        }
        E(acc, cur, wr, wc, fr, fq);
        if (!has_next) break;
#pragma unroll
        for (int a = 0; a < 2; ++a)
#pragma unroll
            for (int b = 0; b < 2; ++b)
#pragma unroll
                for (int m = 0; m < 4; ++m)
#pragma unroll
                    for (int n = 0; n < 2; ++n) acc[a][b][m][n] = (f32x4){0.f, 0.f, 0.f, 0.f};
        cur = nxt; cB = nB; cA = nA; ++ui;
#pragma unroll
        for (int h = 0; h < 2; ++h)
#pragma unroll
            for (int i = 0; i < 2; ++i) vAc[h][i] = vAn[h][i];
    }
    G8_WAIT_V(0);
    if (wr == 0) G8_BAR;
    G8_BAR;
#undef G8_SA
#undef G8_SB
#undef G8_STAGE
#undef G8_LDA
#undef G8_LDB
#undef G8_MMA
#undef G8_WAIT_V
#undef G8_WAIT_L
#undef G8_BAR
#undef G8_SCHED
}

struct DUnit { int pm, pn; };
struct DenseOrder {
    typedef DUnit Unit; static constexpr bool AFFINE = true;
    int nM, nN, nwg, G, c; const char* Bt; int K; int bpe;
    __device__ __forceinline__ void init(int nM_, int nN_, int G_, int c_, const void* Bt_, int K_, int bpe_ = 2) { nM = nM_; nN = nN_; nwg = nM * nN; G = G_; c = c_; Bt = (const char*)Bt_; K = K_; bpe = bpe_; }
    __device__ __forceinline__ bool next(int i, Unit& u) const {
        const long L = (long)i * G + c; if (L >= nwg) return false;
        int wgid = (int)L; { const int q = nwg / NXCD, r = nwg % NXCD, xcd = wgid % NXCD, off = wgid / NXCD; wgid = (xcd < r ? xcd * (q + 1) : r * (q + 1) + (xcd - r) * q) + off; }
        const int nig = WGM * nN, gid = wgid / nig, fm = gid * WGM, gsz = (nM - fm) < WGM ? (nM - fm) : WGM;
        u.pm = fm + ((wgid % nig) % gsz); u.pn = (wgid % nig) / gsz; return true;
    }
    __device__ __forceinline__ int a_row(const Unit& u, int r) const { return u.pm * BM + r; }
    __device__ __forceinline__ const char* b_base(const Unit& u) const { return Bt + (size_t)u.pn * BM * K * bpe; }
};
struct MUnit { int pm, pn, e, nvalid, lbase, idx; };
constexpr int MOE_UTAB = 131072, MOE_RTOK = MOE_UTAB + 128, MOE_RGATE = MOE_RTOK + 4096;
template <bool GATHER> struct MoeOrder {
    typedef MUnit Unit; static constexpr bool AFFINE = !GATHER;
    const int* utab; const int* rtok; const char* W; int K; int bpe;
    __device__ __forceinline__ bool next(int i, Unit& u) const {
        if (i >= 4) return false;
        const int* t = utab + i * 8;
        if (t[5] == 0) return false;
        u.pm = t[0]; u.pn = t[1]; u.e = t[2]; u.nvalid = t[3]; u.lbase = t[4]; u.idx = i; return true;
    }
    __device__ __forceinline__ int a_row(const Unit& u, int r) const { if (GATHER) return rtok[u.idx * 256 + r] >> 1; else return u.pm * BM + r; }
    __device__ __forceinline__ const char* b_base(const Unit& u) const { return W + ((size_t)u.e * 1024 + u.pn * BM) * K * bpe; }
};

struct EpiP2 {
    static constexpr bool PERM = true;
    bf16_t* P;
    __device__ __forceinline__ void operator()(const f32x4 (&acc)[2][2][4][2], const DUnit& u, int wr, int wc, int fr, int fq) const {
        const int row0 = u.pm * BM + wr * 64 + fr, col0 = u.pn * BM + wc * 32 + 8 * fq;
#pragma unroll
        for (int ai = 0; ai < 2; ++ai)
#pragma unroll
            for (int m = 0; m < 4; ++m) { bf16_t* rowp = P + (size_t)(row0 + ai * HALF + m * 16) * PW + col0;
#pragma unroll
                for (int bj = 0; bj < 2; ++bj) { const f32x4 v0 = acc[ai][bj][m][0], v1 = acc[ai][bj][m][1];
                    u32x4 w; w.x = cvt_pk_bf16(v0[0], v0[1]); w.y = cvt_pk_bf16(v0[2], v0[3]); w.z = cvt_pk_bf16(v1[0], v1[1]); w.w = cvt_pk_bf16(v1[2], v1[3]);
                    *(u32x4*)(rowp + bj * HALF) = w; } }
    }
};
struct EpiRes2 {
    static constexpr bool PERM = false;
    float* X; const float* gate; float scl;
    __device__ __forceinline__ void operator()(const f32x4 (&acc)[2][2][4][2], const DUnit& u, int wr, int wc, int fr, int fq) const {
        const int row0 = u.pm * BM + wr * 64 + fr, col0 = u.pn * BM + wc * 32 + 4 * fq;
#pragma unroll
        for (int ai = 0; ai < 2; ++ai)
#pragma unroll
            for (int m = 0; m < 4; ++m) { const int r = row0 + ai * HALF + m * 16; float* rowp = X + (size_t)r * 1024 + col0; const float* gp = gate + (size_t)mod_row(r) * 6144 + col0;
#pragma unroll
                for (int bj = 0; bj < 2; ++bj)
#pragma unroll
                    for (int n = 0; n < 2; ++n) { const f32x4 gv = *(const f32x4*)(gp + bj * HALF + n * 16); f32x4 x = *(f32x4*)(rowp + bj * HALF + n * 16); x += (gv * scl) * acc[ai][bj][m][n]; *(f32x4*)(rowp + bj * HALF + n * 16) = x; }
                asm volatile("" ::: "memory"); }
    }
};
struct EpiDelta {
    static constexpr bool PERM = true;
    bf16_t* Dl; const float* gate; float scl;
    __device__ __forceinline__ void operator()(const f32x4 (&acc)[2][2][4][2], const DUnit& u, int wr, int wc, int fr, int fq) const {
        const int row0 = u.pm * BM + wr * 64 + fr, col0 = u.pn * BM + wc * 32 + 8 * fq;
#pragma unroll
        for (int ai = 0; ai < 2; ++ai)
#pragma unroll
            for (int m = 0; m < 4; ++m) { const int r = row0 + ai * HALF + m * 16; bf16_t* rowp = Dl + (size_t)r * 1024 + col0; const float* gp = gate + (size_t)mod_row(r) * 6144 + col0;
#pragma unroll
                for (int bj = 0; bj < 2; ++bj) { const f32x4 g0 = *(const f32x4*)(gp + bj * HALF) * scl, g1 = *(const f32x4*)(gp + bj * HALF + 4) * scl;
                    const f32x4 v0 = acc[ai][bj][m][0] * g0, v1 = acc[ai][bj][m][1] * g1;
                    u32x4 w; w.x = cvt_pk_bf16(v0[0], v0[1]); w.y = cvt_pk_bf16(v0[2], v0[3]); w.z = cvt_pk_bf16(v1[0], v1[1]); w.w = cvt_pk_bf16(v1[2], v1[3]);
                    *(u32x4*)(rowp + bj * HALF) = w; } }
    }
};
struct EpiGU2 {
    static constexpr bool PERM = true;
    bf16_t* H;
    __device__ __forceinline__ void operator()(const f32x4 (&acc)[2][2][4][2], const MUnit& u, int wr, int wc, int fr, int fq) const {
        const int row0 = u.pm * BM + wr * 64 + fr, col0 = u.pn * BM + wc * 32 + 8 * fq;
#pragma unroll
        for (int ai = 0; ai < 2; ++ai)
#pragma unroll
            for (int m = 0; m < 4; ++m) { bf16_t* rowp = H + (size_t)(row0 + ai * HALF + m * 16) * 512 + (col0 >> 1);
#pragma unroll
                for (int bj = 0; bj < 2; ++bj) { const f32x4 v0 = acc[ai][bj][m][0], v1 = acc[ai][bj][m][1];
                    u32x2 w; w.x = cvt_pk_bf16(siluf(v0[0]) * v0[1], siluf(v0[2]) * v0[3]); w.y = cvt_pk_bf16(siluf(v1[0]) * v1[1], siluf(v1[2]) * v1[3]);
                    *(u32x2*)(rowp + bj * (HALF / 2)) = w; } }
    }
};
struct EpiGU8 {
    static constexpr bool PERM = true;
    unsigned char* H;
    __device__ __forceinline__ void operator()(const f32x4 (&acc)[2][2][4][2], const MUnit& u, int wr, int wc, int fr, int fq) const {
        const int row0 = u.pm * BM + wr * 64 + fr, col0 = u.pn * BM + wc * 32 + 8 * fq;
#pragma unroll
        for (int ai = 0; ai < 2; ++ai)
#pragma unroll
            for (int m = 0; m < 4; ++m) { unsigned char* rowp = H + (size_t)(row0 + ai * HALF + m * 16) * 512 + (col0 >> 1);
#pragma unroll
                for (int bj = 0; bj < 2; ++bj) { const f32x4 v0 = acc[ai][bj][m][0], v1 = acc[ai][bj][m][1];
                    *(unsigned*)(rowp + bj * (HALF / 2)) = pk4_fp8(2.0f * siluf(v0[0]) * v0[1], 2.0f * siluf(v0[2]) * v0[3], 2.0f * siluf(v1[0]) * v1[1], 2.0f * siluf(v1[2]) * v1[3]); } }
    }
};
struct EpiDown2 {
    static constexpr bool PERM = true;
    bf16_t* YB; const int* rtok; const float* rgate;
    __device__ __forceinline__ void operator()(const f32x4 (&acc)[2][2][4][2], const MUnit& u, int wr, int wc, int fr, int fq) const {
        const int r0 = wr * 64 + fr, col0 = u.pn * BM + wc * 32 + 8 * fq;
#pragma unroll
        for (int ai = 0; ai < 2; ++ai)
#pragma unroll
            for (int m = 0; m < 4; ++m) { const int rt = r0 + ai * HALF + m * 16;
                if (rt < u.nvalid) { const int ent = rtok[u.idx * 256 + rt]; const float g = rgate[u.idx * 256 + rt]; bf16_t* rowp = YB + (size_t)ent * 1024 + col0;
#pragma unroll
                    for (int bj = 0; bj < 2; ++bj) { const f32x4 v0 = acc[ai][bj][m][0] * g, v1 = acc[ai][bj][m][1] * g;
                        u32x4 w; w.x = cvt_pk_bf16(v0[0], v0[1]); w.y = cvt_pk_bf16(v0[2], v0[3]); w.z = cvt_pk_bf16(v1[0], v1[1]); w.w = cvt_pk_bf16(v1[2], v1[3]);
                        *(u32x4*)(rowp + bj * HALF) = w; } } }
    }
};
struct EpiDown8 {
    static constexpr bool PERM = true;
    unsigned char* YB; const int* rtok; const float* rgate;
    __device__ __forceinline__ void operator()(const f32x4 (&acc)[2][2][4][2], const MUnit& u, int wr, int wc, int fr, int fq) const {
        const int r0 = wr * 64 + fr, col0 = u.pn * BM + wc * 32 + 8 * fq;
#pragma unroll
        for (int ai = 0; ai < 2; ++ai)
#pragma unroll
            for (int m = 0; m < 4; ++m) { const int rt = r0 + ai * HALF + m * 16;
                if (rt < u.nvalid) { const int ent = rtok[u.idx * 256 + rt]; const float g = 64.0f * rgate[u.idx * 256 + rt]; unsigned char* rowp = YB + (size_t)ent * 1024 + col0;
#pragma unroll
                    for (int bj = 0; bj < 2; ++bj) { const f32x4 v0 = acc[ai][bj][m][0] * g, v1 = acc[ai][bj][m][1] * g;
                        u32x2 w; w.x = pk4_fp8(v0[0], v0[1], v0[2], v0[3]); w.y = pk4_fp8(v1[0], v1[1], v1[2], v1[3]);
                        *(u32x2*)(rowp + bj * HALF) = w; } } }
    }
};
}

__device__ __forceinline__ void transpose_item(const float* __restrict__ W, int K, int N, bf16_t* __restrict__ WT, int mode, float* scr, int item, int lane) {
    const int nblk = N / 32, kb = item / nblk, nb = item % nblk, k0 = 64 * kb, n0 = 32 * nb;
    float wv[32];
#pragma unroll
    for (int i = 0; i < 32; ++i) wv[i] = __builtin_nontemporal_load(W + (size_t)(k0 + 2 * i + (lane >> 5)) * N + n0 + (lane & 31));
#pragma unroll
    for (int i = 0; i < 32; ++i) scr[(2 * i + (lane >> 5)) * 33 + (lane & 31)] = wv[i];
    LDS_WAIT();
    const int c = lane & 7;
#pragma unroll
    for (int j = 0; j < 4; ++j) {
        const int n = (lane >> 3) + 8 * j; const float* s = scr + (8 * c) * 33 + n;
        u32x4 o; o.x = pk2(s[0 * 33], s[1 * 33]); o.y = pk2(s[2 * 33], s[3 * 33]); o.z = pk2(s[4 * 33], s[5 * 33]); o.w = pk2(s[6 * 33], s[7 * 33]);
        const int nabs = n0 + n; const int orow = mode ? ((nabs < 512) ? 2 * nabs : 2 * (nabs - 512) + 1) : nabs;
        *(u32x4*)(WT + (size_t)orow * K + k0 + 8 * c) = o;
    }
    LDS_WAIT();
}


__device__ __forceinline__ void transpose_item8(const float* __restrict__ W, int K, int N, unsigned char* __restrict__ WT, int mode, float scale, float* scr, int item, int lane) {
    const int nblk = N / 32, kb = item / nblk, nb = item % nblk, k0 = 64 * kb, n0 = 32 * nb;
    float wv[32];
#pragma unroll
    for (int i = 0; i < 32; ++i) wv[i] = __builtin_nontemporal_load(W + (size_t)(k0 + 2 * i + (lane >> 5)) * N + n0 + (lane & 31));
#pragma unroll
    for (int i = 0; i < 32; ++i) scr[(2 * i + (lane >> 5)) * 33 + (lane & 31)] = wv[i] * scale;
    LDS_WAIT();
    const int c = lane & 7;
#pragma unroll
    for (int j = 0; j < 4; ++j) {
        const int n = (lane >> 3) + 8 * j; const float* s = scr + (8 * c) * 33 + n;
        u32x2 o; o.x = pk4_fp8(s[0 * 33], s[1 * 33], s[2 * 33], s[3 * 33]); o.y = pk4_fp8(s[4 * 33], s[5 * 33], s[6 * 33], s[7 * 33]);
        const int nabs = n0 + n; const int orow = mode ? ((nabs < 512) ? 2 * nabs : 2 * (nabs - 512) + 1) : nabs;
        *(u32x2*)(WT + (size_t)orow * K + k0 + 8 * c) = o;
    }
    LDS_WAIT();
}

__device__ __forceinline__ void convert_experts(const Params& p, int l, float* scr, int widx, int nwv, int it0, int it1) {
    const int tid = otid(), lane = tid & 63;
    bf16_t* wgu_t = (bf16_t*)(ows(p) + WS_WGU) + (size_t)l * 32 * 1024 * 1024; bf16_t* wdn_t = (bf16_t*)(ows(p) + WS_WDN) + (size_t)l * 32 * 1024 * 512;
    const float* wgu = oin(p, 17) + (size_t)l * 32 * 1024 * 1024; const float* wdn = oin(p, 18) + (size_t)l * 32 * 512 * 1024;
    constexpr int I_GU = 16 * 32, I_DN = 8 * 32, T_GU = 32 * I_GU;
    unsigned char* wgu8 = ows(p) + WS_WGU8 + (size_t)l * 32 * 1024 * 1024; unsigned char* wdn8 = ows(p) + WS_WDN8 + (size_t)l * 32 * 1024 * 512;
    for (int it = it0 + widx; it < it1; it += nwv) {
        if (it < T_GU) { const int m = it / I_GU;
            if (MOE_FP8) transpose_item8(wgu + (size_t)m * 1024 * 1024, 1024, 1024, wgu8 + (size_t)m * 1024 * 1024, 1, 32.0f, scr, it % I_GU, lane);
            else transpose_item(wgu + (size_t)m * 1024 * 1024, 1024, 1024, wgu_t + (size_t)m * 1024 * 1024, 1, scr, it % I_GU, lane); }
        else { const int r = it - T_GU, m = r / I_DN;
            if (MOE_FP8) transpose_item8(wdn + (size_t)m * 512 * 1024, 512, 1024, wdn8 + (size_t)m * 1024 * 512, 0, 16.0f, scr, r % I_DN, lane);
            else transpose_item(wdn + (size_t)m * 512 * 1024, 512, 1024, wdn_t + (size_t)m * 1024 * 512, 0, scr, r % I_DN, lane); }
    }
}

__device__ __forceinline__ void convert_range(const Params& p, float* scr, int widx, int nwv, int g0, int g1) {
    for (int l = g0 / CV_ALL; l < DEPTH && l * CV_ALL < g1; ++l) {
        const int a = max(g0, l * CV_ALL) - l * CV_ALL, b = min(g1, (l + 1) * CV_ALL) - l * CV_ALL;
        convert_experts(p, l, scr, widx, nwv, a, b);
    }
}

__device__ __forceinline__ void phase_prologue(const Params& p, unsigned char* lds) {
    const int tid = otid(), lane = tid & 63, wid = tid >> 6;
    float* scr = (float*)(lds + wid * 16384);
    const int gw = obid() * 8 + wid, NGW = gridDim.x * 8;
    bf16_t* win_t = (bf16_t*)(ows(p) + WS_WIN); bf16_t* wout_t = (bf16_t*)(ows(p) + WS_WOUT);
    constexpr int I_IN = 16 * 128, I_OUT = 16 * 32;
    constexpr int T_IN = 4 * I_IN, T_OUT = 4 * I_OUT;
    for (int it = gw; it < T_IN + T_OUT; it += NGW) {
        int r = it;
        if (r < T_IN) { const int m = r / I_IN; transpose_item(oin(p, 7) + (size_t)m * 1024 * 4096, 1024, 4096, win_t + (size_t)m * 4096 * 1024, 0, scr, r % I_IN, lane); continue; } r -= T_IN;
        { const int m = r / I_OUT;
          if (G2_FP8) transpose_item8(oin(p, 12) + (size_t)m * 1024 * 1024, 1024, 1024, (unsigned char*)wout_t + (size_t)m * 1024 * 1024, 0, 32.0f, scr, r % I_OUT, lane);
          else transpose_item(oin(p, 12) + (size_t)m * 1024 * 1024, 1024, 1024, wout_t + (size_t)m * 1024 * 1024, 0, scr, r % I_OUT, lane); }
    }
    {
        bf16_t* wrh = (bf16_t*)(ows(p) + WS_WRH); bf16_t* wrl = (bf16_t*)(ows(p) + WS_WRL);
        for (int i = obid() * 512 + tid; i < 4 * 48 * 1024; i += gridDim.x * 512) {
            const int l = i / (48 * 1024), j = (i / 1024) % 48, k = i % 1024;
            float w = 0.f;
            if (j < 4) w = oin(p, 13)[((size_t)l * 1024 + k) * 4 + j]; else if (j < 36) w = oin(p, 15)[((size_t)l * 1024 + k) * 32 + (j - 4)];
            const unsigned hi = f2bf(w); const float rem = w - __uint_as_float(hi << 16);
            wrh[i] = (bf16_t)hi; wrl[i] = (bf16_t)f2bf(rem);
        }
    }
    __syncthreads();
    float* modp = (float*)(ows(p) + WS_MODP);
    float* sS = (float*)lds;
    for (int u = obid(); u < 4 * 24 * 8; u += gridDim.x) {
        const int l = u / 192, rem = u % 192, nb = rem / 8, ks = rem % 8;
        __syncthreads();
        for (int i = tid; i < 9 * 128; i += 512) { const int r = i >> 7, k = i & 127; const float cv = (r < 8) ? oin(p, 1)[r * 1024 + ks * 128 + k] : oin(p, 3)[ks * 128 + k]; sS[i] = siluf(cv); }
        __syncthreads();
        const int col = nb * 256 + (tid & 255), kh = tid >> 8;
        float acc[9];
#pragma unroll
        for (int r = 0; r < 9; ++r) acc[r] = 0.f;
        const float* w = oin(p, 5) + ((size_t)l * 1024 + ks * 128 + kh * 64) * 6144 + col;
        for (int k = 0; k < 64; ++k) {
            const float wv = w[(size_t)k * 6144];
#pragma unroll
            for (int r = 0; r < 9; ++r) acc[r] += sS[r * 128 + kh * 64 + k] * wv;
        }
#pragma unroll
        for (int r = 0; r < 9; ++r) modp[(((size_t)l * NMODP + ks * 2 + kh) * 9 + r) * 6144 + col] = acc[r];
    }
}

__device__ __forceinline__ void phase_modreduce(const Params& p) {
    const float* modp = (const float*)(ows(p) + WS_MODP); float* modv = (float*)(ows(p) + WS_MOD);
    for (int i = obid() * 512 + otid(); i < 4 * 9 * 6144; i += gridDim.x * 512) {
        const int l = i / (9 * 6144), rem = i % (9 * 6144), n = rem % 6144;
        float s = oin(p, 6)[l * 6144 + n];
        for (int j = 0; j < NMODP; ++j) s += modp[((size_t)l * NMODP + j) * 9 * 6144 + rem];
        modv[i] = s;
    }
}

__device__ __forceinline__ void phase_norm1(const Params& p, int l, float scl) {
    const int lane = otid() & 63, wid = otid() >> 6;
    bf16_t* xws = (bf16_t*)(ows(p) + WS_X); bf16_t* hb = (bf16_t*)(ows(p) + WS_H); const bf16_t* yb = (const bf16_t*)(ows(p) + WS_YB);
    const float* modv = (const float*)(ows(p) + WS_MOD);
    const float* nw = oin(p, 4) + (size_t)(l * 2 + 0) * 1024;
    for (int r = obid() * 8 + wid; r < NTOK; r += gridDim.x * 8) {
        const int mr = mod_row(r);
        f32x4 v[4];
        if (l == 0) { const float* src = r < NLAT ? oin(p, 0) + (size_t)r * 1024 : oin(p, 2) + (size_t)(r - NLAT) * 1024;
#pragma unroll
            for (int j = 0; j < 4; ++j) v[j] = *(const f32x4*)(src + 4 * lane + 256 * j); }
        else {
#pragma unroll
            for (int j = 0; j < 4; ++j) v[j] = unpk4_bf16(*(const u32x2*)(xws + (size_t)r * 1024 + 4 * lane + 256 * j)); }
        if (l > 0) {
            const float* g5 = modv + ((size_t)(l - 1) * 9 + mr) * 6144 + 5 * 1024;
#pragma unroll
            for (int j = 0; j < 4; ++j) {
                const int c = 4 * lane + 256 * j;
                const f32x4 gv = *(const f32x4*)(g5 + c);
                f32x4 f;
                if (MOE_FP8) { const unsigned char* y8 = ows(p) + WS_YB8; f = (unpk4_fp8(*(const unsigned*)(y8 + (size_t)(2 * r) * 1024 + c)) + unpk4_fp8(*(const unsigned*)(y8 + (size_t)(2 * r + 1) * 1024 + c))) * (1.0f / 64.0f); }
                else { const u32x2 y0 = *(const u32x2*)(yb + (size_t)(2 * r) * 1024 + c), y1 = *(const u32x2*)(yb + (size_t)(2 * r + 1) * 1024 + c);
                f[0] = bf2f(y0.x & 0xffff) + bf2f(y1.x & 0xffff); f[1] = bf2f(y0.x >> 16) + bf2f(y1.x >> 16);
                f[2] = bf2f(y0.y & 0xffff) + bf2f(y1.y & 0xffff); f[3] = bf2f(y0.y >> 16) + bf2f(y1.y >> 16); }
                v[j] += (gv * scl) * f;
            }
        }
#pragma unroll
        for (int j = 0; j < 4; ++j) { u32x2 o; o.x = cvtpk(v[j][0], v[j][1]); o.y = cvtpk(v[j][2], v[j][3]); *(u32x2*)(xws + (size_t)r * 1024 + 4 * lane + 256 * j) = o; }
        float ss = 0.f;
#pragma unroll
        for (int j = 0; j < 4; ++j) ss += (v[j][0] * v[j][0] + v[j][1] * v[j][1]) + (v[j][2] * v[j][2] + v[j][3] * v[j][3]);
        const float rstd = rsqrtf(wave_sum(ss) * (1.0f / 1024.0f) + EPS);
        const float* msh = modv + ((size_t)l * 9 + mr) * 6144; const float* msc = msh + 1024;
#pragma unroll
        for (int j = 0; j < 4; ++j) {
            const int c = 4 * lane + 256 * j;
            const f32x4 w = *(const f32x4*)(nw + c), sh = *(const f32x4*)(msh + c), sc = *(const f32x4*)(msc + c);
            const f32x4 h = (v[j] * rstd * w) * (1.0f + sc) + sh;
            u32x2 o; o.x = pk2(h[0], h[1]); o.y = pk2(h[2], h[3]);
            *(u32x2*)(hb + (size_t)r * 1024 + c) = o;
        }
    }
}

__device__ __forceinline__ void phase_final(const Params& p) {
    const int lane = otid() & 63, wid = otid() >> 6;
    const bf16_t* xws = (const bf16_t*)(ows(p) + WS_X); const bf16_t* yb = (const bf16_t*)(ows(p) + WS_YB);
    const float* modv = (const float*)(ows(p) + WS_MOD); const float* nw = oin(p, 19);
    for (int r = obid() * 8 + wid; r < NLAT; r += gridDim.x * 8) {
        const int mr = mod_row(r);
        const float* g5 = modv + ((size_t)3 * 9 + mr) * 6144 + 5 * 1024;
        f32x4 v[4]; float ss = 0.f;
#pragma unroll
        for (int j = 0; j < 4; ++j) {
            const int c = 4 * lane + 256 * j;
            v[j] = unpk4_bf16(*(const u32x2*)(xws + (size_t)r * 1024 + c));
            const f32x4 gv = *(const f32x4*)(g5 + c);
            f32x4 f;
            if (MOE_FP8) { const unsigned char* y8 = ows(p) + WS_YB8; f = (unpk4_fp8(*(const unsigned*)(y8 + (size_t)(2 * r) * 1024 + c)) + unpk4_fp8(*(const unsigned*)(y8 + (size_t)(2 * r + 1) * 1024 + c))) * (1.0f / 64.0f); }
            else { const u32x2 y0 = *(const u32x2*)(yb + (size_t)(2 * r) * 1024 + c), y1 = *(const u32x2*)(yb + (size_t)(2 * r + 1) * 1024 + c);
            f[0] = bf2f(y0.x & 0xffff) + bf2f(y1.x & 0xffff); f[1] = bf2f(y0.x >> 16) + bf2f(y1.x >> 16);
            f[2] = bf2f(y0.y & 0xffff) + bf2f(y1.y & 0xffff); f[3] = bf2f(y0.y >> 16) + bf2f(y1.y >> 16); }
            v[j] += gv * f;
            ss += (v[j][0] * v[j][0] + v[j][1] * v[j][1]) + (v[j][2] * v[j][2] + v[j][3] * v[j][3]);
        }
        const float rstd = rsqrtf(wave_sum(ss) * (1.0f / 1024.0f) + EPS);
#pragma unroll
        for (int j = 0; j < 4; ++j) { const int c = 4 * lane + 256 * j; const f32x4 w = *(const f32x4*)(nw + c); *(f32x4*)(p.out + (size_t)r * 1024 + c) = v[j] * rstd * w; }
    }
}

__device__ __forceinline__ void phase_gemm1(const Params& p, int l, unsigned char* lds) {
    const bf16_t* hb = (const bf16_t*)(ows(p) + WS_H); const bf16_t* wt = (const bf16_t*)(ows(p) + WS_WIN) + (size_t)l * 4096 * 1024; bf16_t* pb = (bf16_t*)(ows(p) + WS_P);
    constexpr int NT = PW / 128, MT = NTOK / 128;
    for (int u = obid(); u < MT * NT; u += gridDim.x) {
        const int mt = u / NT, nt = u % NT;
        ARowPlain ar{hb + (size_t)mt * 128 * 1024, 1024};
        EpiP ep{pb + (size_t)mt * 128 * PW + nt * 128};
        gemm128(lds, ar, wt + (size_t)nt * 128 * 1024, 1024, ep);
    }
}

__device__ __forceinline__ void unpack8(const u32x4 w, float (&f)[8]) {
    f[0] = bf2f(w.x & 0xffff); f[1] = bf2f(w.x >> 16); f[2] = bf2f(w.y & 0xffff); f[3] = bf2f(w.y >> 16);
    f[4] = bf2f(w.z & 0xffff); f[5] = bf2f(w.z >> 16); f[6] = bf2f(w.w & 0xffff); f[7] = bf2f(w.w >> 16);
}
__device__ __forceinline__ void conv_rows(const Params& p, int l, int widx, int nwv) {
    const int lane = otid() & 63;
    const bf16_t* pb = (const bf16_t*)(ows(p) + WS_P); bf16_t* yb = (bf16_t*)(ows(p) + WS_Y);
    const float* cw = oin(p, 8) + (size_t)l * 3 * 512; const float* cnw = oin(p, 9) + (size_t)l * 512;
    const int nrows = (l == DEPTH - 1) ? NLAT : NTOK;
    const int c0 = lane * 8;
    float w0[8], w1[8], w2[8], nwv8[8];
#pragma unroll
    for (int j = 0; j < 8; ++j) { w0[j] = cw[c0 + j]; w1[j] = cw[512 + c0 + j]; w2[j] = cw[1024 + c0 + j]; nwv8[j] = cnw[c0 + j]; }
    constexpr int NB = 4;
    for (int rb = widx; rb < nrows; rb += NB * nwv) {
        u32x4 vb[NB], vc[NB], vh[NB], vcm[NB], vhm[NB], vcp[NB], vhp[NB]; bool hm[NB], hp[NB];
#pragma unroll
        for (int q = 0; q < NB; ++q) {
            int r = rb + q * nwv; if (r >= nrows) r = rb;
            int rm = -1, rp = -1;
            if (r < NLAT) {
                const int t = r & 2047;
                if (c0 < 256) { if ((t & 63) > 0) rm = r - 1; if ((t & 63) < 63) rp = r + 1; }
                else { if (t >= 64) rm = r - 64; if (t < SEQ - 64) rp = r + 64; }
            } else { const int tc = (r - NLAT) & 255; if (tc > 0) rm = r - 1; if (tc < 255) rp = r + 1; }
            hm[q] = rm >= 0; hp[q] = rp >= 0; if (rm < 0) rm = r; if (rp < 0) rp = r;
            vb[q] = *(const u32x4*)(pb + (size_t)r * PW + OFF_B + c0); vc[q] = *(const u32x4*)(pb + (size_t)r * PW + OFF_C + c0); vh[q] = *(const u32x4*)(pb + (size_t)r * PW + OFF_HV + c0);
            vcm[q] = *(const u32x4*)(pb + (size_t)rm * PW + OFF_C + c0); vhm[q] = *(const u32x4*)(pb + (size_t)rm * PW + OFF_HV + c0);
            vcp[q] = *(const u32x4*)(pb + (size_t)rp * PW + OFF_C + c0); vhp[q] = *(const u32x4*)(pb + (size_t)rp * PW + OFF_HV + c0);
        }
#pragma unroll
        for (int q = 0; q < NB; ++q) {
            const int r = rb + q * nwv;
            float bg[8], u0[8], um[8], up[8], t1[8];
            unpack8(vb[q], bg); unpack8(vc[q], u0); unpack8(vh[q], t1);
#pragma unroll
            for (int j = 0; j < 8; ++j) u0[j] *= t1[j];
            unpack8(vcm[q], um); unpack8(vhm[q], t1);
#pragma unroll
            for (int j = 0; j < 8; ++j) um[j] = hm[q] ? um[j] * t1[j] : 0.f;
            unpack8(vcp[q], up); unpack8(vhp[q], t1);
#pragma unroll
            for (int j = 0; j < 8; ++j) up[j] = hp[q] ? up[j] * t1[j] : 0.f;
            float z[8]; float ss = 0.f;
#pragma unroll
            for (int j = 0; j < 8; ++j) { z[j] = bg[j] * (w0[j] * um[j] + w1[j] * u0[j] + w2[j] * up[j]); ss += z[j] * z[j]; }
            const float rstd = rsqrtf(wave_sum(ss) * (1.0f / 512.0f) + EPS);
            if (G2_FP8) {
                const float rs8 = rstd * 8.0f; u32x2 o8;
                o8.x = pk4_fp8(z[0] * rs8 * nwv8[0], z[1] * rs8 * nwv8[1], z[2] * rs8 * nwv8[2], z[3] * rs8 * nwv8[3]); o8.y = pk4_fp8(z[4] * rs8 * nwv8[4], z[5] * rs8 * nwv8[5], z[6] * rs8 * nwv8[6], z[7] * rs8 * nwv8[7]);
                if (r < nrows) *(u32x2*)((unsigned char*)yb + (size_t)r * 1024 + c0) = o8;
            } else {
            u32x4 o;
            o.x = cvtpk(z[0] * rstd * nwv8[0], z[1] * rstd * nwv8[1]); o.y = cvtpk(z[2] * rstd * nwv8[2], z[3] * rstd * nwv8[3]);
            o.z = cvtpk(z[4] * rstd * nwv8[4], z[5] * rstd * nwv8[5]); o.w = cvtpk(z[6] * rstd * nwv8[6], z[7] * rstd * nwv8[7]);
            if (r < nrows) *(u32x4*)(yb + (size_t)r * 1024 + c0) = o; }
        }
    }
}

template <int DIR>
__device__ __forceinline__ void gla_pre_dir(const Params& p, int l, int chunk, float* sQ, float* sK, const float* sV, float* sA, float* sBq, float (&oacc)[16]) {
    const int ch = otid(), tid = otid(), R0 = chunk * 16;
    const bf16_t* pb = (const bf16_t*)(ows(p) + WS_P);
    bf16_t* qin = (bf16_t*)(ows(p) + WS_QIN); bf16_t* kout = (bf16_t*)(ows(p) + WS_KOUT); float* dch = (float*)(ows(p) + WS_DCH);
    float lbv = 0.f;
    {
        const float* lb = oin(p, 10) + (size_t)DIR * 4 * 512 + ch;
        const float z0 = lb[0], z1 = lb[512], z2 = lb[1024], z3 = lb[1536];
        const float mx = fmaxf(fmaxf(z0, z1), fmaxf(z2, z3));
        const float e0 = __expf(z0 - mx), e1 = __expf(z1 - mx), e2 = __expf(z2 - mx), e3 = __expf(z3 - mx);
        const float inv = 1.0f / (e0 + e1 + e2 + e3);
        lbv = ((l >= 1 ? e1 : 0.f) + (l >= 2 ? e2 : 0.f) + (l >= 3 ? e3 : 0.f)) * inv;
    }
    float b = 0.f;
#pragma unroll 1
    for (int i = 0; i < 16; ++i) {
        const int row = R0 + (DIR ? 15 - i : i);
        const float zf = bf2f(pb[(size_t)row * PW + OFF_ZF + DIR * 512 + ch]);
        const float sg = 1.0f / (1.0f + __expf(-zf)), sn = 1.0f / (1.0f + __expf(zf));
        const float f = fmaxf(lbv + (1.0f - lbv) * sg, 1e-30f);
        b += __logf(f);
        sBq[i * 512 + ch] = b; sK[i * 512 + ch] = (1.0f - lbv) * sn;
        sQ[i * 512 + ch] = siluf(bf2f(pb[(size_t)row * PW + OFF_Q + ch]));
    }
    const float blast = b;
#pragma unroll 1
    for (int i = 0; i < 16; ++i) {
        const int row = R0 + (DIR ? 15 - i : i);
        const float bi = sBq[i * 512 + ch], kq = sK[i * 512 + ch], qv = sQ[i * 512 + ch];
        const float qi = qv * __expf(bi), kt = kq * __expf(fminf(-bi, 80.0f)), ko = kq * __expf(blast - bi);
        sQ[i * 512 + ch] = qi; sK[i * 512 + ch] = kt;
        qin[((size_t)DIR * NTOK + row) * 512 + ch] = (bf16_t)f2bf(qi);
        kout[((size_t)DIR * NTOK + row) * 512 + ch] = (bf16_t)f2bf(ko);
    }
    dch[((size_t)DIR * NCHUNK + chunk) * 512 + ch] = __expf(blast);
    __syncthreads();
#pragma unroll 1
    for (int e2 = 0; e2 < 2; ++e2) {
        const int e = tid * 2 + e2, h = e >> 8, t = (e >> 4) & 15, s = e & 15;
        float sum = 0.f;
        const float* qp = sQ + t * 512 + h * 128; const float* kp = sK + s * 512 + h * 128;
#pragma unroll 8
        for (int k = 0; k < 128; ++k) sum += qp[k] * kp[k];
        sA[e] = (s <= t) ? sum : 0.f;
    }
    __syncthreads();
    const int h = ch >> 7;
#pragma unroll
    for (int t = 0; t < 16; ++t) {
        float o = 0.f;
#pragma unroll 1
        for (int s = 0; s <= t; ++s) o += sA[(h * 16 + t) * 16 + s] * sV[(DIR ? 15 - s : s) * 512 + ch];
        oacc[DIR ? 15 - t : t] += o;
    }
    __syncthreads();
}

__device__ __forceinline__ void phase_conv_glapre(const Params& p, int l, unsigned char* lds) {
    conv_rows(p, l, obid() * 8 + (otid() >> 6), (int)gridDim.x * 8);
    float* sQ = (float*)lds; float* sK = sQ + 16 * 512; float* sV = sK + 16 * 512; float* sBq = sV + 16 * 512; float* sA = sBq + 16 * 512;
    const bf16_t* pb = (const bf16_t*)(ows(p) + WS_P); float* ointra = (float*)(ows(p) + WS_OINTRA);
    const int ch = otid();
    for (int chunk = obid(); chunk < NCHUNK; chunk += gridDim.x) {
        const int R0 = chunk * 16;
        float oacc[16];
#pragma unroll
        for (int i = 0; i < 16; ++i) oacc[i] = 0.f;
        __syncthreads();
#pragma unroll
        for (int ro = 0; ro < 16; ++ro) sV[ro * 512 + ch] = bf2f(pb[(size_t)(R0 + ro) * PW + OFF_I + ch]);
        gla_pre_dir<0>(p, l, chunk, sQ, sK, sV, sA, sBq, oacc);
        gla_pre_dir<1>(p, l, chunk, sQ, sK, sV, sA, sBq, oacc);
#pragma unroll
        for (int ro = 0; ro < 16; ++ro) ointra[(size_t)(R0 + ro) * 512 + ch] = oacc[ro];
    }
}

__device__ __forceinline__ void phase_gla_seq(const Params& p, int l, unsigned char* lds) {
    const int tid = otid();
    float* S = (float*)lds;
    float* sQ = S + 128 * 32;
    float* sKo = sQ + 16 * 128;
    float* sV = sKo + 16 * 128;
    float* sD = sV + 16 * 32;
    const bf16_t* pb = (const bf16_t*)(ows(p) + WS_P);
    const bf16_t* qin = (const bf16_t*)(ows(p) + WS_QIN); const bf16_t* kout = (const bf16_t*)(ows(p) + WS_KOUT); const float* dch = (const float*)(ows(p) + WS_DCH);
    float* ointer = (float*)(ows(p) + WS_OINTER);
    for (int u = obid(); u < 256; u += gridDim.x) {
        const int vblk = u & 3, dir = (u >> 2) & 1, chain = u >> 3, b = chain >> 2, h = chain & 3;
        __syncthreads();
        for (int i = tid; i < 128 * 32; i += 512) S[i] = 0.f;
        for (int c = 0; c < 144; ++c) {
            int R0;
            if (c < 16) { const int cm = dir ? 15 - c : c; R0 = NLAT + b * 256 + cm * 16; }
            else { const int cc = c - 16; const int cm = dir ? 127 - cc : cc; R0 = b * 2048 + cm * 16; }
            __syncthreads();
            for (int i = tid; i < 16 * 128; i += 512) {
                const int si = i >> 7, k = i & 127; const int row = R0 + (dir ? 15 - si : si);
                const size_t g = ((size_t)dir * NTOK + row) * 512 + h * 128 + k;
                sQ[i] = bf2f(qin[g]); sKo[i] = bf2f(kout[g]);
            }
            { const int si = tid >> 5, vv = tid & 31; const int row = R0 + (dir ? 15 - si : si); sV[tid] = bf2f(pb[(size_t)row * PW + OFF_I + h * 128 + vblk * 32 + vv]); }
            if (tid < 128) sD[tid] = dch[((size_t)dir * NCHUNK + (R0 >> 4)) * 512 + h * 128 + tid];
            __syncthreads();
            {
                const int si = tid >> 5, vv = tid & 31; const int row = R0 + (dir ? 15 - si : si);
                float o = 0.f;
                for (int k = 0; k < 128; ++k) o += sQ[si * 128 + k] * S[k * 32 + vv];
                ointer[((size_t)dir * NTOK + row) * 512 + h * 128 + vblk * 32 + vv] = o;
            }
            __syncthreads();
            {
                const int k = tid >> 2, v0 = (tid & 3) * 8; const float d = sD[k];
                float kk[16];
#pragma unroll
                for (int i = 0; i < 16; ++i) kk[i] = sKo[i * 128 + k];
#pragma unroll
                for (int j = 0; j < 8; ++j) {
                    float s = d * S[k * 32 + v0 + j];
#pragma unroll
                    for (int i = 0; i < 16; ++i) s += kk[i] * sV[i * 32 + v0 + j];
                    S[k * 32 + v0 + j] = s;
                }
            }
        }
    }
}


__device__ __forceinline__ float bflo(unsigned w) { return __uint_as_float(w << 16); }
__device__ __forceinline__ float bfhi(unsigned w) { return __uint_as_float(w & 0xffff0000u); }

template <int DIR>
__device__ __forceinline__ void gla_pre2_dir(const float (&q0a)[16], const float (&q1a)[16], const unsigned (&rz)[16], float lb0, float lb1, unsigned char* wl, unsigned char* rec,
                                             f32x4 (&oT)[8], int lane, int fr, int fq) {
    float bq0[16], bq1[16], kk0[16], kk1[16]; float b0 = 0.f, b1 = 0.f;
#pragma unroll
    for (int i = 0; i < 16; ++i) {
        const int t = DIR ? 15 - i : i;
        const float z0 = bflo(rz[t]), z1 = bfhi(rz[t]);
        const float sg0 = frcp(1.0f + __expf(-z0)), sg1 = frcp(1.0f + __expf(-z1));
        const float f0 = fmaxf(lb0 + (1.0f - lb0) * sg0, 1e-30f), f1 = fmaxf(lb1 + (1.0f - lb1) * sg1, 1e-30f);
        b0 += __logf(f0); b1 += __logf(f1); bq0[t] = b0; bq1[t] = b1; kk0[t] = 1.0f - f0; kk1[t] = 1.0f - f1;
    }
    const float bl0 = b0, bl1 = b1;
    unsigned kw0[8], kw1[8];
#pragma unroll
    for (int i = 0; i < 8; ++i) { kw0[i] = 0u; kw1[i] = 0u; }
#pragma unroll
    for (int t = 0; t < 16; ++t) {
        const float e0 = __expf(bq0[t]), e1 = __expf(bq1[t]);
        const float qi0 = q0a[t] * e0, qi1 = q1a[t] * e1;
        const float kt0 = kk0[t] * frcp(fmaxf(e0, 1.8e-35f)), kt1 = kk1[t] * frcp(fmaxf(e1, 1.8e-35f));
        const float ko0 = kk0[t] * __expf(bl0 - bq0[t]), ko1 = kk1[t] * __expf(bl1 - bq1[t]);
        *(unsigned*)(wl + t * 272 + lane * 4) = cvtpk(qi0, qi1);
        *(unsigned*)(wl + 4352 + t * 272 + lane * 4) = cvtpk(kt0, kt1);
        const unsigned kp = cvtpk(ko0, ko1);
        kw0[t >> 1] |= (kp & 0xffffu) << (16 * (t & 1)); kw1[t >> 1] |= (kp >> 16) << (16 * (t & 1));
    }
    {
        const int c0 = 2 * lane, c1 = c0 + 1;
        unsigned char* k0p = rec + 4096 + (c0 >> 4) * 512 + (c0 & 15) * 8; unsigned char* k1p = rec + 4096 + (c1 >> 4) * 512 + (c1 & 15) * 8;
#pragma unroll
        for (int g = 0; g < 4; ++g) { *(u32x2*)(k0p + g * 128) = (u32x2){kw0[2 * g], kw0[2 * g + 1]}; *(u32x2*)(k1p + g * 128) = (u32x2){kw1[2 * g], kw1[2 * g + 1]}; }
        float* dp = (float*)(rec + 8192) + c0; dp[0] = __expf(bl0); dp[1] = __expf(bl1);
    }
    LDS_WAIT();
#pragma unroll
    for (int s = 0; s < 4; ++s) {
        const u32x2 lo = *(const u32x2*)(wl + fr * 272 + (32 * s + 4 * fq) * 2), hi = *(const u32x2*)(wl + fr * 272 + (32 * s + 16 + 4 * fq) * 2);
        *(u32x4*)(rec + s * 1024 + lane * 16) = (u32x4){lo.x, lo.y, hi.x, hi.y};
    }
    f32x4 at = (f32x4){0.f, 0.f, 0.f, 0.f};
#pragma unroll
    for (int s = 0; s < 4; ++s) {
        const bf16x8 kf = *(const bf16x8*)(wl + 4352 + fr * 272 + (32 * s + 8 * fq) * 2);
        const bf16x8 qf = *(const bf16x8*)(wl + fr * 272 + (32 * s + 8 * fq) * 2);
        at = __builtin_amdgcn_mfma_f32_16x16x32_bf16(kf, qf, at, 0, 0, 0);
    }
#pragma unroll
    for (int r = 0; r < 4; ++r) { const int sp = 4 * fq + r; const bool keep = DIR ? (sp >= fr) : (sp <= fr); at[r] = keep ? at[r] : 0.f; }
    union { u32x2 u; s16x4 h; } bop; bop.u = (u32x2){cvtpk(at[0], at[1]), cvtpk(at[2], at[3])};
#pragma unroll
    for (int vb = 0; vb < 8; ++vb) {
        union { u32x2 u; s16x4 h; } aop; aop.u = *(const u32x2*)(wl + 8704 + (vb * 16 + fr) * 32 + 8 * fq);
        oT[vb] = __builtin_amdgcn_mfma_f32_16x16x16bf16_1k(aop.h, bop.h, oT[vb], 0, 0, 0);
    }
    LDS_WAIT();
}

__device__ __forceinline__ void phase_gla_pre2(const Params& p, int l, unsigned char* lds) {
    const int tid = otid(), lane = tid & 63, wid = __builtin_amdgcn_readfirstlane(tid >> 6), fr = lane & 15, fq = lane >> 4;
    unsigned char* wl = lds + wid * 12800;
    unsigned char* ws = ows(p);
    const bf16_t* pb = (const bf16_t*)(ws + WS_P); bf16_t* ointra = (bf16_t*)(ws + WS_OINTRA);
    float lb[2][2];
    {
        const float* hl = oin(p, 10);
#pragma unroll
        for (int d = 0; d < 2; ++d)
#pragma unroll
            for (int e = 0; e < 2; ++e) {
                const float* q = hl + (size_t)d * 4 * 512 + (2 * lane + e);
                lb[d][e] = 0.f; (void)q;
            }
    }
    for (int unit = wid * (int)gridDim.x + obid(); unit < NCHUNK * 4; unit += gridDim.x * 8) {
        const int chunk = unit >> 2, h = unit & 3, R0 = chunk * 16;
        {
            const float* hl = oin(p, 10);
#pragma unroll
            for (int d = 0; d < 2; ++d)
#pragma unroll
                for (int e = 0; e < 2; ++e) {
                    const float* q = hl + (size_t)d * 4 * 512 + h * 128 + 2 * lane + e;
                    const float z0 = q[0], z1 = q[512], z2 = q[1024], z3 = q[1536];
                    const float mx = fmaxf(fmaxf(z0, z1), fmaxf(z2, z3));
                    const float e0 = __expf(z0 - mx), e1 = __expf(z1 - mx), e2 = __expf(z2 - mx), e3 = __expf(z3 - mx);
                    lb[d][e] = ((l >= 1 ? e1 : 0.f) + (l >= 2 ? e2 : 0.f) + (l >= 3 ? e3 : 0.f)) / (e0 + e1 + e2 + e3);
                }
        }
        unsigned rq[16], rf[16], rb[16], rv[16];
#pragma unroll
        for (int t = 0; t < 16; ++t) {
            const bf16_t* base = pb + (size_t)(R0 + t) * PW + h * 128 + 2 * lane;
            rq[t] = *(const unsigned*)(base + OFF_Q); rf[t] = *(const unsigned*)(base + OFF_ZF); rb[t] = *(const unsigned*)(base + OFF_ZF + 512); rv[t] = *(const unsigned*)(base + OFF_I);
        }
        unsigned char* vrec = ws + WS_VREC + (size_t)(chunk * 4 + h) * VREC_BYTES;
        {
            unsigned w0[8], w1[8];
#pragma unroll
            for (int i = 0; i < 8; ++i) { w0[i] = (rv[2 * i] & 0xffffu) | (rv[2 * i + 1] << 16); w1[i] = (rv[2 * i] >> 16) | (rv[2 * i + 1] & 0xffff0000u); }
            const int c0 = 2 * lane, c1 = c0 + 1;
            unsigned char* v0p = vrec + (c0 >> 4) * 512 + (c0 & 15) * 8; unsigned char* v1p = vrec + (c1 >> 4) * 512 + (c1 & 15) * 8;
#pragma unroll
            for (int g = 0; g < 4; ++g) { *(u32x2*)(v0p + g * 128) = (u32x2){w0[2 * g], w0[2 * g + 1]}; *(u32x2*)(v1p + g * 128) = (u32x2){w1[2 * g], w1[2 * g + 1]}; }
            unsigned char* vl = wl + 8704 + c0 * 32;
            *(u32x4*)(vl) = (u32x4){w0[0], w0[1], w0[2], w0[3]}; *(u32x4*)(vl + 16) = (u32x4){w0[4], w0[5], w0[6], w0[7]};
            *(u32x4*)(vl + 32) = (u32x4){w1[0], w1[1], w1[2], w1[3]}; *(u32x4*)(vl + 48) = (u32x4){w1[4], w1[5], w1[6], w1[7]};
        }
        f32x4 oT[8];
#pragma unroll
        for (int vb = 0; vb < 8; ++vb) oT[vb] = (f32x4){0.f, 0.f, 0.f, 0.f};
        float q0a[16], q1a[16];
#pragma unroll
        for (int t = 0; t < 16; ++t) { q0a[t] = siluf(bflo(rq[t])); q1a[t] = siluf(bfhi(rq[t])); }
        gla_pre2_dir<0>(q0a, q1a, rf, lb[0][0], lb[0][1], wl, ws + WS_GREC + ((size_t)(0 * NCHUNK + chunk) * 4 + h) * REC_BYTES, oT, lane, fr, fq);
        gla_pre2_dir<1>(q0a, q1a, rb, lb[1][0], lb[1][1], wl, ws + WS_GREC + ((size_t)(1 * NCHUNK + chunk) * 4 + h) * REC_BYTES, oT, lane, fr, fq);
#pragma unroll
        for (int vb = 0; vb < 8; ++vb) *(u32x2*)(ointra + (size_t)(R0 + fr) * 512 + h * 128 + vb * 16 + 4 * fq) = (u32x2){cvtpk(oT[vb][0], oT[vb][1]), cvtpk(oT[vb][2], oT[vb][3])};
    }
}

constexpr int GR = 8, STG_BYTES = REC_BYTES + VREC_BYTES;
__device__ __forceinline__ int gla_chunk_of_step(int c, int b, int dir) {
    if (c < 16) { const int cm = dir ? 15 - c : c; return (NLAT + b * 256) / 16 + cm; }
    const int cc = c - 16; const int cm = dir ? 127 - cc : cc; return b * 128 + cm;
}
constexpr int SG_STEP = REC_BYTES + 2048, SG_GRP = 2 * SG_STEP, SG_NG = 6;
constexpr int SG_DUMP = SG_NG * SG_GRP;
constexpr int SG_FLAGS = LDS_MISC + 2048;
constexpr unsigned SG_SPIN = 1u << 22;
static_assert(SG_DUMP + 1024 <= LDS_MISC, "scan ring");
__device__ __forceinline__ void gla_scan_unit(const Params& p, int l, unsigned char* lds_, int chain, int vhalf) {
    LAS unsigned char* lds = (LAS unsigned char*)lds_;
    const int tid = otid(), lane = tid & 63, wid = __builtin_amdgcn_readfirstlane(tid >> 6), fr = lane & 15, fq = lane >> 4;
    unsigned char* ws = ows(p);
    const int b = chain >> 3, h = (chain >> 1) & 3, dir = chain & 1;
    volatile LAS unsigned* flg = (volatile LAS unsigned*)(lds + SG_FLAGS);
    __syncthreads();
    if (tid < 32) flg[tid] = 0u;
    __syncthreads();
    if (wid >= 4) {
        const int m = wid & 3;
        const unsigned char* grec = ws + WS_GREC + (size_t)dir * NCHUNK * 4 * REC_BYTES + (size_t)h * REC_BYTES + lane * 16;
        const unsigned char* vrec = ws + WS_VREC + (size_t)h * VREC_BYTES + vhalf * 2048 + lane * 16;
        const volatile LAS unsigned* dn = flg + 4 + (lane & 3);
#define GSEQ_ISSUE(gi) do { const int _g = (gi); _Pragma("unroll") for (int _j = 0; _j < 6; ++_j) { const int _p = m + 4 * _j; const bool _real = _p < 22; const int _s = _real ? _p / 11 : 0, _q = _real ? _p % 11 : 0; \
        const int _c = 2 * _g + _s; const int _cc = _c < 144 ? _c : 143; const int _ch = gla_chunk_of_step(_cc, b, dir); \
        const unsigned char* _src = (_q < 9) ? grec + (size_t)_ch * 4 * REC_BYTES + _q * 1024 : vrec + (size_t)_ch * 4 * VREC_BYTES + (_q - 9) * 1024; \
        const unsigned _dst = _real ? (unsigned)(_g % SG_NG) * SG_GRP + _s * SG_STEP + _q * 1024 : (unsigned)SG_DUMP; \
        __builtin_amdgcn_global_load_lds((const unsigned*)_src, (LAS unsigned*)(lds + _dst), 16, 0, 0); } } while (0)
#pragma unroll 1
        for (int g = 0; g < SG_NG - 1; ++g) GSEQ_ISSUE(g);
#pragma unroll 1
        for (int g = 0; g < 72; ++g) {
            asm volatile("s_waitcnt vmcnt(%0)" :: "n"((SG_NG - 2) * 6) : "memory");
            if (lane == 0) flg[m] = (unsigned)(g + 1);
            { unsigned sp = 0; while (__builtin_amdgcn_ballot_w64(*dn < (unsigned)g) != 0ull && ++sp < SG_SPIN) __builtin_amdgcn_s_sleep(1); asm volatile("" ::: "memory"); }
            GSEQ_ISSUE(g + SG_NG - 1);
        }
#undef GSEQ_ISSUE
    } else {
        const int vt = wid;
        bf16_t* ointer = (bf16_t*)(ws + WS_OINTER) + (size_t)dir * NTOK * 512 + h * 128 + (vhalf * 4 + vt) * 16 + fr;
        const volatile LAS unsigned* fl = flg + (lane & 3);
        f32x4 acc[8];
#pragma unroll
        for (int j = 0; j < 8; ++j) acc[j] = (f32x4){0.f, 0.f, 0.f, 0.f};
        union { u32x4 u; bf16x8 h; } sb[4];
#pragma unroll
        for (int j = 0; j < 4; ++j) sb[j].u = (u32x4){0u, 0u, 0u, 0u};
#pragma unroll 1
        for (int g = 0; g < 72; ++g) {
            { unsigned sp = 0; while (__builtin_amdgcn_ballot_w64(*fl < (unsigned)(g + 1)) != 0ull && ++sp < SG_SPIN) { } asm volatile("" ::: "memory"); }
#pragma unroll
            for (int s2 = 0; s2 < 2; ++s2) {
                const int c = 2 * g + s2;
                const LAS unsigned char* st = lds + (unsigned)(g % SG_NG) * SG_GRP + s2 * SG_STEP;
                const int chunk = gla_chunk_of_step(c, b, dir);
                bf16x8 qa[4]; f32x4 dv[8];
                union { u32x2 u; s16x4 h; } ka[8], vb;
#pragma unroll
                for (int j = 0; j < 4; ++j) qa[j] = *(const LAS bf16x8*)(st + j * 1024 + lane * 16);
                vb.u = *(const LAS u32x2*)(st + REC_BYTES + vt * 512 + lane * 8);
#pragma unroll
                for (int j = 0; j < 8; ++j) { ka[j].u = *(const LAS u32x2*)(st + 4096 + j * 512 + lane * 8); dv[j] = *(const LAS f32x4*)(st + 8192 + (j * 16 + 4 * fq) * 4); }
                f32x4 o0 = (f32x4){0.f, 0.f, 0.f, 0.f}, o1 = (f32x4){0.f, 0.f, 0.f, 0.f};
                o0 = __builtin_amdgcn_mfma_f32_16x16x32_bf16(qa[0], sb[0].h, o0, 0, 0, 0); o1 = __builtin_amdgcn_mfma_f32_16x16x32_bf16(qa[1], sb[1].h, o1, 0, 0, 0);
                o0 = __builtin_amdgcn_mfma_f32_16x16x32_bf16(qa[2], sb[2].h, o0, 0, 0, 0); o1 = __builtin_amdgcn_mfma_f32_16x16x32_bf16(qa[3], sb[3].h, o1, 0, 0, 0);
#pragma unroll
                for (int j = 0; j < 8; ++j) {
                    acc[j] = acc[j] * dv[j];
                    acc[j] = __builtin_amdgcn_mfma_f32_16x16x16bf16_1k(ka[j].h, vb.h, acc[j], 0, 0, 0);
                }
                const f32x4 os = o0 + o1;
                bf16_t* op = ointer + (size_t)(chunk * 16 + 4 * fq) * 512;
                { const unsigned w01 = cvtpk(os[0], os[1]), w23 = cvtpk(os[2], os[3]); op[0] = (bf16_t)(w01 & 0xffffu); op[512] = (bf16_t)(w01 >> 16); op[1024] = (bf16_t)(w23 & 0xffffu); op[1536] = (bf16_t)(w23 >> 16); }
#pragma unroll
                for (int j = 0; j < 4; ++j) sb[j].u = (u32x4){cvtpk(acc[2 * j][0], acc[2 * j][1]), cvtpk(acc[2 * j][2], acc[2 * j][3]), cvtpk(acc[2 * j + 1][0], acc[2 * j + 1][1]), cvtpk(acc[2 * j + 1][2], acc[2 * j + 1][3])};
            }
            asm volatile("s_waitcnt lgkmcnt(0)" ::: "memory");
            if (lane == 0) flg[4 + wid] = (unsigned)(g + 1);
        }
    }
    asm volatile("s_waitcnt vmcnt(0) lgkmcnt(0)" ::: "memory");
    __syncthreads();
}
__device__ __forceinline__ void phase_gla_seq2(const Params& p, int l, unsigned char* lds) {
    const int G = (int)gridDim.x, bid = obid();
    const int nscan = (G >= 256) ? 128 : G;
    for (int rep = 0; rep < ((DUPK == 50) ? 2 : 1); ++rep) {
        for (int r2 = 0; r2 < ((DUPK == 51) ? 2 : 1); ++r2)
        if (bid < nscan) for (int u = bid; u < 128; u += nscan) { const int x = u & 7, jj = u >> 3; gla_scan_unit(p, l, lds, x + 8 * (jj >> 1), jj & 1); }
        const int cg0 = (G == 256) ? l * CV_LAYER + CV_B : l * CV_ALL, cg1 = (G == 256) ? l * CV_LAYER + CV_B + CV_S : (l + 1) * CV_ALL;
        for (int r3 = 0; r3 < ((DUPK == 52) ? 2 : 1); ++r3)
        if (G > nscan) { if (bid >= nscan) { const int widx = (bid - nscan) * 8 + (otid() >> 6), nwv = (G - nscan) * 8; conv_rows(p, l, widx, nwv); convert_range(p, (float*)(lds + (otid() >> 6) * 16384), widx, nwv, cg0, cg1); } }
        else { const int widx = bid * 8 + (otid() >> 6), nwv = G * 8; __syncthreads(); conv_rows(p, l, widx, nwv); convert_range(p, (float*)(lds + (otid() >> 6) * 16384), widx, nwv, cg0, cg1); }
    }
}

__device__ __forceinline__ void phase_gla_post(const Params& p, int l) {
    const int lane = otid() & 63, wid = otid() >> 6;
    const bf16_t* pb = (const bf16_t*)(ows(p) + WS_P); bf16_t* yb = (bf16_t*)(ows(p) + WS_Y);
    const bf16_t* oi = (const bf16_t*)(ows(p) + WS_OINTRA); const bf16_t* oe = (const bf16_t*)(ows(p) + WS_OINTER);
    const float* hnw = oin(p, 11) + (size_t)l * 128;
    const int nrows = (l == DEPTH - 1) ? NLAT : NTOK;
    const int c0 = lane * 8;
    for (int r = obid() * 8 + wid; r < nrows; r += gridDim.x * 8) {
        float o[8], t1[8], t2[8]; float ss = 0.f;
        unpack8(*(const u32x4*)(oi + (size_t)r * 512 + c0), o); unpack8(*(const u32x4*)(oe + (size_t)r * 512 + c0), t1); unpack8(*(const u32x4*)(oe + ((size_t)NTOK + r) * 512 + c0), t2);
#pragma unroll
        for (int j = 0; j < 8; ++j) { o[j] += t1[j] + t2[j]; ss += o[j] * o[j]; }
        ss += __shfl_xor(ss, 1); ss += __shfl_xor(ss, 2); ss += __shfl_xor(ss, 4); ss += __shfl_xor(ss, 8);
        const float rstd = rsqrtf(ss * (1.0f / 128.0f) + EPS);
        float g[8]; unpack8(*(const u32x4*)(pb + (size_t)r * PW + OFF_G + c0), g);
        float y[8];
#pragma unroll
        for (int j = 0; j < 8; ++j) y[j] = o[j] * rstd * hnw[(c0 + j) & 127] * siluf(g[j]);
        if (G2_FP8) { u32x2 w8; w8.x = pk4_fp8(8.0f * y[0], 8.0f * y[1], 8.0f * y[2], 8.0f * y[3]); w8.y = pk4_fp8(8.0f * y[4], 8.0f * y[5], 8.0f * y[6], 8.0f * y[7]); *(u32x2*)((unsigned char*)yb + (size_t)r * 1024 + 512 + c0) = w8; }
        else { u32x4 w; w.x = pk2(y[0], y[1]); w.y = pk2(y[2], y[3]); w.z = pk2(y[4], y[5]); w.w = pk2(y[6], y[7]);
        *(u32x4*)(yb + (size_t)r * 1024 + 512 + c0) = w; }
    }
}

__device__ __forceinline__ void phase_gemm2(const Params& p, int l, unsigned char* lds) {
    const bf16_t* yb = (const bf16_t*)(ows(p) + WS_Y); const bf16_t* wt = (const bf16_t*)(ows(p) + WS_WOUT) + (size_t)l * 1024 * 1024;
    float* xws = (float*)(ows(p) + WS_X); const float* modv = (const float*)(ows(p) + WS_MOD);
    const int MT = ((l == DEPTH - 1) ? NLAT : NTOK) / 128; constexpr int NT = 8;
    for (int u = obid(); u < MT * NT; u += gridDim.x) {
        const int mt = u / NT, nt = u % NT;
        ARowPlain ar{yb + (size_t)mt * 128 * 1024, 1024};
        EpiRes ep{xws + (size_t)mt * 128 * 1024 + nt * 128, modv + (size_t)l * 9 * 6144 + 2 * 1024 + nt * 128, mt * 128};
        gemm128(lds, ar, wt + (size_t)nt * 128 * 1024, 1024, ep);
    }
}

__device__ __forceinline__ void phase_router(const Params& p, int l) {
    const int lane = otid() & 63, wid = otid() >> 6;
    const float* xws = (const float*)(ows(p) + WS_X); bf16_t* hb = (bf16_t*)(ows(p) + WS_H);
    const float* modv = (const float*)(ows(p) + WS_MOD); const float* nw = oin(p, 4) + (size_t)(l * 2 + 1) * 1024;
    const float* wrg = oin(p, 13) + (size_t)l * 1024 * 4; const float* wre = oin(p, 15) + (size_t)l * 1024 * 32;
    const float* brg = oin(p, 14) + l * 4; const float* bre = oin(p, 16) + l * 32;
    unsigned* cnt = (unsigned*)(ows(p) + WS_CTL) + CW_CNT + 64 * l;
    int* ltok = (int*)(ows(p) + WS_LTOK); float* lgate = (float*)(ows(p) + WS_LGATE);
    const int nrows = (l == DEPTH - 1) ? NLAT : NTOK;
    for (int r = obid() * 8 + wid; r < nrows; r += gridDim.x * 8) {
        const int mr = mod_row(r);
        float ss = 0.f;
#pragma unroll
        for (int j = 0; j < 4; ++j) { const f32x4 xv4 = *(const f32x4*)(xws + (size_t)r * 1024 + 4 * lane + 256 * j); ss += (xv4[0] * xv4[0] + xv4[1] * xv4[1]) + (xv4[2] * xv4[2] + xv4[3] * xv4[3]); }
        const float rstd = rsqrtf(wave_sum(ss) * (1.0f / 1024.0f) + EPS);
        const float* msh = modv + ((size_t)l * 9 + mr) * 6144 + 3 * 1024; const float* msc = msh + 1024;
        float lg[36];
#pragma unroll
        for (int i = 0; i < 36; ++i) lg[i] = 0.f;
#pragma unroll 1
        for (int j = 0; j < 4; ++j) {
            const int c = 4 * lane + 256 * j;
            const f32x4 xv4 = *(const f32x4*)(xws + (size_t)r * 1024 + c);
            const f32x4 w = *(const f32x4*)(nw + c), sh = *(const f32x4*)(msh + c), sc = *(const f32x4*)(msc + c);
            const f32x4 h = (xv4 * rstd * w) * (1.0f + sc) + sh;
            u32x2 o; o.x = pk2(h[0], h[1]); o.y = pk2(h[2], h[3]);
            *(u32x2*)(hb + (size_t)r * 1024 + c) = o;
#pragma unroll
            for (int e = 0; e < 4; ++e) {
                const float xv = h[e];
                const f32x4 wg = *(const f32x4*)(wrg + (size_t)(c + e) * 4);
                lg[0] += xv * wg[0]; lg[1] += xv * wg[1]; lg[2] += xv * wg[2]; lg[3] += xv * wg[3];
#pragma unroll
                for (int q = 0; q < 8; ++q) {
                    const f32x4 we = *(const f32x4*)(wre + (size_t)(c + e) * 32 + q * 4);
                    lg[4 + q * 4 + 0] += xv * we[0]; lg[4 + q * 4 + 1] += xv * we[1]; lg[4 + q * 4 + 2] += xv * we[2]; lg[4 + q * 4 + 3] += xv * we[3];
                }
            }
        }
#pragma unroll
        for (int i = 0; i < 36; ++i) lg[i] = wave_sum(lg[i]);
        float gl[4];
#pragma unroll
        for (int i = 0; i < 4; ++i) gl[i] = lg[i] + brg[i];
        int gsel = 0; float gmax = gl[0];
#pragma unroll
        for (int i = 1; i < 4; ++i) if (gl[i] > gmax) { gmax = gl[i]; gsel = i; }
        float gs = 0.f;
#pragma unroll
        for (int i = 0; i < 4; ++i) gs += __expf(gl[i] - gmax);
        const float pg = 1.0f / gs;
        float el[8];
#pragma unroll
        for (int j = 0; j < 8; ++j) {
            float t = lg[4 + j] + bre[j];
#pragma unroll
            for (int g = 1; g < 4; ++g) t = (gsel == g) ? (lg[4 + g * 8 + j] + bre[g * 8 + j]) : t;
            el[j] = t;
        }
        int i1 = 0; float v1 = el[0];
#pragma unroll
        for (int j = 1; j < 8; ++j) if (el[j] > v1) { v1 = el[j]; i1 = j; }
        int i2 = -1; float v2 = -3.0e38f;
#pragma unroll
        for (int j = 0; j < 8; ++j) if (j != i1 && el[j] > v2) { v2 = el[j]; i2 = j; }
        const float e2 = __expf(v2 - v1);
        const float g0 = pg / (1.0f + e2), g1 = pg * e2 / (1.0f + e2);
        if (lane == 0) {
            const int ea = gsel * 8 + i1, eb = gsel * 8 + i2;
            const unsigned pa = atomicAdd(cnt + ea, 1u); ltok[(size_t)ea * NTOK + pa] = r * 2 + 0; lgate[(size_t)ea * NTOK + pa] = g0;
            const unsigned pb2 = atomicAdd(cnt + eb, 1u); ltok[(size_t)eb * NTOK + pb2] = r * 2 + 1; lgate[(size_t)eb * NTOK + pb2] = g1;
        }
    }
}


__device__ __forceinline__ void phase_router2(const Params& p, int l, unsigned char* lds, bool commit) {
    const int tid = otid(), lane = tid & 63, wid = __builtin_amdgcn_readfirstlane(tid >> 6), fr = lane & 15, fq = lane >> 4;
    unsigned char* ws = ows(p);
    const bf16_t* xws = (const bf16_t*)(ws + WS_X); bf16_t* xw = (bf16_t*)(ws + WS_X); const bf16_t* dlt = (const bf16_t*)(ws + WS_DELTA); bf16_t* hb = (bf16_t*)(ws + WS_H);
    const float* modv = (const float*)(ws + WS_MOD); const float* nw = oin(p, 4) + (size_t)(l * 2 + 1) * 1024;
    const float* brg = oin(p, 14) + l * 4; const float* bre = oin(p, 16) + l * 32;
    unsigned* gcnt = (unsigned*)(ws + WS_CTL) + CW_CNT + 64 * 32 * l;
    int* ltok = (int*)(ws + WS_LTOK); float* lgate = (float*)(ws + WS_LGATE);
    constexpr int WPITCH = 2064, WBYTES = 48 * WPITCH;
    unsigned char* wl = lds;
    float* tile = (float*)(lds + WBYTES + wid * 3328);
    int* s_cnt = (int*)(lds + WBYTES + 8 * 3328); int* s_base = s_cnt + 32;
    int* s_e = s_base + 32; int* s_rank = s_e + 256; int* s_tok = s_rank + 256; float* s_gate = (float*)(s_tok + 256);
    __syncthreads();
    {
        const bf16_t* wrh = (const bf16_t*)(ws + WS_WRH) + (size_t)l * 48 * 1024;
        for (int i = tid; i < 48 * 128; i += 512) { const int r = i >> 7, c = i & 127; *(u32x4*)(wl + r * WPITCH + c * 16) = *(const u32x4*)(wrh + (size_t)r * 1024 + c * 8); }
    }
    const int NG = ((l == DEPTH - 1) ? NLAT : NTOK) / 16;
    const int NWV = (int)gridDim.x * 8;
    for (int it = 0; it * NWV < NG; ++it) {
        const int g = it * NWV + wid * (int)gridDim.x + obid();
        __syncthreads();
        if (tid < 32) s_cnt[tid] = 0;
        if (tid < 256) s_e[tid] = -1;
        __syncthreads();
        if (g < NG) {
            const int R0 = g * 16, mr = mod_row(R0);
            float my_rstd = 0.f;
#pragma unroll
            for (int rb = 0; rb < 4; ++rb) {
                f32x4 xv[4][4]; u32x2 dl[4][4], xr[4][4];
#pragma unroll
                for (int rr = 0; rr < 4; ++rr)
#pragma unroll
                    for (int j = 0; j < 4; ++j) { xr[rr][j] = *(const u32x2*)(xws + (size_t)(R0 + rb * 4 + rr) * 1024 + 4 * lane + 256 * j); dl[rr][j] = *(const u32x2*)(dlt + (size_t)(R0 + rb * 4 + rr) * 1024 + 4 * lane + 256 * j); }
#pragma unroll
                for (int rr = 0; rr < 4; ++rr) {
#pragma unroll
                    for (int j = 0; j < 4; ++j) xv[rr][j] = unpk4_bf16(xr[rr][j]);
                    if (commit) {
#pragma unroll
                        for (int j = 0; j < 4; ++j) { xv[rr][j] += unpk4_bf16(dl[rr][j]); u32x2 o; o.x = cvtpk(xv[rr][j][0], xv[rr][j][1]); o.y = cvtpk(xv[rr][j][2], xv[rr][j][3]); *(u32x2*)(xw + (size_t)(R0 + rb * 4 + rr) * 1024 + 4 * lane + 256 * j) = o;
                            xv[rr][j] = unpk4_bf16(o); }
                    }
                    float ss = 0.f;
#pragma unroll
                    for (int j = 0; j < 4; ++j) ss += (xv[rr][j][0] * xv[rr][j][0] + xv[rr][j][1] * xv[rr][j][1]) + (xv[rr][j][2] * xv[rr][j][2] + xv[rr][j][3] * xv[rr][j][3]);
                    const float rs = rsqrtf(wave_sum(ss) * (1.0f / 1024.0f) + EPS);
                    my_rstd = (rb * 4 + rr == fr) ? rs : my_rstd;
                }
            }
            asm volatile("s_waitcnt vmcnt(0)" ::: "memory");
            const float* msh = modv + ((size_t)l * 9 + mr) * 6144 + 3 * 1024 + 8 * fq; const float* msc = msh + 1024; const float* nwp = nw + 8 * fq;
            const bf16_t* xrow = xws + (size_t)(R0 + fr) * 1024 + 8 * fq; bf16_t* hrow = hb + (size_t)(R0 + fr) * 1024 + 8 * fq; unsigned char* h8row = ws + WS_H8 + (size_t)(R0 + fr) * 1024 + 8 * fq;
            f32x4 acc[3];
#pragma unroll
            for (int nt = 0; nt < 3; ++nt) acc[nt] = (f32x4){0.f, 0.f, 0.f, 0.f};
#pragma unroll 1
            for (int kq = 0; kq < 4; ++kq) {
                u32x4 xab[8];
#pragma unroll
                for (int u = 0; u < 8; ++u) xab[u] = *(const u32x4*)(xrow + 256 * kq + 32 * u);
#pragma unroll
                for (int u = 0; u < 8; ++u) {
                    const int k = 256 * kq + 32 * u;
                    float hv[8];
                    const f32x4 xaq[2] = {unpk4_bf16((u32x2){xab[u].x, xab[u].y}), unpk4_bf16((u32x2){xab[u].z, xab[u].w})};
#pragma unroll
                    for (int q = 0; q < 2; ++q) {
                        const f32x4 w = *(const f32x4*)(nwp + k + 4 * q), sh = *(const f32x4*)(msh + k + 4 * q), sc = *(const f32x4*)(msc + k + 4 * q);
                        const f32x4 h = (xaq[q] * my_rstd * w) * (1.0f + sc) + sh;
                        hv[4 * q + 0] = h[0]; hv[4 * q + 1] = h[1]; hv[4 * q + 2] = h[2]; hv[4 * q + 3] = h[3];
                    }
                    union { u32x4 u; bf16x8 h; } ah, al;
                    ah.u = (u32x4){cvtpk(hv[0], hv[1]), cvtpk(hv[2], hv[3]), cvtpk(hv[4], hv[5]), cvtpk(hv[6], hv[7])};
                    float lv[8];
#pragma unroll
                    for (int q = 0; q < 4; ++q) { const unsigned w2 = q == 0 ? ah.u.x : q == 1 ? ah.u.y : q == 2 ? ah.u.z : ah.u.w; lv[2 * q] = hv[2 * q] - __uint_as_float(w2 << 16); lv[2 * q + 1] = hv[2 * q + 1] - __uint_as_float(w2 & 0xffff0000u); }
                    al.u = (u32x4){cvtpk(lv[0], lv[1]), cvtpk(lv[2], lv[3]), cvtpk(lv[4], lv[5]), cvtpk(lv[6], lv[7])};
                    if (MOE_FP8) { u32x2 h8; h8.x = pk4_fp8(hv[0], hv[1], hv[2], hv[3]); h8.y = pk4_fp8(hv[4], hv[5], hv[6], hv[7]); *(u32x2*)(h8row + k) = h8; }
                    else *(u32x4*)(hrow + k) = ah.u;
#pragma unroll
                    for (int nt = 0; nt < 3; ++nt) {
                        const bf16x8 bh = *(const bf16x8*)(wl + (nt * 16 + fr) * WPITCH + (k + 8 * fq) * 2);
                        acc[nt] = __builtin_amdgcn_mfma_f32_16x16x32_bf16(ah.h, bh, acc[nt], 0, 0, 0);
                        acc[nt] = __builtin_amdgcn_mfma_f32_16x16x32_bf16(al.h, bh, acc[nt], 0, 0, 0);
                    }
                }
            }
#pragma unroll
            for (int nt = 0; nt < 3; ++nt)
#pragma unroll
                for (int r = 0; r < 4; ++r) tile[(4 * fq + r) * 52 + nt * 16 + fr] = acc[nt][r];
            LDS_WAIT();
            if (lane < 16) {
                const float* lg = tile + lane * 52;
                float gl[4];
#pragma unroll
                for (int i = 0; i < 4; ++i) gl[i] = lg[i] + brg[i];
                int gsel = 0; float gmax = gl[0];
#pragma unroll
                for (int i = 1; i < 4; ++i) if (gl[i] > gmax) { gmax = gl[i]; gsel = i; }
                float gs = 0.f;
#pragma unroll
                for (int i = 0; i < 4; ++i) gs += __expf(gl[i] - gmax);
                const float pg = 1.0f / gs;
                float el[8];
#pragma unroll
                for (int j = 0; j < 8; ++j) el[j] = lg[4 + gsel * 8 + j] + bre[gsel * 8 + j];
                int i1 = 0; float v1 = el[0];
#pragma unroll
                for (int j = 1; j < 8; ++j) if (el[j] > v1) { v1 = el[j]; i1 = j; }
                int i2 = -1; float v2 = -3.0e38f;
#pragma unroll
                for (int j = 0; j < 8; ++j) if (j != i1 && el[j] > v2) { v2 = el[j]; i2 = j; }
                const float e2 = __expf(v2 - v1);
                const float g0 = pg / (1.0f + e2), g1 = pg * e2 / (1.0f + e2);
                const int ea = gsel * 8 + i1, eb = gsel * 8 + i2, slot = (wid * 16 + lane) * 2, r = R0 + lane;
                s_e[slot] = ea; s_rank[slot] = atomicAdd(&s_cnt[ea], 1); s_tok[slot] = r * 2; s_gate[slot] = g0;
                s_e[slot + 1] = eb; s_rank[slot + 1] = atomicAdd(&s_cnt[eb], 1); s_tok[slot + 1] = r * 2 + 1; s_gate[slot + 1] = g1;
            }
        }
        __syncthreads();
        if (tid < 32) { const int c = s_cnt[tid]; s_base[tid] = (c > 0 && commit) ? (int)atomicAdd(gcnt + 64 * tid, (unsigned)c) : 0; }
        __syncthreads();
        if (tid < 256) { const int e = s_e[tid]; if (e >= 0 && commit) { const size_t pos = (size_t)e * NTOK + s_base[e] + s_rank[tid]; ltok[pos] = s_tok[tid]; lgate[pos] = s_gate[tid]; } }
    }
}

__device__ __forceinline__ int moe_tables(const Params& p, int l, unsigned char* lds) {
    int* s_pref = (int*)(lds + LDS_MISC); int* s_cnt = s_pref + 40;
    unsigned* cnt = (unsigned*)(ows(p) + WS_CTL) + CW_CNT + 64 * l;
    __syncthreads();
    if (otid() == 0) {
        int acc = 0;
        for (int e = 0; e < NEXP; ++e) { const int c = (int)__hip_atomic_load(cnt + e, __ATOMIC_RELAXED, __HIP_MEMORY_SCOPE_AGENT); s_cnt[e] = c; s_pref[e] = acc; acc += (c + 127) >> 7; }
        s_pref[NEXP] = acc;
    }
    __syncthreads();
    return s_pref[NEXP];
}
__device__ __forceinline__ void phase_moe_gu(const Params& p, int l, unsigned char* lds) {
    const int T = moe_tables(p, l, lds);
    const int* s_pref = (const int*)(lds + LDS_MISC); const int* s_cnt = s_pref + 40;
    const bf16_t* hb = (const bf16_t*)(ows(p) + WS_H); bf16_t* hid = (bf16_t*)(ows(p) + WS_HID);
    const int* ltok = (const int*)(ows(p) + WS_LTOK);
    for (int u = obid(); u < T * 8; u += gridDim.x) {
        const int mtg = u >> 3, nt = u & 7;
        int e = 0;
        for (int q = 1; q < NEXP; ++q) if (s_pref[q] <= mtg) e = q;
        const int mt = mtg - s_pref[e]; const int nvalid = min(128, s_cnt[e] - mt * 128);
        ARowGather ar{hb, ltok + (size_t)e * NTOK + mt * 128, nvalid};
        EpiGU ep{hid + (size_t)mtg * 128 * 512 + nt * 64};
        gemm128(lds, ar, (const bf16_t*)(ows(p) + WS_WGU) + ((size_t)(l * 32 + e) * 1024 + nt * 128) * 1024, 1024, ep);
    }
}
__device__ __forceinline__ void phase_moe_down(const Params& p, int l, unsigned char* lds) {
    const int T = moe_tables(p, l, lds);
    const int* s_pref = (const int*)(lds + LDS_MISC); const int* s_cnt = s_pref + 40;
    const bf16_t* hid = (const bf16_t*)(ows(p) + WS_HID); bf16_t* yb = (bf16_t*)(ows(p) + WS_YB);
    const int* ltok = (const int*)(ows(p) + WS_LTOK); const float* lgate = (const float*)(ows(p) + WS_LGATE);
    for (int u = obid(); u < T * 8; u += gridDim.x) {
        const int mtg = u >> 3, nt = u & 7;
        int e = 0;
        for (int q = 1; q < NEXP; ++q) if (s_pref[q] <= mtg) e = q;
        const int mt = mtg - s_pref[e]; const int nvalid = min(128, s_cnt[e] - mt * 128);
        ARowPlain ar{hid + (size_t)mtg * 128 * 512, 512};
        EpiDown ep{yb + nt * 128, ltok + (size_t)e * NTOK + mt * 128, lgate + (size_t)e * NTOK + mt * 128, nvalid};
        gemm128(lds, ar, (const bf16_t*)(ows(p) + WS_WDN) + ((size_t)(l * 32 + e) * 1024 + nt * 128) * 512, 512, ep);
    }
}


#ifndef FAST_G1
#define FAST_G1 1
#endif
#ifndef FAST_G2
#define FAST_G2 1
#endif
#ifndef FAST_MOE
#define FAST_MOE 1
#endif
#ifndef FAST_GLA
#define FAST_GLA 1
#endif
#ifndef FAST_RT
#define FAST_RT 1
#endif
__device__ __forceinline__ void phase_gemm1_fast(const Params& p, int l, unsigned char* lds) {
    g8::DenseOrder S; S.init(NTOK / 256, PW / 256, (int)gridDim.x, obid(), (const bf16_t*)(ows(p) + WS_WIN) + (size_t)l * 4096 * 1024, 1024);
    g8::EpiP2 E{(bf16_t*)(ows(p) + WS_P)};
    g8::gemm_phase((LAS unsigned char*)lds, (const char*)(ows(p) + WS_H), 1024, S, E);
    if (gridDim.x == 256 && obid() >= 128) { __syncthreads(); convert_range(p, (float*)(lds + (otid() >> 6) * 16384), (obid() - 128) * 8 + (otid() >> 6), 128 * 8, l * CV_LAYER, l * CV_LAYER + CV_B); }
}
__device__ __forceinline__ void phase_gemm2_fast(const Params& p, int l, unsigned char* lds, float scl) {
    g8::DenseOrder S; g8::EpiDelta E{(bf16_t*)(ows(p) + WS_DELTA), (const float*)(ows(p) + WS_MOD) + (size_t)l * 9 * 6144 + 2 * 1024, scl};
    if (G2_FP8) {
        S.init(((l == DEPTH - 1) ? NLAT : NTOK) / 256, 4, (int)gridDim.x, obid(), ows(p) + WS_WOUT + (size_t)l * 1024 * 1024, 1024, 1);
        g8::gemm_phase8<0x7A7A7A7A, 0x7C7C7C7C>((LAS unsigned char*)lds, (const char*)(ows(p) + WS_Y), 1024, S, E);
    } else {
        S.init(((l == DEPTH - 1) ? NLAT : NTOK) / 256, 4, (int)gridDim.x, obid(), (const bf16_t*)(ows(p) + WS_WOUT) + (size_t)l * 1024 * 1024, 1024);
        g8::gemm_phase((LAS unsigned char*)lds, (const char*)(ows(p) + WS_Y), 1024, S, E);
    }
    if (gridDim.x == 256 && l < DEPTH - 1 && obid() >= 32 && scl != 0.0f) { __syncthreads(); convert_range(p, (float*)(lds + (otid() >> 6) * 16384), (obid() - 32) * 8 + (otid() >> 6), 224 * 8, l * CV_LAYER + CV_B + CV_S, (l + 1) * CV_LAYER); }
}
__device__ __forceinline__ int moe_tables256(const Params& p, int l, unsigned char* lds) {
    int* s_pref = (int*)(lds + LDS_MISC); int* s_cnt = s_pref + 40;
    unsigned* cnt = (unsigned*)(ows(p) + WS_CTL) + CW_CNT + 64 * 32 * l;
    __syncthreads();
    if (otid() == 0) {
        int acc = 0;
        for (int e = 0; e < NEXP; ++e) { const int c = (int)__hip_atomic_load(cnt + 64 * e, __ATOMIC_RELAXED, __HIP_MEMORY_SCOPE_AGENT); s_cnt[e] = c; s_pref[e] = acc; acc += (c + 255) >> 8; }
        s_pref[NEXP] = acc;
    }
    __syncthreads();
    return s_pref[NEXP];
}
__device__ __forceinline__ void moe_setup(const Params& p, int l, unsigned char* lds) {
    const int T = moe_tables256(p, l, lds);
    const int* s_pref = (const int*)(lds + LDS_MISC); const int* s_cnt = s_pref + 40;
    int* utab = (int*)(lds + g8::MOE_UTAB); int* rtok = (int*)(lds + g8::MOE_RTOK); float* rgate = (float*)(lds + g8::MOE_RGATE);
    const int tid = otid(), G = (int)gridDim.x, c = obid();
    if (tid < 4) {
        const int L = tid * G + c; int* t = utab + tid * 8;
        if (L < T * 4) {
            const int mtg = L >> 2; int e = 0;
            for (int q = 1; q < NEXP; ++q) if (s_pref[q] <= mtg) e = q;
            const int mt = mtg - s_pref[e];
            t[0] = mtg; t[1] = L & 3; t[2] = e; t[3] = min(256, s_cnt[e] - mt * 256); t[4] = e * NTOK + mt * 256; t[5] = 1;
        } else { int z = 0; asm volatile("" : "+v"(z)); t[0] = z; t[1] = z; t[2] = z; t[3] = z; t[4] = z; t[5] = z; }
    }
    __syncthreads();
    const int* ltok = (const int*)(ows(p) + WS_LTOK); const float* lgate = (const float*)(ows(p) + WS_LGATE);
    for (int idx = tid; idx < 1024; idx += 512) {
        const int i = idx >> 8, r = idx & 255; const int* t = utab + i * 8;
        const bool ok = t[5] != 0 && r < t[3];
        rtok[idx] = ok ? ltok[t[4] + r] : 0; rgate[idx] = ok ? lgate[t[4] + r] : 0.f;
    }
    __syncthreads();
}
__device__ __forceinline__ void phase_moe_gu_fast(const Params& p, int l, unsigned char* lds) {
    moe_setup(p, l, lds);
    g8::MoeOrder<true> S; S.utab = (const int*)(lds + g8::MOE_UTAB); S.rtok = (const int*)(lds + g8::MOE_RTOK); S.K = 1024;
    if (MOE_FP8) {
        S.W = (const char*)(ows(p) + WS_WGU8) + (size_t)l * 32 * 1024 * 1024; S.bpe = 1;
        g8::EpiGU8 E{ows(p) + WS_HID8};
        g8::gemm_phase8<0x7A7A7A7A, 0x7F7F7F7F>((LAS unsigned char*)lds, (const char*)(ows(p) + WS_H8), 1024, S, E);
    } else {
        S.W = (const char*)(ows(p) + WS_WGU) + (size_t)l * 32 * 1024 * 1024 * 2; S.bpe = 2;
        g8::EpiGU2 E{(bf16_t*)(ows(p) + WS_HID)};
        g8::gemm_phase((LAS unsigned char*)lds, (const char*)(ows(p) + WS_H), 1024, S, E);
    }
}
__device__ __forceinline__ void phase_moe_down_fast(const Params& p, int l, unsigned char* lds) {
    if (!(FAST_MOE && MOE_FP8) || DUPK == 10 || p.ph_hi - p.ph_lo == 1) moe_setup(p, l, lds);
    g8::MoeOrder<false> S; S.utab = (const int*)(lds + g8::MOE_UTAB); S.rtok = (const int*)(lds + g8::MOE_RTOK); S.K = 512;
    g8::EpiDown2 E{(bf16_t*)(ows(p) + WS_YB), (const int*)(lds + g8::MOE_RTOK), (const float*)(lds + g8::MOE_RGATE)};
    if (MOE_FP8) {
        S.W = (const char*)(ows(p) + WS_WDN8) + (size_t)l * 32 * 1024 * 512; S.bpe = 1;
        g8::EpiDown8 E8{ows(p) + WS_YB8, (const int*)(lds + g8::MOE_RTOK), (const float*)(lds + g8::MOE_RGATE)};
        g8::gemm_phase8<0x7B7B7B7B, 0x7E7E7E7E>((LAS unsigned char*)lds, (const char*)(ows(p) + WS_HID8), 512, S, E8);
    } else {
        S.W = (const char*)(ows(p) + WS_WDN) + (size_t)l * 32 * 1024 * 512 * 2; S.bpe = 2;
        g8::gemm_phase((LAS unsigned char*)lds, (const char*)(ows(p) + WS_HID), 512, S, E);
    }
}

__device__ __forceinline__ void phase_c(const Params& p, int l, unsigned char* lds) {
    phase_gla_pre2(p, l, lds);
}

__global__ void __launch_bounds__(512, 2) mk(Params p) {
    extern __shared__ __attribute__((aligned(16))) unsigned char lds[];
    const int lo = p.ph_lo, hi = p.ph_hi;
    volatile LAS unsigned* misc = (volatile LAS unsigned*)(lds + LDS_MISC + 1024);
    if (threadIdx.x < 4) misc[threadIdx.x] = 0u;
    __syncthreads();
    XcdBarrier bar; bar.bar = (unsigned*)(p.ws + WS_CTL) + CW_BAR; bar.x = 0; bar.st = misc;
    if (hi - lo > 1) bar = xcd_barrier_post((unsigned*)(p.ws + WS_CTL) + CW_BAR, misc);
#define IN(k) (lo <= (k) && (k) < hi)
#define SEAM(k) do { if (IN((k) + 1)) { xcd_barrier(bar); if (DUPK == 20) xcd_barrier(bar); } } while (0)
#define REP(kind) for (int _rep = 0; _rep < ((DUPK == (kind)) ? 2 : 1); ++_rep)
    if (IN(0)) { REP(0) phase_prologue(p, lds); SEAM(0); }
    if (IN(1)) { REP(1) phase_modreduce(p); SEAM(1); }
    for (int l = 0; l < DEPTH; ++l) {
        const int pb = 2 + 9 * l;
        if (IN(pb + 0)) { if (DUPK == 2) phase_norm1(p, l, (float)(lo > 1000)); phase_norm1(p, l, 1.0f); SEAM(pb + 0); }
        if (IN(pb + 1)) { REP(3) { if (FAST_G1) phase_gemm1_fast(p, l, lds); else phase_gemm1(p, l, lds); } SEAM(pb + 1); }
        if (IN(pb + 2)) { REP(4) { phase_c(p, l, lds); } SEAM(pb + 2); }
        if (IN(pb + 3)) { REP(5) { phase_gla_seq2(p, l, lds); } SEAM(pb + 3); }
        if (IN(pb + 4)) { REP(6) phase_gla_post(p, l); SEAM(pb + 4); }
        if (IN(pb + 5)) { if (DUPK == 7) phase_gemm2_fast(p, l, lds, (float)(lo > 1000)); phase_gemm2_fast(p, l, lds, 1.0f); SEAM(pb + 5); }
        if (IN(pb + 6)) { if (DUPK == 8) phase_router2(p, l, lds, lo > 1000); phase_router2(p, l, lds, true); SEAM(pb + 6); }
        if (IN(pb + 7)) { REP(9) { if (FAST_MOE) phase_moe_gu_fast(p, l, lds); else phase_moe_gu(p, l, lds); } SEAM(pb + 7); }
        if (IN(pb + 8)) { REP(10) { if (FAST_MOE) phase_moe_down_fast(p, l, lds); else phase_moe_down(p, l, lds); } SEAM(pb + 8); }
    }
    if (IN(NPH - 1)) { REP(11) phase_final(p); }
#undef IN
#undef SEAM
}

#ifndef MK_LAUNCHES
#define MK_LAUNCHES 1
#endif
extern "C" void kernel_launch(void* const* d_in, const int* in_sizes, int n_in, void* d_out, int out_size, void* d_ws, size_t ws_size, hipStream_t stream) {
    static int grid = 0;
    if (grid == 0) {
        int dev = 0, cus = 0;
        if (n_in != 20 || ws_size < WS_END) { fprintf(stderr, "kernel_launch: unexpected shapes (n_in %d, ws %zu < %zu)\n", n_in, ws_size, (size_t)WS_END); grid = -1; return; }
        if (hipGetDevice(&dev) != hipSuccess || hipDeviceGetAttribute(&cus, hipDeviceAttributeMultiprocessorCount, dev) != hipSuccess) { grid = -1; return; }
        if (hipFuncSetAttribute((const void*)mk, hipFuncAttributeMaxDynamicSharedMemorySize, LDS_BYTES) != hipSuccess) { fprintf(stderr, "kernel_launch: hipFuncSetAttribute failed\n"); grid = -1; return; }
        (void)hipGetLastError();
        grid = cus;
    }
    if (grid < 0) return;
    (void)hipMemsetAsync((char*)d_ws + WS_CTL, 0, CTL_BYTES, stream);
    Params p{};
    for (int i = 0; i < 20; ++i) p.in[i] = (const float*)d_in[i];
    p.out = (float*)d_out; p.ws = (unsigned char*)d_ws;
    if (MK_LAUNCHES == 1) { p.ph_lo = 0; p.ph_hi = NPH; hipLaunchKernelGGL(mk, dim3(grid), dim3(512), LDS_BYTES, stream, p); }
    else for (int ph = 0; ph < NPH; ++ph) { p.ph_lo = ph; p.ph_hi = ph + 1; hipLaunchKernelGGL(mk, dim3(grid), dim3(512), LDS_BYTES, stream, p); }
}
```

```cpp
#include <hip/hip_runtime.h>
#include <stdint.h>
#include <stdio.h>

typedef unsigned short bf16_t;
typedef short bf16x8 __attribute__((ext_vector_type(8)));
typedef float f32x4 __attribute__((ext_vector_type(4)));
typedef unsigned u32x4 __attribute__((ext_vector_type(4)));
typedef unsigned u32x2 __attribute__((ext_vector_type(2)));
typedef int i32x8 __attribute__((ext_vector_type(8)));
typedef int i32x4 __attribute__((ext_vector_type(4)));
typedef short s16x4 __attribute__((ext_vector_type(4)));
typedef float f32x2 __attribute__((ext_vector_type(2)));
#define LAS __attribute__((address_space(3)))
#define GAS __attribute__((address_space(1)))

#ifndef G2_FP8
#define G2_FP8 1
#endif
#ifndef DUPK
#define DUPK -1
#endif
#ifndef MOE_FP8
#define MOE_FP8 1
#endif
constexpr int D = 1024, NB = 8, SEQ = 2048, DEPTH = 4, CTXL = 256;
constexpr int NLAT = NB * SEQ, NCTX = NB * CTXL, NTOK = NLAT + NCTX;
constexpr int PW = 4096;
constexpr int OFF_B = 0, OFF_C = 512, OFF_HV = 1024, OFF_Q = 1536, OFF_ZF = 2048, OFF_I = 3072, OFF_G = 3584;
constexpr int NEXP = 32;
constexpr int NCHUNK = NTOK / 16;
constexpr float EPS = 1e-6f;
constexpr int NMODP = 16;
constexpr int CV_ALL = 32 * (16 * 32 + 8 * 32), CV_B = 128 * 8 * 7, CV_F = 224 * 8 * 6;
constexpr int CV_S = (4 * CV_ALL - 4 * CV_B - 3 * CV_F) / 4, CV_LAYER = CV_B + CV_S + CV_F;
static_assert(4 * CV_B + 4 * CV_S + 3 * CV_F == 4 * CV_ALL, "conversion schedule");
static_assert(CV_LAYER >= CV_ALL && 3 * CV_LAYER + CV_B + CV_S == 4 * CV_ALL, "conversion schedule");

constexpr size_t WS_CTL = 0, CTL_BYTES = 65536;
constexpr size_t WS_WIN = WS_CTL + CTL_BYTES;
constexpr size_t WS_WOUT = WS_WIN + (size_t)4 * 4096 * 1024 * 2;
constexpr size_t WS_WGU = WS_WOUT + (size_t)4 * 1024 * 1024 * 2;
constexpr size_t WS_WDN = WS_WGU + (size_t)4 * 32 * 1024 * 1024 * 2;
constexpr size_t WS_MODP = WS_WDN + (size_t)4 * 32 * 1024 * 512 * 2;
constexpr size_t WS_MOD = WS_MODP + (size_t)4 * NMODP * 9 * 6144 * 4;
constexpr size_t WS_X = WS_MOD + (size_t)4 * 9 * 6144 * 4;
constexpr size_t WS_H = WS_X + (size_t)NTOK * 1024 * 4;
constexpr size_t WS_P = WS_H + (size_t)NTOK * 1024 * 2;
constexpr size_t WS_Y = WS_P + (size_t)NTOK * 4096 * 2;
constexpr size_t WS_QIN = WS_Y + (size_t)NTOK * 1024 * 2;
constexpr size_t WS_KOUT = WS_QIN + (size_t)2 * NTOK * 512 * 2;
constexpr size_t WS_DCH = WS_KOUT + (size_t)2 * NTOK * 512 * 2;
constexpr size_t WS_OINTRA = WS_DCH + (size_t)2 * NCHUNK * 512 * 4;
constexpr size_t WS_OINTER = WS_OINTRA + (size_t)NTOK * 512 * 4;
constexpr size_t WS_LTOK = WS_OINTER + (size_t)2 * NTOK * 512 * 4;
constexpr size_t WS_LGATE = WS_LTOK + (size_t)32 * NTOK * 4;
constexpr int HID_ROWS = 2 * NTOK + 32 * 256;
constexpr size_t WS_HID = WS_LGATE + (size_t)32 * NTOK * 4;
constexpr size_t WS_YB = WS_HID + (size_t)HID_ROWS * 512 * 2;
constexpr int REC_BYTES = 9216, VREC_BYTES = 4096;
constexpr size_t WS_GREC = WS_YB + (size_t)2 * NTOK * 1024 * 2;
constexpr size_t WS_VREC = WS_GREC + (size_t)2 * NCHUNK * 4 * REC_BYTES;
constexpr size_t WS_WRH = WS_VREC + (size_t)NCHUNK * 4 * VREC_BYTES;
constexpr size_t WS_WRL = WS_WRH + (size_t)4 * 48 * 1024 * 2;
constexpr size_t WS_H8 = WS_WRL + (size_t)4 * 48 * 1024 * 2;
constexpr size_t WS_HID8 = WS_H8 + (size_t)NTOK * 1024;
constexpr size_t WS_WGU8 = WS_HID8 + (size_t)HID_ROWS * 512;
constexpr size_t WS_WDN8 = WS_WGU8 + (size_t)4 * 32 * 1024 * 1024;
constexpr size_t WS_YB8 = WS_WDN8 + (size_t)4 * 32 * 1024 * 512;
constexpr size_t WS_DELTA = WS_YB8 + (size_t)2 * NTOK * 1024;
constexpr size_t WS_END = WS_DELTA + (size_t)NTOK * 1024 * 2;
constexpr int CW_BAR = 0;
constexpr int CW_CNT = 8192;

constexpr int LDS_BYTES = 147456;
constexpr int LDS_MISC = 143360;
constexpr int NPH = 2 + 9 * DEPTH + 1;

__device__ __forceinline__ float bf2f(bf16_t b) { return __uint_as_float(((unsigned)b) << 16); }
__device__ __forceinline__ unsigned f2bf(float f) { unsigned u = __float_as_uint(f); return (u + 0x7fffu + ((u >> 16) & 1u)) >> 16; }
__device__ __forceinline__ unsigned pk2(float lo, float hi) { return f2bf(lo) | (f2bf(hi) << 16); }
__device__ __forceinline__ float wave_sum(float v) {
#pragma unroll
    for (int o = 1; o < 64; o <<= 1) v += __shfl_xor(v, o);
    return v;
}
__device__ __forceinline__ float frcp(float x) { return __builtin_amdgcn_rcpf(x); }
__device__ __forceinline__ float sigmoidf(float x) { return frcp(1.0f + __expf(-x)); }
__device__ __forceinline__ float siluf(float x) { return x * frcp(1.0f + __expf(-x)); }
__device__ __forceinline__ float clamp8(float v) { return __builtin_amdgcn_fmed3f(v, -416.0f, 416.0f); }
__device__ __forceinline__ unsigned pk4_fp8_raw(float a, float b, float c, float d) { int r = __builtin_amdgcn_cvt_pk_fp8_f32(a, b, 0, false); r = __builtin_amdgcn_cvt_pk_fp8_f32(c, d, r, true); return (unsigned)r; }
__device__ __forceinline__ unsigned pk4_fp8(float a, float b, float c, float d) { int r = __builtin_amdgcn_cvt_pk_fp8_f32(clamp8(a), clamp8(b), 0, false); r = __builtin_amdgcn_cvt_pk_fp8_f32(clamp8(c), clamp8(d), r, true); return (unsigned)r; }
__device__ __forceinline__ f32x4 unpk4_fp8(unsigned w) { const f32x2 lo = __builtin_amdgcn_cvt_pk_f32_fp8((int)w, false), hi = __builtin_amdgcn_cvt_pk_f32_fp8((int)w, true); return (f32x4){lo.x, lo.y, hi.x, hi.y}; }
typedef __bf16 bf16x2_t __attribute__((ext_vector_type(2)));
__device__ __forceinline__ f32x4 unpk4_bf16(u32x2 w) { return (f32x4){__uint_as_float(w.x << 16), __uint_as_float(w.x & 0xffff0000u), __uint_as_float(w.y << 16), __uint_as_float(w.y & 0xffff0000u)}; }
__device__ __forceinline__ unsigned cvtpk(float lo, float hi) { const f32x2 v = {lo, hi}; const bf16x2_t r = __builtin_convertvector(v, bf16x2_t); return __builtin_bit_cast(unsigned, r); }
__device__ __forceinline__ int mod_row(int r) { return r < NLAT ? (r >> 11) : 8; }
#define LDS_WAIT() asm volatile("s_waitcnt lgkmcnt(0)" ::: "memory")
__device__ __forceinline__ int otid() { int t = threadIdx.x; asm volatile("" : "+v"(t)); return t; }
__device__ __forceinline__ int obid() { int b = blockIdx.x; asm volatile("" : "+s"(b)); return b; }

#define XB_TMO      128
#define XB_XCNT(j)  (256  + 64 * (j))
#define XB_XSUB(j)  (1280 + 64 * (j))
#define XB_XGEN(j)  (2304 + 64 * (j))
#define XB_TOP      3328
#define XB_TOPGEN   3392
#define XCD_BAR_WORDS 3456
#define XB_SPIN_CAP (1u << 18)
__device__ __forceinline__ unsigned xb_ld(unsigned* p)              { return __hip_atomic_load(p, __ATOMIC_RELAXED, __HIP_MEMORY_SCOPE_AGENT); }
__device__ __forceinline__ unsigned xb_add(unsigned* p, unsigned v) { return __hip_atomic_fetch_add(p, v, __ATOMIC_RELAXED, __HIP_MEMORY_SCOPE_AGENT); }
__device__ __forceinline__ unsigned xb_xcc_id() { return (unsigned)__builtin_amdgcn_s_getreg((3 << 11) | 20) & 0xFu; }
#define XB_SPIN(cond, bar) do { unsigned _sp = 0; while (cond) { __builtin_amdgcn_s_sleep(1); \
    if ((++_sp & 255u) == 0u) { if (xb_ld(&(bar)[XB_TMO])) break; if (_sp > XB_SPIN_CAP) { atomicAdd(&(bar)[XB_TMO], 1u); break; } } } } while (0)
struct XcdBarrier { unsigned* bar; unsigned x; volatile LAS unsigned* st; };
__device__ __forceinline__ XcdBarrier xcd_barrier_post(unsigned* bar, volatile LAS unsigned* st) {
    XcdBarrier b; b.bar = bar; b.x = xb_xcc_id(); b.st = st;
    if (threadIdx.x == 0) (void)xb_add(&bar[XB_XCNT(b.x)], 1u);
    return b;
}
__device__ __forceinline__ void xcd_barrier_complete(unsigned* bar, unsigned x, unsigned& nloc, unsigned& nx) {
    const unsigned G = gridDim.x * gridDim.y * gridDim.z;
    unsigned sum, cnt, mine, sp = 0u;
    for (;;) {
        sum = 0u; cnt = 0u; mine = 0u;
#pragma unroll
        for (unsigned j = 0; j < 16; ++j) { const unsigned c = xb_ld(&bar[XB_XCNT(j)]); sum += c; cnt += (c > 0u) ? 1u : 0u; mine = (j == x) ? c : mine; }
        if (sum == G) break;
        __builtin_amdgcn_s_sleep(1);
        if ((++sp & 255u) == 0u) { if (xb_ld(&bar[XB_TMO])) break; if (sp > XB_SPIN_CAP) { atomicAdd(&bar[XB_TMO], 1u); break; } }
    }
    nloc = mine > 0u ? mine : 1u; nx = cnt > 0u ? cnt : 1u;
}
__device__ __forceinline__ void xcd_barrier(const XcdBarrier& b) {
    asm volatile("s_waitcnt vmcnt(0)" ::: "memory");
    __syncthreads();
    if (threadIdx.x == 0) {
        unsigned* bar = b.bar;
        __builtin_amdgcn_s_waitcnt(0);
        unsigned nloc = b.st[0], nx = b.st[1];
        if (nloc == 0u) { xcd_barrier_complete(bar, b.x, nloc, nx); b.st[0] = nloc; b.st[1] = nx; }
        const unsigned old = xb_add(&bar[XB_XSUB(b.x)], 1u);
        const unsigned gen = old / nloc;
        if (old + 1u == (gen + 1u) * nloc) {
            __builtin_amdgcn_fence(__ATOMIC_RELEASE, "agent");
            asm volatile("s_waitcnt vmcnt(0)" ::: "memory");
            const unsigned og = xb_add(&bar[XB_TOP], 1u);
            const unsigned tg = og / nx;
            if (og + 1u == (tg + 1u) * nx) xb_add(&bar[XB_TOPGEN], 1u);
            else XB_SPIN(xb_ld(&bar[XB_TOPGEN]) == tg, bar);
            __builtin_amdgcn_fence(__ATOMIC_ACQUIRE, "agent");
            xb_add(&bar[XB_XGEN(b.x)], 1u);
            asm volatile("s_waitcnt vmcnt(0)" ::: "memory");
        } else {
            XB_SPIN(xb_ld(&bar[XB_XGEN(b.x)]) == gen, bar);
            __builtin_amdgcn_fence(__ATOMIC_ACQUIRE, "agent");
            asm volatile("s_waitcnt vmcnt(0)" ::: "memory");
        }
    }
    __syncthreads();
}

struct Params {
    const float* in[20];
    float* out;
    unsigned char* ws;
    int ph_lo, ph_hi;
};

__device__ __forceinline__ unsigned char* ows(const Params& p) { GAS unsigned char* w = (GAS unsigned char*)p.ws; asm volatile("" : "+s"(w)); return (unsigned char*)w; }
__device__ __forceinline__ const float* oin(const Params& p, int k) { const GAS float* q = (const GAS float*)p.in[k]; asm volatile("" : "+s"(q)); return (const float*)q; }

template <class ARow, class Epi>
__device__ __forceinline__ void gemm128(unsigned char* lds, const ARow& arow, const bf16_t* __restrict__ Bt, int K, const Epi& epi) {
    const int tid = otid(), lane = tid & 63, wid = tid >> 6, wr = wid >> 2, wc = wid & 3, fr = lane & 15, fq = lane >> 4;
    bf16_t* sA = (bf16_t*)lds;
    bf16_t* sB = (bf16_t*)(lds + 128 * 144);
    f32x4 acc[4][2];
#pragma unroll
    for (int m = 0; m < 4; ++m)
#pragma unroll
        for (int n = 0; n < 2; ++n) acc[m][n] = (f32x4){0.f, 0.f, 0.f, 0.f};
    const bf16_t* ap[2]; const bf16_t* bp[2]; int so[2];
#pragma unroll
    for (int i = 0; i < 2; ++i) {
        const int q = tid + 512 * i, row = q >> 3, seg = q & 7;
        ap[i] = arow(row) + seg * 8; bp[i] = Bt + (size_t)row * K + seg * 8; so[i] = row * 72 + seg * 8;
    }
    for (int k0 = 0; k0 < K; k0 += 64) {
        u32x4 va[2], vb[2];
#pragma unroll
        for (int i = 0; i < 2; ++i) { va[i] = *(const u32x4*)(ap[i] + k0); vb[i] = *(const u32x4*)(bp[i] + k0); }
        __syncthreads();
#pragma unroll
        for (int i = 0; i < 2; ++i) { *(u32x4*)(sA + so[i]) = va[i]; *(u32x4*)(sB + so[i]) = vb[i]; }
        __syncthreads();
#pragma unroll
        for (int kk = 0; kk < 2; ++kk) {
            bf16x8 a[4], b[2];
#pragma unroll
            for (int m = 0; m < 4; ++m) a[m] = *(const bf16x8*)(sA + (wr * 64 + m * 16 + fr) * 72 + kk * 32 + fq * 8);
#pragma unroll
            for (int n = 0; n < 2; ++n) b[n] = *(const bf16x8*)(sB + (wc * 32 + n * 16 + fr) * 72 + kk * 32 + fq * 8);
#pragma unroll
            for (int m = 0; m < 4; ++m)
#pragma unroll
                for (int n = 0; n < 2; ++n) acc[m][n] = __builtin_amdgcn_mfma_f32_16x16x32_bf16(b[n], a[m], acc[m][n], 0, 0, 0);
        }
    }
#pragma unroll
    for (int m = 0; m < 4; ++m)
#pragma unroll
        for (int n = 0; n < 2; ++n) epi(wr * 64 + m * 16 + fr, wc * 32 + n * 16 + fq * 4, acc[m][n]);
    __syncthreads();
}

struct ARowPlain { const bf16_t* A; int ld; __device__ __forceinline__ const bf16_t* operator()(int i) const { return A + (size_t)i * ld; } };
struct ARowGather { const bf16_t* A; const int* tok; int nvalid; __device__ __forceinline__ const bf16_t* operator()(int i) const { const int t = (i < nvalid) ? (tok[i] >> 1) : 0; return A + (size_t)t * 1024; } };

struct EpiP { bf16_t* P; __device__ __forceinline__ void operator()(int r, int c, f32x4 v) const {
    u32x2 w; w.x = pk2(v[0], v[1]); w.y = pk2(v[2], v[3]); *(u32x2*)(P + (size_t)r * PW + c) = w; } };
struct EpiRes { float* X; const float* gate; int m0; __device__ __forceinline__ void operator()(int r, int c, f32x4 v) const {
    const float* g = gate + (size_t)mod_row(m0 + r) * 6144 + c; float* xp = X + (size_t)r * 1024 + c;
    f32x4 x = *(f32x4*)xp; const f32x4 gv = *(const f32x4*)g; x += gv * v; *(f32x4*)xp = x; } };
struct EpiGU { bf16_t* H; __device__ __forceinline__ void operator()(int r, int c, f32x4 v) const {
    const float h0 = siluf(v[0]) * v[1], h1 = siluf(v[2]) * v[3]; *(unsigned*)(H + (size_t)r * 512 + (c >> 1)) = pk2(h0, h1); } };
struct EpiDown { bf16_t* YB; const int* tok; const float* gate; int nvalid; __device__ __forceinline__ void operator()(int r, int c, f32x4 v) const {
    if (r < nvalid) { const int e = tok[r]; const float g = gate[r]; u32x2 w; w.x = pk2(g * v[0], g * v[1]); w.y = pk2(g * v[2], g * v[3]); *(u32x2*)(YB + (size_t)e * 1024 + c) = w; } } };


namespace g8 {
constexpr int BM = 256, BK = 64, HALF = 128, HTB = HALF * BK * 2, NXCD = 8, WGM = 8;
__device__ __forceinline__ int lds_byte(int r, int c) { const int st = (r >> 4) * 2 + (c >> 5), rr = r & 15, cc = c & 31, ob = rr * 64 + cc * 2; return st * 1024 + (ob ^ (((ob >> 9) & 1) << 5)); }
__device__ __forceinline__ void stage_rc(int b, int& R, int& C) { const int st = b / 1024, sb = b % 1024, swz = sb ^ (((sb >> 9) & 1) << 5); R = (st >> 1) * 16 + swz / 64; C = (st & 1) * 32 + (swz % 64) / 2; }
__device__ __forceinline__ int perm32(int rho) { const int n = rho >> 4, i = rho & 15; return 8 * (i >> 2) + 4 * n + (i & 3); }
__device__ __forceinline__ unsigned cvt_pk_bf16(float lo, float hi) { return cvtpk(lo, hi); }

__device__ __forceinline__ int g8_ra(int tid, int i) { int R, C; stage_rc(tid * 16 + i * 8192, R, C); return R; }
__device__ __forceinline__ unsigned g8_ca(int tid, int i) { int R, C; stage_rc(tid * 16 + i * 8192, R, C); return (unsigned)C * 2u; }
#define G8_RA(i) g8_ra(otid(), (i))
#define G8_CA(i) g8_ca(otid(), (i))
template <class Epi, class Sched>
__device__ __forceinline__ void gemm_phase(LAS unsigned char* lds, const char* Abase, const int K, const Sched& S, const Epi& E) {
    const int tid = otid(), wid = __builtin_amdgcn_readfirstlane(tid >> 6), lane = tid & 63, wr = wid >> 2, wc = wid & 3, fr = lane & 15, fq = lane >> 4;
    const int nt = K / BK;
    unsigned voffB[2];
#pragma unroll
    for (int i = 0; i < 2; ++i) { int R, C; stage_rc(tid * 16 + i * 8192, R, C); const int Rb = Epi::PERM ? ((R & ~31) + perm32(R & 31)) : R;
        voffB[i] = (unsigned)(Rb * K + C) * 2u; }
    const unsigned rowb = (unsigned)K * 2u;
    const size_t kstep = (size_t)(BK * 2);
    const size_t hstep = (size_t)HALF * K * 2;
    const unsigned ldsw = (unsigned)wid * 1024u;
    const int aoff = lds_byte(wr * 64 + fr, fq * 8), boff = lds_byte(wc * 32 + fr, fq * 8);
#define G8_SA(b, h) (((b) * 2 + (h)) * HTB)
#define G8_SB(b, h) ((4 + (b) * 2 + (h)) * HTB)
#define G8_STAGE(bufoff, gbase, voff) do { _Pragma("unroll") for (int _i = 0; _i < 2; ++_i) \
        __builtin_amdgcn_global_load_lds((const unsigned*)((const char*)(gbase) + (voff)[_i]), (LAS unsigned*)(lds + (bufoff) + ldsw + _i * 8192), 16, 0, 0); } while (0)
#define G8_LDA(dst, b, h) do { _Pragma("unroll") for (int m = 0; m < 4; ++m) _Pragma("unroll") for (int k = 0; k < 2; ++k) dst[m][k] = *(const LAS bf16x8*)(lds + G8_SA(b, h) + aoff + m * 2048 + k * 1024); } while (0)
#define G8_LDB(dst, b, h) do { _Pragma("unroll") for (int n = 0; n < 2; ++n) _Pragma("unroll") for (int k = 0; k < 2; ++k) dst[n][k] = *(const LAS bf16x8*)(lds + G8_SB(b, h) + boff + n * 2048 + k * 1024); } while (0)
#define G8_MMA(ai, bj, At, Bt) do { __builtin_amdgcn_s_setprio(1); _Pragma("unroll") for (int m = 0; m < 4; ++m) _Pragma("unroll") for (int n = 0; n < 2; ++n) _Pragma("unroll") for (int k = 0; k < 2; ++k) \
        acc[ai][bj][m][n] = __builtin_amdgcn_mfma_f32_16x16x32_bf16(Bt[n][k], At[m][k], acc[ai][bj][m][n], 0, 0, 0); __builtin_amdgcn_s_setprio(0); } while (0)
#define G8_WAIT_V(n) asm volatile("s_waitcnt vmcnt(" #n ")" ::: "memory")
#define G8_WAIT_L(n) asm volatile("s_waitcnt lgkmcnt(" #n ")" ::: "memory")
#define G8_BAR __builtin_amdgcn_s_barrier()
#define G8_SCHED __builtin_amdgcn_sched_barrier(0)
    typename Sched::Unit cur, nxt; int ui = 0;
    if (!S.next(0, cur)) return;
    f32x4 acc[2][2][4][2];
#pragma unroll
    for (int a = 0; a < 2; ++a)
#pragma unroll
        for (int b = 0; b < 2; ++b)
#pragma unroll
            for (int m = 0; m < 4; ++m)
#pragma unroll
                for (int n = 0; n < 2; ++n) acc[a][b][m][n] = (f32x4){0.f, 0.f, 0.f, 0.f};
    bf16x8 At[4][2], B0[2][2], B1[2][2];
    unsigned vAc[2][2], vAn[2][2];
#pragma unroll
    for (int h = 0; h < 2; ++h)
#pragma unroll
        for (int i = 0; i < 2; ++i) vAc[h][i] = (Sched::AFFINE ? (unsigned)(h * HALF + G8_RA(i)) : (unsigned)S.a_row(cur, h * HALF + G8_RA(i))) * rowb + G8_CA(i);
    const char* cA = Sched::AFFINE ? Abase + (size_t)S.a_row(cur, 0) * rowb : Abase;
    const char* cB = S.b_base(cur);
    G8_STAGE(G8_SB(0, 0), cB, voffB); G8_STAGE(G8_SA(0, 0), cA, vAc[0]); G8_STAGE(G8_SB(0, 1), cB + hstep, voffB); G8_STAGE(G8_SA(0, 1), cA, vAc[1]);
    if (wr == 1) G8_BAR;
    G8_WAIT_V(4); G8_BAR;
    G8_STAGE(G8_SB(1, 0), cB + kstep, voffB); G8_STAGE(G8_SA(1, 0), cA + kstep, vAc[0]); G8_STAGE(G8_SB(1, 1), cB + hstep + kstep, voffB);
    G8_WAIT_V(6); G8_BAR;
    for (;;) {
        const bool has_next = S.next(ui + 1, nxt);
#pragma unroll
        for (int h = 0; h < 2; ++h)
#pragma unroll
            for (int i = 0; i < 2; ++i) vAn[h][i] = (has_next && !Sched::AFFINE) ? ((unsigned)S.a_row(nxt, h * HALF + G8_RA(i)) * rowb + G8_CA(i)) : vAc[h][i];
        const char* nA = (has_next && Sched::AFFINE) ? Abase + (size_t)S.a_row(nxt, 0) * rowb : cA;
        const char* nB = has_next ? S.b_base(nxt) : cB;
        for (int t = 0; t < nt; t += 2) {
            const bool last = (t == nt - 2);
            const char* a1 = cA + (size_t)(t + 1) * kstep;
            const char* a2 = last ? nA : cA + (size_t)(t + 2) * kstep; const char* b2 = last ? nB : cB + (size_t)(t + 2) * kstep;
            const char* a3 = a2 + kstep; const char* b3 = b2 + kstep;
            unsigned v2[2][2];
#pragma unroll
            for (int h = 0; h < 2; ++h)
#pragma unroll
                for (int i = 0; i < 2; ++i) v2[h][i] = last ? vAn[h][i] : vAc[h][i];
            G8_LDB(B0, 0, 0); G8_SCHED; G8_LDA(At, 0, 0); G8_STAGE(G8_SA(1, 1), a1, vAc[1]);
            G8_WAIT_L(8); G8_BAR; G8_WAIT_L(0); G8_MMA(0, 0, At, B0); G8_BAR; G8_SCHED;
            G8_LDB(B1, 0, 1); G8_STAGE(G8_SB(0, 0), b2, voffB);
            G8_BAR; G8_WAIT_L(0); G8_MMA(0, 1, At, B1); G8_BAR;
            G8_LDA(At, 0, 1); G8_STAGE(G8_SA(0, 0), a2, v2[0]);
            G8_BAR; G8_WAIT_L(0); G8_MMA(1, 0, At, B0); G8_BAR; G8_SCHED;
            G8_STAGE(G8_SB(0, 1), b2 + hstep, voffB);
            G8_WAIT_V(6); G8_BAR; G8_MMA(1, 1, At, B1); G8_BAR;
            G8_LDB(B0, 1, 0); G8_SCHED; G8_LDA(At, 1, 0); G8_STAGE(G8_SA(0, 1), a2, v2[1]);
            G8_WAIT_L(8); G8_BAR; G8_WAIT_L(0); G8_MMA(0, 0, At, B0); G8_BAR; G8_SCHED;
            G8_LDB(B1, 1, 1); G8_STAGE(G8_SB(1, 0), b3, voffB);
            G8_BAR; G8_WAIT_L(0); G8_MMA(0, 1, At, B1); G8_BAR;
            G8_LDA(At, 1, 1); G8_STAGE(G8_SA(1, 0), a3, v2[0]);
            G8_BAR; G8_WAIT_L(0); G8_MMA(1, 0, At, B0); G8_BAR; G8_SCHED;
            G8_STAGE(G8_SB(1, 1), b3 + hstep, voffB);
            G8_WAIT_V(6); G8_BAR; G8_MMA(1, 1, At, B1); G8_BAR;
        }
        E(acc, cur, wr, wc, fr, fq);
        if (!has_next) break;
#pragma unroll
        for (int a = 0; a < 2; ++a)
#pragma unroll
            for (int b = 0; b < 2; ++b)
#pragma unroll
                for (int m = 0; m < 4; ++m)
#pragma unroll
                    for (int n = 0; n < 2; ++n) acc[a][b][m][n] = (f32x4){0.f, 0.f, 0.f, 0.f};
        cur = nxt; cB = nB; cA = nA; ++ui;
#pragma unroll
        for (int h = 0; h < 2; ++h)
#pragma unroll
            for (int i = 0; i < 2; ++i) vAc[h][i] = vAn[h][i];
    }
    G8_WAIT_V(0);
    if (wr == 0) G8_BAR;
    G8_BAR;
#undef G8_SA
#undef G8_SB
#undef G8_STAGE
#undef G8_LDA
#undef G8_LDB
#undef G8_MMA
#undef G8_WAIT_V
#undef G8_WAIT_L
#undef G8_BAR
#undef G8_SCHED
}

template <int sclW, int sclA, class Epi, class Sched>
__device__ __forceinline__ void gemm_phase8(LAS unsigned char* lds, const char* Abase, const int K, const Sched& S, const Epi& E) {
    const int tid = otid(), wid = __builtin_amdgcn_readfirstlane(tid >> 6), lane = tid & 63, wr = wid >> 2, wc = wid & 3, fr = lane & 15, fq = lane >> 4;
    const int nt = K / 128;
    unsigned voffB[2];
#pragma unroll
    for (int i = 0; i < 2; ++i) { int R, C; stage_rc(tid * 16 + i * 8192, R, C); const int Rb = Epi::PERM ? ((R & ~31) + perm32(R & 31)) : R;
        voffB[i] = (unsigned)(Rb * K) + (unsigned)C * 2u; }
    const unsigned rowb = (unsigned)K;
    const size_t kstep = (size_t)(BK * 2);
    const size_t hstep = (size_t)HALF * K;
    const unsigned ldsw = (unsigned)wid * 1024u;
    const int fob = fr * 64 + ((2 * (fq & 1)) ^ (2 * (fr >> 3))) * 16 + (fq >> 1) * 1024;
    const int aoff = ((wr * 64) >> 4) * 2048 + fob, boff = ((wc * 32) >> 4) * 2048 + fob;
#define G8_SA(b, h) (((b) * 2 + (h)) * HTB)
#define G8_SB(b, h) ((4 + (b) * 2 + (h)) * HTB)
#define G8_STAGE(bufoff, gbase, voff) do { _Pragma("unroll") for (int _i = 0; _i < 2; ++_i) \
        __builtin_amdgcn_global_load_lds((const unsigned*)((const char*)(gbase) + (voff)[_i]), (LAS unsigned*)(lds + (bufoff) + ldsw + _i * 8192), 16, 0, 0); } while (0)
#define G8_LDA(dst, b, h) do { _Pragma("unroll") for (int m = 0; m < 4; ++m) { const i32x4 _lo = *(const LAS i32x4*)(lds + G8_SA(b, h) + aoff + m * 2048), _hi = *(const LAS i32x4*)(lds + G8_SA(b, h) + aoff + m * 2048 + 16); dst[m] = __builtin_shufflevector(_lo, _hi, 0, 1, 2, 3, 4, 5, 6, 7); } } while (0)
#define G8_LDB(dst, b, h) do { _Pragma("unroll") for (int n = 0; n < 2; ++n) { const i32x4 _lo = *(const LAS i32x4*)(lds + G8_SB(b, h) + boff + n * 2048), _hi = *(const LAS i32x4*)(lds + G8_SB(b, h) + boff + n * 2048 + 16); dst[n] = __builtin_shufflevector(_lo, _hi, 0, 1, 2, 3, 4, 5, 6, 7); } } while (0)
#define G8_MMA(ai, bj, At, Bt) do { __builtin_amdgcn_s_setprio(1); _Pragma("unroll") for (int m = 0; m < 4; ++m) _Pragma("unroll") for (int n = 0; n < 2; ++n) \
        acc[ai][bj][m][n] = __builtin_amdgcn_mfma_scale_f32_16x16x128_f8f6f4(Bt[n], At[m], acc[ai][bj][m][n], 0, 0, 0, sclW, 0, sclA); \
        _Pragma("unroll") for (int m = 0; m < 4; ++m) asm volatile("" : "+v"(acc[ai][bj][m][0]), "+v"(acc[ai][bj][m][1]));   \
        __builtin_amdgcn_s_setprio(0); } while (0)
#define G8_WAIT_V(n) asm volatile("s_waitcnt vmcnt(" #n ")" ::: "memory")
#define G8_WAIT_L(n) asm volatile("s_waitcnt lgkmcnt(" #n ")" ::: "memory")
#define G8_BAR __builtin_amdgcn_s_barrier()
#define G8_SCHED __builtin_amdgcn_sched_barrier(0)
    typename Sched::Unit cur, nxt; int ui = 0;
    if (!S.next(0, cur)) return;
    f32x4 acc[2][2][4][2];
#pragma unroll
    for (int a = 0; a < 2; ++a)
#pragma unroll
        for (int b = 0; b < 2; ++b)
#pragma unroll
            for (int m = 0; m < 4; ++m)
#pragma unroll
                for (int n = 0; n < 2; ++n) acc[a][b][m][n] = (f32x4){0.f, 0.f, 0.f, 0.f};
    i32x8 At[4], B0[2], B1[2];
    unsigned vAc[2][2], vAn[2][2];
#pragma unroll
    for (int h = 0; h < 2; ++h)
#pragma unroll
        for (int i = 0; i < 2; ++i) vAc[h][i] = (Sched::AFFINE ? (unsigned)(h * HALF + G8_RA(i)) : (unsigned)S.a_row(cur, h * HALF + G8_RA(i))) * rowb + G8_CA(i);
    const char* cA = Sched::AFFINE ? Abase + (size_t)S.a_row(cur, 0) * rowb : Abase;
    const char* cB = S.b_base(cur);
    G8_STAGE(G8_SB(0, 0), cB, voffB); G8_STAGE(G8_SA(0, 0), cA, vAc[0]); G8_STAGE(G8_SB(0, 1), cB + hstep, voffB); G8_STAGE(G8_SA(0, 1), cA, vAc[1]);
    if (wr == 1) G8_BAR;
    G8_WAIT_V(4); G8_BAR;
    G8_STAGE(G8_SB(1, 0), cB + kstep, voffB); G8_STAGE(G8_SA(1, 0), cA + kstep, vAc[0]); G8_STAGE(G8_SB(1, 1), cB + hstep + kstep, voffB);
    G8_WAIT_V(6); G8_BAR;
    for (;;) {
        const bool has_next = S.next(ui + 1, nxt);
#pragma unroll
        for (int h = 0; h < 2; ++h)
#pragma unroll
            for (int i = 0; i < 2; ++i) vAn[h][i] = (has_next && !Sched::AFFINE) ? ((unsigned)S.a_row(nxt, h * HALF + G8_RA(i)) * rowb + G8_CA(i)) : vAc[h][i];
        const char* nA = (has_next && Sched::AFFINE) ? Abase + (size_t)S.a_row(nxt, 0) * rowb : cA;
        const char* nB = has_next ? S.b_base(nxt) : cB;
#pragma unroll 1
        for (int t = 0; t < nt; t += 2) {
            const bool last = (t == nt - 2);
            const char* a1 = cA + (size_t)(t + 1) * kstep;
            const char* a2 = last ? nA : cA + (size_t)(t + 2) * kstep; const char* b2 = last ? nB : cB + (size_t)(t + 2) * kstep;
            const char* a3 = a2 + kstep; const char* b3 = b2 + kstep;
            unsigned v2[2][2];
#pragma unroll
            for (int h = 0; h < 2; ++h)
#pragma unroll
                for (int i = 0; i < 2; ++i) v2[h][i] = last ? vAn[h][i] : vAc[h][i];
            G8_LDB(B0, 0, 0); G8_SCHED; G8_LDA(At, 0, 0); G8_STAGE(G8_SA(1, 1), a1, vAc[1]);
            G8_WAIT_L(8); G8_BAR; G8_WAIT_L(0); G8_MMA(0, 0, At, B0); G8_BAR; G8_SCHED;
            G8_LDB(B1, 0, 1); G8_STAGE(G8_SB(0, 0), b2, voffB);
            G8_BAR; G8_WAIT_L(0); G8_MMA(0, 1, At, B1); G8_BAR;
            G8_LDA(At, 0, 1); G8_STAGE(G8_SA(0, 0), a2, v2[0]);
            G8_BAR; G8_WAIT_L(0); G8_MMA(1, 0, At, B0); G8_BAR; G8_SCHED;
            G8_STAGE(G8_SB(0, 1), b2 + hstep, voffB);
            G8_WAIT_V(6); G8_BAR; G8_MMA(1, 1, At, B1); G8_BAR;
            G8_LDB(B0, 1, 0); G8_SCHED; G8_LDA(At, 1, 0); G8_STAGE(G8_SA(0, 1), a2, v2[1]);
            G8_WAIT_L(8); G8_BAR; G8_WAIT_L(0); G8_MMA(0, 0, At, B0); G8_BAR; G8_SCHED;
            G8_LDB(B1, 1, 1); G8_STAGE(G8_SB(1, 0), b3, voffB);
            G8_BAR; G8_WAIT_L(0); G8_MMA(0, 1, At, B1); G8_BAR;
            G8_LDA(At, 1, 1); G8_STAGE(G8_SA(1, 0), a3, v2[0]);
            G8_BAR; G8_WAIT_L(0); G8_MMA(1, 0, At, B0); G8_BAR; G8_SCHED;
            G8_STAGE(G8_SB(1, 1), b3 + hstep, voffB);
            G8_WAIT_V(6); G8_BAR; G8_MMA(1, 1, At, B1); G8_BAR;
        }
        E(acc, cur, wr, wc, fr, fq);
        if (!has_next) break;
#pragma unroll
        for (int a = 0; a < 2; ++a)
#pragma unroll
            for (int b = 0; b < 2; ++b)
#pragma unroll
                for (int m = 0; m < 4; ++m)
#pragma unroll
                    for (int n = 0; n < 2; ++n) acc[a][b][m][n] = (f32x4){0.f, 0.f, 0.f, 0.f};
        cur = nxt; cB = nB; cA = nA; ++ui;
#pragma unroll
        for (int h = 0; h < 2; ++h)
#pragma unroll
            for (int i = 0; i < 2; ++i) vAc[h][i] = vAn[h][i];
    }
    G8_WAIT_V(0);
    if (wr == 0) G8_BAR;
    G8_BAR;
#undef G8_SA
#undef G8_SB
#undef G8_STAGE
#undef G8_LDA
#undef G8_LDB
#undef G8_MMA
#undef G8_WAIT_V
#undef G8_WAIT_L
#undef G8_BAR
#undef G8_SCHED
}

struct DUnit { int pm, pn; };
struct DenseOrder {
    typedef DUnit Unit; static constexpr bool AFFINE = true;
    int nM, nN, nwg, G, c; const char* Bt; int K; int bpe;
    __device__ __forceinline__ void init(int nM_, int nN_, int G_, int c_, const void* Bt_, int K_, int bpe_ = 2) { nM = nM_; nN = nN_; nwg = nM * nN; G = G_; c = c_; Bt = (const char*)Bt_; K = K_; bpe = bpe_; }
    __device__ __forceinline__ bool next(int i, Unit& u) const {
        const long L = (long)i * G + c; if (L >= nwg) return false;
        int wgid = (int)L; { const int q = nwg / NXCD, r = nwg % NXCD, xcd = wgid % NXCD, off = wgid / NXCD; wgid = (xcd < r ? xcd * (q + 1) : r * (q + 1) + (xcd - r) * q) + off; }
        const int nig = WGM * nN, gid = wgid / nig, fm = gid * WGM, gsz = (nM - fm) < WGM ? (nM - fm) : WGM;
        u.pm = fm + ((wgid % nig) % gsz); u.pn = (wgid % nig) / gsz; return true;
    }
    __device__ __forceinline__ int a_row(const Unit& u, int r) const { return u.pm * BM + r; }
    __device__ __forceinline__ const char* b_base(const Unit& u) const { return Bt + (size_t)u.pn * BM * K * bpe; }
};
struct MUnit { int pm, pn, e, nvalid, lbase, idx; };
constexpr int MOE_UTAB = 131072, MOE_RTOK = MOE_UTAB + 128, MOE_RGATE = MOE_RTOK + 4096;
template <bool GATHER> struct MoeOrder {
    typedef MUnit Unit; static constexpr bool AFFINE = !GATHER;
    const int* utab; const int* rtok; const char* W; int K; int bpe;
    __device__ __forceinline__ bool next(int i, Unit& u) const {
        if (i >= 4) return false;
        const int* t = utab + i * 8;
        if (t[5] == 0) return false;
        u.pm = t[0]; u.pn = t[1]; u.e = t[2]; u.nvalid = t[3]; u.lbase = t[4]; u.idx = i; return true;
    }
    __device__ __forceinline__ int a_row(const Unit& u, int r) const { if (GATHER) return rtok[u.idx * 256 + r] >> 1; else return u.pm * BM + r; }
    __device__ __forceinline__ const char* b_base(const Unit& u) const { return W + ((size_t)u.e * 1024 + u.pn * BM) * K * bpe; }
};

struct EpiP2 {
    static constexpr bool PERM = true;
    bf16_t* P;
    __device__ __forceinline__ void operator()(const f32x4 (&acc)[2][2][4][2], const DUnit& u, int wr, int wc, int fr, int fq) const {
        const int row0 = u.pm * BM + wr * 64 + fr, col0 = u.pn * BM + wc * 32 + 8 * fq;
#pragma unroll
        for (int ai = 0; ai < 2; ++ai)
#pragma unroll
            for (int m = 0; m < 4; ++m) { bf16_t* rowp = P + (size_t)(row0 + ai * HALF + m * 16) * PW + col0;
#pragma unroll
                for (int bj = 0; bj < 2; ++bj) { const f32x4 v0 = acc[ai][bj][m][0], v1 = acc[ai][bj][m][1];
                    u32x4 w; w.x = cvt_pk_bf16(v0[0], v0[1]); w.y = cvt_pk_bf16(v0[2], v0[3]); w.z = cvt_pk_bf16(v1[0], v1[1]); w.w = cvt_pk_bf16(v1[2], v1[3]);
                    *(u32x4*)(rowp + bj * HALF) = w; } }
    }
};
struct EpiRes2 {
    static constexpr bool PERM = false;
    float* X; const float* gate; float scl;
    __device__ __forceinline__ void operator()(const f32x4 (&acc)[2][2][4][2], const DUnit& u, int wr, int wc, int fr, int fq) const {
        const int row0 = u.pm * BM + wr * 64 + fr, col0 = u.pn * BM + wc * 32 + 4 * fq;
#pragma unroll
        for (int ai = 0; ai < 2; ++ai)
#pragma unroll
            for (int m = 0; m < 4; ++m) { const int r = row0 + ai * HALF + m * 16; float* rowp = X + (size_t)r * 1024 + col0; const float* gp = gate + (size_t)mod_row(r) * 6144 + col0;
#pragma unroll
                for (int bj = 0; bj < 2; ++bj)
#pragma unroll
                    for (int n = 0; n < 2; ++n) { const f32x4 gv = *(const f32x4*)(gp + bj * HALF + n * 16); f32x4 x = *(f32x4*)(rowp + bj * HALF + n * 16); x += (gv * scl) * acc[ai][bj][m][n]; *(f32x4*)(rowp + bj * HALF + n * 16) = x; }
                asm volatile("" ::: "memory"); }
    }
};
struct EpiDelta {
    static constexpr bool PERM = true;
    bf16_t* Dl; const float* gate; float scl;
    __device__ __forceinline__ void operator()(const f32x4 (&acc)[2][2][4][2], const DUnit& u, int wr, int wc, int fr, int fq) const {
        const int row0 = u.pm * BM + wr * 64 + fr, col0 = u.pn * BM + wc * 32 + 8 * fq;
#pragma unroll
        for (int ai = 0; ai < 2; ++ai)
#pragma unroll
            for (int m = 0; m < 4; ++m) { const int r = row0 + ai * HALF + m * 16; bf16_t* rowp = Dl + (size_t)r * 1024 + col0; const float* gp = gate + (size_t)mod_row(r) * 6144 + col0;
#pragma unroll
                for (int bj = 0; bj < 2; ++bj) { const f32x4 g0 = *(const f32x4*)(gp + bj * HALF) * scl, g1 = *(const f32x4*)(gp + bj * HALF + 4) * scl;
                    const f32x4 v0 = acc[ai][bj][m][0] * g0, v1 = acc[ai][bj][m][1] * g1;
                    u32x4 w; w.x = cvt_pk_bf16(v0[0], v0[1]); w.y = cvt_pk_bf16(v0[2], v0[3]); w.z = cvt_pk_bf16(v1[0], v1[1]); w.w = cvt_pk_bf16(v1[2], v1[3]);
                    *(u32x4*)(rowp + bj * HALF) = w; } }
    }
};
struct EpiGU2 {
    static constexpr bool PERM = true;
    bf16_t* H;
    __device__ __forceinline__ void operator()(const f32x4 (&acc)[2][2][4][2], const MUnit& u, int wr, int wc, int fr, int fq) const {
        const int row0 = u.pm * BM + wr * 64 + fr, col0 = u.pn * BM + wc * 32 + 8 * fq;
#pragma unroll
        for (int ai = 0; ai < 2; ++ai)
#pragma unroll
            for (int m = 0; m < 4; ++m) { bf16_t* rowp = H + (size_t)(row0 + ai * HALF + m * 16) * 512 + (col0 >> 1);
#pragma unroll
                for (int bj = 0; bj < 2; ++bj) { const f32x4 v0 = acc[ai][bj][m][0], v1 = acc[ai][bj][m][1];
                    u32x2 w; w.x = cvt_pk_bf16(siluf(v0[0]) * v0[1], siluf(v0[2]) * v0[3]); w.y = cvt_pk_bf16(siluf(v1[0]) * v1[1], siluf(v1[2]) * v1[3]);
                    *(u32x2*)(rowp + bj * (HALF / 2)) = w; } }
    }
};
struct EpiGU8 {
    static constexpr bool PERM = true;
    unsigned char* H;
    __device__ __forceinline__ void operator()(const f32x4 (&acc)[2][2][4][2], const MUnit& u, int wr, int wc, int fr, int fq) const {
        const int row0 = u.pm * BM + wr * 64 + fr, col0 = u.pn * BM + wc * 32 + 8 * fq;
#pragma unroll
        for (int ai = 0; ai < 2; ++ai)
#pragma unroll
            for (int m = 0; m < 4; ++m) { unsigned char* rowp = H + (size_t)(row0 + ai * HALF + m * 16) * 512 + (col0 >> 1);
#pragma unroll
                for (int bj = 0; bj < 2; ++bj) { const f32x4 v0 = acc[ai][bj][m][0], v1 = acc[ai][bj][m][1];
                    *(unsigned*)(rowp + bj * (HALF / 2)) = pk4_fp8(2.0f * siluf(v0[0]) * v0[1], 2.0f * siluf(v0[2]) * v0[3], 2.0f * siluf(v1[0]) * v1[1], 2.0f * siluf(v1[2]) * v1[3]); } }
    }
};
struct EpiDown2 {
    static constexpr bool PERM = true;
    bf16_t* YB; const int* rtok; const float* rgate;
    __device__ __forceinline__ void operator()(const f32x4 (&acc)[2][2][4][2], const MUnit& u, int wr, int wc, int fr, int fq) const {
        const int r0 = wr * 64 + fr, col0 = u.pn * BM + wc * 32 + 8 * fq;
#pragma unroll
        for (int ai = 0; ai < 2; ++ai)
#pragma unroll
            for (int m = 0; m < 4; ++m) { const int rt = r0 + ai * HALF + m * 16;
                if (rt < u.nvalid) { const int ent = rtok[u.idx * 256 + rt]; const float g = rgate[u.idx * 256 + rt]; bf16_t* rowp = YB + (size_t)ent * 1024 + col0;
#pragma unroll
                    for (int bj = 0; bj < 2; ++bj) { const f32x4 v0 = acc[ai][bj][m][0] * g, v1 = acc[ai][bj][m][1] * g;
                        u32x4 w; w.x = cvt_pk_bf16(v0[0], v0[1]); w.y = cvt_pk_bf16(v0[2], v0[3]); w.z = cvt_pk_bf16(v1[0], v1[1]); w.w = cvt_pk_bf16(v1[2], v1[3]);
                        *(u32x4*)(rowp + bj * HALF) = w; } } }
    }
};
struct EpiDown8 {
    static constexpr bool PERM = true;
    unsigned char* YB; const int* rtok; const float* rgate;
    __device__ __forceinline__ void operator()(const f32x4 (&acc)[2][2][4][2], const MUnit& u, int wr, int wc, int fr, int fq) const {
        const int r0 = wr * 64 + fr, col0 = u.pn * BM + wc * 32 + 8 * fq;
#pragma unroll
        for (int ai = 0; ai < 2; ++ai)
#pragma unroll
            for (int m = 0; m < 4; ++m) { const int rt = r0 + ai * HALF + m * 16;
                if (rt < u.nvalid) { const int ent = rtok[u.idx * 256 + rt]; const float g = 64.0f * rgate[u.idx * 256 + rt]; unsigned char* rowp = YB + (size_t)ent * 1024 + col0;
#pragma unroll
                    for (int bj = 0; bj < 2; ++bj) { const f32x4 v0 = acc[ai][bj][m][0] * g, v1 = acc[ai][bj][m][1] * g;
                        u32x2 w; w.x = pk4_fp8(v0[0], v0[1], v0[2], v0[3]); w.y = pk4_fp8(v1[0], v1[1], v1[2], v1[3]);
                        *(u32x2*)(rowp + bj * HALF) = w; } } }
    }
};
}

__device__ __forceinline__ void transpose_item(const float* __restrict__ W, int K, int N, bf16_t* __restrict__ WT, int mode, float* scr, int item, int lane) {
    const int nblk = N / 32, kb = item / nblk, nb = item % nblk, k0 = 64 * kb, n0 = 32 * nb;
    float wv[32];
#pragma unroll
    for (int i = 0; i < 32; ++i) wv[i] = __builtin_nontemporal_load(W + (size_t)(k0 + 2 * i + (lane >> 5)) * N + n0 + (lane & 31));
#pragma unroll
    for (int i = 0; i < 32; ++i) scr[(2 * i + (lane >> 5)) * 33 + (lane & 31)] = wv[i];
    LDS_WAIT();
    const int c = lane & 7;
#pragma unroll
    for (int j = 0; j < 4; ++j) {
        const int n = (lane >> 3) + 8 * j; const float* s = scr + (8 * c) * 33 + n;
        u32x4 o; o.x = pk2(s[0 * 33], s[1 * 33]); o.y = pk2(s[2 * 33], s[3 * 33]); o.z = pk2(s[4 * 33], s[5 * 33]); o.w = pk2(s[6 * 33], s[7 * 33]);
        const int nabs = n0 + n; const int orow = mode ? ((nabs < 512) ? 2 * nabs : 2 * (nabs - 512) + 1) : nabs;
        *(u32x4*)(WT + (size_t)orow * K + k0 + 8 * c) = o;
    }
    LDS_WAIT();
}


__device__ __forceinline__ void transpose_item8(const float* __restrict__ W, int K, int N, unsigned char* __restrict__ WT, int mode, float scale, float* scr, int item, int lane) {
    const int nblk = N / 32, kb = item / nblk, nb = item % nblk, k0 = 64 * kb, n0 = 32 * nb;
    float wv[32];
#pragma unroll
    for (int i = 0; i < 32; ++i) wv[i] = __builtin_nontemporal_load(W + (size_t)(k0 + 2 * i + (lane >> 5)) * N + n0 + (lane & 31));
#pragma unroll
    for (int i = 0; i < 32; ++i) scr[(2 * i + (lane >> 5)) * 33 + (lane & 31)] = wv[i] * scale;
    LDS_WAIT();
    const int c = lane & 7;
#pragma unroll
    for (int j = 0; j < 4; ++j) {
        const int n = (lane >> 3) + 8 * j; const float* s = scr + (8 * c) * 33 + n;
        u32x2 o; o.x = pk4_fp8(s[0 * 33], s[1 * 33], s[2 * 33], s[3 * 33]); o.y = pk4_fp8(s[4 * 33], s[5 * 33], s[6 * 33], s[7 * 33]);
        const int nabs = n0 + n; const int orow = mode ? ((nabs < 512) ? 2 * nabs : 2 * (nabs - 512) + 1) : nabs;
        *(u32x2*)(WT + (size_t)orow * K + k0 + 8 * c) = o;
    }
    LDS_WAIT();
}

__device__ __forceinline__ void convert_experts(const Params& p, int l, float* scr, int widx, int nwv, int it0, int it1) {
    const int tid = otid(), lane = tid & 63;
    bf16_t* wgu_t = (bf16_t*)(ows(p) + WS_WGU) + (size_t)l * 32 * 1024 * 1024; bf16_t* wdn_t = (bf16_t*)(ows(p) + WS_WDN) + (size_t)l * 32 * 1024 * 512;
    const float* wgu = oin(p, 17) + (size_t)l * 32 * 1024 * 1024; const float* wdn = oin(p, 18) + (size_t)l * 32 * 512 * 1024;
    constexpr int I_GU = 16 * 32, I_DN = 8 * 32, T_GU = 32 * I_GU;
    unsigned char* wgu8 = ows(p) + WS_WGU8 + (size_t)l * 32 * 1024 * 1024; unsigned char* wdn8 = ows(p) + WS_WDN8 + (size_t)l * 32 * 1024 * 512;
    for (int it = it0 + widx; it < it1; it += nwv) {
        if (it < T_GU) { const int m = it / I_GU;
            if (MOE_FP8) transpose_item8(wgu + (size_t)m * 1024 * 1024, 1024, 1024, wgu8 + (size_t)m * 1024 * 1024, 1, 32.0f, scr, it % I_GU, lane);
            else transpose_item(wgu + (size_t)m * 1024 * 1024, 1024, 1024, wgu_t + (size_t)m * 1024 * 1024, 1, scr, it % I_GU, lane); }
        else { const int r = it - T_GU, m = r / I_DN;
            if (MOE_FP8) transpose_item8(wdn + (size_t)m * 512 * 1024, 512, 1024, wdn8 + (size_t)m * 1024 * 512, 0, 16.0f, scr, r % I_DN, lane);
            else transpose_item(wdn + (size_t)m * 512 * 1024, 512, 1024, wdn_t + (size_t)m * 1024 * 512, 0, scr, r % I_DN, lane); }
    }
}

__device__ __forceinline__ void convert_range(const Params& p, float* scr, int widx, int nwv, int g0, int g1) {
    for (int l = g0 / CV_ALL; l < DEPTH && l * CV_ALL < g1; ++l) {
        const int a = max(g0, l * CV_ALL) - l * CV_ALL, b = min(g1, (l + 1) * CV_ALL) - l * CV_ALL;
        convert_experts(p, l, scr, widx, nwv, a, b);
    }
}

__device__ __forceinline__ void phase_prologue(const Params& p, unsigned char* lds) {
    const int tid = otid(), lane = tid & 63, wid = tid >> 6;
    float* scr = (float*)(lds + wid * 16384);
    const int gw = obid() * 8 + wid, NGW = gridDim.x * 8;
    bf16_t* win_t = (bf16_t*)(ows(p) + WS_WIN); bf16_t* wout_t = (bf16_t*)(ows(p) + WS_WOUT);
    constexpr int I_IN = 16 * 128, I_OUT = 16 * 32;
    constexpr int T_IN = 4 * I_IN, T_OUT = 4 * I_OUT;
    for (int it = gw; it < T_IN + T_OUT; it += NGW) {
        int r = it;
        if (r < T_IN) { const int m = r / I_IN; transpose_item(oin(p, 7) + (size_t)m * 1024 * 4096, 1024, 4096, win_t + (size_t)m * 4096 * 1024, 0, scr, r % I_IN, lane); continue; } r -= T_IN;
        { const int m = r / I_OUT;
          if (G2_FP8) transpose_item8(oin(p, 12) + (size_t)m * 1024 * 1024, 1024, 1024, (unsigned char*)wout_t + (size_t)m * 1024 * 1024, 0, 32.0f, scr, r % I_OUT, lane);
          else transpose_item(oin(p, 12) + (size_t)m * 1024 * 1024, 1024, 1024, wout_t + (size_t)m * 1024 * 1024, 0, scr, r % I_OUT, lane); }
    }
    {
        bf16_t* wrh = (bf16_t*)(ows(p) + WS_WRH); bf16_t* wrl = (bf16_t*)(ows(p) + WS_WRL);
        for (int i = obid() * 512 + tid; i < 4 * 48 * 1024; i += gridDim.x * 512) {
            const int l = i / (48 * 1024), j = (i / 1024) % 48, k = i % 1024;
            float w = 0.f;
            if (j < 4) w = oin(p, 13)[((size_t)l * 1024 + k) * 4 + j]; else if (j < 36) w = oin(p, 15)[((size_t)l * 1024 + k) * 32 + (j - 4)];
            const unsigned hi = f2bf(w); const float rem = w - __uint_as_float(hi << 16);
            wrh[i] = (bf16_t)hi; wrl[i] = (bf16_t)f2bf(rem);
        }
    }
    __syncthreads();
    float* modp = (float*)(ows(p) + WS_MODP);
    float* sS = (float*)lds;
    for (int u = obid(); u < 4 * 24 * 8; u += gridDim.x) {
        const int l = u / 192, rem = u % 192, nb = rem / 8, ks = rem % 8;
        __syncthreads();
        for (int i = tid; i < 9 * 128; i += 512) { const int r = i >> 7, k = i & 127; const float cv = (r < 8) ? oin(p, 1)[r * 1024 + ks * 128 + k] : oin(p, 3)[ks * 128 + k]; sS[i] = siluf(cv); }
        __syncthreads();
        const int col = nb * 256 + (tid & 255), kh = tid >> 8;
        float acc[9];
#pragma unroll
        for (int r = 0; r < 9; ++r) acc[r] = 0.f;
        const float* w = oin(p, 5) + ((size_t)l * 1024 + ks * 128 + kh * 64) * 6144 + col;
        for (int k = 0; k < 64; ++k) {
            const float wv = w[(size_t)k * 6144];
#pragma unroll
            for (int r = 0; r < 9; ++r) acc[r] += sS[r * 128 + kh * 64 + k] * wv;
        }
#pragma unroll
        for (int r = 0; r < 9; ++r) modp[(((size_t)l * NMODP + ks * 2 + kh) * 9 + r) * 6144 + col] = acc[r];
    }
}

__device__ __forceinline__ void phase_modreduce(const Params& p) {
    const float* modp = (const float*)(ows(p) + WS_MODP); float* modv = (float*)(ows(p) + WS_MOD);
    for (int i = obid() * 512 + otid(); i < 4 * 9 * 6144; i += gridDim.x * 512) {
        const int l = i / (9 * 6144), rem = i % (9 * 6144), n = rem % 6144;
        float s = oin(p, 6)[l * 6144 + n];
        for (int j = 0; j < NMODP; ++j) s += modp[((size_t)l * NMODP + j) * 9 * 6144 + rem];
        modv[i] = s;
    }
}

__device__ __forceinline__ void phase_norm1(const Params& p, int l, float scl) {
    const int lane = otid() & 63, wid = otid() >> 6;
    bf16_t* xws = (bf16_t*)(ows(p) + WS_X); bf16_t* hb = (bf16_t*)(ows(p) + WS_H); const bf16_t* yb = (const bf16_t*)(ows(p) + WS_YB);
    const float* modv = (const float*)(ows(p) + WS_MOD);
    const float* nw = oin(p, 4) + (size_t)(l * 2 + 0) * 1024;
    for (int r = obid() * 8 + wid; r < NTOK; r += gridDim.x * 8) {
        const int mr = mod_row(r);
        f32x4 v[4];
        if (l == 0) { const float* src = r < NLAT ? oin(p, 0) + (size_t)r * 1024 : oin(p, 2) + (size_t)(r - NLAT) * 1024;
#pragma unroll
            for (int j = 0; j < 4; ++j) v[j] = *(const f32x4*)(src + 4 * lane + 256 * j); }
        else {
#pragma unroll
            for (int j = 0; j < 4; ++j) v[j] = unpk4_bf16(*(const u32x2*)(xws + (size_t)r * 1024 + 4 * lane + 256 * j)); }
        if (l > 0) {
            const float* g5 = modv + ((size_t)(l - 1) * 9 + mr) * 6144 + 5 * 1024;
#pragma unroll
            for (int j = 0; j < 4; ++j) {
                const int c = 4 * lane + 256 * j;
                const f32x4 gv = *(const f32x4*)(g5 + c);
                f32x4 f;
                if (MOE_FP8) { const unsigned char* y8 = ows(p) + WS_YB8; f = (unpk4_fp8(*(const unsigned*)(y8 + (size_t)(2 * r) * 1024 + c)) + unpk4_fp8(*(const unsigned*)(y8 + (size_t)(2 * r + 1) * 1024 + c))) * (1.0f / 64.0f); }
                else { const u32x2 y0 = *(const u32x2*)(yb + (size_t)(2 * r) * 1024 + c), y1 = *(const u32x2*)(yb + (size_t)(2 * r + 1) * 1024 + c);
                f[0] = bf2f(y0.x & 0xffff) + bf2f(y1.x & 0xffff); f[1] = bf2f(y0.x >> 16) + bf2f(y1.x >> 16);
                f[2] = bf2f(y0.y & 0xffff) + bf2f(y1.y & 0xffff); f[3] = bf2f(y0.y >> 16) + bf2f(y1.y >> 16); }
                v[j] += (gv * scl) * f;
            }
        }
#pragma unroll
        for (int j = 0; j < 4; ++j) { u32x2 o; o.x = cvtpk(v[j][0], v[j][1]); o.y = cvtpk(v[j][2], v[j][3]); *(u32x2*)(xws + (size_t)r * 1024 + 4 * lane + 256 * j) = o; }
        float ss = 0.f;
#pragma unroll
        for (int j = 0; j < 4; ++j) ss += (v[j][0] * v[j][0] + v[j][1] * v[j][1]) + (v[j][2] * v[j][2] + v[j][3] * v[j][3]);
        const float rstd = rsqrtf(wave_sum(ss) * (1.0f / 1024.0f) + EPS);
        const float* msh = modv + ((size_t)l * 9 + mr) * 6144; const float* msc = msh + 1024;
#pragma unroll
        for (int j = 0; j < 4; ++j) {
            const int c = 4 * lane + 256 * j;
            const f32x4 w = *(const f32x4*)(nw + c), sh = *(const f32x4*)(msh + c), sc = *(const f32x4*)(msc + c);
            const f32x4 h = (v[j] * rstd * w) * (1.0f + sc) + sh;
            u32x2 o; o.x = pk2(h[0], h[1]); o.y = pk2(h[2], h[3]);
            *(u32x2*)(hb + (size_t)r * 1024 + c) = o;
        }
    }
}

__device__ __forceinline__ void phase_final(const Params& p) {
    const int lane = otid() & 63, wid = otid() >> 6;
    const bf16_t* xws = (const bf16_t*)(ows(p) + WS_X); const bf16_t* yb = (const bf16_t*)(ows(p) + WS_YB);
    const float* modv = (const float*)(ows(p) + WS_MOD); const float* nw = oin(p, 19);
    for (int r = obid() * 8 + wid; r < NLAT; r += gridDim.x * 8) {
        const int mr = mod_row(r);
        const float* g5 = modv + ((size_t)3 * 9 + mr) * 6144 + 5 * 1024;
        f32x4 v[4]; float ss = 0.f;
#pragma unroll
        for (int j = 0; j < 4; ++j) {
            const int c = 4 * lane + 256 * j;
            v[j] = unpk4_bf16(*(const u32x2*)(xws + (size_t)r * 1024 + c));
            const f32x4 gv = *(const f32x4*)(g5 + c);
            f32x4 f;
            if (MOE_FP8) { const unsigned char* y8 = ows(p) + WS_YB8; f = (unpk4_fp8(*(const unsigned*)(y8 + (size_t)(2 * r) * 1024 + c)) + unpk4_fp8(*(const unsigned*)(y8 + (size_t)(2 * r + 1) * 1024 + c))) * (1.0f / 64.0f); }
            else { const u32x2 y0 = *(const u32x2*)(yb + (size_t)(2 * r) * 1024 + c), y1 = *(const u32x2*)(yb + (size_t)(2 * r + 1) * 1024 + c);
            f[0] = bf2f(y0.x & 0xffff) + bf2f(y1.x & 0xffff); f[1] = bf2f(y0.x >> 16) + bf2f(y1.x >> 16);
            f[2] = bf2f(y0.y & 0xffff) + bf2f(y1.y & 0xffff); f[3] = bf2f(y0.y >> 16) + bf2f(y1.y >> 16); }
            v[j] += gv * f;
            ss += (v[j][0] * v[j][0] + v[j][1] * v[j][1]) + (v[j][2] * v[j][2] + v[j][3] * v[j][3]);
        }
        const float rstd = rsqrtf(wave_sum(ss) * (1.0f / 1024.0f) + EPS);
#pragma unroll
        for (int j = 0; j < 4; ++j) { const int c = 4 * lane + 256 * j; const f32x4 w = *(const f32x4*)(nw + c); *(f32x4*)(p.out + (size_t)r * 1024 + c) = v[j] * rstd * w; }
    }
}

__device__ __forceinline__ void phase_gemm1(const Params& p, int l, unsigned char* lds) {
    const bf16_t* hb = (const bf16_t*)(ows(p) + WS_H); const bf16_t* wt = (const bf16_t*)(ows(p) + WS_WIN) + (size_t)l * 4096 * 1024; bf16_t* pb = (bf16_t*)(ows(p) + WS_P);
    constexpr int NT = PW / 128, MT = NTOK / 128;
    for (int u = obid(); u < MT * NT; u += gridDim.x) {
        const int mt = u / NT, nt = u % NT;
        ARowPlain ar{hb + (size_t)mt * 128 * 1024, 1024};
        EpiP ep{pb + (size_t)mt * 128 * PW + nt * 128};
        gemm128(lds, ar, wt + (size_t)nt * 128 * 1024, 1024, ep);
    }
}

__device__ __forceinline__ void unpack8(const u32x4 w, float (&f)[8]) {
    f[0] = bf2f(w.x & 0xffff); f[1] = bf2f(w.x >> 16); f[2] = bf2f(w.y & 0xffff); f[3] = bf2f(w.y >> 16);
    f[4] = bf2f(w.z & 0xffff); f[5] = bf2f(w.z >> 16); f[6] = bf2f(w.w & 0xffff); f[7] = bf2f(w.w >> 16);
}
__device__ __forceinline__ void conv_rows(const Params& p, int l, int widx, int nwv) {
    const int lane = otid() & 63;
    const bf16_t* pb = (const bf16_t*)(ows(p) + WS_P); bf16_t* yb = (bf16_t*)(ows(p) + WS_Y);
    const float* cw = oin(p, 8) + (size_t)l * 3 * 512; const float* cnw = oin(p, 9) + (size_t)l * 512;
    const int nrows = (l == DEPTH - 1) ? NLAT : NTOK;
    const int c0 = lane * 8;
    float w0[8], w1[8], w2[8], nwv8[8];
#pragma unroll
    for (int j = 0; j < 8; ++j) { w0[j] = cw[c0 + j]; w1[j] = cw[512 + c0 + j]; w2[j] = cw[1024 + c0 + j]; nwv8[j] = cnw[c0 + j]; }
    constexpr int NB = 4;
    for (int rb = widx; rb < nrows; rb += NB * nwv) {
        u32x4 vb[NB], vc[NB], vh[NB], vcm[NB], vhm[NB], vcp[NB], vhp[NB]; bool hm[NB], hp[NB];
#pragma unroll
        for (int q = 0; q < NB; ++q) {
            int r = rb + q * nwv; if (r >= nrows) r = rb;
            int rm = -1, rp = -1;
            if (r < NLAT) {
                const int t = r & 2047;
                if (c0 < 256) { if ((t & 63) > 0) rm = r - 1; if ((t & 63) < 63) rp = r + 1; }
                else { if (t >= 64) rm = r - 64; if (t < SEQ - 64) rp = r + 64; }
            } else { const int tc = (r - NLAT) & 255; if (tc > 0) rm = r - 1; if (tc < 255) rp = r + 1; }
            hm[q] = rm >= 0; hp[q] = rp >= 0; if (rm < 0) rm = r; if (rp < 0) rp = r;
            vb[q] = *(const u32x4*)(pb + (size_t)r * PW + OFF_B + c0); vc[q] = *(const u32x4*)(pb + (size_t)r * PW + OFF_C + c0); vh[q] = *(const u32x4*)(pb + (size_t)r * PW + OFF_HV + c0);
            vcm[q] = *(const u32x4*)(pb + (size_t)rm * PW + OFF_C + c0); vhm[q] = *(const u32x4*)(pb + (size_t)rm * PW + OFF_HV + c0);
            vcp[q] = *(const u32x4*)(pb + (size_t)rp * PW + OFF_C + c0); vhp[q] = *(const u32x4*)(pb + (size_t)rp * PW + OFF_HV + c0);
        }
#pragma unroll
        for (int q = 0; q < NB; ++q) {
            const int r = rb + q * nwv;
            float bg[8], u0[8], um[8], up[8], t1[8];
            unpack8(vb[q], bg); unpack8(vc[q], u0); unpack8(vh[q], t1);
#pragma unroll
            for (int j = 0; j < 8; ++j) u0[j] *= t1[j];
            unpack8(vcm[q], um); unpack8(vhm[q], t1);
#pragma unroll
            for (int j = 0; j < 8; ++j) um[j] = hm[q] ? um[j] * t1[j] : 0.f;
            unpack8(vcp[q], up); unpack8(vhp[q], t1);
#pragma unroll
            for (int j = 0; j < 8; ++j) up[j] = hp[q] ? up[j] * t1[j] : 0.f;
            float z[8]; float ss = 0.f;
#pragma unroll
            for (int j = 0; j < 8; ++j) { z[j] = bg[j] * (w0[j] * um[j] + w1[j] * u0[j] + w2[j] * up[j]); ss += z[j] * z[j]; }
            const float rstd = rsqrtf(wave_sum(ss) * (1.0f / 512.0f) + EPS);
            if (G2_FP8) {
                const float rs8 = rstd * 8.0f; u32x2 o8;
                o8.x = pk4_fp8(z[0] * rs8 * nwv8[0], z[1] * rs8 * nwv8[1], z[2] * rs8 * nwv8[2], z[3] * rs8 * nwv8[3]); o8.y = pk4_fp8(z[4] * rs8 * nwv8[4], z[5] * rs8 * nwv8[5], z[6] * rs8 * nwv8[6], z[7] * rs8 * nwv8[7]);
                if (r < nrows) *(u32x2*)((unsigned char*)yb + (size_t)r * 1024 + c0) = o8;
            } else {
            u32x4 o;
            o.x = cvtpk(z[0] * rstd * nwv8[0], z[1] * rstd * nwv8[1]); o.y = cvtpk(z[2] * rstd * nwv8[2], z[3] * rstd * nwv8[3]);
            o.z = cvtpk(z[4] * rstd * nwv8[4], z[5] * rstd * nwv8[5]); o.w = cvtpk(z[6] * rstd * nwv8[6], z[7] * rstd * nwv8[7]);
            if (r < nrows) *(u32x4*)(yb + (size_t)r * 1024 + c0) = o; }
        }
    }
}

template <int DIR>
__device__ __forceinline__ void gla_pre_dir(const Params& p, int l, int chunk, float* sQ, float* sK, const float* sV, float* sA, float* sBq, float (&oacc)[16]) {
    const int ch = otid(), tid = otid(), R0 = chunk * 16;
    const bf16_t* pb = (const bf16_t*)(ows(p) + WS_P);
    bf16_t* qin = (bf16_t*)(ows(p) + WS_QIN); bf16_t* kout = (bf16_t*)(ows(p) + WS_KOUT); float* dch = (float*)(ows(p) + WS_DCH);
    float lbv = 0.f;
    {
        const float* lb = oin(p, 10) + (size_t)DIR * 4 * 512 + ch;
        const float z0 = lb[0], z1 = lb[512], z2 = lb[1024], z3 = lb[1536];
        const float mx = fmaxf(fmaxf(z0, z1), fmaxf(z2, z3));
        const float e0 = __expf(z0 - mx), e1 = __expf(z1 - mx), e2 = __expf(z2 - mx), e3 = __expf(z3 - mx);
        const float inv = 1.0f / (e0 + e1 + e2 + e3);
        lbv = ((l >= 1 ? e1 : 0.f) + (l >= 2 ? e2 : 0.f) + (l >= 3 ? e3 : 0.f)) * inv;
    }
    float b = 0.f;
#pragma unroll 1
    for (int i = 0; i < 16; ++i) {
        const int row = R0 + (DIR ? 15 - i : i);
        const float zf = bf2f(pb[(size_t)row * PW + OFF_ZF + DIR * 512 + ch]);
        const float sg = 1.0f / (1.0f + __expf(-zf)), sn = 1.0f / (1.0f + __expf(zf));
        const float f = fmaxf(lbv + (1.0f - lbv) * sg, 1e-30f);
        b += __logf(f);
        sBq[i * 512 + ch] = b; sK[i * 512 + ch] = (1.0f - lbv) * sn;
        sQ[i * 512 + ch] = siluf(bf2f(pb[(size_t)row * PW + OFF_Q + ch]));
    }
    const float blast = b;
#pragma unroll 1
    for (int i = 0; i < 16; ++i) {
        const int row = R0 + (DIR ? 15 - i : i);
        const float bi = sBq[i * 512 + ch], kq = sK[i * 512 + ch], qv = sQ[i * 512 + ch];
        const float qi = qv * __expf(bi), kt = kq * __expf(fminf(-bi, 80.0f)), ko = kq * __expf(blast - bi);
        sQ[i * 512 + ch] = qi; sK[i * 512 + ch] = kt;
        qin[((size_t)DIR * NTOK + row) * 512 + ch] = (bf16_t)f2bf(qi);
        kout[((size_t)DIR * NTOK + row) * 512 + ch] = (bf16_t)f2bf(ko);
    }
    dch[((size_t)DIR * NCHUNK + chunk) * 512 + ch] = __expf(blast);
    __syncthreads();
#pragma unroll 1
    for (int e2 = 0; e2 < 2; ++e2) {
        const int e = tid * 2 + e2, h = e >> 8, t = (e >> 4) & 15, s = e & 15;
        float sum = 0.f;
        const float* qp = sQ + t * 512 + h * 128; const float* kp = sK + s * 512 + h * 128;
#pragma unroll 8
        for (int k = 0; k < 128; ++k) sum += qp[k] * kp[k];
        sA[e] = (s <= t) ? sum : 0.f;
    }
    __syncthreads();
    const int h = ch >> 7;
#pragma unroll
    for (int t = 0; t < 16; ++t) {
        float o = 0.f;
#pragma unroll 1
        for (int s = 0; s <= t; ++s) o += sA[(h * 16 + t) * 16 + s] * sV[(DIR ? 15 - s : s) * 512 + ch];
        oacc[DIR ? 15 - t : t] += o;
    }
    __syncthreads();
}

__device__ __forceinline__ void phase_conv_glapre(const Params& p, int l, unsigned char* lds) {
    conv_rows(p, l, obid() * 8 + (otid() >> 6), (int)gridDim.x * 8);
    float* sQ = (float*)lds; float* sK = sQ + 16 * 512; float* sV = sK + 16 * 512; float* sBq = sV + 16 * 512; float* sA = sBq + 16 * 512;
    const bf16_t* pb = (const bf16_t*)(ows(p) + WS_P); float* ointra = (float*)(ows(p) + WS_OINTRA);
    const int ch = otid();
    for (int chunk = obid(); chunk < NCHUNK; chunk += gridDim.x) {
        const int R0 = chunk * 16;
        float oacc[16];
#pragma unroll
        for (int i = 0; i < 16; ++i) oacc[i] = 0.f;
        __syncthreads();
#pragma unroll
        for (int ro = 0; ro < 16; ++ro) sV[ro * 512 + ch] = bf2f(pb[(size_t)(R0 + ro) * PW + OFF_I + ch]);
        gla_pre_dir<0>(p, l, chunk, sQ, sK, sV, sA, sBq, oacc);
        gla_pre_dir<1>(p, l, chunk, sQ, sK, sV, sA, sBq, oacc);
#pragma unroll
        for (int ro = 0; ro < 16; ++ro) ointra[(size_t)(R0 + ro) * 512 + ch] = oacc[ro];
    }
}

__device__ __forceinline__ void phase_gla_seq(const Params& p, int l, unsigned char* lds) {
    const int tid = otid();
    float* S = (float*)lds;
    float* sQ = S + 128 * 32;
    float* sKo = sQ + 16 * 128;
    float* sV = sKo + 16 * 128;
    float* sD = sV + 16 * 32;
    const bf16_t* pb = (const bf16_t*)(ows(p) + WS_P);
    const bf16_t* qin = (const bf16_t*)(ows(p) + WS_QIN); const bf16_t* kout = (const bf16_t*)(ows(p) + WS_KOUT); const float* dch = (const float*)(ows(p) + WS_DCH);
    float* ointer = (float*)(ows(p) + WS_OINTER);
    for (int u = obid(); u < 256; u += gridDim.x) {
        const int vblk = u & 3, dir = (u >> 2) & 1, chain = u >> 3, b = chain >> 2, h = chain & 3;
        __syncthreads();
        for (int i = tid; i < 128 * 32; i += 512) S[i] = 0.f;
        for (int c = 0; c < 144; ++c) {
            int R0;
            if (c < 16) { const int cm = dir ? 15 - c : c; R0 = NLAT + b * 256 + cm * 16; }
            else { const int cc = c - 16; const int cm = dir ? 127 - cc : cc; R0 = b * 2048 + cm * 16; }
            __syncthreads();
            for (int i = tid; i < 16 * 128; i += 512) {
                const int si = i >> 7, k = i & 127; const int row = R0 + (dir ? 15 - si : si);
                const size_t g = ((size_t)dir * NTOK + row) * 512 + h * 128 + k;
                sQ[i] = bf2f(qin[g]); sKo[i] = bf2f(kout[g]);
            }
            { const int si = tid >> 5, vv = tid & 31; const int row = R0 + (dir ? 15 - si : si); sV[tid] = bf2f(pb[(size_t)row * PW + OFF_I + h * 128 + vblk * 32 + vv]); }
            if (tid < 128) sD[tid] = dch[((size_t)dir * NCHUNK + (R0 >> 4)) * 512 + h * 128 + tid];
            __syncthreads();
            {
                const int si = tid >> 5, vv = tid & 31; const int row = R0 + (dir ? 15 - si : si);
                float o = 0.f;
                for (int k = 0; k < 128; ++k) o += sQ[si * 128 + k] * S[k * 32 + vv];
                ointer[((size_t)dir * NTOK + row) * 512 + h * 128 + vblk * 32 + vv] = o;
            }
            __syncthreads();
            {
                const int k = tid >> 2, v0 = (tid & 3) * 8; const float d = sD[k];
                float kk[16];
#pragma unroll
                for (int i = 0; i < 16; ++i) kk[i] = sKo[i * 128 + k];
#pragma unroll
                for (int j = 0; j < 8; ++j) {
                    float s = d * S[k * 32 + v0 + j];
#pragma unroll
                    for (int i = 0; i < 16; ++i) s += kk[i] * sV[i * 32 + v0 + j];
                    S[k * 32 + v0 + j] = s;
                }
            }
        }
    }
}


__device__ __forceinline__ float bflo(unsigned w) { return __uint_as_float(w << 16); }
__device__ __forceinline__ float bfhi(unsigned w) { return __uint_as_float(w & 0xffff0000u); }

template <int DIR>
__device__ __forceinline__ void gla_pre2_dir(const float (&q0a)[16], const float (&q1a)[16], const unsigned (&rz)[16], float lb0, float lb1, unsigned char* wl, unsigned char* rec,
                                             f32x4 (&oT)[8], int lane, int fr, int fq) {
    float bq0[16], bq1[16], kk0[16], kk1[16]; float b0 = 0.f, b1 = 0.f;
#pragma unroll
    for (int i = 0; i < 16; ++i) {
        const int t = DIR ? 15 - i : i;
        const float z0 = bflo(rz[t]), z1 = bfhi(rz[t]);
        const float sg0 = frcp(1.0f + __expf(-z0)), sg1 = frcp(1.0f + __expf(-z1));
        const float f0 = fmaxf(lb0 + (1.0f - lb0) * sg0, 1e-30f), f1 = fmaxf(lb1 + (1.0f - lb1) * sg1, 1e-30f);
        b0 += __logf(f0); b1 += __logf(f1); bq0[t] = b0; bq1[t] = b1; kk0[t] = 1.0f - f0; kk1[t] = 1.0f - f1;
    }
    const float bl0 = b0, bl1 = b1;
    unsigned kw0[8], kw1[8];
#pragma unroll
    for (int i = 0; i < 8; ++i) { kw0[i] = 0u; kw1[i] = 0u; }
#pragma unroll
    for (int t = 0; t < 16; ++t) {
        const float e0 = __expf(bq0[t]), e1 = __expf(bq1[t]);
        const float qi0 = q0a[t] * e0, qi1 = q1a[t] * e1;
        const float kt0 = kk0[t] * frcp(fmaxf(e0, 1.8e-35f)), kt1 = kk1[t] * frcp(fmaxf(e1, 1.8e-35f));
        const float ko0 = kk0[t] * __expf(bl0 - bq0[t]), ko1 = kk1[t] * __expf(bl1 - bq1[t]);
        *(unsigned*)(wl + t * 272 + lane * 4) = cvtpk(qi0, qi1);
        *(unsigned*)(wl + 4352 + t * 272 + lane * 4) = cvtpk(kt0, kt1);
        const unsigned kp = cvtpk(ko0, ko1);
        kw0[t >> 1] |= (kp & 0xffffu) << (16 * (t & 1)); kw1[t >> 1] |= (kp >> 16) << (16 * (t & 1));
    }
    {
        const int c0 = 2 * lane, c1 = c0 + 1;
        unsigned char* k0p = rec + 4096 + (c0 >> 4) * 512 + (c0 & 15) * 8; unsigned char* k1p = rec + 4096 + (c1 >> 4) * 512 + (c1 & 15) * 8;
#pragma unroll
        for (int g = 0; g < 4; ++g) { *(u32x2*)(k0p + g * 128) = (u32x2){kw0[2 * g], kw0[2 * g + 1]}; *(u32x2*)(k1p + g * 128) = (u32x2){kw1[2 * g], kw1[2 * g + 1]}; }
        float* dp = (float*)(rec + 8192) + c0; dp[0] = __expf(bl0); dp[1] = __expf(bl1);
    }
    LDS_WAIT();
#pragma unroll
    for (int s = 0; s < 4; ++s) {
        const u32x2 lo = *(const u32x2*)(wl + fr * 272 + (32 * s + 4 * fq) * 2), hi = *(const u32x2*)(wl + fr * 272 + (32 * s + 16 + 4 * fq) * 2);
        *(u32x4*)(rec + s * 1024 + lane * 16) = (u32x4){lo.x, lo.y, hi.x, hi.y};
    }
    f32x4 at = (f32x4){0.f, 0.f, 0.f, 0.f};
#pragma unroll
    for (int s = 0; s < 4; ++s) {
        const bf16x8 kf = *(const bf16x8*)(wl + 4352 + fr * 272 + (32 * s + 8 * fq) * 2);
        const bf16x8 qf = *(const bf16x8*)(wl + fr * 272 + (32 * s + 8 * fq) * 2);
        at = __builtin_amdgcn_mfma_f32_16x16x32_bf16(kf, qf, at, 0, 0, 0);
    }
#pragma unroll
    for (int r = 0; r < 4; ++r) { const int sp = 4 * fq + r; const bool keep = DIR ? (sp >= fr) : (sp <= fr); at[r] = keep ? at[r] : 0.f; }
    union { u32x2 u; s16x4 h; } bop; bop.u = (u32x2){cvtpk(at[0], at[1]), cvtpk(at[2], at[3])};
#pragma unroll
    for (int vb = 0; vb < 8; ++vb) {
        union { u32x2 u; s16x4 h; } aop; aop.u = *(const u32x2*)(wl + 8704 + (vb * 16 + fr) * 32 + 8 * fq);
        oT[vb] = __builtin_amdgcn_mfma_f32_16x16x16bf16_1k(aop.h, bop.h, oT[vb], 0, 0, 0);
    }
    LDS_WAIT();
}

__device__ __forceinline__ void phase_gla_pre2(const Params& p, int l, unsigned char* lds) {
    const int tid = otid(), lane = tid & 63, wid = __builtin_amdgcn_readfirstlane(tid >> 6), fr = lane & 15, fq = lane >> 4;
    unsigned char* wl = lds + wid * 12800;
    unsigned char* ws = ows(p);
    const bf16_t* pb = (const bf16_t*)(ws + WS_P); bf16_t* ointra = (bf16_t*)(ws + WS_OINTRA);
    float lb[2][2];
    {
        const float* hl = oin(p, 10);
#pragma unroll
        for (int d = 0; d < 2; ++d)
#pragma unroll
            for (int e = 0; e < 2; ++e) {
                const float* q = hl + (size_t)d * 4 * 512 + (2 * lane + e);
                lb[d][e] = 0.f; (void)q;
            }
    }
    for (int unit = wid * (int)gridDim.x + obid(); unit < NCHUNK * 4; unit += gridDim.x * 8) {
        const int chunk = unit >> 2, h = unit & 3, R0 = chunk * 16;
        {
            const float* hl = oin(p, 10);
#pragma unroll
            for (int d = 0; d < 2; ++d)
#pragma unroll
                for (int e = 0; e < 2; ++e) {
                    const float* q = hl + (size_t)d * 4 * 512 + h * 128 + 2 * lane + e;
                    const float z0 = q[0], z1 = q[512], z2 = q[1024], z3 = q[1536];
                    const float mx = fmaxf(fmaxf(z0, z1), fmaxf(z2, z3));
                    const float e0 = __expf(z0 - mx), e1 = __expf(z1 - mx), e2 = __expf(z2 - mx), e3 = __expf(z3 - mx);
                    lb[d][e] = ((l >= 1 ? e1 : 0.f) + (l >= 2 ? e2 : 0.f) + (l >= 3 ? e3 : 0.f)) / (e0 + e1 + e2 + e3);
                }
        }
        unsigned rq[16], rf[16], rb[16], rv[16];
#pragma unroll
        for (int t = 0; t < 16; ++t) {
            const bf16_t* base = pb + (size_t)(R0 + t) * PW + h * 128 + 2 * lane;
            rq[t] = *(const unsigned*)(base + OFF_Q); rf[t] = *(const unsigned*)(base + OFF_ZF); rb[t] = *(const unsigned*)(base + OFF_ZF + 512); rv[t] = *(const unsigned*)(base + OFF_I);
        }
        unsigned char* vrec = ws + WS_VREC + (size_t)(chunk * 4 + h) * VREC_BYTES;
        {
            unsigned w0[8], w1[8];
#pragma unroll
            for (int i = 0; i < 8; ++i) { w0[i] = (rv[2 * i] & 0xffffu) | (rv[2 * i + 1] << 16); w1[i] = (rv[2 * i] >> 16) | (rv[2 * i + 1] & 0xffff0000u); }
            const int c0 = 2 * lane, c1 = c0 + 1;
            unsigned char* v0p = vrec + (c0 >> 4) * 512 + (c0 & 15) * 8; unsigned char* v1p = vrec + (c1 >> 4) * 512 + (c1 & 15) * 8;
#pragma unroll
            for (int g = 0; g < 4; ++g) { *(u32x2*)(v0p + g * 128) = (u32x2){w0[2 * g], w0[2 * g + 1]}; *(u32x2*)(v1p + g * 128) = (u32x2){w1[2 * g], w1[2 * g + 1]}; }
            unsigned char* vl = wl + 8704 + c0 * 32;
            *(u32x4*)(vl) = (u32x4){w0[0], w0[1], w0[2], w0[3]}; *(u32x4*)(vl + 16) = (u32x4){w0[4], w0[5], w0[6], w0[7]};
            *(u32x4*)(vl + 32) = (u32x4){w1[0], w1[1], w1[2], w1[3]}; *(u32x4*)(vl + 48) = (u32x4){w1[4], w1[5], w1[6], w1[7]};
        }
        f32x4 oT[8];
#pragma unroll
        for (int vb = 0; vb < 8; ++vb) oT[vb] = (f32x4){0.f, 0.f, 0.f, 0.f};
        float q0a[16], q1a[16];
#pragma unroll
        for (int t = 0; t < 16; ++t) { q0a[t] = siluf(bflo(rq[t])); q1a[t] = siluf(bfhi(rq[t])); }
        gla_pre2_dir<0>(q0a, q1a, rf, lb[0][0], lb[0][1], wl, ws + WS_GREC + ((size_t)(0 * NCHUNK + chunk) * 4 + h) * REC_BYTES, oT, lane, fr, fq);
        gla_pre2_dir<1>(q0a, q1a, rb, lb[1][0], lb[1][1], wl, ws + WS_GREC + ((size_t)(1 * NCHUNK + chunk) * 4 + h) * REC_BYTES, oT, lane, fr, fq);
#pragma unroll
        for (int vb = 0; vb < 8; ++vb) *(u32x2*)(ointra + (size_t)(R0 + fr) * 512 + h * 128 + vb * 16 + 4 * fq) = (u32x2){cvtpk(oT[vb][0], oT[vb][1]), cvtpk(oT[vb][2], oT[vb][3])};
    }
}

constexpr int GR = 8, STG_BYTES = REC_BYTES + VREC_BYTES;
__device__ __forceinline__ int gla_chunk_of_step(int c, int b, int dir) {
    if (c < 16) { const int cm = dir ? 15 - c : c; return (NLAT + b * 256) / 16 + cm; }
    const int cc = c - 16; const int cm = dir ? 127 - cc : cc; return b * 128 + cm;
}
constexpr int SG_STEP = REC_BYTES + 2048, SG_GRP = 2 * SG_STEP, SG_NG = 6;
constexpr int SG_DUMP = SG_NG * SG_GRP;
constexpr int SG_FLAGS = LDS_MISC + 2048;
constexpr unsigned SG_SPIN = 1u << 22;
static_assert(SG_DUMP + 1024 <= LDS_MISC, "scan ring");
__device__ __forceinline__ void gla_scan_unit(const Params& p, int l, unsigned char* lds_, int chain, int vhalf) {
    LAS unsigned char* lds = (LAS unsigned char*)lds_;
    const int tid = otid(), lane = tid & 63, wid = __builtin_amdgcn_readfirstlane(tid >> 6), fr = lane & 15, fq = lane >> 4;
    unsigned char* ws = ows(p);
    const int b = chain >> 3, h = (chain >> 1) & 3, dir = chain & 1;
    volatile LAS unsigned* flg = (volatile LAS unsigned*)(lds + SG_FLAGS);
    __syncthreads();
    if (tid < 32) flg[tid] = 0u;
    __syncthreads();
    if (wid >= 4) {
        const int m = wid & 3;
        const unsigned char* grec = ws + WS_GREC + (size_t)dir * NCHUNK * 4 * REC_BYTES + (size_t)h * REC_BYTES + lane * 16;
        const unsigned char* vrec = ws + WS_VREC + (size_t)h * VREC_BYTES + vhalf * 2048 + lane * 16;
        const volatile LAS unsigned* dn = flg + 4 + (lane & 3);
#define GSEQ_ISSUE(gi) do { const int _g = (gi); _Pragma("unroll") for (int _j = 0; _j < 6; ++_j) { const int _p = m + 4 * _j; const bool _real = _p < 22; const int _s = _real ? _p / 11 : 0, _q = _real ? _p % 11 : 0; \
        const int _c = 2 * _g + _s; const int _cc = _c < 144 ? _c : 143; const int _ch = gla_chunk_of_step(_cc, b, dir); \
        const unsigned char* _src = (_q < 9) ? grec + (size_t)_ch * 4 * REC_BYTES + _q * 1024 : vrec + (size_t)_ch * 4 * VREC_BYTES + (_q - 9) * 1024; \
        const unsigned _dst = _real ? (unsigned)(_g % SG_NG) * SG_GRP + _s * SG_STEP + _q * 1024 : (unsigned)SG_DUMP; \
        __builtin_amdgcn_global_load_lds((const unsigned*)_src, (LAS unsigned*)(lds + _dst), 16, 0, 0); } } while (0)
#pragma unroll 1
        for (int g = 0; g < SG_NG - 1; ++g) GSEQ_ISSUE(g);
#pragma unroll 1
        for (int g = 0; g < 72; ++g) {
            asm volatile("s_waitcnt vmcnt(%0)" :: "n"((SG_NG - 2) * 6) : "memory");
            if (lane == 0) flg[m] = (unsigned)(g + 1);
            { unsigned sp = 0; while (__builtin_amdgcn_ballot_w64(*dn < (unsigned)g) != 0ull && ++sp < SG_SPIN) __builtin_amdgcn_s_sleep(1); asm volatile("" ::: "memory"); }
            GSEQ_ISSUE(g + SG_NG - 1);
        }
#undef GSEQ_ISSUE
    } else {
        const int vt = wid;
        bf16_t* ointer = (bf16_t*)(ws + WS_OINTER) + (size_t)dir * NTOK * 512 + h * 128 + (vhalf * 4 + vt) * 16 + fr;
        const volatile LAS unsigned* fl = flg + (lane & 3);
        f32x4 acc[8];
#pragma unroll
        for (int j = 0; j < 8; ++j) acc[j] = (f32x4){0.f, 0.f, 0.f, 0.f};
        union { u32x4 u; bf16x8 h; } sb[4];
#pragma unroll
        for (int j = 0; j < 4; ++j) sb[j].u = (u32x4){0u, 0u, 0u, 0u};
#pragma unroll 1
        for (int g = 0; g < 72; ++g) {
            { unsigned sp = 0; while (__builtin_amdgcn_ballot_w64(*fl < (unsigned)(g + 1)) != 0ull && ++sp < SG_SPIN) { } asm volatile("" ::: "memory"); }
#pragma unroll
            for (int s2 = 0; s2 < 2; ++s2) {
                const int c = 2 * g + s2;
                const LAS unsigned char* st = lds + (unsigned)(g % SG_NG) * SG_GRP + s2 * SG_STEP;
                const int chunk = gla_chunk_of_step(c, b, dir);
                bf16x8 qa[4]; f32x4 dv[8];
                union { u32x2 u; s16x4 h; } ka[8], vb;
#pragma unroll
                for (int j = 0; j < 4; ++j) qa[j] = *(const LAS bf16x8*)(st + j * 1024 + lane * 16);
                vb.u = *(const LAS u32x2*)(st + REC_BYTES + vt * 512 + lane * 8);
#pragma unroll
                for (int j = 0; j < 8; ++j) { ka[j].u = *(const LAS u32x2*)(st + 4096 + j * 512 + lane * 8); dv[j] = *(const LAS f32x4*)(st + 8192 + (j * 16 + 4 * fq) * 4); }
                f32x4 o0 = (f32x4){0.f, 0.f, 0.f, 0.f}, o1 = (f32x4){0.f, 0.f, 0.f, 0.f};
                o0 = __builtin_amdgcn_mfma_f32_16x16x32_bf16(qa[0], sb[0].h, o0, 0, 0, 0); o1 = __builtin_amdgcn_mfma_f32_16x16x32_bf16(qa[1], sb[1].h, o1, 0, 0, 0);
                o0 = __builtin_amdgcn_mfma_f32_16x16x32_bf16(qa[2], sb[2].h, o0, 0, 0, 0); o1 = __builtin_amdgcn_mfma_f32_16x16x32_bf16(qa[3], sb[3].h, o1, 0, 0, 0);
#pragma unroll
                for (int j = 0; j < 8; ++j) {
                    acc[j] = acc[j] * dv[j];
                    acc[j] = __builtin_amdgcn_mfma_f32_16x16x16bf16_1k(ka[j].h, vb.h, acc[j], 0, 0, 0);
                }
                const f32x4 os = o0 + o1;
                bf16_t* op = ointer + (size_t)(chunk * 16 + 4 * fq) * 512;
                { const unsigned w01 = cvtpk(os[0], os[1]), w23 = cvtpk(os[2], os[3]); op[0] = (bf16_t)(w01 & 0xffffu); op[512] = (bf16_t)(w01 >> 16); op[1024] = (bf16_t)(w23 & 0xffffu); op[1536] = (bf16_t)(w23 >> 16); }
#pragma unroll
                for (int j = 0; j < 4; ++j) sb[j].u = (u32x4){cvtpk(acc[2 * j][0], acc[2 * j][1]), cvtpk(acc[2 * j][2], acc[2 * j][3]), cvtpk(acc[2 * j + 1][0], acc[2 * j + 1][1]), cvtpk(acc[2 * j + 1][2], acc[2 * j + 1][3])};
            }
            asm volatile("s_waitcnt lgkmcnt(0)" ::: "memory");
            if (lane == 0) flg[4 + wid] = (unsigned)(g + 1);
        }
    }
    asm volatile("s_waitcnt vmcnt(0) lgkmcnt(0)" ::: "memory");
    __syncthreads();
}
__device__ __forceinline__ void phase_gla_seq2(const Params& p, int l, unsigned char* lds) {
    const int G = (int)gridDim.x, bid = obid();
    const int nscan = (G >= 256) ? 128 : G;
    for (int rep = 0; rep < ((DUPK == 50) ? 2 : 1); ++rep) {
        for (int r2 = 0; r2 < ((DUPK == 51) ? 2 : 1); ++r2)
        if (bid < nscan) for (int u = bid; u < 128; u += nscan) { const int x = u & 7, jj = u >> 3; gla_scan_unit(p, l, lds, x + 8 * (jj >> 1), jj & 1); }
        const int cg0 = (G == 256) ? l * CV_LAYER + CV_B : l * CV_ALL, cg1 = (G == 256) ? l * CV_LAYER + CV_B + CV_S : (l + 1) * CV_ALL;
        for (int r3 = 0; r3 < ((DUPK == 52) ? 2 : 1); ++r3)
        if (G > nscan) { if (bid >= nscan) { const int widx = (bid - nscan) * 8 + (otid() >> 6), nwv = (G - nscan) * 8; conv_rows(p, l, widx, nwv); convert_range(p, (float*)(lds + (otid() >> 6) * 16384), widx, nwv, cg0, cg1); } }
        else { const int widx = bid * 8 + (otid() >> 6), nwv = G * 8; __syncthreads(); conv_rows(p, l, widx, nwv); convert_range(p, (float*)(lds + (otid() >> 6) * 16384), widx, nwv, cg0, cg1); }
    }
}

__device__ __forceinline__ void phase_gla_post(const Params& p, int l) {
    const int lane = otid() & 63, wid = otid() >> 6;
    const bf16_t* pb = (const bf16_t*)(ows(p) + WS_P); bf16_t* yb = (bf16_t*)(ows(p) + WS_Y);
    const bf16_t* oi = (const bf16_t*)(ows(p) + WS_OINTRA); const bf16_t* oe = (const bf16_t*)(ows(p) + WS_OINTER);
    const float* hnw = oin(p, 11) + (size_t)l * 128;
    const int nrows = (l == DEPTH - 1) ? NLAT : NTOK;
    const int c0 = lane * 8;
    for (int r = obid() * 8 + wid; r < nrows; r += gridDim.x * 8) {
        float o[8], t1[8], t2[8]; float ss = 0.f;
        unpack8(*(const u32x4*)(oi + (size_t)r * 512 + c0), o); unpack8(*(const u32x4*)(oe + (size_t)r * 512 + c0), t1); unpack8(*(const u32x4*)(oe + ((size_t)NTOK + r) * 512 + c0), t2);
#pragma unroll
        for (int j = 0; j < 8; ++j) { o[j] += t1[j] + t2[j]; ss += o[j] * o[j]; }
        ss += __shfl_xor(ss, 1); ss += __shfl_xor(ss, 2); ss += __shfl_xor(ss, 4); ss += __shfl_xor(ss, 8);
        const float rstd = rsqrtf(ss * (1.0f / 128.0f) + EPS);
        float g[8]; unpack8(*(const u32x4*)(pb + (size_t)r * PW + OFF_G + c0), g);
        float y[8];
#pragma unroll
        for (int j = 0; j < 8; ++j) y[j] = o[j] * rstd * hnw[(c0 + j) & 127] * siluf(g[j]);
        if (G2_FP8) { u32x2 w8; w8.x = pk4_fp8(8.0f * y[0], 8.0f * y[1], 8.0f * y[2], 8.0f * y[3]); w8.y = pk4_fp8(8.0f * y[4], 8.0f * y[5], 8.0f * y[6], 8.0f * y[7]); *(u32x2*)((unsigned char*)yb + (size_t)r * 1024 + 512 + c0) = w8; }
        else { u32x4 w; w.x = pk2(y[0], y[1]); w.y = pk2(y[2], y[3]); w.z = pk2(y[4], y[5]); w.w = pk2(y[6], y[7]);
        *(u32x4*)(yb + (size_t)r * 1024 + 512 + c0) = w; }
    }
}

__device__ __forceinline__ void phase_gemm2(const Params& p, int l, unsigned char* lds) {
    const bf16_t* yb = (const bf16_t*)(ows(p) + WS_Y); const bf16_t* wt = (const bf16_t*)(ows(p) + WS_WOUT) + (size_t)l * 1024 * 1024;
    float* xws = (float*)(ows(p) + WS_X); const float* modv = (const float*)(ows(p) + WS_MOD);
    const int MT = ((l == DEPTH - 1) ? NLAT : NTOK) / 128; constexpr int NT = 8;
    for (int u = obid(); u < MT * NT; u += gridDim.x) {
        const int mt = u / NT, nt = u % NT;
        ARowPlain ar{yb + (size_t)mt * 128 * 1024, 1024};
        EpiRes ep{xws + (size_t)mt * 128 * 1024 + nt * 128, modv + (size_t)l * 9 * 6144 + 2 * 1024 + nt * 128, mt * 128};
        gemm128(lds, ar, wt + (size_t)nt * 128 * 1024, 1024, ep);
    }
}

__device__ __forceinline__ void phase_router(const Params& p, int l) {
    const int lane = otid() & 63, wid = otid() >> 6;
    const float* xws = (const float*)(ows(p) + WS_X); bf16_t* hb = (bf16_t*)(ows(p) + WS_H);
    const float* modv = (const float*)(ows(p) + WS_MOD); const float* nw = oin(p, 4) + (size_t)(l * 2 + 1) * 1024;
    const float* wrg = oin(p, 13) + (size_t)l * 1024 * 4; const float* wre = oin(p, 15) + (size_t)l * 1024 * 32;
    const float* brg = oin(p, 14) + l * 4; const float* bre = oin(p, 16) + l * 32;
    unsigned* cnt = (unsigned*)(ows(p) + WS_CTL) + CW_CNT + 64 * l;
    int* ltok = (int*)(ows(p) + WS_LTOK); float* lgate = (float*)(ows(p) + WS_LGATE);
    const int nrows = (l == DEPTH - 1) ? NLAT : NTOK;
    for (int r = obid() * 8 + wid; r < nrows; r += gridDim.x * 8) {
        const int mr = mod_row(r);
        float ss = 0.f;
#pragma unroll
        for (int j = 0; j < 4; ++j) { const f32x4 xv4 = *(const f32x4*)(xws + (size_t)r * 1024 + 4 * lane + 256 * j); ss += (xv4[0] * xv4[0] + xv4[1] * xv4[1]) + (xv4[2] * xv4[2] + xv4[3] * xv4[3]); }
        const float rstd = rsqrtf(wave_sum(ss) * (1.0f / 1024.0f) + EPS);
        const float* msh = modv + ((size_t)l * 9 + mr) * 6144 + 3 * 1024; const float* msc = msh + 1024;
        float lg[36];
#pragma unroll
        for (int i = 0; i < 36; ++i) lg[i] = 0.f;
#pragma unroll 1
        for (int j = 0; j < 4; ++j) {
            const int c = 4 * lane + 256 * j;
            const f32x4 xv4 = *(const f32x4*)(xws + (size_t)r * 1024 + c);
            const f32x4 w = *(const f32x4*)(nw + c), sh = *(const f32x4*)(msh + c), sc = *(const f32x4*)(msc + c);
            const f32x4 h = (xv4 * rstd * w) * (1.0f + sc) + sh;
            u32x2 o; o.x = pk2(h[0], h[1]); o.y = pk2(h[2], h[3]);
            *(u32x2*)(hb + (size_t)r * 1024 + c) = o;
#pragma unroll
            for (int e = 0; e < 4; ++e) {
                const float xv = h[e];
                const f32x4 wg = *(const f32x4*)(wrg + (size_t)(c + e) * 4);
                lg[0] += xv * wg[0]; lg[1] += xv * wg[1]; lg[2] += xv * wg[2]; lg[3] += xv * wg[3];
#pragma unroll
                for (int q = 0; q < 8; ++q) {
                    const f32x4 we = *(const f32x4*)(wre + (size_t)(c + e) * 32 + q * 4);
                    lg[4 + q * 4 + 0] += xv * we[0]; lg[4 + q * 4 + 1] += xv * we[1]; lg[4 + q * 4 + 2] += xv * we[2]; lg[4 + q * 4 + 3] += xv * we[3];
                }
            }
        }
#pragma unroll
        for (int i = 0; i < 36; ++i) lg[i] = wave_sum(lg[i]);
        float gl[4];
#pragma unroll
        for (int i = 0; i < 4; ++i) gl[i] = lg[i] + brg[i];
        int gsel = 0; float gmax = gl[0];
#pragma unroll
        for (int i = 1; i < 4; ++i) if (gl[i] > gmax) { gmax = gl[i]; gsel = i; }
        float gs = 0.f;
#pragma unroll
        for (int i = 0; i < 4; ++i) gs += __expf(gl[i] - gmax);
        const float pg = 1.0f / gs;
        float el[8];
#pragma unroll
        for (int j = 0; j < 8; ++j) {
            float t = lg[4 + j] + bre[j];
#pragma unroll
            for (int g = 1; g < 4; ++g) t = (gsel == g) ? (lg[4 + g * 8 + j] + bre[g * 8 + j]) : t;
            el[j] = t;
        }
        int i1 = 0; float v1 = el[0];
#pragma unroll
        for (int j = 1; j < 8; ++j) if (el[j] > v1) { v1 = el[j]; i1 = j; }
        int i2 = -1; float v2 = -3.0e38f;
#pragma unroll
        for (int j = 0; j < 8; ++j) if (j != i1 && el[j] > v2) { v2 = el[j]; i2 = j; }
        const float e2 = __expf(v2 - v1);
        const float g0 = pg / (1.0f + e2), g1 = pg * e2 / (1.0f + e2);
        if (lane == 0) {
            const int ea = gsel * 8 + i1, eb = gsel * 8 + i2;
            const unsigned pa = atomicAdd(cnt + ea, 1u); ltok[(size_t)ea * NTOK + pa] = r * 2 + 0; lgate[(size_t)ea * NTOK + pa] = g0;
            const unsigned pb2 = atomicAdd(cnt + eb, 1u); ltok[(size_t)eb * NTOK + pb2] = r * 2 + 1; lgate[(size_t)eb * NTOK + pb2] = g1;
        }
    }
}


__device__ __forceinline__ void phase_router2(const Params& p, int l, unsigned char* lds, bool commit) {
    const int tid = otid(), lane = tid & 63, wid = __builtin_amdgcn_readfirstlane(tid >> 6), fr = lane & 15, fq = lane >> 4;
    unsigned char* ws = ows(p);
    const bf16_t* xws = (const bf16_t*)(ws + WS_X); bf16_t* xw = (bf16_t*)(ws + WS_X); const bf16_t* dlt = (const bf16_t*)(ws + WS_DELTA); bf16_t* hb = (bf16_t*)(ws + WS_H);
    const float* modv = (const float*)(ws + WS_MOD); const float* nw = oin(p, 4) + (size_t)(l * 2 + 1) * 1024;
    const float* brg = oin(p, 14) + l * 4; const float* bre = oin(p, 16) + l * 32;
    unsigned* gcnt = (unsigned*)(ws + WS_CTL) + CW_CNT + 64 * 32 * l;
    int* ltok = (int*)(ws + WS_LTOK); float* lgate = (float*)(ws + WS_LGATE);
    constexpr int WPITCH = 2064, WBYTES = 48 * WPITCH;
    unsigned char* wl = lds;
    float* tile = (float*)(lds + WBYTES + wid * 3328);
    int* s_cnt = (int*)(lds + WBYTES + 8 * 3328); int* s_base = s_cnt + 32;
    int* s_e = s_base + 32; int* s_rank = s_e + 256; int* s_tok = s_rank + 256; float* s_gate = (float*)(s_tok + 256);
    __syncthreads();
    {
        const bf16_t* wrh = (const bf16_t*)(ws + WS_WRH) + (size_t)l * 48 * 1024;
        for (int i = tid; i < 48 * 128; i += 512) { const int r = i >> 7, c = i & 127; *(u32x4*)(wl + r * WPITCH + c * 16) = *(const u32x4*)(wrh + (size_t)r * 1024 + c * 8); }
    }
    const int NG = ((l == DEPTH - 1) ? NLAT : NTOK) / 16;
    const int NWV = (int)gridDim.x * 8;
    for (int it = 0; it * NWV < NG; ++it) {
        const int g = it * NWV + wid * (int)gridDim.x + obid();
        __syncthreads();
        if (tid < 32) s_cnt[tid] = 0;
        if (tid < 256) s_e[tid] = -1;
        __syncthreads();
        if (g < NG) {
            const int R0 = g * 16, mr = mod_row(R0);
            float my_rstd = 0.f;
#pragma unroll
            for (int rb = 0; rb < 4; ++rb) {
                f32x4 xv[4][4]; u32x2 dl[4][4], xr[4][4];
#pragma unroll
                for (int rr = 0; rr < 4; ++rr)
#pragma unroll
                    for (int j = 0; j < 4; ++j) { xr[rr][j] = *(const u32x2*)(xws + (size_t)(R0 + rb * 4 + rr) * 1024 + 4 * lane + 256 * j); dl[rr][j] = *(const u32x2*)(dlt + (size_t)(R0 + rb * 4 + rr) * 1024 + 4 * lane + 256 * j); }
#pragma unroll
                for (int rr = 0; rr < 4; ++rr) {
#pragma unroll
                    for (int j = 0; j < 4; ++j) xv[rr][j] = unpk4_bf16(xr[rr][j]);
                    if (commit) {
#pragma unroll
                        for (int j = 0; j < 4; ++j) { xv[rr][j] += unpk4_bf16(dl[rr][j]); u32x2 o; o.x = cvtpk(xv[rr][j][0], xv[rr][j][1]); o.y = cvtpk(xv[rr][j][2], xv[rr][j][3]); *(u32x2*)(xw + (size_t)(R0 + rb * 4 + rr) * 1024 + 4 * lane + 256 * j) = o;
                            xv[rr][j] = unpk4_bf16(o); }
                    }
                    float ss = 0.f;
#pragma unroll
                    for (int j = 0; j < 4; ++j) ss += (xv[rr][j][0] * xv[rr][j][0] + xv[rr][j][1] * xv[rr][j][1]) + (xv[rr][j][2] * xv[rr][j][2] + xv[rr][j][3] * xv[rr][j][3]);
                    const float rs = rsqrtf(wave_sum(ss) * (1.0f / 1024.0f) + EPS);
                    my_rstd = (rb * 4 + rr == fr) ? rs : my_rstd;
                }
            }
            asm volatile("s_waitcnt vmcnt(0)" ::: "memory");
            const float* msh = modv + ((size_t)l * 9 + mr) * 6144 + 3 * 1024 + 8 * fq; const float* msc = msh + 1024; const float* nwp = nw + 8 * fq;
            const bf16_t* xrow = xws + (size_t)(R0 + fr) * 1024 + 8 * fq; bf16_t* hrow = hb + (size_t)(R0 + fr) * 1024 + 8 * fq; unsigned char* h8row = ws + WS_H8 + (size_t)(R0 + fr) * 1024 + 8 * fq;
            f32x4 acc[3];
#pragma unroll
            for (int nt = 0; nt < 3; ++nt) acc[nt] = (f32x4){0.f, 0.f, 0.f, 0.f};
#pragma unroll 1
            for (int kq = 0; kq < 4; ++kq) {
                u32x4 xab[8];
#pragma unroll
                for (int u = 0; u < 8; ++u) xab[u] = *(const u32x4*)(xrow + 256 * kq + 32 * u);
#pragma unroll
                for (int u = 0; u < 8; ++u) {
                    const int k = 256 * kq + 32 * u;
                    float hv[8];
                    const f32x4 xaq[2] = {unpk4_bf16((u32x2){xab[u].x, xab[u].y}), unpk4_bf16((u32x2){xab[u].z, xab[u].w})};
#pragma unroll
                    for (int q = 0; q < 2; ++q) {
                        const f32x4 w = *(const f32x4*)(nwp + k + 4 * q), sh = *(const f32x4*)(msh + k + 4 * q), sc = *(const f32x4*)(msc + k + 4 * q);
                        const f32x4 h = (xaq[q] * my_rstd * w) * (1.0f + sc) + sh;
                        hv[4 * q + 0] = h[0]; hv[4 * q + 1] = h[1]; hv[4 * q + 2] = h[2]; hv[4 * q + 3] = h[3];
                    }
                    union { u32x4 u; bf16x8 h; } ah, al;
                    ah.u = (u32x4){cvtpk(hv[0], hv[1]), cvtpk(hv[2], hv[3]), cvtpk(hv[4], hv[5]), cvtpk(hv[6], hv[7])};
                    float lv[8];
#pragma unroll
                    for (int q = 0; q < 4; ++q) { const unsigned w2 = q == 0 ? ah.u.x : q == 1 ? ah.u.y : q == 2 ? ah.u.z : ah.u.w; lv[2 * q] = hv[2 * q] - __uint_as_float(w2 << 16); lv[2 * q + 1] = hv[2 * q + 1] - __uint_as_float(w2 & 0xffff0000u); }
                    al.u = (u32x4){cvtpk(lv[0], lv[1]), cvtpk(lv[2], lv[3]), cvtpk(lv[4], lv[5]), cvtpk(lv[6], lv[7])};
                    if (MOE_FP8) { u32x2 h8; h8.x = pk4_fp8(hv[0], hv[1], hv[2], hv[3]); h8.y = pk4_fp8(hv[4], hv[5], hv[6], hv[7]); *(u32x2*)(h8row + k) = h8; }
                    else *(u32x4*)(hrow + k) = ah.u;
#pragma unroll
                    for (int nt = 0; nt < 3; ++nt) {
                        const bf16x8 bh = *(const bf16x8*)(wl + (nt * 16 + fr) * WPITCH + (k + 8 * fq) * 2);
                        acc[nt] = __builtin_amdgcn_mfma_f32_16x16x32_bf16(ah.h, bh, acc[nt], 0, 0, 0);
                        acc[nt] = __builtin_amdgcn_mfma_f32_16x16x32_bf16(al.h, bh, acc[nt], 0, 0, 0);
                    }
                }
            }
#pragma unroll
            for (int nt = 0; nt < 3; ++nt)
#pragma unroll
                for (int r = 0; r < 4; ++r) tile[(4 * fq + r) * 52 + nt * 16 + fr] = acc[nt][r];
            LDS_WAIT();
            if (lane < 16) {
                const float* lg = tile + lane * 52;
                float gl[4];
#pragma unroll
                for (int i = 0; i < 4; ++i) gl[i] = lg[i] + brg[i];
                int gsel = 0; float gmax = gl[0];
#pragma unroll
                for (int i = 1; i < 4; ++i) if (gl[i] > gmax) { gmax = gl[i]; gsel = i; }
                float gs = 0.f;
#pragma unroll
                for (int i = 0; i < 4; ++i) gs += __expf(gl[i] - gmax);
                const float pg = 1.0f / gs;
                float el[8];
#pragma unroll
                for (int j = 0; j < 8; ++j) el[j] = lg[4 + gsel * 8 + j] + bre[gsel * 8 + j];
                int i1 = 0; float v1 = el[0];
#pragma unroll
                for (int j = 1; j < 8; ++j) if (el[j] > v1) { v1 = el[j]; i1 = j; }
                int i2 = -1; float v2 = -3.0e38f;
#pragma unroll
                for (int j = 0; j < 8; ++j) if (j != i1 && el[j] > v2) { v2 = el[j]; i2 = j; }
                const float e2 = __expf(v2 - v1);
                const float g0 = pg / (1.0f + e2), g1 = pg * e2 / (1.0f + e2);
                const int ea = gsel * 8 + i1, eb = gsel * 8 + i2, slot = (wid * 16 + lane) * 2, r = R0 + lane;
                s_e[slot] = ea; s_rank[slot] = atomicAdd(&s_cnt[ea], 1); s_tok[slot] = r * 2; s_gate[slot] = g0;
                s_e[slot + 1] = eb; s_rank[slot + 1] = atomicAdd(&s_cnt[eb], 1); s_tok[slot + 1] = r * 2 + 1; s_gate[slot + 1] = g1;
            }
        }
        __syncthreads();
        if (tid < 32) { const int c = s_cnt[tid]; s_base[tid] = (c > 0 && commit) ? (int)atomicAdd(gcnt + 64 * tid, (unsigned)c) : 0; }
        __syncthreads();
        if (tid < 256) { const int e = s_e[tid]; if (e >= 0 && commit) { const size_t pos = (size_t)e * NTOK + s_base[e] + s_rank[tid]; ltok[pos] = s_tok[tid]; lgate[pos] = s_gate[tid]; } }
    }
}

__device__ __forceinline__ int moe_tables(const Params& p, int l, unsigned char* lds) {
    int* s_pref = (int*)(lds + LDS_MISC); int* s_cnt = s_pref + 40;
    unsigned* cnt = (unsigned*)(ows(p) + WS_CTL) + CW_CNT + 64 * l;
    __syncthreads();
    if (otid() == 0) {
        int acc = 0;
        for (int e = 0; e < NEXP; ++e) { const int c = (int)__hip_atomic_load(cnt + e, __ATOMIC_RELAXED, __HIP_MEMORY_SCOPE_AGENT); s_cnt[e] = c; s_pref[e] = acc; acc += (c + 127) >> 7; }
        s_pref[NEXP] = acc;
    }
    __syncthreads();
    return s_pref[NEXP];
}
__device__ __forceinline__ void phase_moe_gu(const Params& p, int l, unsigned char* lds) {
    const int T = moe_tables(p, l, lds);
    const int* s_pref = (const int*)(lds + LDS_MISC); const int* s_cnt = s_pref + 40;
    const bf16_t* hb = (const bf16_t*)(ows(p) + WS_H); bf16_t* hid = (bf16_t*)(ows(p) + WS_HID);
    const int* ltok = (const int*)(ows(p) + WS_LTOK);
    for (int u = obid(); u < T * 8; u += gridDim.x) {
        const int mtg = u >> 3, nt = u & 7;
        int e = 0;
        for (int q = 1; q < NEXP; ++q) if (s_pref[q] <= mtg) e = q;
        const int mt = mtg - s_pref[e]; const int nvalid = min(128, s_cnt[e] - mt * 128);
        ARowGather ar{hb, ltok + (size_t)e * NTOK + mt * 128, nvalid};
        EpiGU ep{hid + (size_t)mtg * 128 * 512 + nt * 64};
        gemm128(lds, ar, (const bf16_t*)(ows(p) + WS_WGU) + ((size_t)(l * 32 + e) * 1024 + nt * 128) * 1024, 1024, ep);
    }
}
__device__ __forceinline__ void phase_moe_down(const Params& p, int l, unsigned char* lds) {
    const int T = moe_tables(p, l, lds);
    const int* s_pref = (const int*)(lds + LDS_MISC); const int* s_cnt = s_pref + 40;
    const bf16_t* hid = (const bf16_t*)(ows(p) + WS_HID); bf16_t* yb = (bf16_t*)(ows(p) + WS_YB);
    const int* ltok = (const int*)(ows(p) + WS_LTOK); const float* lgate = (const float*)(ows(p) + WS_LGATE);
    for (int u = obid(); u < T * 8; u += gridDim.x) {
        const int mtg = u >> 3, nt = u & 7;
        int e = 0;
        for (int q = 1; q < NEXP; ++q) if (s_pref[q] <= mtg) e = q;
        const int mt = mtg - s_pref[e]; const int nvalid = min(128, s_cnt[e] - mt * 128);
        ARowPlain ar{hid + (size_t)mtg * 128 * 512, 512};
        EpiDown ep{yb + nt * 128, ltok + (size_t)e * NTOK + mt * 128, lgate + (size_t)e * NTOK + mt * 128, nvalid};
        gemm128(lds, ar, (const bf16_t*)(ows(p) + WS_WDN) + ((size_t)(l * 32 + e) * 1024 + nt * 128) * 512, 512, ep);
    }
}


#ifndef FAST_G1
#define FAST_G1 1
#endif
#ifndef FAST_G2
#define FAST_G2 1
#endif
#ifndef FAST_MOE
#define FAST_MOE 1
#endif
#ifndef FAST_GLA
#define FAST_GLA 1
#endif
#ifndef FAST_RT
#define FAST_RT 1
#endif
__device__ __forceinline__ void phase_gemm1_fast(const Params& p, int l, unsigned char* lds) {
    g8::DenseOrder S; S.init(NTOK / 256, PW / 256, (int)gridDim.x, obid(), (const bf16_t*)(ows(p) + WS_WIN) + (size_t)l * 4096 * 1024, 1024);
    g8::EpiP2 E{(bf16_t*)(ows(p) + WS_P)};
    g8::gemm_phase((LAS unsigned char*)lds, (const char*)(ows(p) + WS_H), 1024, S, E);
    if (gridDim.x == 256 && obid() >= 128) { __syncthreads(); convert_range(p, (float*)(lds + (otid() >> 6) * 16384), (obid() - 128) * 8 + (otid() >> 6), 128 * 8, l * CV_LAYER, l * CV_LAYER + CV_B); }
}
__device__ __forceinline__ void phase_gemm2_fast(const Params& p, int l, unsigned char* lds, float scl) {
    g8::DenseOrder S; g8::EpiDelta E{(bf16_t*)(ows(p) + WS_DELTA), (const float*)(ows(p) + WS_MOD) + (size_t)l * 9 * 6144 + 2 * 1024, scl};
    if (G2_FP8) {
        S.init(((l == DEPTH - 1) ? NLAT : NTOK) / 256, 4, (int)gridDim.x, obid(), ows(p) + WS_WOUT + (size_t)l * 1024 * 1024, 1024, 1);
        g8::gemm_phase8<0x7A7A7A7A, 0x7C7C7C7C>((LAS unsigned char*)lds, (const char*)(ows(p) + WS_Y), 1024, S, E);
    } else {
        S.init(((l == DEPTH - 1) ? NLAT : NTOK) / 256, 4, (int)gridDim.x, obid(), (const bf16_t*)(ows(p) + WS_WOUT) + (size_t)l * 1024 * 1024, 1024);
        g8::gemm_phase((LAS unsigned char*)lds, (const char*)(ows(p) + WS_Y), 1024, S, E);
    }
    if (gridDim.x == 256 && l < DEPTH - 1 && obid() >= 32 && scl != 0.0f) { __syncthreads(); convert_range(p, (float*)(lds + (otid() >> 6) * 16384), (obid() - 32) * 8 + (otid() >> 6), 224 * 8, l * CV_LAYER + CV_B + CV_S, (l + 1) * CV_LAYER); }
}
__device__ __forceinline__ int moe_tables256(const Params& p, int l, unsigned char* lds) {
    int* s_pref = (int*)(lds + LDS_MISC); int* s_cnt = s_pref + 40;
    unsigned* cnt = (unsigned*)(ows(p) + WS_CTL) + CW_CNT + 64 * 32 * l;
    __syncthreads();
    if (otid() < 64) {
        const int lane = otid();
        const int c = (lane < NEXP) ? (int)__hip_atomic_load(cnt + 64 * lane, __ATOMIC_RELAXED, __HIP_MEMORY_SCOPE_AGENT) : 0;
        const int t = (c + 255) >> 8; int incl = t;
#pragma unroll
        for (int d = 1; d < 32; d <<= 1) { const int o = __shfl_up(incl, d); if (lane >= d) incl += o; }
        if (lane < NEXP) { s_cnt[lane] = c; s_pref[lane] = incl - t; }
        if (lane == NEXP - 1) s_pref[NEXP] = incl;
    }
    __syncthreads();
    return s_pref[NEXP];
}
__device__ __forceinline__ void moe_setup(const Params& p, int l, unsigned char* lds) {
    const int T = moe_tables256(p, l, lds);
    const int* s_pref = (const int*)(lds + LDS_MISC); const int* s_cnt = s_pref + 40;
    int* utab = (int*)(lds + g8::MOE_UTAB); int* rtok = (int*)(lds + g8::MOE_RTOK); float* rgate = (float*)(lds + g8::MOE_RGATE);
    const int tid = otid(), G = (int)gridDim.x, c = obid();
    if (tid < 4) {
        const int L = tid * G + c; int* t = utab + tid * 8;
        if (L < T * 4) {
            const int mtg = L >> 2; int e = 0;
            for (int q = 1; q < NEXP; ++q) if (s_pref[q] <= mtg) e = q;
            const int mt = mtg - s_pref[e];
            t[0] = mtg; t[1] = L & 3; t[2] = e; t[3] = min(256, s_cnt[e] - mt * 256); t[4] = e * NTOK + mt * 256; t[5] = 1;
        } else { int z = 0; asm volatile("" : "+v"(z)); t[0] = z; t[1] = z; t[2] = z; t[3] = z; t[4] = z; t[5] = z; }
    }
    __syncthreads();
    const int* ltok = (const int*)(ows(p) + WS_LTOK); const float* lgate = (const float*)(ows(p) + WS_LGATE);
    for (int idx = tid; idx < 1024; idx += 512) {
        const int i = idx >> 8, r = idx & 255; const int* t = utab + i * 8;
        const bool ok = t[5] != 0 && r < t[3];
        rtok[idx] = ok ? ltok[t[4] + r] : 0; rgate[idx] = ok ? lgate[t[4] + r] : 0.f;
    }
    __syncthreads();
}
__device__ __forceinline__ void phase_moe_gu_fast(const Params& p, int l, unsigned char* lds) {
    moe_setup(p, l, lds);
    g8::MoeOrder<true> S; S.utab = (const int*)(lds + g8::MOE_UTAB); S.rtok = (const int*)(lds + g8::MOE_RTOK); S.K = 1024;
    if (MOE_FP8) {
        S.W = (const char*)(ows(p) + WS_WGU8) + (size_t)l * 32 * 1024 * 1024; S.bpe = 1;
        g8::EpiGU8 E{ows(p) + WS_HID8};
        g8::gemm_phase8<0x7A7A7A7A, 0x7F7F7F7F>((LAS unsigned char*)lds, (const char*)(ows(p) + WS_H8), 1024, S, E);
    } else {
        S.W = (const char*)(ows(p) + WS_WGU) + (size_t)l * 32 * 1024 * 1024 * 2; S.bpe = 2;
        g8::EpiGU2 E{(bf16_t*)(ows(p) + WS_HID)};
        g8::gemm_phase((LAS unsigned char*)lds, (const char*)(ows(p) + WS_H), 1024, S, E);
    }
}
__device__ __forceinline__ void phase_moe_down_fast(const Params& p, int l, unsigned char* lds) {
    if (!(FAST_MOE && MOE_FP8) || DUPK == 10 || p.ph_hi - p.ph_lo == 1) moe_setup(p, l, lds);
    g8::MoeOrder<false> S; S.utab = (const int*)(lds + g8::MOE_UTAB); S.rtok = (const int*)(lds + g8::MOE_RTOK); S.K = 512;
    g8::EpiDown2 E{(bf16_t*)(ows(p) + WS_YB), (const int*)(lds + g8::MOE_RTOK), (const float*)(lds + g8::MOE_RGATE)};
    if (MOE_FP8) {
        S.W = (const char*)(ows(p) + WS_WDN8) + (size_t)l * 32 * 1024 * 512; S.bpe = 1;
        g8::EpiDown8 E8{ows(p) + WS_YB8, (const int*)(lds + g8::MOE_RTOK), (const float*)(lds + g8::MOE_RGATE)};
        g8::gemm_phase8<0x7B7B7B7B, 0x7E7E7E7E>((LAS unsigned char*)lds, (const char*)(ows(p) + WS_HID8), 512, S, E8);
    } else {
        S.W = (const char*)(ows(p) + WS_WDN) + (size_t)l * 32 * 1024 * 512 * 2; S.bpe = 2;
        g8::gemm_phase((LAS unsigned char*)lds, (const char*)(ows(p) + WS_HID), 512, S, E);
    }
}

__device__ __forceinline__ void phase_c(const Params& p, int l, unsigned char* lds) {
    phase_gla_pre2(p, l, lds);
}

__global__ void __launch_bounds__(512, 2) mk(Params p) {
    extern __shared__ __attribute__((aligned(16))) unsigned char lds[];
    const int lo = p.ph_lo, hi = p.ph_hi;
    volatile LAS unsigned* misc = (volatile LAS unsigned*)(lds + LDS_MISC + 1024);
    if (threadIdx.x < 4) misc[threadIdx.x] = 0u;
    __syncthreads();
    XcdBarrier bar; bar.bar = (unsigned*)(p.ws + WS_CTL) + CW_BAR; bar.x = 0; bar.st = misc;
    if (hi - lo > 1) bar = xcd_barrier_post((unsigned*)(p.ws + WS_CTL) + CW_BAR, misc);
#define IN(k) (lo <= (k) && (k) < hi)
#define SEAM(k) do { if (IN((k) + 1)) { xcd_barrier(bar); if (DUPK == 20) xcd_barrier(bar); } } while (0)
#define REP(kind) for (int _rep = 0; _rep < ((DUPK == (kind)) ? 2 : 1); ++_rep)
    if (IN(0)) { REP(0) phase_prologue(p, lds); SEAM(0); }
    if (IN(1)) { REP(1) phase_modreduce(p); SEAM(1); }
    for (int l = 0; l < DEPTH; ++l) {
        const int pb = 2 + 9 * l;
        if (IN(pb + 0)) { if (DUPK == 2) phase_norm1(p, l, (float)(lo > 1000)); phase_norm1(p, l, 1.0f); SEAM(pb + 0); }
        if (IN(pb + 1)) { REP(3) { if (FAST_G1) phase_gemm1_fast(p, l, lds); else phase_gemm1(p, l, lds); } SEAM(pb + 1); }
        if (IN(pb + 2)) { REP(4) { phase_c(p, l, lds); } SEAM(pb + 2); }
        if (IN(pb + 3)) { REP(5) { phase_gla_seq2(p, l, lds); } SEAM(pb + 3); }
        if (IN(pb + 4)) { REP(6) phase_gla_post(p, l); SEAM(pb + 4); }
        if (IN(pb + 5)) { if (DUPK == 7) phase_gemm2_fast(p, l, lds, (float)(lo > 1000)); phase_gemm2_fast(p, l, lds, 1.0f); SEAM(pb + 5); }
        if (IN(pb + 6)) { if (DUPK == 8) phase_router2(p, l, lds, lo > 1000); phase_router2(p, l, lds, true); SEAM(pb + 6); }
        if (IN(pb + 7)) { REP(9) { if (FAST_MOE) phase_moe_gu_fast(p, l, lds); else phase_moe_gu(p, l, lds); } SEAM(pb + 7); }
        if (IN(pb + 8)) { REP(10) { if (FAST_MOE) phase_moe_down_fast(p, l, lds); else phase_moe_down(p, l, lds); } SEAM(pb + 8); }
    }
    if (IN(NPH - 1)) { REP(11) phase_final(p); }
#undef IN
#undef SEAM
}

#ifndef MK_LAUNCHES
#define MK_LAUNCHES 1
#endif
extern "C" void kernel_launch(void* const* d_in, const int* in_sizes, int n_in, void* d_out, int out_size, void* d_ws, size_t ws_size, hipStream_t stream) {
    static int grid = 0;
    if (grid == 0) {
        int dev = 0, cus = 0;
        if (n_in != 20 || ws_size < WS_END) { fprintf(stderr, "kernel_launch: unexpected shapes (n_in %d, ws %zu < %zu)\n", n_in, ws_size, (size_t)WS_END); grid = -1; return; }
        if (hipGetDevice(&dev) != hipSuccess || hipDeviceGetAttribute(&cus, hipDeviceAttributeMultiprocessorCount, dev) != hipSuccess) { grid = -1; return; }
        if (hipFuncSetAttribute((const void*)mk, hipFuncAttributeMaxDynamicSharedMemorySize, LDS_BYTES) != hipSuccess) { fprintf(stderr, "kernel_launch: hipFuncSetAttribute failed\n"); grid = -1; return; }
        (void)hipGetLastError();
        grid = cus;
    }
    if (grid < 0) return;
    (void)hipMemsetAsync((char*)d_ws + WS_CTL, 0, CTL_BYTES, stream);
    Params p{};
    for (int i = 0; i < 20; ++i) p.in[i] = (const float*)d_in[i];
    p.out = (float*)d_out; p.ws = (unsigned char*)d_ws;
    if (MK_LAUNCHES == 1) { p.ph_lo = 0; p.ph_hi = NPH; hipLaunchKernelGGL(mk, dim3(grid), dim3(512), LDS_BYTES, stream, p); }
    else for (int ph = 0; ph < NPH; ++ph) { p.ph_lo = ph; p.ph_hi = ph + 1; hipLaunchKernelGGL(mk, dim3(grid), dim3(512), LDS_BYTES, stream, p); }
}
```

```cpp
#include <hip/hip_runtime.h>
#include <stdint.h>
#include <stdio.h>

typedef unsigned short bf16_t;
typedef short bf16x8 __attribute__((ext_vector_type(8)));
typedef float f32x4 __attribute__((ext_vector_type(4)));
typedef unsigned u32x4 __attribute__((ext_vector_type(4)));
typedef unsigned u32x2 __attribute__((ext_vector_type(2)));
typedef int i32x8 __attribute__((ext_vector_type(8)));
typedef int i32x4 __attribute__((ext_vector_type(4)));
typedef short s16x4 __attribute__((ext_vector_type(4)));
typedef float f32x2 __attribute__((ext_vector_type(2)));
#define LAS __attribute__((address_space(3)))
#define GAS __attribute__((address_space(1)))

#ifndef G2_FP8
#define G2_FP8 1
#endif
#ifndef DUPK
#define DUPK -1
#endif
#ifndef MOE_FP8
#define MOE_FP8 1
#endif
constexpr int D = 1024, NB = 8, SEQ = 2048, DEPTH = 4, CTXL = 256;
constexpr int NLAT = NB * SEQ, NCTX = NB * CTXL, NTOK = NLAT + NCTX;
constexpr int PW = 4096;
constexpr int OFF_B = 0, OFF_C = 512, OFF_HV = 1024, OFF_Q = 1536, OFF_ZF = 2048, OFF_I = 3072, OFF_G = 3584;
constexpr int NEXP = 32;
constexpr int NCHUNK = NTOK / 16;
constexpr float EPS = 1e-6f;
constexpr int NMODP = 16;
constexpr int CV_ALL = 32 * (16 * 32 + 8 * 32), CV_B = 128 * 8 * 7, CV_F = 224 * 8 * 6;
constexpr int CV_S = (4 * CV_ALL - 4 * CV_B - 3 * CV_F) / 4, CV_LAYER = CV_B + CV_S + CV_F;
static_assert(4 * CV_B + 4 * CV_S + 3 * CV_F == 4 * CV_ALL, "conversion schedule");
static_assert(CV_LAYER >= CV_ALL && 3 * CV_LAYER + CV_B + CV_S == 4 * CV_ALL, "conversion schedule");

constexpr size_t WS_CTL = 0, CTL_BYTES = 65536;
constexpr size_t WS_WIN = WS_CTL + CTL_BYTES;
constexpr size_t WS_WOUT = WS_WIN + (size_t)4 * 4096 * 1024 * 2;
constexpr size_t WS_WGU = WS_WOUT + (size_t)4 * 1024 * 1024 * 2;
constexpr size_t WS_WDN = WS_WGU + (size_t)4 * 32 * 1024 * 1024 * 2;
constexpr size_t WS_MODP = WS_WDN + (size_t)4 * 32 * 1024 * 512 * 2;
constexpr size_t WS_MOD = WS_MODP + (size_t)4 * NMODP * 9 * 6144 * 4;
constexpr size_t WS_X = WS_MOD + (size_t)4 * 9 * 6144 * 4;
constexpr size_t WS_H = WS_X + (size_t)NTOK * 1024 * 4;
constexpr size_t WS_P = WS_H + (size_t)NTOK * 1024 * 2;
constexpr size_t WS_Y = WS_P + (size_t)NTOK * 4096 * 2;
constexpr size_t WS_QIN = WS_Y + (size_t)NTOK * 1024 * 2;
constexpr size_t WS_KOUT = WS_QIN + (size_t)2 * NTOK * 512 * 2;
constexpr size_t WS_DCH = WS_KOUT + (size_t)2 * NTOK * 512 * 2;
constexpr size_t WS_OINTRA = WS_DCH + (size_t)2 * NCHUNK * 512 * 4;
constexpr size_t WS_OINTER = WS_OINTRA + (size_t)NTOK * 512 * 4;
constexpr size_t WS_LTOK = WS_OINTER + (size_t)2 * NTOK * 512 * 4;
constexpr size_t WS_LGATE = WS_LTOK + (size_t)32 * NTOK * 4;
constexpr int HID_ROWS = 2 * NTOK + 32 * 256;
constexpr size_t WS_HID = WS_LGATE + (size_t)32 * NTOK * 4;
constexpr size_t WS_YB = WS_HID + (size_t)HID_ROWS * 512 * 2;
constexpr int REC_BYTES = 9216, VREC_BYTES = 4096;
constexpr size_t WS_GREC = WS_YB + (size_t)2 * NTOK * 1024 * 2;
constexpr size_t WS_VREC = WS_GREC + (size_t)2 * NCHUNK * 4 * REC_BYTES;
constexpr size_t WS_WRH = WS_VREC + (size_t)NCHUNK * 4 * VREC_BYTES;
constexpr size_t WS_WRL = WS_WRH + (size_t)4 * 48 * 1024 * 2;
constexpr size_t WS_H8 = WS_WRL + (size_t)4 * 48 * 1024 * 2;
constexpr size_t WS_HID8 = WS_H8 + (size_t)NTOK * 1024;
constexpr size_t WS_WGU8 = WS_HID8 + (size_t)HID_ROWS * 512;
constexpr size_t WS_WDN8 = WS_WGU8 + (size_t)4 * 32 * 1024 * 1024;
constexpr size_t WS_YB8 = WS_WDN8 + (size_t)4 * 32 * 1024 * 512;
constexpr size_t WS_DELTA = WS_YB8 + (size_t)2 * NTOK * 1024;
constexpr size_t WS_END = WS_DELTA + (size_t)NTOK * 1024 * 2;
constexpr int CW_BAR = 0;
constexpr int CW_CNT = 8192;

constexpr int LDS_BYTES = 147456;
constexpr int LDS_MISC = 143360;
constexpr int NPH = 2 + 9 * DEPTH + 1;

__device__ __forceinline__ float bf2f(bf16_t b) { return __uint_as_float(((unsigned)b) << 16); }
__device__ __forceinline__ unsigned f2bf(float f) { unsigned u = __float_as_uint(f); return (u + 0x7fffu + ((u >> 16) & 1u)) >> 16; }
__device__ __forceinline__ unsigned pk2(float lo, float hi) { return f2bf(lo) | (f2bf(hi) << 16); }
__device__ __forceinline__ float wave_sum(float v) {
#pragma unroll
    for (int o = 1; o < 64; o <<= 1) v += __shfl_xor(v, o);
    return v;
}
__device__ __forceinline__ float frcp(float x) { return __builtin_amdgcn_rcpf(x); }
__device__ __forceinline__ float sigmoidf(float x) { return frcp(1.0f + __expf(-x)); }
__device__ __forceinline__ float siluf(float x) { return x * frcp(1.0f + __expf(-x)); }
__device__ __forceinline__ float clamp8(float v) { return __builtin_amdgcn_fmed3f(v, -416.0f, 416.0f); }
__device__ __forceinline__ unsigned pk4_fp8_raw(float a, float b, float c, float d) { int r = __builtin_amdgcn_cvt_pk_fp8_f32(a, b, 0, false); r = __builtin_amdgcn_cvt_pk_fp8_f32(c, d, r, true); return (unsigned)r; }
__device__ __forceinline__ unsigned pk4_fp8(float a, float b, float c, float d) { int r = __builtin_amdgcn_cvt_pk_fp8_f32(clamp8(a), clamp8(b), 0, false); r = __builtin_amdgcn_cvt_pk_fp8_f32(clamp8(c), clamp8(d), r, true); return (unsigned)r; }
__device__ __forceinline__ f32x4 unpk4_fp8(unsigned w) { const f32x2 lo = __builtin_amdgcn_cvt_pk_f32_fp8((int)w, false), hi = __builtin_amdgcn_cvt_pk_f32_fp8((int)w, true); return (f32x4){lo.x, lo.y, hi.x, hi.y}; }
typedef __bf16 bf16x2_t __attribute__((ext_vector_type(2)));
__device__ __forceinline__ f32x4 unpk4_bf16(u32x2 w) { return (f32x4){__uint_as_float(w.x << 16), __uint_as_float(w.x & 0xffff0000u), __uint_as_float(w.y << 16), __uint_as_float(w.y & 0xffff0000u)}; }
__device__ __forceinline__ unsigned cvtpk(float lo, float hi) { const f32x2 v = {lo, hi}; const bf16x2_t r = __builtin_convertvector(v, bf16x2_t); return __builtin_bit_cast(unsigned, r); }
__device__ __forceinline__ int mod_row(int r) { return r < NLAT ? (r >> 11) : 8; }
#define LDS_WAIT() asm volatile("s_waitcnt lgkmcnt(0)" ::: "memory")
__device__ __forceinline__ int otid() { int t = threadIdx.x; asm volatile("" : "+v"(t)); return t; }
__device__ __forceinline__ int obid() { int b = blockIdx.x; asm volatile("" : "+s"(b)); return b; }

#define XB_TMO      128
#define XB_XCNT(j)  (256  + 64 * (j))
#define XB_XSUB(j)  (1280 + 64 * (j))
#define XB_XGEN(j)  (2304 + 64 * (j))
#define XB_TOP      3328
#define XB_TOPGEN   3392
#define XCD_BAR_WORDS 3456
#define XB_SPIN_CAP (1u << 18)
__device__ __forceinline__ unsigned xb_ld(unsigned* p)              { return __hip_atomic_load(p, __ATOMIC_RELAXED, __HIP_MEMORY_SCOPE_AGENT); }
__device__ __forceinline__ unsigned xb_add(unsigned* p, unsigned v) { return __hip_atomic_fetch_add(p, v, __ATOMIC_RELAXED, __HIP_MEMORY_SCOPE_AGENT); }
__device__ __forceinline__ unsigned xb_xcc_id() { return (unsigned)__builtin_amdgcn_s_getreg((3 << 11) | 20) & 0xFu; }
#define XB_SPIN(cond, bar) do { unsigned _sp = 0; while (cond) { __builtin_amdgcn_s_sleep(1); \
    if ((++_sp & 255u) == 0u) { if (xb_ld(&(bar)[XB_TMO])) break; if (_sp > XB_SPIN_CAP) { atomicAdd(&(bar)[XB_TMO], 1u); break; } } } } while (0)
struct XcdBarrier { unsigned* bar; unsigned x; volatile LAS unsigned* st; };
__device__ __forceinline__ XcdBarrier xcd_barrier_post(unsigned* bar, volatile LAS unsigned* st) {
    XcdBarrier b; b.bar = bar; b.x = xb_xcc_id(); b.st = st;
    if (threadIdx.x == 0) (void)xb_add(&bar[XB_XCNT(b.x)], 1u);
    return b;
}
__device__ __forceinline__ void xcd_barrier_complete(unsigned* bar, unsigned x, unsigned& nloc, unsigned& nx) {
    const unsigned G = gridDim.x * gridDim.y * gridDim.z;
    unsigned sum, cnt, mine, sp = 0u;
    for (;;) {
        sum = 0u; cnt = 0u; mine = 0u;
#pragma unroll
        for (unsigned j = 0; j < 16; ++j) { const unsigned c = xb_ld(&bar[XB_XCNT(j)]); sum += c; cnt += (c > 0u) ? 1u : 0u; mine = (j == x) ? c : mine; }
        if (sum == G) break;
        __builtin_amdgcn_s_sleep(1);
        if ((++sp & 255u) == 0u) { if (xb_ld(&bar[XB_TMO])) break; if (sp > XB_SPIN_CAP) { atomicAdd(&bar[XB_TMO], 1u); break; } }
    }
    nloc = mine > 0u ? mine : 1u; nx = cnt > 0u ? cnt : 1u;
}
__device__ __forceinline__ void xcd_barrier(const XcdBarrier& b) {
    asm volatile("s_waitcnt vmcnt(0)" ::: "memory");
    __syncthreads();
    if (threadIdx.x == 0) {
        unsigned* bar = b.bar;
        __builtin_amdgcn_s_waitcnt(0);
        unsigned nloc = b.st[0], nx = b.st[1];
        if (nloc == 0u) { xcd_barrier_complete(bar, b.x, nloc, nx); b.st[0] = nloc; b.st[1] = nx; }
        const unsigned old = xb_add(&bar[XB_XSUB(b.x)], 1u);
        const unsigned gen = old / nloc;
        if (old + 1u == (gen + 1u) * nloc) {
            __builtin_amdgcn_fence(__ATOMIC_RELEASE, "agent");
            asm volatile("s_waitcnt vmcnt(0)" ::: "memory");
            const unsigned og = xb_add(&bar[XB_TOP], 1u);
            const unsigned tg = og / nx;
            if (og + 1u == (tg + 1u) * nx) xb_add(&bar[XB_TOPGEN], 1u);
            else XB_SPIN(xb_ld(&bar[XB_TOPGEN]) == tg, bar);
            __builtin_amdgcn_fence(__ATOMIC_ACQUIRE, "agent");
            xb_add(&bar[XB_XGEN(b.x)], 1u);
            asm volatile("s_waitcnt vmcnt(0)" ::: "memory");
        } else {
            XB_SPIN(xb_ld(&bar[XB_XGEN(b.x)]) == gen, bar);
            __builtin_amdgcn_fence(__ATOMIC_ACQUIRE, "agent");
            asm volatile("s_waitcnt vmcnt(0)" ::: "memory");
        }
    }
    __syncthreads();
}

struct Params {
    const float* in[20];
    float* out;
    unsigned char* ws;
    int ph_lo, ph_hi;
};

__device__ __forceinline__ unsigned char* ows(const Params& p) { GAS unsigned char* w = (GAS unsigned char*)p.ws; asm volatile("" : "+s"(w)); return (unsigned char*)w; }
__device__ __forceinline__ const float* oin(const Params& p, int k) { const GAS float* q = (const GAS float*)p.in[k]; asm volatile("" : "+s"(q)); return (const float*)q; }

template <class ARow, class Epi>
__device__ __forceinline__ void gemm128(unsigned char* lds, const ARow& arow, const bf16_t* __restrict__ Bt, int K, const Epi& epi) {
    const int tid = otid(), lane = tid & 63, wid = tid >> 6, wr = wid >> 2, wc = wid & 3, fr = lane & 15, fq = lane >> 4;
    bf16_t* sA = (bf16_t*)lds;
    bf16_t* sB = (bf16_t*)(lds + 128 * 144);
    f32x4 acc[4][2];
#pragma unroll
    for (int m = 0; m < 4; ++m)
#pragma unroll
        for (int n = 0; n < 2; ++n) acc[m][n] = (f32x4){0.f, 0.f, 0.f, 0.f};
    const bf16_t* ap[2]; const bf16_t* bp[2]; int so[2];
#pragma unroll
    for (int i = 0; i < 2; ++i) {
        const int q = tid + 512 * i, row = q >> 3, seg = q & 7;
        ap[i] = arow(row) + seg * 8; bp[i] = Bt + (size_t)row * K + seg * 8; so[i] = row * 72 + seg * 8;
    }
    for (int k0 = 0; k0 < K; k0 += 64) {
        u32x4 va[2], vb[2];
#pragma unroll
        for (int i = 0; i < 2; ++i) { va[i] = *(const u32x4*)(ap[i] + k0); vb[i] = *(const u32x4*)(bp[i] + k0); }
        __syncthreads();
#pragma unroll
        for (int i = 0; i < 2; ++i) { *(u32x4*)(sA + so[i]) = va[i]; *(u32x4*)(sB + so[i]) = vb[i]; }
        __syncthreads();
#pragma unroll
        for (int kk = 0; kk < 2; ++kk) {
            bf16x8 a[4], b[2];
#pragma unroll
            for (int m = 0; m < 4; ++m) a[m] = *(const bf16x8*)(sA + (wr * 64 + m * 16 + fr) * 72 + kk * 32 + fq * 8);
#pragma unroll
            for (int n = 0; n < 2; ++n) b[n] = *(const bf16x8*)(sB + (wc * 32 + n * 16 + fr) * 72 + kk * 32 + fq * 8);
#pragma unroll
            for (int m = 0; m < 4; ++m)
#pragma unroll
                for (int n = 0; n < 2; ++n) acc[m][n] = __builtin_amdgcn_mfma_f32_16x16x32_bf16(b[n], a[m], acc[m][n], 0, 0, 0);
        }
    }
#pragma unroll
    for (int m = 0; m < 4; ++m)
#pragma unroll
        for (int n = 0; n < 2; ++n) epi(wr * 64 + m * 16 + fr, wc * 32 + n * 16 + fq * 4, acc[m][n]);
    __syncthreads();
}

struct ARowPlain { const bf16_t* A; int ld; __device__ __forceinline__ const bf16_t* operator()(int i) const { return A + (size_t)i * ld; } };
struct ARowGather { const bf16_t* A; const int* tok; int nvalid; __device__ __forceinline__ const bf16_t* operator()(int i) const { const int t = (i < nvalid) ? (tok[i] >> 1) : 0; return A + (size_t)t * 1024; } };

struct EpiP { bf16_t* P; __device__ __forceinline__ void operator()(int r, int c, f32x4 v) const {
    u32x2 w; w.x = pk2(v[0], v[1]); w.y = pk2(v[2], v[3]); *(u32x2*)(P + (size_t)r * PW + c) = w; } };
struct EpiRes { float* X; const float* gate; int m0; __device__ __forceinline__ void operator()(int r, int c, f32x4 v) const {
    const float* g = gate + (size_t)mod_row(m0 + r) * 6144 + c; float* xp = X + (size_t)r * 1024 + c;
    f32x4 x = *(f32x4*)xp; const f32x4 gv = *(const f32x4*)g; x += gv * v; *(f32x4*)xp = x; } };
struct EpiGU { bf16_t* H; __device__ __forceinline__ void operator()(int r, int c, f32x4 v) const {
    const float h0 = siluf(v[0]) * v[1], h1 = siluf(v[2]) * v[3]; *(unsigned*)(H + (size_t)r * 512 + (c >> 1)) = pk2(h0, h1); } };
struct EpiDown { bf16_t* YB; const int* tok; const float* gate; int nvalid; __device__ __forceinline__ void operator()(int r, int c, f32x4 v) const {
    if (r < nvalid) { const int e = tok[r]; const float g = gate[r]; u32x2 w; w.x = pk2(g * v[0], g * v[1]); w.y = pk2(g * v[2], g * v[3]); *(u32x2*)(YB + (size_t)e * 1024 + c) = w; } } };


namespace g8 {
constexpr int BM = 256, BK = 64, HALF = 128, HTB = HALF * BK * 2, NXCD = 8, WGM = 8;
__device__ __forceinline__ int lds_byte(int r, int c) { const int st = (r >> 4) * 2 + (c >> 5), rr = r & 15, cc = c & 31, ob = rr * 64 + cc * 2; return st * 1024 + (ob ^ (((ob >> 9) & 1) << 5)); }
__device__ __forceinline__ void stage_rc(int b, int& R, int& C) { const int st = b / 1024, sb = b % 1024, swz = sb ^ (((sb >> 9) & 1) << 5); R = (st >> 1) * 16 + swz / 64; C = (st & 1) * 32 + (swz % 64) / 2; }
__device__ __forceinline__ int perm32(int rho) { const int n = rho >> 4, i = rho & 15; return 8 * (i >> 2) + 4 * n + (i & 3); }
__device__ __forceinline__ unsigned cvt_pk_bf16(float lo, float hi) { return cvtpk(lo, hi); }

__device__ __forceinline__ int g8_ra(int tid, int i) { int R, C; stage_rc(tid * 16 + i * 8192, R, C); return R; }
__device__ __forceinline__ unsigned g8_ca(int tid, int i) { int R, C; stage_rc(tid * 16 + i * 8192, R, C); return (unsigned)C * 2u; }
#define G8_RA(i) g8_ra(otid(), (i))
#define G8_CA(i) g8_ca(otid(), (i))
template <class Epi, class Sched>
__device__ __forceinline__ void gemm_phase(LAS unsigned char* lds, const char* Abase, const int K, const Sched& S, const Epi& E) {
    const int tid = otid(), wid = __builtin_amdgcn_readfirstlane(tid >> 6), lane = tid & 63, wr = wid >> 2, wc = wid & 3, fr = lane & 15, fq = lane >> 4;
    const int nt = K / BK;
    unsigned voffB[2];
#pragma unroll
    for (int i = 0; i < 2; ++i) { int R, C; stage_rc(tid * 16 + i * 8192, R, C); const int Rb = Epi::PERM ? ((R & ~31) + perm32(R & 31)) : R;
        voffB[i] = (unsigned)(Rb * K + C) * 2u; }
    const unsigned rowb = (unsigned)K * 2u;
    const size_t kstep = (size_t)(BK * 2);
    const size_t hstep = (size_t)HALF * K * 2;
    const unsigned ldsw = (unsigned)wid * 1024u;
    const int aoff = lds_byte(wr * 64 + fr, fq * 8), boff = lds_byte(wc * 32 + fr, fq * 8);
#define G8_SA(b, h) (((b) * 2 + (h)) * HTB)
#define G8_SB(b, h) ((4 + (b) * 2 + (h)) * HTB)
#define G8_STAGE(bufoff, gbase, voff) do { _Pragma("unroll") for (int _i = 0; _i < 2; ++_i) \
        __builtin_amdgcn_global_load_lds((const unsigned*)((const char*)(gbase) + (voff)[_i]), (LAS unsigned*)(lds + (bufoff) + ldsw + _i * 8192), 16, 0, 0); } while (0)
#define G8_LDA(dst, b, h) do { _Pragma("unroll") for (int m = 0; m < 4; ++m) _Pragma("unroll") for (int k = 0; k < 2; ++k) dst[m][k] = *(const LAS bf16x8*)(lds + G8_SA(b, h) + aoff + m * 2048 + k * 1024); } while (0)
#define G8_LDB(dst, b, h) do { _Pragma("unroll") for (int n = 0; n < 2; ++n) _Pragma("unroll") for (int k = 0; k < 2; ++k) dst[n][k] = *(const LAS bf16x8*)(lds + G8_SB(b, h) + boff + n * 2048 + k * 1024); } while (0)
#define G8_MMA(ai, bj, At, Bt) do { __builtin_amdgcn_s_setprio(1); _Pragma("unroll") for (int m = 0; m < 4; ++m) _Pragma("unroll") for (int n = 0; n < 2; ++n) _Pragma("unroll") for (int k = 0; k < 2; ++k) \
        acc[ai][bj][m][n] = __builtin_amdgcn_mfma_f32_16x16x32_bf16(Bt[n][k], At[m][k], acc[ai][bj][m][n], 0, 0, 0); __builtin_amdgcn_s_setprio(0); } while (0)
#define G8_WAIT_V(n) asm volatile("s_waitcnt vmcnt(" #n ")" ::: "memory")
#define G8_WAIT_L(n) asm volatile("s_waitcnt lgkmcnt(" #n ")" ::: "memory")
#define G8_BAR __builtin_amdgcn_s_barrier()
#define G8_SCHED __builtin_amdgcn_sched_barrier(0)
    typename Sched::Unit cur, nxt; int ui = 0;
    if (!S.next(0, cur)) return;
    f32x4 acc[2][2][4][2];
#pragma unroll
    for (int a = 0; a < 2; ++a)
#pragma unroll
        for (int b = 0; b < 2; ++b)
#pragma unroll
            for (int m = 0; m < 4; ++m)
#pragma unroll
                for (int n = 0; n < 2; ++n) acc[a][b][m][n] = (f32x4){0.f, 0.f, 0.f, 0.f};
    bf16x8 At[4][2], B0[2][2], B1[2][2];
    unsigned vAc[2][2], vAn[2][2];
#pragma unroll
    for (int h = 0; h < 2; ++h)
#pragma unroll
        for (int i = 0; i < 2; ++i) vAc[h][i] = (Sched::AFFINE ? (unsigned)(h * HALF + G8_RA(i)) : (unsigned)S.a_row(cur, h * HALF + G8_RA(i))) * rowb + G8_CA(i);
    const char* cA = Sched::AFFINE ? Abase + (size_t)S.a_row(cur, 0) * rowb : Abase;
    const char* cB = S.b_base(cur);
    G8_STAGE(G8_SB(0, 0), cB, voffB); G8_STAGE(G8_SA(0, 0), cA, vAc[0]); G8_STAGE(G8_SB(0, 1), cB + hstep, voffB); G8_STAGE(G8_SA(0, 1), cA, vAc[1]);
    if (wr == 1) G8_BAR;
    G8_WAIT_V(4); G8_BAR;
    G8_STAGE(G8_SB(1, 0), cB + kstep, voffB); G8_STAGE(G8_SA(1, 0), cA + kstep, vAc[0]); G8_STAGE(G8_SB(1, 1), cB + hstep + kstep, voffB);
    G8_WAIT_V(6); G8_BAR;
    for (;;) {
        const bool has_next = S.next(ui + 1, nxt);
#pragma unroll
        for (int h = 0; h < 2; ++h)
#pragma unroll
            for (int i = 0; i < 2; ++i) vAn[h][i] = (has_next && !Sched::AFFINE) ? ((unsigned)S.a_row(nxt, h * HALF + G8_RA(i)) * rowb + G8_CA(i)) : vAc[h][i];
        const char* nA = (has_next && Sched::AFFINE) ? Abase + (size_t)S.a_row(nxt, 0) * rowb : cA;
        const char* nB = has_next ? S.b_base(nxt) : cB;
        for (int t = 0; t < nt; t += 2) {
            const bool last = (t == nt - 2);
            const char* a1 = cA + (size_t)(t + 1) * kstep;
            const char* a2 = last ? nA : cA + (size_t)(t + 2) * kstep; const char* b2 = last ? nB : cB + (size_t)(t + 2) * kstep;
            const char* a3 = a2 + kstep; const char* b3 = b2 + kstep;
            unsigned v2[2][2];
#pragma unroll
            for (int h = 0; h < 2; ++h)
#pragma unroll
                for (int i = 0; i < 2; ++i) v2[h][i] = last ? vAn[h][i] : vAc[h][i];
            G8_LDB(B0, 0, 0); G8_SCHED; G8_LDA(At, 0, 0); G8_STAGE(G8_SA(1, 1), a1, vAc[1]);
            G8_WAIT_L(8); G8_BAR; G8_WAIT_L(0); G8_MMA(0, 0, At, B0); G8_BAR; G8_SCHED;
            G8_LDB(B1, 0, 1); G8_STAGE(G8_SB(0, 0), b2, voffB);
            G8_BAR; G8_WAIT_L(0); G8_MMA(0, 1, At, B1); G8_BAR;
            G8_LDA(At, 0, 1); G8_STAGE(G8_SA(0, 0), a2, v2[0]);
            G8_BAR; G8_WAIT_L(0); G8_MMA(1, 0, At, B0); G8_BAR; G8_SCHED;
            G8_STAGE(G8_SB(0, 1), b2 + hstep, voffB);
            G8_WAIT_V(6); G8_BAR; G8_MMA(1, 1, At, B1); G8_BAR;
            G8_LDB(B0, 1, 0); G8_SCHED; G8_LDA(At, 1, 0); G8_STAGE(G8_SA(0, 1), a2, v2[1]);
            G8_WAIT_L(8); G8_BAR; G8_WAIT_L(0); G8_MMA(0, 0, At, B0); G8_BAR; G8_SCHED;
            G8_LDB(B1, 1, 1); G8_STAGE(G8_SB(1, 0), b3, voffB);
            G8_BAR; G8_WAIT_L(0); G8_MMA(0, 1, At, B1); G8_BAR;
            G8_LDA(At, 1, 1); G8_STAGE(G8_SA(1, 0), a3, v2[0]);
            G8_BAR; G8_WAIT_L(0); G8_MMA(1, 0, At, B0); G8_BAR; G8_SCHED;
            G8_STAGE(G8_SB(1, 1), b3 + hstep, voffB);
            G8_WAIT_V(6); G8_BAR; G8_MMA(1, 1, At, B1); G8_BAR;
        }
        E(acc, cur, wr, wc, fr, fq);
        if (!has_next) break;
#pragma unroll
        for (int a = 0; a < 2; ++a)
#pragma unroll
            for (int b = 0; b < 2; ++b)
#pragma unroll
                for (int m = 0; m < 4; ++m)
#pragma unroll
                    for (int n = 0; n < 2; ++n) acc[a][b][m][n] = (f32x4){0.f, 0.f, 0.f, 0.f};
        cur = nxt; cB = nB; cA = nA; ++ui;
#pragma unroll
        for (int h = 0; h < 2; ++h)
#pragma unroll
            for (int i = 0; i < 2; ++i) vAc[h][i] = vAn[h][i];
    }
    G8_WAIT_V(0);
    if (wr == 0) G8_BAR;
    G8_BAR;
#undef G8_SA
#undef G8_SB
#undef G8_STAGE
#undef G8_LDA
#undef G8_LDB
#undef G8_MMA
#undef G8_WAIT_V
#undef G8_WAIT_L
#undef G8_BAR
#undef G8_SCHED
}

template <int sclW, int sclA, class Epi, class Sched>
__device__ __forceinline__ void gemm_phase8(LAS unsigned char* lds, const char* Abase, const int K, const Sched& S, const Epi& E) {
    const int tid = otid(), wid = __builtin_amdgcn_readfirstlane(tid >> 6), lane = tid & 63, wr = wid >> 2, wc = wid & 3, fr = lane & 15, fq = lane >> 4;
    const int nt = K / 128;
    unsigned voffB[2];
#pragma unroll
    for (int i = 0; i < 2; ++i) { int R, C; stage_rc(tid * 16 + i * 8192, R, C); const int Rb = Epi::PERM ? ((R & ~31) + perm32(R & 31)) : R;
        voffB[i] = (unsigned)(Rb * K) + (unsigned)C * 2u; }
    const unsigned rowb = (unsigned)K;
    const size_t kstep = (size_t)(BK * 2);
    const size_t hstep = (size_t)HALF * K;
    const unsigned ldsw = (unsigned)wid * 1024u;
    const int fob = fr * 64 + ((2 * (fq & 1)) ^ (2 * (fr >> 3))) * 16 + (fq >> 1) * 1024;
    const int aoff = ((wr * 64) >> 4) * 2048 + fob, boff = ((wc * 32) >> 4) * 2048 + fob;
#define G8_SA(b, h) (((b) * 2 + (h)) * HTB)
#define G8_SB(b, h) ((4 + (b) * 2 + (h)) * HTB)
#define G8_STAGE(bufoff, gbase, voff) do { _Pragma("unroll") for (int _i = 0; _i < 2; ++_i) \
        __builtin_amdgcn_global_load_lds((const unsigned*)((const char*)(gbase) + (voff)[_i]), (LAS unsigned*)(lds + (bufoff) + ldsw + _i * 8192), 16, 0, 0); } while (0)
#define G8_LDA(dst, b, h) do { _Pragma("unroll") for (int m = 0; m < 4; ++m) { const i32x4 _lo = *(const LAS i32x4*)(lds + G8_SA(b, h) + aoff + m * 2048), _hi = *(const LAS i32x4*)(lds + G8_SA(b, h) + aoff + m * 2048 + 16); dst[m] = __builtin_shufflevector(_lo, _hi, 0, 1, 2, 3, 4, 5, 6, 7); } } while (0)
#define G8_LDB(dst, b, h) do { _Pragma("unroll") for (int n = 0; n < 2; ++n) { const i32x4 _lo = *(const LAS i32x4*)(lds + G8_SB(b, h) + boff + n * 2048), _hi = *(const LAS i32x4*)(lds + G8_SB(b, h) + boff + n * 2048 + 16); dst[n] = __builtin_shufflevector(_lo, _hi, 0, 1, 2, 3, 4, 5, 6, 7); } } while (0)
#define G8_MMA(ai, bj, At, Bt) do { __builtin_amdgcn_s_setprio(1); _Pragma("unroll") for (int m = 0; m < 4; ++m) _Pragma("unroll") for (int n = 0; n < 2; ++n) \
        acc[ai][bj][m][n] = __builtin_amdgcn_mfma_scale_f32_16x16x128_f8f6f4(Bt[n], At[m], acc[ai][bj][m][n], 0, 0, 0, sclW, 0, sclA); \
        _Pragma("unroll") for (int m = 0; m < 4; ++m) asm volatile("" : "+v"(acc[ai][bj][m][0]), "+v"(acc[ai][bj][m][1]));   \
        __builtin_amdgcn_s_setprio(0); } while (0)
#define G8_WAIT_V(n) asm volatile("s_waitcnt vmcnt(" #n ")" ::: "memory")
#define G8_WAIT_L(n) asm volatile("s_waitcnt lgkmcnt(" #n ")" ::: "memory")
#define G8_BAR __builtin_amdgcn_s_barrier()
#define G8_SCHED __builtin_amdgcn_sched_barrier(0)
    typename Sched::Unit cur, nxt; int ui = 0;
    if (!S.next(0, cur)) return;
    f32x4 acc[2][2][4][2];
#pragma unroll
    for (int a = 0; a < 2; ++a)
#pragma unroll
        for (int b = 0; b < 2; ++b)
#pragma unroll
            for (int m = 0; m < 4; ++m)
#pragma unroll
                for (int n = 0; n < 2; ++n) acc[a][b][m][n] = (f32x4){0.f, 0.f, 0.f, 0.f};
    i32x8 At[4], B0[2], B1[2];
    unsigned vAc[2][2], vAn[2][2];
#pragma unroll
    for (int h = 0; h < 2; ++h)
#pragma unroll
        for (int i = 0; i < 2; ++i) vAc[h][i] = (Sched::AFFINE ? (unsigned)(h * HALF + G8_RA(i)) : (unsigned)S.a_row(cur, h * HALF + G8_RA(i))) * rowb + G8_CA(i);
    const char* cA = Sched::AFFINE ? Abase + (size_t)S.a_row(cur, 0) * rowb : Abase;
    const char* cB = S.b_base(cur);
    G8_STAGE(G8_SB(0, 0), cB, voffB); G8_STAGE(G8_SA(0, 0), cA, vAc[0]); G8_STAGE(G8_SB(0, 1), cB + hstep, voffB); G8_STAGE(G8_SA(0, 1), cA, vAc[1]);
    if (wr == 1) G8_BAR;
    G8_WAIT_V(4); G8_BAR;
    G8_STAGE(G8_SB(1, 0), cB + kstep, voffB); G8_STAGE(G8_SA(1, 0), cA + kstep, vAc[0]); G8_STAGE(G8_SB(1, 1), cB + hstep + kstep, voffB);
    G8_WAIT_V(6); G8_BAR;
    for (;;) {
        const bool has_next = S.next(ui + 1, nxt);
#pragma unroll
        for (int h = 0; h < 2; ++h)
#pragma unroll
            for (int i = 0; i < 2; ++i) vAn[h][i] = (has_next && !Sched::AFFINE) ? ((unsigned)S.a_row(nxt, h * HALF + G8_RA(i)) * rowb + G8_CA(i)) : vAc[h][i];
        const char* nA = (has_next && Sched::AFFINE) ? Abase + (size_t)S.a_row(nxt, 0) * rowb : cA;
        const char* nB = has_next ? S.b_base(nxt) : cB;
#pragma unroll 1
        for (int t = 0; t < nt; t += 2) {
            const bool last = (t == nt - 2);
            const char* a1 = cA + (size_t)(t + 1) * kstep;
            const char* a2 = last ? nA : cA + (size_t)(t + 2) * kstep; const char* b2 = last ? nB : cB + (size_t)(t + 2) * kstep;
            const char* a3 = a2 + kstep; const char* b3 = b2 + kstep;
            unsigned v2[2][2];
#pragma unroll
            for (int h = 0; h < 2; ++h)
#pragma unroll
                for (int i = 0; i < 2; ++i) v2[h][i] = last ? vAn[h][i] : vAc[h][i];
            G8_LDB(B0, 0, 0); G8_SCHED; G8_LDA(At, 0, 0); G8_STAGE(G8_SA(1, 1), a1, vAc[1]);
            G8_WAIT_L(8); G8_BAR; G8_WAIT_L(0); G8_MMA(0, 0, At, B0); G8_BAR; G8_SCHED;
            G8_LDB(B1, 0, 1); G8_STAGE(G8_SB(0, 0), b2, voffB);
            G8_BAR; G8_WAIT_L(0); G8_MMA(0, 1, At, B1); G8_BAR;
            G8_LDA(At, 0, 1); G8_STAGE(G8_SA(0, 0), a2, v2[0]);
            G8_BAR; G8_WAIT_L(0); G8_MMA(1, 0, At, B0); G8_BAR; G8_SCHED;
            G8_STAGE(G8_SB(0, 1), b2 + hstep, voffB);
            G8_WAIT_V(6); G8_BAR; G8_MMA(1, 1, At, B1); G8_BAR;
            G8_LDB(B0, 1, 0); G8_SCHED; G8_LDA(At, 1, 0); G8_STAGE(G8_SA(0, 1), a2, v2[1]);
            G8_WAIT_L(8); G8_BAR; G8_WAIT_L(0); G8_MMA(0, 0, At, B0); G8_BAR; G8_SCHED;
            G8_LDB(B1, 1, 1); G8_STAGE(G8_SB(1, 0), b3, voffB);
            G8_BAR; G8_WAIT_L(0); G8_MMA(0, 1, At, B1); G8_BAR;
            G8_LDA(At, 1, 1); G8_STAGE(G8_SA(1, 0), a3, v2[0]);
            G8_BAR; G8_WAIT_L(0); G8_MMA(1, 0, At, B0); G8_BAR; G8_SCHED;
            G8_STAGE(G8_SB(1, 1), b3 + hstep, voffB);
            G8_WAIT_V(6); G8_BAR; G8_MMA(1, 1, At, B1); G8_BAR;
        }
        E(acc, cur, wr, wc, fr, fq);
        if (!has_next) break;
#pragma unroll
        for (int a = 0; a < 2; ++a)
#pragma unroll
            for (int b = 0; b < 2; ++b)
#pragma unroll
                for (int m = 0; m < 4; ++m)
#pragma unroll
                    for (int n = 0; n < 2; ++n) acc[a][b][m][n] = (f32x4){0.f, 0.f, 0.f, 0.f};
        cur = nxt; cB = nB; cA = nA; ++ui;
#pragma unroll
        for (int h = 0; h < 2; ++h)
#pragma unroll
            for (int i = 0; i < 2; ++i) vAc[h][i] = vAn[h][i];
    }
    G8_WAIT_V(0);
    if (wr == 0) G8_BAR;
    G8_BAR;
#undef G8_SA
#undef G8_SB
#undef G8_STAGE
#undef G8_LDA
#undef G8_LDB
#undef G8_MMA
#undef G8_WAIT_V
#undef G8_WAIT_L
#undef G8_BAR
#undef G8_SCHED
}

struct DUnit { int pm, pn; };
struct DenseOrder {
    typedef DUnit Unit; static constexpr bool AFFINE = true;
    int nM, nN, nwg, G, c; const char* Bt; int K; int bpe;
    __device__ __forceinline__ void init(int nM_, int nN_, int G_, int c_, const void* Bt_, int K_, int bpe_ = 2) { nM = nM_; nN = nN_; nwg = nM * nN; G = G_; c = c_; Bt = (const char*)Bt_; K = K_; bpe = bpe_; }
    __device__ __forceinline__ bool next(int i, Unit& u) const {
        const long L = (long)i * G + c; if (L >= nwg) return false;
        int wgid = (int)L; { const int q = nwg / NXCD, r = nwg % NXCD, xcd = wgid % NXCD, off = wgid / NXCD; wgid = (xcd < r ? xcd * (q + 1) : r * (q + 1) + (xcd - r) * q) + off; }
        const int nig = WGM * nN, gid = wgid / nig, fm = gid * WGM, gsz = (nM - fm) < WGM ? (nM - fm) : WGM;
        u.pm = fm + ((wgid % nig) % gsz); u.pn = (wgid % nig) / gsz; return true;
    }
    __device__ __forceinline__ int a_row(const Unit& u, int r) const { return u.pm * BM + r; }
    __device__ __forceinline__ const char* b_base(const Unit& u) const { return Bt + (size_t)u.pn * BM * K * bpe; }
};
struct MUnit { int pm, pn, e, nvalid, lbase, idx; };
constexpr int MOE_UTAB = 131072, MOE_RTOK = MOE_UTAB + 128, MOE_RGATE = MOE_RTOK + 4096;
template <bool GATHER> struct MoeOrder {
    typedef MUnit Unit; static constexpr bool AFFINE = !GATHER;
    const int* utab; const int* rtok; const char* W; int K; int bpe;
    __device__ __forceinline__ bool next(int i, Unit& u) const {
        if (i >= 4) return false;
        const int* t = utab + i * 8;
        if (t[5] == 0) return false;
        u.pm = t[0]; u.pn = t[1]; u.e = t[2]; u.nvalid = t[3]; u.lbase = t[4]; u.idx = i; return true;
    }
    __device__ __forceinline__ int a_row(const Unit& u, int r) const { if (GATHER) return rtok[u.idx * 256 + r] >> 1; else return u.pm * BM + r; }
    __device__ __forceinline__ const char* b_base(const Unit& u) const { return W + ((size_t)u.e * 1024 + u.pn * BM) * K * bpe; }
};

struct EpiP2 {
    static constexpr bool PERM = true;
    bf16_t* P;
    __device__ __forceinline__ void operator()(const f32x4 (&acc)[2][2][4][2], const DUnit& u, int wr, int wc, int fr, int fq) const {
        const int row0 = u.pm * BM + wr * 64 + fr, col0 = u.pn * BM + wc * 32 + 8 * fq;
#pragma unroll
        for (int ai = 0; ai < 2; ++ai)
#pragma unroll
            for (int m = 0; m < 4; ++m) { bf16_t* rowp = P + (size_t)(row0 + ai * HALF + m * 16) * PW + col0;
#pragma unroll
                for (int bj = 0; bj < 2; ++bj) { const f32x4 v0 = acc[ai][bj][m][0], v1 = acc[ai][bj][m][1];
                    u32x4 w; w.x = cvt_pk_bf16(v0[0], v0[1]); w.y = cvt_pk_bf16(v0[2], v0[3]); w.z = cvt_pk_bf16(v1[0], v1[1]); w.w = cvt_pk_bf16(v1[2], v1[3]);
                    *(u32x4*)(rowp + bj * HALF) = w; } }
    }
};
struct EpiRes2 {
    static constexpr bool PERM = false;
    float* X; const float* gate; float scl;
    __device__ __forceinline__ void operator()(const f32x4 (&acc)[2][2][4][2], const DUnit& u, int wr, int wc, int fr, int fq) const {
        const int row0 = u.pm * BM + wr * 64 + fr, col0 = u.pn * BM + wc * 32 + 4 * fq;
#pragma unroll
        for (int ai = 0; ai < 2; ++ai)
#pragma unroll
            for (int m = 0; m < 4; ++m) { const int r = row0 + ai * HALF + m * 16; float* rowp = X + (size_t)r * 1024 + col0; const float* gp = gate + (size_t)mod_row(r) * 6144 + col0;
#pragma unroll
                for (int bj = 0; bj < 2; ++bj)
#pragma unroll
                    for (int n = 0; n < 2; ++n) { const f32x4 gv = *(const f32x4*)(gp + bj * HALF + n * 16); f32x4 x = *(f32x4*)(rowp + bj * HALF + n * 16); x += (gv * scl) * acc[ai][bj][m][n]; *(f32x4*)(rowp + bj * HALF + n * 16) = x; }
                asm volatile("" ::: "memory"); }
    }
};
struct EpiDelta {
    static constexpr bool PERM = true;
    bf16_t* Dl; const float* gate; float scl;
    __device__ __forceinline__ void operator()(const f32x4 (&acc)[2][2][4][2], const DUnit& u, int wr, int wc, int fr, int fq) const {
        const int row0 = u.pm * BM + wr * 64 + fr, col0 = u.pn * BM + wc * 32 + 8 * fq;
#pragma unroll
        for (int ai = 0; ai < 2; ++ai)
#pragma unroll
            for (int m = 0; m < 4; ++m) { const int r = row0 + ai * HALF + m * 16; bf16_t* rowp = Dl + (size_t)r * 1024 + col0; const float* gp = gate + (size_t)mod_row(r) * 6144 + col0;
#pragma unroll
                for (int bj = 0; bj < 2; ++bj) { const f32x4 g0 = *(const f32x4*)(gp + bj * HALF) * scl, g1 = *(const f32x4*)(gp + bj * HALF + 4) * scl;
                    const f32x4 v0 = acc[ai][bj][m][0] * g0, v1 = acc[ai][bj][m][1] * g1;
                    u32x4 w; w.x = cvt_pk_bf16(v0[0], v0[1]); w.y = cvt_pk_bf16(v0[2], v0[3]); w.z = cvt_pk_bf16(v1[0], v1[1]); w.w = cvt_pk_bf16(v1[2], v1[3]);
                    *(u32x4*)(rowp + bj * HALF) = w; } }
    }
};
struct EpiGU2 {
    static constexpr bool PERM = true;
    bf16_t* H;
    __device__ __forceinline__ void operator()(const f32x4 (&acc)[2][2][4][2], const MUnit& u, int wr, int wc, int fr, int fq) const {
        const int row0 = u.pm * BM + wr * 64 + fr, col0 = u.pn * BM + wc * 32 + 8 * fq;
#pragma unroll
        for (int ai = 0; ai < 2; ++ai)
#pragma unroll
            for (int m = 0; m < 4; ++m) { bf16_t* rowp = H + (size_t)(row0 + ai * HALF + m * 16) * 512 + (col0 >> 1);
#pragma unroll
                for (int bj = 0; bj < 2; ++bj) { const f32x4 v0 = acc[ai][bj][m][0], v1 = acc[ai][bj][m][1];
                    u32x2 w; w.x = cvt_pk_bf16(siluf(v0[0]) * v0[1], siluf(v0[2]) * v0[3]); w.y = cvt_pk_bf16(siluf(v1[0]) * v1[1], siluf(v1[2]) * v1[3]);
                    *(u32x2*)(rowp + bj * (HALF / 2)) = w; } }
    }
};
struct EpiGU8 {
    static constexpr bool PERM = true;
    unsigned char* H;
    __device__ __forceinline__ void operator()(const f32x4 (&acc)[2][2][4][2], const MUnit& u, int wr, int wc, int fr, int fq) const {
        const int row0 = u.pm * BM + wr * 64 + fr, col0 = u.pn * BM + wc * 32 + 8 * fq;
#pragma unroll
        for (int ai = 0; ai < 2; ++ai)
#pragma unroll
            for (int m = 0; m < 4; ++m) { unsigned char* rowp = H + (size_t)(row0 + ai * HALF + m * 16) * 512 + (col0 >> 1);
#pragma unroll
                for (int bj = 0; bj < 2; ++bj) { const f32x4 v0 = acc[ai][bj][m][0], v1 = acc[ai][bj][m][1];
                    *(unsigned*)(rowp + bj * (HALF / 2)) = pk4_fp8(2.0f * siluf(v0[0]) * v0[1], 2.0f * siluf(v0[2]) * v0[3], 2.0f * siluf(v1[0]) * v1[1], 2.0f * siluf(v1[2]) * v1[3]); } }
    }
};
struct EpiDown2 {
    static constexpr bool PERM = true;
    bf16_t* YB; const int* rtok; const float* rgate;
    __device__ __forceinline__ void operator()(const f32x4 (&acc)[2][2][4][2], const MUnit& u, int wr, int wc, int fr, int fq) const {
        const int r0 = wr * 64 + fr, col0 = u.pn * BM + wc * 32 + 8 * fq;
#pragma unroll
        for (int ai = 0; ai < 2; ++ai)
#pragma unroll
            for (int m = 0; m < 4; ++m) { const int rt = r0 + ai * HALF + m * 16;
                if (rt < u.nvalid) { const int ent = rtok[u.idx * 256 + rt]; const float g = rgate[u.idx * 256 + rt]; bf16_t* rowp = YB + (size_t)ent * 1024 + col0;
#pragma unroll
                    for (int bj = 0; bj < 2; ++bj) { const f32x4 v0 = acc[ai][bj][m][0] * g, v1 = acc[ai][bj][m][1] * g;
                        u32x4 w; w.x = cvt_pk_bf16(v0[0], v0[1]); w.y = cvt_pk_bf16(v0[2], v0[3]); w.z = cvt_pk_bf16(v1[0], v1[1]); w.w = cvt_pk_bf16(v1[2], v1[3]);
                        *(u32x4*)(rowp + bj * HALF) = w; } } }
    }
};
struct EpiDown8 {
    static constexpr bool PERM = true;
    unsigned char* YB; const int* rtok; const float* rgate;
    __device__ __forceinline__ void operator()(const f32x4 (&acc)[2][2][4][2], const MUnit& u, int wr, int wc, int fr, int fq) const {
        const int r0 = wr * 64 + fr, col0 = u.pn * BM + wc * 32 + 8 * fq;
#pragma unroll
        for (int ai = 0; ai < 2; ++ai)
#pragma unroll
            for (int m = 0; m < 4; ++m) { const int rt = r0 + ai * HALF + m * 16;
                if (rt < u.nvalid) { const int ent = rtok[u.idx * 256 + rt]; const float g = 64.0f * rgate[u.idx * 256 + rt]; unsigned char* rowp = YB + (size_t)ent * 1024 + col0;
#pragma unroll
                    for (int bj = 0; bj < 2; ++bj) { const f32x4 v0 = acc[ai][bj][m][0] * g, v1 = acc[ai][bj][m][1] * g;
                        u32x2 w; w.x = pk4_fp8(v0[0], v0[1], v0[2], v0[3]); w.y = pk4_fp8(v1[0], v1[1], v1[2], v1[3]);
                        *(u32x2*)(rowp + bj * HALF) = w; } } }
    }
};
}

__device__ __forceinline__ void transpose_item(const float* __restrict__ W, int K, int N, bf16_t* __restrict__ WT, int mode, float* scr, int item, int lane) {
    const int nblk = N / 32, kb = item / nblk, nb = item % nblk, k0 = 64 * kb, n0 = 32 * nb;
    float wv[32];
#pragma unroll
    for (int i = 0; i < 32; ++i) wv[i] = __builtin_nontemporal_load(W + (size_t)(k0 + 2 * i + (lane >> 5)) * N + n0 + (lane & 31));
#pragma unroll
    for (int i = 0; i < 32; ++i) scr[(2 * i + (lane >> 5)) * 33 + (lane & 31)] = wv[i];
    LDS_WAIT();
    const int c = lane & 7;
#pragma unroll
    for (int j = 0; j < 4; ++j) {
        const int n = (lane >> 3) + 8 * j; const float* s = scr + (8 * c) * 33 + n;
        u32x4 o; o.x = pk2(s[0 * 33], s[1 * 33]); o.y = pk2(s[2 * 33], s[3 * 33]); o.z = pk2(s[4 * 33], s[5 * 33]); o.w = pk2(s[6 * 33], s[7 * 33]);
        const int nabs = n0 + n; const int orow = mode ? ((nabs < 512) ? 2 * nabs : 2 * (nabs - 512) + 1) : nabs;
        *(u32x4*)(WT + (size_t)orow * K + k0 + 8 * c) = o;
    }
    LDS_WAIT();
}


__device__ __forceinline__ void transpose_item8(const float* __restrict__ W, int K, int N, unsigned char* __restrict__ WT, int mode, float scale, float* scr, int item, int lane) {
    const int nblk = N / 32, kb = item / nblk, nb = item % nblk, k0 = 64 * kb, n0 = 32 * nb;
    float wv[32];
#pragma unroll
    for (int i = 0; i < 32; ++i) wv[i] = __builtin_nontemporal_load(W + (size_t)(k0 + 2 * i + (lane >> 5)) * N + n0 + (lane & 31));
#pragma unroll
    for (int i = 0; i < 32; ++i) scr[(2 * i + (lane >> 5)) * 33 + (lane & 31)] = wv[i] * scale;
    LDS_WAIT();
    const int c = lane & 7;
#pragma unroll
    for (int j = 0; j < 4; ++j) {
        const int n = (lane >> 3) + 8 * j; const float* s = scr + (8 * c) * 33 + n;
        u32x2 o; o.x = pk4_fp8(s[0 * 33], s[1 * 33], s[2 * 33], s[3 * 33]); o.y = pk4_fp8(s[4 * 33], s[5 * 33], s[6 * 33], s[7 * 33]);
        const int nabs = n0 + n; const int orow = mode ? ((nabs < 512) ? 2 * nabs : 2 * (nabs - 512) + 1) : nabs;
        *(u32x2*)(WT + (size_t)orow * K + k0 + 8 * c) = o;
    }
    LDS_WAIT();
}

__device__ __forceinline__ void convert_experts(const Params& p, int l, float* scr, int widx, int nwv, int it0, int it1) {
    const int tid = otid(), lane = tid & 63;
    bf16_t* wgu_t = (bf16_t*)(ows(p) + WS_WGU) + (size_t)l * 32 * 1024 * 1024; bf16_t* wdn_t = (bf16_t*)(ows(p) + WS_WDN) + (size_t)l * 32 * 1024 * 512;
    const float* wgu = oin(p, 17) + (size_t)l * 32 * 1024 * 1024; const float* wdn = oin(p, 18) + (size_t)l * 32 * 512 * 1024;
    constexpr int I_GU = 16 * 32, I_DN = 8 * 32, T_GU = 32 * I_GU;
    unsigned char* wgu8 = ows(p) + WS_WGU8 + (size_t)l * 32 * 1024 * 1024; unsigned char* wdn8 = ows(p) + WS_WDN8 + (size_t)l * 32 * 1024 * 512;
    for (int it = it0 + widx; it < it1; it += nwv) {
        if (it < T_GU) { const int m = it / I_GU;
            if (MOE_FP8) transpose_item8(wgu + (size_t)m * 1024 * 1024, 1024, 1024, wgu8 + (size_t)m * 1024 * 1024, 1, 32.0f, scr, it % I_GU, lane);
            else transpose_item(wgu + (size_t)m * 1024 * 1024, 1024, 1024, wgu_t + (size_t)m * 1024 * 1024, 1, scr, it % I_GU, lane); }
        else { const int r = it - T_GU, m = r / I_DN;
            if (MOE_FP8) transpose_item8(wdn + (size_t)m * 512 * 1024, 512, 1024, wdn8 + (size_t)m * 1024 * 512, 0, 16.0f, scr, r % I_DN, lane);
            else transpose_item(wdn + (size_t)m * 512 * 1024, 512, 1024, wdn_t + (size_t)m * 1024 * 512, 0, scr, r % I_DN, lane); }
    }
}

__device__ __forceinline__ void convert_range(const Params& p, float* scr, int widx, int nwv, int g0, int g1) {
    for (int l = g0 / CV_ALL; l < DEPTH && l * CV_ALL < g1; ++l) {
        const int a = max(g0, l * CV_ALL) - l * CV_ALL, b = min(g1, (l + 1) * CV_ALL) - l * CV_ALL;
        convert_experts(p, l, scr, widx, nwv, a, b);
    }
}

__device__ __forceinline__ void phase_prologue(const Params& p, unsigned char* lds) {
    const int tid = otid(), lane = tid & 63, wid = tid >> 6;
    float* scr = (float*)(lds + wid * 16384);
    const int gw = obid() * 8 + wid, NGW = gridDim.x * 8;
    bf16_t* win_t = (bf16_t*)(ows(p) + WS_WIN); bf16_t* wout_t = (bf16_t*)(ows(p) + WS_WOUT);
    constexpr int I_IN = 16 * 128, I_OUT = 16 * 32;
    constexpr int T_IN = 4 * I_IN, T_OUT = 4 * I_OUT;
    for (int it = gw; it < T_IN + T_OUT; it += NGW) {
        int r = it;
        if (r < T_IN) { const int m = r / I_IN; transpose_item(oin(p, 7) + (size_t)m * 1024 * 4096, 1024, 4096, win_t + (size_t)m * 4096 * 1024, 0, scr, r % I_IN, lane); continue; } r -= T_IN;
        { const int m = r / I_OUT;
          if (G2_FP8) transpose_item8(oin(p, 12) + (size_t)m * 1024 * 1024, 1024, 1024, (unsigned char*)wout_t + (size_t)m * 1024 * 1024, 0, 32.0f, scr, r % I_OUT, lane);
          else transpose_item(oin(p, 12) + (size_t)m * 1024 * 1024, 1024, 1024, wout_t + (size_t)m * 1024 * 1024, 0, scr, r % I_OUT, lane); }
    }
    {
        bf16_t* wrh = (bf16_t*)(ows(p) + WS_WRH); bf16_t* wrl = (bf16_t*)(ows(p) + WS_WRL);
        for (int i = obid() * 512 + tid; i < 4 * 48 * 1024; i += gridDim.x * 512) {
            const int l = i / (48 * 1024), j = (i / 1024) % 48, k = i % 1024;
            float w = 0.f;
            if (j < 4) w = oin(p, 13)[((size_t)l * 1024 + k) * 4 + j]; else if (j < 36) w = oin(p, 15)[((size_t)l * 1024 + k) * 32 + (j - 4)];
            const unsigned hi = f2bf(w); const float rem = w - __uint_as_float(hi << 16);
            wrh[i] = (bf16_t)hi; wrl[i] = (bf16_t)f2bf(rem);
        }
    }
    __syncthreads();
    float* modp = (float*)(ows(p) + WS_MODP);
    float* sS = (float*)lds;
    for (int u = obid(); u < 4 * 24 * 8; u += gridDim.x) {
        const int l = u / 192, rem = u % 192, nb = rem / 8, ks = rem % 8;
        __syncthreads();
        for (int i = tid; i < 9 * 128; i += 512) { const int r = i >> 7, k = i & 127; const float cv = (r < 8) ? oin(p, 1)[r * 1024 + ks * 128 + k] : oin(p, 3)[ks * 128 + k]; sS[i] = siluf(cv); }
        __syncthreads();
        const int col = nb * 256 + (tid & 255), kh = tid >> 8;
        float acc[9];
#pragma unroll
        for (int r = 0; r < 9; ++r) acc[r] = 0.f;
        const float* w = oin(p, 5) + ((size_t)l * 1024 + ks * 128 + kh * 64) * 6144 + col;
        for (int k = 0; k < 64; ++k) {
            const float wv = w[(size_t)k * 6144];
#pragma unroll
            for (int r = 0; r < 9; ++r) acc[r] += sS[r * 128 + kh * 64 + k] * wv;
        }
#pragma unroll
        for (int r = 0; r < 9; ++r) modp[(((size_t)l * NMODP + ks * 2 + kh) * 9 + r) * 6144 + col] = acc[r];
    }
}

__device__ __forceinline__ void phase_modreduce(const Params& p) {
    const float* modp = (const float*)(ows(p) + WS_MODP); float* modv = (float*)(ows(p) + WS_MOD);
    for (int i = obid() * 512 + otid(); i < 4 * 9 * 6144; i += gridDim.x * 512) {
        const int l = i / (9 * 6144), rem = i % (9 * 6144), n = rem % 6144;
        float s = oin(p, 6)[l * 6144 + n];
        for (int j = 0; j < NMODP; ++j) s += modp[((size_t)l * NMODP + j) * 9 * 6144 + rem];
        modv[i] = s;
    }
}

__device__ __forceinline__ void phase_norm1(const Params& p, int l, float scl) {
    const int lane = otid() & 63, wid = otid() >> 6;
    bf16_t* xws = (bf16_t*)(ows(p) + WS_X); bf16_t* hb = (bf16_t*)(ows(p) + WS_H); const bf16_t* yb = (const bf16_t*)(ows(p) + WS_YB);
    const float* modv = (const float*)(ows(p) + WS_MOD);
    const float* nw = oin(p, 4) + (size_t)(l * 2 + 0) * 1024;
    for (int r = obid() * 8 + wid; r < NTOK; r += gridDim.x * 8) {
        const int mr = mod_row(r);
        f32x4 v[4], nwv[4], shv[4], scv[4];
        { const float* msh = modv + ((size_t)l * 9 + mr) * 6144; const float* msc = msh + 1024;
#pragma unroll
          for (int j = 0; j < 4; ++j) { const int c = 4 * lane + 256 * j; nwv[j] = *(const f32x4*)(nw + c); shv[j] = *(const f32x4*)(msh + c); scv[j] = *(const f32x4*)(msc + c); } }
        if (l == 0) { const float* src = r < NLAT ? oin(p, 0) + (size_t)r * 1024 : oin(p, 2) + (size_t)(r - NLAT) * 1024;
#pragma unroll
            for (int j = 0; j < 4; ++j) v[j] = *(const f32x4*)(src + 4 * lane + 256 * j); }
        else {
#pragma unroll
            for (int j = 0; j < 4; ++j) v[j] = unpk4_bf16(*(const u32x2*)(xws + (size_t)r * 1024 + 4 * lane + 256 * j)); }
        if (l > 0) {
            const float* g5 = modv + ((size_t)(l - 1) * 9 + mr) * 6144 + 5 * 1024;
#pragma unroll
            for (int j = 0; j < 4; ++j) {
                const int c = 4 * lane + 256 * j;
                const f32x4 gv = *(const f32x4*)(g5 + c);
                f32x4 f;
                if (MOE_FP8) { const unsigned char* y8 = ows(p) + WS_YB8; f = (unpk4_fp8(*(const unsigned*)(y8 + (size_t)(2 * r) * 1024 + c)) + unpk4_fp8(*(const unsigned*)(y8 + (size_t)(2 * r + 1) * 1024 + c))) * (1.0f / 64.0f); }
                else { const u32x2 y0 = *(const u32x2*)(yb + (size_t)(2 * r) * 1024 + c), y1 = *(const u32x2*)(yb + (size_t)(2 * r + 1) * 1024 + c);
                f[0] = bf2f(y0.x & 0xffff) + bf2f(y1.x & 0xffff); f[1] = bf2f(y0.x >> 16) + bf2f(y1.x >> 16);
                f[2] = bf2f(y0.y & 0xffff) + bf2f(y1.y & 0xffff); f[3] = bf2f(y0.y >> 16) + bf2f(y1.y >> 16); }
                v[j] += (gv * scl) * f;
            }
        }
#pragma unroll
        for (int j = 0; j < 4; ++j) { u32x2 o; o.x = cvtpk(v[j][0], v[j][1]); o.y = cvtpk(v[j][2], v[j][3]); *(u32x2*)(xws + (size_t)r * 1024 + 4 * lane + 256 * j) = o; }
        float ss = 0.f;
#pragma unroll
        for (int j = 0; j < 4; ++j) ss += (v[j][0] * v[j][0] + v[j][1] * v[j][1]) + (v[j][2] * v[j][2] + v[j][3] * v[j][3]);
        const float rstd = rsqrtf(wave_sum(ss) * (1.0f / 1024.0f) + EPS);
#pragma unroll
        for (int j = 0; j < 4; ++j) {
            const int c = 4 * lane + 256 * j;
            const f32x4 w = nwv[j], sh = shv[j], sc = scv[j];
            const f32x4 h = (v[j] * rstd * w) * (1.0f + sc) + sh;
            u32x2 o; o.x = pk2(h[0], h[1]); o.y = pk2(h[2], h[3]);
            *(u32x2*)(hb + (size_t)r * 1024 + c) = o;
        }
    }
}

__device__ __forceinline__ void phase_final(const Params& p) {
    const int lane = otid() & 63, wid = otid() >> 6;
    const bf16_t* xws = (const bf16_t*)(ows(p) + WS_X); const bf16_t* yb = (const bf16_t*)(ows(p) + WS_YB);
    const float* modv = (const float*)(ows(p) + WS_MOD); const float* nw = oin(p, 19);
    for (int r = obid() * 8 + wid; r < NLAT; r += gridDim.x * 8) {
        const int mr = mod_row(r);
        const float* g5 = modv + ((size_t)3 * 9 + mr) * 6144 + 5 * 1024;
        f32x4 v[4], fw[4]; float ss = 0.f;
#pragma unroll
        for (int j = 0; j < 4; ++j) fw[j] = *(const f32x4*)(nw + 4 * lane + 256 * j);
#pragma unroll
        for (int j = 0; j < 4; ++j) {
            const int c = 4 * lane + 256 * j;
            v[j] = unpk4_bf16(*(const u32x2*)(xws + (size_t)r * 1024 + c));
            const f32x4 gv = *(const f32x4*)(g5 + c);
            f32x4 f;
            if (MOE_FP8) { const unsigned char* y8 = ows(p) + WS_YB8; f = (unpk4_fp8(*(const unsigned*)(y8 + (size_t)(2 * r) * 1024 + c)) + unpk4_fp8(*(const unsigned*)(y8 + (size_t)(2 * r + 1) * 1024 + c))) * (1.0f / 64.0f); }
            else { const u32x2 y0 = *(const u32x2*)(yb + (size_t)(2 * r) * 1024 + c), y1 = *(const u32x2*)(yb + (size_t)(2 * r + 1) * 1024 + c);
            f[0] = bf2f(y0.x & 0xffff) + bf2f(y1.x & 0xffff); f[1] = bf2f(y0.x >> 16) + bf2f(y1.x >> 16);
            f[2] = bf2f(y0.y & 0xffff) + bf2f(y1.y & 0xffff); f[3] = bf2f(y0.y >> 16) + bf2f(y1.y >> 16); }
            v[j] += gv * f;
            ss += (v[j][0] * v[j][0] + v[j][1] * v[j][1]) + (v[j][2] * v[j][2] + v[j][3] * v[j][3]);
        }
        const float rstd = rsqrtf(wave_sum(ss) * (1.0f / 1024.0f) + EPS);
#pragma unroll
        for (int j = 0; j < 4; ++j) { const int c = 4 * lane + 256 * j; *(f32x4*)(p.out + (size_t)r * 1024 + c) = v[j] * rstd * fw[j]; }
    }
}

__device__ __forceinline__ void phase_gemm1(const Params& p, int l, unsigned char* lds) {
    const bf16_t* hb = (const bf16_t*)(ows(p) + WS_H); const bf16_t* wt = (const bf16_t*)(ows(p) + WS_WIN) + (size_t)l * 4096 * 1024; bf16_t* pb = (bf16_t*)(ows(p) + WS_P);
    constexpr int NT = PW / 128, MT = NTOK / 128;
    for (int u = obid(); u < MT * NT; u += gridDim.x) {
        const int mt = u / NT, nt = u % NT;
        ARowPlain ar{hb + (size_t)mt * 128 * 1024, 1024};
        EpiP ep{pb + (size_t)mt * 128 * PW + nt * 128};
        gemm128(lds, ar, wt + (size_t)nt * 128 * 1024, 1024, ep);
    }
}

__device__ __forceinline__ void unpack8(const u32x4 w, float (&f)[8]) {
    f[0] = bf2f(w.x & 0xffff); f[1] = bf2f(w.x >> 16); f[2] = bf2f(w.y & 0xffff); f[3] = bf2f(w.y >> 16);
    f[4] = bf2f(w.z & 0xffff); f[5] = bf2f(w.z >> 16); f[6] = bf2f(w.w & 0xffff); f[7] = bf2f(w.w >> 16);
}
__device__ __forceinline__ void conv_rows(const Params& p, int l, int widx, int nwv) {
    const int lane = otid() & 63;
    const bf16_t* pb = (const bf16_t*)(ows(p) + WS_P); bf16_t* yb = (bf16_t*)(ows(p) + WS_Y);
    const float* cw = oin(p, 8) + (size_t)l * 3 * 512; const float* cnw = oin(p, 9) + (size_t)l * 512;
    const int nrows = (l == DEPTH - 1) ? NLAT : NTOK;
    const int c0 = lane * 8;
    float w0[8], w1[8], w2[8], nwv8[8];
#pragma unroll
    for (int j = 0; j < 8; ++j) { w0[j] = cw[c0 + j]; w1[j] = cw[512 + c0 + j]; w2[j] = cw[1024 + c0 + j]; nwv8[j] = cnw[c0 + j]; }
    constexpr int NB = 4;
    for (int rb = widx; rb < nrows; rb += NB * nwv) {
        u32x4 vb[NB], vc[NB], vh[NB], vcm[NB], vhm[NB], vcp[NB], vhp[NB]; bool hm[NB], hp[NB];
#pragma unroll
        for (int q = 0; q < NB; ++q) {
            int r = rb + q * nwv; if (r >= nrows) r = rb;
            int rm = -1, rp = -1;
            if (r < NLAT) {
                const int t = r & 2047;
                if (c0 < 256) { if ((t & 63) > 0) rm = r - 1; if ((t & 63) < 63) rp = r + 1; }
                else { if (t >= 64) rm = r - 64; if (t < SEQ - 64) rp = r + 64; }
            } else { const int tc = (r - NLAT) & 255; if (tc > 0) rm = r - 1; if (tc < 255) rp = r + 1; }
            hm[q] = rm >= 0; hp[q] = rp >= 0; if (rm < 0) rm = r; if (rp < 0) rp = r;
            vb[q] = *(const u32x4*)(pb + (size_t)r * PW + OFF_B + c0); vc[q] = *(const u32x4*)(pb + (size_t)r * PW + OFF_C + c0); vh[q] = *(const u32x4*)(pb + (size_t)r * PW + OFF_HV + c0);
            vcm[q] = *(const u32x4*)(pb + (size_t)rm * PW + OFF_C + c0); vhm[q] = *(const u32x4*)(pb + (size_t)rm * PW + OFF_HV + c0);
            vcp[q] = *(const u32x4*)(pb + (size_t)rp * PW + OFF_C + c0); vhp[q] = *(const u32x4*)(pb + (size_t)rp * PW + OFF_HV + c0);
        }
#pragma unroll
        for (int q = 0; q < NB; ++q) {
            const int r = rb + q * nwv;
            float bg[8], u0[8], um[8], up[8], t1[8];
            unpack8(vb[q], bg); unpack8(vc[q], u0); unpack8(vh[q], t1);
#pragma unroll
            for (int j = 0; j < 8; ++j) u0[j] *= t1[j];
            unpack8(vcm[q], um); unpack8(vhm[q], t1);
#pragma unroll
            for (int j = 0; j < 8; ++j) um[j] = hm[q] ? um[j] * t1[j] : 0.f;
            unpack8(vcp[q], up); unpack8(vhp[q], t1);
#pragma unroll
            for (int j = 0; j < 8; ++j) up[j] = hp[q] ? up[j] * t1[j] : 0.f;
            float z[8]; float ss = 0.f;
#pragma unroll
            for (int j = 0; j < 8; ++j) { z[j] = bg[j] * (w0[j] * um[j] + w1[j] * u0[j] + w2[j] * up[j]); ss += z[j] * z[j]; }
            const float rstd = rsqrtf(wave_sum(ss) * (1.0f / 512.0f) + EPS);
            if (G2_FP8) {
                const float rs8 = rstd * 8.0f; u32x2 o8;
                o8.x = pk4_fp8(z[0] * rs8 * nwv8[0], z[1] * rs8 * nwv8[1], z[2] * rs8 * nwv8[2], z[3] * rs8 * nwv8[3]); o8.y = pk4_fp8(z[4] * rs8 * nwv8[4], z[5] * rs8 * nwv8[5], z[6] * rs8 * nwv8[6], z[7] * rs8 * nwv8[7]);
                if (r < nrows) *(u32x2*)((unsigned char*)yb + (size_t)r * 1024 + c0) = o8;
            } else {
            u32x4 o;
            o.x = cvtpk(z[0] * rstd * nwv8[0], z[1] * rstd * nwv8[1]); o.y = cvtpk(z[2] * rstd * nwv8[2], z[3] * rstd * nwv8[3]);
            o.z = cvtpk(z[4] * rstd * nwv8[4], z[5] * rstd * nwv8[5]); o.w = cvtpk(z[6] * rstd * nwv8[6], z[7] * rstd * nwv8[7]);
            if (r < nrows) *(u32x4*)(yb + (size_t)r * 1024 + c0) = o; }
        }
    }
}

template <int DIR>
__device__ __forceinline__ void gla_pre_dir(const Params& p, int l, int chunk, float* sQ, float* sK, const float* sV, float* sA, float* sBq, float (&oacc)[16]) {
    const int ch = otid(), tid = otid(), R0 = chunk * 16;
    const bf16_t* pb = (const bf16_t*)(ows(p) + WS_P);
    bf16_t* qin = (bf16_t*)(ows(p) + WS_QIN); bf16_t* kout = (bf16_t*)(ows(p) + WS_KOUT); float* dch = (float*)(ows(p) + WS_DCH);
    float lbv = 0.f;
    {
        const float* lb = oin(p, 10) + (size_t)DIR * 4 * 512 + ch;
        const float z0 = lb[0], z1 = lb[512], z2 = lb[1024], z3 = lb[1536];
        const float mx = fmaxf(fmaxf(z0, z1), fmaxf(z2, z3));
        const float e0 = __expf(z0 - mx), e1 = __expf(z1 - mx), e2 = __expf(z2 - mx), e3 = __expf(z3 - mx);
        const float inv = 1.0f / (e0 + e1 + e2 + e3);
        lbv = ((l >= 1 ? e1 : 0.f) + (l >= 2 ? e2 : 0.f) + (l >= 3 ? e3 : 0.f)) * inv;
    }
    float b = 0.f;
#pragma unroll 1
    for (int i = 0; i < 16; ++i) {
        const int row = R0 + (DIR ? 15 - i : i);
        const float zf = bf2f(pb[(size_t)row * PW + OFF_ZF + DIR * 512 + ch]);
        const float sg = 1.0f / (1.0f + __expf(-zf)), sn = 1.0f / (1.0f + __expf(zf));
        const float f = fmaxf(lbv + (1.0f - lbv) * sg, 1e-30f);
        b += __logf(f);
        sBq[i * 512 + ch] = b; sK[i * 512 + ch] = (1.0f - lbv) * sn;
        sQ[i * 512 + ch] = siluf(bf2f(pb[(size_t)row * PW + OFF_Q + ch]));
    }
    const float blast = b;
#pragma unroll 1
    for (int i = 0; i < 16; ++i) {
        const int row = R0 + (DIR ? 15 - i : i);
        const float bi = sBq[i * 512 + ch], kq = sK[i * 512 + ch], qv = sQ[i * 512 + ch];
        const float qi = qv * __expf(bi), kt = kq * __expf(fminf(-bi, 80.0f)), ko = kq * __expf(blast - bi);
        sQ[i * 512 + ch] = qi; sK[i * 512 + ch] = kt;
        qin[((size_t)DIR * NTOK + row) * 512 + ch] = (bf16_t)f2bf(qi);
        kout[((size_t)DIR * NTOK + row) * 512 + ch] = (bf16_t)f2bf(ko);
    }
    dch[((size_t)DIR * NCHUNK + chunk) * 512 + ch] = __expf(blast);
    __syncthreads();
#pragma unroll 1
    for (int e2 = 0; e2 < 2; ++e2) {
        const int e = tid * 2 + e2, h = e >> 8, t = (e >> 4) & 15, s = e & 15;
        float sum = 0.f;
        const float* qp = sQ + t * 512 + h * 128; const float* kp = sK + s * 512 + h * 128;
#pragma unroll 8
        for (int k = 0; k < 128; ++k) sum += qp[k] * kp[k];
        sA[e] = (s <= t) ? sum : 0.f;
    }
    __syncthreads();
    const int h = ch >> 7;
#pragma unroll
    for (int t = 0; t < 16; ++t) {
        float o = 0.f;
#pragma unroll 1
        for (int s = 0; s <= t; ++s) o += sA[(h * 16 + t) * 16 + s] * sV[(DIR ? 15 - s : s) * 512 + ch];
        oacc[DIR ? 15 - t : t] += o;
    }
    __syncthreads();
}

__device__ __forceinline__ void phase_conv_glapre(const Params& p, int l, unsigned char* lds) {
    conv_rows(p, l, obid() * 8 + (otid() >> 6), (int)gridDim.x * 8);
    float* sQ = (float*)lds; float* sK = sQ + 16 * 512; float* sV = sK + 16 * 512; float* sBq = sV + 16 * 512; float* sA = sBq + 16 * 512;
    const bf16_t* pb = (const bf16_t*)(ows(p) + WS_P); float* ointra = (float*)(ows(p) + WS_OINTRA);
    const int ch = otid();
    for (int chunk = obid(); chunk < NCHUNK; chunk += gridDim.x) {
        const int R0 = chunk * 16;
        float oacc[16];
#pragma unroll
        for (int i = 0; i < 16; ++i) oacc[i] = 0.f;
        __syncthreads();
#pragma unroll
        for (int ro = 0; ro < 16; ++ro) sV[ro * 512 + ch] = bf2f(pb[(size_t)(R0 + ro) * PW + OFF_I + ch]);
        gla_pre_dir<0>(p, l, chunk, sQ, sK, sV, sA, sBq, oacc);
        gla_pre_dir<1>(p, l, chunk, sQ, sK, sV, sA, sBq, oacc);
#pragma unroll
        for (int ro = 0; ro < 16; ++ro) ointra[(size_t)(R0 + ro) * 512 + ch] = oacc[ro];
    }
}

__device__ __forceinline__ void phase_gla_seq(const Params& p, int l, unsigned char* lds) {
    const int tid = otid();
    float* S = (float*)lds;
    float* sQ = S + 128 * 32;
    float* sKo = sQ + 16 * 128;
    float* sV = sKo + 16 * 128;
    float* sD = sV + 16 * 32;
    const bf16_t* pb = (const bf16_t*)(ows(p) + WS_P);
    const bf16_t* qin = (const bf16_t*)(ows(p) + WS_QIN); const bf16_t* kout = (const bf16_t*)(ows(p) + WS_KOUT); const float* dch = (const float*)(ows(p) + WS_DCH);
    float* ointer = (float*)(ows(p) + WS_OINTER);
    for (int u = obid(); u < 256; u += gridDim.x) {
        const int vblk = u & 3, dir = (u >> 2) & 1, chain = u >> 3, b = chain >> 2, h = chain & 3;
        __syncthreads();
        for (int i = tid; i < 128 * 32; i += 512) S[i] = 0.f;
        for (int c = 0; c < 144; ++c) {
            int R0;
            if (c < 16) { const int cm = dir ? 15 - c : c; R0 = NLAT + b * 256 + cm * 16; }
            else { const int cc = c - 16; const int cm = dir ? 127 - cc : cc; R0 = b * 2048 + cm * 16; }
            __syncthreads();
            for (int i = tid; i < 16 * 128; i += 512) {
                const int si = i >> 7, k = i & 127; const int row = R0 + (dir ? 15 - si : si);
                const size_t g = ((size_t)dir * NTOK + row) * 512 + h * 128 + k;
                sQ[i] = bf2f(qin[g]); sKo[i] = bf2f(kout[g]);
            }
            { const int si = tid >> 5, vv = tid & 31; const int row = R0 + (dir ? 15 - si : si); sV[tid] = bf2f(pb[(size_t)row * PW + OFF_I + h * 128 + vblk * 32 + vv]); }
            if (tid < 128) sD[tid] = dch[((size_t)dir * NCHUNK + (R0 >> 4)) * 512 + h * 128 + tid];
            __syncthreads();
            {
                const int si = tid >> 5, vv = tid & 31; const int row = R0 + (dir ? 15 - si : si);
                float o = 0.f;
                for (int k = 0; k < 128; ++k) o += sQ[si * 128 + k] * S[k * 32 + vv];
                ointer[((size_t)dir * NTOK + row) * 512 + h * 128 + vblk * 32 + vv] = o;
            }
            __syncthreads();
            {
                const int k = tid >> 2, v0 = (tid & 3) * 8; const float d = sD[k];
                float kk[16];
#pragma unroll
                for (int i = 0; i < 16; ++i) kk[i] = sKo[i * 128 + k];
#pragma unroll
                for (int j = 0; j < 8; ++j) {
                    float s = d * S[k * 32 + v0 + j];
#pragma unroll
                    for (int i = 0; i < 16; ++i) s += kk[i] * sV[i * 32 + v0 + j];
                    S[k * 32 + v0 + j] = s;
                }
            }
        }
    }
}


__device__ __forceinline__ float bflo(unsigned w) { return __uint_as_float(w << 16); }
__device__ __forceinline__ float bfhi(unsigned w) { return __uint_as_float(w & 0xffff0000u); }

template <int DIR>
__device__ __forceinline__ void gla_pre2_dir(const float (&q0a)[16], const float (&q1a)[16], const unsigned (&rz)[16], float lb0, float lb1, unsigned char* wl, unsigned char* rec,
                                             f32x4 (&oT)[8], int lane, int fr, int fq) {
    float bq0[16], bq1[16], kk0[16], kk1[16]; float b0 = 0.f, b1 = 0.f;
#pragma unroll
    for (int i = 0; i < 16; ++i) {
        const int t = DIR ? 15 - i : i;
        const float z0 = bflo(rz[t]), z1 = bfhi(rz[t]);
        const float sg0 = frcp(1.0f + __expf(-z0)), sg1 = frcp(1.0f + __expf(-z1));
        const float f0 = fmaxf(lb0 + (1.0f - lb0) * sg0, 1e-30f), f1 = fmaxf(lb1 + (1.0f - lb1) * sg1, 1e-30f);
        b0 += __logf(f0); b1 += __logf(f1); bq0[t] = b0; bq1[t] = b1; kk0[t] = 1.0f - f0; kk1[t] = 1.0f - f1;
    }
    const float bl0 = b0, bl1 = b1;
    unsigned kw0[8], kw1[8];
#pragma unroll
    for (int i = 0; i < 8; ++i) { kw0[i] = 0u; kw1[i] = 0u; }
#pragma unroll
    for (int t = 0; t < 16; ++t) {
        const float e0 = __expf(bq0[t]), e1 = __expf(bq1[t]);
        const float qi0 = q0a[t] * e0, qi1 = q1a[t] * e1;
        const float kt0 = kk0[t] * frcp(fmaxf(e0, 1.8e-35f)), kt1 = kk1[t] * frcp(fmaxf(e1, 1.8e-35f));
        const float ko0 = kk0[t] * __expf(bl0 - bq0[t]), ko1 = kk1[t] * __expf(bl1 - bq1[t]);
        *(unsigned*)(wl + t * 272 + lane * 4) = cvtpk(qi0, qi1);
        *(unsigned*)(wl + 4352 + t * 272 + lane * 4) = cvtpk(kt0, kt1);
        const unsigned kp = cvtpk(ko0, ko1);
        kw0[t >> 1] |= (kp & 0xffffu) << (16 * (t & 1)); kw1[t >> 1] |= (kp >> 16) << (16 * (t & 1));
    }
    {
        const int c0 = 2 * lane, c1 = c0 + 1;
        unsigned char* k0p = rec + 4096 + (c0 >> 4) * 512 + (c0 & 15) * 8; unsigned char* k1p = rec + 4096 + (c1 >> 4) * 512 + (c1 & 15) * 8;
#pragma unroll
        for (int g = 0; g < 4; ++g) { *(u32x2*)(k0p + g * 128) = (u32x2){kw0[2 * g], kw0[2 * g + 1]}; *(u32x2*)(k1p + g * 128) = (u32x2){kw1[2 * g], kw1[2 * g + 1]}; }
        float* dp = (float*)(rec + 8192) + c0; dp[0] = __expf(bl0); dp[1] = __expf(bl1);
    }
    LDS_WAIT();
#pragma unroll
    for (int s = 0; s < 4; ++s) {
        const u32x2 lo = *(const u32x2*)(wl + fr * 272 + (32 * s + 4 * fq) * 2), hi = *(const u32x2*)(wl + fr * 272 + (32 * s + 16 + 4 * fq) * 2);
        *(u32x4*)(rec + s * 1024 + lane * 16) = (u32x4){lo.x, lo.y, hi.x, hi.y};
    }
    f32x4 at = (f32x4){0.f, 0.f, 0.f, 0.f};
#pragma unroll
    for (int s = 0; s < 4; ++s) {
        const bf16x8 kf = *(const bf16x8*)(wl + 4352 + fr * 272 + (32 * s + 8 * fq) * 2);
        const bf16x8 qf = *(const bf16x8*)(wl + fr * 272 + (32 * s + 8 * fq) * 2);
        at = __builtin_amdgcn_mfma_f32_16x16x32_bf16(kf, qf, at, 0, 0, 0);
    }
#pragma unroll
    for (int r = 0; r < 4; ++r) { const int sp = 4 * fq + r; const bool keep = DIR ? (sp >= fr) : (sp <= fr); at[r] = keep ? at[r] : 0.f; }
    union { u32x2 u; s16x4 h; } bop; bop.u = (u32x2){cvtpk(at[0], at[1]), cvtpk(at[2], at[3])};
#pragma unroll
    for (int vb = 0; vb < 8; ++vb) {
        union { u32x2 u; s16x4 h; } aop; aop.u = *(const u32x2*)(wl + 8704 + (vb * 16 + fr) * 32 + 8 * fq);
        oT[vb] = __builtin_amdgcn_mfma_f32_16x16x16bf16_1k(aop.h, bop.h, oT[vb], 0, 0, 0);
    }
    LDS_WAIT();
}

__device__ __forceinline__ void phase_gla_pre2(const Params& p, int l, unsigned char* lds) {
    const int tid = otid(), lane = tid & 63, wid = __builtin_amdgcn_readfirstlane(tid >> 6), fr = lane & 15, fq = lane >> 4;
    unsigned char* wl = lds + wid * 12800;
    unsigned char* ws = ows(p);
    const bf16_t* pb = (const bf16_t*)(ws + WS_P); bf16_t* ointra = (bf16_t*)(ws + WS_OINTRA);
    float lb[2][2];
    {
        const float* hl = oin(p, 10);
#pragma unroll
        for (int d = 0; d < 2; ++d)
#pragma unroll
            for (int e = 0; e < 2; ++e) {
                const float* q = hl + (size_t)d * 4 * 512 + (2 * lane + e);
                lb[d][e] = 0.f; (void)q;
            }
    }
    for (int unit = wid * (int)gridDim.x + obid(); unit < NCHUNK * 4; unit += gridDim.x * 8) {
        const int chunk = unit >> 2, h = unit & 3, R0 = chunk * 16;
        {
            const float* hl = oin(p, 10);
#pragma unroll
            for (int d = 0; d < 2; ++d)
#pragma unroll
                for (int e = 0; e < 2; ++e) {
                    const float* q = hl + (size_t)d * 4 * 512 + h * 128 + 2 * lane + e;
                    const float z0 = q[0], z1 = q[512], z2 = q[1024], z3 = q[1536];
                    const float mx = fmaxf(fmaxf(z0, z1), fmaxf(z2, z3));
                    const float e0 = __expf(z0 - mx), e1 = __expf(z1 - mx), e2 = __expf(z2 - mx), e3 = __expf(z3 - mx);
                    lb[d][e] = ((l >= 1 ? e1 : 0.f) + (l >= 2 ? e2 : 0.f) + (l >= 3 ? e3 : 0.f)) / (e0 + e1 + e2 + e3);
                }
        }
        unsigned rq[16], rf[16], rb[16], rv[16];
#pragma unroll
        for (int t = 0; t < 16; ++t) {
            const bf16_t* base = pb + (size_t)(R0 + t) * PW + h * 128 + 2 * lane;
            rq[t] = *(const unsigned*)(base + OFF_Q); rf[t] = *(const unsigned*)(base + OFF_ZF); rb[t] = *(const unsigned*)(base + OFF_ZF + 512); rv[t] = *(const unsigned*)(base + OFF_I);
        }
        unsigned char* vrec = ws + WS_VREC + (size_t)(chunk * 4 + h) * VREC_BYTES;
        {
            unsigned w0[8], w1[8];
#pragma unroll
            for (int i = 0; i < 8; ++i) { w0[i] = (rv[2 * i] & 0xffffu) | (rv[2 * i + 1] << 16); w1[i] = (rv[2 * i] >> 16) | (rv[2 * i + 1] & 0xffff0000u); }
            const int c0 = 2 * lane, c1 = c0 + 1;
            unsigned char* v0p = vrec + (c0 >> 4) * 512 + (c0 & 15) * 8; unsigned char* v1p = vrec + (c1 >> 4) * 512 + (c1 & 15) * 8;
#pragma unroll
            for (int g = 0; g < 4; ++g) { *(u32x2*)(v0p + g * 128) = (u32x2){w0[2 * g], w0[2 * g + 1]}; *(u32x2*)(v1p + g * 128) = (u32x2){w1[2 * g], w1[2 * g + 1]}; }
            unsigned char* vl = wl + 8704 + c0 * 32;
            *(u32x4*)(vl) = (u32x4){w0[0], w0[1], w0[2], w0[3]}; *(u32x4*)(vl + 16) = (u32x4){w0[4], w0[5], w0[6], w0[7]};
            *(u32x4*)(vl + 32) = (u32x4){w1[0], w1[1], w1[2], w1[3]}; *(u32x4*)(vl + 48) = (u32x4){w1[4], w1[5], w1[6], w1[7]};
        }
        f32x4 oT[8];
#pragma unroll
        for (int vb = 0; vb < 8; ++vb) oT[vb] = (f32x4){0.f, 0.f, 0.f, 0.f};
        float q0a[16], q1a[16];
#pragma unroll
        for (int t = 0; t < 16; ++t) { q0a[t] = siluf(bflo(rq[t])); q1a[t] = siluf(bfhi(rq[t])); }
        gla_pre2_dir<0>(q0a, q1a, rf, lb[0][0], lb[0][1], wl, ws + WS_GREC + ((size_t)(0 * NCHUNK + chunk) * 4 + h) * REC_BYTES, oT, lane, fr, fq);
        gla_pre2_dir<1>(q0a, q1a, rb, lb[1][0], lb[1][1], wl, ws + WS_GREC + ((size_t)(1 * NCHUNK + chunk) * 4 + h) * REC_BYTES, oT, lane, fr, fq);
#pragma unroll
        for (int vb = 0; vb < 8; ++vb) *(u32x2*)(ointra + (size_t)(R0 + fr) * 512 + h * 128 + vb * 16 + 4 * fq) = (u32x2){cvtpk(oT[vb][0], oT[vb][1]), cvtpk(oT[vb][2], oT[vb][3])};
    }
}

constexpr int GR = 8, STG_BYTES = REC_BYTES + VREC_BYTES;
__device__ __forceinline__ int gla_chunk_of_step(int c, int b, int dir) {
    if (c < 16) { const int cm = dir ? 15 - c : c; return (NLAT + b * 256) / 16 + cm; }
    const int cc = c - 16; const int cm = dir ? 127 - cc : cc; return b * 128 + cm;
}
constexpr int SG_STEP = REC_BYTES + 2048, SG_GRP = 2 * SG_STEP, SG_NG = 6;
constexpr int SG_DUMP = SG_NG * SG_GRP;
constexpr int SG_FLAGS = LDS_MISC + 2048;
constexpr unsigned SG_SPIN = 1u << 22;
static_assert(SG_DUMP + 1024 <= LDS_MISC, "scan ring");
__device__ __forceinline__ void gla_scan_unit(const Params& p, int l, unsigned char* lds_, int chain, int vhalf) {
    LAS unsigned char* lds = (LAS unsigned char*)lds_;
    const int tid = otid(), lane = tid & 63, wid = __builtin_amdgcn_readfirstlane(tid >> 6), fr = lane & 15, fq = lane >> 4;
    unsigned char* ws = ows(p);
    const int b = chain >> 3, h = (chain >> 1) & 3, dir = chain & 1;
    volatile LAS unsigned* flg = (volatile LAS unsigned*)(lds + SG_FLAGS);
    __syncthreads();
    if (tid < 32) flg[tid] = 0u;
    __syncthreads();
    if (wid >= 4) {
        const int m = wid & 3;
        const unsigned char* grec = ws + WS_GREC + (size_t)dir * NCHUNK * 4 * REC_BYTES + (size_t)h * REC_BYTES + lane * 16;
        const unsigned char* vrec = ws + WS_VREC + (size_t)h * VREC_BYTES + vhalf * 2048 + lane * 16;
        const volatile LAS unsigned* dn = flg + 4 + (lane & 3);
#define GSEQ_ISSUE(gi) do { const int _g = (gi); _Pragma("unroll") for (int _j = 0; _j < 6; ++_j) { const int _p = m + 4 * _j; const bool _real = _p < 22; const int _s = _real ? _p / 11 : 0, _q = _real ? _p % 11 : 0; \
        const int _c = 2 * _g + _s; const int _cc = _c < 144 ? _c : 143; const int _ch = gla_chunk_of_step(_cc, b, dir); \
        const unsigned char* _src = (_q < 9) ? grec + (size_t)_ch * 4 * REC_BYTES + _q * 1024 : vrec + (size_t)_ch * 4 * VREC_BYTES + (_q - 9) * 1024; \
        const unsigned _dst = _real ? (unsigned)(_g % SG_NG) * SG_GRP + _s * SG_STEP + _q * 1024 : (unsigned)SG_DUMP; \
        __builtin_amdgcn_global_load_lds((const unsigned*)_src, (LAS unsigned*)(lds + _dst), 16, 0, 0); } } while (0)
#pragma unroll 1
        for (int g = 0; g < SG_NG - 1; ++g) GSEQ_ISSUE(g);
#pragma unroll 1
        for (int g = 0; g < 72; ++g) {
            asm volatile("s_waitcnt vmcnt(%0)" :: "n"((SG_NG - 2) * 6) : "memory");
            if (lane == 0) flg[m] = (unsigned)(g + 1);
            { unsigned sp = 0; while (__builtin_amdgcn_ballot_w64(*dn < (unsigned)g) != 0ull && ++sp < SG_SPIN) __builtin_amdgcn_s_sleep(1); asm volatile("" ::: "memory"); }
            GSEQ_ISSUE(g + SG_NG - 1);
        }
#undef GSEQ_ISSUE
    } else {
        const int vt = wid;
        bf16_t* ointer = (bf16_t*)(ws + WS_OINTER) + (size_t)dir * NTOK * 512 + h * 128 + (vhalf * 4 + vt) * 16 + fr;
        const volatile LAS unsigned* fl = flg + (lane & 3);
        f32x4 acc[8];
#pragma unroll
        for (int j = 0; j < 8; ++j) acc[j] = (f32x4){0.f, 0.f, 0.f, 0.f};
        union { u32x4 u; bf16x8 h; } sb[4];
#pragma unroll
        for (int j = 0; j < 4; ++j) sb[j].u = (u32x4){0u, 0u, 0u, 0u};
#pragma unroll 1
        for (int g = 0; g < 72; ++g) {
            { unsigned sp = 0; while (__builtin_amdgcn_ballot_w64(*fl < (unsigned)(g + 1)) != 0ull && ++sp < SG_SPIN) { } asm volatile("" ::: "memory"); }
#pragma unroll
            for (int s2 = 0; s2 < 2; ++s2) {
                const int c = 2 * g + s2;
                const LAS unsigned char* st = lds + (unsigned)(g % SG_NG) * SG_GRP + s2 * SG_STEP;
                const int chunk = gla_chunk_of_step(c, b, dir);
                bf16x8 qa[4]; f32x4 dv[8];
                union { u32x2 u; s16x4 h; } ka[8], vb;
#pragma unroll
                for (int j = 0; j < 4; ++j) qa[j] = *(const LAS bf16x8*)(st + j * 1024 + lane * 16);
                vb.u = *(const LAS u32x2*)(st + REC_BYTES + vt * 512 + lane * 8);
#pragma unroll
                for (int j = 0; j < 8; ++j) { ka[j].u = *(const LAS u32x2*)(st + 4096 + j * 512 + lane * 8); dv[j] = *(const LAS f32x4*)(st + 8192 + (j * 16 + 4 * fq) * 4); }
                f32x4 o0 = (f32x4){0.f, 0.f, 0.f, 0.f}, o1 = (f32x4){0.f, 0.f, 0.f, 0.f};
                o0 = __builtin_amdgcn_mfma_f32_16x16x32_bf16(qa[0], sb[0].h, o0, 0, 0, 0); o1 = __builtin_amdgcn_mfma_f32_16x16x32_bf16(qa[1], sb[1].h, o1, 0, 0, 0);
                o0 = __builtin_amdgcn_mfma_f32_16x16x32_bf16(qa[2], sb[2].h, o0, 0, 0, 0); o1 = __builtin_amdgcn_mfma_f32_16x16x32_bf16(qa[3], sb[3].h, o1, 0, 0, 0);
#pragma unroll
                for (int j = 0; j < 8; ++j) {
                    acc[j] = acc[j] * dv[j];
                    acc[j] = __builtin_amdgcn_mfma_f32_16x16x16bf16_1k(ka[j].h, vb.h, acc[j], 0, 0, 0);
                }
                const f32x4 os = o0 + o1;
                bf16_t* op = ointer + (size_t)(chunk * 16 + 4 * fq) * 512;
                { const unsigned w01 = cvtpk(os[0], os[1]), w23 = cvtpk(os[2], os[3]); op[0] = (bf16_t)(w01 & 0xffffu); op[512] = (bf16_t)(w01 >> 16); op[1024] = (bf16_t)(w23 & 0xffffu); op[1536] = (bf16_t)(w23 >> 16); }
#pragma unroll
                for (int j = 0; j < 4; ++j) sb[j].u = (u32x4){cvtpk(acc[2 * j][0], acc[2 * j][1]), cvtpk(acc[2 * j][2], acc[2 * j][3]), cvtpk(acc[2 * j + 1][0], acc[2 * j + 1][1]), cvtpk(acc[2 * j + 1][2], acc[2 * j + 1][3])};
            }
            asm volatile("s_waitcnt lgkmcnt(0)" ::: "memory");
            if (lane == 0) flg[4 + wid] = (unsigned)(g + 1);
        }
    }
    asm volatile("s_waitcnt vmcnt(0) lgkmcnt(0)" ::: "memory");
    __syncthreads();
}
__device__ __forceinline__ void phase_gla_seq2(const Params& p, int l, unsigned char* lds) {
    const int G = (int)gridDim.x, bid = obid();
    const int nscan = (G >= 256) ? 128 : G;
    for (int rep = 0; rep < ((DUPK == 50) ? 2 : 1); ++rep) {
        for (int r2 = 0; r2 < ((DUPK == 51) ? 2 : 1); ++r2)
        if (bid < nscan) for (int u = bid; u < 128; u += nscan) { const int x = u & 7, jj = u >> 3; gla_scan_unit(p, l, lds, x + 8 * (jj >> 1), jj & 1); }
        const int cg0 = (G == 256) ? l * CV_LAYER + CV_B : l * CV_ALL, cg1 = (G == 256) ? l * CV_LAYER + CV_B + CV_S : (l + 1) * CV_ALL;
        for (int r3 = 0; r3 < ((DUPK == 52) ? 2 : 1); ++r3)
        if (G > nscan) { if (bid >= nscan) { const int widx = (bid - nscan) * 8 + (otid() >> 6), nwv = (G - nscan) * 8; conv_rows(p, l, widx, nwv); convert_range(p, (float*)(lds + (otid() >> 6) * 16384), widx, nwv, cg0, cg1); } }
        else { const int widx = bid * 8 + (otid() >> 6), nwv = G * 8; __syncthreads(); conv_rows(p, l, widx, nwv); convert_range(p, (float*)(lds + (otid() >> 6) * 16384), widx, nwv, cg0, cg1); }
    }
}

__device__ __forceinline__ void phase_gla_post(const Params& p, int l) {
    const int lane = otid() & 63, wid = otid() >> 6;
    const bf16_t* pb = (const bf16_t*)(ows(p) + WS_P); bf16_t* yb = (bf16_t*)(ows(p) + WS_Y);
    const bf16_t* oi = (const bf16_t*)(ows(p) + WS_OINTRA); const bf16_t* oe = (const bf16_t*)(ows(p) + WS_OINTER);
    const float* hnw = oin(p, 11) + (size_t)l * 128;
    const int nrows = (l == DEPTH - 1) ? NLAT : NTOK;
    const int c0 = lane * 8;
    for (int r = obid() * 8 + wid; r < nrows; r += gridDim.x * 8) {
        float o[8], t1[8], t2[8]; float ss = 0.f;
        const u32x4 gw = *(const u32x4*)(pb + (size_t)r * PW + OFF_G + c0);
        unpack8(*(const u32x4*)(oi + (size_t)r * 512 + c0), o); unpack8(*(const u32x4*)(oe + (size_t)r * 512 + c0), t1); unpack8(*(const u32x4*)(oe + ((size_t)NTOK + r) * 512 + c0), t2);
#pragma unroll
        for (int j = 0; j < 8; ++j) { o[j] += t1[j] + t2[j]; ss += o[j] * o[j]; }
        ss += __shfl_xor(ss, 1); ss += __shfl_xor(ss, 2); ss += __shfl_xor(ss, 4); ss += __shfl_xor(ss, 8);
        const float rstd = rsqrtf(ss * (1.0f / 128.0f) + EPS);
        float g[8]; unpack8(gw, g);
        float y[8];
#pragma unroll
        for (int j = 0; j < 8; ++j) y[j] = o[j] * rstd * hnw[(c0 + j) & 127] * siluf(g[j]);
        if (G2_FP8) { u32x2 w8; w8.x = pk4_fp8(8.0f * y[0], 8.0f * y[1], 8.0f * y[2], 8.0f * y[3]); w8.y = pk4_fp8(8.0f * y[4], 8.0f * y[5], 8.0f * y[6], 8.0f * y[7]); *(u32x2*)((unsigned char*)yb + (size_t)r * 1024 + 512 + c0) = w8; }
        else { u32x4 w; w.x = pk2(y[0], y[1]); w.y = pk2(y[2], y[3]); w.z = pk2(y[4], y[5]); w.w = pk2(y[6], y[7]);
        *(u32x4*)(yb + (size_t)r * 1024 + 512 + c0) = w; }
    }
}

__device__ __forceinline__ void phase_gemm2(const Params& p, int l, unsigned char* lds) {
    const bf16_t* yb = (const bf16_t*)(ows(p) + WS_Y); const bf16_t* wt = (const bf16_t*)(ows(p) + WS_WOUT) + (size_t)l * 1024 * 1024;
    float* xws = (float*)(ows(p) + WS_X); const float* modv = (const float*)(ows(p) + WS_MOD);
    const int MT = ((l == DEPTH - 1) ? NLAT : NTOK) / 128; constexpr int NT = 8;
    for (int u = obid(); u < MT * NT; u += gridDim.x) {
        const int mt = u / NT, nt = u % NT;
        ARowPlain ar{yb + (size_t)mt * 128 * 1024, 1024};
        EpiRes ep{xws + (size_t)mt * 128 * 1024 + nt * 128, modv + (size_t)l * 9 * 6144 + 2 * 1024 + nt * 128, mt * 128};
        gemm128(lds, ar, wt + (size_t)nt * 128 * 1024, 1024, ep);
    }
}

__device__ __forceinline__ void phase_router(const Params& p, int l) {
    const int lane = otid() & 63, wid = otid() >> 6;
    const float* xws = (const float*)(ows(p) + WS_X); bf16_t* hb = (bf16_t*)(ows(p) + WS_H);
    const float* modv = (const float*)(ows(p) + WS_MOD); const float* nw = oin(p, 4) + (size_t)(l * 2 + 1) * 1024;
    const float* wrg = oin(p, 13) + (size_t)l * 1024 * 4; const float* wre = oin(p, 15) + (size_t)l * 1024 * 32;
    const float* brg = oin(p, 14) + l * 4; const float* bre = oin(p, 16) + l * 32;
    unsigned* cnt = (unsigned*)(ows(p) + WS_CTL) + CW_CNT + 64 * l;
    int* ltok = (int*)(ows(p) + WS_LTOK); float* lgate = (float*)(ows(p) + WS_LGATE);
    const int nrows = (l == DEPTH - 1) ? NLAT : NTOK;
    for (int r = obid() * 8 + wid; r < nrows; r += gridDim.x * 8) {
        const int mr = mod_row(r);
        float ss = 0.f;
#pragma unroll
        for (int j = 0; j < 4; ++j) { const f32x4 xv4 = *(const f32x4*)(xws + (size_t)r * 1024 + 4 * lane + 256 * j); ss += (xv4[0] * xv4[0] + xv4[1] * xv4[1]) + (xv4[2] * xv4[2] + xv4[3] * xv4[3]); }
        const float rstd = rsqrtf(wave_sum(ss) * (1.0f / 1024.0f) + EPS);
        const float* msh = modv + ((size_t)l * 9 + mr) * 6144 + 3 * 1024; const float* msc = msh + 1024;
        float lg[36];
#pragma unroll
        for (int i = 0; i < 36; ++i) lg[i] = 0.f;
#pragma unroll 1
        for (int j = 0; j < 4; ++j) {
            const int c = 4 * lane + 256 * j;
            const f32x4 xv4 = *(const f32x4*)(xws + (size_t)r * 1024 + c);
            const f32x4 w = *(const f32x4*)(nw + c), sh = *(const f32x4*)(msh + c), sc = *(const f32x4*)(msc + c);
            const f32x4 h = (xv4 * rstd * w) * (1.0f + sc) + sh;
            u32x2 o; o.x = pk2(h[0], h[1]); o.y = pk2(h[2], h[3]);
            *(u32x2*)(hb + (size_t)r * 1024 + c) = o;
#pragma unroll
            for (int e = 0; e < 4; ++e) {
                const float xv = h[e];
                const f32x4 wg = *(const f32x4*)(wrg + (size_t)(c + e) * 4);
                lg[0] += xv * wg[0]; lg[1] += xv * wg[1]; lg[2] += xv * wg[2]; lg[3] += xv * wg[3];
#pragma unroll
                for (int q = 0; q < 8; ++q) {
                    const f32x4 we = *(const f32x4*)(wre + (size_t)(c + e) * 32 + q * 4);
                    lg[4 + q * 4 + 0] += xv * we[0]; lg[4 + q * 4 + 1] += xv * we[1]; lg[4 + q * 4 + 2] += xv * we[2]; lg[4 + q * 4 + 3] += xv * we[3];
                }
            }
        }
#pragma unroll
        for (int i = 0; i < 36; ++i) lg[i] = wave_sum(lg[i]);
        float gl[4];
#pragma unroll
        for (int i = 0; i < 4; ++i) gl[i] = lg[i] + brg[i];
        int gsel = 0; float gmax = gl[0];
#pragma unroll
        for (int i = 1; i < 4; ++i) if (gl[i] > gmax) { gmax = gl[i]; gsel = i; }
        float gs = 0.f;
#pragma unroll
        for (int i = 0; i < 4; ++i) gs += __expf(gl[i] - gmax);
        const float pg = 1.0f / gs;
        float el[8];
#pragma unroll
        for (int j = 0; j < 8; ++j) {
            float t = lg[4 + j] + bre[j];
#pragma unroll
            for (int g = 1; g < 4; ++g) t = (gsel == g) ? (lg[4 + g * 8 + j] + bre[g * 8 + j]) : t;
            el[j] = t;
        }
        int i1 = 0; float v1 = el[0];
#pragma unroll
        for (int j = 1; j < 8; ++j) if (el[j] > v1) { v1 = el[j]; i1 = j; }
        int i2 = -1; float v2 = -3.0e38f;
#pragma unroll
        for (int j = 0; j < 8; ++j) if (j != i1 && el[j] > v2) { v2 = el[j]; i2 = j; }
        const float e2 = __expf(v2 - v1);
        const float g0 = pg / (1.0f + e2), g1 = pg * e2 / (1.0f + e2);
        if (lane == 0) {
            const int ea = gsel * 8 + i1, eb = gsel * 8 + i2;
            const unsigned pa = atomicAdd(cnt + ea, 1u); ltok[(size_t)ea * NTOK + pa] = r * 2 + 0; lgate[(size_t)ea * NTOK + pa] = g0;
            const unsigned pb2 = atomicAdd(cnt + eb, 1u); ltok[(size_t)eb * NTOK + pb2] = r * 2 + 1; lgate[(size_t)eb * NTOK + pb2] = g1;
        }
    }
}


__device__ __forceinline__ void phase_router2(const Params& p, int l, unsigned char* lds, bool commit) {
    const int tid = otid(), lane = tid & 63, wid = __builtin_amdgcn_readfirstlane(tid >> 6), fr = lane & 15, fq = lane >> 4;
    unsigned char* ws = ows(p);
    const bf16_t* xws = (const bf16_t*)(ws + WS_X); bf16_t* xw = (bf16_t*)(ws + WS_X); const bf16_t* dlt = (const bf16_t*)(ws + WS_DELTA); bf16_t* hb = (bf16_t*)(ws + WS_H);
    const float* modv = (const float*)(ws + WS_MOD); const float* nw = oin(p, 4) + (size_t)(l * 2 + 1) * 1024;
    const float* brg = oin(p, 14) + l * 4; const float* bre = oin(p, 16) + l * 32;
    unsigned* gcnt = (unsigned*)(ws + WS_CTL) + CW_CNT + 64 * 32 * l;
    int* ltok = (int*)(ws + WS_LTOK); float* lgate = (float*)(ws + WS_LGATE);
    constexpr int WPITCH = 2064, WBYTES = 48 * WPITCH;
    unsigned char* wl = lds;
    float* tile = (float*)(lds + WBYTES + wid * 3328);
    int* s_cnt = (int*)(lds + WBYTES + 8 * 3328); int* s_base = s_cnt + 32;
    int* s_e = s_base + 32; int* s_rank = s_e + 256; int* s_tok = s_rank + 256; float* s_gate = (float*)(s_tok + 256);
    __syncthreads();
    {
        const bf16_t* wrh = (const bf16_t*)(ws + WS_WRH) + (size_t)l * 48 * 1024;
        u32x4 wv[12];
#pragma unroll
        for (int j = 0; j < 12; ++j) { const int i = tid + 512 * j, r = i >> 7, c = i & 127; wv[j] = *(const u32x4*)(wrh + (size_t)r * 1024 + c * 8); }
#pragma unroll
        for (int j = 0; j < 12; ++j) { const int i = tid + 512 * j, r = i >> 7, c = i & 127; *(u32x4*)(wl + r * WPITCH + c * 16) = wv[j]; }
    }
    const int NG = ((l == DEPTH - 1) ? NLAT : NTOK) / 16;
    const int NWV = (int)gridDim.x * 8;
    for (int it = 0; it * NWV < NG; ++it) {
        const int g = it * NWV + wid * (int)gridDim.x + obid();
        __syncthreads();
        if (tid < 32) s_cnt[tid] = 0;
        if (tid < 256) s_e[tid] = -1;
        __syncthreads();
        if (g < NG) {
            const int R0 = g * 16, mr = mod_row(R0);
            float my_rstd = 0.f;
#pragma unroll
            for (int rb = 0; rb < 4; ++rb) {
                f32x4 xv[4][4]; u32x2 dl[4][4], xr[4][4];
#pragma unroll
                for (int rr = 0; rr < 4; ++rr)
#pragma unroll
                    for (int j = 0; j < 4; ++j) { xr[rr][j] = *(const u32x2*)(xws + (size_t)(R0 + rb * 4 + rr) * 1024 + 4 * lane + 256 * j); dl[rr][j] = *(const u32x2*)(dlt + (size_t)(R0 + rb * 4 + rr) * 1024 + 4 * lane + 256 * j); }
#pragma unroll
                for (int rr = 0; rr < 4; ++rr) {
#pragma unroll
                    for (int j = 0; j < 4; ++j) xv[rr][j] = unpk4_bf16(xr[rr][j]);
                    if (commit) {
#pragma unroll
                        for (int j = 0; j < 4; ++j) { xv[rr][j] += unpk4_bf16(dl[rr][j]); u32x2 o; o.x = cvtpk(xv[rr][j][0], xv[rr][j][1]); o.y = cvtpk(xv[rr][j][2], xv[rr][j][3]); *(u32x2*)(xw + (size_t)(R0 + rb * 4 + rr) * 1024 + 4 * lane + 256 * j) = o;
                            xv[rr][j] = unpk4_bf16(o); }
                    }
                    float ss = 0.f;
#pragma unroll
                    for (int j = 0; j < 4; ++j) ss += (xv[rr][j][0] * xv[rr][j][0] + xv[rr][j][1] * xv[rr][j][1]) + (xv[rr][j][2] * xv[rr][j][2] + xv[rr][j][3] * xv[rr][j][3]);
                    const float rs = rsqrtf(wave_sum(ss) * (1.0f / 1024.0f) + EPS);
                    my_rstd = (rb * 4 + rr == fr) ? rs : my_rstd;
                }
            }
            asm volatile("s_waitcnt vmcnt(0)" ::: "memory");
            const float* msh = modv + ((size_t)l * 9 + mr) * 6144 + 3 * 1024 + 8 * fq; const float* msc = msh + 1024; const float* nwp = nw + 8 * fq;
            const bf16_t* xrow = xws + (size_t)(R0 + fr) * 1024 + 8 * fq; bf16_t* hrow = hb + (size_t)(R0 + fr) * 1024 + 8 * fq; unsigned char* h8row = ws + WS_H8 + (size_t)(R0 + fr) * 1024 + 8 * fq;
            f32x4 acc[3];
#pragma unroll
            for (int nt = 0; nt < 3; ++nt) acc[nt] = (f32x4){0.f, 0.f, 0.f, 0.f};
#pragma unroll 1
            for (int kq = 0; kq < 8; ++kq) {
                u32x4 xab[4]; f32x4 pw[4][2], psh[4][2], psc[4][2];
#pragma unroll
                for (int u = 0; u < 4; ++u) { const int k = 128 * kq + 32 * u; xab[u] = *(const u32x4*)(xrow + k);
#pragma unroll
                    for (int q = 0; q < 2; ++q) { pw[u][q] = *(const f32x4*)(nwp + k + 4 * q); psh[u][q] = *(const f32x4*)(msh + k + 4 * q); psc[u][q] = *(const f32x4*)(msc + k + 4 * q); } }
#pragma unroll
                for (int u = 0; u < 4; ++u) {
                    const int k = 128 * kq + 32 * u;
                    float hv[8];
                    const f32x4 xaq[2] = {unpk4_bf16((u32x2){xab[u].x, xab[u].y}), unpk4_bf16((u32x2){xab[u].z, xab[u].w})};
#pragma unroll
                    for (int q = 0; q < 2; ++q) {
                        const f32x4 w = pw[u][q], sh = psh[u][q], sc = psc[u][q];
                        const f32x4 h = (xaq[q] * my_rstd * w) * (1.0f + sc) + sh;
                        hv[4 * q + 0] = h[0]; hv[4 * q + 1] = h[1]; hv[4 * q + 2] = h[2]; hv[4 * q + 3] = h[3];
                    }
                    union { u32x4 u; bf16x8 h; } ah, al;
                    ah.u = (u32x4){cvtpk(hv[0], hv[1]), cvtpk(hv[2], hv[3]), cvtpk(hv[4], hv[5]), cvtpk(hv[6], hv[7])};
                    float lv[8];
#pragma unroll
                    for (int q = 0; q < 4; ++q) { const unsigned w2 = q == 0 ? ah.u.x : q == 1 ? ah.u.y : q == 2 ? ah.u.z : ah.u.w; lv[2 * q] = hv[2 * q] - __uint_as_float(w2 << 16); lv[2 * q + 1] = hv[2 * q + 1] - __uint_as_float(w2 & 0xffff0000u); }
                    al.u = (u32x4){cvtpk(lv[0], lv[1]), cvtpk(lv[2], lv[3]), cvtpk(lv[4], lv[5]), cvtpk(lv[6], lv[7])};
                    if (MOE_FP8) { u32x2 h8; h8.x = pk4_fp8(hv[0], hv[1], hv[2], hv[3]); h8.y = pk4_fp8(hv[4], hv[5], hv[6], hv[7]); *(u32x2*)(h8row + k) = h8; }
                    else *(u32x4*)(hrow + k) = ah.u;
#pragma unroll
                    for (int nt = 0; nt < 3; ++nt) {
                        const bf16x8 bh = *(const bf16x8*)(wl + (nt * 16 + fr) * WPITCH + (k + 8 * fq) * 2);
                        acc[nt] = __builtin_amdgcn_mfma_f32_16x16x32_bf16(ah.h, bh, acc[nt], 0, 0, 0);
                        acc[nt] = __builtin_amdgcn_mfma_f32_16x16x32_bf16(al.h, bh, acc[nt], 0, 0, 0);
                    }
                }
            }
#pragma unroll
            for (int nt = 0; nt < 3; ++nt)
#pragma unroll
                for (int r = 0; r < 4; ++r) tile[(4 * fq + r) * 52 + nt * 16 + fr] = acc[nt][r];
            LDS_WAIT();
            if (lane < 16) {
                const float* lg = tile + lane * 52;
                float gl[4];
#pragma unroll
                for (int i = 0; i < 4; ++i) gl[i] = lg[i] + brg[i];
                int gsel = 0; float gmax = gl[0];
#pragma unroll
                for (int i = 1; i < 4; ++i) if (gl[i] > gmax) { gmax = gl[i]; gsel = i; }
                float gs = 0.f;
#pragma unroll
                for (int i = 0; i < 4; ++i) gs += __expf(gl[i] - gmax);
                const float pg = 1.0f / gs;
                float el[8];
#pragma unroll
                for (int j = 0; j < 8; ++j) el[j] = lg[4 + gsel * 8 + j] + bre[gsel * 8 + j];
                int i1 = 0; float v1 = el[0];
#pragma unroll
                for (int j = 1; j < 8; ++j) if (el[j] > v1) { v1 = el[j]; i1 = j; }
                int i2 = -1; float v2 = -3.0e38f;
#pragma unroll
                for (int j = 0; j < 8; ++j) if (j != i1 && el[j] > v2) { v2 = el[j]; i2 = j; }
                const float e2 = __expf(v2 - v1);
                const float g0 = pg / (1.0f + e2), g1 = pg * e2 / (1.0f + e2);
                const int ea = gsel * 8 + i1, eb = gsel * 8 + i2, slot = (wid * 16 + lane) * 2, r = R0 + lane;
                s_e[slot] = ea; s_rank[slot] = atomicAdd(&s_cnt[ea], 1); s_tok[slot] = r * 2; s_gate[slot] = g0;
                s_e[slot + 1] = eb; s_rank[slot + 1] = atomicAdd(&s_cnt[eb], 1); s_tok[slot + 1] = r * 2 + 1; s_gate[slot + 1] = g1;
            }
        }
        __syncthreads();
        if (tid < 32) { const int c = s_cnt[tid]; s_base[tid] = (c > 0 && commit) ? (int)atomicAdd(gcnt + 64 * tid, (unsigned)c) : 0; }
        __syncthreads();
        if (tid < 256) { const int e = s_e[tid]; if (e >= 0 && commit) { const size_t pos = (size_t)e * NTOK + s_base[e] + s_rank[tid]; ltok[pos] = s_tok[tid]; lgate[pos] = s_gate[tid]; } }
    }
}

__device__ __forceinline__ int moe_tables(const Params& p, int l, unsigned char* lds) {
    int* s_pref = (int*)(lds + LDS_MISC); int* s_cnt = s_pref + 40;
    unsigned* cnt = (unsigned*)(ows(p) + WS_CTL) + CW_CNT + 64 * l;
    __syncthreads();
    if (otid() == 0) {
        int acc = 0;
        for (int e = 0; e < NEXP; ++e) { const int c = (int)__hip_atomic_load(cnt + e, __ATOMIC_RELAXED, __HIP_MEMORY_SCOPE_AGENT); s_cnt[e] = c; s_pref[e] = acc; acc += (c + 127) >> 7; }
        s_pref[NEXP] = acc;
    }
    __syncthreads();
    return s_pref[NEXP];
}
__device__ __forceinline__ void phase_moe_gu(const Params& p, int l, unsigned char* lds) {
    const int T = moe_tables(p, l, lds);
    const int* s_pref = (const int*)(lds + LDS_MISC); const int* s_cnt = s_pref + 40;
    const bf16_t* hb = (const bf16_t*)(ows(p) + WS_H); bf16_t* hid = (bf16_t*)(ows(p) + WS_HID);
    const int* ltok = (const int*)(ows(p) + WS_LTOK);
    for (int u = obid(); u < T * 8; u += gridDim.x) {
        const int mtg = u >> 3, nt = u & 7;
        int e = 0;
        for (int q = 1; q < NEXP; ++q) if (s_pref[q] <= mtg) e = q;
        const int mt = mtg - s_pref[e]; const int nvalid = min(128, s_cnt[e] - mt * 128);
        ARowGather ar{hb, ltok + (size_t)e * NTOK + mt * 128, nvalid};
        EpiGU ep{hid + (size_t)mtg * 128 * 512 + nt * 64};
        gemm128(lds, ar, (const bf16_t*)(ows(p) + WS_WGU) + ((size_t)(l * 32 + e) * 1024 + nt * 128) * 1024, 1024, ep);
    }
}
__device__ __forceinline__ void phase_moe_down(const Params& p, int l, unsigned char* lds) {
    const int T = moe_tables(p, l, lds);
    const int* s_pref = (const int*)(lds + LDS_MISC); const int* s_cnt = s_pref + 40;
    const bf16_t* hid = (const bf16_t*)(ows(p) + WS_HID); bf16_t* yb = (bf16_t*)(ows(p) + WS_YB);
    const int* ltok = (const int*)(ows(p) + WS_LTOK); const float* lgate = (const float*)(ows(p) + WS_LGATE);
    for (int u = obid(); u < T * 8; u += gridDim.x) {
        const int mtg = u >> 3, nt = u & 7;
        int e = 0;
        for (int q = 1; q < NEXP; ++q) if (s_pref[q] <= mtg) e = q;
        const int mt = mtg - s_pref[e]; const int nvalid = min(128, s_cnt[e] - mt * 128);
        ARowPlain ar{hid + (size_t)mtg * 128 * 512, 512};
        EpiDown ep{yb + nt * 128, ltok + (size_t)e * NTOK + mt * 128, lgate + (size_t)e * NTOK + mt * 128, nvalid};
        gemm128(lds, ar, (const bf16_t*)(ows(p) + WS_WDN) + ((size_t)(l * 32 + e) * 1024 + nt * 128) * 512, 512, ep);
    }
}


#ifndef FAST_G1
#define FAST_G1 1
#endif
#ifndef FAST_G2
#define FAST_G2 1
#endif
#ifndef FAST_MOE
#define FAST_MOE 1
#endif
#ifndef FAST_GLA
#define FAST_GLA 1
#endif
#ifndef FAST_RT
#define FAST_RT 1
#endif
__device__ __forceinline__ void phase_gemm1_fast(const Params& p, int l, unsigned char* lds) {
    g8::DenseOrder S; S.init(NTOK / 256, PW / 256, (int)gridDim.x, obid(), (const bf16_t*)(ows(p) + WS_WIN) + (size_t)l * 4096 * 1024, 1024);
    g8::EpiP2 E{(bf16_t*)(ows(p) + WS_P)};
    g8::gemm_phase((LAS unsigned char*)lds, (const char*)(ows(p) + WS_H), 1024, S, E);
    if (gridDim.x == 256 && obid() >= 128) { __syncthreads(); convert_range(p, (float*)(lds + (otid() >> 6) * 16384), (obid() - 128) * 8 + (otid() >> 6), 128 * 8, l * CV_LAYER, l * CV_LAYER + CV_B); }
}
__device__ __forceinline__ void phase_gemm2_fast(const Params& p, int l, unsigned char* lds, float scl) {
    g8::DenseOrder S; g8::EpiDelta E{(bf16_t*)(ows(p) + WS_DELTA), (const float*)(ows(p) + WS_MOD) + (size_t)l * 9 * 6144 + 2 * 1024, scl};
    if (G2_FP8) {
        S.init(((l == DEPTH - 1) ? NLAT : NTOK) / 256, 4, (int)gridDim.x, obid(), ows(p) + WS_WOUT + (size_t)l * 1024 * 1024, 1024, 1);
        g8::gemm_phase8<0x7A7A7A7A, 0x7C7C7C7C>((LAS unsigned char*)lds, (const char*)(ows(p) + WS_Y), 1024, S, E);
    } else {
        S.init(((l == DEPTH - 1) ? NLAT : NTOK) / 256, 4, (int)gridDim.x, obid(), (const bf16_t*)(ows(p) + WS_WOUT) + (size_t)l * 1024 * 1024, 1024);
        g8::gemm_phase((LAS unsigned char*)lds, (const char*)(ows(p) + WS_Y), 1024, S, E);
    }
    if (gridDim.x == 256 && l < DEPTH - 1 && obid() >= 32 && scl != 0.0f) { __syncthreads(); convert_range(p, (float*)(lds + (otid() >> 6) * 16384), (obid() - 32) * 8 + (otid() >> 6), 224 * 8, l * CV_LAYER + CV_B + CV_S, (l + 1) * CV_LAYER); }
}
__device__ __forceinline__ int moe_tables256(const Params& p, int l, unsigned char* lds) {
    int* s_pref = (int*)(lds + LDS_MISC); int* s_cnt = s_pref + 40;
    unsigned* cnt = (unsigned*)(ows(p) + WS_CTL) + CW_CNT + 64 * 32 * l;
    __syncthreads();
    if (otid() < 64) {
        const int lane = otid();
        const int c = (lane < NEXP) ? (int)__hip_atomic_load(cnt + 64 * lane, __ATOMIC_RELAXED, __HIP_MEMORY_SCOPE_AGENT) : 0;
        const int t = (c + 255) >> 8; int incl = t;
#pragma unroll
        for (int d = 1; d < 32; d <<= 1) { const int o = __shfl_up(incl, d); if (lane >= d) incl += o; }
        if (lane < NEXP) { s_cnt[lane] = c; s_pref[lane] = incl - t; }
        if (lane == NEXP - 1) s_pref[NEXP] = incl;
    }
    __syncthreads();
    return s_pref[NEXP];
}
__device__ __forceinline__ void moe_setup(const Params& p, int l, unsigned char* lds) {
    const int T = moe_tables256(p, l, lds);
    const int* s_pref = (const int*)(lds + LDS_MISC); const int* s_cnt = s_pref + 40;
    int* utab = (int*)(lds + g8::MOE_UTAB); int* rtok = (int*)(lds + g8::MOE_RTOK); float* rgate = (float*)(lds + g8::MOE_RGATE);
    const int tid = otid(), G = (int)gridDim.x, c = obid();
    if (tid < 4 * NEXP) {
        const int i = tid >> 5, e = tid & 31; const int L = i * G + c; int* t = utab + i * 8;
        if (L < T * 4) {
            const int mtg = L >> 2;
            if (s_pref[e] <= mtg && mtg < s_pref[e + 1]) {
                const int mt = mtg - s_pref[e];
                t[0] = mtg; t[1] = L & 3; t[2] = e; t[3] = min(256, s_cnt[e] - mt * 256); t[4] = e * NTOK + mt * 256; t[5] = 1;
            }
        } else if (e == 0) { int z = 0; asm volatile("" : "+v"(z)); t[0] = z; t[1] = z; t[2] = z; t[3] = z; t[4] = z; t[5] = z; }
    }
    __syncthreads();
    const int* ltok = (const int*)(ows(p) + WS_LTOK); const float* lgate = (const float*)(ows(p) + WS_LGATE);
    {   int tk[2]; float gt[2];
#pragma unroll
        for (int j = 0; j < 2; ++j) { const int idx = tid + 512 * j, i = idx >> 8, r = idx & 255; const int* t = utab + i * 8; const bool ok = t[5] != 0 && r < t[3]; const int src = ok ? t[4] + r : 0;
            tk[j] = ltok[src]; gt[j] = lgate[src]; if (!ok) { tk[j] = 0; gt[j] = 0.f; } }
#pragma unroll
        for (int j = 0; j < 2; ++j) { rtok[tid + 512 * j] = tk[j]; rgate[tid + 512 * j] = gt[j]; }
    }
    __syncthreads();
}
__device__ __forceinline__ void phase_moe_gu_fast(const Params& p, int l, unsigned char* lds) {
    moe_setup(p, l, lds);
    g8::MoeOrder<true> S; S.utab = (const int*)(lds + g8::MOE_UTAB); S.rtok = (const int*)(lds + g8::MOE_RTOK); S.K = 1024;
    if (MOE_FP8) {
        S.W = (const char*)(ows(p) + WS_WGU8) + (size_t)l * 32 * 1024 * 1024; S.bpe = 1;
        g8::EpiGU8 E{ows(p) + WS_HID8};
        g8::gemm_phase8<0x7A7A7A7A, 0x7F7F7F7F>((LAS unsigned char*)lds, (const char*)(ows(p) + WS_H8), 1024, S, E);
    } else {
        S.W = (const char*)(ows(p) + WS_WGU) + (size_t)l * 32 * 1024 * 1024 * 2; S.bpe = 2;
        g8::EpiGU2 E{(bf16_t*)(ows(p) + WS_HID)};
        g8::gemm_phase((LAS unsigned char*)lds, (const char*)(ows(p) + WS_H), 1024, S, E);
    }
}
__device__ __forceinline__ void phase_moe_down_fast(const Params& p, int l, unsigned char* lds) {
    if (!(FAST_MOE && MOE_FP8) || DUPK == 10 || p.ph_hi - p.ph_lo == 1) moe_setup(p, l, lds);
    g8::MoeOrder<false> S; S.utab = (const int*)(lds + g8::MOE_UTAB); S.rtok = (const int*)(lds + g8::MOE_RTOK); S.K = 512;
    g8::EpiDown2 E{(bf16_t*)(ows(p) + WS_YB), (const int*)(lds + g8::MOE_RTOK), (const float*)(lds + g8::MOE_RGATE)};
    if (MOE_FP8) {
        S.W = (const char*)(ows(p) + WS_WDN8) + (size_t)l * 32 * 1024 * 512; S.bpe = 1;
        g8::EpiDown8 E8{ows(p) + WS_YB8, (const int*)(lds + g8::MOE_RTOK), (const float*)(lds + g8::MOE_RGATE)};
        g8::gemm_phase8<0x7B7B7B7B, 0x7E7E7E7E>((LAS unsigned char*)lds, (const char*)(ows(p) + WS_HID8), 512, S, E8);
    } else {
        S.W = (const char*)(ows(p) + WS_WDN) + (size_t)l * 32 * 1024 * 512 * 2; S.bpe = 2;
        g8::gemm_phase((LAS unsigned char*)lds, (const char*)(ows(p) + WS_HID), 512, S, E);
    }
}

__device__ __forceinline__ void phase_c(const Params& p, int l, unsigned char* lds) {
    phase_gla_pre2(p, l, lds);
}

__global__ void __launch_bounds__(512, 2) mk(Params p) {
    extern __shared__ __attribute__((aligned(16))) unsigned char lds[];
    const int lo = p.ph_lo, hi = p.ph_hi;
    volatile LAS unsigned* misc = (volatile LAS unsigned*)(lds + LDS_MISC + 1024);
    if (threadIdx.x < 4) misc[threadIdx.x] = 0u;
    __syncthreads();
    XcdBarrier bar; bar.bar = (unsigned*)(p.ws + WS_CTL) + CW_BAR; bar.x = 0; bar.st = misc;
    if (hi - lo > 1) bar = xcd_barrier_post((unsigned*)(p.ws + WS_CTL) + CW_BAR, misc);
#define IN(k) (lo <= (k) && (k) < hi)
#define SEAM(k) do { if (IN((k) + 1)) { xcd_barrier(bar); if (DUPK == 20) xcd_barrier(bar); } } while (0)
#define REP(kind) for (int _rep = 0; _rep < ((DUPK == (kind)) ? 2 : 1); ++_rep)
    if (IN(0)) { REP(0) phase_prologue(p, lds); SEAM(0); }
    if (IN(1)) { REP(1) phase_modreduce(p); SEAM(1); }
    for (int l = 0; l < DEPTH; ++l) {
        const int pb = 2 + 9 * l;
        if (IN(pb + 0)) { if (DUPK == 2) phase_norm1(p, l, (float)(lo > 1000)); phase_norm1(p, l, 1.0f); SEAM(pb + 0); }
        if (IN(pb + 1)) { REP(3) { if (FAST_G1) phase_gemm1_fast(p, l, lds); else phase_gemm1(p, l, lds); } SEAM(pb + 1); }
        if (IN(pb + 2)) { REP(4) { phase_c(p, l, lds); } SEAM(pb + 2); }
        if (IN(pb + 3)) { REP(5) { phase_gla_seq2(p, l, lds); } SEAM(pb + 3); }
        if (IN(pb + 4)) { REP(6) phase_gla_post(p, l); SEAM(pb + 4); }
        if (IN(pb + 5)) { if (DUPK == 7) phase_gemm2_fast(p, l, lds, (float)(lo > 1000)); phase_gemm2_fast(p, l, lds, 1.0f); SEAM(pb + 5); }
        if (IN(pb + 6)) { if (DUPK == 8) phase_router2(p, l, lds, lo > 1000); phase_router2(p, l, lds, true); SEAM(pb + 6); }
        if (IN(pb + 7)) { REP(9) { if (FAST_MOE) phase_moe_gu_fast(p, l, lds); else phase_moe_gu(p, l, lds); } SEAM(pb + 7); }
        if (IN(pb + 8)) { REP(10) { if (FAST_MOE) phase_moe_down_fast(p, l, lds); else phase_moe_down(p, l, lds); } SEAM(pb + 8); }
    }
    if (IN(NPH - 1)) { REP(11) phase_final(p); }
#undef IN
#undef SEAM
}

#ifndef MK_LAUNCHES
#define MK_LAUNCHES 1
#endif
extern "C" void kernel_launch(void* const* d_in, const int* in_sizes, int n_in, void* d_out, int out_size, void* d_ws, size_t ws_size, hipStream_t stream) {
    static int grid = 0;
    if (grid == 0) {
        int dev = 0, cus = 0;
        if (n_in != 20 || ws_size < WS_END) { fprintf(stderr, "kernel_launch: unexpected shapes (n_in %d, ws %zu < %zu)\n", n_in, ws_size, (size_t)WS_END); grid = -1; return; }
        if (hipGetDevice(&dev) != hipSuccess || hipDeviceGetAttribute(&cus, hipDeviceAttributeMultiprocessorCount, dev) != hipSuccess) { grid = -1; return; }
        if (hipFuncSetAttribute((const void*)mk, hipFuncAttributeMaxDynamicSharedMemorySize, LDS_BYTES) != hipSuccess) { fprintf(stderr, "kernel_launch: hipFuncSetAttribute failed\n"); grid = -1; return; }
        (void)hipGetLastError();
        grid = cus;
    }
    if (grid < 0) return;
    (void)hipMemsetAsync((char*)d_ws + WS_CTL, 0, CTL_BYTES, stream);
    Params p{};
    for (int i = 0; i < 20; ++i) p.in[i] = (const float*)d_in[i];
    p.out = (float*)d_out; p.ws = (unsigned char*)d_ws;
    if (MK_LAUNCHES == 1) { p.ph_lo = 0; p.ph_hi = NPH; hipLaunchKernelGGL(mk, dim3(grid), dim3(512), LDS_BYTES, stream, p); }
    else for (int ph = 0; ph < NPH; ++ph) { p.ph_lo = ph; p.ph_hi = ph + 1; hipLaunchKernelGGL(mk, dim3(grid), dim3(512), LDS_BYTES, stream, p); }
}
```

```cpp
#include <hip/hip_runtime.h>
#include <stdint.h>
#include <stdio.h>

typedef unsigned short bf16_t;
typedef short bf16x8 __attribute__((ext_vector_type(8)));
typedef float f32x4 __attribute__((ext_vector_type(4)));
typedef unsigned u32x4 __attribute__((ext_vector_type(4)));
typedef unsigned u32x2 __attribute__((ext_vector_type(2)));
typedef int i32x8 __attribute__((ext_vector_type(8)));
typedef int i32x4 __attribute__((ext_vector_type(4)));
typedef short s16x4 __attribute__((ext_vector_type(4)));
typedef float f32x2 __attribute__((ext_vector_type(2)));
#define LAS __attribute__((address_space(3)))
#define GAS __attribute__((address_space(1)))

#ifndef G2_FP8
#define G2_FP8 1
#endif
#ifndef DUPK
#define DUPK -1
#endif
#ifndef MOE_FP8
#define MOE_FP8 1
#endif
constexpr int D = 1024, NB = 8, SEQ = 2048, DEPTH = 4, CTXL = 256;
constexpr int NLAT = NB * SEQ, NCTX = NB * CTXL, NTOK = NLAT + NCTX;
constexpr int PW = 4096;
constexpr int OFF_B = 0, OFF_C = 512, OFF_HV = 1024, OFF_Q = 1536, OFF_ZF = 2048, OFF_I = 3072, OFF_G = 3584;
constexpr int NEXP = 32;
constexpr int NCHUNK = NTOK / 16;
constexpr float EPS = 1e-6f;
constexpr int NMODP = 16;
constexpr int CV_ALL = 32 * (16 * 32 + 8 * 32), CV_B = 128 * 8 * 7, CV_F = 224 * 8 * 6;
constexpr int CV_S = (4 * CV_ALL - 4 * CV_B - 3 * CV_F) / 4, CV_LAYER = CV_B + CV_S + CV_F;
static_assert(4 * CV_B + 4 * CV_S + 3 * CV_F == 4 * CV_ALL, "conversion schedule");
static_assert(CV_LAYER >= CV_ALL && 3 * CV_LAYER + CV_B + CV_S == 4 * CV_ALL, "conversion schedule");

constexpr size_t WS_CTL = 0, CTL_BYTES = 65536;
constexpr size_t WS_WIN = WS_CTL + CTL_BYTES;
constexpr size_t WS_WOUT = WS_WIN + (size_t)4 * 4096 * 1024 * 2;
constexpr size_t WS_WGU = WS_WOUT + (size_t)4 * 1024 * 1024 * 2;
constexpr size_t WS_WDN = WS_WGU + (size_t)4 * 32 * 1024 * 1024 * 2;
constexpr size_t WS_MODP = WS_WDN + (size_t)4 * 32 * 1024 * 512 * 2;
constexpr size_t WS_MOD = WS_MODP + (size_t)4 * NMODP * 9 * 6144 * 4;
constexpr size_t WS_X = WS_MOD + (size_t)4 * 9 * 6144 * 4;
constexpr size_t WS_H = WS_X + (size_t)NTOK * 1024 * 4;
constexpr size_t WS_P = WS_H + (size_t)NTOK * 1024 * 2;
constexpr size_t WS_Y = WS_P + (size_t)NTOK * 4096 * 2;
constexpr size_t WS_QIN = WS_Y + (size_t)NTOK * 1024 * 2;
constexpr size_t WS_KOUT = WS_QIN + (size_t)2 * NTOK * 512 * 2;
constexpr size_t WS_DCH = WS_KOUT + (size_t)2 * NTOK * 512 * 2;
constexpr size_t WS_OINTRA = WS_DCH + (size_t)2 * NCHUNK * 512 * 4;
constexpr size_t WS_OINTER = WS_OINTRA + (size_t)NTOK * 512 * 4;
constexpr size_t WS_LTOK = WS_OINTER + (size_t)2 * NTOK * 512 * 4;
constexpr size_t WS_LGATE = WS_LTOK + (size_t)32 * NTOK * 4;
constexpr int HID_ROWS = 2 * NTOK + 32 * 256;
constexpr size_t WS_HID = WS_LGATE + (size_t)32 * NTOK * 4;
constexpr size_t WS_YB = WS_HID + (size_t)HID_ROWS * 512 * 2;
constexpr int REC_BYTES = 9216, VREC_BYTES = 4096;
constexpr size_t WS_GREC = WS_YB + (size_t)2 * NTOK * 1024 * 2;
constexpr size_t WS_VREC = WS_GREC + (size_t)2 * NCHUNK * 4 * REC_BYTES;
constexpr size_t WS_WRH = WS_VREC + (size_t)NCHUNK * 4 * VREC_BYTES;
constexpr size_t WS_WRL = WS_WRH + (size_t)4 * 48 * 1024 * 2;
constexpr size_t WS_H8 = WS_WRL + (size_t)4 * 48 * 1024 * 2;
constexpr size_t WS_HID8 = WS_H8 + (size_t)NTOK * 1024;
constexpr size_t WS_WGU8 = WS_HID8 + (size_t)HID_ROWS * 512;
constexpr size_t WS_WDN8 = WS_WGU8 + (size_t)4 * 32 * 1024 * 1024;
constexpr size_t WS_YB8 = WS_WDN8 + (size_t)4 * 32 * 1024 * 512;
constexpr size_t WS_DELTA = WS_YB8 + (size_t)2 * NTOK * 1024;
constexpr size_t WS_END = WS_DELTA + (size_t)NTOK * 1024 * 2;
constexpr int CW_BAR = 0;
constexpr int CW_CNT = 8192;

constexpr int LDS_BYTES = 147456;
constexpr int LDS_MISC = 143360;
constexpr int NPH = 2 + 9 * DEPTH + 1;

__device__ __forceinline__ float bf2f(bf16_t b) { return __uint_as_float(((unsigned)b) << 16); }
__device__ __forceinline__ unsigned f2bf(float f) { unsigned u = __float_as_uint(f); return (u + 0x7fffu + ((u >> 16) & 1u)) >> 16; }
__device__ __forceinline__ unsigned pk2(float lo, float hi) { return f2bf(lo) | (f2bf(hi) << 16); }
__device__ __forceinline__ float wave_sum(float v) {
#pragma unroll
    for (int o = 1; o < 64; o <<= 1) v += __shfl_xor(v, o);
    return v;
}
__device__ __forceinline__ float frcp(float x) { return __builtin_amdgcn_rcpf(x); }
__device__ __forceinline__ float sigmoidf(float x) { return frcp(1.0f + __expf(-x)); }
__device__ __forceinline__ float siluf(float x) { return x * frcp(1.0f + __expf(-x)); }
__device__ __forceinline__ float clamp8(float v) { return __builtin_amdgcn_fmed3f(v, -416.0f, 416.0f); }
__device__ __forceinline__ unsigned pk4_fp8_raw(float a, float b, float c, float d) { int r = __builtin_amdgcn_cvt_pk_fp8_f32(a, b, 0, false); r = __builtin_amdgcn_cvt_pk_fp8_f32(c, d, r, true); return (unsigned)r; }
__device__ __forceinline__ unsigned pk4_fp8(float a, float b, float c, float d) { int r = __builtin_amdgcn_cvt_pk_fp8_f32(clamp8(a), clamp8(b), 0, false); r = __builtin_amdgcn_cvt_pk_fp8_f32(clamp8(c), clamp8(d), r, true); return (unsigned)r; }
__device__ __forceinline__ f32x4 unpk4_fp8(unsigned w) { const f32x2 lo = __builtin_amdgcn_cvt_pk_f32_fp8((int)w, false), hi = __builtin_amdgcn_cvt_pk_f32_fp8((int)w, true); return (f32x4){lo.x, lo.y, hi.x, hi.y}; }
typedef __bf16 bf16x2_t __attribute__((ext_vector_type(2)));
__device__ __forceinline__ f32x4 unpk4_bf16(u32x2 w) { return (f32x4){__uint_as_float(w.x << 16), __uint_as_float(w.x & 0xffff0000u), __uint_as_float(w.y << 16), __uint_as_float(w.y & 0xffff0000u)}; }
__device__ __forceinline__ unsigned cvtpk(float lo, float hi) { const f32x2 v = {lo, hi}; const bf16x2_t r = __builtin_convertvector(v, bf16x2_t); return __builtin_bit_cast(unsigned, r); }
__device__ __forceinline__ int mod_row(int r) { return r < NLAT ? (r >> 11) : 8; }
#define LDS_WAIT() asm volatile("s_waitcnt lgkmcnt(0)" ::: "memory")
__device__ __forceinline__ int otid() { int t = threadIdx.x; asm volatile("" : "+v"(t)); return t; }
__device__ __forceinline__ int obid() { int b = blockIdx.x; asm volatile("" : "+s"(b)); return b; }

#define XB_TMO      128
#define XB_XCNT(j)  (256  + 64 * (j))
#define XB_XSUB(j)  (1280 + 64 * (j))
#define XB_XGEN(j)  (2304 + 64 * (j))
#define XB_TOP      3328
#define XB_TOPGEN   3392
#define XCD_BAR_WORDS 3456
#define XB_SPIN_CAP (1u << 18)
__device__ __forceinline__ unsigned xb_ld(unsigned* p)              { return __hip_atomic_load(p, __ATOMIC_RELAXED, __HIP_MEMORY_SCOPE_AGENT); }
__device__ __forceinline__ unsigned xb_add(unsigned* p, unsigned v) { return __hip_atomic_fetch_add(p, v, __ATOMIC_RELAXED, __HIP_MEMORY_SCOPE_AGENT); }
__device__ __forceinline__ unsigned xb_xcc_id() { return (unsigned)__builtin_amdgcn_s_getreg((3 << 11) | 20) & 0xFu; }
#define XB_SPIN(cond, bar) do { unsigned _sp = 0; while (cond) { __builtin_amdgcn_s_sleep(1); \
    if ((++_sp & 255u) == 0u) { if (xb_ld(&(bar)[XB_TMO])) break; if (_sp > XB_SPIN_CAP) { atomicAdd(&(bar)[XB_TMO], 1u); break; } } } } while (0)
struct XcdBarrier { unsigned* bar; unsigned x; volatile LAS unsigned* st; };
__device__ __forceinline__ XcdBarrier xcd_barrier_post(unsigned* bar, volatile LAS unsigned* st) {
    XcdBarrier b; b.bar = bar; b.x = xb_xcc_id(); b.st = st;
    if (threadIdx.x == 0) (void)xb_add(&bar[XB_XCNT(b.x)], 1u);
    return b;
}
__device__ __forceinline__ void xcd_barrier_complete(unsigned* bar, unsigned x, unsigned& nloc, unsigned& nx) {
    const unsigned G = gridDim.x * gridDim.y * gridDim.z;
    unsigned sum, cnt, mine, sp = 0u;
    for (;;) {
        sum = 0u; cnt = 0u; mine = 0u;
#pragma unroll
        for (unsigned j = 0; j < 16; ++j) { const unsigned c = xb_ld(&bar[XB_XCNT(j)]); sum += c; cnt += (c > 0u) ? 1u : 0u; mine = (j == x) ? c : mine; }
        if (sum == G) break;
        __builtin_amdgcn_s_sleep(1);
        if ((++sp & 255u) == 0u) { if (xb_ld(&bar[XB_TMO])) break; if (sp > XB_SPIN_CAP) { atomicAdd(&bar[XB_TMO], 1u); break; } }
    }
    nloc = mine > 0u ? mine : 1u; nx = cnt > 0u ? cnt : 1u;
}
__device__ __forceinline__ void xcd_barrier(const XcdBarrier& b) {
    asm volatile("s_waitcnt vmcnt(0)" ::: "memory");
    __syncthreads();
    if (threadIdx.x == 0) {
        unsigned* bar = b.bar;
        __builtin_amdgcn_s_waitcnt(0);
        unsigned nloc = b.st[0], nx = b.st[1];
        if (nloc == 0u) { xcd_barrier_complete(bar, b.x, nloc, nx); b.st[0] = nloc; b.st[1] = nx; }
        const unsigned old = xb_add(&bar[XB_XSUB(b.x)], 1u);
        const unsigned gen = old / nloc;
        if (old + 1u == (gen + 1u) * nloc) {
            __builtin_amdgcn_fence(__ATOMIC_RELEASE, "agent");
            asm volatile("s_waitcnt vmcnt(0)" ::: "memory");
            const unsigned og = xb_add(&bar[XB_TOP], 1u);
            const unsigned tg = og / nx;
            if (og + 1u == (tg + 1u) * nx) xb_add(&bar[XB_TOPGEN], 1u);
            else XB_SPIN(xb_ld(&bar[XB_TOPGEN]) == tg, bar);
            __builtin_amdgcn_fence(__ATOMIC_ACQUIRE, "agent");
            xb_add(&bar[XB_XGEN(b.x)], 1u);
            asm volatile("s_waitcnt vmcnt(0)" ::: "memory");
        } else {
            XB_SPIN(xb_ld(&bar[XB_XGEN(b.x)]) == gen, bar);
            __builtin_amdgcn_fence(__ATOMIC_ACQUIRE, "agent");
            asm volatile("s_waitcnt vmcnt(0)" ::: "memory");
        }
    }
    __syncthreads();
}

struct Params {
    const float* in[20];
    float* out;
    unsigned char* ws;
    int ph_lo, ph_hi;
};

__device__ __forceinline__ unsigned char* ows(const Params& p) { GAS unsigned char* w = (GAS unsigned char*)p.ws; asm volatile("" : "+s"(w)); return (unsigned char*)w; }
__device__ __forceinline__ const float* oin(const Params& p, int k) { const GAS float* q = (const GAS float*)p.in[k]; asm volatile("" : "+s"(q)); return (const float*)q; }

template <class ARow, class Epi>
__device__ __forceinline__ void gemm128(unsigned char* lds, const ARow& arow, const bf16_t* __restrict__ Bt, int K, const Epi& epi) {
    const int tid = otid(), lane = tid & 63, wid = tid >> 6, wr = wid >> 2, wc = wid & 3, fr = lane & 15, fq = lane >> 4;
    bf16_t* sA = (bf16_t*)lds;
    bf16_t* sB = (bf16_t*)(lds + 128 * 144);
    f32x4 acc[4][2];
#pragma unroll
    for (int m = 0; m < 4; ++m)
#pragma unroll
        for (int n = 0; n < 2; ++n) acc[m][n] = (f32x4){0.f, 0.f, 0.f, 0.f};
    const bf16_t* ap[2]; const bf16_t* bp[2]; int so[2];
#pragma unroll
    for (int i = 0; i < 2; ++i) {
        const int q = tid + 512 * i, row = q >> 3, seg = q & 7;
        ap[i] = arow(row) + seg * 8; bp[i] = Bt + (size_t)row * K + seg * 8; so[i] = row * 72 + seg * 8;
    }
    for (int k0 = 0; k0 < K; k0 += 64) {
        u32x4 va[2], vb[2];
#pragma unroll
        for (int i = 0; i < 2; ++i) { va[i] = *(const u32x4*)(ap[i] + k0); vb[i] = *(const u32x4*)(bp[i] + k0); }
        __syncthreads();
#pragma unroll
        for (int i = 0; i < 2; ++i) { *(u32x4*)(sA + so[i]) = va[i]; *(u32x4*)(sB + so[i]) = vb[i]; }
        __syncthreads();
#pragma unroll
        for (int kk = 0; kk < 2; ++kk) {
            bf16x8 a[4], b[2];
#pragma unroll
            for (int m = 0; m < 4; ++m) a[m] = *(const bf16x8*)(sA + (wr * 64 + m * 16 + fr) * 72 + kk * 32 + fq * 8);
#pragma unroll
            for (int n = 0; n < 2; ++n) b[n] = *(const bf16x8*)(sB + (wc * 32 + n * 16 + fr) * 72 + kk * 32 + fq * 8);
#pragma unroll
            for (int m = 0; m < 4; ++m)
#pragma unroll
                for (int n = 0; n < 2; ++n) acc[m][n] = __builtin_amdgcn_mfma_f32_16x16x32_bf16(b[n], a[m], acc[m][n], 0, 0, 0);
        }
    }
#pragma unroll
    for (int m = 0; m < 4; ++m)
#pragma unroll
        for (int n = 0; n < 2; ++n) epi(wr * 64 + m * 16 + fr, wc * 32 + n * 16 + fq * 4, acc[m][n]);
    __syncthreads();
}

struct ARowPlain { const bf16_t* A; int ld; __device__ __forceinline__ const bf16_t* operator()(int i) const { return A + (size_t)i * ld; } };
struct ARowGather { const bf16_t* A; const int* tok; int nvalid; __device__ __forceinline__ const bf16_t* operator()(int i) const { const int t = (i < nvalid) ? (tok[i] >> 1) : 0; return A + (size_t)t * 1024; } };

struct EpiP { bf16_t* P; __device__ __forceinline__ void operator()(int r, int c, f32x4 v) const {
    u32x2 w; w.x = pk2(v[0], v[1]); w.y = pk2(v[2], v[3]); *(u32x2*)(P + (size_t)r * PW + c) = w; } };
struct EpiRes { float* X; const float* gate; int m0; __device__ __forceinline__ void operator()(int r, int c, f32x4 v) const {
    const float* g = gate + (size_t)mod_row(m0 + r) * 6144 + c; float* xp = X + (size_t)r * 1024 + c;
    f32x4 x = *(f32x4*)xp; const f32x4 gv = *(const f32x4*)g; x += gv * v; *(f32x4*)xp = x; } };
struct EpiGU { bf16_t* H; __device__ __forceinline__ void operator()(int r, int c, f32x4 v) const {
    const float h0 = siluf(v[0]) * v[1], h1 = siluf(v[2]) * v[3]; *(unsigned*)(H + (size_t)r * 512 + (c >> 1)) = pk2(h0, h1); } };
struct EpiDown { bf16_t* YB; const int* tok; const float* gate; int nvalid; __device__ __forceinline__ void operator()(int r, int c, f32x4 v) const {
    if (r < nvalid) { const int e = tok[r]; const float g = gate[r]; u32x2 w; w.x = pk2(g * v[0], g * v[1]); w.y = pk2(g * v[2], g * v[3]); *(u32x2*)(YB + (size_t)e * 1024 + c) = w; } } };


namespace g8 {
constexpr int BM = 256, BK = 64, HALF = 128, HTB = HALF * BK * 2, NXCD = 8, WGM = 8;
__device__ __forceinline__ int lds_byte(int r, int c) { const int st = (r >> 4) * 2 + (c >> 5), rr = r & 15, cc = c & 31, ob = rr * 64 + cc * 2; return st * 1024 + (ob ^ (((ob >> 9) & 1) << 5)); }
__device__ __forceinline__ void stage_rc(int b, int& R, int& C) { const int st = b / 1024, sb = b % 1024, swz = sb ^ (((sb >> 9) & 1) << 5); R = (st >> 1) * 16 + swz / 64; C = (st & 1) * 32 + (swz % 64) / 2; }
__device__ __forceinline__ int perm32(int rho) { const int n = rho >> 4, i = rho & 15; return 8 * (i >> 2) + 4 * n + (i & 3); }
__device__ __forceinline__ unsigned cvt_pk_bf16(float lo, float hi) { return cvtpk(lo, hi); }

__device__ __forceinline__ int g8_ra(int tid, int i) { int R, C; stage_rc(tid * 16 + i * 8192, R, C); return R; }
__device__ __forceinline__ unsigned g8_ca(int tid, int i) { int R, C; stage_rc(tid * 16 + i * 8192, R, C); return (unsigned)C * 2u; }
#define G8_RA(i) g8_ra(otid(), (i))
#define G8_CA(i) g8_ca(otid(), (i))
template <class Epi, class Sched>
__device__ __forceinline__ void gemm_phase(LAS unsigned char* lds, const char* Abase, const int K, const Sched& S, const Epi& E) {
    const int tid = otid(), wid = __builtin_amdgcn_readfirstlane(tid >> 6), lane = tid & 63, wr = wid >> 2, wc = wid & 3, fr = lane & 15, fq = lane >> 4;
    const int nt = K / BK;
    unsigned voffB[2];
#pragma unroll
    for (int i = 0; i < 2; ++i) { int R, C; stage_rc(tid * 16 + i * 8192, R, C); const int Rb = Epi::PERM ? ((R & ~31) + perm32(R & 31)) : R;
        voffB[i] = (unsigned)(Rb * K + C) * 2u; }
    const unsigned rowb = (unsigned)K * 2u;
    const size_t kstep = (size_t)(BK * 2);
    const size_t hstep = (size_t)HALF * K * 2;
    const unsigned ldsw = (unsigned)wid * 1024u;
    const int aoff = lds_byte(wr * 64 + fr, fq * 8), boff = lds_byte(wc * 32 + fr, fq * 8);
#define G8_SA(b, h) (((b) * 2 + (h)) * HTB)
#define G8_SB(b, h) ((4 + (b) * 2 + (h)) * HTB)
#define G8_STAGE(bufoff, gbase, voff) do { _Pragma("unroll") for (int _i = 0; _i < 2; ++_i) \
        __builtin_amdgcn_global_load_lds((const unsigned*)((const char*)(gbase) + (voff)[_i]), (LAS unsigned*)(lds + (bufoff) + ldsw + _i * 8192), 16, 0, 0); } while (0)
#define G8_LDA(dst, b, h) do { _Pragma("unroll") for (int m = 0; m < 4; ++m) _Pragma("unroll") for (int k = 0; k < 2; ++k) dst[m][k] = *(const LAS bf16x8*)(lds + G8_SA(b, h) + aoff + m * 2048 + k * 1024); } while (0)
#define G8_LDB(dst, b, h) do { _Pragma("unroll") for (int n = 0; n < 2; ++n) _Pragma("unroll") for (int k = 0; k < 2; ++k) dst[n][k] = *(const LAS bf16x8*)(lds + G8_SB(b, h) + boff + n * 2048 + k * 1024); } while (0)
#define G8_MMA(ai, bj, At, Bt) do { __builtin_amdgcn_s_setprio(1); _Pragma("unroll") for (int m = 0; m < 4; ++m) _Pragma("unroll") for (int n = 0; n < 2; ++n) _Pragma("unroll") for (int k = 0; k < 2; ++k) \
        acc[ai][bj][m][n] = __builtin_amdgcn_mfma_f32_16x16x32_bf16(Bt[n][k], At[m][k], acc[ai][bj][m][n], 0, 0, 0); __builtin_amdgcn_s_setprio(0); } while (0)
#define G8_WAIT_V(n) asm volatile("s_waitcnt vmcnt(" #n ")" ::: "memory")
#define G8_WAIT_L(n) asm volatile("s_waitcnt lgkmcnt(" #n ")" ::: "memory")
#define G8_BAR __builtin_amdgcn_s_barrier()
#define G8_SCHED __builtin_amdgcn_sched_barrier(0)
    typename Sched::Unit cur, nxt; int ui = 0;
    if (!S.next(0, cur)) return;
    f32x4 acc[2][2][4][2];
#pragma unroll
    for (int a = 0; a < 2; ++a)
#pragma unroll
        for (int b = 0; b < 2; ++b)
#pragma unroll
            for (int m = 0; m < 4; ++m)
#pragma unroll
                for (int n = 0; n < 2; ++n) acc[a][b][m][n] = (f32x4){0.f, 0.f, 0.f, 0.f};
    bf16x8 At[4][2], B0[2][2], B1[2][2];
    unsigned vAc[2][2], vAn[2][2];
#pragma unroll
    for (int h = 0; h < 2; ++h)
#pragma unroll
        for (int i = 0; i < 2; ++i) vAc[h][i] = (Sched::AFFINE ? (unsigned)(h * HALF + G8_RA(i)) : (unsigned)S.a_row(cur, h * HALF + G8_RA(i))) * rowb + G8_CA(i);
    const char* cA = Sched::AFFINE ? Abase + (size_t)S.a_row(cur, 0) * rowb : Abase;
    const char* cB = S.b_base(cur);
    G8_STAGE(G8_SB(0, 0), cB, voffB); G8_STAGE(G8_SA(0, 0), cA, vAc[0]); G8_STAGE(G8_SB(0, 1), cB + hstep, voffB); G8_STAGE(G8_SA(0, 1), cA, vAc[1]);
    if (wr == 1) G8_BAR;
    G8_WAIT_V(4); G8_BAR;
    G8_STAGE(G8_SB(1, 0), cB + kstep, voffB); G8_STAGE(G8_SA(1, 0), cA + kstep, vAc[0]); G8_STAGE(G8_SB(1, 1), cB + hstep + kstep, voffB);
    G8_WAIT_V(6); G8_BAR;
    for (;;) {
        const bool has_next = S.next(ui + 1, nxt);
#pragma unroll
        for (int h = 0; h < 2; ++h)
#pragma unroll
            for (int i = 0; i < 2; ++i) vAn[h][i] = (has_next && !Sched::AFFINE) ? ((unsigned)S.a_row(nxt, h * HALF + G8_RA(i)) * rowb + G8_CA(i)) : vAc[h][i];
        const char* nA = (has_next && Sched::AFFINE) ? Abase + (size_t)S.a_row(nxt, 0) * rowb : cA;
        const char* nB = has_next ? S.b_base(nxt) : cB;
        for (int t = 0; t < nt; t += 2) {
            const bool last = (t == nt - 2);
            const char* a1 = cA + (size_t)(t + 1) * kstep;
            const char* a2 = last ? nA : cA + (size_t)(t + 2) * kstep; const char* b2 = last ? nB : cB + (size_t)(t + 2) * kstep;
            const char* a3 = a2 + kstep; const char* b3 = b2 + kstep;
            unsigned v2[2][2];
#pragma unroll
            for (int h = 0; h < 2; ++h)
#pragma unroll
                for (int i = 0; i < 2; ++i) v2[h][i] = last ? vAn[h][i] : vAc[h][i];
            G8_LDB(B0, 0, 0); G8_SCHED; G8_LDA(At, 0, 0); G8_STAGE(G8_SA(1, 1), a1, vAc[1]);
            G8_WAIT_L(8); G8_BAR; G8_WAIT_L(0); G8_MMA(0, 0, At, B0); G8_BAR; G8_SCHED;
            G8_LDB(B1, 0, 1); G8_STAGE(G8_SB(0, 0), b2, voffB);
            G8_BAR; G8_WAIT_L(0); G8_MMA(0, 1, At, B1); G8_BAR;
            G8_LDA(At, 0, 1); G8_STAGE(G8_SA(0, 0), a2, v2[0]);
            G8_BAR; G8_WAIT_L(0); G8_MMA(1, 0, At, B0); G8_BAR; G8_SCHED;
            G8_STAGE(G8_SB(0, 1), b2 + hstep, voffB);
            G8_WAIT_V(6); G8_BAR; G8_MMA(1, 1, At, B1); G8_BAR;
            G8_LDB(B0, 1, 0); G8_SCHED; G8_LDA(At, 1, 0); G8_STAGE(G8_SA(0, 1), a2, v2[1]);
            G8_WAIT_L(8); G8_BAR; G8_WAIT_L(0); G8_MMA(0, 0, At, B0); G8_BAR; G8_SCHED;
            G8_LDB(B1, 1, 1); G8_STAGE(G8_SB(1, 0), b3, voffB);
            G8_BAR; G8_WAIT_L(0); G8_MMA(0, 1, At, B1); G8_BAR;
            G8_LDA(At, 1, 1); G8_STAGE(G8_SA(1, 0), a3, v2[0]);
            G8_BAR; G8_WAIT_L(0); G8_MMA(1, 0, At, B0); G8_BAR; G8_SCHED;
            G8_STAGE(G8_SB(1, 1), b3 + hstep, voffB);
            G8_WAIT_V(6); G8_BAR; G8_MMA(1, 1, At, B1); G8_BAR;
        }
        E(acc, cur, wr, wc, fr, fq);
        if (!has_next) break;
#pragma unroll
        for (int a = 0; a < 2; ++a)
#pragma unroll
            for (int b = 0; b < 2; ++b)
#pragma unroll
                for (int m = 0; m < 4; ++m)
#pragma unroll
                    for (int n = 0; n < 2; ++n) acc[a][b][m][n] = (f32x4){0.f, 0.f, 0.f, 0.f};
        cur = nxt; cB = nB; cA = nA; ++ui;
#pragma unroll
        for (int h = 0; h < 2; ++h)
#pragma unroll
            for (int i = 0; i < 2; ++i) vAc[h][i] = vAn[h][i];
    }
    G8_WAIT_V(0);
    if (wr == 0) G8_BAR;
    G8_BAR;
#undef G8_SA
#undef G8_SB
#undef G8_STAGE
#undef G8_LDA
#undef G8_LDB
#undef G8_MMA
#undef G8_WAIT_V
#undef G8_WAIT_L
#undef G8_BAR
#undef G8_SCHED
}

template <int sclW, int sclA, class Epi, class Sched>
__device__ __forceinline__ void gemm_phase8(LAS unsigned char* lds, const char* Abase, const int K, const Sched& S, const Epi& E) {
    const int tid = otid(), wid = __builtin_amdgcn_readfirstlane(tid >> 6), lane = tid & 63, wr = wid >> 2, wc = wid & 3, fr = lane & 15, fq = lane >> 4;
    const int nt = K / 128;
    unsigned voffB[2];
#pragma unroll
    for (int i = 0; i < 2; ++i) { int R, C; stage_rc(tid * 16 + i * 8192, R, C); const int Rb = Epi::PERM ? ((R & ~31) + perm32(R & 31)) : R;
        voffB[i] = (unsigned)(Rb * K) + (unsigned)C * 2u; }
    const unsigned rowb = (unsigned)K;
    const size_t kstep = (size_t)(BK * 2);
    const size_t hstep = (size_t)HALF * K;
    const unsigned ldsw = (unsigned)wid * 1024u;
    const int fob = fr * 64 + ((2 * (fq & 1)) ^ (2 * (fr >> 3))) * 16 + (fq >> 1) * 1024;
    const int aoff = ((wr * 64) >> 4) * 2048 + fob, boff = ((wc * 32) >> 4) * 2048 + fob;
#define G8_SA(b, h) (((b) * 2 + (h)) * HTB)
#define G8_SB(b, h) ((4 + (b) * 2 + (h)) * HTB)
#define G8_STAGE(bufoff, gbase, voff) do { _Pragma("unroll") for (int _i = 0; _i < 2; ++_i) \
        __builtin_amdgcn_global_load_lds((const unsigned*)((const char*)(gbase) + (voff)[_i]), (LAS unsigned*)(lds + (bufoff) + ldsw + _i * 8192), 16, 0, 0); } while (0)
#define G8_LDA(dst, b, h) do { _Pragma("unroll") for (int m = 0; m < 4; ++m) { const i32x4 _lo = *(const LAS i32x4*)(lds + G8_SA(b, h) + aoff + m * 2048), _hi = *(const LAS i32x4*)(lds + G8_SA(b, h) + aoff + m * 2048 + 16); dst[m] = __builtin_shufflevector(_lo, _hi, 0, 1, 2, 3, 4, 5, 6, 7); } } while (0)
#define G8_LDB(dst, b, h) do { _Pragma("unroll") for (int n = 0; n < 2; ++n) { const i32x4 _lo = *(const LAS i32x4*)(lds + G8_SB(b, h) + boff + n * 2048), _hi = *(const LAS i32x4*)(lds + G8_SB(b, h) + boff + n * 2048 + 16); dst[n] = __builtin_shufflevector(_lo, _hi, 0, 1, 2, 3, 4, 5, 6, 7); } } while (0)
#define G8_MMA(ai, bj, At, Bt) do { __builtin_amdgcn_s_setprio(1); _Pragma("unroll") for (int m = 0; m < 4; ++m) _Pragma("unroll") for (int n = 0; n < 2; ++n) \
        acc[ai][bj][m][n] = __builtin_amdgcn_mfma_scale_f32_16x16x128_f8f6f4(Bt[n], At[m], acc[ai][bj][m][n], 0, 0, 0, sclW, 0, sclA); \
        _Pragma("unroll") for (int m = 0; m < 4; ++m) asm volatile("" : "+v"(acc[ai][bj][m][0]), "+v"(acc[ai][bj][m][1]));   \
        __builtin_amdgcn_s_setprio(0); } while (0)
#define G8_WAIT_V(n) asm volatile("s_waitcnt vmcnt(" #n ")" ::: "memory")
#define G8_WAIT_L(n) asm volatile("s_waitcnt lgkmcnt(" #n ")" ::: "memory")
#define G8_BAR __builtin_amdgcn_s_barrier()
#define G8_SCHED __builtin_amdgcn_sched_barrier(0)
    typename Sched::Unit cur, nxt; int ui = 0;
    if (!S.next(0, cur)) return;
    f32x4 acc[2][2][4][2];
#pragma unroll
    for (int a = 0; a < 2; ++a)
#pragma unroll
        for (int b = 0; b < 2; ++b)
#pragma unroll
            for (int m = 0; m < 4; ++m)
#pragma unroll
                for (int n = 0; n < 2; ++n) acc[a][b][m][n] = (f32x4){0.f, 0.f, 0.f, 0.f};
    i32x8 At[4], B0[2], B1[2];
    unsigned vAc[2][2], vAn[2][2];
#pragma unroll
    for (int h = 0; h < 2; ++h)
#pragma unroll
        for (int i = 0; i < 2; ++i) vAc[h][i] = (Sched::AFFINE ? (unsigned)(h * HALF + G8_RA(i)) : (unsigned)S.a_row(cur, h * HALF + G8_RA(i))) * rowb + G8_CA(i);
    const char* cA = Sched::AFFINE ? Abase + (size_t)S.a_row(cur, 0) * rowb : Abase;
    const char* cB = S.b_base(cur);
    G8_STAGE(G8_SB(0, 0), cB, voffB); G8_STAGE(G8_SA(0, 0), cA, vAc[0]); G8_STAGE(G8_SB(0, 1), cB + hstep, voffB); G8_STAGE(G8_SA(0, 1), cA, vAc[1]);
    if (wr == 1) G8_BAR;
    G8_WAIT_V(4); G8_BAR;
    G8_STAGE(G8_SB(1, 0), cB + kstep, voffB); G8_STAGE(G8_SA(1, 0), cA + kstep, vAc[0]); G8_STAGE(G8_SB(1, 1), cB + hstep + kstep, voffB);
    G8_WAIT_V(6); G8_BAR;
    for (;;) {
        const bool has_next = S.next(ui + 1, nxt);
#pragma unroll
        for (int h = 0; h < 2; ++h)
#pragma unroll
            for (int i = 0; i < 2; ++i) vAn[h][i] = (has_next && !Sched::AFFINE) ? ((unsigned)S.a_row(nxt, h * HALF + G8_RA(i)) * rowb + G8_CA(i)) : vAc[h][i];
        const char* nA = (has_next && Sched::AFFINE) ? Abase + (size_t)S.a_row(nxt, 0) * rowb : cA;
        const char* nB = has_next ? S.b_base(nxt) : cB;
#pragma unroll 1
        for (int t = 0; t < nt; t += 2) {
            const bool last = (t == nt - 2);
            const char* a1 = cA + (size_t)(t + 1) * kstep;
            const char* a2 = last ? nA : cA + (size_t)(t + 2) * kstep; const char* b2 = last ? nB : cB + (size_t)(t + 2) * kstep;
            const char* a3 = a2 + kstep; const char* b3 = b2 + kstep;
            unsigned v2[2][2];
#pragma unroll
            for (int h = 0; h < 2; ++h)
#pragma unroll
                for (int i = 0; i < 2; ++i) v2[h][i] = last ? vAn[h][i] : vAc[h][i];
            G8_LDB(B0, 0, 0); G8_SCHED; G8_LDA(At, 0, 0); G8_STAGE(G8_SA(1, 1), a1, vAc[1]);
            G8_WAIT_L(8); G8_BAR; G8_WAIT_L(0); G8_MMA(0, 0, At, B0); G8_BAR; G8_SCHED;
            G8_LDB(B1, 0, 1); G8_STAGE(G8_SB(0, 0), b2, voffB);
            G8_BAR; G8_WAIT_L(0); G8_MMA(0, 1, At, B1); G8_BAR;
            G8_LDA(At, 0, 1); G8_STAGE(G8_SA(0, 0), a2, v2[0]);
            G8_BAR; G8_WAIT_L(0); G8_MMA(1, 0, At, B0); G8_BAR; G8_SCHED;
            G8_STAGE(G8_SB(0, 1), b2 + hstep, voffB);
            G8_WAIT_V(6); G8_BAR; G8_MMA(1, 1, At, B1); G8_BAR;
            G8_LDB(B0, 1, 0); G8_SCHED; G8_LDA(At, 1, 0); G8_STAGE(G8_SA(0, 1), a2, v2[1]);
            G8_WAIT_L(8); G8_BAR; G8_WAIT_L(0); G8_MMA(0, 0, At, B0); G8_BAR; G8_SCHED;
            G8_LDB(B1, 1, 1); G8_STAGE(G8_SB(1, 0), b3, voffB);
            G8_BAR; G8_WAIT_L(0); G8_MMA(0, 1, At, B1); G8_BAR;
            G8_LDA(At, 1, 1); G8_STAGE(G8_SA(1, 0), a3, v2[0]);
            G8_BAR; G8_WAIT_L(0); G8_MMA(1, 0, At, B0); G8_BAR; G8_SCHED;
            G8_STAGE(G8_SB(1, 1), b3 + hstep, voffB);
            G8_WAIT_V(6); G8_BAR; G8_MMA(1, 1, At, B1); G8_BAR;
        }
        E(acc, cur, wr, wc, fr, fq);
        if (!has_next) break;
#pragma unroll
        for (int a = 0; a < 2; ++a)
#pragma unroll
            for (int b = 0; b < 2; ++b)
#pragma unroll
                for (int m = 0; m < 4; ++m)
#pragma unroll
                    for (int n = 0; n < 2; ++n) acc[a][b][m][n] = (f32x4){0.f, 0.f, 0.f, 0.f};
        cur = nxt; cB = nB; cA = nA; ++ui;
#pragma unroll
        for (int h = 0; h < 2; ++h)
#pragma unroll
            for (int i = 0; i < 2; ++i) vAc[h][i] = vAn[h][i];
    }
    G8_WAIT_V(0);
    if (wr == 0) G8_BAR;
    G8_BAR;
#undef G8_SA
#undef G8_SB
#undef G8_STAGE
#undef G8_LDA
#undef G8_LDB
#undef G8_MMA
#undef G8_WAIT_V
#undef G8_WAIT_L
#undef G8_BAR
#undef G8_SCHED
}

struct DUnit { int pm, pn; };
struct DenseOrder {
    typedef DUnit Unit; static constexpr bool AFFINE = true;
    int nM, nN, nwg, G, c; const char* Bt; int K; int bpe;
    __device__ __forceinline__ void init(int nM_, int nN_, int G_, int c_, const void* Bt_, int K_, int bpe_ = 2) { nM = nM_; nN = nN_; nwg = nM * nN; G = G_; c = c_; Bt = (const char*)Bt_; K = K_; bpe = bpe_; }
    __device__ __forceinline__ bool next(int i, Unit& u) const {
        const long L = (long)i * G + c; if (L >= nwg) return false;
        int wgid = (int)L; { const int q = nwg / NXCD, r = nwg % NXCD, xcd = wgid % NXCD, off = wgid / NXCD; wgid = (xcd < r ? xcd * (q + 1) : r * (q + 1) + (xcd - r) * q) + off; }
        const int nig = WGM * nN, gid = wgid / nig, fm = gid * WGM, gsz = (nM - fm) < WGM ? (nM - fm) : WGM;
        u.pm = fm + ((wgid % nig) % gsz); u.pn = (wgid % nig) / gsz; return true;
    }
    __device__ __forceinline__ int a_row(const Unit& u, int r) const { return u.pm * BM + r; }
    __device__ __forceinline__ const char* b_base(const Unit& u) const { return Bt + (size_t)u.pn * BM * K * bpe; }
};
struct MUnit { int pm, pn, e, nvalid, lbase, idx; };
constexpr int MOE_UTAB = 131072, MOE_RTOK = MOE_UTAB + 128, MOE_RGATE = MOE_RTOK + 4096;
template <bool GATHER> struct MoeOrder {
    typedef MUnit Unit; static constexpr bool AFFINE = !GATHER;
    const int* utab; const int* rtok; const char* W; int K; int bpe;
    __device__ __forceinline__ bool next(int i, Unit& u) const {
        if (i >= 4) return false;
        const int* t = utab + i * 8;
        if (t[5] == 0) return false;
        u.pm = t[0]; u.pn = t[1]; u.e = t[2]; u.nvalid = t[3]; u.lbase = t[4]; u.idx = i; return true;
    }
    __device__ __forceinline__ int a_row(const Unit& u, int r) const { if (GATHER) return rtok[u.idx * 256 + r] >> 1; else return u.pm * BM + r; }
    __device__ __forceinline__ const char* b_base(const Unit& u) const { return W + ((size_t)u.e * 1024 + u.pn * BM) * K * bpe; }
};

struct EpiP2 {
    static constexpr bool PERM = true;
    bf16_t* P;
    __device__ __forceinline__ void operator()(const f32x4 (&acc)[2][2][4][2], const DUnit& u, int wr, int wc, int fr, int fq) const {
        const int row0 = u.pm * BM + wr * 64 + fr, col0 = u.pn * BM + wc * 32 + 8 * fq;
#pragma unroll
        for (int ai = 0; ai < 2; ++ai)
#pragma unroll
            for (int m = 0; m < 4; ++m) { bf16_t* rowp = P + (size_t)(row0 + ai * HALF + m * 16) * PW + col0;
#pragma unroll
                for (int bj = 0; bj < 2; ++bj) { const f32x4 v0 = acc[ai][bj][m][0], v1 = acc[ai][bj][m][1];
                    u32x4 w; w.x = cvt_pk_bf16(v0[0], v0[1]); w.y = cvt_pk_bf16(v0[2], v0[3]); w.z = cvt_pk_bf16(v1[0], v1[1]); w.w = cvt_pk_bf16(v1[2], v1[3]);
                    *(u32x4*)(rowp + bj * HALF) = w; } }
    }
};
struct EpiRes2 {
    static constexpr bool PERM = false;
    float* X; const float* gate; float scl;
    __device__ __forceinline__ void operator()(const f32x4 (&acc)[2][2][4][2], const DUnit& u, int wr, int wc, int fr, int fq) const {
        const int row0 = u.pm * BM + wr * 64 + fr, col0 = u.pn * BM + wc * 32 + 4 * fq;
#pragma unroll
        for (int ai = 0; ai < 2; ++ai)
#pragma unroll
            for (int m = 0; m < 4; ++m) { const int r = row0 + ai * HALF + m * 16; float* rowp = X + (size_t)r * 1024 + col0; const float* gp = gate + (size_t)mod_row(r) * 6144 + col0;
#pragma unroll
                for (int bj = 0; bj < 2; ++bj)
#pragma unroll
                    for (int n = 0; n < 2; ++n) { const f32x4 gv = *(const f32x4*)(gp + bj * HALF + n * 16); f32x4 x = *(f32x4*)(rowp + bj * HALF + n * 16); x += (gv * scl) * acc[ai][bj][m][n]; *(f32x4*)(rowp + bj * HALF + n * 16) = x; }
                asm volatile("" ::: "memory"); }
    }
};
struct EpiDelta {
    static constexpr bool PERM = true;
    bf16_t* Dl; const float* gate; float scl;
    __device__ __forceinline__ void operator()(const f32x4 (&acc)[2][2][4][2], const DUnit& u, int wr, int wc, int fr, int fq) const {
        const int row0 = u.pm * BM + wr * 64 + fr, col0 = u.pn * BM + wc * 32 + 8 * fq;
#pragma unroll
        for (int ai = 0; ai < 2; ++ai)
#pragma unroll
            for (int m = 0; m < 4; ++m) { const int r = row0 + ai * HALF + m * 16; bf16_t* rowp = Dl + (size_t)r * 1024 + col0; const float* gp = gate + (size_t)mod_row(r) * 6144 + col0;
#pragma unroll
                for (int bj = 0; bj < 2; ++bj) { const f32x4 g0 = *(const f32x4*)(gp + bj * HALF) * scl, g1 = *(const f32x4*)(gp + bj * HALF + 4) * scl;
                    const f32x4 v0 = acc[ai][bj][m][0] * g0, v1 = acc[ai][bj][m][1] * g1;
                    u32x4 w; w.x = cvt_pk_bf16(v0[0], v0[1]); w.y = cvt_pk_bf16(v0[2], v0[3]); w.z = cvt_pk_bf16(v1[0], v1[1]); w.w = cvt_pk_bf16(v1[2], v1[3]);
                    *(u32x4*)(rowp + bj * HALF) = w; } }
    }
};
struct EpiGU2 {
    static constexpr bool PERM = true;
    bf16_t* H;
    __device__ __forceinline__ void operator()(const f32x4 (&acc)[2][2][4][2], const MUnit& u, int wr, int wc, int fr, int fq) const {
        const int row0 = u.pm * BM + wr * 64 + fr, col0 = u.pn * BM + wc * 32 + 8 * fq;
#pragma unroll
        for (int ai = 0; ai < 2; ++ai)
#pragma unroll
            for (int m = 0; m < 4; ++m) { bf16_t* rowp = H + (size_t)(row0 + ai * HALF + m * 16) * 512 + (col0 >> 1);
#pragma unroll
                for (int bj = 0; bj < 2; ++bj) { const f32x4 v0 = acc[ai][bj][m][0], v1 = acc[ai][bj][m][1];
                    u32x2 w; w.x = cvt_pk_bf16(siluf(v0[0]) * v0[1], siluf(v0[2]) * v0[3]); w.y = cvt_pk_bf16(siluf(v1[0]) * v1[1], siluf(v1[2]) * v1[3]);
                    *(u32x2*)(rowp + bj * (HALF / 2)) = w; } }
    }
};
struct EpiGU8 {
    static constexpr bool PERM = true;
    unsigned char* H;
    __device__ __forceinline__ void operator()(const f32x4 (&acc)[2][2][4][2], const MUnit& u, int wr, int wc, int fr, int fq) const {
        const int row0 = u.pm * BM + wr * 64 + fr, col0 = u.pn * BM + wc * 32 + 8 * fq;
#pragma unroll
        for (int ai = 0; ai < 2; ++ai)
#pragma unroll
            for (int m = 0; m < 4; ++m) { unsigned char* rowp = H + (size_t)(row0 + ai * HALF + m * 16) * 512 + (col0 >> 1);
#pragma unroll
                for (int bj = 0; bj < 2; ++bj) { const f32x4 v0 = acc[ai][bj][m][0], v1 = acc[ai][bj][m][1];
                    *(unsigned*)(rowp + bj * (HALF / 2)) = pk4_fp8(2.0f * siluf(v0[0]) * v0[1], 2.0f * siluf(v0[2]) * v0[3], 2.0f * siluf(v1[0]) * v1[1], 2.0f * siluf(v1[2]) * v1[3]); } }
    }
};
struct EpiDown2 {
    static constexpr bool PERM = true;
    bf16_t* YB; const int* rtok; const float* rgate;
    __device__ __forceinline__ void operator()(const f32x4 (&acc)[2][2][4][2], const MUnit& u, int wr, int wc, int fr, int fq) const {
        const int r0 = wr * 64 + fr, col0 = u.pn * BM + wc * 32 + 8 * fq;
#pragma unroll
        for (int ai = 0; ai < 2; ++ai)
#pragma unroll
            for (int m = 0; m < 4; ++m) { const int rt = r0 + ai * HALF + m * 16;
                if (rt < u.nvalid) { const int ent = rtok[u.idx * 256 + rt]; const float g = rgate[u.idx * 256 + rt]; bf16_t* rowp = YB + (size_t)ent * 1024 + col0;
#pragma unroll
                    for (int bj = 0; bj < 2; ++bj) { const f32x4 v0 = acc[ai][bj][m][0] * g, v1 = acc[ai][bj][m][1] * g;
                        u32x4 w; w.x = cvt_pk_bf16(v0[0], v0[1]); w.y = cvt_pk_bf16(v0[2], v0[3]); w.z = cvt_pk_bf16(v1[0], v1[1]); w.w = cvt_pk_bf16(v1[2], v1[3]);
                        *(u32x4*)(rowp + bj * HALF) = w; } } }
    }
};
struct EpiDown8 {
    static constexpr bool PERM = true;
    unsigned char* YB; const int* rtok; const float* rgate;
    __device__ __forceinline__ void operator()(const f32x4 (&acc)[2][2][4][2], const MUnit& u, int wr, int wc, int fr, int fq) const {
        const int r0 = wr * 64 + fr, col0 = u.pn * BM + wc * 32 + 8 * fq;
#pragma unroll
        for (int ai = 0; ai < 2; ++ai)
#pragma unroll
            for (int m = 0; m < 4; ++m) { const int rt = r0 + ai * HALF + m * 16;
                if (rt < u.nvalid) { const int ent = rtok[u.idx * 256 + rt]; const float g = 64.0f * rgate[u.idx * 256 + rt]; unsigned char* rowp = YB + (size_t)ent * 1024 + col0;
#pragma unroll
                    for (int bj = 0; bj < 2; ++bj) { const f32x4 v0 = acc[ai][bj][m][0] * g, v1 = acc[ai][bj][m][1] * g;
                        u32x2 w; w.x = pk4_fp8(v0[0], v0[1], v0[2], v0[3]); w.y = pk4_fp8(v1[0], v1[1], v1[2], v1[3]);
                        *(u32x2*)(rowp + bj * HALF) = w; } } }
    }
};
}

__device__ __forceinline__ void transpose_item(const float* __restrict__ W, int K, int N, bf16_t* __restrict__ WT, int mode, float* scr, int item, int lane) {
    const int nblk = N / 32, kb = item / nblk, nb = item % nblk, k0 = 64 * kb, n0 = 32 * nb;
    float wv[32];
#pragma unroll
    for (int i = 0; i < 32; ++i) wv[i] = __builtin_nontemporal_load(W + (size_t)(k0 + 2 * i + (lane >> 5)) * N + n0 + (lane & 31));
#pragma unroll
    for (int i = 0; i < 32; ++i) scr[(2 * i + (lane >> 5)) * 33 + (lane & 31)] = wv[i];
    LDS_WAIT();
    const int c = lane & 7;
#pragma unroll
    for (int j = 0; j < 4; ++j) {
        const int n = (lane >> 3) + 8 * j; const float* s = scr + (8 * c) * 33 + n;
        u32x4 o; o.x = pk2(s[0 * 33], s[1 * 33]); o.y = pk2(s[2 * 33], s[3 * 33]); o.z = pk2(s[4 * 33], s[5 * 33]); o.w = pk2(s[6 * 33], s[7 * 33]);
        const int nabs = n0 + n; const int orow = mode ? ((nabs < 512) ? 2 * nabs : 2 * (nabs - 512) + 1) : nabs;
        *(u32x4*)(WT + (size_t)orow * K + k0 + 8 * c) = o;
    }
    LDS_WAIT();
}


__device__ __forceinline__ void transpose_item8(const float* __restrict__ W, int K, int N, unsigned char* __restrict__ WT, int mode, float scale, float* scr, int item, int lane) {
    const int nblk = N / 32, kb = item / nblk, nb = item % nblk, k0 = 64 * kb, n0 = 32 * nb;
    float wv[32];
#pragma unroll
    for (int i = 0; i < 32; ++i) wv[i] = __builtin_nontemporal_load(W + (size_t)(k0 + 2 * i + (lane >> 5)) * N + n0 + (lane & 31));
#pragma unroll
    for (int i = 0; i < 32; ++i) scr[(2 * i + (lane >> 5)) * 33 + (lane & 31)] = wv[i] * scale;
    LDS_WAIT();
    const int c = lane & 7;
#pragma unroll
    for (int j = 0; j < 4; ++j) {
        const int n = (lane >> 3) + 8 * j; const float* s = scr + (8 * c) * 33 + n;
        u32x2 o; o.x = pk4_fp8(s[0 * 33], s[1 * 33], s[2 * 33], s[3 * 33]); o.y = pk4_fp8(s[4 * 33], s[5 * 33], s[6 * 33], s[7 * 33]);
        const int nabs = n0 + n; const int orow = mode ? ((nabs < 512) ? 2 * nabs : 2 * (nabs - 512) + 1) : nabs;
        *(u32x2*)(WT + (size_t)orow * K + k0 + 8 * c) = o;
    }
    LDS_WAIT();
}

__device__ __forceinline__ void convert_experts(const Params& p, int l, float* scr, int widx, int nwv, int it0, int it1) {
    const int tid = otid(), lane = tid & 63;
    bf16_t* wgu_t = (bf16_t*)(ows(p) + WS_WGU) + (size_t)l * 32 * 1024 * 1024; bf16_t* wdn_t = (bf16_t*)(ows(p) + WS_WDN) + (size_t)l * 32 * 1024 * 512;
    const float* wgu = oin(p, 17) + (size_t)l * 32 * 1024 * 1024; const float* wdn = oin(p, 18) + (size_t)l * 32 * 512 * 1024;
    constexpr int I_GU = 16 * 32, I_DN = 8 * 32, T_GU = 32 * I_GU;
    unsigned char* wgu8 = ows(p) + WS_WGU8 + (size_t)l * 32 * 1024 * 1024; unsigned char* wdn8 = ows(p) + WS_WDN8 + (size_t)l * 32 * 1024 * 512;
    for (int it = it0 + widx; it < it1; it += nwv) {
        if (it < T_GU) { const int m = it / I_GU;
            if (MOE_FP8) transpose_item8(wgu + (size_t)m * 1024 * 1024, 1024, 1024, wgu8 + (size_t)m * 1024 * 1024, 1, 32.0f, scr, it % I_GU, lane);
            else transpose_item(wgu + (size_t)m * 1024 * 1024, 1024, 1024, wgu_t + (size_t)m * 1024 * 1024, 1, scr, it % I_GU, lane); }
        else { const int r = it - T_GU, m = r / I_DN;
            if (MOE_FP8) transpose_item8(wdn + (size_t)m * 512 * 1024, 512, 1024, wdn8 + (size_t)m * 1024 * 512, 0, 16.0f, scr, r % I_DN, lane);
            else transpose_item(wdn + (size_t)m * 512 * 1024, 512, 1024, wdn_t + (size_t)m * 1024 * 512, 0, scr, r % I_DN, lane); }
    }
}

__device__ __forceinline__ void convert_range(const Params& p, float* scr, int widx, int nwv, int g0, int g1) {
    for (int l = g0 / CV_ALL; l < DEPTH && l * CV_ALL < g1; ++l) {
        const int a = max(g0, l * CV_ALL) - l * CV_ALL, b = min(g1, (l + 1) * CV_ALL) - l * CV_ALL;
        convert_experts(p, l, scr, widx, nwv, a, b);
    }
}

__device__ __forceinline__ void phase_prologue(const Params& p, unsigned char* lds) {
    const int tid = otid(), lane = tid & 63, wid = tid >> 6;
    float* scr = (float*)(lds + wid * 16384);
    const int gw = obid() * 8 + wid, NGW = gridDim.x * 8;
    bf16_t* win_t = (bf16_t*)(ows(p) + WS_WIN); bf16_t* wout_t = (bf16_t*)(ows(p) + WS_WOUT);
    constexpr int I_IN = 16 * 128, I_OUT = 16 * 32;
    constexpr int T_IN = 4 * I_IN, T_OUT = 4 * I_OUT;
    for (int it = gw; it < T_IN + T_OUT; it += NGW) {
        int r = it;
        if (r < T_IN) { const int m = r / I_IN; transpose_item(oin(p, 7) + (size_t)m * 1024 * 4096, 1024, 4096, win_t + (size_t)m * 4096 * 1024, 0, scr, r % I_IN, lane); continue; } r -= T_IN;
        { const int m = r / I_OUT;
          if (G2_FP8) transpose_item8(oin(p, 12) + (size_t)m * 1024 * 1024, 1024, 1024, (unsigned char*)wout_t + (size_t)m * 1024 * 1024, 0, 32.0f, scr, r % I_OUT, lane);
          else transpose_item(oin(p, 12) + (size_t)m * 1024 * 1024, 1024, 1024, wout_t + (size_t)m * 1024 * 1024, 0, scr, r % I_OUT, lane); }
    }
    {
        bf16_t* wrh = (bf16_t*)(ows(p) + WS_WRH); bf16_t* wrl = (bf16_t*)(ows(p) + WS_WRL);
        for (int i = obid() * 512 + tid; i < 4 * 48 * 1024; i += gridDim.x * 512) {
            const int l = i / (48 * 1024), j = (i / 1024) % 48, k = i % 1024;
            float w = 0.f;
            if (j < 4) w = oin(p, 13)[((size_t)l * 1024 + k) * 4 + j]; else if (j < 36) w = oin(p, 15)[((size_t)l * 1024 + k) * 32 + (j - 4)];
            const unsigned hi = f2bf(w); const float rem = w - __uint_as_float(hi << 16);
            wrh[i] = (bf16_t)hi; wrl[i] = (bf16_t)f2bf(rem);
        }
    }
    __syncthreads();
    float* modp = (float*)(ows(p) + WS_MODP);
    float* sS = (float*)lds;
    for (int u = obid(); u < 4 * 24 * 8; u += gridDim.x) {
        const int l = u / 192, rem = u % 192, nb = rem / 8, ks = rem % 8;
        __syncthreads();
        for (int i = tid; i < 9 * 128; i += 512) { const int r = i >> 7, k = i & 127; const float cv = (r < 8) ? oin(p, 1)[r * 1024 + ks * 128 + k] : oin(p, 3)[ks * 128 + k]; sS[i] = siluf(cv); }
        __syncthreads();
        const int col = nb * 256 + (tid & 255), kh = tid >> 8;
        float acc[9];
#pragma unroll
        for (int r = 0; r < 9; ++r) acc[r] = 0.f;
        const float* w = oin(p, 5) + ((size_t)l * 1024 + ks * 128 + kh * 64) * 6144 + col;
        for (int k = 0; k < 64; ++k) {
            const float wv = w[(size_t)k * 6144];
#pragma unroll
            for (int r = 0; r < 9; ++r) acc[r] += sS[r * 128 + kh * 64 + k] * wv;
        }
#pragma unroll
        for (int r = 0; r < 9; ++r) modp[(((size_t)l * NMODP + ks * 2 + kh) * 9 + r) * 6144 + col] = acc[r];
    }
}

__device__ __forceinline__ void phase_modreduce(const Params& p) {
    const float* modp = (const float*)(ows(p) + WS_MODP); float* modv = (float*)(ows(p) + WS_MOD);
    for (int i = obid() * 512 + otid(); i < 4 * 9 * 6144; i += gridDim.x * 512) {
        const int l = i / (9 * 6144), rem = i % (9 * 6144), n = rem % 6144;
        float s = oin(p, 6)[l * 6144 + n];
        for (int j = 0; j < NMODP; ++j) s += modp[((size_t)l * NMODP + j) * 9 * 6144 + rem];
        modv[i] = s;
    }
}

template <int NB>
__device__ __forceinline__ void norm1_rows(const Params& p, int l, float scl, int r0, int stride, const f32x4 (&nwv)[4], const f32x4 (&shv)[4], const f32x4 (&scv)[4], const f32x4 (&g5v)[4]) {
    const int lane = otid() & 63;
    bf16_t* xws = (bf16_t*)(ows(p) + WS_X); bf16_t* hb = (bf16_t*)(ows(p) + WS_H); const unsigned char* y8 = ows(p) + WS_YB8;
    f32x4 v[NB][4]; u32x2 xr[NB][4]; unsigned ya[NB][4], yc[NB][4];
#pragma unroll
    for (int q = 0; q < NB; ++q) {
        const int r = r0 + q * stride;
        if (l == 0) { const float* src = r < NLAT ? oin(p, 0) + (size_t)r * 1024 : oin(p, 2) + (size_t)(r - NLAT) * 1024;
#pragma unroll
            for (int j = 0; j < 4; ++j) v[q][j] = *(const f32x4*)(src + 4 * lane + 256 * j); }
        else {
#pragma unroll
            for (int j = 0; j < 4; ++j) { const int c = 4 * lane + 256 * j; xr[q][j] = *(const u32x2*)(xws + (size_t)r * 1024 + c);
                ya[q][j] = *(const unsigned*)(y8 + (size_t)(2 * r) * 1024 + c); yc[q][j] = *(const unsigned*)(y8 + (size_t)(2 * r + 1) * 1024 + c); } }
    }
#pragma unroll
    for (int q = 0; q < NB; ++q) {
        const int r = r0 + q * stride;
        if (l > 0) {
#pragma unroll
            for (int j = 0; j < 4; ++j) { const f32x4 f = (unpk4_fp8(ya[q][j]) + unpk4_fp8(yc[q][j])) * (1.0f / 64.0f); v[q][j] = unpk4_bf16(xr[q][j]) + (g5v[j] * scl) * f; }
        }
#pragma unroll
        for (int j = 0; j < 4; ++j) { u32x2 o; o.x = cvtpk(v[q][j][0], v[q][j][1]); o.y = cvtpk(v[q][j][2], v[q][j][3]); *(u32x2*)(xws + (size_t)r * 1024 + 4 * lane + 256 * j) = o; }
        float ss = 0.f;
#pragma unroll
        for (int j = 0; j < 4; ++j) ss += (v[q][j][0] * v[q][j][0] + v[q][j][1] * v[q][j][1]) + (v[q][j][2] * v[q][j][2] + v[q][j][3] * v[q][j][3]);
        const float rstd = rsqrtf(wave_sum(ss) * (1.0f / 1024.0f) + EPS);
#pragma unroll
        for (int j = 0; j < 4; ++j) {
            const f32x4 h = (v[q][j] * rstd * nwv[j]) * (1.0f + scv[j]) + shv[j];
            u32x2 o; o.x = pk2(h[0], h[1]); o.y = pk2(h[2], h[3]);
            *(u32x2*)(hb + (size_t)r * 1024 + 4 * lane + 256 * j) = o;
        }
    }
}
__device__ __forceinline__ void phase_norm1(const Params& p, int l, float scl) {
    static_assert(MOE_FP8 == 1 && SEQ % 8 == 0, "norm1 reads the fp8 slot outputs");
    const int lane = otid() & 63, wid = otid() >> 6;
    const float* modv = (const float*)(ows(p) + WS_MOD);
    const float* nw = oin(p, 4) + (size_t)(l * 2 + 0) * 1024;
    const int w = obid() * 8 + wid, nwvs = (int)gridDim.x * 8;
    f32x4 nwv[4];
#pragma unroll
    for (int j = 0; j < 4; ++j) nwv[j] = *(const f32x4*)(nw + 4 * lane + 256 * j);
    for (int blk = w; blk < NLAT / 8 + (NTOK - NLAT); blk += nwvs) {
        const bool lat = blk < NLAT / 8;
        const int r0 = lat ? blk * 8 : NLAT + (blk - NLAT / 8), mr = mod_row(r0);
        f32x4 shv[4], scv[4], g5v[4];
        const float* msh = modv + ((size_t)l * 9 + mr) * 6144; const float* msc = msh + 1024; const float* g5 = modv + ((size_t)(l > 0 ? l - 1 : 0) * 9 + mr) * 6144 + 5 * 1024;
#pragma unroll
        for (int j = 0; j < 4; ++j) { const int c = 4 * lane + 256 * j; shv[j] = *(const f32x4*)(msh + c); scv[j] = *(const f32x4*)(msc + c); g5v[j] = *(const f32x4*)(g5 + c); }
        if (lat) { norm1_rows<4>(p, l, scl, r0, 1, nwv, shv, scv, g5v); norm1_rows<4>(p, l, scl, r0 + 4, 1, nwv, shv, scv, g5v); }
        else norm1_rows<1>(p, l, scl, r0, 1, nwv, shv, scv, g5v);
    }
}

__device__ __forceinline__ void phase_final(const Params& p) {
    const int lane = otid() & 63, wid = otid() >> 6;
    const bf16_t* xws = (const bf16_t*)(ows(p) + WS_X); const bf16_t* yb = (const bf16_t*)(ows(p) + WS_YB);
    const float* modv = (const float*)(ows(p) + WS_MOD); const float* nw = oin(p, 19);
    for (int r = obid() * 8 + wid; r < NLAT; r += gridDim.x * 8) {
        const int mr = mod_row(r);
        const float* g5 = modv + ((size_t)3 * 9 + mr) * 6144 + 5 * 1024;
        f32x4 v[4], fw[4]; float ss = 0.f;
#pragma unroll
        for (int j = 0; j < 4; ++j) fw[j] = *(const f32x4*)(nw + 4 * lane + 256 * j);
#pragma unroll
        for (int j = 0; j < 4; ++j) {
            const int c = 4 * lane + 256 * j;
            v[j] = unpk4_bf16(*(const u32x2*)(xws + (size_t)r * 1024 + c));
            const f32x4 gv = *(const f32x4*)(g5 + c);
            f32x4 f;
            if (MOE_FP8) { const unsigned char* y8 = ows(p) + WS_YB8; f = (unpk4_fp8(*(const unsigned*)(y8 + (size_t)(2 * r) * 1024 + c)) + unpk4_fp8(*(const unsigned*)(y8 + (size_t)(2 * r + 1) * 1024 + c))) * (1.0f / 64.0f); }
            else { const u32x2 y0 = *(const u32x2*)(yb + (size_t)(2 * r) * 1024 + c), y1 = *(const u32x2*)(yb + (size_t)(2 * r + 1) * 1024 + c);
            f[0] = bf2f(y0.x & 0xffff) + bf2f(y1.x & 0xffff); f[1] = bf2f(y0.x >> 16) + bf2f(y1.x >> 16);
            f[2] = bf2f(y0.y & 0xffff) + bf2f(y1.y & 0xffff); f[3] = bf2f(y0.y >> 16) + bf2f(y1.y >> 16); }
            v[j] += gv * f;
            ss += (v[j][0] * v[j][0] + v[j][1] * v[j][1]) + (v[j][2] * v[j][2] + v[j][3] * v[j][3]);
        }
        const float rstd = rsqrtf(wave_sum(ss) * (1.0f / 1024.0f) + EPS);
#pragma unroll
        for (int j = 0; j < 4; ++j) { const int c = 4 * lane + 256 * j; *(f32x4*)(p.out + (size_t)r * 1024 + c) = v[j] * rstd * fw[j]; }
    }
}

__device__ __forceinline__ void phase_gemm1(const Params& p, int l, unsigned char* lds) {
    const bf16_t* hb = (const bf16_t*)(ows(p) + WS_H); const bf16_t* wt = (const bf16_t*)(ows(p) + WS_WIN) + (size_t)l * 4096 * 1024; bf16_t* pb = (bf16_t*)(ows(p) + WS_P);
    constexpr int NT = PW / 128, MT = NTOK / 128;
    for (int u = obid(); u < MT * NT; u += gridDim.x) {
        const int mt = u / NT, nt = u % NT;
        ARowPlain ar{hb + (size_t)mt * 128 * 1024, 1024};
        EpiP ep{pb + (size_t)mt * 128 * PW + nt * 128};
        gemm128(lds, ar, wt + (size_t)nt * 128 * 1024, 1024, ep);
    }
}

__device__ __forceinline__ void unpack8(const u32x4 w, float (&f)[8]) {
    f[0] = bf2f(w.x & 0xffff); f[1] = bf2f(w.x >> 16); f[2] = bf2f(w.y & 0xffff); f[3] = bf2f(w.y >> 16);
    f[4] = bf2f(w.z & 0xffff); f[5] = bf2f(w.z >> 16); f[6] = bf2f(w.w & 0xffff); f[7] = bf2f(w.w >> 16);
}
__device__ __forceinline__ void conv_rows(const Params& p, int l, int widx, int nwv) {
    const int lane = otid() & 63;
    const bf16_t* pb = (const bf16_t*)(ows(p) + WS_P); bf16_t* yb = (bf16_t*)(ows(p) + WS_Y);
    const float* cw = oin(p, 8) + (size_t)l * 3 * 512; const float* cnw = oin(p, 9) + (size_t)l * 512;
    const int nrows = (l == DEPTH - 1) ? NLAT : NTOK;
    const int c0 = lane * 8;
    float w0[8], w1[8], w2[8], nwv8[8];
#pragma unroll
    for (int j = 0; j < 8; ++j) { w0[j] = cw[c0 + j]; w1[j] = cw[512 + c0 + j]; w2[j] = cw[1024 + c0 + j]; nwv8[j] = cnw[c0 + j]; }
    constexpr int NB = 4;
    for (int rb = widx; rb < nrows; rb += NB * nwv) {
        u32x4 vb[NB], vc[NB], vh[NB], vcm[NB], vhm[NB], vcp[NB], vhp[NB]; bool hm[NB], hp[NB];
#pragma unroll
        for (int q = 0; q < NB; ++q) {
            int r = rb + q * nwv; if (r >= nrows) r = rb;
            int rm = -1, rp = -1;
            if (r < NLAT) {
                const int t = r & 2047;
                if (c0 < 256) { if ((t & 63) > 0) rm = r - 1; if ((t & 63) < 63) rp = r + 1; }
                else { if (t >= 64) rm = r - 64; if (t < SEQ - 64) rp = r + 64; }
            } else { const int tc = (r - NLAT) & 255; if (tc > 0) rm = r - 1; if (tc < 255) rp = r + 1; }
            hm[q] = rm >= 0; hp[q] = rp >= 0; if (rm < 0) rm = r; if (rp < 0) rp = r;
            vb[q] = *(const u32x4*)(pb + (size_t)r * PW + OFF_B + c0); vc[q] = *(const u32x4*)(pb + (size_t)r * PW + OFF_C + c0); vh[q] = *(const u32x4*)(pb + (size_t)r * PW + OFF_HV + c0);
            vcm[q] = *(const u32x4*)(pb + (size_t)rm * PW + OFF_C + c0); vhm[q] = *(const u32x4*)(pb + (size_t)rm * PW + OFF_HV + c0);
            vcp[q] = *(const u32x4*)(pb + (size_t)rp * PW + OFF_C + c0); vhp[q] = *(const u32x4*)(pb + (size_t)rp * PW + OFF_HV + c0);
        }
#pragma unroll
        for (int q = 0; q < NB; ++q) {
            const int r = rb + q * nwv;
            float bg[8], u0[8], um[8], up[8], t1[8];
            unpack8(vb[q], bg); unpack8(vc[q], u0); unpack8(vh[q], t1);
#pragma unroll
            for (int j = 0; j < 8; ++j) u0[j] *= t1[j];
            unpack8(vcm[q], um); unpack8(vhm[q], t1);
#pragma unroll
            for (int j = 0; j < 8; ++j) um[j] = hm[q] ? um[j] * t1[j] : 0.f;
            unpack8(vcp[q], up); unpack8(vhp[q], t1);
#pragma unroll
            for (int j = 0; j < 8; ++j) up[j] = hp[q] ? up[j] * t1[j] : 0.f;
            float z[8]; float ss = 0.f;
#pragma unroll
            for (int j = 0; j < 8; ++j) { z[j] = bg[j] * (w0[j] * um[j] + w1[j] * u0[j] + w2[j] * up[j]); ss += z[j] * z[j]; }
            const float rstd = rsqrtf(wave_sum(ss) * (1.0f / 512.0f) + EPS);
            if (G2_FP8) {
                const float rs8 = rstd * 8.0f; u32x2 o8;
                o8.x = pk4_fp8(z[0] * rs8 * nwv8[0], z[1] * rs8 * nwv8[1], z[2] * rs8 * nwv8[2], z[3] * rs8 * nwv8[3]); o8.y = pk4_fp8(z[4] * rs8 * nwv8[4], z[5] * rs8 * nwv8[5], z[6] * rs8 * nwv8[6], z[7] * rs8 * nwv8[7]);
                if (r < nrows) *(u32x2*)((unsigned char*)yb + (size_t)r * 1024 + c0) = o8;
            } else {
            u32x4 o;
            o.x = cvtpk(z[0] * rstd * nwv8[0], z[1] * rstd * nwv8[1]); o.y = cvtpk(z[2] * rstd * nwv8[2], z[3] * rstd * nwv8[3]);
            o.z = cvtpk(z[4] * rstd * nwv8[4], z[5] * rstd * nwv8[5]); o.w = cvtpk(z[6] * rstd * nwv8[6], z[7] * rstd * nwv8[7]);
            if (r < nrows) *(u32x4*)(yb + (size_t)r * 1024 + c0) = o; }
        }
    }
}

template <int DIR>
__device__ __forceinline__ void gla_pre_dir(const Params& p, int l, int chunk, float* sQ, float* sK, const float* sV, float* sA, float* sBq, float (&oacc)[16]) {
    const int ch = otid(), tid = otid(), R0 = chunk * 16;
    const bf16_t* pb = (const bf16_t*)(ows(p) + WS_P);
    bf16_t* qin = (bf16_t*)(ows(p) + WS_QIN); bf16_t* kout = (bf16_t*)(ows(p) + WS_KOUT); float* dch = (float*)(ows(p) + WS_DCH);
    float lbv = 0.f;
    {
        const float* lb = oin(p, 10) + (size_t)DIR * 4 * 512 + ch;
        const float z0 = lb[0], z1 = lb[512], z2 = lb[1024], z3 = lb[1536];
        const float mx = fmaxf(fmaxf(z0, z1), fmaxf(z2, z3));
        const float e0 = __expf(z0 - mx), e1 = __expf(z1 - mx), e2 = __expf(z2 - mx), e3 = __expf(z3 - mx);
        const float inv = 1.0f / (e0 + e1 + e2 + e3);
        lbv = ((l >= 1 ? e1 : 0.f) + (l >= 2 ? e2 : 0.f) + (l >= 3 ? e3 : 0.f)) * inv;
    }
    float b = 0.f;
#pragma unroll 1
    for (int i = 0; i < 16; ++i) {
        const int row = R0 + (DIR ? 15 - i : i);
        const float zf = bf2f(pb[(size_t)row * PW + OFF_ZF + DIR * 512 + ch]);
        const float sg = 1.0f / (1.0f + __expf(-zf)), sn = 1.0f / (1.0f + __expf(zf));
        const float f = fmaxf(lbv + (1.0f - lbv) * sg, 1e-30f);
        b += __logf(f);
        sBq[i * 512 + ch] = b; sK[i * 512 + ch] = (1.0f - lbv) * sn;
        sQ[i * 512 + ch] = siluf(bf2f(pb[(size_t)row * PW + OFF_Q + ch]));
    }
    const float blast = b;
#pragma unroll 1
    for (int i = 0; i < 16; ++i) {
        const int row = R0 + (DIR ? 15 - i : i);
        const float bi = sBq[i * 512 + ch], kq = sK[i * 512 + ch], qv = sQ[i * 512 + ch];
        const float qi = qv * __expf(bi), kt = kq * __expf(fminf(-bi, 80.0f)), ko = kq * __expf(blast - bi);
        sQ[i * 512 + ch] = qi; sK[i * 512 + ch] = kt;
        qin[((size_t)DIR * NTOK + row) * 512 + ch] = (bf16_t)f2bf(qi);
        kout[((size_t)DIR * NTOK + row) * 512 + ch] = (bf16_t)f2bf(ko);
    }
    dch[((size_t)DIR * NCHUNK + chunk) * 512 + ch] = __expf(blast);
    __syncthreads();
#pragma unroll 1
    for (int e2 = 0; e2 < 2; ++e2) {
        const int e = tid * 2 + e2, h = e >> 8, t = (e >> 4) & 15, s = e & 15;
        float sum = 0.f;
        const float* qp = sQ + t * 512 + h * 128; const float* kp = sK + s * 512 + h * 128;
#pragma unroll 8
        for (int k = 0; k < 128; ++k) sum += qp[k] * kp[k];
        sA[e] = (s <= t) ? sum : 0.f;
    }
    __syncthreads();
    const int h = ch >> 7;
#pragma unroll
    for (int t = 0; t < 16; ++t) {
        float o = 0.f;
#pragma unroll 1
        for (int s = 0; s <= t; ++s) o += sA[(h * 16 + t) * 16 + s] * sV[(DIR ? 15 - s : s) * 512 + ch];
        oacc[DIR ? 15 - t : t] += o;
    }
    __syncthreads();
}

__device__ __forceinline__ void phase_conv_glapre(const Params& p, int l, unsigned char* lds) {
    conv_rows(p, l, obid() * 8 + (otid() >> 6), (int)gridDim.x * 8);
    float* sQ = (float*)lds; float* sK = sQ + 16 * 512; float* sV = sK + 16 * 512; float* sBq = sV + 16 * 512; float* sA = sBq + 16 * 512;
    const bf16_t* pb = (const bf16_t*)(ows(p) + WS_P); float* ointra = (float*)(ows(p) + WS_OINTRA);
    const int ch = otid();
    for (int chunk = obid(); chunk < NCHUNK; chunk += gridDim.x) {
        const int R0 = chunk * 16;
        float oacc[16];
#pragma unroll
        for (int i = 0; i < 16; ++i) oacc[i] = 0.f;
        __syncthreads();
#pragma unroll
        for (int ro = 0; ro < 16; ++ro) sV[ro * 512 + ch] = bf2f(pb[(size_t)(R0 + ro) * PW + OFF_I + ch]);
        gla_pre_dir<0>(p, l, chunk, sQ, sK, sV, sA, sBq, oacc);
        gla_pre_dir<1>(p, l, chunk, sQ, sK, sV, sA, sBq, oacc);
#pragma unroll
        for (int ro = 0; ro < 16; ++ro) ointra[(size_t)(R0 + ro) * 512 + ch] = oacc[ro];
    }
}

__device__ __forceinline__ void phase_gla_seq(const Params& p, int l, unsigned char* lds) {
    const int tid = otid();
    float* S = (float*)lds;
    float* sQ = S + 128 * 32;
    float* sKo = sQ + 16 * 128;
    float* sV = sKo + 16 * 128;
    float* sD = sV + 16 * 32;
    const bf16_t* pb = (const bf16_t*)(ows(p) + WS_P);
    const bf16_t* qin = (const bf16_t*)(ows(p) + WS_QIN); const bf16_t* kout = (const bf16_t*)(ows(p) + WS_KOUT); const float* dch = (const float*)(ows(p) + WS_DCH);
    float* ointer = (float*)(ows(p) + WS_OINTER);
    for (int u = obid(); u < 256; u += gridDim.x) {
        const int vblk = u & 3, dir = (u >> 2) & 1, chain = u >> 3, b = chain >> 2, h = chain & 3;
        __syncthreads();
        for (int i = tid; i < 128 * 32; i += 512) S[i] = 0.f;
        for (int c = 0; c < 144; ++c) {
            int R0;
            if (c < 16) { const int cm = dir ? 15 - c : c; R0 = NLAT + b * 256 + cm * 16; }
            else { const int cc = c - 16; const int cm = dir ? 127 - cc : cc; R0 = b * 2048 + cm * 16; }
            __syncthreads();
            for (int i = tid; i < 16 * 128; i += 512) {
                const int si = i >> 7, k = i & 127; const int row = R0 + (dir ? 15 - si : si);
                const size_t g = ((size_t)dir * NTOK + row) * 512 + h * 128 + k;
                sQ[i] = bf2f(qin[g]); sKo[i] = bf2f(kout[g]);
            }
            { const int si = tid >> 5, vv = tid & 31; const int row = R0 + (dir ? 15 - si : si); sV[tid] = bf2f(pb[(size_t)row * PW + OFF_I + h * 128 + vblk * 32 + vv]); }
            if (tid < 128) sD[tid] = dch[((size_t)dir * NCHUNK + (R0 >> 4)) * 512 + h * 128 + tid];
            __syncthreads();
            {
                const int si = tid >> 5, vv = tid & 31; const int row = R0 + (dir ? 15 - si : si);
                float o = 0.f;
                for (int k = 0; k < 128; ++k) o += sQ[si * 128 + k] * S[k * 32 + vv];
                ointer[((size_t)dir * NTOK + row) * 512 + h * 128 + vblk * 32 + vv] = o;
            }
            __syncthreads();
            {
                const int k = tid >> 2, v0 = (tid & 3) * 8; const float d = sD[k];
                float kk[16];
#pragma unroll
                for (int i = 0; i < 16; ++i) kk[i] = sKo[i * 128 + k];
#pragma unroll
                for (int j = 0; j < 8; ++j) {
                    float s = d * S[k * 32 + v0 + j];
#pragma unroll
                    for (int i = 0; i < 16; ++i) s += kk[i] * sV[i * 32 + v0 + j];
                    S[k * 32 + v0 + j] = s;
                }
            }
        }
    }
}


__device__ __forceinline__ float bflo(unsigned w) { return __uint_as_float(w << 16); }
__device__ __forceinline__ float bfhi(unsigned w) { return __uint_as_float(w & 0xffff0000u); }

template <int DIR>
__device__ __forceinline__ void gla_pre2_dir(const float (&q0a)[16], const float (&q1a)[16], const unsigned (&rz)[16], float lb0, float lb1, unsigned char* wl, unsigned char* rec,
                                             f32x4 (&oT)[8], int lane, int fr, int fq) {
    float bq0[16], bq1[16], kk0[16], kk1[16]; float b0 = 0.f, b1 = 0.f;
#pragma unroll
    for (int i = 0; i < 16; ++i) {
        const int t = DIR ? 15 - i : i;
        const float z0 = bflo(rz[t]), z1 = bfhi(rz[t]);
        const float sg0 = frcp(1.0f + __expf(-z0)), sg1 = frcp(1.0f + __expf(-z1));
        const float f0 = fmaxf(lb0 + (1.0f - lb0) * sg0, 1e-30f), f1 = fmaxf(lb1 + (1.0f - lb1) * sg1, 1e-30f);
        b0 += __logf(f0); b1 += __logf(f1); bq0[t] = b0; bq1[t] = b1; kk0[t] = 1.0f - f0; kk1[t] = 1.0f - f1;
    }
    const float bl0 = b0, bl1 = b1;
    unsigned kw0[8], kw1[8];
#pragma unroll
    for (int i = 0; i < 8; ++i) { kw0[i] = 0u; kw1[i] = 0u; }
#pragma unroll
    for (int t = 0; t < 16; ++t) {
        const float e0 = __expf(bq0[t]), e1 = __expf(bq1[t]);
        const float qi0 = q0a[t] * e0, qi1 = q1a[t] * e1;
        const float kt0 = kk0[t] * frcp(fmaxf(e0, 1.8e-35f)), kt1 = kk1[t] * frcp(fmaxf(e1, 1.8e-35f));
        const float ko0 = kk0[t] * __expf(bl0 - bq0[t]), ko1 = kk1[t] * __expf(bl1 - bq1[t]);
        *(unsigned*)(wl + t * 272 + lane * 4) = cvtpk(qi0, qi1);
        *(unsigned*)(wl + 4352 + t * 272 + lane * 4) = cvtpk(kt0, kt1);
        const unsigned kp = cvtpk(ko0, ko1);
        kw0[t >> 1] |= (kp & 0xffffu) << (16 * (t & 1)); kw1[t >> 1] |= (kp >> 16) << (16 * (t & 1));
    }
    {
        const int c0 = 2 * lane, c1 = c0 + 1;
        unsigned char* k0p = rec + 4096 + (c0 >> 4) * 512 + (c0 & 15) * 8; unsigned char* k1p = rec + 4096 + (c1 >> 4) * 512 + (c1 & 15) * 8;
#pragma unroll
        for (int g = 0; g < 4; ++g) { *(u32x2*)(k0p + g * 128) = (u32x2){kw0[2 * g], kw0[2 * g + 1]}; *(u32x2*)(k1p + g * 128) = (u32x2){kw1[2 * g], kw1[2 * g + 1]}; }
        float* dp = (float*)(rec + 8192) + c0; dp[0] = __expf(bl0); dp[1] = __expf(bl1);
    }
    LDS_WAIT();
#pragma unroll
    for (int s = 0; s < 4; ++s) {
        const u32x2 lo = *(const u32x2*)(wl + fr * 272 + (32 * s + 4 * fq) * 2), hi = *(const u32x2*)(wl + fr * 272 + (32 * s + 16 + 4 * fq) * 2);
        *(u32x4*)(rec + s * 1024 + lane * 16) = (u32x4){lo.x, lo.y, hi.x, hi.y};
    }
    f32x4 at = (f32x4){0.f, 0.f, 0.f, 0.f};
#pragma unroll
    for (int s = 0; s < 4; ++s) {
        const bf16x8 kf = *(const bf16x8*)(wl + 4352 + fr * 272 + (32 * s + 8 * fq) * 2);
        const bf16x8 qf = *(const bf16x8*)(wl + fr * 272 + (32 * s + 8 * fq) * 2);
        at = __builtin_amdgcn_mfma_f32_16x16x32_bf16(kf, qf, at, 0, 0, 0);
    }
#pragma unroll
    for (int r = 0; r < 4; ++r) { const int sp = 4 * fq + r; const bool keep = DIR ? (sp >= fr) : (sp <= fr); at[r] = keep ? at[r] : 0.f; }
    union { u32x2 u; s16x4 h; } bop; bop.u = (u32x2){cvtpk(at[0], at[1]), cvtpk(at[2], at[3])};
#pragma unroll
    for (int vb = 0; vb < 8; ++vb) {
        union { u32x2 u; s16x4 h; } aop; aop.u = *(const u32x2*)(wl + 8704 + (vb * 16 + fr) * 32 + 8 * fq);
        oT[vb] = __builtin_amdgcn_mfma_f32_16x16x16bf16_1k(aop.h, bop.h, oT[vb], 0, 0, 0);
    }
    LDS_WAIT();
}

__device__ __forceinline__ void phase_gla_pre2(const Params& p, int l, unsigned char* lds) {
    const int tid = otid(), lane = tid & 63, wid = __builtin_amdgcn_readfirstlane(tid >> 6), fr = lane & 15, fq = lane >> 4;
    unsigned char* wl = lds + wid * 12800;
    unsigned char* ws = ows(p);
    const bf16_t* pb = (const bf16_t*)(ws + WS_P); bf16_t* ointra = (bf16_t*)(ws + WS_OINTRA);
    float lb[2][2];
    {
        const float* hl = oin(p, 10);
#pragma unroll
        for (int d = 0; d < 2; ++d)
#pragma unroll
            for (int e = 0; e < 2; ++e) {
                const float* q = hl + (size_t)d * 4 * 512 + (2 * lane + e);
                lb[d][e] = 0.f; (void)q;
            }
    }
    for (int unit = wid * (int)gridDim.x + obid(); unit < NCHUNK * 4; unit += gridDim.x * 8) {
        const int chunk = unit >> 2, h = unit & 3, R0 = chunk * 16;
        {
            const float* hl = oin(p, 10);
#pragma unroll
            for (int d = 0; d < 2; ++d)
#pragma unroll
                for (int e = 0; e < 2; ++e) {
                    const float* q = hl + (size_t)d * 4 * 512 + h * 128 + 2 * lane + e;
                    const float z0 = q[0], z1 = q[512], z2 = q[1024], z3 = q[1536];
                    const float mx = fmaxf(fmaxf(z0, z1), fmaxf(z2, z3));
                    const float e0 = __expf(z0 - mx), e1 = __expf(z1 - mx), e2 = __expf(z2 - mx), e3 = __expf(z3 - mx);
                    lb[d][e] = ((l >= 1 ? e1 : 0.f) + (l >= 2 ? e2 : 0.f) + (l >= 3 ? e3 : 0.f)) / (e0 + e1 + e2 + e3);
                }
        }
        unsigned rq[16], rf[16], rb[16], rv[16];
#pragma unroll
        for (int t = 0; t < 16; ++t) {
            const bf16_t* base = pb + (size_t)(R0 + t) * PW + h * 128 + 2 * lane;
            rq[t] = *(const unsigned*)(base + OFF_Q); rf[t] = *(const unsigned*)(base + OFF_ZF); rb[t] = *(const unsigned*)(base + OFF_ZF + 512); rv[t] = *(const unsigned*)(base + OFF_I);
        }
        unsigned char* vrec = ws + WS_VREC + (size_t)(chunk * 4 + h) * VREC_BYTES;
        {
            unsigned w0[8], w1[8];
#pragma unroll
            for (int i = 0; i < 8; ++i) { w0[i] = (rv[2 * i] & 0xffffu) | (rv[2 * i + 1] << 16); w1[i] = (rv[2 * i] >> 16) | (rv[2 * i + 1] & 0xffff0000u); }
            const int c0 = 2 * lane, c1 = c0 + 1;
            unsigned char* v0p = vrec + (c0 >> 4) * 512 + (c0 & 15) * 8; unsigned char* v1p = vrec + (c1 >> 4) * 512 + (c1 & 15) * 8;
#pragma unroll
            for (int g = 0; g < 4; ++g) { *(u32x2*)(v0p + g * 128) = (u32x2){w0[2 * g], w0[2 * g + 1]}; *(u32x2*)(v1p + g * 128) = (u32x2){w1[2 * g], w1[2 * g + 1]}; }
            unsigned char* vl = wl + 8704 + c0 * 32;
            *(u32x4*)(vl) = (u32x4){w0[0], w0[1], w0[2], w0[3]}; *(u32x4*)(vl + 16) = (u32x4){w0[4], w0[5], w0[6], w0[7]};
            *(u32x4*)(vl + 32) = (u32x4){w1[0], w1[1], w1[2], w1[3]}; *(u32x4*)(vl + 48) = (u32x4){w1[4], w1[5], w1[6], w1[7]};
        }
        f32x4 oT[8];
#pragma unroll
        for (int vb = 0; vb < 8; ++vb) oT[vb] = (f32x4){0.f, 0.f, 0.f, 0.f};
        float q0a[16], q1a[16];
#pragma unroll
        for (int t = 0; t < 16; ++t) { q0a[t] = siluf(bflo(rq[t])); q1a[t] = siluf(bfhi(rq[t])); }
        gla_pre2_dir<0>(q0a, q1a, rf, lb[0][0], lb[0][1], wl, ws + WS_GREC + ((size_t)(0 * NCHUNK + chunk) * 4 + h) * REC_BYTES, oT, lane, fr, fq);
        gla_pre2_dir<1>(q0a, q1a, rb, lb[1][0], lb[1][1], wl, ws + WS_GREC + ((size_t)(1 * NCHUNK + chunk) * 4 + h) * REC_BYTES, oT, lane, fr, fq);
#pragma unroll
        for (int vb = 0; vb < 8; ++vb) *(u32x2*)(ointra + (size_t)(R0 + fr) * 512 + h * 128 + vb * 16 + 4 * fq) = (u32x2){cvtpk(oT[vb][0], oT[vb][1]), cvtpk(oT[vb][2], oT[vb][3])};
    }
}

constexpr int GR = 8, STG_BYTES = REC_BYTES + VREC_BYTES;
__device__ __forceinline__ int gla_chunk_of_step(int c, int b, int dir) {
    if (c < 16) { const int cm = dir ? 15 - c : c; return (NLAT + b * 256) / 16 + cm; }
    const int cc = c - 16; const int cm = dir ? 127 - cc : cc; return b * 128 + cm;
}
constexpr int SG_STEP = REC_BYTES + 2048, SG_GRP = 2 * SG_STEP, SG_NG = 6;
constexpr int SG_DUMP = SG_NG * SG_GRP;
constexpr int SG_FLAGS = LDS_MISC + 2048;
constexpr unsigned SG_SPIN = 1u << 22;
static_assert(SG_DUMP + 1024 <= LDS_MISC, "scan ring");
__device__ __forceinline__ void gla_scan_unit(const Params& p, int l, unsigned char* lds_, int chain, int vhalf) {
    LAS unsigned char* lds = (LAS unsigned char*)lds_;
    const int tid = otid(), lane = tid & 63, wid = __builtin_amdgcn_readfirstlane(tid >> 6), fr = lane & 15, fq = lane >> 4;
    unsigned char* ws = ows(p);
    const int b = chain >> 3, h = (chain >> 1) & 3, dir = chain & 1;
    volatile LAS unsigned* flg = (volatile LAS unsigned*)(lds + SG_FLAGS);
    __syncthreads();
    if (tid < 32) flg[tid] = 0u;
    __syncthreads();
    if (wid >= 4) {
        const int m = wid & 3;
        const unsigned char* grec = ws + WS_GREC + (size_t)dir * NCHUNK * 4 * REC_BYTES + (size_t)h * REC_BYTES + lane * 16;
        const unsigned char* vrec = ws + WS_VREC + (size_t)h * VREC_BYTES + vhalf * 2048 + lane * 16;
        const volatile LAS unsigned* dn = flg + 4 + (lane & 3);
#define GSEQ_ISSUE(gi) do { const int _g = (gi); _Pragma("unroll") for (int _j = 0; _j < 6; ++_j) { const int _p = m + 4 * _j; const bool _real = _p < 22; const int _s = _real ? _p / 11 : 0, _q = _real ? _p % 11 : 0; \
        const int _c = 2 * _g + _s; const int _cc = _c < 144 ? _c : 143; const int _ch = gla_chunk_of_step(_cc, b, dir); \
        const unsigned char* _src = (_q < 9) ? grec + (size_t)_ch * 4 * REC_BYTES + _q * 1024 : vrec + (size_t)_ch * 4 * VREC_BYTES + (_q - 9) * 1024; \
        const unsigned _dst = _real ? (unsigned)(_g % SG_NG) * SG_GRP + _s * SG_STEP + _q * 1024 : (unsigned)SG_DUMP; \
        __builtin_amdgcn_global_load_lds((const unsigned*)_src, (LAS unsigned*)(lds + _dst), 16, 0, 0); } } while (0)
#pragma unroll 1
        for (int g = 0; g < SG_NG - 1; ++g) GSEQ_ISSUE(g);
#pragma unroll 1
        for (int g = 0; g < 72; ++g) {
            asm volatile("s_waitcnt vmcnt(%0)" :: "n"((SG_NG - 2) * 6) : "memory");
            if (lane == 0) flg[m] = (unsigned)(g + 1);
            { unsigned sp = 0; while (__builtin_amdgcn_ballot_w64(*dn < (unsigned)g) != 0ull && ++sp < SG_SPIN) __builtin_amdgcn_s_sleep(1); asm volatile("" ::: "memory"); }
            GSEQ_ISSUE(g + SG_NG - 1);
        }
#undef GSEQ_ISSUE
    } else {
        const int vt = wid;
        bf16_t* ointer = (bf16_t*)(ws + WS_OINTER) + (size_t)dir * NTOK * 512 + h * 128 + (vhalf * 4 + vt) * 16 + fr;
        const volatile LAS unsigned* fl = flg + (lane & 3);
        f32x4 acc[8];
#pragma unroll
        for (int j = 0; j < 8; ++j) acc[j] = (f32x4){0.f, 0.f, 0.f, 0.f};
        union { u32x4 u; bf16x8 h; } sb[4];
#pragma unroll
        for (int j = 0; j < 4; ++j) sb[j].u = (u32x4){0u, 0u, 0u, 0u};
#pragma unroll 1
        for (int g = 0; g < 72; ++g) {
            { unsigned sp = 0; while (__builtin_amdgcn_ballot_w64(*fl < (unsigned)(g + 1)) != 0ull && ++sp < SG_SPIN) { } asm volatile("" ::: "memory"); }
#pragma unroll
            for (int s2 = 0; s2 < 2; ++s2) {
                const int c = 2 * g + s2;
                const LAS unsigned char* st = lds + (unsigned)(g % SG_NG) * SG_GRP + s2 * SG_STEP;
                const int chunk = gla_chunk_of_step(c, b, dir);
                bf16x8 qa[4]; f32x4 dv[8];
                union { u32x2 u; s16x4 h; } ka[8], vb;
#pragma unroll
                for (int j = 0; j < 4; ++j) qa[j] = *(const LAS bf16x8*)(st + j * 1024 + lane * 16);
                vb.u = *(const LAS u32x2*)(st + REC_BYTES + vt * 512 + lane * 8);
#pragma unroll
                for (int j = 0; j < 8; ++j) { ka[j].u = *(const LAS u32x2*)(st + 4096 + j * 512 + lane * 8); dv[j] = *(const LAS f32x4*)(st + 8192 + (j * 16 + 4 * fq) * 4); }
                f32x4 o0 = (f32x4){0.f, 0.f, 0.f, 0.f}, o1 = (f32x4){0.f, 0.f, 0.f, 0.f};
                o0 = __builtin_amdgcn_mfma_f32_16x16x32_bf16(qa[0], sb[0].h, o0, 0, 0, 0); o1 = __builtin_amdgcn_mfma_f32_16x16x32_bf16(qa[1], sb[1].h, o1, 0, 0, 0);
                o0 = __builtin_amdgcn_mfma_f32_16x16x32_bf16(qa[2], sb[2].h, o0, 0, 0, 0); o1 = __builtin_amdgcn_mfma_f32_16x16x32_bf16(qa[3], sb[3].h, o1, 0, 0, 0);
#pragma unroll
                for (int j = 0; j < 8; ++j) {
                    acc[j] = acc[j] * dv[j];
                    acc[j] = __builtin_amdgcn_mfma_f32_16x16x16bf16_1k(ka[j].h, vb.h, acc[j], 0, 0, 0);
                }
                const f32x4 os = o0 + o1;
                bf16_t* op = ointer + (size_t)(chunk * 16 + 4 * fq) * 512;
                { const unsigned w01 = cvtpk(os[0], os[1]), w23 = cvtpk(os[2], os[3]); op[0] = (bf16_t)(w01 & 0xffffu); op[512] = (bf16_t)(w01 >> 16); op[1024] = (bf16_t)(w23 & 0xffffu); op[1536] = (bf16_t)(w23 >> 16); }
#pragma unroll
                for (int j = 0; j < 4; ++j) sb[j].u = (u32x4){cvtpk(acc[2 * j][0], acc[2 * j][1]), cvtpk(acc[2 * j][2], acc[2 * j][3]), cvtpk(acc[2 * j + 1][0], acc[2 * j + 1][1]), cvtpk(acc[2 * j + 1][2], acc[2 * j + 1][3])};
            }
            asm volatile("s_waitcnt lgkmcnt(0)" ::: "memory");
            if (lane == 0) flg[4 + wid] = (unsigned)(g + 1);
        }
    }
    asm volatile("s_waitcnt vmcnt(0) lgkmcnt(0)" ::: "memory");
    __syncthreads();
}
__device__ __forceinline__ void phase_gla_seq2(const Params& p, int l, unsigned char* lds) {
    const int G = (int)gridDim.x, bid = obid();
    const int nscan = (G >= 256) ? 128 : G;
    for (int rep = 0; rep < ((DUPK == 50) ? 2 : 1); ++rep) {
        for (int r2 = 0; r2 < ((DUPK == 51) ? 2 : 1); ++r2)
        if (bid < nscan) for (int u = bid; u < 128; u += nscan) { const int x = u & 7, jj = u >> 3; gla_scan_unit(p, l, lds, x + 8 * (jj >> 1), jj & 1); }
        const int cg0 = (G == 256) ? l * CV_LAYER + CV_B : l * CV_ALL, cg1 = (G == 256) ? l * CV_LAYER + CV_B + CV_S : (l + 1) * CV_ALL;
        for (int r3 = 0; r3 < ((DUPK == 52) ? 2 : 1); ++r3)
        if (G > nscan) { if (bid >= nscan) { const int widx = (bid - nscan) * 8 + (otid() >> 6), nwv = (G - nscan) * 8; conv_rows(p, l, widx, nwv); convert_range(p, (float*)(lds + (otid() >> 6) * 16384), widx, nwv, cg0, cg1); } }
        else { const int widx = bid * 8 + (otid() >> 6), nwv = G * 8; __syncthreads(); conv_rows(p, l, widx, nwv); convert_range(p, (float*)(lds + (otid() >> 6) * 16384), widx, nwv, cg0, cg1); }
    }
}

__device__ __forceinline__ void phase_gla_post(const Params& p, int l) {
    const int lane = otid() & 63, wid = otid() >> 6;
    const bf16_t* pb = (const bf16_t*)(ows(p) + WS_P); bf16_t* yb = (bf16_t*)(ows(p) + WS_Y);
    const bf16_t* oi = (const bf16_t*)(ows(p) + WS_OINTRA); const bf16_t* oe = (const bf16_t*)(ows(p) + WS_OINTER);
    const float* hnw = oin(p, 11) + (size_t)l * 128;
    const int nrows = (l == DEPTH - 1) ? NLAT : NTOK;
    const int c0 = lane * 8;
    float hw[8];
#pragma unroll
    for (int j = 0; j < 8; ++j) hw[j] = hnw[(c0 + j) & 127];
    constexpr int PNB = 3;
    const int nwv = (int)gridDim.x * 8;
    for (int rb = obid() * 8 + wid; rb < nrows; rb += PNB * nwv) {
        u32x4 gw[PNB], wi[PNB], w1[PNB], w2[PNB];
#pragma unroll
        for (int q = 0; q < PNB; ++q) {
            int r = rb + q * nwv; if (r >= nrows) r = rb;
            gw[q] = *(const u32x4*)(pb + (size_t)r * PW + OFF_G + c0); wi[q] = *(const u32x4*)(oi + (size_t)r * 512 + c0);
            w1[q] = *(const u32x4*)(oe + (size_t)r * 512 + c0); w2[q] = *(const u32x4*)(oe + ((size_t)NTOK + r) * 512 + c0);
        }
#pragma unroll
        for (int q = 0; q < PNB; ++q) {
            const int r = rb + q * nwv;
            float o[8], t1[8], t2[8]; float ss = 0.f;
            unpack8(wi[q], o); unpack8(w1[q], t1); unpack8(w2[q], t2);
#pragma unroll
            for (int j = 0; j < 8; ++j) { o[j] += t1[j] + t2[j]; ss += o[j] * o[j]; }
            ss += __shfl_xor(ss, 1); ss += __shfl_xor(ss, 2); ss += __shfl_xor(ss, 4); ss += __shfl_xor(ss, 8);
            const float rstd = rsqrtf(ss * (1.0f / 128.0f) + EPS);
            float g[8]; unpack8(gw[q], g);
            float y[8];
#pragma unroll
            for (int j = 0; j < 8; ++j) y[j] = o[j] * rstd * hw[j] * siluf(g[j]);
            if (r < nrows) {
                if (G2_FP8) { u32x2 w8; w8.x = pk4_fp8(8.0f * y[0], 8.0f * y[1], 8.0f * y[2], 8.0f * y[3]); w8.y = pk4_fp8(8.0f * y[4], 8.0f * y[5], 8.0f * y[6], 8.0f * y[7]); *(u32x2*)((unsigned char*)yb + (size_t)r * 1024 + 512 + c0) = w8; }
                else { u32x4 w; w.x = pk2(y[0], y[1]); w.y = pk2(y[2], y[3]); w.z = pk2(y[4], y[5]); w.w = pk2(y[6], y[7]); *(u32x4*)(yb + (size_t)r * 1024 + 512 + c0) = w; }
            }
        }
    }
}

__device__ __forceinline__ void phase_gemm2(const Params& p, int l, unsigned char* lds) {
    const bf16_t* yb = (const bf16_t*)(ows(p) + WS_Y); const bf16_t* wt = (const bf16_t*)(ows(p) + WS_WOUT) + (size_t)l * 1024 * 1024;
    float* xws = (float*)(ows(p) + WS_X); const float* modv = (const float*)(ows(p) + WS_MOD);
    const int MT = ((l == DEPTH - 1) ? NLAT : NTOK) / 128; constexpr int NT = 8;
    for (int u = obid(); u < MT * NT; u += gridDim.x) {
        const int mt = u / NT, nt = u % NT;
        ARowPlain ar{yb + (size_t)mt * 128 * 1024, 1024};
        EpiRes ep{xws + (size_t)mt * 128 * 1024 + nt * 128, modv + (size_t)l * 9 * 6144 + 2 * 1024 + nt * 128, mt * 128};
        gemm128(lds, ar, wt + (size_t)nt * 128 * 1024, 1024, ep);
    }
}

__device__ __forceinline__ void phase_router(const Params& p, int l) {
    const int lane = otid() & 63, wid = otid() >> 6;
    const float* xws = (const float*)(ows(p) + WS_X); bf16_t* hb = (bf16_t*)(ows(p) + WS_H);
    const float* modv = (const float*)(ows(p) + WS_MOD); const float* nw = oin(p, 4) + (size_t)(l * 2 + 1) * 1024;
    const float* wrg = oin(p, 13) + (size_t)l * 1024 * 4; const float* wre = oin(p, 15) + (size_t)l * 1024 * 32;
    const float* brg = oin(p, 14) + l * 4; const float* bre = oin(p, 16) + l * 32;
    unsigned* cnt = (unsigned*)(ows(p) + WS_CTL) + CW_CNT + 64 * l;
    int* ltok = (int*)(ows(p) + WS_LTOK); float* lgate = (float*)(ows(p) + WS_LGATE);
    const int nrows = (l == DEPTH - 1) ? NLAT : NTOK;
    for (int r = obid() * 8 + wid; r < nrows; r += gridDim.x * 8) {
        const int mr = mod_row(r);
        float ss = 0.f;
#pragma unroll
        for (int j = 0; j < 4; ++j) { const f32x4 xv4 = *(const f32x4*)(xws + (size_t)r * 1024 + 4 * lane + 256 * j); ss += (xv4[0] * xv4[0] + xv4[1] * xv4[1]) + (xv4[2] * xv4[2] + xv4[3] * xv4[3]); }
        const float rstd = rsqrtf(wave_sum(ss) * (1.0f / 1024.0f) + EPS);
        const float* msh = modv + ((size_t)l * 9 + mr) * 6144 + 3 * 1024; const float* msc = msh + 1024;
        float lg[36];
#pragma unroll
        for (int i = 0; i < 36; ++i) lg[i] = 0.f;
#pragma unroll 1
        for (int j = 0; j < 4; ++j) {
            const int c = 4 * lane + 256 * j;
            const f32x4 xv4 = *(const f32x4*)(xws + (size_t)r * 1024 + c);
            const f32x4 w = *(const f32x4*)(nw + c), sh = *(const f32x4*)(msh + c), sc = *(const f32x4*)(msc + c);
            const f32x4 h = (xv4 * rstd * w) * (1.0f + sc) + sh;
            u32x2 o; o.x = pk2(h[0], h[1]); o.y = pk2(h[2], h[3]);
            *(u32x2*)(hb + (size_t)r * 1024 + c) = o;
#pragma unroll
            for (int e = 0; e < 4; ++e) {
                const float xv = h[e];
                const f32x4 wg = *(const f32x4*)(wrg + (size_t)(c + e) * 4);
                lg[0] += xv * wg[0]; lg[1] += xv * wg[1]; lg[2] += xv * wg[2]; lg[3] += xv * wg[3];
#pragma unroll
                for (int q = 0; q < 8; ++q) {
                    const f32x4 we = *(const f32x4*)(wre + (size_t)(c + e) * 32 + q * 4);
                    lg[4 + q * 4 + 0] += xv * we[0]; lg[4 + q * 4 + 1] += xv * we[1]; lg[4 + q * 4 + 2] += xv * we[2]; lg[4 + q * 4 + 3] += xv * we[3];
                }
            }
        }
#pragma unroll
        for (int i = 0; i < 36; ++i) lg[i] = wave_sum(lg[i]);
        float gl[4];
#pragma unroll
        for (int i = 0; i < 4; ++i) gl[i] = lg[i] + brg[i];
        int gsel = 0; float gmax = gl[0];
#pragma unroll
        for (int i = 1; i < 4; ++i) if (gl[i] > gmax) { gmax = gl[i]; gsel = i; }
        float gs = 0.f;
#pragma unroll
        for (int i = 0; i < 4; ++i) gs += __expf(gl[i] - gmax);
        const float pg = 1.0f / gs;
        float el[8];
#pragma unroll
        for (int j = 0; j < 8; ++j) {
            float t = lg[4 + j] + bre[j];
#pragma unroll
            for (int g = 1; g < 4; ++g) t = (gsel == g) ? (lg[4 + g * 8 + j] + bre[g * 8 + j]) : t;
            el[j] = t;
        }
        int i1 = 0; float v1 = el[0];
#pragma unroll
        for (int j = 1; j < 8; ++j) if (el[j] > v1) { v1 = el[j]; i1 = j; }
        int i2 = -1; float v2 = -3.0e38f;
#pragma unroll
        for (int j = 0; j < 8; ++j) if (j != i1 && el[j] > v2) { v2 = el[j]; i2 = j; }
        const float e2 = __expf(v2 - v1);
        const float g0 = pg / (1.0f + e2), g1 = pg * e2 / (1.0f + e2);
        if (lane == 0) {
            const int ea = gsel * 8 + i1, eb = gsel * 8 + i2;
            const unsigned pa = atomicAdd(cnt + ea, 1u); ltok[(size_t)ea * NTOK + pa] = r * 2 + 0; lgate[(size_t)ea * NTOK + pa] = g0;
            const unsigned pb2 = atomicAdd(cnt + eb, 1u); ltok[(size_t)eb * NTOK + pb2] = r * 2 + 1; lgate[(size_t)eb * NTOK + pb2] = g1;
        }
    }
}


__device__ __forceinline__ void phase_router2(const Params& p, int l, unsigned char* lds, bool commit) {
    const int tid = otid(), lane = tid & 63, wid = __builtin_amdgcn_readfirstlane(tid >> 6), fr = lane & 15, fq = lane >> 4;
    unsigned char* ws = ows(p);
    const bf16_t* xws = (const bf16_t*)(ws + WS_X); bf16_t* xw = (bf16_t*)(ws + WS_X); const bf16_t* dlt = (const bf16_t*)(ws + WS_DELTA); bf16_t* hb = (bf16_t*)(ws + WS_H);
    const float* modv = (const float*)(ws + WS_MOD); const float* nw = oin(p, 4) + (size_t)(l * 2 + 1) * 1024;
    const float* brg = oin(p, 14) + l * 4; const float* bre = oin(p, 16) + l * 32;
    unsigned* gcnt = (unsigned*)(ws + WS_CTL) + CW_CNT + 64 * 32 * l;
    int* ltok = (int*)(ws + WS_LTOK); float* lgate = (float*)(ws + WS_LGATE);
    constexpr int WPITCH = 2064, WBYTES = 48 * WPITCH;
    unsigned char* wl = lds;
    float* tile = (float*)(lds + WBYTES + wid * 3328);
    int* s_cnt = (int*)(lds + WBYTES + 8 * 3328); int* s_base = s_cnt + 32;
    int* s_e = s_base + 32; int* s_rank = s_e + 256; int* s_tok = s_rank + 256; float* s_gate = (float*)(s_tok + 256);
    __syncthreads();
    {
        const bf16_t* wrh = (const bf16_t*)(ws + WS_WRH) + (size_t)l * 48 * 1024;
        u32x4 wv[12];
#pragma unroll
        for (int j = 0; j < 12; ++j) { const int i = tid + 512 * j, r = i >> 7, c = i & 127; wv[j] = *(const u32x4*)(wrh + (size_t)r * 1024 + c * 8); }
#pragma unroll
        for (int j = 0; j < 12; ++j) { const int i = tid + 512 * j, r = i >> 7, c = i & 127; *(u32x4*)(wl + r * WPITCH + c * 16) = wv[j]; }
    }
    const int NG = ((l == DEPTH - 1) ? NLAT : NTOK) / 16;
    const int NWV = (int)gridDim.x * 8;
    for (int it = 0; it * NWV < NG; ++it) {
        const int g = it * NWV + wid * (int)gridDim.x + obid();
        __syncthreads();
        if (tid < 32) s_cnt[tid] = 0;
        if (tid < 256) s_e[tid] = -1;
        __syncthreads();
        if (g < NG) {
            const int R0 = g * 16, mr = mod_row(R0);
            float my_rstd = 0.f;
#pragma unroll
            for (int rb = 0; rb < 4; ++rb) {
                f32x4 xv[4][4]; u32x2 dl[4][4], xr[4][4];
#pragma unroll
                for (int rr = 0; rr < 4; ++rr)
#pragma unroll
                    for (int j = 0; j < 4; ++j) { xr[rr][j] = *(const u32x2*)(xws + (size_t)(R0 + rb * 4 + rr) * 1024 + 4 * lane + 256 * j); dl[rr][j] = *(const u32x2*)(dlt + (size_t)(R0 + rb * 4 + rr) * 1024 + 4 * lane + 256 * j); }
#pragma unroll
                for (int rr = 0; rr < 4; ++rr) {
#pragma unroll
                    for (int j = 0; j < 4; ++j) xv[rr][j] = unpk4_bf16(xr[rr][j]);
                    if (commit) {
#pragma unroll
                        for (int j = 0; j < 4; ++j) { xv[rr][j] += unpk4_bf16(dl[rr][j]); u32x2 o; o.x = cvtpk(xv[rr][j][0], xv[rr][j][1]); o.y = cvtpk(xv[rr][j][2], xv[rr][j][3]); *(u32x2*)(xw + (size_t)(R0 + rb * 4 + rr) * 1024 + 4 * lane + 256 * j) = o;
                            xv[rr][j] = unpk4_bf16(o); }
                    }
                    float ss = 0.f;
#pragma unroll
                    for (int j = 0; j < 4; ++j) ss += (xv[rr][j][0] * xv[rr][j][0] + xv[rr][j][1] * xv[rr][j][1]) + (xv[rr][j][2] * xv[rr][j][2] + xv[rr][j][3] * xv[rr][j][3]);
                    const float rs = rsqrtf(wave_sum(ss) * (1.0f / 1024.0f) + EPS);
                    my_rstd = (rb * 4 + rr == fr) ? rs : my_rstd;
                }
            }
            asm volatile("s_waitcnt vmcnt(0)" ::: "memory");
            const float* msh = modv + ((size_t)l * 9 + mr) * 6144 + 3 * 1024 + 8 * fq; const float* msc = msh + 1024; const float* nwp = nw + 8 * fq;
            const bf16_t* xrow = xws + (size_t)(R0 + fr) * 1024 + 8 * fq; bf16_t* hrow = hb + (size_t)(R0 + fr) * 1024 + 8 * fq; unsigned char* h8row = ws + WS_H8 + (size_t)(R0 + fr) * 1024 + 8 * fq;
            f32x4 acc[3];
#pragma unroll
            for (int nt = 0; nt < 3; ++nt) acc[nt] = (f32x4){0.f, 0.f, 0.f, 0.f};
#pragma unroll 1
            for (int kq = 0; kq < 8; ++kq) {
                u32x4 xab[4]; f32x4 pw[4][2], psh[4][2], psc[4][2];
#pragma unroll
                for (int u = 0; u < 4; ++u) { const int k = 128 * kq + 32 * u; xab[u] = *(const u32x4*)(xrow + k);
#pragma unroll
                    for (int q = 0; q < 2; ++q) { pw[u][q] = *(const f32x4*)(nwp + k + 4 * q); psh[u][q] = *(const f32x4*)(msh + k + 4 * q); psc[u][q] = *(const f32x4*)(msc + k + 4 * q); } }
#pragma unroll
                for (int u = 0; u < 4; ++u) {
                    const int k = 128 * kq + 32 * u;
                    float hv[8];
                    const f32x4 xaq[2] = {unpk4_bf16((u32x2){xab[u].x, xab[u].y}), unpk4_bf16((u32x2){xab[u].z, xab[u].w})};
#pragma unroll
                    for (int q = 0; q < 2; ++q) {
                        const f32x4 w = pw[u][q], sh = psh[u][q], sc = psc[u][q];
                        const f32x4 h = (xaq[q] * my_rstd * w) * (1.0f + sc) + sh;
                        hv[4 * q + 0] = h[0]; hv[4 * q + 1] = h[1]; hv[4 * q + 2] = h[2]; hv[4 * q + 3] = h[3];
                    }
                    union { u32x4 u; bf16x8 h; } ah, al;
                    ah.u = (u32x4){cvtpk(hv[0], hv[1]), cvtpk(hv[2], hv[3]), cvtpk(hv[4], hv[5]), cvtpk(hv[6], hv[7])};
                    float lv[8];
#pragma unroll
                    for (int q = 0; q < 4; ++q) { const unsigned w2 = q == 0 ? ah.u.x : q == 1 ? ah.u.y : q == 2 ? ah.u.z : ah.u.w; lv[2 * q] = hv[2 * q] - __uint_as_float(w2 << 16); lv[2 * q + 1] = hv[2 * q + 1] - __uint_as_float(w2 & 0xffff0000u); }
                    al.u = (u32x4){cvtpk(lv[0], lv[1]), cvtpk(lv[2], lv[3]), cvtpk(lv[4], lv[5]), cvtpk(lv[6], lv[7])};
                    if (MOE_FP8) { u32x2 h8; h8.x = pk4_fp8(hv[0], hv[1], hv[2], hv[3]); h8.y = pk4_fp8(hv[4], hv[5], hv[6], hv[7]); *(u32x2*)(h8row + k) = h8; }
                    else *(u32x4*)(hrow + k) = ah.u;
#pragma unroll
                    for (int nt = 0; nt < 3; ++nt) {
                        const bf16x8 bh = *(const bf16x8*)(wl + (nt * 16 + fr) * WPITCH + (k + 8 * fq) * 2);
                        acc[nt] = __builtin_amdgcn_mfma_f32_16x16x32_bf16(ah.h, bh, acc[nt], 0, 0, 0);
                        acc[nt] = __builtin_amdgcn_mfma_f32_16x16x32_bf16(al.h, bh, acc[nt], 0, 0, 0);
                    }
                }
            }
#pragma unroll
            for (int nt = 0; nt < 3; ++nt)
#pragma unroll
                for (int r = 0; r < 4; ++r) tile[(4 * fq + r) * 52 + nt * 16 + fr] = acc[nt][r];
            LDS_WAIT();
            if (lane < 16) {
                const float* lg = tile + lane * 52;
                float gl[4];
#pragma unroll
                for (int i = 0; i < 4; ++i) gl[i] = lg[i] + brg[i];
                int gsel = 0; float gmax = gl[0];
#pragma unroll
                for (int i = 1; i < 4; ++i) if (gl[i] > gmax) { gmax = gl[i]; gsel = i; }
                float gs = 0.f;
#pragma unroll
                for (int i = 0; i < 4; ++i) gs += __expf(gl[i] - gmax);
                const float pg = 1.0f / gs;
                float el[8];
#pragma unroll
                for (int j = 0; j < 8; ++j) el[j] = lg[4 + gsel * 8 + j] + bre[gsel * 8 + j];
                int i1 = 0; float v1 = el[0];
#pragma unroll
                for (int j = 1; j < 8; ++j) if (el[j] > v1) { v1 = el[j]; i1 = j; }
                int i2 = -1; float v2 = -3.0e38f;
#pragma unroll
                for (int j = 0; j < 8; ++j) if (j != i1 && el[j] > v2) { v2 = el[j]; i2 = j; }
                const float e2 = __expf(v2 - v1);
                const float g0 = pg / (1.0f + e2), g1 = pg * e2 / (1.0f + e2);
                const int ea = gsel * 8 + i1, eb = gsel * 8 + i2, slot = (wid * 16 + lane) * 2, r = R0 + lane;
                s_e[slot] = ea; s_rank[slot] = atomicAdd(&s_cnt[ea], 1); s_tok[slot] = r * 2; s_gate[slot] = g0;
                s_e[slot + 1] = eb; s_rank[slot + 1] = atomicAdd(&s_cnt[eb], 1); s_tok[slot + 1] = r * 2 + 1; s_gate[slot + 1] = g1;
            }
        }
        __syncthreads();
        if (tid < 32) { const int c = s_cnt[tid]; s_base[tid] = (c > 0 && commit) ? (int)atomicAdd(gcnt + 64 * tid, (unsigned)c) : 0; }
        __syncthreads();
        if (tid < 256) { const int e = s_e[tid]; if (e >= 0 && commit) { const size_t pos = (size_t)e * NTOK + s_base[e] + s_rank[tid]; ltok[pos] = s_tok[tid]; lgate[pos] = s_gate[tid]; } }
    }
}

__device__ __forceinline__ int moe_tables(const Params& p, int l, unsigned char* lds) {
    int* s_pref = (int*)(lds + LDS_MISC); int* s_cnt = s_pref + 40;
    unsigned* cnt = (unsigned*)(ows(p) + WS_CTL) + CW_CNT + 64 * l;
    __syncthreads();
    if (otid() == 0) {
        int acc = 0;
        for (int e = 0; e < NEXP; ++e) { const int c = (int)__hip_atomic_load(cnt + e, __ATOMIC_RELAXED, __HIP_MEMORY_SCOPE_AGENT); s_cnt[e] = c; s_pref[e] = acc; acc += (c + 127) >> 7; }
        s_pref[NEXP] = acc;
    }
    __syncthreads();
    return s_pref[NEXP];
}
__device__ __forceinline__ void phase_moe_gu(const Params& p, int l, unsigned char* lds) {
    const int T = moe_tables(p, l, lds);
    const int* s_pref = (const int*)(lds + LDS_MISC); const int* s_cnt = s_pref + 40;
    const bf16_t* hb = (const bf16_t*)(ows(p) + WS_H); bf16_t* hid = (bf16_t*)(ows(p) + WS_HID);
    const int* ltok = (const int*)(ows(p) + WS_LTOK);
    for (int u = obid(); u < T * 8; u += gridDim.x) {
        const int mtg = u >> 3, nt = u & 7;
        int e = 0;
        for (int q = 1; q < NEXP; ++q) if (s_pref[q] <= mtg) e = q;
        const int mt = mtg - s_pref[e]; const int nvalid = min(128, s_cnt[e] - mt * 128);
        ARowGather ar{hb, ltok + (size_t)e * NTOK + mt * 128, nvalid};
        EpiGU ep{hid + (size_t)mtg * 128 * 512 + nt * 64};
        gemm128(lds, ar, (const bf16_t*)(ows(p) + WS_WGU) + ((size_t)(l * 32 + e) * 1024 + nt * 128) * 1024, 1024, ep);
    }
}
__device__ __forceinline__ void phase_moe_down(const Params& p, int l, unsigned char* lds) {
    const int T = moe_tables(p, l, lds);
    const int* s_pref = (const int*)(lds + LDS_MISC); const int* s_cnt = s_pref + 40;
    const bf16_t* hid = (const bf16_t*)(ows(p) + WS_HID); bf16_t* yb = (bf16_t*)(ows(p) + WS_YB);
    const int* ltok = (const int*)(ows(p) + WS_LTOK); const float* lgate = (const float*)(ows(p) + WS_LGATE);
    for (int u = obid(); u < T * 8; u += gridDim.x) {
        const int mtg = u >> 3, nt = u & 7;
        int e = 0;
        for (int q = 1; q < NEXP; ++q) if (s_pref[q] <= mtg) e = q;
        const int mt = mtg - s_pref[e]; const int nvalid = min(128, s_cnt[e] - mt * 128);
        ARowPlain ar{hid + (size_t)mtg * 128 * 512, 512};
        EpiDown ep{yb + nt * 128, ltok + (size_t)e * NTOK + mt * 128, lgate + (size_t)e * NTOK + mt * 128, nvalid};
        gemm128(lds, ar, (const bf16_t*)(ows(p) + WS_WDN) + ((size_t)(l * 32 + e) * 1024 + nt * 128) * 512, 512, ep);
    }
}


#ifndef FAST_G1
#define FAST_G1 1
#endif
#ifndef FAST_G2
#define FAST_G2 1
#endif
#ifndef FAST_MOE
#define FAST_MOE 1
#endif
#ifndef FAST_GLA
#define FAST_GLA 1
#endif
#ifndef FAST_RT
#define FAST_RT 1
#endif
__device__ __forceinline__ void phase_gemm1_fast(const Params& p, int l, unsigned char* lds) {
    g8::DenseOrder S; S.init(NTOK / 256, PW / 256, (int)gridDim.x, obid(), (const bf16_t*)(ows(p) + WS_WIN) + (size_t)l * 4096 * 1024, 1024);
    g8::EpiP2 E{(bf16_t*)(ows(p) + WS_P)};
    g8::gemm_phase((LAS unsigned char*)lds, (const char*)(ows(p) + WS_H), 1024, S, E);
    if (gridDim.x == 256 && obid() >= 128) { __syncthreads(); convert_range(p, (float*)(lds + (otid() >> 6) * 16384), (obid() - 128) * 8 + (otid() >> 6), 128 * 8, l * CV_LAYER, l * CV_LAYER + CV_B); }
}
__device__ __forceinline__ void phase_gemm2_fast(const Params& p, int l, unsigned char* lds, float scl) {
    g8::DenseOrder S; g8::EpiDelta E{(bf16_t*)(ows(p) + WS_DELTA), (const float*)(ows(p) + WS_MOD) + (size_t)l * 9 * 6144 + 2 * 1024, scl};
    if (G2_FP8) {
        S.init(((l == DEPTH - 1) ? NLAT : NTOK) / 256, 4, (int)gridDim.x, obid(), ows(p) + WS_WOUT + (size_t)l * 1024 * 1024, 1024, 1);
        g8::gemm_phase8<0x7A7A7A7A, 0x7C7C7C7C>((LAS unsigned char*)lds, (const char*)(ows(p) + WS_Y), 1024, S, E);
    } else {
        S.init(((l == DEPTH - 1) ? NLAT : NTOK) / 256, 4, (int)gridDim.x, obid(), (const bf16_t*)(ows(p) + WS_WOUT) + (size_t)l * 1024 * 1024, 1024);
        g8::gemm_phase((LAS unsigned char*)lds, (const char*)(ows(p) + WS_Y), 1024, S, E);
    }
    if (gridDim.x == 256 && l < DEPTH - 1 && obid() >= 32 && scl != 0.0f) { __syncthreads(); convert_range(p, (float*)(lds + (otid() >> 6) * 16384), (obid() - 32) * 8 + (otid() >> 6), 224 * 8, l * CV_LAYER + CV_B + CV_S, (l + 1) * CV_LAYER); }
}
__device__ __forceinline__ int moe_tables256(const Params& p, int l, unsigned char* lds) {
    int* s_pref = (int*)(lds + LDS_MISC); int* s_cnt = s_pref + 40;
    unsigned* cnt = (unsigned*)(ows(p) + WS_CTL) + CW_CNT + 64 * 32 * l;
    __syncthreads();
    if (otid() < 64) {
        const int lane = otid();
        const int c = (lane < NEXP) ? (int)__hip_atomic_load(cnt + 64 * lane, __ATOMIC_RELAXED, __HIP_MEMORY_SCOPE_AGENT) : 0;
        const int t = (c + 255) >> 8; int incl = t;
#pragma unroll
        for (int d = 1; d < 32; d <<= 1) { const int o = __shfl_up(incl, d); if (lane >= d) incl += o; }
        if (lane < NEXP) { s_cnt[lane] = c; s_pref[lane] = incl - t; }
        if (lane == NEXP - 1) s_pref[NEXP] = incl;
    }
    __syncthreads();
    return s_pref[NEXP];
}
__device__ __forceinline__ void moe_setup(const Params& p, int l, unsigned char* lds) {
    const int T = moe_tables256(p, l, lds);
    const int* s_pref = (const int*)(lds + LDS_MISC); const int* s_cnt = s_pref + 40;
    int* utab = (int*)(lds + g8::MOE_UTAB); int* rtok = (int*)(lds + g8::MOE_RTOK); float* rgate = (float*)(lds + g8::MOE_RGATE);
    const int tid = otid(), G = (int)gridDim.x, c = obid();
    if (tid < 4 * NEXP) {
        const int i = tid >> 5, e = tid & 31; const int L = i * G + c; int* t = utab + i * 8;
        if (L < T * 4) {
            const int mtg = L >> 2;
            if (s_pref[e] <= mtg && mtg < s_pref[e + 1]) {
                const int mt = mtg - s_pref[e];
                t[0] = mtg; t[1] = L & 3; t[2] = e; t[3] = min(256, s_cnt[e] - mt * 256); t[4] = e * NTOK + mt * 256; t[5] = 1;
            }
        } else if (e == 0) { int z = 0; asm volatile("" : "+v"(z)); t[0] = z; t[1] = z; t[2] = z; t[3] = z; t[4] = z; t[5] = z; }
    }
    __syncthreads();
    const int* ltok = (const int*)(ows(p) + WS_LTOK); const float* lgate = (const float*)(ows(p) + WS_LGATE);
    {   int tk[2]; float gt[2];
#pragma unroll
        for (int j = 0; j < 2; ++j) { const int idx = tid + 512 * j, i = idx >> 8, r = idx & 255; const int* t = utab + i * 8; const bool ok = t[5] != 0 && r < t[3]; const int src = ok ? t[4] + r : 0;
            tk[j] = ltok[src]; gt[j] = lgate[src]; if (!ok) { tk[j] = 0; gt[j] = 0.f; } }
#pragma unroll
        for (int j = 0; j < 2; ++j) { rtok[tid + 512 * j] = tk[j]; rgate[tid + 512 * j] = gt[j]; }
    }
    __syncthreads();
}
__device__ __forceinline__ void phase_moe_gu_fast(const Params& p, int l, unsigned char* lds) {
    moe_setup(p, l, lds);
    g8::MoeOrder<true> S; S.utab = (const int*)(lds + g8::MOE_UTAB); S.rtok = (const int*)(lds + g8::MOE_RTOK); S.K = 1024;
    if (MOE_FP8) {
        S.W = (const char*)(ows(p) + WS_WGU8) + (size_t)l * 32 * 1024 * 1024; S.bpe = 1;
        g8::EpiGU8 E{ows(p) + WS_HID8};
        g8::gemm_phase8<0x7A7A7A7A, 0x7F7F7F7F>((LAS unsigned char*)lds, (const char*)(ows(p) + WS_H8), 1024, S, E);
    } else {
        S.W = (const char*)(ows(p) + WS_WGU) + (size_t)l * 32 * 1024 * 1024 * 2; S.bpe = 2;
        g8::EpiGU2 E{(bf16_t*)(ows(p) + WS_HID)};
        g8::gemm_phase((LAS unsigned char*)lds, (const char*)(ows(p) + WS_H), 1024, S, E);
    }
}
__device__ __forceinline__ void phase_moe_down_fast(const Params& p, int l, unsigned char* lds) {
    if (!(FAST_MOE && MOE_FP8) || DUPK == 10 || p.ph_hi - p.ph_lo == 1) moe_setup(p, l, lds);
    g8::MoeOrder<false> S; S.utab = (const int*)(lds + g8::MOE_UTAB); S.rtok = (const int*)(lds + g8::MOE_RTOK); S.K = 512;
    g8::EpiDown2 E{(bf16_t*)(ows(p) + WS_YB), (const int*)(lds + g8::MOE_RTOK), (const float*)(lds + g8::MOE_RGATE)};
    if (MOE_FP8) {
        S.W = (const char*)(ows(p) + WS_WDN8) + (size_t)l * 32 * 1024 * 512; S.bpe = 1;
        g8::EpiDown8 E8{ows(p) + WS_YB8, (const int*)(lds + g8::MOE_RTOK), (const float*)(lds + g8::MOE_RGATE)};
        g8::gemm_phase8<0x7B7B7B7B, 0x7E7E7E7E>((LAS unsigned char*)lds, (const char*)(ows(p) + WS_HID8), 512, S, E8);
    } else {
        S.W = (const char*)(ows(p) + WS_WDN) + (size_t)l * 32 * 1024 * 512 * 2; S.bpe = 2;
        g8::gemm_phase((LAS unsigned char*)lds, (const char*)(ows(p) + WS_HID), 512, S, E);
    }
}

__device__ __forceinline__ void phase_c(const Params& p, int l, unsigned char* lds) {
    phase_gla_pre2(p, l, lds);
}

__global__ void __launch_bounds__(512, 2) mk(Params p) {
    extern __shared__ __attribute__((aligned(16))) unsigned char lds[];
    const int lo = p.ph_lo, hi = p.ph_hi;
    volatile LAS unsigned* misc = (volatile LAS unsigned*)(lds + LDS_MISC + 1024);
    if (threadIdx.x < 4) misc[threadIdx.x] = 0u;
    __syncthreads();
    XcdBarrier bar; bar.bar = (unsigned*)(p.ws + WS_CTL) + CW_BAR; bar.x = 0; bar.st = misc;
    if (hi - lo > 1) bar = xcd_barrier_post((unsigned*)(p.ws + WS_CTL) + CW_BAR, misc);
#define IN(k) (lo <= (k) && (k) < hi)
#define SEAM(k) do { if (IN((k) + 1)) { xcd_barrier(bar); if (DUPK == 20) xcd_barrier(bar); } } while (0)
#define REP(kind) for (int _rep = 0; _rep < ((DUPK == (kind)) ? 2 : 1); ++_rep)
    if (IN(0)) { REP(0) phase_prologue(p, lds); SEAM(0); }
    if (IN(1)) { REP(1) phase_modreduce(p); SEAM(1); }
    for (int l = 0; l < DEPTH; ++l) {
        const int pb = 2 + 9 * l;
        if (IN(pb + 0)) { if (DUPK == 2) phase_norm1(p, l, (float)(lo > 1000)); phase_norm1(p, l, 1.0f); SEAM(pb + 0); }
        if (IN(pb + 1)) { REP(3) { if (FAST_G1) phase_gemm1_fast(p, l, lds); else phase_gemm1(p, l, lds); } SEAM(pb + 1); }
        if (IN(pb + 2)) { REP(4) { phase_c(p, l, lds); } SEAM(pb + 2); }
        if (IN(pb + 3)) { REP(5) { phase_gla_seq2(p, l, lds); } SEAM(pb + 3); }
        if (IN(pb + 4)) { REP(6) phase_gla_post(p, l); SEAM(pb + 4); }
        if (IN(pb + 5)) { if (DUPK == 7) phase_gemm2_fast(p, l, lds, (float)(lo > 1000)); phase_gemm2_fast(p, l, lds, 1.0f); SEAM(pb + 5); }
        if (IN(pb + 6)) { if (DUPK == 8) phase_router2(p, l, lds, lo > 1000); phase_router2(p, l, lds, true); SEAM(pb + 6); }
        if (IN(pb + 7)) { REP(9) { if (FAST_MOE) phase_moe_gu_fast(p, l, lds); else phase_moe_gu(p, l, lds); } SEAM(pb + 7); }
        if (IN(pb + 8)) { REP(10) { if (FAST_MOE) phase_moe_down_fast(p, l, lds); else phase_moe_down(p, l, lds); } SEAM(pb + 8); }
    }
    if (IN(NPH - 1)) { REP(11) phase_final(p); }
#undef IN
#undef SEAM
}

#ifndef MK_LAUNCHES
#define MK_LAUNCHES 1
#endif
extern "C" void kernel_launch(void* const* d_in, const int* in_sizes, int n_in, void* d_out, int out_size, void* d_ws, size_t ws_size, hipStream_t stream) {
    static int grid = 0;
    if (grid == 0) {
        int dev = 0, cus = 0;
        if (n_in != 20 || ws_size < WS_END) { fprintf(stderr, "kernel_launch: unexpected shapes (n_in %d, ws %zu < %zu)\n", n_in, ws_size, (size_t)WS_END); grid = -1; return; }
        if (hipGetDevice(&dev) != hipSuccess || hipDeviceGetAttribute(&cus, hipDeviceAttributeMultiprocessorCount, dev) != hipSuccess) { grid = -1; return; }
        if (hipFuncSetAttribute((const void*)mk, hipFuncAttributeMaxDynamicSharedMemorySize, LDS_BYTES) != hipSuccess) { fprintf(stderr, "kernel_launch: hipFuncSetAttribute failed\n"); grid = -1; return; }
        (void)hipGetLastError();
        grid = cus;
    }
    if (grid < 0) return;
    (void)hipMemsetAsync((char*)d_ws + WS_CTL, 0, CTL_BYTES, stream);
    Params p{};
    for (int i = 0; i < 20; ++i) p.in[i] = (const float*)d_in[i];
    p.out = (float*)d_out; p.ws = (unsigned char*)d_ws;
    if (MK_LAUNCHES == 1) { p.ph_lo = 0; p.ph_hi = NPH; hipLaunchKernelGGL(mk, dim3(grid), dim3(512), LDS_BYTES, stream, p); }
    else for (int ph = 0; ph < NPH; ++ph) { p.ph_lo = ph; p.ph_hi = ph + 1; hipLaunchKernelGGL(mk, dim3(grid), dim3(512), LDS_BYTES, stream, p); }
}
```

```cpp
#include <hip/hip_runtime.h>
#include <stdint.h>
#include <stdio.h>

typedef unsigned short bf16_t;
typedef short bf16x8 __attribute__((ext_vector_type(8)));
typedef float f32x4 __attribute__((ext_vector_type(4)));
typedef unsigned u32x4 __attribute__((ext_vector_type(4)));
typedef unsigned u32x2 __attribute__((ext_vector_type(2)));
typedef int i32x8 __attribute__((ext_vector_type(8)));
typedef int i32x4 __attribute__((ext_vector_type(4)));
typedef short s16x4 __attribute__((ext_vector_type(4)));
typedef float f32x2 __attribute__((ext_vector_type(2)));
#define LAS __attribute__((address_space(3)))
#define GAS __attribute__((address_space(1)))

#ifndef G2_FP8
#define G2_FP8 1
#endif
#ifndef DUPK
#define DUPK -1
#endif
#ifndef MOE_FP8
#define MOE_FP8 1
#endif
constexpr int D = 1024, NB = 8, SEQ = 2048, DEPTH = 4, CTXL = 256;
constexpr int NLAT = NB * SEQ, NCTX = NB * CTXL, NTOK = NLAT + NCTX;
constexpr int PW = 4096;
constexpr int OFF_B = 0, OFF_C = 512, OFF_HV = 1024, OFF_Q = 1536, OFF_ZF = 2048, OFF_I = 3072, OFF_G = 3584;
constexpr int NEXP = 32;
constexpr int NCHUNK = NTOK / 16;
constexpr float EPS = 1e-6f;
constexpr int NMODP = 16;
constexpr int CV_ALL = 32 * (16 * 32 + 8 * 32), CV_B = 128 * 8 * 7, CV_F = 224 * 8 * 6;
constexpr int CV_S = (4 * CV_ALL - 4 * CV_B - 3 * CV_F) / 4, CV_LAYER = CV_B + CV_S + CV_F;
static_assert(4 * CV_B + 4 * CV_S + 3 * CV_F == 4 * CV_ALL, "conversion schedule");
static_assert(CV_LAYER >= CV_ALL && 3 * CV_LAYER + CV_B + CV_S == 4 * CV_ALL, "conversion schedule");

constexpr size_t WS_CTL = 0, CTL_BYTES = 65536;
constexpr size_t WS_WIN = WS_CTL + CTL_BYTES;
constexpr size_t WS_WOUT = WS_WIN + (size_t)4 * 4096 * 1024 * 2;
constexpr size_t WS_WGU = WS_WOUT + (size_t)4 * 1024 * 1024 * 2;
constexpr size_t WS_WDN = WS_WGU + (size_t)4 * 32 * 1024 * 1024 * 2;
constexpr size_t WS_MODP = WS_WDN + (size_t)4 * 32 * 1024 * 512 * 2;
constexpr size_t WS_MOD = WS_MODP + (size_t)4 * NMODP * 9 * 6144 * 4;
constexpr size_t WS_X = WS_MOD + (size_t)4 * 9 * 6144 * 4;
constexpr size_t WS_H = WS_X + (size_t)NTOK * 1024 * 4;
constexpr size_t WS_P = WS_H + (size_t)NTOK * 1024 * 2;
constexpr size_t WS_Y = WS_P + (size_t)NTOK * 4096 * 2;
constexpr size_t WS_QIN = WS_Y + (size_t)NTOK * 1024 * 2;
constexpr size_t WS_KOUT = WS_QIN + (size_t)2 * NTOK * 512 * 2;
constexpr size_t WS_DCH = WS_KOUT + (size_t)2 * NTOK * 512 * 2;
constexpr size_t WS_OINTRA = WS_DCH + (size_t)2 * NCHUNK * 512 * 4;
constexpr size_t WS_OINTER = WS_OINTRA + (size_t)NTOK * 512 * 4;
constexpr size_t WS_LTOK = WS_OINTER + (size_t)2 * NTOK * 512 * 4;
constexpr size_t WS_LGATE = WS_LTOK + (size_t)32 * NTOK * 4;
constexpr int HID_ROWS = 2 * NTOK + 32 * 256;
constexpr size_t WS_HID = WS_LGATE + (size_t)32 * NTOK * 4;
constexpr size_t WS_YB = WS_HID + (size_t)HID_ROWS * 512 * 2;
constexpr int REC_BYTES = 9216, VREC_BYTES = 4096;
constexpr size_t WS_GREC = WS_YB + (size_t)2 * NTOK * 1024 * 2;
constexpr size_t WS_VREC = WS_GREC + (size_t)2 * NCHUNK * 4 * REC_BYTES;
constexpr size_t WS_WRH = WS_VREC + (size_t)NCHUNK * 4 * VREC_BYTES;
constexpr size_t WS_WRL = WS_WRH + (size_t)4 * 48 * 1024 * 2;
constexpr size_t WS_H8 = WS_WRL + (size_t)4 * 48 * 1024 * 2;
constexpr size_t WS_HID8 = WS_H8 + (size_t)NTOK * 1024;
constexpr size_t WS_WGU8 = WS_HID8 + (size_t)HID_ROWS * 512;
constexpr size_t WS_WDN8 = WS_WGU8 + (size_t)4 * 32 * 1024 * 1024;
constexpr size_t WS_YB8 = WS_WDN8 + (size_t)4 * 32 * 1024 * 512;
constexpr size_t WS_DELTA = WS_YB8 + (size_t)2 * NTOK * 1024;
constexpr size_t WS_END = WS_DELTA + (size_t)NTOK * 1024 * 2;
constexpr int CW_BAR = 0;
constexpr int CW_CNT = 8192;

constexpr int LDS_BYTES = 147456;
constexpr int LDS_MISC = 143360;
constexpr int NPH = 2 + 9 * DEPTH + 1;

__device__ __forceinline__ float bf2f(bf16_t b) { return __uint_as_float(((unsigned)b) << 16); }
__device__ __forceinline__ unsigned f2bf(float f) { unsigned u = __float_as_uint(f); return (u + 0x7fffu + ((u >> 16) & 1u)) >> 16; }
__device__ __forceinline__ unsigned pk2(float lo, float hi) { return f2bf(lo) | (f2bf(hi) << 16); }
__device__ __forceinline__ float wave_sum(float v) {
#pragma unroll
    for (int o = 1; o < 64; o <<= 1) v += __shfl_xor(v, o);
    return v;
}
__device__ __forceinline__ float frcp(float x) { return __builtin_amdgcn_rcpf(x); }
__device__ __forceinline__ float sigmoidf(float x) { return frcp(1.0f + __expf(-x)); }
__device__ __forceinline__ float siluf(float x) { return x * frcp(1.0f + __expf(-x)); }
__device__ __forceinline__ float clamp8(float v) { return __builtin_amdgcn_fmed3f(v, -416.0f, 416.0f); }
__device__ __forceinline__ unsigned pk4_fp8_raw(float a, float b, float c, float d) { int r = __builtin_amdgcn_cvt_pk_fp8_f32(a, b, 0, false); r = __builtin_amdgcn_cvt_pk_fp8_f32(c, d, r, true); return (unsigned)r; }
__device__ __forceinline__ unsigned pk4_fp8(float a, float b, float c, float d) { int r = __builtin_amdgcn_cvt_pk_fp8_f32(clamp8(a), clamp8(b), 0, false); r = __builtin_amdgcn_cvt_pk_fp8_f32(clamp8(c), clamp8(d), r, true); return (unsigned)r; }
__device__ __forceinline__ f32x4 unpk4_fp8(unsigned w) { const f32x2 lo = __builtin_amdgcn_cvt_pk_f32_fp8((int)w, false), hi = __builtin_amdgcn_cvt_pk_f32_fp8((int)w, true); return (f32x4){lo.x, lo.y, hi.x, hi.y}; }
typedef __bf16 bf16x2_t __attribute__((ext_vector_type(2)));
__device__ __forceinline__ f32x4 unpk4_bf16(u32x2 w) { return (f32x4){__uint_as_float(w.x << 16), __uint_as_float(w.x & 0xffff0000u), __uint_as_float(w.y << 16), __uint_as_float(w.y & 0xffff0000u)}; }
__device__ __forceinline__ unsigned cvtpk(float lo, float hi) { const f32x2 v = {lo, hi}; const bf16x2_t r = __builtin_convertvector(v, bf16x2_t); return __builtin_bit_cast(unsigned, r); }
__device__ __forceinline__ int mod_row(int r) { return r < NLAT ? (r >> 11) : 8; }
#define LDS_WAIT() asm volatile("s_waitcnt lgkmcnt(0)" ::: "memory")
__device__ __forceinline__ int otid() { int t = threadIdx.x; asm volatile("" : "+v"(t)); return t; }
__device__ __forceinline__ int obid() { int b = blockIdx.x; asm volatile("" : "+s"(b)); return b; }

#define XB_TMO      128
#define XB_XCNT(j)  (256  + 64 * (j))
#define XB_XSUB(j)  (1280 + 64 * (j))
#define XB_XGEN(j)  (2304 + 64 * (j))
#define XB_TOP      3328
#define XB_TOPGEN   3392
#define XCD_BAR_WORDS 3456
#define XB_SPIN_CAP (1u << 18)
__device__ __forceinline__ unsigned xb_ld(unsigned* p)              { return __hip_atomic_load(p, __ATOMIC_RELAXED, __HIP_MEMORY_SCOPE_AGENT); }
__device__ __forceinline__ unsigned xb_add(unsigned* p, unsigned v) { return __hip_atomic_fetch_add(p, v, __ATOMIC_RELAXED, __HIP_MEMORY_SCOPE_AGENT); }
__device__ __forceinline__ unsigned xb_xcc_id() { return (unsigned)__builtin_amdgcn_s_getreg((3 << 11) | 20) & 0xFu; }
#define XB_SPIN(cond, bar) do { unsigned _sp = 0; while (cond) { __builtin_amdgcn_s_sleep(1); \
    if ((++_sp & 255u) == 0u) { if (xb_ld(&(bar)[XB_TMO])) break; if (_sp > XB_SPIN_CAP) { atomicAdd(&(bar)[XB_TMO], 1u); break; } } } } while (0)
struct XcdBarrier { unsigned* bar; unsigned x; volatile LAS unsigned* st; };
__device__ __forceinline__ XcdBarrier xcd_barrier_post(unsigned* bar, volatile LAS unsigned* st) {
    XcdBarrier b; b.bar = bar; b.x = xb_xcc_id(); b.st = st;
    if (threadIdx.x == 0) (void)xb_add(&bar[XB_XCNT(b.x)], 1u);
    return b;
}
__device__ __forceinline__ void xcd_barrier_complete(unsigned* bar, unsigned x, unsigned& nloc, unsigned& nx) {
    const unsigned G = gridDim.x * gridDim.y * gridDim.z;
    unsigned sum, cnt, mine, sp = 0u;
    for (;;) {
        sum = 0u; cnt = 0u; mine = 0u;
#pragma unroll
        for (unsigned j = 0; j < 16; ++j) { const unsigned c = xb_ld(&bar[XB_XCNT(j)]); sum += c; cnt += (c > 0u) ? 1u : 0u; mine = (j == x) ? c : mine; }
        if (sum == G) break;
        __builtin_amdgcn_s_sleep(1);
        if ((++sp & 255u) == 0u) { if (xb_ld(&bar[XB_TMO])) break; if (sp > XB_SPIN_CAP) { atomicAdd(&bar[XB_TMO], 1u); break; } }
    }
    nloc = mine > 0u ? mine : 1u; nx = cnt > 0u ? cnt : 1u;
}
__device__ __forceinline__ void xcd_barrier(const XcdBarrier& b) {
    asm volatile("s_waitcnt vmcnt(0)" ::: "memory");
    __syncthreads();
    if (threadIdx.x == 0) {
        unsigned* bar = b.bar;
        __builtin_amdgcn_s_waitcnt(0);
        unsigned nloc = b.st[0], nx = b.st[1];
        if (nloc == 0u) { xcd_barrier_complete(bar, b.x, nloc, nx); b.st[0] = nloc; b.st[1] = nx; }
        const unsigned old = xb_add(&bar[XB_XSUB(b.x)], 1u);
        const unsigned gen = old / nloc;
        if (old + 1u == (gen + 1u) * nloc) {
            __builtin_amdgcn_fence(__ATOMIC_RELEASE, "agent");
            asm volatile("s_waitcnt vmcnt(0)" ::: "memory");
            const unsigned og = xb_add(&bar[XB_TOP], 1u);
            const unsigned tg = og / nx;
            if (og + 1u == (tg + 1u) * nx) xb_add(&bar[XB_TOPGEN], 1u);
            else XB_SPIN(xb_ld(&bar[XB_TOPGEN]) == tg, bar);
            __builtin_amdgcn_fence(__ATOMIC_ACQUIRE, "agent");
            xb_add(&bar[XB_XGEN(b.x)], 1u);
            asm volatile("s_waitcnt vmcnt(0)" ::: "memory");
        } else {
            XB_SPIN(xb_ld(&bar[XB_XGEN(b.x)]) == gen, bar);
            __builtin_amdgcn_fence(__ATOMIC_ACQUIRE, "agent");
            asm volatile("s_waitcnt vmcnt(0)" ::: "memory");
        }
    }
    __syncthreads();
}

struct Params {
    const float* in[20];
    float* out;
    unsigned char* ws;
    int ph_lo, ph_hi;
};

__device__ __forceinline__ unsigned char* ows(const Params& p) { GAS unsigned char* w = (GAS unsigned char*)p.ws; asm volatile("" : "+s"(w)); return (unsigned char*)w; }
__device__ __forceinline__ const float* oin(const Params& p, int k) { const GAS float* q = (const GAS float*)p.in[k]; asm volatile("" : "+s"(q)); return (const float*)q; }

template <class ARow, class Epi>
__device__ __forceinline__ void gemm128(unsigned char* lds, const ARow& arow, const bf16_t* __restrict__ Bt, int K, const Epi& epi) {
    const int tid = otid(), lane = tid & 63, wid = tid >> 6, wr = wid >> 2, wc = wid & 3, fr = lane & 15, fq = lane >> 4;
    bf16_t* sA = (bf16_t*)lds;
    bf16_t* sB = (bf16_t*)(lds + 128 * 144);
    f32x4 acc[4][2];
#pragma unroll
    for (int m = 0; m < 4; ++m)
#pragma unroll
        for (int n = 0; n < 2; ++n) acc[m][n] = (f32x4){0.f, 0.f, 0.f, 0.f};
    const bf16_t* ap[2]; const bf16_t* bp[2]; int so[2];
#pragma unroll
    for (int i = 0; i < 2; ++i) {
        const int q = tid + 512 * i, row = q >> 3, seg = q & 7;
        ap[i] = arow(row) + seg * 8; bp[i] = Bt + (size_t)row * K + seg * 8; so[i] = row * 72 + seg * 8;
    }
    for (int k0 = 0; k0 < K; k0 += 64) {
        u32x4 va[2], vb[2];
#pragma unroll
        for (int i = 0; i < 2; ++i) { va[i] = *(const u32x4*)(ap[i] + k0); vb[i] = *(const u32x4*)(bp[i] + k0); }
        __syncthreads();
#pragma unroll
        for (int i = 0; i < 2; ++i) { *(u32x4*)(sA + so[i]) = va[i]; *(u32x4*)(sB + so[i]) = vb[i]; }
        __syncthreads();
#pragma unroll
        for (int kk = 0; kk < 2; ++kk) {
            bf16x8 a[4], b[2];
#pragma unroll
            for (int m = 0; m < 4; ++m) a[m] = *(const bf16x8*)(sA + (wr * 64 + m * 16 + fr) * 72 + kk * 32 + fq * 8);
#pragma unroll
            for (int n = 0; n < 2; ++n) b[n] = *(const bf16x8*)(sB + (wc * 32 + n * 16 + fr) * 72 + kk * 32 + fq * 8);
#pragma unroll
            for (int m = 0; m < 4; ++m)
#pragma unroll
                for (int n = 0; n < 2; ++n) acc[m][n] = __builtin_amdgcn_mfma_f32_16x16x32_bf16(b[n], a[m], acc[m][n], 0, 0, 0);
        }
    }
#pragma unroll
    for (int m = 0; m < 4; ++m)
#pragma unroll
        for (int n = 0; n < 2; ++n) epi(wr * 64 + m * 16 + fr, wc * 32 + n * 16 + fq * 4, acc[m][n]);
    __syncthreads();
}

struct ARowPlain { const bf16_t* A; int ld; __device__ __forceinline__ const bf16_t* operator()(int i) const { return A + (size_t)i * ld; } };
struct ARowGather { const bf16_t* A; const int* tok; int nvalid; __device__ __forceinline__ const bf16_t* operator()(int i) const { const int t = (i < nvalid) ? (tok[i] >> 1) : 0; return A + (size_t)t * 1024; } };

struct EpiP { bf16_t* P; __device__ __forceinline__ void operator()(int r, int c, f32x4 v) const {
    u32x2 w; w.x = pk2(v[0], v[1]); w.y = pk2(v[2], v[3]); *(u32x2*)(P + (size_t)r * PW + c) = w; } };
struct EpiRes { float* X; const float* gate; int m0; __device__ __forceinline__ void operator()(int r, int c, f32x4 v) const {
    const float* g = gate + (size_t)mod_row(m0 + r) * 6144 + c; float* xp = X + (size_t)r * 1024 + c;
    f32x4 x = *(f32x4*)xp; const f32x4 gv = *(const f32x4*)g; x += gv * v; *(f32x4*)xp = x; } };
struct EpiGU { bf16_t* H; __device__ __forceinline__ void operator()(int r, int c, f32x4 v) const {
    const float h0 = siluf(v[0]) * v[1], h1 = siluf(v[2]) * v[3]; *(unsigned*)(H + (size_t)r * 512 + (c >> 1)) = pk2(h0, h1); } };
struct EpiDown { bf16_t* YB; const int* tok; const float* gate; int nvalid; __device__ __forceinline__ void operator()(int r, int c, f32x4 v) const {
    if (r < nvalid) { const int e = tok[r]; const float g = gate[r]; u32x2 w; w.x = pk2(g * v[0], g * v[1]); w.y = pk2(g * v[2], g * v[3]); *(u32x2*)(YB + (size_t)e * 1024 + c) = w; } } };


namespace g8 {
constexpr int BM = 256, BK = 64, HALF = 128, HTB = HALF * BK * 2, NXCD = 8, WGM = 8;
__device__ __forceinline__ int lds_byte(int r, int c) { const int st = (r >> 4) * 2 + (c >> 5), rr = r & 15, cc = c & 31, ob = rr * 64 + cc * 2; return st * 1024 + (ob ^ (((ob >> 9) & 1) << 5)); }
__device__ __forceinline__ void stage_rc(int b, int& R, int& C) { const int st = b / 1024, sb = b % 1024, swz = sb ^ (((sb >> 9) & 1) << 5); R = (st >> 1) * 16 + swz / 64; C = (st & 1) * 32 + (swz % 64) / 2; }
__device__ __forceinline__ int perm32(int rho) { const int n = rho >> 4, i = rho & 15; return 8 * (i >> 2) + 4 * n + (i & 3); }
__device__ __forceinline__ unsigned cvt_pk_bf16(float lo, float hi) { return cvtpk(lo, hi); }

__device__ __forceinline__ int g8_ra(int tid, int i) { int R, C; stage_rc(tid * 16 + i * 8192, R, C); return R; }
__device__ __forceinline__ unsigned g8_ca(int tid, int i) { int R, C; stage_rc(tid * 16 + i * 8192, R, C); return (unsigned)C * 2u; }
#define G8_RA(i) g8_ra(otid(), (i))
#define G8_CA(i) g8_ca(otid(), (i))
template <class Epi, class Sched>
__device__ __forceinline__ void gemm_phase(LAS unsigned char* lds, const char* Abase, const int K, const Sched& S, const Epi& E) {
    const int tid = otid(), wid = __builtin_amdgcn_readfirstlane(tid >> 6), lane = tid & 63, wr = wid >> 2, wc = wid & 3, fr = lane & 15, fq = lane >> 4;
    const int nt = K / BK;
    unsigned voffB[2];
#pragma unroll
    for (int i = 0; i < 2; ++i) { int R, C; stage_rc(tid * 16 + i * 8192, R, C); const int Rb = Epi::PERM ? ((R & ~31) + perm32(R & 31)) : R;
        voffB[i] = (unsigned)(Rb * K + C) * 2u; }
    const unsigned rowb = (unsigned)K * 2u;
    const size_t kstep = (size_t)(BK * 2);
    const size_t hstep = (size_t)HALF * K * 2;
    const unsigned ldsw = (unsigned)wid * 1024u;
    const int aoff = lds_byte(wr * 64 + fr, fq * 8), boff = lds_byte(wc * 32 + fr, fq * 8);
#define G8_SA(b, h) (((b) * 2 + (h)) * HTB)
#define G8_SB(b, h) ((4 + (b) * 2 + (h)) * HTB)
#define G8_STAGE(bufoff, gbase, voff) do { _Pragma("unroll") for (int _i = 0; _i < 2; ++_i) \
        __builtin_amdgcn_global_load_lds((const unsigned*)((const char*)(gbase) + (voff)[_i]), (LAS unsigned*)(lds + (bufoff) + ldsw + _i * 8192), 16, 0, 0); } while (0)
#define G8_LDA(dst, b, h) do { _Pragma("unroll") for (int m = 0; m < 4; ++m) _Pragma("unroll") for (int k = 0; k < 2; ++k) dst[m][k] = *(const LAS bf16x8*)(lds + G8_SA(b, h) + aoff + m * 2048 + k * 1024); } while (0)
#define G8_LDB(dst, b, h) do { _Pragma("unroll") for (int n = 0; n < 2; ++n) _Pragma("unroll") for (int k = 0; k < 2; ++k) dst[n][k] = *(const LAS bf16x8*)(lds + G8_SB(b, h) + boff + n * 2048 + k * 1024); } while (0)
#define G8_MMA(ai, bj, At, Bt) do { __builtin_amdgcn_s_setprio(1); _Pragma("unroll") for (int m = 0; m < 4; ++m) _Pragma("unroll") for (int n = 0; n < 2; ++n) _Pragma("unroll") for (int k = 0; k < 2; ++k) \
        acc[ai][bj][m][n] = __builtin_amdgcn_mfma_f32_16x16x32_bf16(Bt[n][k], At[m][k], acc[ai][bj][m][n], 0, 0, 0); __builtin_amdgcn_s_setprio(0); } while (0)
#define G8_WAIT_V(n) asm volatile("s_waitcnt vmcnt(" #n ")" ::: "memory")
#define G8_WAIT_L(n) asm volatile("s_waitcnt lgkmcnt(" #n ")" ::: "memory")
#define G8_BAR __builtin_amdgcn_s_barrier()
#define G8_SCHED __builtin_amdgcn_sched_barrier(0)
    typename Sched::Unit cur, nxt; int ui = 0;
    if (!S.next(0, cur)) return;
    f32x4 acc[2][2][4][2];
#pragma unroll
    for (int a = 0; a < 2; ++a)
#pragma unroll
        for (int b = 0; b < 2; ++b)
#pragma unroll
            for (int m = 0; m < 4; ++m)
#pragma unroll
                for (int n = 0; n < 2; ++n) acc[a][b][m][n] = (f32x4){0.f, 0.f, 0.f, 0.f};
    bf16x8 At[4][2], B0[2][2], B1[2][2];
    unsigned vAc[2][2], vAn[2][2];
#pragma unroll
    for (int h = 0; h < 2; ++h)
#pragma unroll
        for (int i = 0; i < 2; ++i) vAc[h][i] = (Sched::AFFINE ? (unsigned)(h * HALF + G8_RA(i)) : (unsigned)S.a_row(cur, h * HALF + G8_RA(i))) * rowb + G8_CA(i);
    const char* cA = Sched::AFFINE ? Abase + (size_t)S.a_row(cur, 0) * rowb : Abase;
    const char* cB = S.b_base(cur);
    G8_STAGE(G8_SB(0, 0), cB, voffB); G8_STAGE(G8_SA(0, 0), cA, vAc[0]); G8_STAGE(G8_SB(0, 1), cB + hstep, voffB); G8_STAGE(G8_SA(0, 1), cA, vAc[1]);
    if (wr == 1) G8_BAR;
    G8_WAIT_V(4); G8_BAR;
    G8_STAGE(G8_SB(1, 0), cB + kstep, voffB); G8_STAGE(G8_SA(1, 0), cA + kstep, vAc[0]); G8_STAGE(G8_SB(1, 1), cB + hstep + kstep, voffB);
    G8_WAIT_V(6); G8_BAR;
    for (;;) {
        const bool has_next = S.next(ui + 1, nxt);
#pragma unroll
        for (int h = 0; h < 2; ++h)
#pragma unroll
            for (int i = 0; i < 2; ++i) vAn[h][i] = (has_next && !Sched::AFFINE) ? ((unsigned)S.a_row(nxt, h * HALF + G8_RA(i)) * rowb + G8_CA(i)) : vAc[h][i];
        const char* nA = (has_next && Sched::AFFINE) ? Abase + (size_t)S.a_row(nxt, 0) * rowb : cA;
        const char* nB = has_next ? S.b_base(nxt) : cB;
        for (int t = 0; t < nt; t += 2) {
            const bool last = (t == nt - 2);
            const char* a1 = cA + (size_t)(t + 1) * kstep;
            const char* a2 = last ? nA : cA + (size_t)(t + 2) * kstep; const char* b2 = last ? nB : cB + (size_t)(t + 2) * kstep;
            const char* a3 = a2 + kstep; const char* b3 = b2 + kstep;
            unsigned v2[2][2];
#pragma unroll
            for (int h = 0; h < 2; ++h)
#pragma unroll
                for (int i = 0; i < 2; ++i) v2[h][i] = last ? vAn[h][i] : vAc[h][i];
            G8_LDB(B0, 0, 0); G8_SCHED; G8_LDA(At, 0, 0); G8_STAGE(G8_SA(1, 1), a1, vAc[1]);
            G8_WAIT_L(8); G8_BAR; G8_WAIT_L(0); G8_MMA(0, 0, At, B0); G8_BAR; G8_SCHED;
            G8_LDB(B1, 0, 1); G8_STAGE(G8_SB(0, 0), b2, voffB);
            G8_BAR; G8_WAIT_L(0); G8_MMA(0, 1, At, B1); G8_BAR;
            G8_LDA(At, 0, 1); G8_STAGE(G8_SA(0, 0), a2, v2[0]);
            G8_BAR; G8_WAIT_L(0); G8_MMA(1, 0, At, B0); G8_BAR; G8_SCHED;
            G8_STAGE(G8_SB(0, 1), b2 + hstep, voffB);
            G8_WAIT_V(6); G8_BAR; G8_MMA(1, 1, At, B1); G8_BAR;
            G8_LDB(B0, 1, 0); G8_SCHED; G8_LDA(At, 1, 0); G8_STAGE(G8_SA(0, 1), a2, v2[1]);
            G8_WAIT_L(8); G8_BAR; G8_WAIT_L(0); G8_MMA(0, 0, At, B0); G8_BAR; G8_SCHED;
            G8_LDB(B1, 1, 1); G8_STAGE(G8_SB(1, 0), b3, voffB);
            G8_BAR; G8_WAIT_L(0); G8_MMA(0, 1, At, B1); G8_BAR;
            G8_LDA(At, 1, 1); G8_STAGE(G8_SA(1, 0), a3, v2[0]);
            G8_BAR; G8_WAIT_L(0); G8_MMA(1, 0, At, B0); G8_BAR; G8_SCHED;
            G8_STAGE(G8_SB(1, 1), b3 + hstep, voffB);
            G8_WAIT_V(6); G8_BAR; G8_MMA(1, 1, At, B1); G8_BAR;
        }
        E(acc, cur, wr, wc, fr, fq);
        if (!has_next) break;
#pragma unroll
        for (int a = 0; a < 2; ++a)
#pragma unroll
            for (int b = 0; b < 2; ++b)
#pragma unroll
                for (int m = 0; m < 4; ++m)
#pragma unroll
                    for (int n = 0; n < 2; ++n) acc[a][b][m][n] = (f32x4){0.f, 0.f, 0.f, 0.f};
        cur = nxt; cB = nB; cA = nA; ++ui;
#pragma unroll
        for (int h = 0; h < 2; ++h)
#pragma unroll
            for (int i = 0; i < 2; ++i) vAc[h][i] = vAn[h][i];
    }
    G8_WAIT_V(0);
    if (wr == 0) G8_BAR;
    G8_BAR;
#undef G8_SA
#undef G8_SB
#undef G8_STAGE
#undef G8_LDA
#undef G8_LDB
#undef G8_MMA
#undef G8_WAIT_V
#undef G8_WAIT_L
#undef G8_BAR
#undef G8_SCHED
}

template <int sclW, int sclA, class Epi, class Sched>
__device__ __forceinline__ void gemm_phase8(LAS unsigned char* lds, const char* Abase, const int K, const Sched& S, const Epi& E) {
    const int tid = otid(), wid = __builtin_amdgcn_readfirstlane(tid >> 6), lane = tid & 63, wr = wid >> 2, wc = wid & 3, fr = lane & 15, fq = lane >> 4;
    const int nt = K / 128;
    unsigned voffB[2];
#pragma unroll
    for (int i = 0; i < 2; ++i) { int R, C; stage_rc(tid * 16 + i * 8192, R, C); const int Rb = Epi::PERM ? ((R & ~31) + perm32(R & 31)) : R;
        voffB[i] = (unsigned)(Rb * K) + (unsigned)C * 2u; }
    const unsigned rowb = (unsigned)K;
    const size_t kstep = (size_t)(BK * 2);
    const size_t hstep = (size_t)HALF * K;
    const unsigned ldsw = (unsigned)wid * 1024u;
    const int fob = fr * 64 + ((2 * (fq & 1)) ^ (2 * (fr >> 3))) * 16 + (fq >> 1) * 1024;
    const int aoff = ((wr * 64) >> 4) * 2048 + fob, boff = ((wc * 32) >> 4) * 2048 + fob;
#define G8_SA(b, h) (((b) * 2 + (h)) * HTB)
#define G8_SB(b, h) ((4 + (b) * 2 + (h)) * HTB)
#define G8_STAGE(bufoff, gbase, voff) do { _Pragma("unroll") for (int _i = 0; _i < 2; ++_i) \
        __builtin_amdgcn_global_load_lds((const unsigned*)((const char*)(gbase) + (voff)[_i]), (LAS unsigned*)(lds + (bufoff) + ldsw + _i * 8192), 16, 0, 0); } while (0)
#define G8_LDA(dst, b, h) do { _Pragma("unroll") for (int m = 0; m < 4; ++m) { const i32x4 _lo = *(const LAS i32x4*)(lds + G8_SA(b, h) + aoff + m * 2048), _hi = *(const LAS i32x4*)(lds + G8_SA(b, h) + aoff + m * 2048 + 16); dst[m] = __builtin_shufflevector(_lo, _hi, 0, 1, 2, 3, 4, 5, 6, 7); } } while (0)
#define G8_LDB(dst, b, h) do { _Pragma("unroll") for (int n = 0; n < 2; ++n) { const i32x4 _lo = *(const LAS i32x4*)(lds + G8_SB(b, h) + boff + n * 2048), _hi = *(const LAS i32x4*)(lds + G8_SB(b, h) + boff + n * 2048 + 16); dst[n] = __builtin_shufflevector(_lo, _hi, 0, 1, 2, 3, 4, 5, 6, 7); } } while (0)
#define G8_MMA(ai, bj, At, Bt) do { __builtin_amdgcn_s_setprio(1); _Pragma("unroll") for (int m = 0; m < 4; ++m) _Pragma("unroll") for (int n = 0; n < 2; ++n) \
        acc[ai][bj][m][n] = __builtin_amdgcn_mfma_scale_f32_16x16x128_f8f6f4(Bt[n], At[m], acc[ai][bj][m][n], 0, 0, 0, sclW, 0, sclA); \
        _Pragma("unroll") for (int m = 0; m < 4; ++m) asm volatile("" : "+v"(acc[ai][bj][m][0]), "+v"(acc[ai][bj][m][1]));   \
        __builtin_amdgcn_s_setprio(0); } while (0)
#define G8_WAIT_V(n) asm volatile("s_waitcnt vmcnt(" #n ")" ::: "memory")
#define G8_WAIT_L(n) asm volatile("s_waitcnt lgkmcnt(" #n ")" ::: "memory")
#define G8_BAR __builtin_amdgcn_s_barrier()
#define G8_SCHED __builtin_amdgcn_sched_barrier(0)
    typename Sched::Unit cur, nxt; int ui = 0;
    if (!S.next(0, cur)) return;
    f32x4 acc[2][2][4][2];
#pragma unroll
    for (int a = 0; a < 2; ++a)
#pragma unroll
        for (int b = 0; b < 2; ++b)
#pragma unroll
            for (int m = 0; m < 4; ++m)
#pragma unroll
                for (int n = 0; n < 2; ++n) acc[a][b][m][n] = (f32x4){0.f, 0.f, 0.f, 0.f};
    i32x8 At[4], B0[2], B1[2];
    unsigned vAc[2][2], vAn[2][2];
#pragma unroll
    for (int h = 0; h < 2; ++h)
#pragma unroll
        for (int i = 0; i < 2; ++i) vAc[h][i] = (Sched::AFFINE ? (unsigned)(h * HALF + G8_RA(i)) : (unsigned)S.a_row(cur, h * HALF + G8_RA(i))) * rowb + G8_CA(i);
    const char* cA = Sched::AFFINE ? Abase + (size_t)S.a_row(cur, 0) * rowb : Abase;
    const char* cB = S.b_base(cur);
    G8_STAGE(G8_SB(0, 0), cB, voffB); G8_STAGE(G8_SA(0, 0), cA, vAc[0]); G8_STAGE(G8_SB(0, 1), cB + hstep, voffB); G8_STAGE(G8_SA(0, 1), cA, vAc[1]);
    if (wr == 1) G8_BAR;
    G8_WAIT_V(4); G8_BAR;
    G8_STAGE(G8_SB(1, 0), cB + kstep, voffB); G8_STAGE(G8_SA(1, 0), cA + kstep, vAc[0]); G8_STAGE(G8_SB(1, 1), cB + hstep + kstep, voffB);
    G8_WAIT_V(6); G8_BAR;
    for (;;) {
        const bool has_next = S.next(ui + 1, nxt);
#pragma unroll
        for (int h = 0; h < 2; ++h)
#pragma unroll
            for (int i = 0; i < 2; ++i) vAn[h][i] = (has_next && !Sched::AFFINE) ? ((unsigned)S.a_row(nxt, h * HALF + G8_RA(i)) * rowb + G8_CA(i)) : vAc[h][i];
        const char* nA = (has_next && Sched::AFFINE) ? Abase + (size_t)S.a_row(nxt, 0) * rowb : cA;
        const char* nB = has_next ? S.b_base(nxt) : cB;
#pragma unroll 1
        for (int t = 0; t < nt; t += 2) {
            const bool last = (t == nt - 2);
            const char* a1 = cA + (size_t)(t + 1) * kstep;
            const char* a2 = last ? nA : cA + (size_t)(t + 2) * kstep; const char* b2 = last ? nB : cB + (size_t)(t + 2) * kstep;
            const char* a3 = a2 + kstep; const char* b3 = b2 + kstep;
            unsigned v2[2][2];
#pragma unroll
            for (int h = 0; h < 2; ++h)
#pragma unroll
                for (int i = 0; i < 2; ++i) v2[h][i] = last ? vAn[h][i] : vAc[h][i];
            G8_LDB(B0, 0, 0); G8_SCHED; G8_LDA(At, 0, 0); G8_STAGE(G8_SA(1, 1), a1, vAc[1]);
            G8_WAIT_L(8); G8_BAR; G8_WAIT_L(0); G8_MMA(0, 0, At, B0); G8_BAR; G8_SCHED;
            G8_LDB(B1, 0, 1); G8_STAGE(G8_SB(0, 0), b2, voffB);
            G8_BAR; G8_WAIT_L(0); G8_MMA(0, 1, At, B1); G8_BAR;
            G8_LDA(At, 0, 1); G8_STAGE(G8_SA(0, 0), a2, v2[0]);
            G8_BAR; G8_WAIT_L(0); G8_MMA(1, 0, At, B0); G8_BAR; G8_SCHED;
            G8_STAGE(G8_SB(0, 1), b2 + hstep, voffB);
            G8_WAIT_V(6); G8_BAR; G8_MMA(1, 1, At, B1); G8_BAR;
            G8_LDB(B0, 1, 0); G8_SCHED; G8_LDA(At, 1, 0); G8_STAGE(G8_SA(0, 1), a2, v2[1]);
            G8_WAIT_L(8); G8_BAR; G8_WAIT_L(0); G8_MMA(0, 0, At, B0); G8_BAR; G8_SCHED;
            G8_LDB(B1, 1, 1); G8_STAGE(G8_SB(1, 0), b3, voffB);
            G8_BAR; G8_WAIT_L(0); G8_MMA(0, 1, At, B1); G8_BAR;
            G8_LDA(At, 1, 1); G8_STAGE(G8_SA(1, 0), a3, v2[0]);
            G8_BAR; G8_WAIT_L(0); G8_MMA(1, 0, At, B0); G8_BAR; G8_SCHED;
            G8_STAGE(G8_SB(1, 1), b3 + hstep, voffB);
            G8_WAIT_V(6); G8_BAR; G8_MMA(1, 1, At, B1); G8_BAR;
        }
        E(acc, cur, wr, wc, fr, fq);
        if (!has_next) break;
#pragma unroll
        for (int a = 0; a < 2; ++a)
#pragma unroll
            for (int b = 0; b < 2; ++b)
#pragma unroll
                for (int m = 0; m < 4; ++m)
#pragma unroll
                    for (int n = 0; n < 2; ++n) acc[a][b][m][n] = (f32x4){0.f, 0.f, 0.f, 0.f};
        cur = nxt; cB = nB; cA = nA; ++ui;
#pragma unroll
        for (int h = 0; h < 2; ++h)
#pragma unroll
            for (int i = 0; i < 2; ++i) vAc[h][i] = vAn[h][i];
    }
    G8_WAIT_V(0);
    if (wr == 0) G8_BAR;
    G8_BAR;
#undef G8_SA
#undef G8_SB
#undef G8_STAGE
#undef G8_LDA
#undef G8_LDB
#undef G8_MMA
#undef G8_WAIT_V
#undef G8_WAIT_L
#undef G8_BAR
#undef G8_SCHED
}

struct DUnit { int pm, pn; };
struct DenseOrder {
    typedef DUnit Unit; static constexpr bool AFFINE = true;
    int nM, nN, nwg, G, c; const char* Bt; int K; int bpe;
    __device__ __forceinline__ void init(int nM_, int nN_, int G_, int c_, const void* Bt_, int K_, int bpe_ = 2) { nM = nM_; nN = nN_; nwg = nM * nN; G = G_; c = c_; Bt = (const char*)Bt_; K = K_; bpe = bpe_; }
    __device__ __forceinline__ bool next(int i, Unit& u) const {
        const long L = (long)i * G + c; if (L >= nwg) return false;
        int wgid = (int)L; { const int q = nwg / NXCD, r = nwg % NXCD, xcd = wgid % NXCD, off = wgid / NXCD; wgid = (xcd < r ? xcd * (q + 1) : r * (q + 1) + (xcd - r) * q) + off; }
        const int nig = WGM * nN, gid = wgid / nig, fm = gid * WGM, gsz = (nM - fm) < WGM ? (nM - fm) : WGM;
        u.pm = fm + ((wgid % nig) % gsz); u.pn = (wgid % nig) / gsz; return true;
    }
    __device__ __forceinline__ int a_row(const Unit& u, int r) const { return u.pm * BM + r; }
    __device__ __forceinline__ const char* b_base(const Unit& u) const { return Bt + (size_t)u.pn * BM * K * bpe; }
};
struct MUnit { int pm, pn, e, nvalid, lbase, idx; };
constexpr int MOE_UTAB = 131072, MOE_RTOK = MOE_UTAB + 128, MOE_RGATE = MOE_RTOK + 4096;
template <bool GATHER> struct MoeOrder {
    typedef MUnit Unit; static constexpr bool AFFINE = !GATHER;
    const int* utab; const int* rtok; const char* W; int K; int bpe;
    __device__ __forceinline__ bool next(int i, Unit& u) const {
        if (i >= 4) return false;
        const int* t = utab + i * 8;
        if (t[5] == 0) return false;
        u.pm = t[0]; u.pn = t[1]; u.e = t[2]; u.nvalid = t[3]; u.lbase = t[4]; u.idx = i; return true;
    }
    __device__ __forceinline__ int a_row(const Unit& u, int r) const { if (GATHER) return rtok[u.idx * 256 + r] >> 1; else return u.pm * BM + r; }
    __device__ __forceinline__ const char* b_base(const Unit& u) const { return W + ((size_t)u.e * 1024 + u.pn * BM) * K * bpe; }
};

struct EpiP2 {
    static constexpr bool PERM = true;
    bf16_t* P;
    __device__ __forceinline__ void operator()(const f32x4 (&acc)[2][2][4][2], const DUnit& u, int wr, int wc, int fr, int fq) const {
        const int row0 = u.pm * BM + wr * 64 + fr, col0 = u.pn * BM + wc * 32 + 8 * fq;
#pragma unroll
        for (int ai = 0; ai < 2; ++ai)
#pragma unroll
            for (int m = 0; m < 4; ++m) { bf16_t* rowp = P + (size_t)(row0 + ai * HALF + m * 16) * PW + col0;
#pragma unroll
                for (int bj = 0; bj < 2; ++bj) { const f32x4 v0 = acc[ai][bj][m][0], v1 = acc[ai][bj][m][1];
                    u32x4 w; w.x = cvt_pk_bf16(v0[0], v0[1]); w.y = cvt_pk_bf16(v0[2], v0[3]); w.z = cvt_pk_bf16(v1[0], v1[1]); w.w = cvt_pk_bf16(v1[2], v1[3]);
                    *(u32x4*)(rowp + bj * HALF) = w; } }
    }
};
struct EpiRes2 {
    static constexpr bool PERM = false;
    float* X; const float* gate; float scl;
    __device__ __forceinline__ void operator()(const f32x4 (&acc)[2][2][4][2], const DUnit& u, int wr, int wc, int fr, int fq) const {
        const int row0 = u.pm * BM + wr * 64 + fr, col0 = u.pn * BM + wc * 32 + 4 * fq;
#pragma unroll
        for (int ai = 0; ai < 2; ++ai)
#pragma unroll
            for (int m = 0; m < 4; ++m) { const int r = row0 + ai * HALF + m * 16; float* rowp = X + (size_t)r * 1024 + col0; const float* gp = gate + (size_t)mod_row(r) * 6144 + col0;
#pragma unroll
                for (int bj = 0; bj < 2; ++bj)
#pragma unroll
                    for (int n = 0; n < 2; ++n) { const f32x4 gv = *(const f32x4*)(gp + bj * HALF + n * 16); f32x4 x = *(f32x4*)(rowp + bj * HALF + n * 16); x += (gv * scl) * acc[ai][bj][m][n]; *(f32x4*)(rowp + bj * HALF + n * 16) = x; }
                asm volatile("" ::: "memory"); }
    }
};
struct EpiDelta {
    static constexpr bool PERM = true;
    bf16_t* Dl; const float* gate; float scl;
    __device__ __forceinline__ void operator()(const f32x4 (&acc)[2][2][4][2], const DUnit& u, int wr, int wc, int fr, int fq) const {
        const int row0 = u.pm * BM + wr * 64 + fr, col0 = u.pn * BM + wc * 32 + 8 * fq;
        f32x4 gv[2][2];
        { const float* gp = gate + (size_t)mod_row(u.pm * BM) * 6144 + col0;
#pragma unroll
          for (int bj = 0; bj < 2; ++bj) { gv[bj][0] = *(const f32x4*)(gp + bj * HALF) * scl; gv[bj][1] = *(const f32x4*)(gp + bj * HALF + 4) * scl; } }
#pragma unroll
        for (int ai = 0; ai < 2; ++ai)
#pragma unroll
            for (int m = 0; m < 4; ++m) { const int r = row0 + ai * HALF + m * 16; bf16_t* rowp = Dl + (size_t)r * 1024 + col0;
#pragma unroll
                for (int bj = 0; bj < 2; ++bj) { const f32x4 g0 = gv[bj][0], g1 = gv[bj][1];
                    const f32x4 v0 = acc[ai][bj][m][0] * g0, v1 = acc[ai][bj][m][1] * g1;
                    u32x4 w; w.x = cvt_pk_bf16(v0[0], v0[1]); w.y = cvt_pk_bf16(v0[2], v0[3]); w.z = cvt_pk_bf16(v1[0], v1[1]); w.w = cvt_pk_bf16(v1[2], v1[3]);
                    *(u32x4*)(rowp + bj * HALF) = w; } }
    }
};
struct EpiGU2 {
    static constexpr bool PERM = true;
    bf16_t* H;
    __device__ __forceinline__ void operator()(const f32x4 (&acc)[2][2][4][2], const MUnit& u, int wr, int wc, int fr, int fq) const {
        const int row0 = u.pm * BM + wr * 64 + fr, col0 = u.pn * BM + wc * 32 + 8 * fq;
#pragma unroll
        for (int ai = 0; ai < 2; ++ai)
#pragma unroll
            for (int m = 0; m < 4; ++m) { bf16_t* rowp = H + (size_t)(row0 + ai * HALF + m * 16) * 512 + (col0 >> 1);
#pragma unroll
                for (int bj = 0; bj < 2; ++bj) { const f32x4 v0 = acc[ai][bj][m][0], v1 = acc[ai][bj][m][1];
                    u32x2 w; w.x = cvt_pk_bf16(siluf(v0[0]) * v0[1], siluf(v0[2]) * v0[3]); w.y = cvt_pk_bf16(siluf(v1[0]) * v1[1], siluf(v1[2]) * v1[3]);
                    *(u32x2*)(rowp + bj * (HALF / 2)) = w; } }
    }
};
struct EpiGU8 {
    static constexpr bool PERM = true;
    unsigned char* H;
    __device__ __forceinline__ void operator()(const f32x4 (&acc)[2][2][4][2], const MUnit& u, int wr, int wc, int fr, int fq) const {
        const int row0 = u.pm * BM + wr * 64 + fr, col0 = u.pn * BM + wc * 32 + 8 * fq;
#pragma unroll
        for (int ai = 0; ai < 2; ++ai)
#pragma unroll
            for (int m = 0; m < 4; ++m) { unsigned char* rowp = H + (size_t)(row0 + ai * HALF + m * 16) * 512 + (col0 >> 1);
#pragma unroll
                for (int bj = 0; bj < 2; ++bj) { const f32x4 v0 = acc[ai][bj][m][0], v1 = acc[ai][bj][m][1];
                    *(unsigned*)(rowp + bj * (HALF / 2)) = pk4_fp8(2.0f * siluf(v0[0]) * v0[1], 2.0f * siluf(v0[2]) * v0[3], 2.0f * siluf(v1[0]) * v1[1], 2.0f * siluf(v1[2]) * v1[3]); } }
    }
};
struct EpiDown2 {
    static constexpr bool PERM = true;
    bf16_t* YB; const int* rtok; const float* rgate;
    __device__ __forceinline__ void operator()(const f32x4 (&acc)[2][2][4][2], const MUnit& u, int wr, int wc, int fr, int fq) const {
        const int r0 = wr * 64 + fr, col0 = u.pn * BM + wc * 32 + 8 * fq;
#pragma unroll
        for (int ai = 0; ai < 2; ++ai)
#pragma unroll
            for (int m = 0; m < 4; ++m) { const int rt = r0 + ai * HALF + m * 16;
                if (rt < u.nvalid) { const int ent = rtok[u.idx * 256 + rt]; const float g = rgate[u.idx * 256 + rt]; bf16_t* rowp = YB + (size_t)ent * 1024 + col0;
#pragma unroll
                    for (int bj = 0; bj < 2; ++bj) { const f32x4 v0 = acc[ai][bj][m][0] * g, v1 = acc[ai][bj][m][1] * g;
                        u32x4 w; w.x = cvt_pk_bf16(v0[0], v0[1]); w.y = cvt_pk_bf16(v0[2], v0[3]); w.z = cvt_pk_bf16(v1[0], v1[1]); w.w = cvt_pk_bf16(v1[2], v1[3]);
                        *(u32x4*)(rowp + bj * HALF) = w; } } }
    }
};
struct EpiDown8 {
    static constexpr bool PERM = true;
    unsigned char* YB; const int* rtok; const float* rgate;
    __device__ __forceinline__ void operator()(const f32x4 (&acc)[2][2][4][2], const MUnit& u, int wr, int wc, int fr, int fq) const {
        const int r0 = wr * 64 + fr, col0 = u.pn * BM + wc * 32 + 8 * fq;
#pragma unroll
        for (int ai = 0; ai < 2; ++ai)
#pragma unroll
            for (int m = 0; m < 4; ++m) { const int rt = r0 + ai * HALF + m * 16;
                if (rt < u.nvalid) { const int ent = rtok[u.idx * 256 + rt]; const float g = 64.0f * rgate[u.idx * 256 + rt]; unsigned char* rowp = YB + (size_t)ent * 1024 + col0;
#pragma unroll
                    for (int bj = 0; bj < 2; ++bj) { const f32x4 v0 = acc[ai][bj][m][0] * g, v1 = acc[ai][bj][m][1] * g;
                        u32x2 w; w.x = pk4_fp8(v0[0], v0[1], v0[2], v0[3]); w.y = pk4_fp8(v1[0], v1[1], v1[2], v1[3]);
                        *(u32x2*)(rowp + bj * HALF) = w; } } }
    }
};
}

__device__ __forceinline__ void transpose_item(const float* __restrict__ W, int K, int N, bf16_t* __restrict__ WT, int mode, float* scr, int item, int lane) {
    const int nblk = N / 32, kb = item / nblk, nb = item % nblk, k0 = 64 * kb, n0 = 32 * nb;
    float wv[32];
#pragma unroll
    for (int i = 0; i < 32; ++i) wv[i] = __builtin_nontemporal_load(W + (size_t)(k0 + 2 * i + (lane >> 5)) * N + n0 + (lane & 31));
#pragma unroll
    for (int i = 0; i < 32; ++i) scr[(2 * i + (lane >> 5)) * 33 + (lane & 31)] = wv[i];
    LDS_WAIT();
    const int c = lane & 7;
#pragma unroll
    for (int j = 0; j < 4; ++j) {
        const int n = (lane >> 3) + 8 * j; const float* s = scr + (8 * c) * 33 + n;
        u32x4 o; o.x = pk2(s[0 * 33], s[1 * 33]); o.y = pk2(s[2 * 33], s[3 * 33]); o.z = pk2(s[4 * 33], s[5 * 33]); o.w = pk2(s[6 * 33], s[7 * 33]);
        const int nabs = n0 + n; const int orow = mode ? ((nabs < 512) ? 2 * nabs : 2 * (nabs - 512) + 1) : nabs;
        *(u32x4*)(WT + (size_t)orow * K + k0 + 8 * c) = o;
    }
    LDS_WAIT();
}


__device__ __forceinline__ void transpose_item8(const float* __restrict__ W, int K, int N, unsigned char* __restrict__ WT, int mode, float scale, float* scr, int item, int lane) {
    const int nblk = N / 32, kb = item / nblk, nb = item % nblk, k0 = 64 * kb, n0 = 32 * nb;
    float wv[32];
#pragma unroll
    for (int i = 0; i < 32; ++i) wv[i] = __builtin_nontemporal_load(W + (size_t)(k0 + 2 * i + (lane >> 5)) * N + n0 + (lane & 31));
#pragma unroll
    for (int i = 0; i < 32; ++i) scr[(2 * i + (lane >> 5)) * 33 + (lane & 31)] = wv[i] * scale;
    LDS_WAIT();
    const int c = lane & 7;
#pragma unroll
    for (int j = 0; j < 4; ++j) {
        const int n = (lane >> 3) + 8 * j; const float* s = scr + (8 * c) * 33 + n;
        u32x2 o; o.x = pk4_fp8(s[0 * 33], s[1 * 33], s[2 * 33], s[3 * 33]); o.y = pk4_fp8(s[4 * 33], s[5 * 33], s[6 * 33], s[7 * 33]);
        const int nabs = n0 + n; const int orow = mode ? ((nabs < 512) ? 2 * nabs : 2 * (nabs - 512) + 1) : nabs;
        *(u32x2*)(WT + (size_t)orow * K + k0 + 8 * c) = o;
    }
    LDS_WAIT();
}

__device__ __forceinline__ void convert_experts(const Params& p, int l, float* scr, int widx, int nwv, int it0, int it1) {
    const int tid = otid(), lane = tid & 63;
    bf16_t* wgu_t = (bf16_t*)(ows(p) + WS_WGU) + (size_t)l * 32 * 1024 * 1024; bf16_t* wdn_t = (bf16_t*)(ows(p) + WS_WDN) + (size_t)l * 32 * 1024 * 512;
    const float* wgu = oin(p, 17) + (size_t)l * 32 * 1024 * 1024; const float* wdn = oin(p, 18) + (size_t)l * 32 * 512 * 1024;
    constexpr int I_GU = 16 * 32, I_DN = 8 * 32, T_GU = 32 * I_GU;
    unsigned char* wgu8 = ows(p) + WS_WGU8 + (size_t)l * 32 * 1024 * 1024; unsigned char* wdn8 = ows(p) + WS_WDN8 + (size_t)l * 32 * 1024 * 512;
    for (int it = it0 + widx; it < it1; it += nwv) {
        if (it < T_GU) { const int m = it / I_GU;
            if (MOE_FP8) transpose_item8(wgu + (size_t)m * 1024 * 1024, 1024, 1024, wgu8 + (size_t)m * 1024 * 1024, 1, 32.0f, scr, it % I_GU, lane);
            else transpose_item(wgu + (size_t)m * 1024 * 1024, 1024, 1024, wgu_t + (size_t)m * 1024 * 1024, 1, scr, it % I_GU, lane); }
        else { const int r = it - T_GU, m = r / I_DN;
            if (MOE_FP8) transpose_item8(wdn + (size_t)m * 512 * 1024, 512, 1024, wdn8 + (size_t)m * 1024 * 512, 0, 16.0f, scr, r % I_DN, lane);
            else transpose_item(wdn + (size_t)m * 512 * 1024, 512, 1024, wdn_t + (size_t)m * 1024 * 512, 0, scr, r % I_DN, lane); }
    }
}

__device__ __forceinline__ void convert_range(const Params& p, float* scr, int widx, int nwv, int g0, int g1) {
    for (int l = g0 / CV_ALL; l < DEPTH && l * CV_ALL < g1; ++l) {
        const int a = max(g0, l * CV_ALL) - l * CV_ALL, b = min(g1, (l + 1) * CV_ALL) - l * CV_ALL;
        convert_experts(p, l, scr, widx, nwv, a, b);
    }
}

__device__ __forceinline__ void phase_prologue(const Params& p, unsigned char* lds) {
    const int tid = otid(), lane = tid & 63, wid = tid >> 6;
    float* scr = (float*)(lds + wid * 16384);
    const int gw = obid() * 8 + wid, NGW = gridDim.x * 8;
    bf16_t* win_t = (bf16_t*)(ows(p) + WS_WIN); bf16_t* wout_t = (bf16_t*)(ows(p) + WS_WOUT);
    constexpr int I_IN = 16 * 128, I_OUT = 16 * 32;
    constexpr int T_IN = 4 * I_IN, T_OUT = 4 * I_OUT;
    for (int it = gw; it < T_IN + T_OUT; it += NGW) {
        int r = it;
        if (r < T_IN) { const int m = r / I_IN; transpose_item(oin(p, 7) + (size_t)m * 1024 * 4096, 1024, 4096, win_t + (size_t)m * 4096 * 1024, 0, scr, r % I_IN, lane); continue; } r -= T_IN;
        { const int m = r / I_OUT;
          if (G2_FP8) transpose_item8(oin(p, 12) + (size_t)m * 1024 * 1024, 1024, 1024, (unsigned char*)wout_t + (size_t)m * 1024 * 1024, 0, 32.0f, scr, r % I_OUT, lane);
          else transpose_item(oin(p, 12) + (size_t)m * 1024 * 1024, 1024, 1024, wout_t + (size_t)m * 1024 * 1024, 0, scr, r % I_OUT, lane); }
    }
    {
        bf16_t* wrh = (bf16_t*)(ows(p) + WS_WRH); bf16_t* wrl = (bf16_t*)(ows(p) + WS_WRL);
        for (int i = obid() * 512 + tid; i < 4 * 48 * 1024; i += gridDim.x * 512) {
            const int l = i / (48 * 1024), j = (i / 1024) % 48, k = i % 1024;
            float w = 0.f;
            if (j < 4) w = oin(p, 13)[((size_t)l * 1024 + k) * 4 + j]; else if (j < 36) w = oin(p, 15)[((size_t)l * 1024 + k) * 32 + (j - 4)];
            const unsigned hi = f2bf(w); const float rem = w - __uint_as_float(hi << 16);
            wrh[i] = (bf16_t)hi; wrl[i] = (bf16_t)f2bf(rem);
        }
    }
    __syncthreads();
    float* modp = (float*)(ows(p) + WS_MODP);
    float* sS = (float*)lds;
    for (int u = obid(); u < 4 * 24 * 8; u += gridDim.x) {
        const int l = u / 192, rem = u % 192, nb = rem / 8, ks = rem % 8;
        __syncthreads();
        for (int i = tid; i < 9 * 128; i += 512) { const int r = i >> 7, k = i & 127; const float cv = (r < 8) ? oin(p, 1)[r * 1024 + ks * 128 + k] : oin(p, 3)[ks * 128 + k]; sS[i] = siluf(cv); }
        __syncthreads();
        const int col = nb * 256 + (tid & 255), kh = tid >> 8;
        float acc[9];
#pragma unroll
        for (int r = 0; r < 9; ++r) acc[r] = 0.f;
        const float* w = oin(p, 5) + ((size_t)l * 1024 + ks * 128 + kh * 64) * 6144 + col;
        for (int k = 0; k < 64; ++k) {
            const float wv = w[(size_t)k * 6144];
#pragma unroll
            for (int r = 0; r < 9; ++r) acc[r] += sS[r * 128 + kh * 64 + k] * wv;
        }
#pragma unroll
        for (int r = 0; r < 9; ++r) modp[(((size_t)l * NMODP + ks * 2 + kh) * 9 + r) * 6144 + col] = acc[r];
    }
}

__device__ __forceinline__ void phase_modreduce(const Params& p) {
    const float* modp = (const float*)(ows(p) + WS_MODP); float* modv = (float*)(ows(p) + WS_MOD);
    for (int i = obid() * 512 + otid(); i < 4 * 9 * 6144; i += gridDim.x * 512) {
        const int l = i / (9 * 6144), rem = i % (9 * 6144), n = rem % 6144;
        float s = oin(p, 6)[l * 6144 + n];
        for (int j = 0; j < NMODP; ++j) s += modp[((size_t)l * NMODP + j) * 9 * 6144 + rem];
        modv[i] = s;
    }
}

template <int NB>
__device__ __forceinline__ void norm1_rows(const Params& p, int l, float scl, int r0, int stride, const f32x4 (&nwv)[4], const f32x4 (&shv)[4], const f32x4 (&scv)[4], const f32x4 (&g5v)[4]) {
    const int lane = otid() & 63;
    bf16_t* xws = (bf16_t*)(ows(p) + WS_X); bf16_t* hb = (bf16_t*)(ows(p) + WS_H); const unsigned char* y8 = ows(p) + WS_YB8;
    f32x4 v[NB][4]; u32x2 xr[NB][4]; unsigned ya[NB][4], yc[NB][4];
#pragma unroll
    for (int q = 0; q < NB; ++q) {
        const int r = r0 + q * stride;
        if (l == 0) { const float* src = r < NLAT ? oin(p, 0) + (size_t)r * 1024 : oin(p, 2) + (size_t)(r - NLAT) * 1024;
#pragma unroll
            for (int j = 0; j < 4; ++j) v[q][j] = *(const f32x4*)(src + 4 * lane + 256 * j); }
        else {
#pragma unroll
            for (int j = 0; j < 4; ++j) { const int c = 4 * lane + 256 * j; xr[q][j] = *(const u32x2*)(xws + (size_t)r * 1024 + c);
                ya[q][j] = *(const unsigned*)(y8 + (size_t)(2 * r) * 1024 + c); yc[q][j] = *(const unsigned*)(y8 + (size_t)(2 * r + 1) * 1024 + c); } }
    }
#pragma unroll
    for (int q = 0; q < NB; ++q) {
        const int r = r0 + q * stride;
        if (l > 0) {
#pragma unroll
            for (int j = 0; j < 4; ++j) { const f32x4 f = (unpk4_fp8(ya[q][j]) + unpk4_fp8(yc[q][j])) * (1.0f / 64.0f); v[q][j] = unpk4_bf16(xr[q][j]) + (g5v[j] * scl) * f; }
        }
#pragma unroll
        for (int j = 0; j < 4; ++j) { u32x2 o; o.x = cvtpk(v[q][j][0], v[q][j][1]); o.y = cvtpk(v[q][j][2], v[q][j][3]); *(u32x2*)(xws + (size_t)r * 1024 + 4 * lane + 256 * j) = o; }
        float ss = 0.f;
#pragma unroll
        for (int j = 0; j < 4; ++j) ss += (v[q][j][0] * v[q][j][0] + v[q][j][1] * v[q][j][1]) + (v[q][j][2] * v[q][j][2] + v[q][j][3] * v[q][j][3]);
        const float rstd = rsqrtf(wave_sum(ss) * (1.0f / 1024.0f) + EPS);
#pragma unroll
        for (int j = 0; j < 4; ++j) {
            const f32x4 h = (v[q][j] * rstd * nwv[j]) * (1.0f + scv[j]) + shv[j];
            u32x2 o; o.x = pk2(h[0], h[1]); o.y = pk2(h[2], h[3]);
            *(u32x2*)(hb + (size_t)r * 1024 + 4 * lane + 256 * j) = o;
        }
    }
}
__device__ __forceinline__ void phase_norm1(const Params& p, int l, float scl) {
    static_assert(MOE_FP8 == 1 && SEQ % 8 == 0, "norm1 reads the fp8 slot outputs");
    const int lane = otid() & 63, wid = otid() >> 6;
    const float* modv = (const float*)(ows(p) + WS_MOD);
    const float* nw = oin(p, 4) + (size_t)(l * 2 + 0) * 1024;
    const int w = obid() * 8 + wid, nwvs = (int)gridDim.x * 8;
    f32x4 nwv[4];
#pragma unroll
    for (int j = 0; j < 4; ++j) nwv[j] = *(const f32x4*)(nw + 4 * lane + 256 * j);
    for (int blk = w; blk < NLAT / 8 + (NTOK - NLAT); blk += nwvs) {
        const bool lat = blk < NLAT / 8;
        const int r0 = lat ? blk * 8 : NLAT + (blk - NLAT / 8), mr = mod_row(r0);
        f32x4 shv[4], scv[4], g5v[4];
        const float* msh = modv + ((size_t)l * 9 + mr) * 6144; const float* msc = msh + 1024; const float* g5 = modv + ((size_t)(l > 0 ? l - 1 : 0) * 9 + mr) * 6144 + 5 * 1024;
#pragma unroll
        for (int j = 0; j < 4; ++j) { const int c = 4 * lane + 256 * j; shv[j] = *(const f32x4*)(msh + c); scv[j] = *(const f32x4*)(msc + c); g5v[j] = *(const f32x4*)(g5 + c); }
        if (lat) { norm1_rows<4>(p, l, scl, r0, 1, nwv, shv, scv, g5v); norm1_rows<4>(p, l, scl, r0 + 4, 1, nwv, shv, scv, g5v); }
        else norm1_rows<1>(p, l, scl, r0, 1, nwv, shv, scv, g5v);
    }
}

__device__ __forceinline__ void phase_final(const Params& p) {
    const int lane = otid() & 63, wid = otid() >> 6;
    const bf16_t* xws = (const bf16_t*)(ows(p) + WS_X); const unsigned char* y8 = ows(p) + WS_YB8;
    const float* modv = (const float*)(ows(p) + WS_MOD); const float* nw = oin(p, 19);
    f32x4 fw[4];
#pragma unroll
    for (int j = 0; j < 4; ++j) fw[j] = *(const f32x4*)(nw + 4 * lane + 256 * j);
    for (int blk = obid() * 8 + wid; blk < NLAT / 4; blk += gridDim.x * 8) {
        const int r0 = blk * 4, mr = mod_row(r0);
        const float* g5 = modv + ((size_t)3 * 9 + mr) * 6144 + 5 * 1024;
        f32x4 g5v[4]; u32x2 xr[4][4]; unsigned ya[4][4], yc[4][4];
#pragma unroll
        for (int j = 0; j < 4; ++j) g5v[j] = *(const f32x4*)(g5 + 4 * lane + 256 * j);
#pragma unroll
        for (int q = 0; q < 4; ++q)
#pragma unroll
            for (int j = 0; j < 4; ++j) { const int r = r0 + q, c = 4 * lane + 256 * j; xr[q][j] = *(const u32x2*)(xws + (size_t)r * 1024 + c);
                ya[q][j] = *(const unsigned*)(y8 + (size_t)(2 * r) * 1024 + c); yc[q][j] = *(const unsigned*)(y8 + (size_t)(2 * r + 1) * 1024 + c); }
#pragma unroll
        for (int q = 0; q < 4; ++q) {
            f32x4 v[4]; float ss = 0.f;
#pragma unroll
            for (int j = 0; j < 4; ++j) {
                const f32x4 f = (unpk4_fp8(ya[q][j]) + unpk4_fp8(yc[q][j])) * (1.0f / 64.0f);
                v[j] = unpk4_bf16(xr[q][j]) + g5v[j] * f;
                ss += (v[j][0] * v[j][0] + v[j][1] * v[j][1]) + (v[j][2] * v[j][2] + v[j][3] * v[j][3]);
            }
            const float rstd = rsqrtf(wave_sum(ss) * (1.0f / 1024.0f) + EPS);
#pragma unroll
            for (int j = 0; j < 4; ++j) *(f32x4*)(p.out + (size_t)(r0 + q) * 1024 + 4 * lane + 256 * j) = v[j] * rstd * fw[j];
        }
    }
}

__device__ __forceinline__ void phase_gemm1(const Params& p, int l, unsigned char* lds) {
    const bf16_t* hb = (const bf16_t*)(ows(p) + WS_H); const bf16_t* wt = (const bf16_t*)(ows(p) + WS_WIN) + (size_t)l * 4096 * 1024; bf16_t* pb = (bf16_t*)(ows(p) + WS_P);
    constexpr int NT = PW / 128, MT = NTOK / 128;
    for (int u = obid(); u < MT * NT; u += gridDim.x) {
        const int mt = u / NT, nt = u % NT;
        ARowPlain ar{hb + (size_t)mt * 128 * 1024, 1024};
        EpiP ep{pb + (size_t)mt * 128 * PW + nt * 128};
        gemm128(lds, ar, wt + (size_t)nt * 128 * 1024, 1024, ep);
    }
}

__device__ __forceinline__ void unpack8(const u32x4 w, float (&f)[8]) {
    f[0] = bf2f(w.x & 0xffff); f[1] = bf2f(w.x >> 16); f[2] = bf2f(w.y & 0xffff); f[3] = bf2f(w.y >> 16);
    f[4] = bf2f(w.z & 0xffff); f[5] = bf2f(w.z >> 16); f[6] = bf2f(w.w & 0xffff); f[7] = bf2f(w.w >> 16);
}
__device__ __forceinline__ void conv_rows(const Params& p, int l, int widx, int nwv) {
    const int lane = otid() & 63;
    const bf16_t* pb = (const bf16_t*)(ows(p) + WS_P); bf16_t* yb = (bf16_t*)(ows(p) + WS_Y);
    const float* cw = oin(p, 8) + (size_t)l * 3 * 512; const float* cnw = oin(p, 9) + (size_t)l * 512;
    const int nrows = (l == DEPTH - 1) ? NLAT : NTOK;
    const int c0 = lane * 8;
    float w0[8], w1[8], w2[8], nwv8[8];
#pragma unroll
    for (int j = 0; j < 8; ++j) { w0[j] = cw[c0 + j]; w1[j] = cw[512 + c0 + j]; w2[j] = cw[1024 + c0 + j]; nwv8[j] = cnw[c0 + j]; }
    constexpr int NB = 4;
    for (int rb = widx; rb < nrows; rb += NB * nwv) {
        u32x4 vb[NB], vc[NB], vh[NB], vcm[NB], vhm[NB], vcp[NB], vhp[NB]; bool hm[NB], hp[NB];
#pragma unroll
        for (int q = 0; q < NB; ++q) {
            int r = rb + q * nwv; if (r >= nrows) r = rb;
            int rm = -1, rp = -1;
            if (r < NLAT) {
                const int t = r & 2047;
                if (c0 < 256) { if ((t & 63) > 0) rm = r - 1; if ((t & 63) < 63) rp = r + 1; }
                else { if (t >= 64) rm = r - 64; if (t < SEQ - 64) rp = r + 64; }
            } else { const int tc = (r - NLAT) & 255; if (tc > 0) rm = r - 1; if (tc < 255) rp = r + 1; }
            hm[q] = rm >= 0; hp[q] = rp >= 0; if (rm < 0) rm = r; if (rp < 0) rp = r;
            vb[q] = *(const u32x4*)(pb + (size_t)r * PW + OFF_B + c0); vc[q] = *(const u32x4*)(pb + (size_t)r * PW + OFF_C + c0); vh[q] = *(const u32x4*)(pb + (size_t)r * PW + OFF_HV + c0);
            vcm[q] = *(const u32x4*)(pb + (size_t)rm * PW + OFF_C + c0); vhm[q] = *(const u32x4*)(pb + (size_t)rm * PW + OFF_HV + c0);
            vcp[q] = *(const u32x4*)(pb + (size_t)rp * PW + OFF_C + c0); vhp[q] = *(const u32x4*)(pb + (size_t)rp * PW + OFF_HV + c0);
        }
#pragma unroll
        for (int q = 0; q < NB; ++q) {
            const int r = rb + q * nwv;
            float bg[8], u0[8], um[8], up[8], t1[8];
            unpack8(vb[q], bg); unpack8(vc[q], u0); unpack8(vh[q], t1);
#pragma unroll
            for (int j = 0; j < 8; ++j) u0[j] *= t1[j];
            unpack8(vcm[q], um); unpack8(vhm[q], t1);
#pragma unroll
            for (int j = 0; j < 8; ++j) um[j] = hm[q] ? um[j] * t1[j] : 0.f;
            unpack8(vcp[q], up); unpack8(vhp[q], t1);
#pragma unroll
            for (int j = 0; j < 8; ++j) up[j] = hp[q] ? up[j] * t1[j] : 0.f;
            float z[8]; float ss = 0.f;
#pragma unroll
            for (int j = 0; j < 8; ++j) { z[j] = bg[j] * (w0[j] * um[j] + w1[j] * u0[j] + w2[j] * up[j]); ss += z[j] * z[j]; }
            const float rstd = rsqrtf(wave_sum(ss) * (1.0f / 512.0f) + EPS);
            if (G2_FP8) {
                const float rs8 = rstd * 8.0f; u32x2 o8;
                o8.x = pk4_fp8(z[0] * rs8 * nwv8[0], z[1] * rs8 * nwv8[1], z[2] * rs8 * nwv8[2], z[3] * rs8 * nwv8[3]); o8.y = pk4_fp8(z[4] * rs8 * nwv8[4], z[5] * rs8 * nwv8[5], z[6] * rs8 * nwv8[6], z[7] * rs8 * nwv8[7]);
                if (r < nrows) *(u32x2*)((unsigned char*)yb + (size_t)r * 1024 + c0) = o8;
            } else {
            u32x4 o;
            o.x = cvtpk(z[0] * rstd * nwv8[0], z[1] * rstd * nwv8[1]); o.y = cvtpk(z[2] * rstd * nwv8[2], z[3] * rstd * nwv8[3]);
            o.z = cvtpk(z[4] * rstd * nwv8[4], z[5] * rstd * nwv8[5]); o.w = cvtpk(z[6] * rstd * nwv8[6], z[7] * rstd * nwv8[7]);
            if (r < nrows) *(u32x4*)(yb + (size_t)r * 1024 + c0) = o; }
        }
    }
}

template <int DIR>
__device__ __forceinline__ void gla_pre_dir(const Params& p, int l, int chunk, float* sQ, float* sK, const float* sV, float* sA, float* sBq, float (&oacc)[16]) {
    const int ch = otid(), tid = otid(), R0 = chunk * 16;
    const bf16_t* pb = (const bf16_t*)(ows(p) + WS_P);
    bf16_t* qin = (bf16_t*)(ows(p) + WS_QIN); bf16_t* kout = (bf16_t*)(ows(p) + WS_KOUT); float* dch = (float*)(ows(p) + WS_DCH);
    float lbv = 0.f;
    {
        const float* lb = oin(p, 10) + (size_t)DIR * 4 * 512 + ch;
        const float z0 = lb[0], z1 = lb[512], z2 = lb[1024], z3 = lb[1536];
        const float mx = fmaxf(fmaxf(z0, z1), fmaxf(z2, z3));
        const float e0 = __expf(z0 - mx), e1 = __expf(z1 - mx), e2 = __expf(z2 - mx), e3 = __expf(z3 - mx);
        const float inv = 1.0f / (e0 + e1 + e2 + e3);
        lbv = ((l >= 1 ? e1 : 0.f) + (l >= 2 ? e2 : 0.f) + (l >= 3 ? e3 : 0.f)) * inv;
    }
    float b = 0.f;
#pragma unroll 1
    for (int i = 0; i < 16; ++i) {
        const int row = R0 + (DIR ? 15 - i : i);
        const float zf = bf2f(pb[(size_t)row * PW + OFF_ZF + DIR * 512 + ch]);
        const float sg = 1.0f / (1.0f + __expf(-zf)), sn = 1.0f / (1.0f + __expf(zf));
        const float f = fmaxf(lbv + (1.0f - lbv) * sg, 1e-30f);
        b += __logf(f);
        sBq[i * 512 + ch] = b; sK[i * 512 + ch] = (1.0f - lbv) * sn;
        sQ[i * 512 + ch] = siluf(bf2f(pb[(size_t)row * PW + OFF_Q + ch]));
    }
    const float blast = b;
#pragma unroll 1
    for (int i = 0; i < 16; ++i) {
        const int row = R0 + (DIR ? 15 - i : i);
        const float bi = sBq[i * 512 + ch], kq = sK[i * 512 + ch], qv = sQ[i * 512 + ch];
        const float qi = qv * __expf(bi), kt = kq * __expf(fminf(-bi, 80.0f)), ko = kq * __expf(blast - bi);
        sQ[i * 512 + ch] = qi; sK[i * 512 + ch] = kt;
        qin[((size_t)DIR * NTOK + row) * 512 + ch] = (bf16_t)f2bf(qi);
        kout[((size_t)DIR * NTOK + row) * 512 + ch] = (bf16_t)f2bf(ko);
    }
    dch[((size_t)DIR * NCHUNK + chunk) * 512 + ch] = __expf(blast);
    __syncthreads();
#pragma unroll 1
    for (int e2 = 0; e2 < 2; ++e2) {
        const int e = tid * 2 + e2, h = e >> 8, t = (e >> 4) & 15, s = e & 15;
        float sum = 0.f;
        const float* qp = sQ + t * 512 + h * 128; const float* kp = sK + s * 512 + h * 128;
#pragma unroll 8
        for (int k = 0; k < 128; ++k) sum += qp[k] * kp[k];
        sA[e] = (s <= t) ? sum : 0.f;
    }
    __syncthreads();
    const int h = ch >> 7;
#pragma unroll
    for (int t = 0; t < 16; ++t) {
        float o = 0.f;
#pragma unroll 1
        for (int s = 0; s <= t; ++s) o += sA[(h * 16 + t) * 16 + s] * sV[(DIR ? 15 - s : s) * 512 + ch];
        oacc[DIR ? 15 - t : t] += o;
    }
    __syncthreads();
}

__device__ __forceinline__ void phase_conv_glapre(const Params& p, int l, unsigned char* lds) {
    conv_rows(p, l, obid() * 8 + (otid() >> 6), (int)gridDim.x * 8);
    float* sQ = (float*)lds; float* sK = sQ + 16 * 512; float* sV = sK + 16 * 512; float* sBq = sV + 16 * 512; float* sA = sBq + 16 * 512;
    const bf16_t* pb = (const bf16_t*)(ows(p) + WS_P); float* ointra = (float*)(ows(p) + WS_OINTRA);
    const int ch = otid();
    for (int chunk = obid(); chunk < NCHUNK; chunk += gridDim.x) {
        const int R0 = chunk * 16;
        float oacc[16];
#pragma unroll
        for (int i = 0; i < 16; ++i) oacc[i] = 0.f;
        __syncthreads();
#pragma unroll
        for (int ro = 0; ro < 16; ++ro) sV[ro * 512 + ch] = bf2f(pb[(size_t)(R0 + ro) * PW + OFF_I + ch]);
        gla_pre_dir<0>(p, l, chunk, sQ, sK, sV, sA, sBq, oacc);
        gla_pre_dir<1>(p, l, chunk, sQ, sK, sV, sA, sBq, oacc);
#pragma unroll
        for (int ro = 0; ro < 16; ++ro) ointra[(size_t)(R0 + ro) * 512 + ch] = oacc[ro];
    }
}

__device__ __forceinline__ void phase_gla_seq(const Params& p, int l, unsigned char* lds) {
    const int tid = otid();
    float* S = (float*)lds;
    float* sQ = S + 128 * 32;
    float* sKo = sQ + 16 * 128;
    float* sV = sKo + 16 * 128;
    float* sD = sV + 16 * 32;
    const bf16_t* pb = (const bf16_t*)(ows(p) + WS_P);
    const bf16_t* qin = (const bf16_t*)(ows(p) + WS_QIN); const bf16_t* kout = (const bf16_t*)(ows(p) + WS_KOUT); const float* dch = (const float*)(ows(p) + WS_DCH);
    float* ointer = (float*)(ows(p) + WS_OINTER);
    for (int u = obid(); u < 256; u += gridDim.x) {
        const int vblk = u & 3, dir = (u >> 2) & 1, chain = u >> 3, b = chain >> 2, h = chain & 3;
        __syncthreads();
        for (int i = tid; i < 128 * 32; i += 512) S[i] = 0.f;
        for (int c = 0; c < 144; ++c) {
            int R0;
            if (c < 16) { const int cm = dir ? 15 - c : c; R0 = NLAT + b * 256 + cm * 16; }
            else { const int cc = c - 16; const int cm = dir ? 127 - cc : cc; R0 = b * 2048 + cm * 16; }
            __syncthreads();
            for (int i = tid; i < 16 * 128; i += 512) {
                const int si = i >> 7, k = i & 127; const int row = R0 + (dir ? 15 - si : si);
                const size_t g = ((size_t)dir * NTOK + row) * 512 + h * 128 + k;
                sQ[i] = bf2f(qin[g]); sKo[i] = bf2f(kout[g]);
            }
            { const int si = tid >> 5, vv = tid & 31; const int row = R0 + (dir ? 15 - si : si); sV[tid] = bf2f(pb[(size_t)row * PW + OFF_I + h * 128 + vblk * 32 + vv]); }
            if (tid < 128) sD[tid] = dch[((size_t)dir * NCHUNK + (R0 >> 4)) * 512 + h * 128 + tid];
            __syncthreads();
            {
                const int si = tid >> 5, vv = tid & 31; const int row = R0 + (dir ? 15 - si : si);
                float o = 0.f;
                for (int k = 0; k < 128; ++k) o += sQ[si * 128 + k] * S[k * 32 + vv];
                ointer[((size_t)dir * NTOK + row) * 512 + h * 128 + vblk * 32 + vv] = o;
            }
            __syncthreads();
            {
                const int k = tid >> 2, v0 = (tid & 3) * 8; const float d = sD[k];
                float kk[16];
#pragma unroll
                for (int i = 0; i < 16; ++i) kk[i] = sKo[i * 128 + k];
#pragma unroll
                for (int j = 0; j < 8; ++j) {
                    float s = d * S[k * 32 + v0 + j];
#pragma unroll
                    for (int i = 0; i < 16; ++i) s += kk[i] * sV[i * 32 + v0 + j];
                    S[k * 32 + v0 + j] = s;
                }
            }
        }
    }
}


__device__ __forceinline__ float bflo(unsigned w) { return __uint_as_float(w << 16); }
__device__ __forceinline__ float bfhi(unsigned w) { return __uint_as_float(w & 0xffff0000u); }

template <int DIR>
__device__ __forceinline__ void gla_pre2_dir(const float (&q0a)[16], const float (&q1a)[16], const unsigned (&rz)[16], float lb0, float lb1, unsigned char* wl, unsigned char* rec,
                                             f32x4 (&oT)[8], int lane, int fr, int fq) {
    float bq0[16], bq1[16], kk0[16], kk1[16]; float b0 = 0.f, b1 = 0.f;
#pragma unroll
    for (int i = 0; i < 16; ++i) {
        const int t = DIR ? 15 - i : i;
        const float z0 = bflo(rz[t]), z1 = bfhi(rz[t]);
        const float sg0 = frcp(1.0f + __expf(-z0)), sg1 = frcp(1.0f + __expf(-z1));
        const float f0 = fmaxf(lb0 + (1.0f - lb0) * sg0, 1e-30f), f1 = fmaxf(lb1 + (1.0f - lb1) * sg1, 1e-30f);
        b0 += __logf(f0); b1 += __logf(f1); bq0[t] = b0; bq1[t] = b1; kk0[t] = 1.0f - f0; kk1[t] = 1.0f - f1;
    }
    const float bl0 = b0, bl1 = b1;
    unsigned kw0[8], kw1[8];
#pragma unroll
    for (int i = 0; i < 8; ++i) { kw0[i] = 0u; kw1[i] = 0u; }
#pragma unroll
    for (int t = 0; t < 16; ++t) {
        const float e0 = __expf(bq0[t]), e1 = __expf(bq1[t]);
        const float qi0 = q0a[t] * e0, qi1 = q1a[t] * e1;
        const float kt0 = kk0[t] * frcp(fmaxf(e0, 1.8e-35f)), kt1 = kk1[t] * frcp(fmaxf(e1, 1.8e-35f));
        const float ko0 = kk0[t] * __expf(bl0 - bq0[t]), ko1 = kk1[t] * __expf(bl1 - bq1[t]);
        *(unsigned*)(wl + t * 272 + lane * 4) = cvtpk(qi0, qi1);
        *(unsigned*)(wl + 4352 + t * 272 + lane * 4) = cvtpk(kt0, kt1);
        const unsigned kp = cvtpk(ko0, ko1);
        kw0[t >> 1] |= (kp & 0xffffu) << (16 * (t & 1)); kw1[t >> 1] |= (kp >> 16) << (16 * (t & 1));
    }
    {
        const int c0 = 2 * lane, c1 = c0 + 1;
        unsigned char* k0p = rec + 4096 + (c0 >> 4) * 512 + (c0 & 15) * 8; unsigned char* k1p = rec + 4096 + (c1 >> 4) * 512 + (c1 & 15) * 8;
#pragma unroll
        for (int g = 0; g < 4; ++g) { *(u32x2*)(k0p + g * 128) = (u32x2){kw0[2 * g], kw0[2 * g + 1]}; *(u32x2*)(k1p + g * 128) = (u32x2){kw1[2 * g], kw1[2 * g + 1]}; }
        float* dp = (float*)(rec + 8192) + c0; dp[0] = __expf(bl0); dp[1] = __expf(bl1);
    }
    LDS_WAIT();
#pragma unroll
    for (int s = 0; s < 4; ++s) {
        const u32x2 lo = *(const u32x2*)(wl + fr * 272 + (32 * s + 4 * fq) * 2), hi = *(const u32x2*)(wl + fr * 272 + (32 * s + 16 + 4 * fq) * 2);
        *(u32x4*)(rec + s * 1024 + lane * 16) = (u32x4){lo.x, lo.y, hi.x, hi.y};
    }
    f32x4 at = (f32x4){0.f, 0.f, 0.f, 0.f};
#pragma unroll
    for (int s = 0; s < 4; ++s) {
        const bf16x8 kf = *(const bf16x8*)(wl + 4352 + fr * 272 + (32 * s + 8 * fq) * 2);
        const bf16x8 qf = *(const bf16x8*)(wl + fr * 272 + (32 * s + 8 * fq) * 2);
        at = __builtin_amdgcn_mfma_f32_16x16x32_bf16(kf, qf, at, 0, 0, 0);
    }
#pragma unroll
    for (int r = 0; r < 4; ++r) { const int sp = 4 * fq + r; const bool keep = DIR ? (sp >= fr) : (sp <= fr); at[r] = keep ? at[r] : 0.f; }
    union { u32x2 u; s16x4 h; } bop; bop.u = (u32x2){cvtpk(at[0], at[1]), cvtpk(at[2], at[3])};
#pragma unroll
    for (int vb = 0; vb < 8; ++vb) {
        union { u32x2 u; s16x4 h; } aop; aop.u = *(const u32x2*)(wl + 8704 + (vb * 16 + fr) * 32 + 8 * fq);
        oT[vb] = __builtin_amdgcn_mfma_f32_16x16x16bf16_1k(aop.h, bop.h, oT[vb], 0, 0, 0);
    }
    LDS_WAIT();
}

__device__ __forceinline__ void phase_gla_pre2(const Params& p, int l, unsigned char* lds) {
    const int tid = otid(), lane = tid & 63, wid = __builtin_amdgcn_readfirstlane(tid >> 6), fr = lane & 15, fq = lane >> 4;
    unsigned char* wl = lds + wid * 12800;
    unsigned char* ws = ows(p);
    const bf16_t* pb = (const bf16_t*)(ws + WS_P); bf16_t* ointra = (bf16_t*)(ws + WS_OINTRA);
    float lb[2][2];
    {
        const float* hl = oin(p, 10);
#pragma unroll
        for (int d = 0; d < 2; ++d)
#pragma unroll
            for (int e = 0; e < 2; ++e) {
                const float* q = hl + (size_t)d * 4 * 512 + (2 * lane + e);
                lb[d][e] = 0.f; (void)q;
            }
    }
    for (int unit = wid * (int)gridDim.x + obid(); unit < NCHUNK * 4; unit += gridDim.x * 8) {
        const int chunk = unit >> 2, h = unit & 3, R0 = chunk * 16;
        {
            const float* hl = oin(p, 10);
#pragma unroll
            for (int d = 0; d < 2; ++d)
#pragma unroll
                for (int e = 0; e < 2; ++e) {
                    const float* q = hl + (size_t)d * 4 * 512 + h * 128 + 2 * lane + e;
                    const float z0 = q[0], z1 = q[512], z2 = q[1024], z3 = q[1536];
                    const float mx = fmaxf(fmaxf(z0, z1), fmaxf(z2, z3));
                    const float e0 = __expf(z0 - mx), e1 = __expf(z1 - mx), e2 = __expf(z2 - mx), e3 = __expf(z3 - mx);
                    lb[d][e] = ((l >= 1 ? e1 : 0.f) + (l >= 2 ? e2 : 0.f) + (l >= 3 ? e3 : 0.f)) / (e0 + e1 + e2 + e3);
                }
        }
        unsigned rq[16], rf[16], rb[16], rv[16];
#pragma unroll
        for (int t = 0; t < 16; ++t) {
            const bf16_t* base = pb + (size_t)(R0 + t) * PW + h * 128 + 2 * lane;
            rq[t] = *(const unsigned*)(base + OFF_Q); rf[t] = *(const unsigned*)(base + OFF_ZF); rb[t] = *(const unsigned*)(base + OFF_ZF + 512); rv[t] = *(const unsigned*)(base + OFF_I);
        }
        unsigned char* vrec = ws + WS_VREC + (size_t)(chunk * 4 + h) * VREC_BYTES;
        {
            unsigned w0[8], w1[8];
#pragma unroll
            for (int i = 0; i < 8; ++i) { w0[i] = (rv[2 * i] & 0xffffu) | (rv[2 * i + 1] << 16); w1[i] = (rv[2 * i] >> 16) | (rv[2 * i + 1] & 0xffff0000u); }
            const int c0 = 2 * lane, c1 = c0 + 1;
            unsigned char* v0p = vrec + (c0 >> 4) * 512 + (c0 & 15) * 8; unsigned char* v1p = vrec + (c1 >> 4) * 512 + (c1 & 15) * 8;
#pragma unroll
            for (int g = 0; g < 4; ++g) { *(u32x2*)(v0p + g * 128) = (u32x2){w0[2 * g], w0[2 * g + 1]}; *(u32x2*)(v1p + g * 128) = (u32x2){w1[2 * g], w1[2 * g + 1]}; }
            unsigned char* vl = wl + 8704 + c0 * 32;
            *(u32x4*)(vl) = (u32x4){w0[0], w0[1], w0[2], w0[3]}; *(u32x4*)(vl + 16) = (u32x4){w0[4], w0[5], w0[6], w0[7]};
            *(u32x4*)(vl + 32) = (u32x4){w1[0], w1[1], w1[2], w1[3]}; *(u32x4*)(vl + 48) = (u32x4){w1[4], w1[5], w1[6], w1[7]};
        }
        f32x4 oT[8];
#pragma unroll
        for (int vb = 0; vb < 8; ++vb) oT[vb] = (f32x4){0.f, 0.f, 0.f, 0.f};
        float q0a[16], q1a[16];
#pragma unroll
        for (int t = 0; t < 16; ++t) { q0a[t] = siluf(bflo(rq[t])); q1a[t] = siluf(bfhi(rq[t])); }
        gla_pre2_dir<0>(q0a, q1a, rf, lb[0][0], lb[0][1], wl, ws + WS_GREC + ((size_t)(0 * NCHUNK + chunk) * 4 + h) * REC_BYTES, oT, lane, fr, fq);
        gla_pre2_dir<1>(q0a, q1a, rb, lb[1][0], lb[1][1], wl, ws + WS_GREC + ((size_t)(1 * NCHUNK + chunk) * 4 + h) * REC_BYTES, oT, lane, fr, fq);
#pragma unroll
        for (int vb = 0; vb < 8; ++vb) *(u32x2*)(ointra + (size_t)(R0 + fr) * 512 + h * 128 + vb * 16 + 4 * fq) = (u32x2){cvtpk(oT[vb][0], oT[vb][1]), cvtpk(oT[vb][2], oT[vb][3])};
    }
}

constexpr int GR = 8, STG_BYTES = REC_BYTES + VREC_BYTES;
__device__ __forceinline__ int gla_chunk_of_step(int c, int b, int dir) {
    if (c < 16) { const int cm = dir ? 15 - c : c; return (NLAT + b * 256) / 16 + cm; }
    const int cc = c - 16; const int cm = dir ? 127 - cc : cc; return b * 128 + cm;
}
constexpr int SG_STEP = REC_BYTES + 2048, SG_GRP = 2 * SG_STEP, SG_NG = 6;
constexpr int SG_DUMP = SG_NG * SG_GRP;
constexpr int SG_FLAGS = LDS_MISC + 2048;
constexpr unsigned SG_SPIN = 1u << 22;
static_assert(SG_DUMP + 1024 <= LDS_MISC, "scan ring");
__device__ __forceinline__ void gla_scan_unit(const Params& p, int l, unsigned char* lds_, int chain, int vhalf) {
    LAS unsigned char* lds = (LAS unsigned char*)lds_;
    const int tid = otid(), lane = tid & 63, wid = __builtin_amdgcn_readfirstlane(tid >> 6), fr = lane & 15, fq = lane >> 4;
    unsigned char* ws = ows(p);
    const int b = chain >> 3, h = (chain >> 1) & 3, dir = chain & 1;
    volatile LAS unsigned* flg = (volatile LAS unsigned*)(lds + SG_FLAGS);
    __syncthreads();
    if (tid < 32) flg[tid] = 0u;
    __syncthreads();
    if (wid >= 4) {
        const int m = wid & 3;
        const unsigned char* grec = ws + WS_GREC + (size_t)dir * NCHUNK * 4 * REC_BYTES + (size_t)h * REC_BYTES + lane * 16;
        const unsigned char* vrec = ws + WS_VREC + (size_t)h * VREC_BYTES + vhalf * 2048 + lane * 16;
        const volatile LAS unsigned* dn = flg + 4 + (lane & 3);
#define GSEQ_ISSUE(gi) do { const int _g = (gi); _Pragma("unroll") for (int _j = 0; _j < 6; ++_j) { const int _p = m + 4 * _j; const bool _real = _p < 22; const int _s = _real ? _p / 11 : 0, _q = _real ? _p % 11 : 0; \
        const int _c = 2 * _g + _s; const int _cc = _c < 144 ? _c : 143; const int _ch = gla_chunk_of_step(_cc, b, dir); \
        const unsigned char* _src = (_q < 9) ? grec + (size_t)_ch * 4 * REC_BYTES + _q * 1024 : vrec + (size_t)_ch * 4 * VREC_BYTES + (_q - 9) * 1024; \
        const unsigned _dst = _real ? (unsigned)(_g % SG_NG) * SG_GRP + _s * SG_STEP + _q * 1024 : (unsigned)SG_DUMP; \
        __builtin_amdgcn_global_load_lds((const unsigned*)_src, (LAS unsigned*)(lds + _dst), 16, 0, 0); } } while (0)
#pragma unroll 1
        for (int g = 0; g < SG_NG - 1; ++g) GSEQ_ISSUE(g);
#pragma unroll 1
        for (int g = 0; g < 72; ++g) {
            asm volatile("s_waitcnt vmcnt(%0)" :: "n"((SG_NG - 2) * 6) : "memory");
            if (lane == 0) flg[m] = (unsigned)(g + 1);
            { unsigned sp = 0; while (__builtin_amdgcn_ballot_w64(*dn < (unsigned)g) != 0ull && ++sp < SG_SPIN) __builtin_amdgcn_s_sleep(1); asm volatile("" ::: "memory"); }
            GSEQ_ISSUE(g + SG_NG - 1);
        }
#undef GSEQ_ISSUE
    } else {
        const int vt = wid;
        bf16_t* ointer = (bf16_t*)(ws + WS_OINTER) + (size_t)dir * NTOK * 512 + h * 128 + (vhalf * 4 + vt) * 16 + fr;
        const volatile LAS unsigned* fl = flg + (lane & 3);
        f32x4 acc[8];
#pragma unroll
        for (int j = 0; j < 8; ++j) acc[j] = (f32x4){0.f, 0.f, 0.f, 0.f};
        union { u32x4 u; bf16x8 h; } sb[4];
#pragma unroll
        for (int j = 0; j < 4; ++j) sb[j].u = (u32x4){0u, 0u, 0u, 0u};
#pragma unroll 1
        for (int g = 0; g < 72; ++g) {
            { unsigned sp = 0; while (__builtin_amdgcn_ballot_w64(*fl < (unsigned)(g + 1)) != 0ull && ++sp < SG_SPIN) { } asm volatile("" ::: "memory"); }
#pragma unroll
            for (int s2 = 0; s2 < 2; ++s2) {
                const int c = 2 * g + s2;
                const LAS unsigned char* st = lds + (unsigned)(g % SG_NG) * SG_GRP + s2 * SG_STEP;
                const int chunk = gla_chunk_of_step(c, b, dir);
                bf16x8 qa[4]; f32x4 dv[8];
                union { u32x2 u; s16x4 h; } ka[8], vb;
#pragma unroll
                for (int j = 0; j < 4; ++j) qa[j] = *(const LAS bf16x8*)(st + j * 1024 + lane * 16);
                vb.u = *(const LAS u32x2*)(st + REC_BYTES + vt * 512 + lane * 8);
#pragma unroll
                for (int j = 0; j < 8; ++j) { ka[j].u = *(const LAS u32x2*)(st + 4096 + j * 512 + lane * 8); dv[j] = *(const LAS f32x4*)(st + 8192 + (j * 16 + 4 * fq) * 4); }
                f32x4 o0 = (f32x4){0.f, 0.f, 0.f, 0.f}, o1 = (f32x4){0.f, 0.f, 0.f, 0.f};
                o0 = __builtin_amdgcn_mfma_f32_16x16x32_bf16(qa[0], sb[0].h, o0, 0, 0, 0); o1 = __builtin_amdgcn_mfma_f32_16x16x32_bf16(qa[1], sb[1].h, o1, 0, 0, 0);
                o0 = __builtin_amdgcn_mfma_f32_16x16x32_bf16(qa[2], sb[2].h, o0, 0, 0, 0); o1 = __builtin_amdgcn_mfma_f32_16x16x32_bf16(qa[3], sb[3].h, o1, 0, 0, 0);
#pragma unroll
                for (int j = 0; j < 8; ++j) {
                    acc[j] = acc[j] * dv[j];
                    acc[j] = __builtin_amdgcn_mfma_f32_16x16x16bf16_1k(ka[j].h, vb.h, acc[j], 0, 0, 0);
                }
                const f32x4 os = o0 + o1;
                bf16_t* op = ointer + (size_t)(chunk * 16 + 4 * fq) * 512;
                { const unsigned w01 = cvtpk(os[0], os[1]), w23 = cvtpk(os[2], os[3]); op[0] = (bf16_t)(w01 & 0xffffu); op[512] = (bf16_t)(w01 >> 16); op[1024] = (bf16_t)(w23 & 0xffffu); op[1536] = (bf16_t)(w23 >> 16); }
#pragma unroll
                for (int j = 0; j < 4; ++j) sb[j].u = (u32x4){cvtpk(acc[2 * j][0], acc[2 * j][1]), cvtpk(acc[2 * j][2], acc[2 * j][3]), cvtpk(acc[2 * j + 1][0], acc[2 * j + 1][1]), cvtpk(acc[2 * j + 1][2], acc[2 * j + 1][3])};
            }
            asm volatile("s_waitcnt lgkmcnt(0)" ::: "memory");
            if (lane == 0) flg[4 + wid] = (unsigned)(g + 1);
        }
    }
    asm volatile("s_waitcnt vmcnt(0) lgkmcnt(0)" ::: "memory");
    __syncthreads();
}
__device__ __forceinline__ void phase_gla_seq2(const Params& p, int l, unsigned char* lds) {
    const int G = (int)gridDim.x, bid = obid();
    const int nscan = (G >= 256) ? 128 : G;
    for (int rep = 0; rep < ((DUPK == 50) ? 2 : 1); ++rep) {
        for (int r2 = 0; r2 < ((DUPK == 51) ? 2 : 1); ++r2)
        if (bid < nscan) for (int u = bid; u < 128; u += nscan) { const int x = u & 7, jj = u >> 3; gla_scan_unit(p, l, lds, x + 8 * (jj >> 1), jj & 1); }
        const int cg0 = (G == 256) ? l * CV_LAYER + CV_B : l * CV_ALL, cg1 = (G == 256) ? l * CV_LAYER + CV_B + CV_S : (l + 1) * CV_ALL;
        for (int r3 = 0; r3 < ((DUPK == 52) ? 2 : 1); ++r3)
        if (G > nscan) { if (bid >= nscan) { const int widx = (bid - nscan) * 8 + (otid() >> 6), nwv = (G - nscan) * 8; conv_rows(p, l, widx, nwv); convert_range(p, (float*)(lds + (otid() >> 6) * 16384), widx, nwv, cg0, cg1); } }
        else { const int widx = bid * 8 + (otid() >> 6), nwv = G * 8; __syncthreads(); conv_rows(p, l, widx, nwv); convert_range(p, (float*)(lds + (otid() >> 6) * 16384), widx, nwv, cg0, cg1); }
    }
}

__device__ __forceinline__ void phase_gla_post(const Params& p, int l) {
    const int lane = otid() & 63, wid = otid() >> 6;
    const bf16_t* pb = (const bf16_t*)(ows(p) + WS_P); bf16_t* yb = (bf16_t*)(ows(p) + WS_Y);
    const bf16_t* oi = (const bf16_t*)(ows(p) + WS_OINTRA); const bf16_t* oe = (const bf16_t*)(ows(p) + WS_OINTER);
    const float* hnw = oin(p, 11) + (size_t)l * 128;
    const int nrows = (l == DEPTH - 1) ? NLAT : NTOK;
    const int c0 = lane * 8;
    float hw[8];
#pragma unroll
    for (int j = 0; j < 8; ++j) hw[j] = hnw[(c0 + j) & 127];
    constexpr int PNB = 3;
    const int nwv = (int)gridDim.x * 8;
    for (int rb = obid() * 8 + wid; rb < nrows; rb += PNB * nwv) {
        u32x4 gw[PNB], wi[PNB], w1[PNB], w2[PNB];
#pragma unroll
        for (int q = 0; q < PNB; ++q) {
            int r = rb + q * nwv; if (r >= nrows) r = rb;
            gw[q] = *(const u32x4*)(pb + (size_t)r * PW + OFF_G + c0); wi[q] = *(const u32x4*)(oi + (size_t)r * 512 + c0);
            w1[q] = *(const u32x4*)(oe + (size_t)r * 512 + c0); w2[q] = *(const u32x4*)(oe + ((size_t)NTOK + r) * 512 + c0);
        }
#pragma unroll
        for (int q = 0; q < PNB; ++q) {
            const int r = rb + q * nwv;
            float o[8], t1[8], t2[8]; float ss = 0.f;
            unpack8(wi[q], o); unpack8(w1[q], t1); unpack8(w2[q], t2);
#pragma unroll
            for (int j = 0; j < 8; ++j) { o[j] += t1[j] + t2[j]; ss += o[j] * o[j]; }
            ss += __shfl_xor(ss, 1); ss += __shfl_xor(ss, 2); ss += __shfl_xor(ss, 4); ss += __shfl_xor(ss, 8);
            const float rstd = rsqrtf(ss * (1.0f / 128.0f) + EPS);
            float g[8]; unpack8(gw[q], g);
            float y[8];
#pragma unroll
            for (int j = 0; j < 8; ++j) y[j] = o[j] * rstd * hw[j] * siluf(g[j]);
            if (r < nrows) {
                if (G2_FP8) { u32x2 w8; w8.x = pk4_fp8(8.0f * y[0], 8.0f * y[1], 8.0f * y[2], 8.0f * y[3]); w8.y = pk4_fp8(8.0f * y[4], 8.0f * y[5], 8.0f * y[6], 8.0f * y[7]); *(u32x2*)((unsigned char*)yb + (size_t)r * 1024 + 512 + c0) = w8; }
                else { u32x4 w; w.x = pk2(y[0], y[1]); w.y = pk2(y[2], y[3]); w.z = pk2(y[4], y[5]); w.w = pk2(y[6], y[7]); *(u32x4*)(yb + (size_t)r * 1024 + 512 + c0) = w; }
            }
        }
    }
}

__device__ __forceinline__ void phase_gemm2(const Params& p, int l, unsigned char* lds) {
    const bf16_t* yb = (const bf16_t*)(ows(p) + WS_Y); const bf16_t* wt = (const bf16_t*)(ows(p) + WS_WOUT) + (size_t)l * 1024 * 1024;
    float* xws = (float*)(ows(p) + WS_X); const float* modv = (const float*)(ows(p) + WS_MOD);
    const int MT = ((l == DEPTH - 1) ? NLAT : NTOK) / 128; constexpr int NT = 8;
    for (int u = obid(); u < MT * NT; u += gridDim.x) {
        const int mt = u / NT, nt = u % NT;
        ARowPlain ar{yb + (size_t)mt * 128 * 1024, 1024};
        EpiRes ep{xws + (size_t)mt * 128 * 1024 + nt * 128, modv + (size_t)l * 9 * 6144 + 2 * 1024 + nt * 128, mt * 128};
        gemm128(lds, ar, wt + (size_t)nt * 128 * 1024, 1024, ep);
    }
}

__device__ __forceinline__ void phase_router(const Params& p, int l) {
    const int lane = otid() & 63, wid = otid() >> 6;
    const float* xws = (const float*)(ows(p) + WS_X); bf16_t* hb = (bf16_t*)(ows(p) + WS_H);
    const float* modv = (const float*)(ows(p) + WS_MOD); const float* nw = oin(p, 4) + (size_t)(l * 2 + 1) * 1024;
    const float* wrg = oin(p, 13) + (size_t)l * 1024 * 4; const float* wre = oin(p, 15) + (size_t)l * 1024 * 32;
    const float* brg = oin(p, 14) + l * 4; const float* bre = oin(p, 16) + l * 32;
    unsigned* cnt = (unsigned*)(ows(p) + WS_CTL) + CW_CNT + 64 * l;
    int* ltok = (int*)(ows(p) + WS_LTOK); float* lgate = (float*)(ows(p) + WS_LGATE);
    const int nrows = (l == DEPTH - 1) ? NLAT : NTOK;
    for (int r = obid() * 8 + wid; r < nrows; r += gridDim.x * 8) {
        const int mr = mod_row(r);
        float ss = 0.f;
#pragma unroll
        for (int j = 0; j < 4; ++j) { const f32x4 xv4 = *(const f32x4*)(xws + (size_t)r * 1024 + 4 * lane + 256 * j); ss += (xv4[0] * xv4[0] + xv4[1] * xv4[1]) + (xv4[2] * xv4[2] + xv4[3] * xv4[3]); }
        const float rstd = rsqrtf(wave_sum(ss) * (1.0f / 1024.0f) + EPS);
        const float* msh = modv + ((size_t)l * 9 + mr) * 6144 + 3 * 1024; const float* msc = msh + 1024;
        float lg[36];
#pragma unroll
        for (int i = 0; i < 36; ++i) lg[i] = 0.f;
#pragma unroll 1
        for (int j = 0; j < 4; ++j) {
            const int c = 4 * lane + 256 * j;
            const f32x4 xv4 = *(const f32x4*)(xws + (size_t)r * 1024 + c);
            const f32x4 w = *(const f32x4*)(nw + c), sh = *(const f32x4*)(msh + c), sc = *(const f32x4*)(msc + c);
            const f32x4 h = (xv4 * rstd * w) * (1.0f + sc) + sh;
            u32x2 o; o.x = pk2(h[0], h[1]); o.y = pk2(h[2], h[3]);
            *(u32x2*)(hb + (size_t)r * 1024 + c) = o;
#pragma unroll
            for (int e = 0; e < 4; ++e) {
                const float xv = h[e];
                const f32x4 wg = *(const f32x4*)(wrg + (size_t)(c + e) * 4);
                lg[0] += xv * wg[0]; lg[1] += xv * wg[1]; lg[2] += xv * wg[2]; lg[3] += xv * wg[3];
#pragma unroll
                for (int q = 0; q < 8; ++q) {
                    const f32x4 we = *(const f32x4*)(wre + (size_t)(c + e) * 32 + q * 4);
                    lg[4 + q * 4 + 0] += xv * we[0]; lg[4 + q * 4 + 1] += xv * we[1]; lg[4 + q * 4 + 2] += xv * we[2]; lg[4 + q * 4 + 3] += xv * we[3];
                }
            }
        }
#pragma unroll
        for (int i = 0; i < 36; ++i) lg[i] = wave_sum(lg[i]);
        float gl[4];
#pragma unroll
        for (int i = 0; i < 4; ++i) gl[i] = lg[i] + brg[i];
        int gsel = 0; float gmax = gl[0];
#pragma unroll
        for (int i = 1; i < 4; ++i) if (gl[i] > gmax) { gmax = gl[i]; gsel = i; }
        float gs = 0.f;
#pragma unroll
        for (int i = 0; i < 4; ++i) gs += __expf(gl[i] - gmax);
        const float pg = 1.0f / gs;
        float el[8];
#pragma unroll
        for (int j = 0; j < 8; ++j) {
            float t = lg[4 + j] + bre[j];
#pragma unroll
            for (int g = 1; g < 4; ++g) t = (gsel == g) ? (lg[4 + g * 8 + j] + bre[g * 8 + j]) : t;
            el[j] = t;
        }
        int i1 = 0; float v1 = el[0];
#pragma unroll
        for (int j = 1; j < 8; ++j) if (el[j] > v1) { v1 = el[j]; i1 = j; }
        int i2 = -1; float v2 = -3.0e38f;
#pragma unroll
        for (int j = 0; j < 8; ++j) if (j != i1 && el[j] > v2) { v2 = el[j]; i2 = j; }
        const float e2 = __expf(v2 - v1);
        const float g0 = pg / (1.0f + e2), g1 = pg * e2 / (1.0f + e2);
        if (lane == 0) {
            const int ea = gsel * 8 + i1, eb = gsel * 8 + i2;
            const unsigned pa = atomicAdd(cnt + ea, 1u); ltok[(size_t)ea * NTOK + pa] = r * 2 + 0; lgate[(size_t)ea * NTOK + pa] = g0;
            const unsigned pb2 = atomicAdd(cnt + eb, 1u); ltok[(size_t)eb * NTOK + pb2] = r * 2 + 1; lgate[(size_t)eb * NTOK + pb2] = g1;
        }
    }
}


__device__ __forceinline__ void phase_router2(const Params& p, int l, unsigned char* lds, bool commit) {
    const int tid = otid(), lane = tid & 63, wid = __builtin_amdgcn_readfirstlane(tid >> 6), fr = lane & 15, fq = lane >> 4;
    unsigned char* ws = ows(p);
    const bf16_t* xws = (const bf16_t*)(ws + WS_X); bf16_t* xw = (bf16_t*)(ws + WS_X); const bf16_t* dlt = (const bf16_t*)(ws + WS_DELTA); bf16_t* hb = (bf16_t*)(ws + WS_H);
    const float* modv = (const float*)(ws + WS_MOD); const float* nw = oin(p, 4) + (size_t)(l * 2 + 1) * 1024;
    const float* brg = oin(p, 14) + l * 4; const float* bre = oin(p, 16) + l * 32;
    unsigned* gcnt = (unsigned*)(ws + WS_CTL) + CW_CNT + 64 * 32 * l;
    int* ltok = (int*)(ws + WS_LTOK); float* lgate = (float*)(ws + WS_LGATE);
    constexpr int WPITCH = 2064, WBYTES = 48 * WPITCH;
    unsigned char* wl = lds;
    float* tile = (float*)(lds + WBYTES + (wid < 5 ? wid : 4) * 3328);
    int* s_cnt = (int*)(lds + WBYTES + 5 * 3328); int* s_base = s_cnt + 32;
    int* s_e = s_base + 32; int* s_rank = s_e + 256; int* s_tok = s_rank + 256; float* s_gate = (float*)(s_tok + 256);
    float* modt = (float*)(s_gate + 256);
    static_assert(WBYTES + 5 * 3328 + 4352 + 16384 <= LDS_MISC, "router LDS");
    __syncthreads();
    {
        const bf16_t* wrh = (const bf16_t*)(ws + WS_WRH) + (size_t)l * 48 * 1024;
        u32x4 wv[12];
#pragma unroll
        for (int j = 0; j < 12; ++j) { const int i = tid + 512 * j, r = i >> 7, c = i & 127; wv[j] = *(const u32x4*)(wrh + (size_t)r * 1024 + c * 8); }
#pragma unroll
        for (int j = 0; j < 12; ++j) { const int i = tid + 512 * j, r = i >> 7, c = i & 127; *(u32x4*)(wl + r * WPITCH + c * 16) = wv[j]; }
    }
    const int NQ = NLAT / 64, NCG = (l == DEPTH - 1) ? 0 : NCTX / 16, G = (int)gridDim.x;
    for (int it = 0; it * G < (NQ > NCG ? NQ : NCG); ++it) {
        const int quad = it * G + obid();
        const int g = (wid < 4) ? (quad < NQ ? 4 * quad + wid : -1) : (wid == 4 && quad < NCG) ? NLAT / 16 + quad : -1;
        __syncthreads();
        if (tid < 32) s_cnt[tid] = 0;
        if (tid < 256) s_e[tid] = -1;
        {
            const int smp = quad < NQ ? (quad >> 5) : 0;
            float wq[2], sq0[2], cq0[2], sq1[2], cq1[2];
#pragma unroll
            for (int j = 0; j < 2; ++j) { const int i = tid + 512 * j; const float* m0 = modv + ((size_t)l * 9 + smp) * 6144 + 3 * 1024; const float* m1 = modv + ((size_t)l * 9 + 8) * 6144 + 3 * 1024;
                wq[j] = nw[i]; sq0[j] = m0[i]; cq0[j] = m0[1024 + i]; sq1[j] = m1[i]; cq1[j] = m1[1024 + i]; }
#pragma unroll
            for (int j = 0; j < 2; ++j) { const int i = tid + 512 * j; modt[i] = wq[j] * (1.0f + cq0[j]); modt[1024 + i] = sq0[j]; modt[2048 + i] = wq[j] * (1.0f + cq1[j]); modt[3072 + i] = sq1[j]; }
        }
        __syncthreads();
        if (g >= 0) {
            const int R0 = g * 16;
            const size_t rofs = (size_t)(R0 + fr) * 1024 + 16 * fq;
            u32x4 xk[32]; float ss = 0.f;
#pragma unroll
            for (int pb4 = 0; pb4 < 4; ++pb4) {
                u32x4 xa[4][2], da[4][2];
#pragma unroll
                for (int pp = 0; pp < 4; ++pp)
#pragma unroll
                    for (int e = 0; e < 2; ++e) { const int k = 64 * (pb4 * 4 + pp) + 8 * e; xa[pp][e] = *(const u32x4*)(xws + rofs + k); da[pp][e] = *(const u32x4*)(dlt + rofs + k); }
#pragma unroll
                for (int pp = 0; pp < 4; ++pp)
#pragma unroll
                    for (int e = 0; e < 2; ++e) {
                        const int k = 64 * (pb4 * 4 + pp) + 8 * e;
                        float xf[8], df[8]; unpack8(xa[pp][e], xf); unpack8(da[pp][e], df);
                        u32x4 o = xa[pp][e];
                        if (commit) {
#pragma unroll
                            for (int j = 0; j < 8; ++j) xf[j] += df[j];
                            o = (u32x4){cvtpk(xf[0], xf[1]), cvtpk(xf[2], xf[3]), cvtpk(xf[4], xf[5]), cvtpk(xf[6], xf[7])};
                            *(u32x4*)(xw + rofs + k) = o;
                            unpack8(o, xf);
                        }
                        xk[2 * (pb4 * 4 + pp) + e] = o;
#pragma unroll
                        for (int j = 0; j < 8; ++j) ss += xf[j] * xf[j];
                    }
                __builtin_amdgcn_sched_barrier(0);
            }
            ss += __shfl_xor(ss, 16); ss += __shfl_xor(ss, 32);
            const float my_rstd = rsqrtf(ss * (1.0f / 1024.0f) + EPS);
#pragma unroll
            for (int u = 0; u < 32; ++u) asm volatile("" : "+v"(xk[u]));
            const float* gt = modt + (wid == 4 ? 2048 : 0) + 16 * fq; const float* st = gt + 1024;
            bf16_t* hrow = hb + rofs; unsigned char* h8row = ws + WS_H8 + rofs;
            f32x4 acc[3];
#pragma unroll
            for (int nt = 0; nt < 3; ++nt) acc[nt] = (f32x4){0.f, 0.f, 0.f, 0.f};
#pragma unroll
            for (int u = 0; u < 32; ++u) {
                const int k = 64 * (u >> 1) + 8 * (u & 1);
                float xf[8], hv[8]; unpack8(xk[u], xf);
#pragma unroll
                for (int q = 0; q < 2; ++q) {
                    const f32x4 gq = *(const f32x4*)(gt + k + 4 * q), sq = *(const f32x4*)(st + k + 4 * q);
#pragma unroll
                    for (int j = 0; j < 4; ++j) hv[4 * q + j] = (xf[4 * q + j] * my_rstd) * gq[j] + sq[j];
                }
                union { u32x4 u; bf16x8 h; } ah, al;
                ah.u = (u32x4){cvtpk(hv[0], hv[1]), cvtpk(hv[2], hv[3]), cvtpk(hv[4], hv[5]), cvtpk(hv[6], hv[7])};
                float lv[8];
#pragma unroll
                for (int q = 0; q < 4; ++q) { const unsigned w2 = q == 0 ? ah.u.x : q == 1 ? ah.u.y : q == 2 ? ah.u.z : ah.u.w; lv[2 * q] = hv[2 * q] - __uint_as_float(w2 << 16); lv[2 * q + 1] = hv[2 * q + 1] - __uint_as_float(w2 & 0xffff0000u); }
                al.u = (u32x4){cvtpk(lv[0], lv[1]), cvtpk(lv[2], lv[3]), cvtpk(lv[4], lv[5]), cvtpk(lv[6], lv[7])};
                if (MOE_FP8) { u32x2 h8; h8.x = pk4_fp8(hv[0], hv[1], hv[2], hv[3]); h8.y = pk4_fp8(hv[4], hv[5], hv[6], hv[7]); *(u32x2*)(h8row + k) = h8; }
                else *(u32x4*)(hrow + k) = ah.u;
#pragma unroll
                for (int nt = 0; nt < 3; ++nt) {
                    const bf16x8 bh = *(const bf16x8*)(wl + (nt * 16 + fr) * WPITCH + (k + 16 * fq) * 2);
                    acc[nt] = __builtin_amdgcn_mfma_f32_16x16x32_bf16(ah.h, bh, acc[nt], 0, 0, 0);
                    acc[nt] = __builtin_amdgcn_mfma_f32_16x16x32_bf16(al.h, bh, acc[nt], 0, 0, 0);
                }
                __builtin_amdgcn_sched_barrier(0);
            }
#pragma unroll
            for (int nt = 0; nt < 3; ++nt)
#pragma unroll
                for (int r = 0; r < 4; ++r) tile[(4 * fq + r) * 52 + nt * 16 + fr] = acc[nt][r];
            LDS_WAIT();
            if (lane < 16) {
                const float* lg = tile + lane * 52;
                float gl[4];
#pragma unroll
                for (int i = 0; i < 4; ++i) gl[i] = lg[i] + brg[i];
                int gsel = 0; float gmax = gl[0];
#pragma unroll
                for (int i = 1; i < 4; ++i) if (gl[i] > gmax) { gmax = gl[i]; gsel = i; }
                float gs = 0.f;
#pragma unroll
                for (int i = 0; i < 4; ++i) gs += __expf(gl[i] - gmax);
                const float pg = 1.0f / gs;
                float el[8];
#pragma unroll
                for (int j = 0; j < 8; ++j) el[j] = lg[4 + gsel * 8 + j] + bre[gsel * 8 + j];
                int i1 = 0; float v1 = el[0];
#pragma unroll
                for (int j = 1; j < 8; ++j) if (el[j] > v1) { v1 = el[j]; i1 = j; }
                int i2 = -1; float v2 = -3.0e38f;
#pragma unroll
                for (int j = 0; j < 8; ++j) if (j != i1 && el[j] > v2) { v2 = el[j]; i2 = j; }
                const float e2 = __expf(v2 - v1);
                const float g0 = pg / (1.0f + e2), g1 = pg * e2 / (1.0f + e2);
                const int ea = gsel * 8 + i1, eb = gsel * 8 + i2, slot = (wid * 16 + lane) * 2, r = R0 + lane;
                s_e[slot] = ea; s_rank[slot] = atomicAdd(&s_cnt[ea], 1); s_tok[slot] = r * 2; s_gate[slot] = g0;
                s_e[slot + 1] = eb; s_rank[slot + 1] = atomicAdd(&s_cnt[eb], 1); s_tok[slot + 1] = r * 2 + 1; s_gate[slot + 1] = g1;
            }
        }
        __syncthreads();
        if (tid < 32) { const int c = s_cnt[tid]; s_base[tid] = (c > 0 && commit) ? (int)atomicAdd(gcnt + 64 * tid, (unsigned)c) : 0; }
        __syncthreads();
        if (tid < 256) { const int e = s_e[tid]; if (e >= 0 && commit) { const size_t pos = (size_t)e * NTOK + s_base[e] + s_rank[tid]; ltok[pos] = s_tok[tid]; lgate[pos] = s_gate[tid]; } }
    }
}

__device__ __forceinline__ int moe_tables(const Params& p, int l, unsigned char* lds) {
    int* s_pref = (int*)(lds + LDS_MISC); int* s_cnt = s_pref + 40;
    unsigned* cnt = (unsigned*)(ows(p) + WS_CTL) + CW_CNT + 64 * l;
    __syncthreads();
    if (otid() == 0) {
        int acc = 0;
        for (int e = 0; e < NEXP; ++e) { const int c = (int)__hip_atomic_load(cnt + e, __ATOMIC_RELAXED, __HIP_MEMORY_SCOPE_AGENT); s_cnt[e] = c; s_pref[e] = acc; acc += (c + 127) >> 7; }
        s_pref[NEXP] = acc;
    }
    __syncthreads();
    return s_pref[NEXP];
}
__device__ __forceinline__ void phase_moe_gu(const Params& p, int l, unsigned char* lds) {
    const int T = moe_tables(p, l, lds);
    const int* s_pref = (const int*)(lds + LDS_MISC); const int* s_cnt = s_pref + 40;
    const bf16_t* hb = (const bf16_t*)(ows(p) + WS_H); bf16_t* hid = (bf16_t*)(ows(p) + WS_HID);
    const int* ltok = (const int*)(ows(p) + WS_LTOK);
    for (int u = obid(); u < T * 8; u += gridDim.x) {
        const int mtg = u >> 3, nt = u & 7;
        int e = 0;
        for (int q = 1; q < NEXP; ++q) if (s_pref[q] <= mtg) e = q;
        const int mt = mtg - s_pref[e]; const int nvalid = min(128, s_cnt[e] - mt * 128);
        ARowGather ar{hb, ltok + (size_t)e * NTOK + mt * 128, nvalid};
        EpiGU ep{hid + (size_t)mtg * 128 * 512 + nt * 64};
        gemm128(lds, ar, (const bf16_t*)(ows(p) + WS_WGU) + ((size_t)(l * 32 + e) * 1024 + nt * 128) * 1024, 1024, ep);
    }
}
__device__ __forceinline__ void phase_moe_down(const Params& p, int l, unsigned char* lds) {
    const int T = moe_tables(p, l, lds);
    const int* s_pref = (const int*)(lds + LDS_MISC); const int* s_cnt = s_pref + 40;
    const bf16_t* hid = (const bf16_t*)(ows(p) + WS_HID); bf16_t* yb = (bf16_t*)(ows(p) + WS_YB);
    const int* ltok = (const int*)(ows(p) + WS_LTOK); const float* lgate = (const float*)(ows(p) + WS_LGATE);
    for (int u = obid(); u < T * 8; u += gridDim.x) {
        const int mtg = u >> 3, nt = u & 7;
        int e = 0;
        for (int q = 1; q < NEXP; ++q) if (s_pref[q] <= mtg) e = q;
        const int mt = mtg - s_pref[e]; const int nvalid = min(128, s_cnt[e] - mt * 128);
        ARowPlain ar{hid + (size_t)mtg * 128 * 512, 512};
        EpiDown ep{yb + nt * 128, ltok + (size_t)e * NTOK + mt * 128, lgate + (size_t)e * NTOK + mt * 128, nvalid};
        gemm128(lds, ar, (const bf16_t*)(ows(p) + WS_WDN) + ((size_t)(l * 32 + e) * 1024 + nt * 128) * 512, 512, ep);
    }
}


#ifndef FAST_G1
#define FAST_G1 1
#endif
#ifndef FAST_G2
#define FAST_G2 1
#endif
#ifndef FAST_MOE
#define FAST_MOE 1
#endif
#ifndef FAST_GLA
#define FAST_GLA 1
#endif
#ifndef FAST_RT
#define FAST_RT 1
#endif
__device__ __forceinline__ void phase_gemm1_fast(const Params& p, int l, unsigned char* lds) {
    g8::DenseOrder S; S.init(NTOK / 256, PW / 256, (int)gridDim.x, obid(), (const bf16_t*)(ows(p) + WS_WIN) + (size_t)l * 4096 * 1024, 1024);
    g8::EpiP2 E{(bf16_t*)(ows(p) + WS_P)};
    g8::gemm_phase((LAS unsigned char*)lds, (const char*)(ows(p) + WS_H), 1024, S, E);
    if (gridDim.x == 256 && obid() >= 128) { __syncthreads(); convert_range(p, (float*)(lds + (otid() >> 6) * 16384), (obid() - 128) * 8 + (otid() >> 6), 128 * 8, l * CV_LAYER, l * CV_LAYER + CV_B); }
}
__device__ __forceinline__ void phase_gemm2_fast(const Params& p, int l, unsigned char* lds, float scl) {
    g8::DenseOrder S; g8::EpiDelta E{(bf16_t*)(ows(p) + WS_DELTA), (const float*)(ows(p) + WS_MOD) + (size_t)l * 9 * 6144 + 2 * 1024, scl};
    if (G2_FP8) {
        S.init(((l == DEPTH - 1) ? NLAT : NTOK) / 256, 4, (int)gridDim.x, obid(), ows(p) + WS_WOUT + (size_t)l * 1024 * 1024, 1024, 1);
        g8::gemm_phase8<0x7A7A7A7A, 0x7C7C7C7C>((LAS unsigned char*)lds, (const char*)(ows(p) + WS_Y), 1024, S, E);
    } else {
        S.init(((l == DEPTH - 1) ? NLAT : NTOK) / 256, 4, (int)gridDim.x, obid(), (const bf16_t*)(ows(p) + WS_WOUT) + (size_t)l * 1024 * 1024, 1024);
        g8::gemm_phase((LAS unsigned char*)lds, (const char*)(ows(p) + WS_Y), 1024, S, E);
    }
    if (gridDim.x == 256 && l < DEPTH - 1 && obid() >= 32 && scl != 0.0f) { __syncthreads(); convert_range(p, (float*)(lds + (otid() >> 6) * 16384), (obid() - 32) * 8 + (otid() >> 6), 224 * 8, l * CV_LAYER + CV_B + CV_S, (l + 1) * CV_LAYER); }
}
__device__ __forceinline__ int moe_tables256(const Params& p, int l, unsigned char* lds) {
    int* s_pref = (int*)(lds + LDS_MISC); int* s_cnt = s_pref + 40;
    unsigned* cnt = (unsigned*)(ows(p) + WS_CTL) + CW_CNT + 64 * 32 * l;
    __syncthreads();
    if (otid() < 64) {
        const int lane = otid();
        const int c = (lane < NEXP) ? (int)__hip_atomic_load(cnt + 64 * lane, __ATOMIC_RELAXED, __HIP_MEMORY_SCOPE_AGENT) : 0;
        const int t = (c + 255) >> 8; int incl = t;
#pragma unroll
        for (int d = 1; d < 32; d <<= 1) { const int o = __shfl_up(incl, d); if (lane >= d) incl += o; }
        if (lane < NEXP) { s_cnt[lane] = c; s_pref[lane] = incl - t; }
        if (lane == NEXP - 1) s_pref[NEXP] = incl;
    }
    __syncthreads();
    return s_pref[NEXP];
}
__device__ __forceinline__ void moe_setup(const Params& p, int l, unsigned char* lds) {
    const int T = moe_tables256(p, l, lds);
    const int* s_pref = (const int*)(lds + LDS_MISC); const int* s_cnt = s_pref + 40;
    int* utab = (int*)(lds + g8::MOE_UTAB); int* rtok = (int*)(lds + g8::MOE_RTOK); float* rgate = (float*)(lds + g8::MOE_RGATE);
    const int tid = otid(), G = (int)gridDim.x, c = obid();
    if (tid < 4 * NEXP) {
        const int i = tid >> 5, e = tid & 31; const int L = i * G + c; int* t = utab + i * 8;
        if (L < T * 4) {
            const int mtg = L >> 2;
            if (s_pref[e] <= mtg && mtg < s_pref[e + 1]) {
                const int mt = mtg - s_pref[e];
                t[0] = mtg; t[1] = L & 3; t[2] = e; t[3] = min(256, s_cnt[e] - mt * 256); t[4] = e * NTOK + mt * 256; t[5] = 1;
            }
        } else if (e == 0) { int z = 0; asm volatile("" : "+v"(z)); t[0] = z; t[1] = z; t[2] = z; t[3] = z; t[4] = z; t[5] = z; }
    }
    __syncthreads();
    const int* ltok = (const int*)(ows(p) + WS_LTOK); const float* lgate = (const float*)(ows(p) + WS_LGATE);
    {   int tk[2]; float gt[2];
#pragma unroll
        for (int j = 0; j < 2; ++j) { const int idx = tid + 512 * j, i = idx >> 8, r = idx & 255; const int* t = utab + i * 8; const bool ok = t[5] != 0 && r < t[3]; const int src = ok ? t[4] + r : 0;
            tk[j] = ltok[src]; gt[j] = lgate[src]; if (!ok) { tk[j] = 0; gt[j] = 0.f; } }
#pragma unroll
        for (int j = 0; j < 2; ++j) { rtok[tid + 512 * j] = tk[j]; rgate[tid + 512 * j] = gt[j]; }
    }
    __syncthreads();
}
__device__ __forceinline__ void phase_moe_gu_fast(const Params& p, int l, unsigned char* lds) {
    moe_setup(p, l, lds);
    g8::MoeOrder<true> S; S.utab = (const int*)(lds + g8::MOE_UTAB); S.rtok = (const int*)(lds + g8::MOE_RTOK); S.K = 1024;
    if (MOE_FP8) {
        S.W = (const char*)(ows(p) + WS_WGU8) + (size_t)l * 32 * 1024 * 1024; S.bpe = 1;
        g8::EpiGU8 E{ows(p) + WS_HID8};
        g8::gemm_phase8<0x7A7A7A7A, 0x7F7F7F7F>((LAS unsigned char*)lds, (const char*)(ows(p) + WS_H8), 1024, S, E);
    } else {
        S.W = (const char*)(ows(p) + WS_WGU) + (size_t)l * 32 * 1024 * 1024 * 2; S.bpe = 2;
        g8::EpiGU2 E{(bf16_t*)(ows(p) + WS_HID)};
        g8::gemm_phase((LAS unsigned char*)lds, (const char*)(ows(p) + WS_H), 1024, S, E);
    }
}
__device__ __forceinline__ void phase_moe_down_fast(const Params& p, int l, unsigned char* lds) {
    if (!(FAST_MOE && MOE_FP8) || DUPK == 10 || p.ph_hi - p.ph_lo == 1) moe_setup(p, l, lds);
    g8::MoeOrder<false> S; S.utab = (const int*)(lds + g8::MOE_UTAB); S.rtok = (const int*)(lds + g8::MOE_RTOK); S.K = 512;
    g8::EpiDown2 E{(bf16_t*)(ows(p) + WS_YB), (const int*)(lds + g8::MOE_RTOK), (const float*)(lds + g8::MOE_RGATE)};
    if (MOE_FP8) {
        S.W = (const char*)(ows(p) + WS_WDN8) + (size_t)l * 32 * 1024 * 512; S.bpe = 1;
        g8::EpiDown8 E8{ows(p) + WS_YB8, (const int*)(lds + g8::MOE_RTOK), (const float*)(lds + g8::MOE_RGATE)};
        g8::gemm_phase8<0x7B7B7B7B, 0x7E7E7E7E>((LAS unsigned char*)lds, (const char*)(ows(p) + WS_HID8), 512, S, E8);
    } else {
        S.W = (const char*)(ows(p) + WS_WDN) + (size_t)l * 32 * 1024 * 512 * 2; S.bpe = 2;
        g8::gemm_phase((LAS unsigned char*)lds, (const char*)(ows(p) + WS_HID), 512, S, E);
    }
}

__device__ __forceinline__ void phase_c(const Params& p, int l, unsigned char* lds) {
    phase_gla_pre2(p, l, lds);
}

__global__ void __launch_bounds__(512, 2) mk(Params p) {
    extern __shared__ __attribute__((aligned(16))) unsigned char lds[];
    const int lo = p.ph_lo, hi = p.ph_hi;
    volatile LAS unsigned* misc = (volatile LAS unsigned*)(lds + LDS_MISC + 1024);
    if (threadIdx.x < 4) misc[threadIdx.x] = 0u;
    __syncthreads();
    XcdBarrier bar; bar.bar = (unsigned*)(p.ws + WS_CTL) + CW_BAR; bar.x = 0; bar.st = misc;
    if (hi - lo > 1) bar = xcd_barrier_post((unsigned*)(p.ws + WS_CTL) + CW_BAR, misc);
#define IN(k) (lo <= (k) && (k) < hi)
#define SEAM(k) do { if (IN((k) + 1)) { xcd_barrier(bar); if (DUPK == 20) xcd_barrier(bar); } } while (0)
#define REP(kind) for (int _rep = 0; _rep < ((DUPK == (kind)) ? 2 : 1); ++_rep)
    if (IN(0)) { REP(0) phase_prologue(p, lds); SEAM(0); }
    if (IN(1)) { REP(1) phase_modreduce(p); SEAM(1); }
    for (int l = 0; l < DEPTH; ++l) {
        const int pb = 2 + 9 * l;
        if (IN(pb + 0)) { if (DUPK == 2) phase_norm1(p, l, (float)(lo > 1000)); phase_norm1(p, l, 1.0f); SEAM(pb + 0); }
        if (IN(pb + 1)) { REP(3) { if (FAST_G1) phase_gemm1_fast(p, l, lds); else phase_gemm1(p, l, lds); } SEAM(pb + 1); }
        if (IN(pb + 2)) { REP(4) { phase_c(p, l, lds); } SEAM(pb + 2); }
        if (IN(pb + 3)) { REP(5) { phase_gla_seq2(p, l, lds); } SEAM(pb + 3); }
        if (IN(pb + 4)) { REP(6) phase_gla_post(p, l); SEAM(pb + 4); }
        if (IN(pb + 5)) { if (DUPK == 7) phase_gemm2_fast(p, l, lds, (float)(lo > 1000)); phase_gemm2_fast(p, l, lds, 1.0f); SEAM(pb + 5); }
        if (IN(pb + 6)) { if (DUPK == 8) phase_router2(p, l, lds, lo > 1000); phase_router2(p, l, lds, true); SEAM(pb + 6); }
        if (IN(pb + 7)) { REP(9) { if (FAST_MOE) phase_moe_gu_fast(p, l, lds); else phase_moe_gu(p, l, lds); } SEAM(pb + 7); }
        if (IN(pb + 8)) { REP(10) { if (FAST_MOE) phase_moe_down_fast(p, l, lds); else phase_moe_down(p, l, lds); } SEAM(pb + 8); }
    }
    if (IN(NPH - 1)) { REP(11) phase_final(p); }
#undef IN
#undef SEAM
}

#ifndef MK_LAUNCHES
#define MK_LAUNCHES 1
#endif
extern "C" void kernel_launch(void* const* d_in, const int* in_sizes, int n_in, void* d_out, int out_size, void* d_ws, size_t ws_size, hipStream_t stream) {
    static int grid = 0;
    if (grid == 0) {
        int dev = 0, cus = 0;
        if (n_in != 20 || ws_size < WS_END) { fprintf(stderr, "kernel_launch: unexpected shapes (n_in %d, ws %zu < %zu)\n", n_in, ws_size, (size_t)WS_END); grid = -1; return; }
        if (hipGetDevice(&dev) != hipSuccess || hipDeviceGetAttribute(&cus, hipDeviceAttributeMultiprocessorCount, dev) != hipSuccess) { grid = -1; return; }
        if (hipFuncSetAttribute((const void*)mk, hipFuncAttributeMaxDynamicSharedMemorySize, LDS_BYTES) != hipSuccess) { fprintf(stderr, "kernel_launch: hipFuncSetAttribute failed\n"); grid = -1; return; }
        (void)hipGetLastError();
        grid = cus;
    }
    if (grid < 0) return;
    (void)hipMemsetAsync((char*)d_ws + WS_CTL, 0, CTL_BYTES, stream);
    Params p{};
    for (int i = 0; i < 20; ++i) p.in[i] = (const float*)d_in[i];
    p.out = (float*)d_out; p.ws = (unsigned char*)d_ws;
    if (MK_LAUNCHES == 1) { p.ph_lo = 0; p.ph_hi = NPH; hipLaunchKernelGGL(mk, dim3(grid), dim3(512), LDS_BYTES, stream, p); }
    else for (int ph = 0; ph < NPH; ++ph) { p.ph_lo = ph; p.ph_hi = ph + 1; hipLaunchKernelGGL(mk, dim3(grid), dim3(512), LDS_BYTES, stream, p); }
}
```
